# Optimizing an MI355X kernel written in HIP

```python
import jax
import jax.numpy as jnp
from jax import lax
import numpy as np

D_MODEL = 2048
BATCH = 1
SEQ = 16384
DEPTH = 2

RW_HEADS = 16
RW_HEAD = 64
RW_WIDTH = RW_HEADS * RW_HEAD
RW_DECAY_LORA = 96
RW_A_LORA = 96
RW_V_LORA = 64
RW_G_LORA = 256
RW_GN_EPS = 64e-5
RW_BASE_SIZES = (RW_WIDTH, RW_WIDTH, RW_WIDTH, RW_DECAY_LORA, RW_A_LORA, RW_G_LORA)
RW_COLS_FIRST = sum(RW_BASE_SIZES)
RW_COLS_DEEP = RW_COLS_FIRST + RW_V_LORA

NSA_HEADS = 16
NSA_KV_GROUPS = 4
NSA_HPG = NSA_HEADS // NSA_KV_GROUPS
NSA_HEAD = 64
NSA_WIDTH = NSA_HEADS * NSA_HEAD
NSA_KV = NSA_KV_GROUPS * NSA_HEAD
CMP_LEN = 32
CMP_STRIDE = 16
CMP_HIDDEN = 128
SEL_BLOCK = 64
SEL_TOPN = 16
WINDOW = 512
Q_BLOCK = 128
FORCE_BONUS = 1e4
NEG_INF = -1e30
NSA_SIZES = (NSA_WIDTH,) + (NSA_KV,) * 6 + (3 * NSA_HEADS,)
NSA_COLS = sum(NSA_SIZES)

RET_HEADS = 8
RET_HEAD = 128
RET_WIDTH = RET_HEADS * RET_HEAD
RET_CHUNK = 128
RET_THETA = 10000.0
RET_GN_EPS = 1e-5
RET_SIZES = (RET_WIDTH,) * 4
RET_COLS = sum(RET_SIZES)

IN_COLS_FIRST = RW_COLS_FIRST + NSA_COLS + RET_COLS + 3 * D_MODEL
IN_COLS_DEEP = RW_COLS_DEEP + NSA_COLS + RET_COLS + 3 * D_MODEL

N_GROUPS = 4
EXPERTS_PER_GROUP = 8
N_EXPERTS = N_GROUPS * EXPERTS_PER_GROUP
EXPERT_FF = 512
EXPERT_TOPK = 2
MOE_BLOCK = 128

DN_ALPHA = (2 * DEPTH) ** 0.25
DN_BETA = (8 * DEPTH) ** -0.25
LN_EPS = 1e-5

kernel_name = 'hybrid_rwkv7_nsa_retention_hmoe'


def _split(p, sizes):
    idx = [int(i) for i in np.cumsum(sizes)[:-1]]
    return jnp.split(p, idx, axis=-1)


def _layer_norm(x, g, b):
    xf = x.astype(jnp.float32)
    mu = jnp.mean(xf, -1, keepdims=True)
    var = jnp.mean(jnp.square(xf - mu), -1, keepdims=True)
    return ((xf - mu) * lax.rsqrt(var + LN_EPS)).astype(x.dtype) * g + b


def _head_norm(x, eps):
    x = x.astype(jnp.float32)
    mu = jnp.mean(x, -1, keepdims=True)
    var = jnp.mean(jnp.square(x - mu), -1, keepdims=True)
    return (x - mu) * lax.rsqrt(var + eps)


def _token_shift(z, mu):
    prev = jnp.pad(z, ((0, 0), (1, 0), (0, 0)))[:, :-1]
    return z + (prev - z) * mu


def _masked_softmax(s, mask):
    s = jnp.where(mask, s, NEG_INF)
    p = jax.nn.softmax(s, axis=-1)
    return jnp.where(mask, p, 0.0)


def _rwkv7_time_mix(p, mu, w0, w_up, a0, a_up, g_up, k_k, k_a, r_k, lnx_g, lnx_b, v_first, v0, v_up):
    B, S, _ = p.shape
    H, N = RW_HEADS, RW_HEAD
    f32 = jnp.float32
    p = _token_shift(p, mu)
    if v_first is None:
        r, k, v, xw, xa, xg = _split(p, RW_BASE_SIZES)
        v_first = v
    else:
        r, k, v, xw, xa, xg, xv = _split(p, RW_BASE_SIZES + (RW_V_LORA,))
        v = v + (v_first - v) * jax.nn.sigmoid(v0 + xv @ v_up)
    w_log = -jax.nn.softplus(-(w0 + jnp.tanh(xw) @ w_up)) - 0.5
    decay = jnp.exp(-jnp.exp(w_log.astype(f32)))
    a = jax.nn.sigmoid(a0 + xa @ a_up)
    g = jax.nn.sigmoid(xg) @ g_up
    kk = (k * k_k).astype(f32).reshape(B, S, H, N)
    kk = kk / jnp.maximum(jnp.linalg.norm(kk, axis=-1, keepdims=True), 1e-12)
    k = k * (1.0 + (a - 1.0) * k_a)
    heads = lambda t: t.astype(f32).reshape(B, S, H, N)
    r_h, k_h, v_h, a_h, w_h = heads(r), heads(k), heads(v), heads(a), heads(decay)

    def step(state, inp):
        r_t, w_t, k_t, v_t, kk_t, a_t = inp
        s_kk = jnp.einsum('bhij,bhj->bhi', state, kk_t)
        state = (state * w_t[:, :, None, :] - s_kk[..., :, None] * (kk_t * a_t)[..., None, :]
                 + v_t[..., :, None] * k_t[..., None, :])
        return state, jnp.einsum('bhij,bhj->bhi', state, r_t)

    seq_first = lambda t: jnp.moveaxis(t, 1, 0)
    xs = (seq_first(r_h), seq_first(w_h), seq_first(k_h), seq_first(v_h), seq_first(kk), seq_first(a_h))
    _, y = lax.scan(step, jnp.zeros((B, H, N, N), f32), xs)
    y = jnp.moveaxis(y, 0, 1)
    y = _head_norm(y, RW_GN_EPS).reshape(B, S, RW_WIDTH) * lnx_g + lnx_b
    bonus = jnp.sum(r_h * k_h * r_k, -1, keepdims=True) * v_h
    out = (y + bonus.reshape(B, S, RW_WIDTH)) * g.astype(f32)
    return out.astype(p.dtype), v_first


def _nsa_compress(t, pe, w1, b1, w2):
    B, S, G, DH = t.shape
    n_cmp = (S - CMP_LEN) // CMP_STRIDE + 1
    idx = jnp.arange(n_cmp)[:, None] * CMP_STRIDE + jnp.arange(CMP_LEN)[None, :]
    blocks = t[:, idx] + pe[:, None, :]
    blocks = jnp.swapaxes(blocks, 2, 3).reshape(B, n_cmp, G, CMP_LEN * DH)
    return jax.nn.gelu(blocks @ w1 + b1) @ w2


def _nsa(p, cmp_pe, cmp_w1, cmp_b1, cmp_w2):
    B, S, _ = p.shape
    G, HPG, DH = NSA_KV_GROUPS, NSA_HPG, NSA_HEAD
    f32 = jnp.float32
    q, kc, vc, ks, vs, kw, vw, gate = _split(p, NSA_SIZES)
    kv = lambda t: t.reshape(B, S, G, DH)
    q = q.reshape(B, S, G, HPG, DH) * (DH ** -0.5)
    gate = jax.nn.sigmoid(gate).reshape(B, S, G, HPG, 3)
    k_cmp = _nsa_compress(kv(kc), cmp_pe[0], cmp_w1[0], cmp_b1[0], cmp_w2[0])
    v_cmp = _nsa_compress(kv(vc), cmp_pe[1], cmp_w1[1], cmp_b1[1], cmp_w2[1])
    n_cmp = k_cmp.shape[1]
    cmp_start = jnp.arange(n_cmp) * CMP_STRIDE
    cmp_end = cmp_start + CMP_LEN - 1
    n_sel = S // SEL_BLOCK
    top_n = min(SEL_TOPN, n_sel)
    sel_j = jnp.arange(n_sel)
    sel_start = sel_j * SEL_BLOCK
    overlap = ((cmp_start[:, None] < sel_start[None] + SEL_BLOCK)
               & (cmp_start[:, None] + CMP_LEN > sel_start[None])).astype(f32)
    to_blocks = lambda t: kv(t).reshape(B, n_sel, SEL_BLOCK, G, DH).transpose(0, 3, 1, 2, 4)
    ks_b, vs_b = to_blocks(ks), to_blocks(vs)
    pad = lambda t: jnp.pad(kv(t), ((0, 0), (WINDOW, 0), (0, 0), (0, 0)))
    kw_p, vw_p = pad(kw), pad(vw)
    gather_blocks = jax.vmap(jax.vmap(lambda blocks, ids: blocks[ids]))
    win_off = jnp.arange(WINDOW + Q_BLOCK) - WINDOW

    def query_block(qi):
        q0 = qi * Q_BLOCK
        t = q0 + jnp.arange(Q_BLOCK)
        qb = lax.dynamic_slice_in_dim(q, q0, Q_BLOCK, axis=1)
        gb = lax.dynamic_slice_in_dim(gate, q0, Q_BLOCK, axis=1)
        s = jnp.einsum('bqghd,bcgd->bghqc', qb, k_cmp).astype(f32)
        p_cmp = _masked_softmax(s, cmp_end[None, :] <= t[:, None])
        o_cmp = jnp.einsum('bghqc,bcgd->bqghd', p_cmp.astype(v_cmp.dtype), v_cmp)
        imp = jnp.einsum('bghqc,cn->bgqn', p_cmp, overlap)
        cur = (t // SEL_BLOCK)[:, None]
        causal = sel_j[None] <= cur
        forced = (sel_j[None] == 0) | (sel_j[None] == cur) | (sel_j[None] == cur - 1)
        score = jnp.where(causal, imp + jnp.where(forced, FORCE_BONUS, 0.0), NEG_INF)
        top_val, top_idx = lax.top_k(score, top_n)
        k_sel = gather_blocks(ks_b, top_idx).reshape(B, G, Q_BLOCK, top_n * SEL_BLOCK, DH)
        v_sel = gather_blocks(vs_b, top_idx).reshape(B, G, Q_BLOCK, top_n * SEL_BLOCK, DH)
        tok = top_idx[..., None] * SEL_BLOCK + jnp.arange(SEL_BLOCK)
        m_sel = (top_val[..., None] > 0.5 * NEG_INF) & (tok <= t[:, None, None])
        m_sel = m_sel.reshape(B, G, 1, Q_BLOCK, top_n * SEL_BLOCK)
        s = jnp.einsum('bqghd,bgqkd->bghqk', qb, k_sel).astype(f32)
        p_sel = _masked_softmax(s, m_sel)
        o_sel = jnp.einsum('bghqk,bgqkd->bqghd', p_sel.astype(v_sel.dtype), v_sel)
        kwb = lax.dynamic_slice_in_dim(kw_p, q0, WINDOW + Q_BLOCK, axis=1)
        vwb = lax.dynamic_slice_in_dim(vw_p, q0, WINDOW + Q_BLOCK, axis=1)
        s_pos = q0 + win_off
        dist = t[:, None] - s_pos[None]
        m_win = (dist >= 0) & (dist < WINDOW) & (s_pos[None] >= 0)
        s = jnp.einsum('bqghd,bkgd->bghqk', qb, kwb).astype(f32)
        p_win = _masked_softmax(s, m_win)
        o_win = jnp.einsum('bghqk,bkgd->bqghd', p_win.astype(vwb.dtype), vwb)
        return gb[..., 0:1] * o_cmp + gb[..., 1:2] * o_sel + gb[..., 2:3] * o_win

    out = lax.map(query_block, jnp.arange(S // Q_BLOCK))
    return jnp.moveaxis(out, 0, 1).reshape(B, S, NSA_WIDTH)


def _rotate_half(t, cos, sin):
    t1, t2 = jnp.split(t, 2, axis=-1)
    c, s = cos[:, None, :], sin[:, None, :]
    return jnp.concatenate([t1 * c - t2 * s, t1 * s + t2 * c], axis=-1)


def _retention(p):
    B, S, _ = p.shape
    H, DK = RET_HEADS, RET_HEAD
    f32 = jnp.float32
    q, k, v, g = _split(p, RET_SIZES)
    heads = lambda t: t.astype(f32).reshape(B, S, H, DK)
    inv_freq = 1.0 / (RET_THETA ** jnp.linspace(0.0, 1.0, DK // 2))
    ang = jnp.arange(S, dtype=f32)[:, None] * inv_freq[None, :]
    cos, sin = jnp.cos(ang), jnp.sin(ang)
    q = _rotate_half(heads(q), cos, sin)
    k = _rotate_half(heads(k), cos, sin) * (DK ** -0.5)
    v = heads(v)
    log_g = jnp.log1p(-jnp.exp2(-5.0 - jnp.arange(H, dtype=f32)))
    C = RET_CHUNK
    n_chunks = S // C
    i = jnp.arange(C, dtype=f32)
    diff = i[:, None] - i[None, :]
    inner_decay = jnp.where(diff >= 0, jnp.exp(log_g[:, None, None] * jnp.maximum(diff, 0.0)), 0.0)
    q_decay = jnp.exp(log_g[:, None] * (i + 1.0))[..., None]
    k_decay = jnp.exp(log_g[:, None] * (C - 1.0 - i))[..., None]
    c_decay = jnp.exp(log_g * C)[:, None, None]
    chunks = lambda t: t.reshape(B, n_chunks, C, H, DK).transpose(1, 0, 3, 2, 4)

    def step(R, inp):
        qc, kc, vc = inp
        att = jnp.einsum('bhqd,bhkd->bhqk', qc, kc) * inner_decay
        o = jnp.einsum('bhqk,bhkd->bhqd', att, vc) + jnp.einsum('bhqd,bhde->bhqe', qc, R) * q_decay
        R = R * c_decay + jnp.einsum('bhkd,bhke->bhde', kc * k_decay, vc)
        return R, o

    _, o = lax.scan(step, jnp.zeros((B, H, DK, DK), f32), (chunks(q), chunks(k), chunks(v)))
    o = o.transpose(1, 0, 3, 2, 4).reshape(B, S, H, DK)
    o = _head_norm(o, RET_GN_EPS).reshape(B, S, RET_WIDTH)
    return (jax.nn.silu(g.astype(f32)) * o).astype(p.dtype)


def _hier_moe(x, w_grp, b_grp, w_exp, b_exp, w_gate, w_up, w_down):
    B, S, D = x.shape
    T = B * S
    f32 = jnp.float32
    xt = x.reshape(T, D)
    grp_logits = (xt @ w_grp + b_grp).astype(f32)
    grp = jnp.argmax(grp_logits, axis=-1)
    grp_w = jnp.take_along_axis(jax.nn.softmax(grp_logits, -1), grp[:, None], axis=-1)
    exp_logits = (xt @ w_exp + b_exp).astype(f32).reshape(T, N_GROUPS, EXPERTS_PER_GROUP)
    in_grp = jnp.take_along_axis(exp_logits, grp[:, None, None], axis=1)[:, 0]
    top_val, top_idx = lax.top_k(in_grp, EXPERT_TOPK)
    gate_w = (jax.nn.softmax(top_val, -1) * grp_w).reshape(-1)
    expert = (grp[:, None] * EXPERTS_PER_GROUP + top_idx).reshape(-1)
    token = jnp.repeat(jnp.arange(T, dtype=jnp.int32), EXPERT_TOPK)
    n_assign = T * EXPERT_TOPK
    order = jnp.argsort(expert)
    e_s, t_s, w_s = expert[order], token[order], gate_w[order]
    counts = jnp.zeros((N_EXPERTS,), jnp.int32).at[expert].add(1)
    start = jnp.cumsum(counts) - counts
    padded = (counts + MOE_BLOCK - 1) // MOE_BLOCK * MOE_BLOCK
    pad_end = jnp.cumsum(padded)
    slot = (pad_end - padded)[e_s] + jnp.arange(n_assign, dtype=jnp.int32) - start[e_s]
    n_blocks = -(-n_assign // MOE_BLOCK) + N_EXPERTS
    n_slots = n_blocks * MOE_BLOCK
    slot_tok = jnp.full((n_slots,), T, jnp.int32).at[slot].set(t_s)
    slot_w = jnp.zeros((n_slots,), f32).at[slot].set(w_s)
    blk_expert = jnp.minimum(jnp.searchsorted(pad_end, jnp.arange(n_blocks, dtype=jnp.int32) * MOE_BLOCK, side='right'), N_EXPERTS - 1)
    x_slots = jnp.concatenate([xt, jnp.zeros((1, D), xt.dtype)])[slot_tok].reshape(n_blocks, MOE_BLOCK, D)

    def expert_block(args):
        xb, e = args
        h = jax.nn.silu(xb @ w_gate[e]) * (xb @ w_up[e])
        return h @ w_down[e]

    y = lax.map(expert_block, (x_slots, blk_expert)).reshape(n_slots, D)
    out = jax.ops.segment_sum(y * slot_w[:, None].astype(y.dtype), slot_tok, num_segments=T + 1)[:T]
    return out.reshape(B, S, D)


def setup_inputs(seed: int = 0) -> dict:
    key = jax.random.key(seed)
    keys = iter(jax.random.split(key, 48))
    f32 = jnp.float32
    L, D = DEPTH, D_MODEL
    nrm = lambda shape, scale: jax.random.normal(next(keys), shape, f32) * scale
    around = lambda shape, center, scale: center + nrm(shape, scale)
    ratio = (jnp.arange(RW_WIDTH, dtype=f32) / (RW_WIDTH - 1)) ** 0.85
    return {
        'x': nrm((BATCH, SEQ, D), 1.0),
        'w_in_first': nrm((D, IN_COLS_FIRST), D ** -0.5),
        'w_in_deep': nrm((L - 1, D, IN_COLS_DEEP), D ** -0.5),
        'rw_mu_first': jax.random.uniform(next(keys), (RW_COLS_FIRST,), f32),
        'rw_mu_deep': jax.random.uniform(next(keys), (L - 1, RW_COLS_DEEP), f32),
        'rw_w0': -6.0 + 5.0 * ratio + nrm((L, RW_WIDTH), 0.1),
        'rw_w_up': nrm((L, RW_DECAY_LORA, RW_WIDTH), 0.5 * RW_DECAY_LORA ** -0.5),
        'rw_a0': nrm((L, RW_WIDTH), 0.1),
        'rw_a_up': nrm((L, RW_A_LORA, RW_WIDTH), RW_A_LORA ** -0.5),
        'rw_v0': around((L - 1, RW_WIDTH), 1.0, 0.1),
        'rw_v_up': nrm((L - 1, RW_V_LORA, RW_WIDTH), RW_V_LORA ** -0.5),
        'rw_g_up': nrm((L, RW_G_LORA, RW_WIDTH), RW_G_LORA ** -0.5),
        'rw_k_k': around((L, RW_WIDTH), 0.85, 0.05),
        'rw_k_a': around((L, RW_WIDTH), 1.0, 0.05),
        'rw_r_k': nrm((L, RW_HEADS, RW_HEAD), 0.1),
        'rw_lnx_g': around((L, RW_WIDTH), 1.0, 0.05),
        'rw_lnx_b': nrm((L, RW_WIDTH), 0.02),
        'nsa_cmp_pe': nrm((L, 2, CMP_LEN, NSA_HEAD), 0.2),
        'nsa_cmp_w1': nrm((L, 2, CMP_LEN * NSA_HEAD, CMP_HIDDEN), (CMP_LEN * NSA_HEAD) ** -0.5),
        'nsa_cmp_b1': nrm((L, 2, CMP_HIDDEN), 0.02),
        'nsa_cmp_w2': nrm((L, 2, CMP_HIDDEN, NSA_HEAD), CMP_HIDDEN ** -0.5),
        'w_br_rw': nrm((L, RW_WIDTH, D), RW_WIDTH ** -0.5),
        'w_br_nsa': nrm((L, NSA_WIDTH, D), NSA_WIDTH ** -0.5),
        'w_br_ret': nrm((L, RET_WIDTH, D), RET_WIDTH ** -0.5),
        'w_out': nrm((L, D, D), D ** -0.5 * DN_BETA),
        'ln1_g': around((L, D), 1.0, 0.05),
        'ln1_b': nrm((L, D), 0.02),
        'moe_w_grp': nrm((L, D, N_GROUPS), D ** -0.5),
        'moe_b_grp': nrm((L, N_GROUPS), 0.01),
        'moe_w_exp': nrm((L, D, N_EXPERTS), D ** -0.5),
        'moe_b_exp': nrm((L, N_EXPERTS), 0.01),
        'moe_w_gate': nrm((L, N_EXPERTS, D, EXPERT_FF), D ** -0.5),
        'moe_w_up': nrm((L, N_EXPERTS, D, EXPERT_FF), D ** -0.5),
        'moe_w_down': nrm((L, N_EXPERTS, EXPERT_FF, D), EXPERT_FF ** -0.5 * DN_BETA),
        'ln2_g': around((L, D), 1.0, 0.05),
        'ln2_b': nrm((L, D), 0.02),
    }


def reference(x, w_in_first, w_in_deep, rw_mu_first, rw_mu_deep, rw_w0, rw_w_up, rw_a0, rw_a_up, rw_v0, rw_v_up, rw_g_up, rw_k_k, rw_k_a, rw_r_k, rw_lnx_g, rw_lnx_b, nsa_cmp_pe, nsa_cmp_w1, nsa_cmp_b1, nsa_cmp_w2, w_br_rw, w_br_nsa, w_br_ret, w_out, ln1_g, ln1_b, moe_w_grp, moe_b_grp, moe_w_exp, moe_b_exp, moe_w_gate, moe_w_up, moe_w_down, ln2_g, ln2_b):
    v_first = None
    for l in range(DEPTH):
        first = l == 0
        w_in = w_in_first if first else w_in_deep[l - 1]
        mu = rw_mu_first if first else rw_mu_deep[l - 1]
        rw_cols = RW_COLS_FIRST if first else RW_COLS_DEEP
        proj = x @ w_in
        p_rw, p_nsa, p_ret, g_rw, g_nsa, g_ret = _split(proj, (rw_cols, NSA_COLS, RET_COLS, D_MODEL, D_MODEL, D_MODEL))
        y_rw, v_first = _rwkv7_time_mix(p_rw, mu, rw_w0[l], rw_w_up[l], rw_a0[l], rw_a_up[l], rw_g_up[l],
                                        rw_k_k[l], rw_k_a[l], rw_r_k[l], rw_lnx_g[l], rw_lnx_b[l], v_first,
                                        None if first else rw_v0[l - 1], None if first else rw_v_up[l - 1])
        y_nsa = _nsa(p_nsa, nsa_cmp_pe[l], nsa_cmp_w1[l], nsa_cmp_b1[l], nsa_cmp_w2[l])
        y_ret = _retention(p_ret)
        merged = (jax.nn.sigmoid(g_rw) * (y_rw @ w_br_rw[l])
                  + jax.nn.sigmoid(g_nsa) * (y_nsa @ w_br_nsa[l])
                  + jax.nn.sigmoid(g_ret) * (y_ret @ w_br_ret[l]))
        x = _layer_norm(DN_ALPHA * x + merged @ w_out[l], ln1_g[l], ln1_b[l])
        moe = _hier_moe(x, moe_w_grp[l], moe_b_grp[l], moe_w_exp[l], moe_b_exp[l], moe_w_gate[l], moe_w_up[l], moe_w_down[l])
        x = _layer_norm(DN_ALPHA * x + moe, ln2_g[l], ln2_b[l])
    return x
```

```cpp
#define MK_ONE_LAUNCH 1
#include <hip/hip_runtime.h>
#include <cstdio>
#include <cstdint>

#ifndef MK_ONE_LAUNCH
#define MK_ONE_LAUNCH 0
#endif

namespace pg8 {
#define PG8_LAS __attribute__((address_space(3)))
typedef unsigned short bf16_t;
typedef short bf16x8 __attribute__((ext_vector_type(8)));
typedef float f32x4 __attribute__((ext_vector_type(4)));
typedef unsigned u32x4 __attribute__((ext_vector_type(4)));
constexpr int BM = 256, BK = 64, HALF = 128, HTB = HALF * BK * 2  , STAGE_BYTES = 8 * HTB, NXCD = 8, WGM = 8;

__host__ __device__ __forceinline__ int lds_byte(int r, int c) { const int st = (r >> 4) * 2 + (c >> 5), rr = r & 15, cc = c & 31, ob = rr * 64 + cc * 2; return st * 1024 + (ob ^ (((ob >> 9) & 1) << 5)); }
__host__ __device__ __forceinline__ void stage_rc(int b, int& R, int& C) { const int st = b / 1024, sb = b % 1024, swz = sb ^ (((sb >> 9) & 1) << 5); R = (st >> 1) * 16 + swz / 64; C = (st & 1) * 32 + (swz % 64) / 2; }
__host__ __device__ __forceinline__ int perm32(int rho) { const int n = rho >> 4, i = rho & 15; return 8 * (i >> 2) + 4 * n + (i & 3); }

struct Unit { int pm, pn, aux; const char* a; const char* b; };
struct Gemm { int K, lda, ldb; };

struct TileOrder {
    int nM, nN, nwg;
    __device__ void init(int nM_, int nN_) { nM = nM_; nN = nN_; nwg = nM * nN; }
    __device__ bool tile(long L, int& pm, int& pn) const {
        if (L >= nwg) return false;
        int wgid = (int)L; { const int q = nwg / NXCD, r = nwg % NXCD, xcd = wgid % NXCD, off = wgid / NXCD; wgid = (xcd < r ? xcd * (q + 1) : r * (q + 1) + (xcd - r) * q) + off; }
        const int nig = WGM * nN, gid = wgid / nig, fm = gid * WGM, gsz = (nM - fm) < WGM ? (nM - fm) : WGM;
        pm = fm + ((wgid % nig) % gsz); pn = (wgid % nig) / gsz; return true;
    }
};

typedef float f32x2_t __attribute__((ext_vector_type(2))); typedef __bf16 bf16x2_t __attribute__((ext_vector_type(2)));
__device__ __forceinline__ unsigned cvt_pk_bf16(float lo, float hi) { f32x2_t v = {lo, hi}; bf16x2_t b = __builtin_convertvector(v, bf16x2_t); return __builtin_bit_cast(unsigned, b); }

template <class Epi, class Sched, bool ALIGN_EPI = false, bool SP2 = false>
__device__ __forceinline__ void gemm_phase(PG8_LAS unsigned char* lds, const Gemm g, const Sched& S, const Epi& E) {
    const int tid = S.tid, wid = __builtin_amdgcn_readfirstlane(tid >> 6), lane = tid & 63, wr = wid >> 2, wc = wid & 3, fr = lane & 15, fq = lane >> 4;
    const int K = g.K, nt = K / BK;
    unsigned voffA[2], voffB[2];
#pragma unroll
    for (int i = 0; i < 2; ++i) { int R, C; stage_rc(tid * 16 + i * 8192, R, C); const int Rb = Epi::PERM ? ((R & ~31) + perm32(R & 31)) : R;
        voffA[i] = (unsigned)(R * g.lda + C) * 2u; voffB[i] = (unsigned)(Rb * g.ldb + C) * 2u; }
    const size_t kstep = (size_t)(BK * 2);
    const size_t hstepA = (size_t)HALF * g.lda * 2, hstepB = (size_t)HALF * g.ldb * 2;
    const unsigned ldsw = (unsigned)wid * 1024u;
    const int aoff = lds_byte(wr * 64 + fr, fq * 8), boff = lds_byte(wc * 32 + fr, fq * 8);
#define PG8_SA(b, h) (((b) * 2 + (h)) * HTB)
#define PG8_SB(b, h) ((4 + (b) * 2 + (h)) * HTB)
#define PG8_STAGE(bufoff, gbase, voff) do { _Pragma("unroll") for (int _i = 0; _i < 2; ++_i) \
        __builtin_amdgcn_global_load_lds((const unsigned*)((const char*)(gbase) + (voff)[_i]), (PG8_LAS unsigned*)(lds + (bufoff) + ldsw + _i * 8192), 16, 0, 0); } while (0)
#define PG8_LDA(dst, b, h) do { _Pragma("unroll") for (int m = 0; m < 4; ++m) _Pragma("unroll") for (int k = 0; k < 2; ++k) dst[m][k] = *(const PG8_LAS bf16x8*)(lds + PG8_SA(b, h) + aoff + m * 2048 + k * 1024); } while (0)
#define PG8_LDB(dst, b, h) do { _Pragma("unroll") for (int n = 0; n < 2; ++n) _Pragma("unroll") for (int k = 0; k < 2; ++k) dst[n][k] = *(const PG8_LAS bf16x8*)(lds + PG8_SB(b, h) + boff + n * 2048 + k * 1024); } while (0)
#define PG8_MMA(ai, bj, At, Bt) do { __builtin_amdgcn_s_setprio(1); _Pragma("unroll") for (int m = 0; m < 4; ++m) _Pragma("unroll") for (int n = 0; n < 2; ++n) _Pragma("unroll") for (int k = 0; k < 2; ++k) \
        acc[ai][bj][m][n] = __builtin_amdgcn_mfma_f32_16x16x32_bf16(Bt[n][k], At[m][k], acc[ai][bj][m][n], 0, 0, 0); __builtin_amdgcn_s_setprio(0); } while (0)
#define PG8_WAIT_V(n) asm volatile("s_waitcnt vmcnt(" #n ")" ::: "memory")
#define PG8_WAIT_L(n) asm volatile("s_waitcnt lgkmcnt(" #n ")" ::: "memory")
#define PG8_BAR __builtin_amdgcn_s_barrier()
#define PG8_SCHED __builtin_amdgcn_sched_barrier(0)
    Unit cur, nxt; int ui = 0;
    if (!S.next(0, cur)) return;
    f32x4 acc[2][2][4][2];
#pragma unroll
    for (int a = 0; a < 2; ++a)
#pragma unroll
        for (int b = 0; b < 2; ++b)
#pragma unroll
            for (int m = 0; m < 4; ++m)
#pragma unroll
                for (int n = 0; n < 2; ++n) acc[a][b][m][n] = (f32x4){0.f, 0.f, 0.f, 0.f};
    bf16x8 At[4][2], B0[2][2], B1[2][2];
    const char* cA = cur.a; const char* cB = cur.b;
    if constexpr (SP2) {
        PG8_STAGE(PG8_SB(0, 0), cB, voffB); PG8_STAGE(PG8_SB(0, 1), cB + hstepB, voffB); PG8_STAGE(PG8_SA(0, 0), cA, voffA); PG8_STAGE(PG8_SA(0, 1), cA + hstepA, voffA);
        if (wr == 1) PG8_BAR;
        PG8_WAIT_V(2); PG8_BAR;
        PG8_STAGE(PG8_SB(1, 0), cB + kstep, voffB); PG8_STAGE(PG8_SA(1, 0), cA + kstep, voffA); PG8_STAGE(PG8_SB(1, 1), cB + hstepB + kstep, voffB);
        PG8_WAIT_V(6); PG8_BAR;
    } else {
        PG8_STAGE(PG8_SB(0, 0), cB, voffB); PG8_STAGE(PG8_SA(0, 0), cA, voffA); PG8_STAGE(PG8_SB(0, 1), cB + hstepB, voffB); PG8_STAGE(PG8_SA(0, 1), cA + hstepA, voffA);
        if (wr == 1) PG8_BAR;
        PG8_WAIT_V(4); PG8_BAR;
        PG8_STAGE(PG8_SB(1, 0), cB + kstep, voffB); PG8_STAGE(PG8_SA(1, 0), cA + kstep, voffA); PG8_STAGE(PG8_SB(1, 1), cB + hstepB + kstep, voffB);
        PG8_WAIT_V(6); PG8_BAR;
    }
    for (;;) {
        const bool has_next = S.next(ui + 1, nxt);
        const char* nA = has_next ? nxt.a : cA; const char* nB = has_next ? nxt.b : cB;
        for (int t = 0; t < nt; t += 2) {
            const bool last = (t == nt - 2);
            const char* a1 = cA + (size_t)(t + 1) * kstep;
            const char* a2 = last ? nA : cA + (size_t)(t + 2) * kstep; const char* b2 = last ? nB : cB + (size_t)(t + 2) * kstep;
            const char* a3 = a2 + kstep; const char* b3 = b2 + kstep;
            if constexpr (SP2) {
            PG8_LDB(B0, 0, 0); PG8_LDB(B1, 0, 1); PG8_SCHED; PG8_LDA(At, 0, 0); PG8_STAGE(PG8_SA(1, 1), a1 + hstepA, voffA);
            PG8_WAIT_V(8); PG8_WAIT_L(0); PG8_BAR; PG8_MMA(0, 0, At, B0); PG8_MMA(0, 1, At, B1); PG8_BAR; PG8_SCHED;
            PG8_LDA(At, 0, 1); PG8_STAGE(PG8_SB(0, 0), b2, voffB); PG8_STAGE(PG8_SB(0, 1), b2 + hstepB, voffB); PG8_STAGE(PG8_SA(0, 0), a2, voffA);
            PG8_WAIT_V(8); PG8_WAIT_L(0); PG8_BAR; PG8_MMA(1, 0, At, B0); PG8_MMA(1, 1, At, B1); PG8_BAR; PG8_SCHED;
            PG8_LDB(B0, 1, 0); PG8_LDB(B1, 1, 1); PG8_SCHED; PG8_LDA(At, 1, 0); PG8_STAGE(PG8_SA(0, 1), a2 + hstepA, voffA);
            PG8_WAIT_V(8); PG8_WAIT_L(0); PG8_BAR; PG8_MMA(0, 0, At, B0); PG8_MMA(0, 1, At, B1); PG8_BAR; PG8_SCHED;
            PG8_LDA(At, 1, 1); PG8_STAGE(PG8_SB(1, 0), b3, voffB); PG8_STAGE(PG8_SB(1, 1), b3 + hstepB, voffB); PG8_STAGE(PG8_SA(1, 0), a3, voffA);
            PG8_WAIT_V(8); PG8_WAIT_L(0); PG8_BAR; PG8_MMA(1, 0, At, B0); PG8_MMA(1, 1, At, B1); PG8_BAR; PG8_SCHED;
            } else {
            PG8_LDB(B0, 0, 0); PG8_SCHED; PG8_LDA(At, 0, 0); PG8_STAGE(PG8_SA(1, 1), a1 + hstepA, voffA);
            PG8_WAIT_L(8); PG8_BAR; PG8_WAIT_L(0); PG8_MMA(0, 0, At, B0); PG8_BAR; PG8_SCHED;
            PG8_LDB(B1, 0, 1); PG8_STAGE(PG8_SB(0, 0), b2, voffB);
            PG8_BAR; PG8_WAIT_L(0); PG8_MMA(0, 1, At, B1); PG8_BAR;
            PG8_LDA(At, 0, 1); PG8_STAGE(PG8_SA(0, 0), a2, voffA);
            PG8_BAR; PG8_WAIT_L(0); PG8_MMA(1, 0, At, B0); PG8_BAR; PG8_SCHED;
            PG8_STAGE(PG8_SB(0, 1), b2 + hstepB, voffB);
            PG8_WAIT_V(6); PG8_BAR; PG8_MMA(1, 1, At, B1); PG8_BAR;
            PG8_LDB(B0, 1, 0); PG8_SCHED; PG8_LDA(At, 1, 0); PG8_STAGE(PG8_SA(0, 1), a2 + hstepA, voffA);
            PG8_WAIT_L(8); PG8_BAR; PG8_WAIT_L(0); PG8_MMA(0, 0, At, B0); PG8_BAR; PG8_SCHED;
            PG8_LDB(B1, 1, 1); PG8_STAGE(PG8_SB(1, 0), b3, voffB);
            PG8_BAR; PG8_WAIT_L(0); PG8_MMA(0, 1, At, B1); PG8_BAR;
            PG8_LDA(At, 1, 1); PG8_STAGE(PG8_SA(1, 0), a3, voffA);
            PG8_BAR; PG8_WAIT_L(0); PG8_MMA(1, 0, At, B0); PG8_BAR; PG8_SCHED;
            PG8_STAGE(PG8_SB(1, 1), b3 + hstepB, voffB);
            PG8_WAIT_V(6); PG8_BAR; PG8_MMA(1, 1, At, B1); PG8_BAR;
            }
        }
        if constexpr (ALIGN_EPI) { if (wr == 0) PG8_BAR; }
        E(acc, cur, wr, wc, fr, fq);
        if (!has_next) break;
#pragma unroll
        for (int a = 0; a < 2; ++a)
#pragma unroll
            for (int b = 0; b < 2; ++b)
#pragma unroll
                for (int m = 0; m < 4; ++m)
#pragma unroll
                    for (int n = 0; n < 2; ++n) acc[a][b][m][n] = (f32x4){0.f, 0.f, 0.f, 0.f};
        cur = nxt; cA = nA; cB = nB; ++ui;
        if constexpr (ALIGN_EPI) { if (wr == 1) PG8_BAR; }
    }
    PG8_WAIT_V(0);
    if constexpr (!ALIGN_EPI) { if (wr == 0) PG8_BAR; }
    PG8_BAR;
    #undef PG8_SA
#undef PG8_SB
#undef PG8_STAGE
#undef PG8_LDA
#undef PG8_LDB
#undef PG8_MMA
#undef PG8_WAIT_V
#undef PG8_WAIT_L
#undef PG8_BAR
#undef PG8_SCHED
}
}

#ifndef PG8_SP2
#define PG8_SP2 true
#endif
#ifndef PG8_ALIGN
#define PG8_ALIGN true
#endif

constexpr int T = 16384, D = 2048, DEPTH = 2;
constexpr int RWW = 1024;
constexpr int NCMP = 1023, NSELB = 256;
constexpr int NEXP = 32, FF = 512;
constexpr int LDP = 10496;
constexpr int NG = 6144;
constexpr int PC_RW_R = 0, PC_RW_K = 1024, PC_RW_V = 2048, PC_NQ = 3072, PC_KC = 4096, PC_VC = 4352, PC_KS = 4608, PC_VS = 4864, PC_KW = 5120, PC_VW = 5376,
              PC_RQ = 5632, PC_RK = 6656, PC_RV = 7680, PC_RG = 8704, PC_XW = 9728, PC_XA = 9824, PC_XG = 9920, PC_XV = 10176, PC_GATE = 10240;
constexpr float DN_ALPHA = 1.41421356237f, LN_EPS = 1e-5f;

constexpr size_t MiB = 1u << 20;
constexpr size_t WS_CTL = 0, CTL_ZERO_BYTES = 1 * MiB;
constexpr size_t WS_TEXP = 1 * MiB, WS_TOKE = WS_TEXP + 65536, WS_TOKW = WS_TOKE + 131072, WS_SLOT = WS_TOKW + 131072;
constexpr size_t WS_KCMP = 2 * MiB, WS_VCMP = 3 * MiB, WS_RKB = 4 * MiB, WS_COS = 8 * MiB, WS_SIN = 12 * MiB;
constexpr size_t WS_WIN = 16 * MiB, WS_WG = 57 * MiB, WS_WBR = 81 * MiB, WS_WOUT = 93 * MiB;
constexpr size_t WS_XB = 112 * MiB, WS_VF = 176 * MiB, WS_PROJ = 208 * MiB;
constexpr size_t WS_RW_R = 536 * MiB, WS_RW_K = 568 * MiB, WS_RW_V = 600 * MiB, WS_RW_KK = 632 * MiB, WS_RW_B = 664 * MiB, WS_RW_W = 696 * MiB, WS_RW_G = 760 * MiB;
constexpr size_t WS_YRW = 800 * MiB, WS_YNSA = 832 * MiB, WS_YRET = 864 * MiB;
constexpr size_t WS_RWP = 896 * MiB, WS_RWU = 912 * MiB, WS_RWS = 928 * MiB, WS_RETKV = 944 * MiB, WS_END = 1008 * MiB;
constexpr size_t WS_GATES = 536 * MiB, WS_MERGED = 728 * MiB;
constexpr size_t WS_WGU = 208 * MiB, WS_WDN = 336 * MiB, WS_XS = 400 * MiB, WS_H = 560 * MiB, WS_YS = 600 * MiB;
static_assert(WS_PROJ + (size_t)T * LDP * 2 <= WS_RW_R && WS_GATES + (size_t)T * NG * 2 <= WS_MERGED && WS_MERGED + (size_t)T * D * 2 <= WS_YRW, "ws map");
static_assert(WS_XS + (size_t)160 * 256 * D * 2 <= WS_H && WS_H + (size_t)160 * 256 * FF * 2 <= WS_YS && WS_YS + (size_t)160 * 256 * D * 2 <= WS_RW_G, "ws map moe");
constexpr int CW_TMO = 0, CW_CNT = 1024, CW_CUR = 1088, CW_BAR = 4096;
constexpr int LDS_BYTES = 147456, LDS_BARW = LDS_BYTES - 64;

#define GAS __attribute__((address_space(1)))
#define LAS __attribute__((address_space(3)))
typedef unsigned short bf16;
typedef float f32x4 __attribute__((ext_vector_type(4)));
typedef unsigned u32x4 __attribute__((ext_vector_type(4)));
#define LDS_WAIT() asm volatile("s_waitcnt lgkmcnt(0)" ::: "memory")
#define VM_WAIT() asm volatile("s_waitcnt vmcnt(0)" ::: "memory")

__device__ __forceinline__ float bf2f(unsigned short b) { return __uint_as_float(((unsigned)b) << 16); }
__device__ __forceinline__ unsigned f2bf(float f) { unsigned u = __float_as_uint(f); return (u + 0x7fffu + ((u >> 16) & 1u)) >> 16; }
__device__ __forceinline__ unsigned pk2(float lo, float hi) { return f2bf(lo) | (f2bf(hi) << 16); }
__device__ __forceinline__ float bflo(unsigned w) { return __uint_as_float(w << 16); }
__device__ __forceinline__ float bfhi(unsigned w) { return __uint_as_float(w & 0xffff0000u); }
__device__ __forceinline__ float wave_sum(float v) {
#pragma unroll
    for (int o = 1; o < 64; o <<= 1) v += __shfl_xor(v, o);
    return v;
}
__device__ __forceinline__ float wave_max(float v) {
#pragma unroll
    for (int o = 1; o < 64; o <<= 1) v = fmaxf(v, __shfl_xor(v, o));
    return v;
}
__device__ __forceinline__ int wave_min_i(int v) {
#pragma unroll
    for (int o = 1; o < 64; o <<= 1) { const int w = __shfl_xor(v, o); v = w < v ? w : v; }
    return v;
}
__device__ __forceinline__ float sigm(float x) { return 1.f / (1.f + expf(-x)); }
__device__ __forceinline__ float sigm_fast(float x) { return __builtin_amdgcn_rcpf(1.f + __builtin_amdgcn_exp2f(-1.4426950408889634f * x)); }

__device__ const double INV_FREQ[64] = {1.00000000000000000e+00, 8.63988449483968579e-01, 7.46476040841712152e-01, 6.44946677103762411e-01, 5.57226479550717357e-01, 4.81437242078434580e-01, 4.15956216307184767e-01, 3.59381366380462752e-01, 3.10501349512486036e-01, 2.68269579527972590e-01, 2.31781818060089240e-01, 2.00256813604311801e-01, 1.73019573884589412e-01, 1.49486913370923374e-01, 1.29154966501488389e-01, 1.11588399250774864e-01, 9.64110880490750138e-02, 8.32980664765826800e-02, 7.19685673001152076e-02, 6.21800108732091794e-02, 5.37228111832403141e-02, 4.64158883361278016e-02, 4.01027913949520837e-02, 3.46483485573036779e-02, 2.99357729472049007e-02, 2.58641620527596990e-02, 2.23463372691659473e-02, 1.93069772888325060e-02, 1.66810053720005923e-02, 1.44121959671885402e-02, 1.24519708473503302e-02, 1.07583589854217902e-02, 9.29509789880649494e-03, 8.03085722139152032e-03, 6.93856787873718770e-03, 5.99484250318940964e-03, 5.17947467923121282e-03, 4.47500629725045354e-03, 3.86635375219241198e-03, 3.34048498351324471e-03, 2.88614044143008968e-03, 2.49359200498416086e-03, 2.15443469003188427e-03, 1.86140668735512152e-03, 1.60823387766704205e-03, 1.38949549437313892e-03, 1.20050805774840792e-03, 1.03722509540705695e-03, 8.96150501946605012e-04, 7.74263682681127744e-04, 6.68954878691414585e-04, 5.77969288415331340e-04, 4.99358789347314927e-04, 4.31440226144378508e-04, 3.72759372031494166e-04, 3.22059791872108224e-04, 2.78255940220712632e-04, 2.40409918350997456e-04, 2.07711392596645640e-04, 1.79460244029731636e-04, 1.55051577983262559e-04, 1.33962772451801717e-04, 1.15742288059205792e-04, 1.00000000000000005e-04};
__device__ const float RET_LOGG[8] = {-0.0317486983145803f, -0.015748356968139168f, -0.007843177461025893f, -0.003913899321136329f, -0.0019550348358033506f, -0.0009770396478266127f, -0.0004884004981088745f, -0.0002441704321739145f};

#define XB_TMO      128
#define XB_XCNT(j)  (256  + 64 * (j))
#define XB_XSUB(j)  (1280 + 64 * (j))
#define XB_XGEN(j)  (2304 + 64 * (j))
#define XB_TOP      3328
#define XB_TOPGEN   3392
#define XCD_BAR_WORDS 3456
#define XB_SPIN_CAP (1u << 18)

__device__ __forceinline__ unsigned xb_ld(unsigned* p)              { return __hip_atomic_load(p, __ATOMIC_RELAXED, __HIP_MEMORY_SCOPE_AGENT); }
__device__ __forceinline__ unsigned xb_add(unsigned* p, unsigned v) { return __hip_atomic_fetch_add(p, v, __ATOMIC_RELAXED, __HIP_MEMORY_SCOPE_AGENT); }
__device__ __forceinline__ unsigned xb_xcc_id() { return (unsigned)__builtin_amdgcn_s_getreg((3 << 11) | 20) & 0xFu; }
#define XB_SPIN(cond, bar) do { unsigned _sp = 0; while (cond) { __builtin_amdgcn_s_sleep(1); \
    if ((++_sp & 255u) == 0u) { if (xb_ld(&(bar)[XB_TMO])) break; if (_sp > XB_SPIN_CAP) { atomicAdd(&(bar)[XB_TMO], 1u); break; } } } } while (0)

struct XcdBarrier {
    unsigned* bar; unsigned x;
    volatile LAS unsigned* st;
};
__device__ __forceinline__ XcdBarrier xcd_barrier_post(unsigned* bar, volatile LAS unsigned* st) {
    XcdBarrier b; b.bar = bar; b.x = xb_xcc_id(); b.st = st;
    if (threadIdx.x == 0) (void)xb_add(&bar[XB_XCNT(b.x)], 1u);
    return b;
}
__device__ __forceinline__ void xcd_barrier_complete(unsigned* bar, unsigned x, unsigned& nloc, unsigned& nx) {
    const unsigned G = gridDim.x * gridDim.y * gridDim.z;
    unsigned sum, cnt, mine, sp = 0u;
    for (;;) {
        sum = 0u; cnt = 0u; mine = 0u;
#pragma unroll
        for (unsigned j = 0; j < 16; ++j) { const unsigned c = xb_ld(&bar[XB_XCNT(j)]); sum += c; cnt += (c > 0u) ? 1u : 0u; mine = (j == x) ? c : mine; }
        if (sum == G) break;
        __builtin_amdgcn_s_sleep(1);
        if ((++sp & 255u) == 0u) { if (xb_ld(&bar[XB_TMO])) break; if (sp > XB_SPIN_CAP) { atomicAdd(&bar[XB_TMO], 1u); break; } }
    }
    nloc = mine > 0u ? mine : 1u; nx = cnt > 0u ? cnt : 1u;
}
__device__ __forceinline__ void xcd_barrier(const XcdBarrier& b) {
    asm volatile("s_waitcnt vmcnt(0)" ::: "memory");
    __syncthreads();
    if (threadIdx.x == 0) {
        unsigned* bar = b.bar;
        __builtin_amdgcn_s_waitcnt(0);
        unsigned nloc = b.st[0], nx = b.st[1];
        if (nloc == 0u) { xcd_barrier_complete(bar, b.x, nloc, nx); b.st[0] = nloc; b.st[1] = nx; }
        const unsigned old = xb_add(&bar[XB_XSUB(b.x)], 1u);
        const unsigned gen = old / nloc;
        if (old + 1u == (gen + 1u) * nloc) {
            __builtin_amdgcn_fence(__ATOMIC_RELEASE, "agent");
            asm volatile("s_waitcnt vmcnt(0)" ::: "memory");
            const unsigned og = xb_add(&bar[XB_TOP], 1u);
            const unsigned tg = og / nx;
            if (og + 1u == (tg + 1u) * nx) xb_add(&bar[XB_TOPGEN], 1u);
            else XB_SPIN(xb_ld(&bar[XB_TOPGEN]) == tg, bar);
            __builtin_amdgcn_fence(__ATOMIC_ACQUIRE, "agent");
            xb_add(&bar[XB_XGEN(b.x)], 1u);
            asm volatile("s_waitcnt vmcnt(0)" ::: "memory");
        } else {
            XB_SPIN(xb_ld(&bar[XB_XGEN(b.x)]) == gen, bar);
            __builtin_amdgcn_fence(__ATOMIC_ACQUIRE, "agent");
            asm volatile("s_waitcnt vmcnt(0)" ::: "memory");
        }
    }
    __syncthreads();
}

struct Args { const float* in[36]; float* out; unsigned char* ws; int ph_lo, ph_hi; };
constexpr int LDS_PTAB = LDS_BYTES - 512;
struct PA { unsigned char* ws; float* out; const LAS unsigned* tab;
    __device__ __forceinline__ const float* in(int i) const { const unsigned lo = __builtin_amdgcn_readfirstlane(tab[2 * i]), hi = __builtin_amdgcn_readfirstlane(tab[2 * i + 1]);
        return (const float*)(((unsigned long long)hi << 32) | lo); } };

using pg8::Unit; using pg8::Gemm; using pg8::TileOrder;
struct SchedPlain {
    TileOrder to; int G, c, tid; const char* A; const char* B; size_t ta, tb;
    __device__ __forceinline__ bool next(int i, Unit& u) const {
        if (!to.tile((long)i * G + c, u.pm, u.pn)) return false;
        u.a = A + (size_t)u.pm * ta; u.b = B + (size_t)u.pn * tb; u.aux = 0; return true; }
};
struct SchedBranch {
    TileOrder to; int G, c, tid; const char* A0; const char* B0; size_t sa, sb, ta, tb;
    __device__ __forceinline__ bool next(int i, Unit& u) const {
        const int br = i % 3;
        if (!to.tile((long)(i / 3) * G + c, u.pm, u.pn)) return false;
        u.a = A0 + (size_t)br * sa + (size_t)u.pm * ta; u.b = B0 + (size_t)br * sb + (size_t)u.pn * tb; u.aux = br; return true; }
};
struct SchedMoe {
    int nM, nN, G, c, tid; const char* A; const char* B; size_t ta, tb, te; const int* texp;
    __device__ __forceinline__ bool next(int i, Unit& u) const {
        const long L = (long)i * G + c; if (L >= (long)nM * nN) return false;
        u.pm = (int)(L % nM); u.pn = (int)(L / nM); const int e = texp[u.pm];
        u.a = A + (size_t)u.pm * ta; u.b = B + (size_t)e * te + (size_t)u.pn * tb; u.aux = e; return true; }
};
template <int ACT  > struct EpiStore {
    static constexpr bool PERM = true;
    bf16* O; int ldc;
    __device__ __forceinline__ void operator()(const f32x4 (&acc)[2][2][4][2], const Unit& u, int wr, int wc, int fr, int fq) const {
        const int row0 = u.pm * 256 + wr * 64 + fr, col0 = u.pn * 256 + wc * 32 + 8 * fq;
#pragma unroll
        for (int ai = 0; ai < 2; ++ai)
#pragma unroll
            for (int m = 0; m < 4; ++m) { bf16* rowp = O + (size_t)(row0 + ai * 128 + m * 16) * ldc + col0;
#pragma unroll
                for (int bj = 0; bj < 2; ++bj) { f32x4 v0 = acc[ai][bj][m][0], v1 = acc[ai][bj][m][1];
                    if (ACT == 1) {
#pragma unroll
                        for (int j = 0; j < 4; ++j) { v0[j] = sigm_fast(v0[j]); v1[j] = sigm_fast(v1[j]); } }
                    u32x4 w; w.x = pg8::cvt_pk_bf16(v0[0], v0[1]); w.y = pg8::cvt_pk_bf16(v0[2], v0[3]); w.z = pg8::cvt_pk_bf16(v1[0], v1[1]); w.w = pg8::cvt_pk_bf16(v1[2], v1[3]);
                    *(u32x4*)(rowp + bj * 128) = w; __builtin_amdgcn_sched_barrier(0); } }
    }
};
struct EpiBranch {
    static constexpr bool PERM = true;
    bf16* Mg; const bf16* Gt;
    __device__ __forceinline__ void operator()(const f32x4 (&acc)[2][2][4][2], const Unit& u, int wr, int wc, int fr, int fq) const {
        const int row0 = u.pm * 256 + wr * 64 + fr, col0 = u.pn * 256 + wc * 32 + 8 * fq, br = u.aux;
#pragma unroll
        for (int ai = 0; ai < 2; ++ai)
#pragma unroll
            for (int m = 0; m < 4; ++m) { const size_t r = (size_t)(row0 + ai * 128 + m * 16);
#pragma unroll
                for (int bj = 0; bj < 2; ++bj) { const int col = col0 + bj * 128;
                    const u32x4 gw = *(const u32x4*)(Gt + r * NG + br * 2048 + col);
                    f32x4 v0 = acc[ai][bj][m][0], v1 = acc[ai][bj][m][1];
                    v0[0] *= bflo(gw.x); v0[1] *= bfhi(gw.x); v0[2] *= bflo(gw.y); v0[3] *= bfhi(gw.y); v1[0] *= bflo(gw.z); v1[1] *= bfhi(gw.z); v1[2] *= bflo(gw.w); v1[3] *= bfhi(gw.w);
                    bf16* mp = Mg + r * D + col;
                    if (br != 0) { const u32x4 ow = *(const u32x4*)mp;
                        v0[0] += bflo(ow.x); v0[1] += bfhi(ow.x); v0[2] += bflo(ow.y); v0[3] += bfhi(ow.y); v1[0] += bflo(ow.z); v1[1] += bfhi(ow.z); v1[2] += bflo(ow.w); v1[3] += bfhi(ow.w); }
                    u32x4 w; w.x = pg8::cvt_pk_bf16(v0[0], v0[1]); w.y = pg8::cvt_pk_bf16(v0[2], v0[3]); w.z = pg8::cvt_pk_bf16(v1[0], v1[1]); w.w = pg8::cvt_pk_bf16(v1[2], v1[3]);
                    *(u32x4*)mp = w; __builtin_amdgcn_sched_barrier(0); } }
    }
};
struct EpiResid {
    static constexpr bool PERM = true;
    float* X;
    __device__ __forceinline__ void operator()(const f32x4 (&acc)[2][2][4][2], const Unit& u, int wr, int wc, int fr, int fq) const {
        const int row0 = u.pm * 256 + wr * 64 + fr, col0 = u.pn * 256 + wc * 32 + 8 * fq;
#pragma unroll
        for (int ai = 0; ai < 2; ++ai)
#pragma unroll
            for (int m = 0; m < 4; ++m) { float* rowp = X + (size_t)(row0 + ai * 128 + m * 16) * D + col0;
#pragma unroll
                for (int bj = 0; bj < 2; ++bj) { f32x4* p = (f32x4*)(rowp + bj * 128);
                    const f32x4 x0 = p[0], x1 = p[1];
                    p[0] = x0 * DN_ALPHA + acc[ai][bj][m][0]; p[1] = x1 * DN_ALPHA + acc[ai][bj][m][1]; __builtin_amdgcn_sched_barrier(0); } }
    }
};
struct EpiGateUp {
    static constexpr bool PERM = true;
    bf16* H;
    __device__ __forceinline__ void operator()(const f32x4 (&acc)[2][2][4][2], const Unit& u, int wr, int wc, int fr, int fq) const {
        const int row0 = u.pm * 256 + wr * 64 + fr, col0 = u.pn * 128 + wc * 32 + 8 * fq;
#pragma unroll
        for (int ai = 0; ai < 2; ++ai)
#pragma unroll
            for (int m = 0; m < 4; ++m) { bf16* rowp = H + (size_t)(row0 + ai * 128 + m * 16) * FF + col0;
                f32x4 h0, h1;
#pragma unroll
                for (int j = 0; j < 4; ++j) { const float g0 = acc[ai][0][m][0][j], g1 = acc[ai][0][m][1][j];
                    h0[j] = g0 * sigm_fast(g0) * acc[ai][1][m][0][j]; h1[j] = g1 * sigm_fast(g1) * acc[ai][1][m][1][j]; }
                u32x4 w; w.x = pg8::cvt_pk_bf16(h0[0], h0[1]); w.y = pg8::cvt_pk_bf16(h0[2], h0[3]); w.z = pg8::cvt_pk_bf16(h1[0], h1[1]); w.w = pg8::cvt_pk_bf16(h1[2], h1[3]);
                *(u32x4*)rowp = w; }
    }
};

struct Ctx { LAS unsigned char* lds; int tid, lane, wave, G, bx, gw, NGW; };

template <class SRC>
__device__ __forceinline__ void transpose_task(const Ctx& c, const SRC& src, int ldsrc, int K, bf16* dst, int ndst) {
    LAS float* scr = (LAS float*)(c.lds + c.wave * 8704);
    const int nblk = ndst / 32, items = (K / 64) * nblk, lane = c.lane;
    for (int it = c.gw; it < items; it += c.NGW) {
        const int kb = it / nblk, nb = it % nblk, k0 = 64 * kb, n0 = 32 * nb;
        const float* sp = src(n0 + (lane & 31));
#pragma unroll 8
        for (int i = 0; i < 32; ++i) { const int kk = 2 * i + (lane >> 5); scr[kk * 33 + (lane & 31)] = sp ? sp[(size_t)(k0 + kk) * ldsrc] : 0.f; }
        LDS_WAIT();
        const int cc = lane & 7;
#pragma unroll
        for (int j = 0; j < 4; ++j) { const int n = (lane >> 3) + 8 * j; const LAS float* s = scr + (8 * cc) * 33 + n;
            u32x4 o; o.x = pk2(s[0 * 33], s[1 * 33]); o.y = pk2(s[2 * 33], s[3 * 33]); o.z = pk2(s[4 * 33], s[5 * 33]); o.w = pk2(s[6 * 33], s[7 * 33]);
            *(u32x4*)(dst + (size_t)(n0 + n) * K + k0 + 8 * cc) = o; }
        LDS_WAIT();
    }
}
struct SrcWin { const float* W; int layer;
    __device__ __forceinline__ const float* operator()(int n) const {
        const int rw = layer ? 3584 : 3520; int sc;
        if (n < 3072) sc = n; else if (n < 5632) sc = rw + (n - 3072); else if (n < 9728) sc = rw + 2608 + (n - 5632); else if (n < 10176) sc = 3072 + (n - 9728);
        else if (n < 10240) sc = layer ? 3520 + (n - 10176) : -1; else if (n < 10288) sc = rw + 2560 + (n - 10240); else sc = -1;
        return sc >= 0 ? W + sc : nullptr; } };
struct SrcOff { const float* W; __device__ __forceinline__ const float* operator()(int n) const { return W + n; } };
struct SrcGU { const float* Wg; const float* Wu;
    __device__ __forceinline__ const float* operator()(int nn) const { const int e = nn >> 10, r1 = nn & 1023, pn = r1 >> 8, rr = r1 & 255;
        const size_t du = (size_t)((const char*)Wu - (const char*)Wg);
        return (const float*)((const char*)Wg + (rr < 128 ? (size_t)0 : du)) + (size_t)e * D * FF + 128 * pn + (rr & 127); } };
struct SrcDN { const float* Wd;
    __device__ __forceinline__ const float* operator()(int nn) const { const int e = nn >> 11, n = nn & 2047; return Wd + (size_t)e * FF * D + n; } };

__device__ __forceinline__ void ph_conv(const Ctx& c, const PA& a, int layer) {
    unsigned char* ws = a.ws;
    const float* Win = layer ? a.in(2) : a.in(1); const int ldw = layer ? 16432 : 16368, rw = layer ? 3584 : 3520;
    transpose_task(c, SrcWin{Win, layer}, ldw, D, (bf16*)(ws + WS_WIN), LDP);
    transpose_task(c, SrcOff{Win + rw + 2608 + 4096}, ldw, D, (bf16*)(ws + WS_WG), NG);
    transpose_task(c, SrcOff{a.in(21) + (size_t)layer * RWW * D}, D, RWW, (bf16*)(ws + WS_WBR), D);
    transpose_task(c, SrcOff{a.in(22) + (size_t)layer * RWW * D}, D, RWW, (bf16*)(ws + WS_WBR) + (size_t)D * RWW, D);
    transpose_task(c, SrcOff{a.in(23) + (size_t)layer * RWW * D}, D, RWW, (bf16*)(ws + WS_WBR) + (size_t)2 * D * RWW, D);
    transpose_task(c, SrcOff{a.in(24) + (size_t)layer * D * D}, D, D, (bf16*)(ws + WS_WOUT), D);
    if (layer == 0) {
        const f32x4* x4 = (const f32x4*)a.in(0); f32x4* o4 = (f32x4*)a.out; uint2* xb = (uint2*)(ws + WS_XB);
        for (size_t i = (size_t)c.bx * 512 + c.tid; i < (size_t)T * D / 4; i += (size_t)c.G * 512) { const f32x4 v = x4[i]; o4[i] = v; xb[i] = make_uint2(pk2(v[0], v[1]), pk2(v[2], v[3])); }
        float* cs = (float*)(ws + WS_COS); float* sn = (float*)(ws + WS_SIN);
        for (int i = c.bx * 512 + c.tid; i < T * 64; i += c.G * 512) { const int t = i >> 6, j = i & 63;
            const double rev = (double)t * INV_FREQ[j] * 0.15915494309189533577; const float fr = (float)(rev - __builtin_rint(rev));
            cs[i] = __builtin_amdgcn_cosf(fr); sn[i] = __builtin_amdgcn_sinf(fr); }
    }
}
__device__ __forceinline__ void ph_conv_moe(const Ctx& c, const PA& a, int layer) {
    unsigned char* ws = a.ws; const size_t lo = (size_t)layer * NEXP * D * FF;
    transpose_task(c, SrcGU{a.in(31) + lo, a.in(32) + lo}, FF, D, (bf16*)(ws + WS_WGU), NEXP * 1024);
    transpose_task(c, SrcDN{a.in(33) + lo}, D, FF, (bf16*)(ws + WS_WDN), NEXP * D);
}

__device__ __forceinline__ float softplusf_(float x) { return fmaxf(x, 0.f) + log1pf(expf(-fabsf(x))); }
__device__ __forceinline__ void prep_rwkv(const Ctx& c, const PA& a, int layer) {
    unsigned char* ws = a.ws; const bf16* proj = (const bf16*)(ws + WS_PROJ);
    LAS float* sh_r = (LAS float*)c.lds; LAS float* sh_k = sh_r + 8 * 1024; LAS float* sh_v = sh_k + 8 * 1024; LAS float* sh_x = sh_v + 8 * 1024;
    bf16* oR = (bf16*)(ws + WS_RW_R); bf16* oK = (bf16*)(ws + WS_RW_K); bf16* oV = (bf16*)(ws + WS_RW_V); bf16* oKK = (bf16*)(ws + WS_RW_KK); bf16* oB = (bf16*)(ws + WS_RW_B);
    float* oW = (float*)(ws + WS_RW_W); bf16* oG = (bf16*)(ws + WS_RW_G); bf16* VF = (bf16*)(ws + WS_VF); float* rkb = (float*)(ws + WS_RKB);
    const int lane = c.lane, w = c.wave, tid = c.tid;
    for (int it = c.bx; it < T / 8; it += c.G) {
        const int t = it * 8 + w;
        const bf16* prow = proj + (size_t)t * LDP; const bf16* pprev = prow - LDP;
        const float* mu = a.in(layer ? 4 : 3);
#pragma unroll
        for (int i = 0; i < 6; ++i) { const int c8 = (lane + 64 * i) * 8;
            const u32x4 p = *(const u32x4*)(prow + c8); u32x4 q = (u32x4){0u, 0u, 0u, 0u}; if (t > 0) q = *(const u32x4*)(pprev + c8);
            const f32x4 m0 = *(const f32x4*)(mu + c8), m1 = *(const f32x4*)(mu + c8 + 4);
            float pv[8] = {bflo(p.x), bfhi(p.x), bflo(p.y), bfhi(p.y), bflo(p.z), bfhi(p.z), bflo(p.w), bfhi(p.w)};
            float qv[8] = {bflo(q.x), bfhi(q.x), bflo(q.y), bfhi(q.y), bflo(q.z), bfhi(q.z), bflo(q.w), bfhi(q.w)};
            LAS float* dstp = (c8 < 1024 ? sh_r + w * 1024 + c8 : (c8 < 2048 ? sh_k + w * 1024 + (c8 - 1024) : sh_v + w * 1024 + (c8 - 2048)));
#pragma unroll
            for (int j = 0; j < 8; ++j) { const float mm = j < 4 ? m0[j] : m1[j - 4]; dstp[j] = pv[j] + (qv[j] - pv[j]) * mm; } }
        { const int i8 = lane * 8; int sc, mi, fn;
            if (i8 < 96) { sc = PC_XW + i8; mi = 3072 + i8; fn = 1; } else if (i8 < 192) { sc = PC_XA + (i8 - 96); mi = 3168 + (i8 - 96); fn = 0; }
            else if (i8 < 448) { sc = PC_XG + (i8 - 192); mi = 3264 + (i8 - 192); fn = 2; } else { sc = PC_XV + (i8 - 448); mi = 3520 + (i8 - 448); fn = layer ? 0 : 3; }
            const u32x4 p = *(const u32x4*)(prow + sc); u32x4 q = (u32x4){0u, 0u, 0u, 0u}; if (t > 0) q = *(const u32x4*)(pprev + sc);
            float pv[8] = {bflo(p.x), bfhi(p.x), bflo(p.y), bfhi(p.y), bflo(p.z), bfhi(p.z), bflo(p.w), bfhi(p.w)};
            float qv[8] = {bflo(q.x), bfhi(q.x), bflo(q.y), bfhi(q.y), bflo(q.z), bfhi(q.z), bflo(q.w), bfhi(q.w)};
#pragma unroll
            for (int j = 0; j < 8; ++j) { float s = 0.f;
                if (fn != 3) { const float mm = mu[mi + j]; s = pv[j] + (qv[j] - pv[j]) * mm; if (fn == 1) s = tanhf(s); else if (fn == 2) s = sigm(s); }
                sh_x[w * 512 + i8 + j] = s; } }
        __syncthreads();
        float sw[8][2], sa[8][2], sg[8][2], sv[8][2];
#pragma unroll
        for (int k = 0; k < 8; ++k) { sw[k][0] = sw[k][1] = sa[k][0] = sa[k][1] = sg[k][0] = sg[k][1] = sv[k][0] = sv[k][1] = 0.f; }
        { const float* w_up = a.in(6) + (size_t)layer * 96 * 1024; const float* a_up = a.in(8) + (size_t)layer * 96 * 1024;
        for (int k = 0; k < 96; ++k) { const float u0 = w_up[k * 1024 + tid], u1 = w_up[k * 1024 + tid + 512], b0 = a_up[k * 1024 + tid], b1 = a_up[k * 1024 + tid + 512];
#pragma unroll
            for (int tk = 0; tk < 8; ++tk) { const float x = sh_x[tk * 512 + k], y = sh_x[tk * 512 + 96 + k]; sw[tk][0] += x * u0; sw[tk][1] += x * u1; sa[tk][0] += y * b0; sa[tk][1] += y * b1; } } }
        { const float* g_up = a.in(11) + (size_t)layer * 256 * 1024;
        for (int k = 0; k < 256; ++k) { const float u0 = g_up[k * 1024 + tid], u1 = g_up[k * 1024 + tid + 512];
#pragma unroll
            for (int tk = 0; tk < 8; ++tk) { const float x = sh_x[tk * 512 + 192 + k]; sg[tk][0] += x * u0; sg[tk][1] += x * u1; } } }
        if (layer) { const float* v_up = a.in(10);
        for (int k = 0; k < 64; ++k) { const float u0 = v_up[k * 1024 + tid], u1 = v_up[k * 1024 + tid + 512];
#pragma unroll
            for (int tk = 0; tk < 8; ++tk) { const float x = sh_x[tk * 512 + 448 + k]; sv[tk][0] += x * u0; sv[tk][1] += x * u1; } } }
#pragma unroll
        for (int ci = 0; ci < 2; ++ci) { const int col = tid + 512 * ci, head = w + 8 * ci;
            const float kkc = a.in(12)[layer * 1024 + col], kac = a.in(13)[layer * 1024 + col], rkc = a.in(14)[layer * 1024 + col], w0c = a.in(5)[layer * 1024 + col], a0c = a.in(7)[layer * 1024 + col], v0c = layer ? a.in(9)[col] : 0.f;
#pragma unroll
            for (int tk = 0; tk < 8; ++tk) { const int tt = it * 8 + tk; const size_t o = (size_t)tt * 1024 + col;
                const float k0 = sh_k[tk * 1024 + col], r = sh_r[tk * 1024 + col], v0 = sh_v[tk * 1024 + col];
                const float kkraw = k0 * kkc, n2 = wave_sum(kkraw * kkraw), kkn = kkraw / fmaxf(sqrtf(n2), 1e-12f);
                const float aa = sigm(a0c + sa[tk][ci]), bb = kkn * aa, kf = k0 * (1.f + (aa - 1.f) * kac);
                const float z = w0c + sw[tk][ci], wl = -softplusf_(-z) - 0.5f, dec = expf(-expf(wl));
                float vv = v0;
                if (layer) { const float vf = bf2f(VF[o]); vv = v0 + (vf - v0) * sigm(v0c + sv[tk][ci]); } else VF[o] = (bf16)f2bf(v0);
                const float rk = wave_sum(r * kf * rkc);
                if (lane == 0) rkb[tt * 16 + head] = rk;
                oR[o] = (bf16)f2bf(r); oK[o] = (bf16)f2bf(kf); oV[o] = (bf16)f2bf(vv); oKK[o] = (bf16)f2bf(kkn); oB[o] = (bf16)f2bf(bb); oW[o] = dec; oG[o] = (bf16)f2bf(sg[tk][ci]); } }
        __syncthreads();
    }
}
__device__ __forceinline__ float gelu_tanh(float x) { return 0.5f * x * (1.f + tanhf(0.7978845608028654f * (x + 0.044715f * x * x * x))); }
__device__ __forceinline__ void prep_cmp(const Ctx& c, const PA& a, int layer) {
    unsigned char* ws = a.ws; const bf16* proj = (const bf16*)(ws + WS_PROJ);
    LAS float* sh_in = (LAS float*)c.lds; LAS float* sh_h = sh_in + 4 * 2048;
    const int tid = c.tid;
    for (int it = c.bx; it < NCMP * 2; it += c.G) {
        const int cb = it >> 1, kv = it & 1, col0 = kv ? PC_VC : PC_KC, lk = layer * 2 + kv;
        const float* pe = a.in(17) + (size_t)lk * 2048; const float* w1 = a.in(18) + (size_t)lk * 2048 * 128; const float* b1 = a.in(19) + lk * 128; const float* w2 = a.in(20) + (size_t)lk * 128 * 64;
        for (int idx = tid; idx < 8192; idx += 512) { const int g = idx >> 11, r = idx & 2047, l = r >> 6, d = r & 63;
            sh_in[idx] = bf2f(proj[(size_t)(16 * cb + l) * LDP + col0 + g * 64 + d]) + pe[r]; }
        __syncthreads();
        { const int g = tid >> 7, j = tid & 127; float acc = b1[j]; const LAS float* in = sh_in + g * 2048;
#pragma unroll 8
            for (int i = 0; i < 2048; ++i) acc += in[i] * w1[i * 128 + j];
            sh_h[tid] = gelu_tanh(acc); }
        __syncthreads();
        if (tid < 256) { const int g = tid >> 6, d = tid & 63; float o = 0.f;
#pragma unroll 8
            for (int j = 0; j < 128; ++j) o += sh_h[g * 128 + j] * w2[j * 64 + d];
            ((float*)(ws + (kv ? WS_VCMP : WS_KCMP)))[((size_t)g * 1024 + cb) * 64 + d] = o; }
        __syncthreads();
    }
}
__device__ __forceinline__ void prep_rope(const Ctx& c, const PA& a) {
    unsigned char* ws = a.ws; bf16* proj = (bf16*)(ws + WS_PROJ); const float* cs = (const float*)(ws + WS_COS); const float* sn = (const float*)(ws + WS_SIN);
    for (int i = c.bx * 512 + c.tid; i < T * 8 * 64; i += c.G * 512) { const int j = i & 63, h = (i >> 6) & 7, t = i >> 9;
        const float co = cs[t * 64 + j], si = sn[t * 64 + j];
        bf16* q = proj + (size_t)t * LDP + PC_RQ + h * 128 + j; bf16* k = proj + (size_t)t * LDP + PC_RK + h * 128 + j;
        const float q1 = bf2f(q[0]), q2 = bf2f(q[64]), k1 = bf2f(k[0]), k2 = bf2f(k[64]);
        q[0] = (bf16)f2bf(q1 * co - q2 * si); q[64] = (bf16)f2bf(q1 * si + q2 * co);
        k[0] = (bf16)f2bf((k1 * co - k2 * si) * 0.08838834764831845f); k[64] = (bf16)f2bf((k1 * si + k2 * co) * 0.08838834764831845f); }
}

constexpr int RW_NC = 64, RW_CL = 256, RW_TS = 8;
__device__ __forceinline__ void rw_stage(const unsigned char* ws, LAS float* tile, int t0, int h, int lane, bool need_r) {
    const unsigned e0 = (unsigned)(t0 * 1024 + h * 64 + lane);
#pragma unroll
    for (int s = 0; s < RW_TS; ++s) { const unsigned e = e0 + (unsigned)s * 1024u; LAS float* tp = tile + s * 384 + lane;
        tp[0] = bf2f(*(const bf16*)(ws + ((unsigned)WS_RW_KK + e * 2u))); tp[64] = bf2f(*(const bf16*)(ws + ((unsigned)WS_RW_B + e * 2u))); tp[128] = *(const float*)(ws + ((unsigned)WS_RW_W + e * 4u));
        tp[192] = bf2f(*(const bf16*)(ws + ((unsigned)WS_RW_K + e * 2u))); tp[256] = need_r ? bf2f(*(const bf16*)(ws + ((unsigned)WS_RW_R + e * 2u))) : 0.f; tp[320] = bf2f(*(const bf16*)(ws + ((unsigned)WS_RW_V + e * 2u))); }
}
#define RW_STEP_UPDATE(tp, vi) { \
    float s0 = 0.f, s1 = 0.f, s2 = 0.f, s3 = 0.f; \
    _Pragma("unroll") for (int jj = 0; jj < 16; ++jj) { const f32x4 k4 = *(const LAS f32x4*)((tp) + 4 * jj); s0 += S[4 * jj] * k4[0]; s1 += S[4 * jj + 1] * k4[1]; s2 += S[4 * jj + 2] * k4[2]; s3 += S[4 * jj + 3] * k4[3]; } \
    const float sk = (s0 + s1) + (s2 + s3); \
    _Pragma("unroll") for (int jj = 0; jj < 16; ++jj) { const f32x4 b4 = *(const LAS f32x4*)((tp) + 64 + 4 * jj), w4 = *(const LAS f32x4*)((tp) + 128 + 4 * jj), k4 = *(const LAS f32x4*)((tp) + 192 + 4 * jj); \
        _Pragma("unroll") for (int q = 0; q < 4; ++q) S[4 * jj + q] = S[4 * jj + q] * w4[q] + ((vi) * k4[q] - sk * b4[q]); } }

__device__ __forceinline__ void rw_pass1(const Ctx& c, const PA& a) {
    const unsigned char* ws = a.ws; LAS float* tile = (LAS float*)(c.lds + c.wave * (RW_TS * 384 * 4));
    const int lane = c.lane;
    for (int task = c.gw; task < 16 * RW_NC * 2; task += c.NGW) {
        const int kind = task & 1, hc = task >> 1, h = hc / RW_NC, ch = hc % RW_NC;
        float S[64]; int lz = kind ? 64 : lane; asm volatile("" : "+v"(lz));
#pragma unroll
        for (int j = 0; j < 64; ++j) S[j] = (j == lz) ? 1.f : 0.f;
        for (int t0 = ch * RW_CL; t0 < (ch + 1) * RW_CL; t0 += RW_TS) {
            rw_stage(ws, tile, t0, h, lane, false);
            LDS_WAIT();
#pragma unroll 1
            for (int s = 0; s < RW_TS; ++s) { const LAS float* tp = tile + s * 384; const float vi = kind ? tp[320 + lane] : 0.f; RW_STEP_UPDATE(tp, vi); }
            LDS_WAIT();
        }
        float* out = (float*)(a.ws + (kind ? WS_RWU : WS_RWP)) + ((size_t)hc * 64 + lane) * 64;
#pragma unroll
        for (int jj = 0; jj < 16; ++jj) *(f32x4*)(out + 4 * jj) = (f32x4){S[4 * jj], S[4 * jj + 1], S[4 * jj + 2], S[4 * jj + 3]};
    }
}
__device__ __forceinline__ void rw_pass2(const Ctx& c, const PA& a) {
    const float* P = (const float*)(a.ws + WS_RWP); const float* U = (const float*)(a.ws + WS_RWU); float* Si = (float*)(a.ws + WS_RWS);
    const int lane = c.lane;
    for (int task = c.gw; task < 16 * 64; task += c.NGW) { const int h = task >> 6, i = task & 63;
        float s = 0.f;
        for (int ch = 0; ch < RW_NC; ++ch) { const size_t hc = (size_t)h * RW_NC + ch;
            Si[(hc * 64 + i) * 64 + lane] = s;
            float acc = U[(hc * 64 + i) * 64 + lane]; const float* Pc = P + hc * 4096 + lane;
#pragma unroll
            for (int i2 = 0; i2 < 64; ++i2) acc += __shfl(s, i2) * Pc[i2 * 64];
            s = acc; }
    }
}
__device__ __forceinline__ void rw_pass3(const Ctx& c, const PA& a, int layer) {
    const unsigned char* ws = a.ws; LAS float* tile = (LAS float*)(c.lds + c.wave * (RW_TS * 384 * 4));
    const float* Si = (const float*)(ws + WS_RWS); const float* rkb = (const float*)(ws + WS_RKB); const bf16* G = (const bf16*)(ws + WS_RW_G); bf16* Y = (bf16*)(a.ws + WS_YRW);
    const float* lng = a.in(15) + layer * 1024; const float* lnb = a.in(16) + layer * 1024;
    const int lane = c.lane;
    for (int task = c.gw; task < 16 * RW_NC; task += c.NGW) {
        const int h = task / RW_NC, ch = task % RW_NC, col = h * 64 + lane;
        const float lg = lng[col], lb = lnb[col];
        float S[64]; const float* sp = Si + ((size_t)task * 64 + lane) * 64;
#pragma unroll
        for (int jj = 0; jj < 16; ++jj) { const f32x4 v = *(const f32x4*)(sp + 4 * jj); S[4 * jj] = v[0]; S[4 * jj + 1] = v[1]; S[4 * jj + 2] = v[2]; S[4 * jj + 3] = v[3]; }
        for (int t0 = ch * RW_CL; t0 < (ch + 1) * RW_CL; t0 += RW_TS) {
            rw_stage(ws, tile, t0, h, lane, true);
            LDS_WAIT();
#pragma unroll 1
            for (int s = 0; s < RW_TS; ++s) { const LAS float* tp = tile + s * 384; const float vi = tp[320 + lane]; RW_STEP_UPDATE(tp, vi);
                float y0 = 0.f, y1 = 0.f, y2 = 0.f, y3 = 0.f;
#pragma unroll
                for (int jj = 0; jj < 16; ++jj) { const f32x4 r4 = *(const LAS f32x4*)(tp + 256 + 4 * jj); y0 += S[4 * jj] * r4[0]; y1 += S[4 * jj + 1] * r4[1]; y2 += S[4 * jj + 2] * r4[2]; y3 += S[4 * jj + 3] * r4[3]; }
                const float y = (y0 + y1) + (y2 + y3), mean = wave_sum(y) * (1.f / 64.f), dlt = y - mean, var = wave_sum(dlt * dlt) * (1.f / 64.f);
                const float yn = dlt * (1.f / sqrtf(var + 64e-5f)); const int t = t0 + s; const size_t o = (size_t)t * 1024 + col;
                Y[o] = (bf16)f2bf((yn * lg + lb + rkb[t * 16 + h] * vi) * bf2f(G[o])); }
            LDS_WAIT();
        }
    }
}

__device__ __forceinline__ void ret_kv(const Ctx& c, const PA& a) {
    const bf16* proj = (const bf16*)(a.ws + WS_PROJ); float* KV = (float*)(a.ws + WS_RETKV);
    const int dv = c.tid & 127, dkg = c.tid >> 7;
    for (int it = c.bx; it < 128 * 8; it += c.G) { const int ch = it >> 3, h = it & 7; const float lg = RET_LOGG[h];
        float acc[32];
#pragma unroll
        for (int q = 0; q < 32; ++q) acc[q] = 0.f;
        for (int i = 0; i < 128; ++i) { const bf16* row = proj + (size_t)(ch * 128 + i) * LDP;
            const float vv = bf2f(row[PC_RV + h * 128 + dv]) * expf(lg * (float)(127 - i));
            const u32x4* kp = (const u32x4*)(row + PC_RK + h * 128 + 32 * dkg);
#pragma unroll
            for (int q4 = 0; q4 < 4; ++q4) { const u32x4 kw = kp[q4];
                acc[8 * q4 + 0] += bflo(kw.x) * vv; acc[8 * q4 + 1] += bfhi(kw.x) * vv; acc[8 * q4 + 2] += bflo(kw.y) * vv; acc[8 * q4 + 3] += bfhi(kw.y) * vv;
                acc[8 * q4 + 4] += bflo(kw.z) * vv; acc[8 * q4 + 5] += bfhi(kw.z) * vv; acc[8 * q4 + 6] += bflo(kw.w) * vv; acc[8 * q4 + 7] += bfhi(kw.w) * vv; } }
        float* o = KV + ((size_t)it * 128 + 32 * dkg) * 128 + dv;
#pragma unroll
        for (int q = 0; q < 32; ++q) o[q * 128] = acc[q];
    }
}
__device__ __forceinline__ void ret_prefix(const Ctx& c, const PA& a) {
    float* KV = (float*)(a.ws + WS_RETKV);
    for (int i = c.bx * 512 + c.tid; i < 8 * 16384; i += c.G * 512) { const int h = i >> 14, e = i & 16383; const float cd = expf(RET_LOGG[h] * 128.f);
        float r = 0.f;
        for (int ch = 0; ch < 128; ++ch) { float* p = KV + ((size_t)(ch * 8 + h) << 14) + e; const float tmp = *p; *p = r; r = r * cd + tmp; } }
}
__device__ __forceinline__ void ret_out(const Ctx& c, const PA& a) {
    const bf16* proj = (const bf16*)(a.ws + WS_PROJ); const float* KV = (const float*)(a.ws + WS_RETKV); bf16* Y = (bf16*)(a.ws + WS_YRET);
    constexpr int RS = 130;
    LAS bf16* sq = (LAS bf16*)c.lds; LAS bf16* sk = sq + 128 * RS; LAS bf16* sv = sk + 128 * RS; LAS float* att = (LAS float*)(sv + 128 * RS);
    const int tid = c.tid, lane = c.lane, w = c.wave;
    for (int it = c.bx; it < 128 * 8; it += c.G) { const int ch = it >> 3, h = it & 7; const float lg = RET_LOGG[h];
        for (int idx = tid; idx < 128 * 64; idx += 512) { const int i = idx >> 6, d2 = (idx & 63) * 2; const bf16* row = proj + (size_t)(ch * 128 + i) * LDP + h * 128 + d2;
            *(LAS unsigned*)(sq + i * RS + d2) = *(const unsigned*)(row + PC_RQ); *(LAS unsigned*)(sk + i * RS + d2) = *(const unsigned*)(row + PC_RK); *(LAS unsigned*)(sv + i * RS + d2) = *(const unsigned*)(row + PC_RV); }
        __syncthreads();
        for (int half = 0; half < 2; ++half) {
            { const int s = tid & 127, ig = tid >> 7;
                float ac[16];
#pragma unroll
                for (int r = 0; r < 16; ++r) ac[r] = 0.f;
                for (int d2 = 0; d2 < 128; d2 += 2) { const unsigned kw = *(const LAS unsigned*)(sk + s * RS + d2); const float k0 = bflo(kw), k1 = bfhi(kw);
#pragma unroll
                    for (int r = 0; r < 16; ++r) { const unsigned qw = *(const LAS unsigned*)(sq + (64 * half + 16 * ig + r) * RS + d2); ac[r] += bflo(qw) * k0 + bfhi(qw) * k1; } }
#pragma unroll
                for (int r = 0; r < 16; ++r) { const int i = 64 * half + 16 * ig + r; att[(16 * ig + r) * 128 + s] = (i >= s) ? ac[r] * expf(lg * (float)(i - s)) : 0.f; } }
            __syncthreads();
            float o[16];
            { const int dv = tid & 127, ig = tid >> 7;
#pragma unroll
                for (int r = 0; r < 16; ++r) o[r] = 0.f;
                for (int dk = 0; dk < 128; ++dk) { const float rv = KV[((size_t)it * 128 + dk) * 128 + dv];
#pragma unroll
                    for (int r = 0; r < 16; ++r) o[r] += bf2f(sq[(64 * half + 16 * ig + r) * RS + dk]) * rv; }
#pragma unroll
                for (int r = 0; r < 16; ++r) o[r] *= expf(lg * (float)(64 * half + 16 * ig + r + 1));
                for (int s = 0; s < 128; ++s) { const float vv = bf2f(sv[s * RS + dv]);
#pragma unroll
                    for (int r = 0; r < 16; ++r) o[r] += att[(16 * ig + r) * 128 + s] * vv; } }
            __syncthreads();
            { const int dv = tid & 127, ig = tid >> 7;
#pragma unroll
                for (int r = 0; r < 16; ++r) att[(16 * ig + r) * 128 + dv] = o[r]; }
            __syncthreads();
            for (int rr = 0; rr < 8; ++rr) { const int ip = w * 8 + rr, t = ch * 128 + 64 * half + ip;
                const float x0 = att[ip * 128 + lane], x1 = att[ip * 128 + 64 + lane];
                const float mean = wave_sum(x0 + x1) * (1.f / 128.f), d0 = x0 - mean, d1 = x1 - mean, var = wave_sum(d0 * d0 + d1 * d1) * (1.f / 128.f), rs = 1.f / sqrtf(var + 1e-5f);
                const bf16* grow = proj + (size_t)t * LDP + PC_RG + h * 128; const float g0 = bf2f(grow[lane]), g1 = bf2f(grow[64 + lane]);
                Y[(size_t)t * 1024 + h * 128 + lane] = (bf16)f2bf(g0 * sigm(g0) * d0 * rs); Y[(size_t)t * 1024 + h * 128 + 64 + lane] = (bf16)f2bf(g1 * sigm(g1) * d1 * rs); }
            __syncthreads();
        }
    }
}

constexpr int NSA_WLDS = 17920;
template <int KIND>
__device__ __forceinline__ f32x4 nsa_branch(const unsigned char* ws, LAS f32x4* P, const LAS f32x4* Q4, const LAS int* KST, int nblk, int hi, int g, int lane, f32x4& inv) {
    const bf16* proj = (const bf16*)(ws + WS_PROJ); const float* kcmp = (const float*)(ws + WS_KCMP) + (size_t)g * 1024 * 64; const float* vcmp = (const float*)(ws + WS_VCMP) + (size_t)g * 1024 * 64;
    constexpr int KC = KIND == 1 ? PC_KS : PC_KW, VC = KIND == 1 ? PC_VS : PC_VW;
    const float NINF = -3.0e38f;
    f32x4 m = (f32x4){NINF, NINF, NINF, NINF};
    for (int b = 0; b < nblk; ++b) { const int key = KST[b] + lane; const bool valid = key >= 0 && key <= hi;
        f32x4 s = (f32x4){NINF, NINF, NINF, NINF};
        if (valid) { f32x4 acc = (f32x4){0.f, 0.f, 0.f, 0.f};
            if (KIND == 0) { const f32x4* kp = (const f32x4*)(kcmp + (size_t)key * 64);
#pragma unroll 4
                for (int d4 = 0; d4 < 16; ++d4) { const f32x4 kv = kp[d4]; acc += Q4[4 * d4] * kv[0] + Q4[4 * d4 + 1] * kv[1] + Q4[4 * d4 + 2] * kv[2] + Q4[4 * d4 + 3] * kv[3]; } }
            else { const u32x4* kp = (const u32x4*)(proj + (size_t)key * LDP + KC + g * 64);
#pragma unroll 2
                for (int d8 = 0; d8 < 8; ++d8) { const u32x4 kw = kp[d8];
                    acc += Q4[8 * d8] * bflo(kw.x) + Q4[8 * d8 + 1] * bfhi(kw.x) + Q4[8 * d8 + 2] * bflo(kw.y) + Q4[8 * d8 + 3] * bfhi(kw.y)
                         + Q4[8 * d8 + 4] * bflo(kw.z) + Q4[8 * d8 + 5] * bfhi(kw.z) + Q4[8 * d8 + 6] * bflo(kw.w) + Q4[8 * d8 + 7] * bfhi(kw.w); } }
            s = acc; }
        P[b * 64 + lane] = s;
        m[0] = fmaxf(m[0], s[0]); m[1] = fmaxf(m[1], s[1]); m[2] = fmaxf(m[2], s[2]); m[3] = fmaxf(m[3], s[3]); }
    m[0] = wave_max(m[0]); m[1] = wave_max(m[1]); m[2] = wave_max(m[2]); m[3] = wave_max(m[3]);
    f32x4 l = (f32x4){0.f, 0.f, 0.f, 0.f};
    LDS_WAIT();
    for (int b = 0; b < nblk; ++b) { const f32x4 s = P[b * 64 + lane]; f32x4 e;
#pragma unroll
        for (int q = 0; q < 4; ++q) e[q] = (s[q] > -1.0e37f) ? expf(s[q] - m[q]) : 0.f;
        P[b * 64 + lane] = e; l += e; }
    l[0] = wave_sum(l[0]); l[1] = wave_sum(l[1]); l[2] = wave_sum(l[2]); l[3] = wave_sum(l[3]);
#pragma unroll
    for (int q = 0; q < 4; ++q) inv[q] = l[q] > 0.f ? 1.f / l[q] : 0.f;
    LDS_WAIT();
    f32x4 acc = (f32x4){0.f, 0.f, 0.f, 0.f};
    for (int b = 0; b < nblk; ++b) { const int ks = KST[b]; const int lo = ks < 0 ? -ks : 0; int up = hi - ks; up = up > 63 ? 63 : up;
        for (int kk = lo; kk <= up; ++kk) { const int key = ks + kk; const f32x4 e = P[b * 64 + kk];
            const float vv = KIND == 0 ? vcmp[(size_t)key * 64 + lane] : bf2f(proj[(size_t)key * LDP + VC + g * 64 + lane]);
            acc += e * vv; } }
    return acc * inv;
}
__device__ __forceinline__ void nsa_attn(const Ctx& c, const PA& a) {
    const unsigned char* ws = a.ws; const bf16* proj = (const bf16*)(ws + WS_PROJ); bf16* Y = (bf16*)(a.ws + WS_YNSA);
    LAS f32x4* P = (LAS f32x4*)(c.lds + c.wave * NSA_WLDS); LAS f32x4* Q4 = P + 1024; LAS int* KST = (LAS int*)(Q4 + 64);
    const int lane = c.lane;
    for (int task = c.gw; task < T * 4; task += c.NGW) { const int t = task >> 2, g = task & 3;
        const bf16* prow = proj + (size_t)t * LDP;
        { f32x4 q; q[0] = bf2f(prow[PC_NQ + (g * 4 + 0) * 64 + lane]) * 0.125f; q[1] = bf2f(prow[PC_NQ + (g * 4 + 1) * 64 + lane]) * 0.125f;
            q[2] = bf2f(prow[PC_NQ + (g * 4 + 2) * 64 + lane]) * 0.125f; q[3] = bf2f(prow[PC_NQ + (g * 4 + 3) * 64 + lane]) * 0.125f; Q4[lane] = q; }
        const int cur = t >> 6, ncv = t >= 31 ? ((t - 31) >> 4) + 1 : 0;
        if (lane < 16) KST[lane] = 64 * lane;
        LDS_WAIT();
        f32x4 inv; f32x4 y = (f32x4){0.f, 0.f, 0.f, 0.f};
        int nb = (cur >> 4) + 1; nb = nb > 16 ? 16 : nb;
        const f32x4 oc = nsa_branch<0>(ws, P, Q4, KST, nb, ncv - 1, g, lane, inv);
        float sc[4];
#pragma unroll
        for (int mm = 0; mm < 4; ++mm) { const int j = 4 * lane + mm; float s = 0.f;
            if (j <= cur) {
#pragma unroll
                for (int q = -1; q < 4; ++q) { const int cc = 4 * j + q; if (cc >= 0) { const f32x4 e = P[cc]; s += (e[0] * inv[0] + e[1] * inv[1]) + (e[2] * inv[2] + e[3] * inv[3]); } }
                if (j == 0 || j == cur || j == cur - 1) s += 1.0e4f; }
            else s = -1.0e30f;
            sc[mm] = s; }
        LDS_WAIT();
        int nsel = 0;
        for (int itk = 0; itk < 16; ++itk) {
            float lv = sc[0]; int lj = 4 * lane;
            if (sc[1] > lv) { lv = sc[1]; lj = 4 * lane + 1; } if (sc[2] > lv) { lv = sc[2]; lj = 4 * lane + 2; } if (sc[3] > lv) { lv = sc[3]; lj = 4 * lane + 3; }
            const float vmax = wave_max(lv); if (vmax < -5.0e29f) break;
            const int jmin = wave_min_i(lv == vmax ? lj : (1 << 30));
            if (lane == 0) KST[itk] = jmin * 64;
            if ((jmin >> 2) == lane) { const int mm = jmin & 3; if (mm == 0) sc[0] = -3.0e38f; else if (mm == 1) sc[1] = -3.0e38f; else if (mm == 2) sc[2] = -3.0e38f; else sc[3] = -3.0e38f; }
            ++nsel; }
        LDS_WAIT();
        const f32x4 os = nsa_branch<1>(ws, P, Q4, KST, nsel, t, g, lane, inv);
        LDS_WAIT();
        if (lane < 8) KST[lane] = t - 511 + 64 * lane;
        LDS_WAIT();
        const f32x4 ow = nsa_branch<2>(ws, P, Q4, KST, 8, t, g, lane, inv);
        LDS_WAIT();
#pragma unroll
        for (int hh = 0; hh < 4; ++hh) { const bf16* gp = prow + PC_GATE + (g * 4 + hh) * 3;
            y[hh] = sigm(bf2f(gp[0])) * oc[hh] + sigm(bf2f(gp[1])) * os[hh] + sigm(bf2f(gp[2])) * ow[hh];
            Y[(size_t)t * 1024 + (g * 4 + hh) * 64 + lane] = (bf16)f2bf(y[hh]); }
    }
}

__device__ __forceinline__ void ln_row(f32x4 (&v)[8], const float* gam, const float* bet, int lane) {
    float s = 0.f;
#pragma unroll
    for (int j = 0; j < 8; ++j) s += (v[j][0] + v[j][1]) + (v[j][2] + v[j][3]);
    const float mean = wave_sum(s) * (1.f / D); float s2 = 0.f;
#pragma unroll
    for (int j = 0; j < 8; ++j) { v[j] = v[j] - mean; s2 += (v[j][0] * v[j][0] + v[j][1] * v[j][1]) + (v[j][2] * v[j][2] + v[j][3] * v[j][3]); }
    const float rstd = 1.f / sqrtf(wave_sum(s2) * (1.f / D) + LN_EPS);
#pragma unroll
    for (int j = 0; j < 8; ++j) { const f32x4 g4 = *(const f32x4*)(gam + 4 * (lane + 64 * j)), b4 = *(const f32x4*)(bet + 4 * (lane + 64 * j)); v[j] = v[j] * rstd * g4 + b4; }
}
__device__ __forceinline__ void ph_ln1_route(const Ctx& c, const PA& a, int layer) {
    unsigned char* ws = a.ws; float* X = a.out; uint2* xb = (uint2*)(ws + WS_XB);
    const float* gam = a.in(25) + layer * D; const float* bet = a.in(26) + layer * D;
    const float* wg = a.in(27) + (size_t)layer * D * 4; const float* bg = a.in(28) + layer * 4; const float* we = a.in(29) + (size_t)layer * D * 32; const float* be = a.in(30) + layer * 32;
    int* toke = (int*)(ws + WS_TOKE); float* tokw = (float*)(ws + WS_TOKW); unsigned* cnt = (unsigned*)(ws + WS_CTL) + CW_CNT + layer * 128;
    LAS float* lg = (LAS float*)(c.lds + c.wave * 256);
    const int lane = c.lane;
    for (int t = c.gw; t < T; t += c.NGW) {
        f32x4* row = (f32x4*)(X + (size_t)t * D); f32x4 v[8];
#pragma unroll
        for (int j = 0; j < 8; ++j) v[j] = row[lane + 64 * j];
        ln_row(v, gam, bet, lane);
#pragma unroll
        for (int j = 0; j < 8; ++j) { row[lane + 64 * j] = v[j]; xb[(size_t)t * (D / 4) + lane + 64 * j] = make_uint2(pk2(v[j][0], v[j][1]), pk2(v[j][2], v[j][3])); }
        LAS float* xr = (LAS float*)(c.lds + 4096 + c.wave * 8192);
#pragma unroll
        for (int j = 0; j < 8; ++j) *(LAS f32x4*)(xr + 4 * (lane + 64 * j)) = v[j];
        LDS_WAIT();
        f32x4 ag = (f32x4){0.f, 0.f, 0.f, 0.f}; f32x4 ae[8];
#pragma unroll
        for (int q = 0; q < 8; ++q) ae[q] = (f32x4){0.f, 0.f, 0.f, 0.f};
#pragma unroll 2
        for (int i = 0; i < 32; ++i) { const int d = lane + 64 * i; const float x = xr[d];
            ag += *(const f32x4*)(wg + (size_t)d * 4) * x;
            const f32x4* wp = (const f32x4*)(we + (size_t)d * 32);
#pragma unroll
            for (int e4 = 0; e4 < 8; ++e4) ae[e4] += wp[e4] * x; }
#pragma unroll
        for (int q = 0; q < 4; ++q) ag[q] = wave_sum(ag[q]) + bg[q];
#pragma unroll
        for (int e4 = 0; e4 < 8; ++e4)
#pragma unroll
            for (int q = 0; q < 4; ++q) ae[e4][q] = wave_sum(ae[e4][q]);
        if (lane == 0) {
#pragma unroll
            for (int e4 = 0; e4 < 8; ++e4)
#pragma unroll
                for (int q = 0; q < 4; ++q) lg[e4 * 4 + q] = ae[e4][q] + be[e4 * 4 + q]; }
        LDS_WAIT();
        int grp = 0; float gm = ag[0];
        if (ag[1] > gm) { gm = ag[1]; grp = 1; } if (ag[2] > gm) { gm = ag[2]; grp = 2; } if (ag[3] > gm) { gm = ag[3]; grp = 3; }
        const float gw_ = 1.f / (expf(ag[0] - gm) + expf(ag[1] - gm) + expf(ag[2] - gm) + expf(ag[3] - gm));
        float v0 = -3.0e38f, v1 = -3.0e38f; int i0 = 0, i1 = 0;
        for (int i = 0; i < 8; ++i) { const float x = lg[grp * 8 + i];
            if (x > v0) { v1 = v0; i1 = i0; v0 = x; i0 = i; } else if (x > v1) { v1 = x; i1 = i; } }
        const float e1 = expf(v1 - v0), p0 = 1.f / (1.f + e1), p1 = e1 * p0;
        if (lane == 0) { toke[2 * t] = grp * 8 + i0; toke[2 * t + 1] = grp * 8 + i1; tokw[2 * t] = p0 * gw_; tokw[2 * t + 1] = p1 * gw_;
            __hip_atomic_fetch_add(cnt + grp * 8 + i0, 1u, __ATOMIC_RELAXED, __HIP_MEMORY_SCOPE_AGENT); __hip_atomic_fetch_add(cnt + grp * 8 + i1, 1u, __ATOMIC_RELAXED, __HIP_MEMORY_SCOPE_AGENT); }
        LDS_WAIT();
    }
}
__device__ __forceinline__ void ph_slot(const Ctx& c, const PA& a, int layer) {
    unsigned char* ws = a.ws; unsigned* cnt = (unsigned*)(ws + WS_CTL) + CW_CNT + layer * 128; unsigned* cur = (unsigned*)(ws + WS_CTL) + CW_CUR + layer * 128;
    int* texp = (int*)(ws + WS_TEXP) + layer * 512; const int* toke = (const int*)(ws + WS_TOKE); int* slot = (int*)(ws + WS_SLOT);
    LAS int* pst = (LAS int*)c.lds;
    if (c.tid == 0) { int off = 0, nt = 0;
#pragma unroll 1
        for (int e = 0; e < NEXP; ++e) { const int n = (int)__hip_atomic_load(cnt + e, __ATOMIC_RELAXED, __HIP_MEMORY_SCOPE_AGENT), tl = (n + 255) >> 8;
            pst[e] = off; off += tl * 256;
            if (c.bx == 0) for (int q = 0; q < tl; ++q) texp[nt + q] = e;
            nt += tl; }
        if (c.bx == 0) texp[255] = nt; }
    __syncthreads();
    const u32x4* xb = (const u32x4*)(ws + WS_XB); u32x4* xs = (u32x4*)(ws + WS_XS);
    for (int as = c.gw; as < 2 * T; as += c.NGW) { const int t = as >> 1, e = toke[as]; int s = 0;
        if (c.lane == 0) s = pst[e] + (int)__hip_atomic_fetch_add(cur + e, 1u, __ATOMIC_RELAXED, __HIP_MEMORY_SCOPE_AGENT);
        s = __shfl(s, 0);
        if (c.lane == 0) slot[as] = s;
#pragma unroll
        for (int j = 0; j < 4; ++j) xs[(size_t)s * 256 + c.lane + 64 * j] = xb[(size_t)t * 256 + c.lane + 64 * j]; }
}
__device__ __forceinline__ void ph_ln2(const Ctx& c, const PA& a, int layer) {
    unsigned char* ws = a.ws; float* X = a.out; uint2* xb = (uint2*)(ws + WS_XB); const uint2* ys = (const uint2*)(ws + WS_YS);
    const float* gam = a.in(34) + layer * D; const float* bet = a.in(35) + layer * D; const int* slot = (const int*)(ws + WS_SLOT); const float* tokw = (const float*)(ws + WS_TOKW);
    const int lane = c.lane;
    for (int t = c.gw; t < T; t += c.NGW) {
        const int s0 = slot[2 * t], s1 = slot[2 * t + 1]; const float w0 = tokw[2 * t], w1 = tokw[2 * t + 1];
        f32x4* row = (f32x4*)(X + (size_t)t * D); f32x4 v[8];
#pragma unroll
        for (int j = 0; j < 8; ++j) { const uint2 y0 = ys[(size_t)s0 * 512 + lane + 64 * j], y1 = ys[(size_t)s1 * 512 + lane + 64 * j]; const f32x4 x = row[lane + 64 * j];
            v[j][0] = x[0] * DN_ALPHA + w0 * bflo(y0.x) + w1 * bflo(y1.x); v[j][1] = x[1] * DN_ALPHA + w0 * bfhi(y0.x) + w1 * bfhi(y1.x);
            v[j][2] = x[2] * DN_ALPHA + w0 * bflo(y0.y) + w1 * bflo(y1.y); v[j][3] = x[3] * DN_ALPHA + w0 * bfhi(y0.y) + w1 * bfhi(y1.y); }
        ln_row(v, gam, bet, lane);
#pragma unroll
        for (int j = 0; j < 8; ++j) { row[lane + 64 * j] = v[j]; xb[(size_t)t * (D / 4) + lane + 64 * j] = make_uint2(pk2(v[j][0], v[j][1]), pk2(v[j][2], v[j][3])); }
    }
}

enum { PH_CONV = 0, PH_INPROJ, PH_PREP, PH_SCAN1, PH_SCAN2, PH_SCAN3, PH_GATES, PH_BRANCH, PH_OUT, PH_LN1, PH_SLOT, PH_MOE_GU, PH_MOE_DN, PH_LN2, NPH_L };
constexpr int NPH = NPH_L * DEPTH;

__device__ __forceinline__ Ctx mkctx(LAS unsigned char* lds, int wv) {
    int ln; asm volatile("v_mbcnt_lo_u32_b32 %0, -1, 0\n\tv_mbcnt_hi_u32_b32 %0, -1, %0" : "=v"(ln));
    int tid = wv * 64 + ln, bx = blockIdx.x, G = gridDim.x;
    asm volatile("" : "+s"(bx)); asm volatile("" : "+s"(G));
    Ctx c; c.lds = lds; c.tid = tid; c.lane = tid & 63; c.wave = __builtin_amdgcn_readfirstlane(tid >> 6); c.G = G; c.bx = bx; c.gw = bx * 8 + c.wave; c.NGW = G * 8; return c;
}
__global__ void __launch_bounds__(512, 2) fwd(Args args0) {
    extern __shared__ __attribute__((aligned(16))) unsigned char lds_raw[];
    LAS unsigned char* const lds0 = (LAS unsigned char*)lds_raw;
    const int lo = args0.ph_lo, hi = args0.ph_hi;
    const int wv0 = __builtin_amdgcn_readfirstlane(threadIdx.x >> 6);
    if (threadIdx.x < 36) ((LAS unsigned long long*)(lds0 + LDS_PTAB))[threadIdx.x] = (unsigned long long)args0.in[threadIdx.x];
    __syncthreads();
#if MK_ONE_LAUNCH
    volatile LAS unsigned* barw = (volatile LAS unsigned*)(lds0 + LDS_BARW);
    if (threadIdx.x == 0) { barw[0] = 0u; barw[1] = 0u; barw[2] = 0u; barw[3] = 0u; }
    __syncthreads();
    XcdBarrier bar = xcd_barrier_post((unsigned*)(args0.ws + WS_CTL) + CW_BAR, barw);
#define SEAM(p) do { if ((p) + 1 < hi) xcd_barrier(bar); } while (0)
#else
#define SEAM(p) do { } while (0)
#endif
#ifndef ONLY_PHASE
#define ONLY_PHASE -1
#endif
#define PHASE_BEGIN PA args; { unsigned char* w_ = args0.ws; asm volatile("" : "+s"(w_)); args.ws = w_; float* o_ = args0.out; asm volatile("" : "+s"(o_)); args.out = o_; args.tab = (const LAS unsigned*)(lds0 + LDS_PTAB); } unsigned char* const ws = args.ws; const Ctx c = mkctx(lds0, wv0); (void)ws; (void)c;
#define TASK_CTX() mkctx(lds0, wv0)
#define IN(p) ((ONLY_PHASE < 0 || ONLY_PHASE == ((p) - pb)) && lo <= (p) && (p) < hi)
    for (int layer = 0; layer < DEPTH; ++layer) {
        const int pb = layer * NPH_L;
        if (IN(pb + PH_CONV)) { PHASE_BEGIN ph_conv(c, args, layer); __syncthreads(); SEAM(pb + PH_CONV); }
        if (IN(pb + PH_INPROJ)) { PHASE_BEGIN
            Gemm g{D, D, D}; SchedPlain S; S.to.init(T / 256, LDP / 256); S.G = c.G; S.c = c.bx; S.tid = c.tid; S.A = (const char*)(ws + WS_XB); S.B = (const char*)(ws + WS_WIN); S.ta = (size_t)256 * D * 2; S.tb = (size_t)256 * D * 2;
            EpiStore<0> E{(bf16*)(ws + WS_PROJ), LDP};
            pg8::gemm_phase<EpiStore<0>, SchedPlain, PG8_ALIGN, PG8_SP2>(c.lds, g, S, E);
            SEAM(pb + PH_INPROJ); }
        if (IN(pb + PH_PREP)) { PHASE_BEGIN prep_rwkv(c, args, layer); __syncthreads(); prep_cmp(TASK_CTX(), args, layer); prep_rope(TASK_CTX(), args); __syncthreads(); SEAM(pb + PH_PREP); }
        if (IN(pb + PH_SCAN1)) { PHASE_BEGIN rw_pass1(c, args); ret_kv(TASK_CTX(), args); __syncthreads(); nsa_attn(TASK_CTX(), args); __syncthreads(); SEAM(pb + PH_SCAN1); }
        if (IN(pb + PH_SCAN2)) { PHASE_BEGIN rw_pass2(c, args); ret_prefix(TASK_CTX(), args); __syncthreads(); SEAM(pb + PH_SCAN2); }
        if (IN(pb + PH_SCAN3)) { PHASE_BEGIN rw_pass3(c, args, layer); __syncthreads(); ret_out(TASK_CTX(), args); __syncthreads(); SEAM(pb + PH_SCAN3); }
        if (IN(pb + PH_GATES)) { PHASE_BEGIN
            Gemm g{D, D, D}; SchedPlain S; S.to.init(T / 256, NG / 256); S.G = c.G; S.c = c.bx; S.tid = c.tid; S.A = (const char*)(ws + WS_XB); S.B = (const char*)(ws + WS_WG); S.ta = (size_t)256 * D * 2; S.tb = (size_t)256 * D * 2;
            EpiStore<1> E{(bf16*)(ws + WS_GATES), NG};
            pg8::gemm_phase<EpiStore<1>, SchedPlain, PG8_ALIGN, PG8_SP2>(c.lds, g, S, E);
            SEAM(pb + PH_GATES); }
        if (IN(pb + PH_BRANCH)) { PHASE_BEGIN
            Gemm g{RWW, RWW, RWW}; SchedBranch S; S.to.init(T / 256, D / 256); S.G = c.G; S.c = c.bx; S.tid = c.tid;
            S.A0 = (const char*)(ws + WS_YRW); S.sa = WS_YNSA - WS_YRW; static_assert(WS_YRET - WS_YNSA == WS_YNSA - WS_YRW, "y buffers equally spaced");
            S.B0 = (const char*)(ws + WS_WBR); S.sb = (size_t)D * RWW * 2; S.ta = (size_t)256 * RWW * 2; S.tb = (size_t)256 * RWW * 2;
            EpiBranch E{(bf16*)(ws + WS_MERGED), (const bf16*)(ws + WS_GATES)};
            pg8::gemm_phase<EpiBranch, SchedBranch, PG8_ALIGN, PG8_SP2>(c.lds, g, S, E);
            SEAM(pb + PH_BRANCH); }
        if (IN(pb + PH_OUT)) { PHASE_BEGIN
            Gemm g{D, D, D}; SchedPlain S; S.to.init(T / 256, D / 256); S.G = c.G; S.c = c.bx; S.tid = c.tid; S.A = (const char*)(ws + WS_MERGED); S.B = (const char*)(ws + WS_WOUT); S.ta = (size_t)256 * D * 2; S.tb = (size_t)256 * D * 2;
            EpiResid E{args.out};
            pg8::gemm_phase<EpiResid, SchedPlain, PG8_ALIGN, PG8_SP2>(c.lds, g, S, E);
            SEAM(pb + PH_OUT); }
        if (IN(pb + PH_LN1)) { PHASE_BEGIN ph_ln1_route(c, args, layer); __syncthreads(); ph_conv_moe(TASK_CTX(), args, layer); __syncthreads(); SEAM(pb + PH_LN1); }
        if (IN(pb + PH_SLOT)) { PHASE_BEGIN ph_slot(c, args, layer); __syncthreads(); SEAM(pb + PH_SLOT); }
        if (IN(pb + PH_MOE_GU)) { PHASE_BEGIN
            const int* texp = (const int*)(ws + WS_TEXP) + layer * 512;
            Gemm g{D, D, D}; SchedMoe S; S.nM = texp[255]; S.nN = 4; S.G = c.G; S.c = c.bx; S.tid = c.tid; S.A = (const char*)(ws + WS_XS); S.B = (const char*)(ws + WS_WGU); S.ta = (size_t)256 * D * 2; S.tb = (size_t)256 * D * 2; S.te = (size_t)1024 * D * 2; S.texp = texp;
            EpiGateUp E{(bf16*)(ws + WS_H)};
            pg8::gemm_phase<EpiGateUp, SchedMoe, PG8_ALIGN, PG8_SP2>(c.lds, g, S, E);
            SEAM(pb + PH_MOE_GU); }
        if (IN(pb + PH_MOE_DN)) { PHASE_BEGIN
            const int* texp = (const int*)(ws + WS_TEXP) + layer * 512;
            Gemm g{FF, FF, FF}; SchedMoe S; S.nM = texp[255]; S.nN = 8; S.G = c.G; S.c = c.bx; S.tid = c.tid; S.A = (const char*)(ws + WS_H); S.B = (const char*)(ws + WS_WDN); S.ta = (size_t)256 * FF * 2; S.tb = (size_t)256 * FF * 2; S.te = (size_t)D * FF * 2; S.texp = texp;
            EpiStore<0> E{(bf16*)(ws + WS_YS), D};
            pg8::gemm_phase<EpiStore<0>, SchedMoe, PG8_ALIGN, PG8_SP2>(c.lds, g, S, E);
            SEAM(pb + PH_MOE_DN); }
        if (IN(pb + PH_LN2)) { PHASE_BEGIN ph_ln2(c, args, layer); __syncthreads(); SEAM(pb + PH_LN2); }
    }
#undef IN
#undef SEAM
}

#ifndef TRUNC_PH
#define TRUNC_PH NPH
#endif
#ifndef DUMP_MODE
#define DUMP_MODE 0
#endif
#if DUMP_MODE
__global__ void dump_k(float* out, const unsigned char* ws) {
    for (size_t i = (size_t)blockIdx.x * blockDim.x + threadIdx.x; i < (size_t)T * D; i += (size_t)gridDim.x * blockDim.x) {
        const int t = (int)(i / D), c = (int)(i % D); float v = 0.f;
#if DUMP_MODE == 1
        v = bf2f(((const bf16*)(ws + WS_PROJ))[(size_t)t * LDP + c * 5]);
#elif DUMP_MODE == 2
        if (c < 1024) v = bf2f(((const bf16*)(ws + WS_YRW))[(size_t)t * 1024 + c]); else v = bf2f(((const bf16*)(ws + WS_YNSA))[(size_t)t * 1024 + c - 1024]);
#elif DUMP_MODE == 3
        if (c < 1024) v = bf2f(((const bf16*)(ws + WS_YRET))[(size_t)t * 1024 + c]); else v = bf2f(((const bf16*)(ws + WS_MERGED))[(size_t)t * D + c]);
#elif DUMP_MODE == 4
        if (c < 1024) v = bf2f(((const bf16*)(ws + WS_YRET))[(size_t)t * 1024 + c]);
#elif DUMP_MODE == 5
        v = bf2f(((const bf16*)(ws + WS_GATES))[(size_t)t * NG + c * 3]);
#endif
        out[i] = (v == v && fabsf(v) < 1e30f) ? v : 0.f; }
}
#endif
extern "C" void kernel_launch(void* const* d_in, const int* in_sizes, int n_in, void* d_out, int out_size, void* d_ws, size_t ws_size, hipStream_t stream) {
    static int grid = 0;
    if (grid == 0) {
        if (n_in != 36 || out_size != T * D || ws_size < WS_END) { fprintf(stderr, "kernel_launch: unexpected shapes (n_in %d out %d ws %zu)\n", n_in, out_size, ws_size); grid = -1; return; }
        int dev = 0, cus = 0, per_cu = 0;
        if (hipGetDevice(&dev) != hipSuccess || hipDeviceGetAttribute(&cus, hipDeviceAttributeMultiprocessorCount, dev) != hipSuccess) { grid = -1; return; }
        if (hipFuncSetAttribute((const void*)fwd, hipFuncAttributeMaxDynamicSharedMemorySize, LDS_BYTES) != hipSuccess) { fprintf(stderr, "kernel_launch: hipFuncSetAttribute failed\n"); grid = -1; return; }
        if (hipOccupancyMaxActiveBlocksPerMultiprocessor(&per_cu, (const void*)fwd, 512, LDS_BYTES) != hipSuccess || per_cu < 1) fprintf(stderr, "kernel_launch: occupancy query says %d\n", per_cu);
        (void)hipGetLastError();
        grid = cus;
    }
    if (grid < 0) return;
    if (hipMemsetAsync((char*)d_ws + WS_CTL, 0, CTL_ZERO_BYTES, stream) != hipSuccess) return;
    Args a{};
    for (int i = 0; i < 36; ++i) a.in[i] = (const float*)d_in[i];
    a.out = (float*)d_out; a.ws = (unsigned char*)d_ws;
#if MK_ONE_LAUNCH
    a.ph_lo = 0; a.ph_hi = NPH;
    hipLaunchKernelGGL(fwd, dim3(grid), dim3(512), LDS_BYTES, stream, a);
#else
    for (int p = 0; p < TRUNC_PH; ++p) { a.ph_lo = p; a.ph_hi = p + 1; hipLaunchKernelGGL(fwd, dim3(grid), dim3(512), LDS_BYTES, stream, a); }
#if DUMP_MODE
    dump_k<<<2048, 256, 0, stream>>>((float*)d_out, (const unsigned char*)d_ws);
#endif
#endif
}
```

```cpp
#define MK_ONE_LAUNCH 1
#include <hip/hip_runtime.h>
#include <cstdio>
#include <cstdint>

#ifndef MK_ONE_LAUNCH
#define MK_ONE_LAUNCH 0
#endif

namespace pg8 {
#define PG8_LAS __attribute__((address_space(3)))
typedef unsigned short bf16_t;
typedef short bf16x8 __attribute__((ext_vector_type(8)));
typedef float f32x4 __attribute__((ext_vector_type(4)));
typedef unsigned u32x4 __attribute__((ext_vector_type(4)));
constexpr int BM = 256, BK = 64, HALF = 128, HTB = HALF * BK * 2  , STAGE_BYTES = 8 * HTB, NXCD = 8, WGM = 8;

__host__ __device__ __forceinline__ int lds_byte(int r, int c) { const int st = (r >> 4) * 2 + (c >> 5), rr = r & 15, cc = c & 31, ob = rr * 64 + cc * 2; return st * 1024 + (ob ^ (((ob >> 9) & 1) << 5)); }
__host__ __device__ __forceinline__ void stage_rc(int b, int& R, int& C) { const int st = b / 1024, sb = b % 1024, swz = sb ^ (((sb >> 9) & 1) << 5); R = (st >> 1) * 16 + swz / 64; C = (st & 1) * 32 + (swz % 64) / 2; }
__host__ __device__ __forceinline__ int perm32(int rho) { const int n = rho >> 4, i = rho & 15; return 8 * (i >> 2) + 4 * n + (i & 3); }

struct Unit { int pm, pn, aux; const char* a; const char* b; };
struct Gemm { int K, lda, ldb; };

struct TileOrder {
    int nM, nN, nwg;
    __device__ void init(int nM_, int nN_) { nM = nM_; nN = nN_; nwg = nM * nN; }
    __device__ bool tile(long L, int& pm, int& pn) const {
        if (L >= nwg) return false;
        int wgid = (int)L; { const int q = nwg / NXCD, r = nwg % NXCD, xcd = wgid % NXCD, off = wgid / NXCD; wgid = (xcd < r ? xcd * (q + 1) : r * (q + 1) + (xcd - r) * q) + off; }
        const int nig = WGM * nN, gid = wgid / nig, fm = gid * WGM, gsz = (nM - fm) < WGM ? (nM - fm) : WGM;
        pm = fm + ((wgid % nig) % gsz); pn = (wgid % nig) / gsz; return true;
    }
};

typedef float f32x2_t __attribute__((ext_vector_type(2))); typedef __bf16 bf16x2_t __attribute__((ext_vector_type(2)));
__device__ __forceinline__ unsigned cvt_pk_bf16(float lo, float hi) { f32x2_t v = {lo, hi}; bf16x2_t b = __builtin_convertvector(v, bf16x2_t); return __builtin_bit_cast(unsigned, b); }

template <class Epi, class Sched, bool ALIGN_EPI = false, bool SP2 = false>
__device__ __forceinline__ void gemm_phase(PG8_LAS unsigned char* lds, const Gemm g, const Sched& S, const Epi& E) {
    const int tid = S.tid, wid = __builtin_amdgcn_readfirstlane(tid >> 6), lane = tid & 63, wr = wid >> 2, wc = wid & 3, fr = lane & 15, fq = lane >> 4;
    const int K = g.K, nt = K / BK;
    unsigned voffA[2], voffB[2];
#pragma unroll
    for (int i = 0; i < 2; ++i) { int R, C; stage_rc(tid * 16 + i * 8192, R, C); const int Rb = Epi::PERM ? ((R & ~31) + perm32(R & 31)) : R;
        voffA[i] = (unsigned)(R * g.lda + C) * 2u; voffB[i] = (unsigned)(Rb * g.ldb + C) * 2u; }
    const size_t kstep = (size_t)(BK * 2);
    const size_t hstepA = (size_t)HALF * g.lda * 2, hstepB = (size_t)HALF * g.ldb * 2;
    const unsigned ldsw = (unsigned)wid * 1024u;
    const int aoff = lds_byte(wr * 64 + fr, fq * 8), boff = lds_byte(wc * 32 + fr, fq * 8);
#define PG8_SA(b, h) (((b) * 2 + (h)) * HTB)
#define PG8_SB(b, h) ((4 + (b) * 2 + (h)) * HTB)
#define PG8_STAGE(bufoff, gbase, voff) do { _Pragma("unroll") for (int _i = 0; _i < 2; ++_i) \
        __builtin_amdgcn_global_load_lds((const unsigned*)((const char*)(gbase) + (voff)[_i]), (PG8_LAS unsigned*)(lds + (bufoff) + ldsw + _i * 8192), 16, 0, 0); } while (0)
#define PG8_LDA(dst, b, h) do { _Pragma("unroll") for (int m = 0; m < 4; ++m) _Pragma("unroll") for (int k = 0; k < 2; ++k) dst[m][k] = *(const PG8_LAS bf16x8*)(lds + PG8_SA(b, h) + aoff + m * 2048 + k * 1024); } while (0)
#define PG8_LDB(dst, b, h) do { _Pragma("unroll") for (int n = 0; n < 2; ++n) _Pragma("unroll") for (int k = 0; k < 2; ++k) dst[n][k] = *(const PG8_LAS bf16x8*)(lds + PG8_SB(b, h) + boff + n * 2048 + k * 1024); } while (0)
#define PG8_MMA(ai, bj, At, Bt) do { __builtin_amdgcn_s_setprio(1); _Pragma("unroll") for (int m = 0; m < 4; ++m) _Pragma("unroll") for (int n = 0; n < 2; ++n) _Pragma("unroll") for (int k = 0; k < 2; ++k) \
        acc[ai][bj][m][n] = __builtin_amdgcn_mfma_f32_16x16x32_bf16(Bt[n][k], At[m][k], acc[ai][bj][m][n], 0, 0, 0); __builtin_amdgcn_s_setprio(0); } while (0)
#define PG8_WAIT_V(n) asm volatile("s_waitcnt vmcnt(" #n ")" ::: "memory")
#define PG8_WAIT_L(n) asm volatile("s_waitcnt lgkmcnt(" #n ")" ::: "memory")
#define PG8_BAR __builtin_amdgcn_s_barrier()
#define PG8_SCHED __builtin_amdgcn_sched_barrier(0)
    Unit cur, nxt; int ui = 0;
    if (!S.next(0, cur)) return;
    f32x4 acc[2][2][4][2];
#pragma unroll
    for (int a = 0; a < 2; ++a)
#pragma unroll
        for (int b = 0; b < 2; ++b)
#pragma unroll
            for (int m = 0; m < 4; ++m)
#pragma unroll
                for (int n = 0; n < 2; ++n) acc[a][b][m][n] = (f32x4){0.f, 0.f, 0.f, 0.f};
    bf16x8 At[4][2], B0[2][2], B1[2][2];
    const char* cA = cur.a; const char* cB = cur.b;
    if constexpr (SP2) {
        PG8_STAGE(PG8_SB(0, 0), cB, voffB); PG8_STAGE(PG8_SB(0, 1), cB + hstepB, voffB); PG8_STAGE(PG8_SA(0, 0), cA, voffA); PG8_STAGE(PG8_SA(0, 1), cA + hstepA, voffA);
        if (wr == 1) PG8_BAR;
        PG8_WAIT_V(2); PG8_BAR;
        PG8_STAGE(PG8_SB(1, 0), cB + kstep, voffB); PG8_STAGE(PG8_SA(1, 0), cA + kstep, voffA); PG8_STAGE(PG8_SB(1, 1), cB + hstepB + kstep, voffB);
        PG8_WAIT_V(6); PG8_BAR;
    } else {
        PG8_STAGE(PG8_SB(0, 0), cB, voffB); PG8_STAGE(PG8_SA(0, 0), cA, voffA); PG8_STAGE(PG8_SB(0, 1), cB + hstepB, voffB); PG8_STAGE(PG8_SA(0, 1), cA + hstepA, voffA);
        if (wr == 1) PG8_BAR;
        PG8_WAIT_V(4); PG8_BAR;
        PG8_STAGE(PG8_SB(1, 0), cB + kstep, voffB); PG8_STAGE(PG8_SA(1, 0), cA + kstep, voffA); PG8_STAGE(PG8_SB(1, 1), cB + hstepB + kstep, voffB);
        PG8_WAIT_V(6); PG8_BAR;
    }
    for (;;) {
        const bool has_next = S.next(ui + 1, nxt);
        const char* nA = has_next ? nxt.a : cA; const char* nB = has_next ? nxt.b : cB;
        for (int t = 0; t < nt; t += 2) {
            const bool last = (t == nt - 2);
            const char* a1 = cA + (size_t)(t + 1) * kstep;
            const char* a2 = last ? nA : cA + (size_t)(t + 2) * kstep; const char* b2 = last ? nB : cB + (size_t)(t + 2) * kstep;
            const char* a3 = a2 + kstep; const char* b3 = b2 + kstep;
            if constexpr (SP2) {
            PG8_LDB(B0, 0, 0); PG8_LDB(B1, 0, 1); PG8_SCHED; PG8_LDA(At, 0, 0); PG8_STAGE(PG8_SA(1, 1), a1 + hstepA, voffA);
            PG8_WAIT_V(8); PG8_WAIT_L(0); PG8_BAR; PG8_MMA(0, 0, At, B0); PG8_MMA(0, 1, At, B1); PG8_BAR; PG8_SCHED;
            PG8_LDA(At, 0, 1); PG8_STAGE(PG8_SB(0, 0), b2, voffB); PG8_STAGE(PG8_SB(0, 1), b2 + hstepB, voffB); PG8_STAGE(PG8_SA(0, 0), a2, voffA);
            PG8_WAIT_V(8); PG8_WAIT_L(0); PG8_BAR; PG8_MMA(1, 0, At, B0); PG8_MMA(1, 1, At, B1); PG8_BAR; PG8_SCHED;
            PG8_LDB(B0, 1, 0); PG8_LDB(B1, 1, 1); PG8_SCHED; PG8_LDA(At, 1, 0); PG8_STAGE(PG8_SA(0, 1), a2 + hstepA, voffA);
            PG8_WAIT_V(8); PG8_WAIT_L(0); PG8_BAR; PG8_MMA(0, 0, At, B0); PG8_MMA(0, 1, At, B1); PG8_BAR; PG8_SCHED;
            PG8_LDA(At, 1, 1); PG8_STAGE(PG8_SB(1, 0), b3, voffB); PG8_STAGE(PG8_SB(1, 1), b3 + hstepB, voffB); PG8_STAGE(PG8_SA(1, 0), a3, voffA);
            PG8_WAIT_V(8); PG8_WAIT_L(0); PG8_BAR; PG8_MMA(1, 0, At, B0); PG8_MMA(1, 1, At, B1); PG8_BAR; PG8_SCHED;
            } else {
            PG8_LDB(B0, 0, 0); PG8_SCHED; PG8_LDA(At, 0, 0); PG8_STAGE(PG8_SA(1, 1), a1 + hstepA, voffA);
            PG8_WAIT_L(8); PG8_BAR; PG8_WAIT_L(0); PG8_MMA(0, 0, At, B0); PG8_BAR; PG8_SCHED;
            PG8_LDB(B1, 0, 1); PG8_STAGE(PG8_SB(0, 0), b2, voffB);
            PG8_BAR; PG8_WAIT_L(0); PG8_MMA(0, 1, At, B1); PG8_BAR;
            PG8_LDA(At, 0, 1); PG8_STAGE(PG8_SA(0, 0), a2, voffA);
            PG8_BAR; PG8_WAIT_L(0); PG8_MMA(1, 0, At, B0); PG8_BAR; PG8_SCHED;
            PG8_STAGE(PG8_SB(0, 1), b2 + hstepB, voffB);
            PG8_WAIT_V(6); PG8_BAR; PG8_MMA(1, 1, At, B1); PG8_BAR;
            PG8_LDB(B0, 1, 0); PG8_SCHED; PG8_LDA(At, 1, 0); PG8_STAGE(PG8_SA(0, 1), a2 + hstepA, voffA);
            PG8_WAIT_L(8); PG8_BAR; PG8_WAIT_L(0); PG8_MMA(0, 0, At, B0); PG8_BAR; PG8_SCHED;
            PG8_LDB(B1, 1, 1); PG8_STAGE(PG8_SB(1, 0), b3, voffB);
            PG8_BAR; PG8_WAIT_L(0); PG8_MMA(0, 1, At, B1); PG8_BAR;
            PG8_LDA(At, 1, 1); PG8_STAGE(PG8_SA(1, 0), a3, voffA);
            PG8_BAR; PG8_WAIT_L(0); PG8_MMA(1, 0, At, B0); PG8_BAR; PG8_SCHED;
            PG8_STAGE(PG8_SB(1, 1), b3 + hstepB, voffB);
            PG8_WAIT_V(6); PG8_BAR; PG8_MMA(1, 1, At, B1); PG8_BAR;
            }
        }
        if constexpr (ALIGN_EPI) { if (wr == 0) PG8_BAR; }
        E(acc, cur, wr, wc, fr, fq);
        if (!has_next) break;
#pragma unroll
        for (int a = 0; a < 2; ++a)
#pragma unroll
            for (int b = 0; b < 2; ++b)
#pragma unroll
                for (int m = 0; m < 4; ++m)
#pragma unroll
                    for (int n = 0; n < 2; ++n) acc[a][b][m][n] = (f32x4){0.f, 0.f, 0.f, 0.f};
        cur = nxt; cA = nA; cB = nB; ++ui;
        if constexpr (ALIGN_EPI) { if (wr == 1) PG8_BAR; }
    }
    PG8_WAIT_V(0);
    if constexpr (!ALIGN_EPI) { if (wr == 0) PG8_BAR; }
    PG8_BAR;
    #undef PG8_SA
#undef PG8_SB
#undef PG8_STAGE
#undef PG8_LDA
#undef PG8_LDB
#undef PG8_MMA
#undef PG8_WAIT_V
#undef PG8_WAIT_L
#undef PG8_BAR
#undef PG8_SCHED
}
}

#ifndef PG8_SP2
#define PG8_SP2 true
#endif
#ifndef PG8_ALIGN
#define PG8_ALIGN true
#endif

constexpr int T = 16384, D = 2048, DEPTH = 2;
constexpr int RWW = 1024;
constexpr int NCMP = 1023, NSELB = 256;
constexpr int NEXP = 32, FF = 512;
constexpr int LDP = 10496;
constexpr int NG = 6144;
constexpr int PC_RW_R = 0, PC_RW_K = 1024, PC_RW_V = 2048, PC_NQ = 3072, PC_KC = 4096, PC_VC = 4352, PC_KS = 4608, PC_VS = 4864, PC_KW = 5120, PC_VW = 5376,
              PC_RQ = 5632, PC_RK = 6656, PC_RV = 7680, PC_RG = 8704, PC_XW = 9728, PC_XA = 9824, PC_XG = 9920, PC_XV = 10176, PC_GATE = 10240;
constexpr float DN_ALPHA = 1.41421356237f, LN_EPS = 1e-5f;

constexpr size_t MiB = 1u << 20;
constexpr size_t WS_CTL = 0, CTL_ZERO_BYTES = 1 * MiB;
constexpr size_t WS_TEXP = 1 * MiB, WS_TOKE = WS_TEXP + 65536, WS_TOKW = WS_TOKE + 131072, WS_SLOT = WS_TOKW + 131072;
constexpr size_t WS_KCMPB = 2 * MiB, WS_VCMPT = 3 * MiB, WS_RKB = 4 * MiB, WS_COS = 8 * MiB, WS_SIN = 12 * MiB;
constexpr size_t WS_WIN = 16 * MiB, WS_WG = 57 * MiB, WS_WBR = 81 * MiB, WS_WOUT = 93 * MiB;
constexpr size_t WS_XB = 112 * MiB, WS_VF = 176 * MiB, WS_PROJ = 208 * MiB;
constexpr size_t WS_RW_R = 536 * MiB, WS_RW_K = 568 * MiB, WS_RW_V = 600 * MiB, WS_RW_KK = 632 * MiB, WS_RW_B = 664 * MiB, WS_RW_W = 696 * MiB, WS_RW_G = 760 * MiB;
constexpr size_t WS_YRW = 800 * MiB, WS_YNSA = 832 * MiB, WS_YRET = 864 * MiB;
constexpr size_t WS_RWP = 896 * MiB, WS_RWU = 912 * MiB, WS_RWS = 928 * MiB, WS_RETKV = 944 * MiB, WS_VST = 1008 * MiB, WS_VWT = 1016 * MiB, WS_END = 1024 * MiB;
constexpr size_t WS_GATES = 536 * MiB, WS_MERGED = 728 * MiB;
constexpr size_t WS_WGU = 208 * MiB, WS_WDN = 336 * MiB, WS_XS = 400 * MiB, WS_H = 560 * MiB, WS_YS = 600 * MiB;
static_assert(WS_PROJ + (size_t)T * LDP * 2 <= WS_RW_R && WS_GATES + (size_t)T * NG * 2 <= WS_MERGED && WS_MERGED + (size_t)T * D * 2 <= WS_YRW, "ws map");
static_assert(WS_XS + (size_t)160 * 256 * D * 2 <= WS_H && WS_H + (size_t)160 * 256 * FF * 2 <= WS_YS && WS_YS + (size_t)160 * 256 * D * 2 <= WS_RW_G, "ws map moe");
constexpr int CW_TMO = 0, CW_CNT = 1024, CW_CUR = 1088, CW_BAR = 4096;
constexpr int LDS_BYTES = 147456, LDS_BARW = LDS_BYTES - 64;

#define GAS __attribute__((address_space(1)))
#define LAS __attribute__((address_space(3)))
typedef unsigned short bf16;
typedef float f32x4 __attribute__((ext_vector_type(4)));
typedef unsigned u32x4 __attribute__((ext_vector_type(4)));
#define LDS_WAIT() asm volatile("s_waitcnt lgkmcnt(0)" ::: "memory")
#define VM_WAIT() asm volatile("s_waitcnt vmcnt(0)" ::: "memory")

__device__ __forceinline__ float bf2f(unsigned short b) { return __uint_as_float(((unsigned)b) << 16); }
__device__ __forceinline__ unsigned f2bf(float f) { unsigned u = __float_as_uint(f); return (u + 0x7fffu + ((u >> 16) & 1u)) >> 16; }
__device__ __forceinline__ unsigned pk2(float lo, float hi) { return f2bf(lo) | (f2bf(hi) << 16); }
__device__ __forceinline__ float bflo(unsigned w) { return __uint_as_float(w << 16); }
__device__ __forceinline__ float bfhi(unsigned w) { return __uint_as_float(w & 0xffff0000u); }
__device__ __forceinline__ float wave_sum(float v) {
#pragma unroll
    for (int o = 1; o < 64; o <<= 1) v += __shfl_xor(v, o);
    return v;
}
__device__ __forceinline__ float wave_max(float v) {
#pragma unroll
    for (int o = 1; o < 64; o <<= 1) v = fmaxf(v, __shfl_xor(v, o));
    return v;
}
__device__ __forceinline__ int wave_min_i(int v) {
#pragma unroll
    for (int o = 1; o < 64; o <<= 1) { const int w = __shfl_xor(v, o); v = w < v ? w : v; }
    return v;
}
__device__ __forceinline__ float sigm(float x) { return 1.f / (1.f + expf(-x)); }
__device__ __forceinline__ float sigm_fast(float x) { return __builtin_amdgcn_rcpf(1.f + __builtin_amdgcn_exp2f(-1.4426950408889634f * x)); }

__device__ const double INV_FREQ[64] = {1.00000000000000000e+00, 8.63988449483968579e-01, 7.46476040841712152e-01, 6.44946677103762411e-01, 5.57226479550717357e-01, 4.81437242078434580e-01, 4.15956216307184767e-01, 3.59381366380462752e-01, 3.10501349512486036e-01, 2.68269579527972590e-01, 2.31781818060089240e-01, 2.00256813604311801e-01, 1.73019573884589412e-01, 1.49486913370923374e-01, 1.29154966501488389e-01, 1.11588399250774864e-01, 9.64110880490750138e-02, 8.32980664765826800e-02, 7.19685673001152076e-02, 6.21800108732091794e-02, 5.37228111832403141e-02, 4.64158883361278016e-02, 4.01027913949520837e-02, 3.46483485573036779e-02, 2.99357729472049007e-02, 2.58641620527596990e-02, 2.23463372691659473e-02, 1.93069772888325060e-02, 1.66810053720005923e-02, 1.44121959671885402e-02, 1.24519708473503302e-02, 1.07583589854217902e-02, 9.29509789880649494e-03, 8.03085722139152032e-03, 6.93856787873718770e-03, 5.99484250318940964e-03, 5.17947467923121282e-03, 4.47500629725045354e-03, 3.86635375219241198e-03, 3.34048498351324471e-03, 2.88614044143008968e-03, 2.49359200498416086e-03, 2.15443469003188427e-03, 1.86140668735512152e-03, 1.60823387766704205e-03, 1.38949549437313892e-03, 1.20050805774840792e-03, 1.03722509540705695e-03, 8.96150501946605012e-04, 7.74263682681127744e-04, 6.68954878691414585e-04, 5.77969288415331340e-04, 4.99358789347314927e-04, 4.31440226144378508e-04, 3.72759372031494166e-04, 3.22059791872108224e-04, 2.78255940220712632e-04, 2.40409918350997456e-04, 2.07711392596645640e-04, 1.79460244029731636e-04, 1.55051577983262559e-04, 1.33962772451801717e-04, 1.15742288059205792e-04, 1.00000000000000005e-04};
__device__ const float RET_LOGG[8] = {-0.0317486983145803f, -0.015748356968139168f, -0.007843177461025893f, -0.003913899321136329f, -0.0019550348358033506f, -0.0009770396478266127f, -0.0004884004981088745f, -0.0002441704321739145f};

#define XB_TMO      128
#define XB_XCNT(j)  (256  + 64 * (j))
#define XB_XSUB(j)  (1280 + 64 * (j))
#define XB_XGEN(j)  (2304 + 64 * (j))
#define XB_TOP      3328
#define XB_TOPGEN   3392
#define XCD_BAR_WORDS 3456
#define XB_SPIN_CAP (1u << 18)

__device__ __forceinline__ unsigned xb_ld(unsigned* p)              { return __hip_atomic_load(p, __ATOMIC_RELAXED, __HIP_MEMORY_SCOPE_AGENT); }
__device__ __forceinline__ unsigned xb_add(unsigned* p, unsigned v) { return __hip_atomic_fetch_add(p, v, __ATOMIC_RELAXED, __HIP_MEMORY_SCOPE_AGENT); }
__device__ __forceinline__ unsigned xb_xcc_id() { return (unsigned)__builtin_amdgcn_s_getreg((3 << 11) | 20) & 0xFu; }
#define XB_SPIN(cond, bar) do { unsigned _sp = 0; while (cond) { __builtin_amdgcn_s_sleep(1); \
    if ((++_sp & 255u) == 0u) { if (xb_ld(&(bar)[XB_TMO])) break; if (_sp > XB_SPIN_CAP) { atomicAdd(&(bar)[XB_TMO], 1u); break; } } } } while (0)

struct XcdBarrier {
    unsigned* bar; unsigned x;
    volatile LAS unsigned* st;
};
__device__ __forceinline__ XcdBarrier xcd_barrier_post(unsigned* bar, volatile LAS unsigned* st) {
    XcdBarrier b; b.bar = bar; b.x = xb_xcc_id(); b.st = st;
    if (threadIdx.x == 0) (void)xb_add(&bar[XB_XCNT(b.x)], 1u);
    return b;
}
__device__ __forceinline__ void xcd_barrier_complete(unsigned* bar, unsigned x, unsigned& nloc, unsigned& nx) {
    const unsigned G = gridDim.x * gridDim.y * gridDim.z;
    unsigned sum, cnt, mine, sp = 0u;
    for (;;) {
        sum = 0u; cnt = 0u; mine = 0u;
#pragma unroll
        for (unsigned j = 0; j < 16; ++j) { const unsigned c = xb_ld(&bar[XB_XCNT(j)]); sum += c; cnt += (c > 0u) ? 1u : 0u; mine = (j == x) ? c : mine; }
        if (sum == G) break;
        __builtin_amdgcn_s_sleep(1);
        if ((++sp & 255u) == 0u) { if (xb_ld(&bar[XB_TMO])) break; if (sp > XB_SPIN_CAP) { atomicAdd(&bar[XB_TMO], 1u); break; } }
    }
    nloc = mine > 0u ? mine : 1u; nx = cnt > 0u ? cnt : 1u;
}
__device__ __forceinline__ void xcd_barrier(const XcdBarrier& b) {
    asm volatile("s_waitcnt vmcnt(0)" ::: "memory");
    __syncthreads();
    if (threadIdx.x == 0) {
        unsigned* bar = b.bar;
        __builtin_amdgcn_s_waitcnt(0);
        unsigned nloc = b.st[0], nx = b.st[1];
        if (nloc == 0u) { xcd_barrier_complete(bar, b.x, nloc, nx); b.st[0] = nloc; b.st[1] = nx; }
        const unsigned old = xb_add(&bar[XB_XSUB(b.x)], 1u);
        const unsigned gen = old / nloc;
        if (old + 1u == (gen + 1u) * nloc) {
            __builtin_amdgcn_fence(__ATOMIC_RELEASE, "agent");
            asm volatile("s_waitcnt vmcnt(0)" ::: "memory");
            const unsigned og = xb_add(&bar[XB_TOP], 1u);
            const unsigned tg = og / nx;
            if (og + 1u == (tg + 1u) * nx) xb_add(&bar[XB_TOPGEN], 1u);
            else XB_SPIN(xb_ld(&bar[XB_TOPGEN]) == tg, bar);
            __builtin_amdgcn_fence(__ATOMIC_ACQUIRE, "agent");
            xb_add(&bar[XB_XGEN(b.x)], 1u);
            asm volatile("s_waitcnt vmcnt(0)" ::: "memory");
        } else {
            XB_SPIN(xb_ld(&bar[XB_XGEN(b.x)]) == gen, bar);
            __builtin_amdgcn_fence(__ATOMIC_ACQUIRE, "agent");
            asm volatile("s_waitcnt vmcnt(0)" ::: "memory");
        }
    }
    __syncthreads();
}

struct Args { const float* in[36]; float* out; unsigned char* ws; int ph_lo, ph_hi; };
constexpr int LDS_PTAB = LDS_BYTES - 512;
struct PA { unsigned char* ws; float* out; const LAS unsigned* tab;
    __device__ __forceinline__ const float* in(int i) const { const unsigned lo = __builtin_amdgcn_readfirstlane(tab[2 * i]), hi = __builtin_amdgcn_readfirstlane(tab[2 * i + 1]);
        return (const float*)(((unsigned long long)hi << 32) | lo); } };

using pg8::Unit; using pg8::Gemm; using pg8::TileOrder;
struct SchedPlain {
    TileOrder to; int G, c, tid; const char* A; const char* B; size_t ta, tb;
    __device__ __forceinline__ bool next(int i, Unit& u) const {
        if (!to.tile((long)i * G + c, u.pm, u.pn)) return false;
        u.a = A + (size_t)u.pm * ta; u.b = B + (size_t)u.pn * tb; u.aux = 0; return true; }
};
struct SchedBranch {
    TileOrder to; int G, c, tid; const char* A0; const char* B0; size_t sa, sb, ta, tb;
    __device__ __forceinline__ bool next(int i, Unit& u) const {
        const int br = i % 3;
        if (!to.tile((long)(i / 3) * G + c, u.pm, u.pn)) return false;
        u.a = A0 + (size_t)br * sa + (size_t)u.pm * ta; u.b = B0 + (size_t)br * sb + (size_t)u.pn * tb; u.aux = br; return true; }
};
struct SchedMoe {
    int nM, nN, G, c, tid; const char* A; const char* B; size_t ta, tb, te; const int* texp;
    __device__ __forceinline__ bool next(int i, Unit& u) const {
        const long L = (long)i * G + c; if (L >= (long)nM * nN) return false;
        u.pm = (int)(L % nM); u.pn = (int)(L / nM); const int e = texp[u.pm];
        u.a = A + (size_t)u.pm * ta; u.b = B + (size_t)e * te + (size_t)u.pn * tb; u.aux = e; return true; }
};
template <int ACT  > struct EpiStore {
    static constexpr bool PERM = true;
    bf16* O; int ldc;
    __device__ __forceinline__ void operator()(const f32x4 (&acc)[2][2][4][2], const Unit& u, int wr, int wc, int fr, int fq) const {
        const int row0 = u.pm * 256 + wr * 64 + fr, col0 = u.pn * 256 + wc * 32 + 8 * fq;
#pragma unroll
        for (int ai = 0; ai < 2; ++ai)
#pragma unroll
            for (int m = 0; m < 4; ++m) { bf16* rowp = O + (size_t)(row0 + ai * 128 + m * 16) * ldc + col0;
#pragma unroll
                for (int bj = 0; bj < 2; ++bj) { f32x4 v0 = acc[ai][bj][m][0], v1 = acc[ai][bj][m][1];
                    if (ACT == 1) {
#pragma unroll
                        for (int j = 0; j < 4; ++j) { v0[j] = sigm_fast(v0[j]); v1[j] = sigm_fast(v1[j]); } }
                    u32x4 w; w.x = pg8::cvt_pk_bf16(v0[0], v0[1]); w.y = pg8::cvt_pk_bf16(v0[2], v0[3]); w.z = pg8::cvt_pk_bf16(v1[0], v1[1]); w.w = pg8::cvt_pk_bf16(v1[2], v1[3]);
                    *(u32x4*)(rowp + bj * 128) = w; __builtin_amdgcn_sched_barrier(0); } }
    }
};
struct EpiBranch {
    static constexpr bool PERM = true;
    bf16* Mg; const bf16* Gt;
    __device__ __forceinline__ void operator()(const f32x4 (&acc)[2][2][4][2], const Unit& u, int wr, int wc, int fr, int fq) const {
        const int row0 = u.pm * 256 + wr * 64 + fr, col0 = u.pn * 256 + wc * 32 + 8 * fq, br = u.aux;
#pragma unroll
        for (int ai = 0; ai < 2; ++ai)
#pragma unroll
            for (int m = 0; m < 4; ++m) { const size_t r = (size_t)(row0 + ai * 128 + m * 16);
#pragma unroll
                for (int bj = 0; bj < 2; ++bj) { const int col = col0 + bj * 128;
                    const u32x4 gw = *(const u32x4*)(Gt + r * NG + br * 2048 + col);
                    f32x4 v0 = acc[ai][bj][m][0], v1 = acc[ai][bj][m][1];
                    v0[0] *= bflo(gw.x); v0[1] *= bfhi(gw.x); v0[2] *= bflo(gw.y); v0[3] *= bfhi(gw.y); v1[0] *= bflo(gw.z); v1[1] *= bfhi(gw.z); v1[2] *= bflo(gw.w); v1[3] *= bfhi(gw.w);
                    bf16* mp = Mg + r * D + col;
                    if (br != 0) { const u32x4 ow = *(const u32x4*)mp;
                        v0[0] += bflo(ow.x); v0[1] += bfhi(ow.x); v0[2] += bflo(ow.y); v0[3] += bfhi(ow.y); v1[0] += bflo(ow.z); v1[1] += bfhi(ow.z); v1[2] += bflo(ow.w); v1[3] += bfhi(ow.w); }
                    u32x4 w; w.x = pg8::cvt_pk_bf16(v0[0], v0[1]); w.y = pg8::cvt_pk_bf16(v0[2], v0[3]); w.z = pg8::cvt_pk_bf16(v1[0], v1[1]); w.w = pg8::cvt_pk_bf16(v1[2], v1[3]);
                    *(u32x4*)mp = w; __builtin_amdgcn_sched_barrier(0); } }
    }
};
struct EpiResid {
    static constexpr bool PERM = true;
    float* X;
    __device__ __forceinline__ void operator()(const f32x4 (&acc)[2][2][4][2], const Unit& u, int wr, int wc, int fr, int fq) const {
        const int row0 = u.pm * 256 + wr * 64 + fr, col0 = u.pn * 256 + wc * 32 + 8 * fq;
#pragma unroll
        for (int ai = 0; ai < 2; ++ai)
#pragma unroll
            for (int m = 0; m < 4; ++m) { float* rowp = X + (size_t)(row0 + ai * 128 + m * 16) * D + col0;
#pragma unroll
                for (int bj = 0; bj < 2; ++bj) { f32x4* p = (f32x4*)(rowp + bj * 128);
                    const f32x4 x0 = p[0], x1 = p[1];
                    p[0] = x0 * DN_ALPHA + acc[ai][bj][m][0]; p[1] = x1 * DN_ALPHA + acc[ai][bj][m][1]; __builtin_amdgcn_sched_barrier(0); } }
    }
};
struct EpiGateUp {
    static constexpr bool PERM = true;
    bf16* H;
    __device__ __forceinline__ void operator()(const f32x4 (&acc)[2][2][4][2], const Unit& u, int wr, int wc, int fr, int fq) const {
        const int row0 = u.pm * 256 + wr * 64 + fr, col0 = u.pn * 128 + wc * 32 + 8 * fq;
#pragma unroll
        for (int ai = 0; ai < 2; ++ai)
#pragma unroll
            for (int m = 0; m < 4; ++m) { bf16* rowp = H + (size_t)(row0 + ai * 128 + m * 16) * FF + col0;
                f32x4 h0, h1;
#pragma unroll
                for (int j = 0; j < 4; ++j) { const float g0 = acc[ai][0][m][0][j], g1 = acc[ai][0][m][1][j];
                    h0[j] = g0 * sigm_fast(g0) * acc[ai][1][m][0][j]; h1[j] = g1 * sigm_fast(g1) * acc[ai][1][m][1][j]; }
                u32x4 w; w.x = pg8::cvt_pk_bf16(h0[0], h0[1]); w.y = pg8::cvt_pk_bf16(h0[2], h0[3]); w.z = pg8::cvt_pk_bf16(h1[0], h1[1]); w.w = pg8::cvt_pk_bf16(h1[2], h1[3]);
                *(u32x4*)rowp = w; }
    }
};

struct Ctx { LAS unsigned char* lds; int tid, lane, wave, G, bx, gw, NGW; };

template <class SRC>
__device__ __forceinline__ void transpose_task(const Ctx& c, const SRC& src, int ldsrc, int K, bf16* dst, int ndst) {
    LAS float* scr = (LAS float*)(c.lds + c.wave * 8704);
    const int nblk = ndst / 32, items = (K / 64) * nblk, lane = c.lane;
    for (int it = c.gw; it < items; it += c.NGW) {
        const int kb = it / nblk, nb = it % nblk, k0 = 64 * kb, n0 = 32 * nb;
        const float* sp = src(n0 + (lane & 31));
#pragma unroll 8
        for (int i = 0; i < 32; ++i) { const int kk = 2 * i + (lane >> 5); scr[kk * 33 + (lane & 31)] = sp ? sp[(size_t)(k0 + kk) * ldsrc] : 0.f; }
        LDS_WAIT();
        const int cc = lane & 7;
#pragma unroll
        for (int j = 0; j < 4; ++j) { const int n = (lane >> 3) + 8 * j; const LAS float* s = scr + (8 * cc) * 33 + n;
            u32x4 o; o.x = pk2(s[0 * 33], s[1 * 33]); o.y = pk2(s[2 * 33], s[3 * 33]); o.z = pk2(s[4 * 33], s[5 * 33]); o.w = pk2(s[6 * 33], s[7 * 33]);
            *(u32x4*)(dst + (size_t)(n0 + n) * K + k0 + 8 * cc) = o; }
        LDS_WAIT();
    }
}
struct SrcWin { const float* W; int layer;
    __device__ __forceinline__ const float* operator()(int n) const {
        const int rw = layer ? 3584 : 3520; int sc;
        if (n < 3072) sc = n; else if (n < 5632) sc = rw + (n - 3072); else if (n < 9728) sc = rw + 2608 + (n - 5632); else if (n < 10176) sc = 3072 + (n - 9728);
        else if (n < 10240) sc = layer ? 3520 + (n - 10176) : -1; else if (n < 10288) sc = rw + 2560 + (n - 10240); else sc = -1;
        return sc >= 0 ? W + sc : nullptr; } };
struct SrcOff { const float* W; __device__ __forceinline__ const float* operator()(int n) const { return W + n; } };
struct SrcGU { const float* Wg; const float* Wu;
    __device__ __forceinline__ const float* operator()(int nn) const { const int e = nn >> 10, r1 = nn & 1023, pn = r1 >> 8, rr = r1 & 255;
        const size_t du = (size_t)((const char*)Wu - (const char*)Wg);
        return (const float*)((const char*)Wg + (rr < 128 ? (size_t)0 : du)) + (size_t)e * D * FF + 128 * pn + (rr & 127); } };
struct SrcDN { const float* Wd;
    __device__ __forceinline__ const float* operator()(int nn) const { const int e = nn >> 11, n = nn & 2047; return Wd + (size_t)e * FF * D + n; } };

__device__ __forceinline__ void ph_conv(const Ctx& c, const PA& a, int layer) {
    unsigned char* ws = a.ws;
    const float* Win = layer ? a.in(2) : a.in(1); const int ldw = layer ? 16432 : 16368, rw = layer ? 3584 : 3520;
    transpose_task(c, SrcWin{Win, layer}, ldw, D, (bf16*)(ws + WS_WIN), LDP);
    transpose_task(c, SrcOff{Win + rw + 2608 + 4096}, ldw, D, (bf16*)(ws + WS_WG), NG);
    transpose_task(c, SrcOff{a.in(21) + (size_t)layer * RWW * D}, D, RWW, (bf16*)(ws + WS_WBR), D);
    transpose_task(c, SrcOff{a.in(22) + (size_t)layer * RWW * D}, D, RWW, (bf16*)(ws + WS_WBR) + (size_t)D * RWW, D);
    transpose_task(c, SrcOff{a.in(23) + (size_t)layer * RWW * D}, D, RWW, (bf16*)(ws + WS_WBR) + (size_t)2 * D * RWW, D);
    transpose_task(c, SrcOff{a.in(24) + (size_t)layer * D * D}, D, D, (bf16*)(ws + WS_WOUT), D);
    if (layer == 0) {
        const f32x4* x4 = (const f32x4*)a.in(0); f32x4* o4 = (f32x4*)a.out; uint2* xb = (uint2*)(ws + WS_XB);
        for (size_t i = (size_t)c.bx * 512 + c.tid; i < (size_t)T * D / 4; i += (size_t)c.G * 512) { const f32x4 v = x4[i]; o4[i] = v; xb[i] = make_uint2(pk2(v[0], v[1]), pk2(v[2], v[3])); }
        float* cs = (float*)(ws + WS_COS); float* sn = (float*)(ws + WS_SIN);
        for (int i = c.bx * 512 + c.tid; i < T * 64; i += c.G * 512) { const int t = i >> 6, j = i & 63;
            const double rev = (double)t * INV_FREQ[j] * 0.15915494309189533577; const float fr = (float)(rev - __builtin_rint(rev));
            cs[i] = __builtin_amdgcn_cosf(fr); sn[i] = __builtin_amdgcn_sinf(fr); }
    }
}
__device__ __forceinline__ void ph_conv_moe(const Ctx& c, const PA& a, int layer) {
    unsigned char* ws = a.ws; const size_t lo = (size_t)layer * NEXP * D * FF;
    transpose_task(c, SrcGU{a.in(31) + lo, a.in(32) + lo}, FF, D, (bf16*)(ws + WS_WGU), NEXP * 1024);
    transpose_task(c, SrcDN{a.in(33) + lo}, D, FF, (bf16*)(ws + WS_WDN), NEXP * D);
}

__device__ __forceinline__ float softplusf_(float x) { return fmaxf(x, 0.f) + log1pf(expf(-fabsf(x))); }
__device__ __forceinline__ void prep_rwkv(const Ctx& c, const PA& a, int layer) {
    unsigned char* ws = a.ws; const bf16* proj = (const bf16*)(ws + WS_PROJ);
    LAS float* sh_r = (LAS float*)c.lds; LAS float* sh_k = sh_r + 8 * 1024; LAS float* sh_v = sh_k + 8 * 1024; LAS float* sh_x = sh_v + 8 * 1024;
    bf16* oR = (bf16*)(ws + WS_RW_R); bf16* oK = (bf16*)(ws + WS_RW_K); bf16* oV = (bf16*)(ws + WS_RW_V); bf16* oKK = (bf16*)(ws + WS_RW_KK); bf16* oB = (bf16*)(ws + WS_RW_B);
    float* oW = (float*)(ws + WS_RW_W); bf16* oG = (bf16*)(ws + WS_RW_G); bf16* VF = (bf16*)(ws + WS_VF); float* rkb = (float*)(ws + WS_RKB);
    const int lane = c.lane, w = c.wave, tid = c.tid;
    for (int it = c.bx; it < T / 8; it += c.G) {
        const int t = it * 8 + w;
        const bf16* prow = proj + (size_t)t * LDP; const bf16* pprev = prow - LDP;
        const float* mu = a.in(layer ? 4 : 3);
#pragma unroll
        for (int i = 0; i < 6; ++i) { const int c8 = (lane + 64 * i) * 8;
            const u32x4 p = *(const u32x4*)(prow + c8); u32x4 q = (u32x4){0u, 0u, 0u, 0u}; if (t > 0) q = *(const u32x4*)(pprev + c8);
            const f32x4 m0 = *(const f32x4*)(mu + c8), m1 = *(const f32x4*)(mu + c8 + 4);
            float pv[8] = {bflo(p.x), bfhi(p.x), bflo(p.y), bfhi(p.y), bflo(p.z), bfhi(p.z), bflo(p.w), bfhi(p.w)};
            float qv[8] = {bflo(q.x), bfhi(q.x), bflo(q.y), bfhi(q.y), bflo(q.z), bfhi(q.z), bflo(q.w), bfhi(q.w)};
            LAS float* dstp = (c8 < 1024 ? sh_r + w * 1024 + c8 : (c8 < 2048 ? sh_k + w * 1024 + (c8 - 1024) : sh_v + w * 1024 + (c8 - 2048)));
#pragma unroll
            for (int j = 0; j < 8; ++j) { const float mm = j < 4 ? m0[j] : m1[j - 4]; dstp[j] = pv[j] + (qv[j] - pv[j]) * mm; } }
        { const int i8 = lane * 8; int sc, mi, fn;
            if (i8 < 96) { sc = PC_XW + i8; mi = 3072 + i8; fn = 1; } else if (i8 < 192) { sc = PC_XA + (i8 - 96); mi = 3168 + (i8 - 96); fn = 0; }
            else if (i8 < 448) { sc = PC_XG + (i8 - 192); mi = 3264 + (i8 - 192); fn = 2; } else { sc = PC_XV + (i8 - 448); mi = 3520 + (i8 - 448); fn = layer ? 0 : 3; }
            const u32x4 p = *(const u32x4*)(prow + sc); u32x4 q = (u32x4){0u, 0u, 0u, 0u}; if (t > 0) q = *(const u32x4*)(pprev + sc);
            float pv[8] = {bflo(p.x), bfhi(p.x), bflo(p.y), bfhi(p.y), bflo(p.z), bfhi(p.z), bflo(p.w), bfhi(p.w)};
            float qv[8] = {bflo(q.x), bfhi(q.x), bflo(q.y), bfhi(q.y), bflo(q.z), bfhi(q.z), bflo(q.w), bfhi(q.w)};
#pragma unroll
            for (int j = 0; j < 8; ++j) { float s = 0.f;
                if (fn != 3) { const float mm = mu[mi + j]; s = pv[j] + (qv[j] - pv[j]) * mm; if (fn == 1) s = tanhf(s); else if (fn == 2) s = sigm(s); }
                sh_x[w * 512 + i8 + j] = s; } }
        __syncthreads();
        float sw[8][2], sa[8][2], sg[8][2], sv[8][2];
#pragma unroll
        for (int k = 0; k < 8; ++k) { sw[k][0] = sw[k][1] = sa[k][0] = sa[k][1] = sg[k][0] = sg[k][1] = sv[k][0] = sv[k][1] = 0.f; }
        { const float* w_up = a.in(6) + (size_t)layer * 96 * 1024; const float* a_up = a.in(8) + (size_t)layer * 96 * 1024;
        for (int k = 0; k < 96; ++k) { const float u0 = w_up[k * 1024 + tid], u1 = w_up[k * 1024 + tid + 512], b0 = a_up[k * 1024 + tid], b1 = a_up[k * 1024 + tid + 512];
#pragma unroll
            for (int tk = 0; tk < 8; ++tk) { const float x = sh_x[tk * 512 + k], y = sh_x[tk * 512 + 96 + k]; sw[tk][0] += x * u0; sw[tk][1] += x * u1; sa[tk][0] += y * b0; sa[tk][1] += y * b1; } } }
        { const float* g_up = a.in(11) + (size_t)layer * 256 * 1024;
        for (int k = 0; k < 256; ++k) { const float u0 = g_up[k * 1024 + tid], u1 = g_up[k * 1024 + tid + 512];
#pragma unroll
            for (int tk = 0; tk < 8; ++tk) { const float x = sh_x[tk * 512 + 192 + k]; sg[tk][0] += x * u0; sg[tk][1] += x * u1; } } }
        if (layer) { const float* v_up = a.in(10);
        for (int k = 0; k < 64; ++k) { const float u0 = v_up[k * 1024 + tid], u1 = v_up[k * 1024 + tid + 512];
#pragma unroll
            for (int tk = 0; tk < 8; ++tk) { const float x = sh_x[tk * 512 + 448 + k]; sv[tk][0] += x * u0; sv[tk][1] += x * u1; } } }
#pragma unroll
        for (int ci = 0; ci < 2; ++ci) { const int col = tid + 512 * ci, head = w + 8 * ci;
            const float kkc = a.in(12)[layer * 1024 + col], kac = a.in(13)[layer * 1024 + col], rkc = a.in(14)[layer * 1024 + col], w0c = a.in(5)[layer * 1024 + col], a0c = a.in(7)[layer * 1024 + col], v0c = layer ? a.in(9)[col] : 0.f;
#pragma unroll
            for (int tk = 0; tk < 8; ++tk) { const int tt = it * 8 + tk; const size_t o = (size_t)tt * 1024 + col;
                const float k0 = sh_k[tk * 1024 + col], r = sh_r[tk * 1024 + col], v0 = sh_v[tk * 1024 + col];
                const float kkraw = k0 * kkc, n2 = wave_sum(kkraw * kkraw), kkn = kkraw / fmaxf(sqrtf(n2), 1e-12f);
                const float aa = sigm(a0c + sa[tk][ci]), bb = kkn * aa, kf = k0 * (1.f + (aa - 1.f) * kac);
                const float z = w0c + sw[tk][ci], wl = -softplusf_(-z) - 0.5f, dec = expf(-expf(wl));
                float vv = v0;
                if (layer) { const float vf = bf2f(VF[o]); vv = v0 + (vf - v0) * sigm(v0c + sv[tk][ci]); } else VF[o] = (bf16)f2bf(v0);
                const float rk = wave_sum(r * kf * rkc);
                if (lane == 0) rkb[tt * 16 + head] = rk;
                oR[o] = (bf16)f2bf(r); oK[o] = (bf16)f2bf(kf); oV[o] = (bf16)f2bf(vv); oKK[o] = (bf16)f2bf(kkn); oB[o] = (bf16)f2bf(bb); oW[o] = dec; oG[o] = (bf16)f2bf(sg[tk][ci]); } }
        __syncthreads();
    }
}
__device__ __forceinline__ float gelu_tanh(float x) { return 0.5f * x * (1.f + tanhf(0.7978845608028654f * (x + 0.044715f * x * x * x))); }
__device__ __forceinline__ void prep_cmp(const Ctx& c, const PA& a, int layer) {
    unsigned char* ws = a.ws; const bf16* proj = (const bf16*)(ws + WS_PROJ);
    LAS float* sh_in = (LAS float*)c.lds; LAS float* sh_h = sh_in + 4 * 2048;
    const int tid = c.tid;
    for (int it = c.bx; it < NCMP * 2; it += c.G) {
        const int cb = it >> 1, kv = it & 1, col0 = kv ? PC_VC : PC_KC, lk = layer * 2 + kv;
        const float* pe = a.in(17) + (size_t)lk * 2048; const float* w1 = a.in(18) + (size_t)lk * 2048 * 128; const float* b1 = a.in(19) + lk * 128; const float* w2 = a.in(20) + (size_t)lk * 128 * 64;
        for (int idx = tid; idx < 8192; idx += 512) { const int g = idx >> 11, r = idx & 2047, l = r >> 6, d = r & 63;
            sh_in[idx] = bf2f(proj[(size_t)(16 * cb + l) * LDP + col0 + g * 64 + d]) + pe[r]; }
        __syncthreads();
        { const int g = tid >> 7, j = tid & 127; float acc = b1[j]; const LAS float* in = sh_in + g * 2048;
#pragma unroll 8
            for (int i = 0; i < 2048; ++i) acc += in[i] * w1[i * 128 + j];
            sh_h[tid] = gelu_tanh(acc); }
        __syncthreads();
        if (tid < 256) { const int g = tid >> 6, d = tid & 63; float o = 0.f;
#pragma unroll 8
            for (int j = 0; j < 128; ++j) o += sh_h[g * 128 + j] * w2[j * 64 + d];
            if (kv == 0) ((bf16*)(ws + WS_KCMPB))[((size_t)g * 1024 + cb) * 64 + d] = (bf16)f2bf(o); else ((bf16*)(ws + WS_VCMPT))[((size_t)g * 64 + d) * 1024 + cb] = (bf16)f2bf(o);
            if (cb == 0) { if (kv == 0) ((bf16*)(ws + WS_KCMPB))[((size_t)g * 1024 + 1023) * 64 + d] = 0; else ((bf16*)(ws + WS_VCMPT))[((size_t)g * 64 + d) * 1024 + 1023] = 0; } }
        __syncthreads();
    }
}
__device__ __forceinline__ void prep_rope(const Ctx& c, const PA& a) {
    unsigned char* ws = a.ws; bf16* proj = (bf16*)(ws + WS_PROJ); const float* cs = (const float*)(ws + WS_COS); const float* sn = (const float*)(ws + WS_SIN);
    for (int i = c.bx * 512 + c.tid; i < T * 8 * 64; i += c.G * 512) { const int j = i & 63, h = (i >> 6) & 7, t = i >> 9;
        const float co = cs[t * 64 + j], si = sn[t * 64 + j];
        bf16* q = proj + (size_t)t * LDP + PC_RQ + h * 128 + j; bf16* k = proj + (size_t)t * LDP + PC_RK + h * 128 + j;
        const float q1 = bf2f(q[0]), q2 = bf2f(q[64]), k1 = bf2f(k[0]), k2 = bf2f(k[64]);
        q[0] = (bf16)f2bf(q1 * co - q2 * si); q[64] = (bf16)f2bf(q1 * si + q2 * co);
        k[0] = (bf16)f2bf((k1 * co - k2 * si) * 0.08838834764831845f); k[64] = (bf16)f2bf((k1 * si + k2 * co) * 0.08838834764831845f); }
}

constexpr int RW_NC = 64, RW_CL = 256, RW_TS = 8;
__device__ __forceinline__ void rw_stage(const unsigned char* ws, LAS float* tile, int t0, int h, int lane, bool need_r) {
    const unsigned e0 = (unsigned)(t0 * 1024 + h * 64 + lane);
#pragma unroll
    for (int s = 0; s < RW_TS; ++s) { const unsigned e = e0 + (unsigned)s * 1024u; LAS float* tp = tile + s * 384 + lane;
        tp[0] = bf2f(*(const bf16*)(ws + ((unsigned)WS_RW_KK + e * 2u))); tp[64] = bf2f(*(const bf16*)(ws + ((unsigned)WS_RW_B + e * 2u))); tp[128] = *(const float*)(ws + ((unsigned)WS_RW_W + e * 4u));
        tp[192] = bf2f(*(const bf16*)(ws + ((unsigned)WS_RW_K + e * 2u))); tp[256] = need_r ? bf2f(*(const bf16*)(ws + ((unsigned)WS_RW_R + e * 2u))) : 0.f; tp[320] = bf2f(*(const bf16*)(ws + ((unsigned)WS_RW_V + e * 2u))); }
}
#define RW_STEP_UPDATE(tp, vi) { \
    float s0 = 0.f, s1 = 0.f, s2 = 0.f, s3 = 0.f; \
    _Pragma("unroll") for (int jj = 0; jj < 16; ++jj) { const f32x4 k4 = *(const LAS f32x4*)((tp) + 4 * jj); s0 += S[4 * jj] * k4[0]; s1 += S[4 * jj + 1] * k4[1]; s2 += S[4 * jj + 2] * k4[2]; s3 += S[4 * jj + 3] * k4[3]; } \
    const float sk = (s0 + s1) + (s2 + s3); \
    _Pragma("unroll") for (int jj = 0; jj < 16; ++jj) { const f32x4 b4 = *(const LAS f32x4*)((tp) + 64 + 4 * jj), w4 = *(const LAS f32x4*)((tp) + 128 + 4 * jj), k4 = *(const LAS f32x4*)((tp) + 192 + 4 * jj); \
        _Pragma("unroll") for (int q = 0; q < 4; ++q) S[4 * jj + q] = S[4 * jj + q] * w4[q] + ((vi) * k4[q] - sk * b4[q]); } }

__device__ __forceinline__ void rw_pass1(const Ctx& c, const PA& a) {
    const unsigned char* ws = a.ws; LAS float* tile = (LAS float*)(c.lds + c.wave * (RW_TS * 384 * 4));
    const int lane = c.lane;
    for (int task = c.gw; task < 16 * RW_NC * 2; task += c.NGW) {
        const int kind = task & 1, hc = task >> 1, h = hc / RW_NC, ch = hc % RW_NC;
        float S[64]; int lz = kind ? 64 : lane; asm volatile("" : "+v"(lz));
#pragma unroll
        for (int j = 0; j < 64; ++j) S[j] = (j == lz) ? 1.f : 0.f;
        for (int t0 = ch * RW_CL; t0 < (ch + 1) * RW_CL; t0 += RW_TS) {
            rw_stage(ws, tile, t0, h, lane, false);
            LDS_WAIT();
#pragma unroll 1
            for (int s = 0; s < RW_TS; ++s) { const LAS float* tp = tile + s * 384; const float vi = kind ? tp[320 + lane] : 0.f; RW_STEP_UPDATE(tp, vi); }
            LDS_WAIT();
        }
        float* out = (float*)(a.ws + (kind ? WS_RWU : WS_RWP)) + ((size_t)hc * 64 + lane) * 64;
#pragma unroll
        for (int jj = 0; jj < 16; ++jj) *(f32x4*)(out + 4 * jj) = (f32x4){S[4 * jj], S[4 * jj + 1], S[4 * jj + 2], S[4 * jj + 3]};
    }
}
__device__ __forceinline__ void rw_pass2(const Ctx& c, const PA& a) {
    const float* P = (const float*)(a.ws + WS_RWP); const float* U = (const float*)(a.ws + WS_RWU); float* Si = (float*)(a.ws + WS_RWS);
    const int lane = c.lane;
    for (int task = c.gw; task < 16 * 64; task += c.NGW) { const int h = task >> 6, i = task & 63;
        float s = 0.f;
        for (int ch = 0; ch < RW_NC; ++ch) { const size_t hc = (size_t)h * RW_NC + ch;
            Si[(hc * 64 + i) * 64 + lane] = s;
            float acc = U[(hc * 64 + i) * 64 + lane]; const float* Pc = P + hc * 4096 + lane;
#pragma unroll
            for (int i2 = 0; i2 < 64; ++i2) acc += __shfl(s, i2) * Pc[i2 * 64];
            s = acc; }
    }
}
__device__ __forceinline__ void rw_pass3(const Ctx& c, const PA& a, int layer) {
    const unsigned char* ws = a.ws; LAS float* tile = (LAS float*)(c.lds + c.wave * (RW_TS * 384 * 4));
    const float* Si = (const float*)(ws + WS_RWS); const float* rkb = (const float*)(ws + WS_RKB); const bf16* G = (const bf16*)(ws + WS_RW_G); bf16* Y = (bf16*)(a.ws + WS_YRW);
    const float* lng = a.in(15) + layer * 1024; const float* lnb = a.in(16) + layer * 1024;
    const int lane = c.lane;
    for (int task = c.gw; task < 16 * RW_NC; task += c.NGW) {
        const int h = task / RW_NC, ch = task % RW_NC, col = h * 64 + lane;
        const float lg = lng[col], lb = lnb[col];
        float S[64]; const float* sp = Si + ((size_t)task * 64 + lane) * 64;
#pragma unroll
        for (int jj = 0; jj < 16; ++jj) { const f32x4 v = *(const f32x4*)(sp + 4 * jj); S[4 * jj] = v[0]; S[4 * jj + 1] = v[1]; S[4 * jj + 2] = v[2]; S[4 * jj + 3] = v[3]; }
        for (int t0 = ch * RW_CL; t0 < (ch + 1) * RW_CL; t0 += RW_TS) {
            rw_stage(ws, tile, t0, h, lane, true);
            LDS_WAIT();
#pragma unroll 1
            for (int s = 0; s < RW_TS; ++s) { const LAS float* tp = tile + s * 384; const float vi = tp[320 + lane]; RW_STEP_UPDATE(tp, vi);
                float y0 = 0.f, y1 = 0.f, y2 = 0.f, y3 = 0.f;
#pragma unroll
                for (int jj = 0; jj < 16; ++jj) { const f32x4 r4 = *(const LAS f32x4*)(tp + 256 + 4 * jj); y0 += S[4 * jj] * r4[0]; y1 += S[4 * jj + 1] * r4[1]; y2 += S[4 * jj + 2] * r4[2]; y3 += S[4 * jj + 3] * r4[3]; }
                const float y = (y0 + y1) + (y2 + y3), mean = wave_sum(y) * (1.f / 64.f), dlt = y - mean, var = wave_sum(dlt * dlt) * (1.f / 64.f);
                const float yn = dlt * (1.f / sqrtf(var + 64e-5f)); const int t = t0 + s; const size_t o = (size_t)t * 1024 + col;
                Y[o] = (bf16)f2bf((yn * lg + lb + rkb[t * 16 + h] * vi) * bf2f(G[o])); }
            LDS_WAIT();
        }
    }
}

__device__ __forceinline__ void ret_kv(const Ctx& c, const PA& a) {
    const bf16* proj = (const bf16*)(a.ws + WS_PROJ); float* KV = (float*)(a.ws + WS_RETKV);
    const int dv = c.tid & 127, dkg = c.tid >> 7;
    for (int it = c.bx; it < 128 * 8; it += c.G) { const int ch = it >> 3, h = it & 7; const float lg = RET_LOGG[h];
        float acc[32];
#pragma unroll
        for (int q = 0; q < 32; ++q) acc[q] = 0.f;
        for (int i = 0; i < 128; ++i) { const bf16* row = proj + (size_t)(ch * 128 + i) * LDP;
            const float vv = bf2f(row[PC_RV + h * 128 + dv]) * expf(lg * (float)(127 - i));
            const u32x4* kp = (const u32x4*)(row + PC_RK + h * 128 + 32 * dkg);
#pragma unroll
            for (int q4 = 0; q4 < 4; ++q4) { const u32x4 kw = kp[q4];
                acc[8 * q4 + 0] += bflo(kw.x) * vv; acc[8 * q4 + 1] += bfhi(kw.x) * vv; acc[8 * q4 + 2] += bflo(kw.y) * vv; acc[8 * q4 + 3] += bfhi(kw.y) * vv;
                acc[8 * q4 + 4] += bflo(kw.z) * vv; acc[8 * q4 + 5] += bfhi(kw.z) * vv; acc[8 * q4 + 6] += bflo(kw.w) * vv; acc[8 * q4 + 7] += bfhi(kw.w) * vv; } }
        float* o = KV + ((size_t)it * 128 + 32 * dkg) * 128 + dv;
#pragma unroll
        for (int q = 0; q < 32; ++q) o[q * 128] = acc[q];
    }
}
__device__ __forceinline__ void ret_prefix(const Ctx& c, const PA& a) {
    float* KV = (float*)(a.ws + WS_RETKV);
    for (int i = c.bx * 512 + c.tid; i < 8 * 16384; i += c.G * 512) { const int h = i >> 14, e = i & 16383; const float cd = expf(RET_LOGG[h] * 128.f);
        float r = 0.f;
        for (int ch = 0; ch < 128; ++ch) { float* p = KV + ((size_t)(ch * 8 + h) << 14) + e; const float tmp = *p; *p = r; r = r * cd + tmp; } }
}
__device__ __forceinline__ void ret_out(const Ctx& c, const PA& a) {
    const bf16* proj = (const bf16*)(a.ws + WS_PROJ); const float* KV = (const float*)(a.ws + WS_RETKV); bf16* Y = (bf16*)(a.ws + WS_YRET);
    constexpr int RS = 130;
    LAS bf16* sq = (LAS bf16*)c.lds; LAS bf16* sk = sq + 128 * RS; LAS bf16* sv = sk + 128 * RS; LAS float* att = (LAS float*)(sv + 128 * RS);
    const int tid = c.tid, lane = c.lane, w = c.wave;
    for (int it = c.bx; it < 128 * 8; it += c.G) { const int ch = it >> 3, h = it & 7; const float lg = RET_LOGG[h];
        for (int idx = tid; idx < 128 * 64; idx += 512) { const int i = idx >> 6, d2 = (idx & 63) * 2; const bf16* row = proj + (size_t)(ch * 128 + i) * LDP + h * 128 + d2;
            *(LAS unsigned*)(sq + i * RS + d2) = *(const unsigned*)(row + PC_RQ); *(LAS unsigned*)(sk + i * RS + d2) = *(const unsigned*)(row + PC_RK); *(LAS unsigned*)(sv + i * RS + d2) = *(const unsigned*)(row + PC_RV); }
        __syncthreads();
        for (int half = 0; half < 2; ++half) {
            { const int s = tid & 127, ig = tid >> 7;
                float ac[16];
#pragma unroll
                for (int r = 0; r < 16; ++r) ac[r] = 0.f;
                for (int d2 = 0; d2 < 128; d2 += 2) { const unsigned kw = *(const LAS unsigned*)(sk + s * RS + d2); const float k0 = bflo(kw), k1 = bfhi(kw);
#pragma unroll
                    for (int r = 0; r < 16; ++r) { const unsigned qw = *(const LAS unsigned*)(sq + (64 * half + 16 * ig + r) * RS + d2); ac[r] += bflo(qw) * k0 + bfhi(qw) * k1; } }
#pragma unroll
                for (int r = 0; r < 16; ++r) { const int i = 64 * half + 16 * ig + r; att[(16 * ig + r) * 128 + s] = (i >= s) ? ac[r] * expf(lg * (float)(i - s)) : 0.f; } }
            __syncthreads();
            float o[16];
            { const int dv = tid & 127, ig = tid >> 7;
#pragma unroll
                for (int r = 0; r < 16; ++r) o[r] = 0.f;
                for (int dk = 0; dk < 128; ++dk) { const float rv = KV[((size_t)it * 128 + dk) * 128 + dv];
#pragma unroll
                    for (int r = 0; r < 16; ++r) o[r] += bf2f(sq[(64 * half + 16 * ig + r) * RS + dk]) * rv; }
#pragma unroll
                for (int r = 0; r < 16; ++r) o[r] *= expf(lg * (float)(64 * half + 16 * ig + r + 1));
                for (int s = 0; s < 128; ++s) { const float vv = bf2f(sv[s * RS + dv]);
#pragma unroll
                    for (int r = 0; r < 16; ++r) o[r] += att[(16 * ig + r) * 128 + s] * vv; } }
            __syncthreads();
            { const int dv = tid & 127, ig = tid >> 7;
#pragma unroll
                for (int r = 0; r < 16; ++r) att[(16 * ig + r) * 128 + dv] = o[r]; }
            __syncthreads();
            for (int rr = 0; rr < 8; ++rr) { const int ip = w * 8 + rr, t = ch * 128 + 64 * half + ip;
                const float x0 = att[ip * 128 + lane], x1 = att[ip * 128 + 64 + lane];
                const float mean = wave_sum(x0 + x1) * (1.f / 128.f), d0 = x0 - mean, d1 = x1 - mean, var = wave_sum(d0 * d0 + d1 * d1) * (1.f / 128.f), rs = 1.f / sqrtf(var + 1e-5f);
                const bf16* grow = proj + (size_t)t * LDP + PC_RG + h * 128; const float g0 = bf2f(grow[lane]), g1 = bf2f(grow[64 + lane]);
                Y[(size_t)t * 1024 + h * 128 + lane] = (bf16)f2bf(g0 * sigm(g0) * d0 * rs); Y[(size_t)t * 1024 + h * 128 + 64 + lane] = (bf16)f2bf(g1 * sigm(g1) * d1 * rs); }
            __syncthreads();
        }
    }
}


typedef short bf16x8 __attribute__((ext_vector_type(8)));
typedef short bf16x4 __attribute__((ext_vector_type(4)));
constexpr float NSA_C = 0.125f * 1.4426950408889634f;
struct NsaSrc { const bf16* k; int krs; const bf16* vt; int vrs; int kmax; };

template <int MODE>
__device__ __forceinline__ void nsa_block(const NsaSrc& src, int key0, int lo, int hi, const bf16x8 (&qf)[2], f32x4 (&O)[4], float& m, float& l, float inv, int r, int q, LAS float* impA, LAS float* impB) {
    bf16x8 kf[4][2];
#pragma unroll
    for (int j = 0; j < 4; ++j) { int row = key0 + 16 * j + r; row = row < 0 ? 0 : (row > src.kmax ? src.kmax : row); const bf16* kp = src.k + (size_t)row * src.krs + 8 * q;
        kf[j][0] = *(const bf16x8*)kp; kf[j][1] = *(const bf16x8*)(kp + 32); }
    bf16x8 vf[4][2];
    if (MODE != 0) {
#pragma unroll
        for (int mt = 0; mt < 4; ++mt) { const bf16* vp = src.vt + (size_t)(16 * mt + r) * src.vrs + key0 + 4 * q;
#pragma unroll
            for (int ks = 0; ks < 2; ++ks) { const bf16x4 a = *(const bf16x4*)(vp + 32 * ks), b = *(const bf16x4*)(vp + 32 * ks + 16);
                vf[mt][ks] = (bf16x8){a[0], a[1], a[2], a[3], b[0], b[1], b[2], b[3]}; } } }
    f32x4 st[4];
#pragma unroll
    for (int j = 0; j < 4; ++j) { st[j] = (f32x4){0.f, 0.f, 0.f, 0.f};
        st[j] = __builtin_amdgcn_mfma_f32_16x16x32_bf16(kf[j][0], qf[0], st[j], 0, 0, 0); st[j] = __builtin_amdgcn_mfma_f32_16x16x32_bf16(kf[j][1], qf[1], st[j], 0, 0, 0); }
    float mx = -1.0e30f;
#pragma unroll
    for (int j = 0; j < 4; ++j)
#pragma unroll
        for (int i = 0; i < 4; ++i) { const int key = key0 + 16 * j + 4 * q + i; const bool ok = key >= lo && key <= hi; st[j][i] = ok ? st[j][i] : -1.0e30f; mx = fmaxf(mx, st[j][i]); }
    float mn = m;
    if (MODE != 2) { mx = fmaxf(mx, __shfl_xor(mx, 16)); mx = fmaxf(mx, __shfl_xor(mx, 32)); mn = fmaxf(m, mx); }
    float ps = 0.f;
#pragma unroll
    for (int j = 0; j < 4; ++j)
#pragma unroll
        for (int i = 0; i < 4; ++i) { const float e = st[j][i] > -1.0e29f ? __builtin_amdgcn_exp2f(NSA_C * (st[j][i] - mn)) : 0.f; st[j][i] = MODE == 2 ? e * inv : e; ps += e; }
    if (MODE != 2) { ps += __shfl_xor(ps, 16); ps += __shfl_xor(ps, 32);
        const float sc = __builtin_amdgcn_exp2f(NSA_C * (m - mn)); l = l * sc + ps; m = mn;
        if (MODE == 1) {
#pragma unroll
            for (int mt = 0; mt < 4; ++mt) O[mt] = O[mt] * sc; } }
    if (MODE == 2) {
#pragma unroll
        for (int j = 0; j < 4; ++j) { float a = (st[j][0] + st[j][1]) + (st[j][2] + st[j][3]), b = st[j][3];
            a += __shfl_xor(a, 1); a += __shfl_xor(a, 2); b += __shfl_xor(b, 1); b += __shfl_xor(b, 2);
            if (r == 0) { const int J = (key0 >> 2) + 4 * j + q; impA[J] = a; impB[J] = b; } } }
    if (MODE != 0) {
        bf16x8 pf[2];
#pragma unroll
        for (int ks = 0; ks < 2; ++ks) { const unsigned w0 = pg8::cvt_pk_bf16(st[2 * ks][0], st[2 * ks][1]), w1 = pg8::cvt_pk_bf16(st[2 * ks][2], st[2 * ks][3]),
                                                        w2 = pg8::cvt_pk_bf16(st[2 * ks + 1][0], st[2 * ks + 1][1]), w3 = pg8::cvt_pk_bf16(st[2 * ks + 1][2], st[2 * ks + 1][3]);
            const u32x4 w = (u32x4){w0, w1, w2, w3}; pf[ks] = __builtin_bit_cast(bf16x8, w); }
#pragma unroll
        for (int mt = 0; mt < 4; ++mt) { O[mt] = __builtin_amdgcn_mfma_f32_16x16x32_bf16(vf[mt][0], pf[0], O[mt], 0, 0, 0); O[mt] = __builtin_amdgcn_mfma_f32_16x16x32_bf16(vf[mt][1], pf[1], O[mt], 0, 0, 0); } }
}
constexpr int NSA2_WLDS = 4096;
__device__ __forceinline__ void nsa_attn2(const Ctx& c, const PA& a) {
    const unsigned char* ws = a.ws; const bf16* proj = (const bf16*)(ws + WS_PROJ); bf16* Y = (bf16*)(a.ws + WS_YNSA);
    LAS float* impA = (LAS float*)(c.lds + c.wave * NSA2_WLDS); LAS float* impB = impA + 256; LAS int* KST = (LAS int*)(impB + 256);
    const int lane = c.lane, r = lane & 15, q = lane >> 4;
    for (int task = c.gw; task < T * 4; task += c.NGW) { const int t = task >> 2, g = task & 3;
        const bf16* prow = proj + (size_t)t * LDP;
        bf16x8 qf[2]; qf[0] = (bf16x8){0, 0, 0, 0, 0, 0, 0, 0}; qf[1] = qf[0];
        float gt0 = 0.f, gt1 = 0.f, gt2 = 0.f;
        if (r < 4) { const bf16* qp = prow + PC_NQ + (g * 4 + r) * 64 + 8 * q; qf[0] = *(const bf16x8*)qp; qf[1] = *(const bf16x8*)(qp + 32);
            const bf16* gp = prow + PC_GATE + (g * 4 + r) * 3; gt0 = sigm(bf2f(gp[0])); gt1 = sigm(bf2f(gp[1])); gt2 = sigm(bf2f(gp[2])); }
        const int cur = t >> 6, ncv = t >= 31 ? ((t - 31) >> 4) + 1 : 0;
#pragma unroll
        for (int i = 0; i < 4; ++i) { impA[lane + 64 * i] = 0.f; impB[lane + 64 * i] = 0.f; }
        LDS_WAIT();
        f32x4 yacc[4], O[4];
#pragma unroll
        for (int mt = 0; mt < 4; ++mt) yacc[mt] = (f32x4){0.f, 0.f, 0.f, 0.f};
        if (ncv > 0) {
            NsaSrc sc; sc.k = (const bf16*)(ws + WS_KCMPB) + (size_t)g * 1024 * 64; sc.krs = 64; sc.vt = (const bf16*)(ws + WS_VCMPT) + (size_t)g * 64 * 1024; sc.vrs = 1024; sc.kmax = 1023;
            const int nb = (ncv + 63) >> 6; float m = -1.0e30f, l = 0.f;
            for (int b = 0; b < nb; ++b) nsa_block<0>(sc, 64 * b, 0, ncv - 1, qf, O, m, l, 0.f, r, q, impA, impB);
            const float inv = 1.f / l;
#pragma unroll
            for (int mt = 0; mt < 4; ++mt) O[mt] = (f32x4){0.f, 0.f, 0.f, 0.f};
            for (int b = 0; b < nb; ++b) nsa_block<2>(sc, 64 * b, 0, ncv - 1, qf, O, m, l, inv, r, q, impA, impB);
#pragma unroll
            for (int mt = 0; mt < 4; ++mt) yacc[mt] = O[mt] * gt0;
        }
        LDS_WAIT();
        float scv[4];
#pragma unroll
        for (int mm = 0; mm < 4; ++mm) { const int j = 4 * lane + mm; float s = -1.0e30f;
            if (j <= cur) { s = impA[j] + (j > 0 ? impB[j - 1] : 0.f); if (j == 0 || j == cur || j == cur - 1) s += 1.0e4f; }
            scv[mm] = s; }
        int nsel = 0;
        for (int itk = 0; itk < 16; ++itk) {
            float lv = scv[0]; int lj = 4 * lane;
            if (scv[1] > lv) { lv = scv[1]; lj = 4 * lane + 1; } if (scv[2] > lv) { lv = scv[2]; lj = 4 * lane + 2; } if (scv[3] > lv) { lv = scv[3]; lj = 4 * lane + 3; }
            const float vmax = wave_max(lv); if (vmax < -5.0e29f) break;
            const int jmin = wave_min_i(lv == vmax ? lj : (1 << 30));
            if (lane == 0) KST[itk] = jmin * 64;
            if ((jmin >> 2) == lane) { const int mm = jmin & 3; if (mm == 0) scv[0] = -3.0e38f; else if (mm == 1) scv[1] = -3.0e38f; else if (mm == 2) scv[2] = -3.0e38f; else scv[3] = -3.0e38f; }
            ++nsel; }
        LDS_WAIT();
        { NsaSrc ss; ss.k = proj + PC_KS + g * 64; ss.krs = LDP; ss.vt = (const bf16*)(ws + WS_VST) + (size_t)g * 64 * T; ss.vrs = T; ss.kmax = T - 1;
            float m = -1.0e30f, l = 0.f;
#pragma unroll
            for (int mt = 0; mt < 4; ++mt) O[mt] = (f32x4){0.f, 0.f, 0.f, 0.f};
            for (int b = 0; b < nsel; ++b) nsa_block<1>(ss, KST[b], 0, t, qf, O, m, l, 0.f, r, q, impA, impB);
            const float sc = gt1 / l;
#pragma unroll
            for (int mt = 0; mt < 4; ++mt) yacc[mt] += O[mt] * sc; }
        { NsaSrc sw; sw.k = proj + PC_KW + g * 64; sw.krs = LDP; sw.vt = (const bf16*)(ws + WS_VWT) + (size_t)g * 64 * T; sw.vrs = T; sw.kmax = T - 1;
            float m = -1.0e30f, l = 0.f; const int wlo = t - 511 > 0 ? t - 511 : 0;
#pragma unroll
            for (int mt = 0; mt < 4; ++mt) O[mt] = (f32x4){0.f, 0.f, 0.f, 0.f};
            for (int jb = wlo >> 6; jb <= cur; ++jb) nsa_block<1>(sw, 64 * jb, wlo, t, qf, O, m, l, 0.f, r, q, impA, impB);
            const float sc = gt2 / l;
#pragma unroll
            for (int mt = 0; mt < 4; ++mt) yacc[mt] += O[mt] * sc; }
        if (r < 4) {
#pragma unroll
            for (int mt = 0; mt < 4; ++mt) { uint2 w; w.x = pg8::cvt_pk_bf16(yacc[mt][0], yacc[mt][1]); w.y = pg8::cvt_pk_bf16(yacc[mt][2], yacc[mt][3]);
                *(uint2*)(Y + (size_t)t * 1024 + (g * 4 + r) * 64 + 16 * mt + 4 * q) = w; } }
    }
}
__device__ __forceinline__ void prep_vT(const Ctx& c, const PA& a) {
    const bf16* proj = (const bf16*)(a.ws + WS_PROJ);
    LAS bf16* tile = (LAS bf16*)(c.lds + c.wave * 8704);
    const int lane = c.lane;
    for (int it = c.gw; it < (T / 64) * 8; it += c.NGW) { const int tb = it >> 3, cb = it & 7, t0 = tb * 64;
        const int scol = (cb < 4 ? PC_VS : PC_VW) + (cb & 3) * 64; bf16* dst = (bf16*)(a.ws + (cb < 4 ? WS_VST : WS_VWT)) + (size_t)(cb & 3) * 64 * T;
        const u32x4* sp = (const u32x4*)(proj + (size_t)(t0 + lane) * LDP + scol);
#pragma unroll
        for (int i = 0; i < 8; ++i) { const u32x4 v = sp[i]; LAS unsigned* tp = (LAS unsigned*)(tile + lane * 66 + 8 * i); tp[0] = v.x; tp[1] = v.y; tp[2] = v.z; tp[3] = v.w; }
        LDS_WAIT();
        unsigned w[32];
#pragma unroll
        for (int i = 0; i < 32; ++i) w[i] = (unsigned)tile[(2 * i) * 66 + lane] | ((unsigned)tile[(2 * i + 1) * 66 + lane] << 16);
        u32x4* dp = (u32x4*)(dst + (size_t)lane * T + t0);
#pragma unroll
        for (int i = 0; i < 8; ++i) dp[i] = (u32x4){w[4 * i], w[4 * i + 1], w[4 * i + 2], w[4 * i + 3]};
        LDS_WAIT();
    }
}

__device__ __forceinline__ void ln_row(f32x4 (&v)[8], const float* gam, const float* bet, int lane) {
    float s = 0.f;
#pragma unroll
    for (int j = 0; j < 8; ++j) s += (v[j][0] + v[j][1]) + (v[j][2] + v[j][3]);
    const float mean = wave_sum(s) * (1.f / D); float s2 = 0.f;
#pragma unroll
    for (int j = 0; j < 8; ++j) { v[j] = v[j] - mean; s2 += (v[j][0] * v[j][0] + v[j][1] * v[j][1]) + (v[j][2] * v[j][2] + v[j][3] * v[j][3]); }
    const float rstd = 1.f / sqrtf(wave_sum(s2) * (1.f / D) + LN_EPS);
#pragma unroll
    for (int j = 0; j < 8; ++j) { const f32x4 g4 = *(const f32x4*)(gam + 4 * (lane + 64 * j)), b4 = *(const f32x4*)(bet + 4 * (lane + 64 * j)); v[j] = v[j] * rstd * g4 + b4; }
}
__device__ __forceinline__ void ph_ln1_route(const Ctx& c, const PA& a, int layer) {
    unsigned char* ws = a.ws; float* X = a.out; uint2* xb = (uint2*)(ws + WS_XB);
    const float* gam = a.in(25) + layer * D; const float* bet = a.in(26) + layer * D;
    const float* wg = a.in(27) + (size_t)layer * D * 4; const float* bg = a.in(28) + layer * 4; const float* we = a.in(29) + (size_t)layer * D * 32; const float* be = a.in(30) + layer * 32;
    int* toke = (int*)(ws + WS_TOKE); float* tokw = (float*)(ws + WS_TOKW); unsigned* cnt = (unsigned*)(ws + WS_CTL) + CW_CNT + layer * 128;
    LAS float* lg = (LAS float*)(c.lds + c.wave * 256);
    const int lane = c.lane;
    for (int t = c.gw; t < T; t += c.NGW) {
        f32x4* row = (f32x4*)(X + (size_t)t * D); f32x4 v[8];
#pragma unroll
        for (int j = 0; j < 8; ++j) v[j] = row[lane + 64 * j];
        ln_row(v, gam, bet, lane);
#pragma unroll
        for (int j = 0; j < 8; ++j) { row[lane + 64 * j] = v[j]; xb[(size_t)t * (D / 4) + lane + 64 * j] = make_uint2(pk2(v[j][0], v[j][1]), pk2(v[j][2], v[j][3])); }
        LAS float* xr = (LAS float*)(c.lds + 4096 + c.wave * 8192);
#pragma unroll
        for (int j = 0; j < 8; ++j) *(LAS f32x4*)(xr + 4 * (lane + 64 * j)) = v[j];
        LDS_WAIT();
        f32x4 ag = (f32x4){0.f, 0.f, 0.f, 0.f}; f32x4 ae[8];
#pragma unroll
        for (int q = 0; q < 8; ++q) ae[q] = (f32x4){0.f, 0.f, 0.f, 0.f};
#pragma unroll 2
        for (int i = 0; i < 32; ++i) { const int d = lane + 64 * i; const float x = xr[d];
            ag += *(const f32x4*)(wg + (size_t)d * 4) * x;
            const f32x4* wp = (const f32x4*)(we + (size_t)d * 32);
#pragma unroll
            for (int e4 = 0; e4 < 8; ++e4) ae[e4] += wp[e4] * x; }
#pragma unroll
        for (int q = 0; q < 4; ++q) ag[q] = wave_sum(ag[q]) + bg[q];
#pragma unroll
        for (int e4 = 0; e4 < 8; ++e4)
#pragma unroll
            for (int q = 0; q < 4; ++q) ae[e4][q] = wave_sum(ae[e4][q]);
        if (lane == 0) {
#pragma unroll
            for (int e4 = 0; e4 < 8; ++e4)
#pragma unroll
                for (int q = 0; q < 4; ++q) lg[e4 * 4 + q] = ae[e4][q] + be[e4 * 4 + q]; }
        LDS_WAIT();
        int grp = 0; float gm = ag[0];
        if (ag[1] > gm) { gm = ag[1]; grp = 1; } if (ag[2] > gm) { gm = ag[2]; grp = 2; } if (ag[3] > gm) { gm = ag[3]; grp = 3; }
        const float gw_ = 1.f / (expf(ag[0] - gm) + expf(ag[1] - gm) + expf(ag[2] - gm) + expf(ag[3] - gm));
        float v0 = -3.0e38f, v1 = -3.0e38f; int i0 = 0, i1 = 0;
        for (int i = 0; i < 8; ++i) { const float x = lg[grp * 8 + i];
            if (x > v0) { v1 = v0; i1 = i0; v0 = x; i0 = i; } else if (x > v1) { v1 = x; i1 = i; } }
        const float e1 = expf(v1 - v0), p0 = 1.f / (1.f + e1), p1 = e1 * p0;
        if (lane == 0) { toke[2 * t] = grp * 8 + i0; toke[2 * t + 1] = grp * 8 + i1; tokw[2 * t] = p0 * gw_; tokw[2 * t + 1] = p1 * gw_;
            __hip_atomic_fetch_add(cnt + grp * 8 + i0, 1u, __ATOMIC_RELAXED, __HIP_MEMORY_SCOPE_AGENT); __hip_atomic_fetch_add(cnt + grp * 8 + i1, 1u, __ATOMIC_RELAXED, __HIP_MEMORY_SCOPE_AGENT); }
        LDS_WAIT();
    }
}
__device__ __forceinline__ void ph_slot(const Ctx& c, const PA& a, int layer) {
    unsigned char* ws = a.ws; unsigned* cnt = (unsigned*)(ws + WS_CTL) + CW_CNT + layer * 128; unsigned* cur = (unsigned*)(ws + WS_CTL) + CW_CUR + layer * 128;
    int* texp = (int*)(ws + WS_TEXP) + layer * 512; const int* toke = (const int*)(ws + WS_TOKE); int* slot = (int*)(ws + WS_SLOT);
    LAS int* pst = (LAS int*)c.lds;
    if (c.tid == 0) { int off = 0, nt = 0;
#pragma unroll 1
        for (int e = 0; e < NEXP; ++e) { const int n = (int)__hip_atomic_load(cnt + e, __ATOMIC_RELAXED, __HIP_MEMORY_SCOPE_AGENT), tl = (n + 255) >> 8;
            pst[e] = off; off += tl * 256;
            if (c.bx == 0) for (int q = 0; q < tl; ++q) texp[nt + q] = e;
            nt += tl; }
        if (c.bx == 0) texp[255] = nt; }
    __syncthreads();
    const u32x4* xb = (const u32x4*)(ws + WS_XB); u32x4* xs = (u32x4*)(ws + WS_XS);
    for (int as = c.gw; as < 2 * T; as += c.NGW) { const int t = as >> 1, e = toke[as]; int s = 0;
        if (c.lane == 0) s = pst[e] + (int)__hip_atomic_fetch_add(cur + e, 1u, __ATOMIC_RELAXED, __HIP_MEMORY_SCOPE_AGENT);
        s = __shfl(s, 0);
        if (c.lane == 0) slot[as] = s;
#pragma unroll
        for (int j = 0; j < 4; ++j) xs[(size_t)s * 256 + c.lane + 64 * j] = xb[(size_t)t * 256 + c.lane + 64 * j]; }
}
__device__ __forceinline__ void ph_ln2(const Ctx& c, const PA& a, int layer) {
    unsigned char* ws = a.ws; float* X = a.out; uint2* xb = (uint2*)(ws + WS_XB); const uint2* ys = (const uint2*)(ws + WS_YS);
    const float* gam = a.in(34) + layer * D; const float* bet = a.in(35) + layer * D; const int* slot = (const int*)(ws + WS_SLOT); const float* tokw = (const float*)(ws + WS_TOKW);
    const int lane = c.lane;
    for (int t = c.gw; t < T; t += c.NGW) {
        const int s0 = slot[2 * t], s1 = slot[2 * t + 1]; const float w0 = tokw[2 * t], w1 = tokw[2 * t + 1];
        f32x4* row = (f32x4*)(X + (size_t)t * D); f32x4 v[8];
#pragma unroll
        for (int j = 0; j < 8; ++j) { const uint2 y0 = ys[(size_t)s0 * 512 + lane + 64 * j], y1 = ys[(size_t)s1 * 512 + lane + 64 * j]; const f32x4 x = row[lane + 64 * j];
            v[j][0] = x[0] * DN_ALPHA + w0 * bflo(y0.x) + w1 * bflo(y1.x); v[j][1] = x[1] * DN_ALPHA + w0 * bfhi(y0.x) + w1 * bfhi(y1.x);
            v[j][2] = x[2] * DN_ALPHA + w0 * bflo(y0.y) + w1 * bflo(y1.y); v[j][3] = x[3] * DN_ALPHA + w0 * bfhi(y0.y) + w1 * bfhi(y1.y); }
        ln_row(v, gam, bet, lane);
#pragma unroll
        for (int j = 0; j < 8; ++j) { row[lane + 64 * j] = v[j]; xb[(size_t)t * (D / 4) + lane + 64 * j] = make_uint2(pk2(v[j][0], v[j][1]), pk2(v[j][2], v[j][3])); }
    }
}

enum { PH_CONV = 0, PH_INPROJ, PH_PREP, PH_SCAN1, PH_SCAN2, PH_SCAN3, PH_GATES, PH_BRANCH, PH_OUT, PH_LN1, PH_SLOT, PH_MOE_GU, PH_MOE_DN, PH_LN2, NPH_L };
constexpr int NPH = NPH_L * DEPTH;

__device__ __forceinline__ Ctx mkctx(LAS unsigned char* lds, int wv) {
    int ln; asm volatile("v_mbcnt_lo_u32_b32 %0, -1, 0\n\tv_mbcnt_hi_u32_b32 %0, -1, %0" : "=v"(ln));
    int tid = wv * 64 + ln, bx = blockIdx.x, G = gridDim.x;
    asm volatile("" : "+s"(bx)); asm volatile("" : "+s"(G));
    Ctx c; c.lds = lds; c.tid = tid; c.lane = tid & 63; c.wave = __builtin_amdgcn_readfirstlane(tid >> 6); c.G = G; c.bx = bx; c.gw = bx * 8 + c.wave; c.NGW = G * 8; return c;
}
__global__ void __launch_bounds__(512, 2) fwd(Args args0) {
    extern __shared__ __attribute__((aligned(16))) unsigned char lds_raw[];
    LAS unsigned char* const lds0 = (LAS unsigned char*)lds_raw;
    const int lo = args0.ph_lo, hi = args0.ph_hi;
    const int wv0 = __builtin_amdgcn_readfirstlane(threadIdx.x >> 6);
    if (threadIdx.x < 36) ((LAS unsigned long long*)(lds0 + LDS_PTAB))[threadIdx.x] = (unsigned long long)args0.in[threadIdx.x];
    __syncthreads();
#if MK_ONE_LAUNCH
    volatile LAS unsigned* barw = (volatile LAS unsigned*)(lds0 + LDS_BARW);
    if (threadIdx.x == 0) { barw[0] = 0u; barw[1] = 0u; barw[2] = 0u; barw[3] = 0u; }
    __syncthreads();
    XcdBarrier bar = xcd_barrier_post((unsigned*)(args0.ws + WS_CTL) + CW_BAR, barw);
#define SEAM(p) do { if ((p) + 1 < hi) xcd_barrier(bar); } while (0)
#else
#define SEAM(p) do { } while (0)
#endif
#ifndef ONLY_PHASE
#define ONLY_PHASE -1
#endif
#define PHASE_BEGIN PA args; { unsigned char* w_ = args0.ws; asm volatile("" : "+s"(w_)); args.ws = w_; float* o_ = args0.out; asm volatile("" : "+s"(o_)); args.out = o_; args.tab = (const LAS unsigned*)(lds0 + LDS_PTAB); } unsigned char* const ws = args.ws; const Ctx c = mkctx(lds0, wv0); (void)ws; (void)c;
#define TASK_CTX() mkctx(lds0, wv0)
#define IN(p) ((ONLY_PHASE < 0 || ONLY_PHASE == ((p) - pb)) && lo <= (p) && (p) < hi)
    for (int layer = 0; layer < DEPTH; ++layer) {
        const int pb = layer * NPH_L;
        if (IN(pb + PH_CONV)) { PHASE_BEGIN ph_conv(c, args, layer); __syncthreads(); SEAM(pb + PH_CONV); }
        if (IN(pb + PH_INPROJ)) { PHASE_BEGIN
            Gemm g{D, D, D}; SchedPlain S; S.to.init(T / 256, LDP / 256); S.G = c.G; S.c = c.bx; S.tid = c.tid; S.A = (const char*)(ws + WS_XB); S.B = (const char*)(ws + WS_WIN); S.ta = (size_t)256 * D * 2; S.tb = (size_t)256 * D * 2;
            EpiStore<0> E{(bf16*)(ws + WS_PROJ), LDP};
            pg8::gemm_phase<EpiStore<0>, SchedPlain, PG8_ALIGN, PG8_SP2>(c.lds, g, S, E);
#ifdef REP_GEMM
            pg8::gemm_phase<EpiStore<0>, SchedPlain, PG8_ALIGN, PG8_SP2>(c.lds, g, S, E);
#endif
            SEAM(pb + PH_INPROJ); }
        if (IN(pb + PH_PREP)) { PHASE_BEGIN prep_rwkv(c, args, layer); __syncthreads(); prep_cmp(TASK_CTX(), args, layer); prep_rope(TASK_CTX(), args); prep_vT(TASK_CTX(), args); __syncthreads(); SEAM(pb + PH_PREP); }
        if (IN(pb + PH_SCAN1)) { PHASE_BEGIN rw_pass1(c, args); ret_kv(TASK_CTX(), args); __syncthreads(); nsa_attn2(TASK_CTX(), args); __syncthreads();
 SEAM(pb + PH_SCAN1); }
        if (IN(pb + PH_SCAN2)) { PHASE_BEGIN rw_pass2(c, args); ret_prefix(TASK_CTX(), args); __syncthreads(); SEAM(pb + PH_SCAN2); }
        if (IN(pb + PH_SCAN3)) { PHASE_BEGIN rw_pass3(c, args, layer); __syncthreads(); ret_out(TASK_CTX(), args); __syncthreads(); SEAM(pb + PH_SCAN3); }
        if (IN(pb + PH_GATES)) { PHASE_BEGIN
            Gemm g{D, D, D}; SchedPlain S; S.to.init(T / 256, NG / 256); S.G = c.G; S.c = c.bx; S.tid = c.tid; S.A = (const char*)(ws + WS_XB); S.B = (const char*)(ws + WS_WG); S.ta = (size_t)256 * D * 2; S.tb = (size_t)256 * D * 2;
            EpiStore<1> E{(bf16*)(ws + WS_GATES), NG};
            pg8::gemm_phase<EpiStore<1>, SchedPlain, PG8_ALIGN, PG8_SP2>(c.lds, g, S, E);
#ifdef REP_GEMM
            pg8::gemm_phase<EpiStore<1>, SchedPlain, PG8_ALIGN, PG8_SP2>(c.lds, g, S, E);
#endif
            SEAM(pb + PH_GATES); }
        if (IN(pb + PH_BRANCH)) { PHASE_BEGIN
            Gemm g{RWW, RWW, RWW}; SchedBranch S; S.to.init(T / 256, D / 256); S.G = c.G; S.c = c.bx; S.tid = c.tid;
            S.A0 = (const char*)(ws + WS_YRW); S.sa = WS_YNSA - WS_YRW; static_assert(WS_YRET - WS_YNSA == WS_YNSA - WS_YRW, "y buffers equally spaced");
            S.B0 = (const char*)(ws + WS_WBR); S.sb = (size_t)D * RWW * 2; S.ta = (size_t)256 * RWW * 2; S.tb = (size_t)256 * RWW * 2;
            EpiBranch E{(bf16*)(ws + WS_MERGED), (const bf16*)(ws + WS_GATES)};
            pg8::gemm_phase<EpiBranch, SchedBranch, PG8_ALIGN, PG8_SP2>(c.lds, g, S, E);
#ifdef REP_GEMM
            pg8::gemm_phase<EpiBranch, SchedBranch, PG8_ALIGN, PG8_SP2>(c.lds, g, S, E);
#endif
            SEAM(pb + PH_BRANCH); }
        if (IN(pb + PH_OUT)) { PHASE_BEGIN
            Gemm g{D, D, D}; SchedPlain S; S.to.init(T / 256, D / 256); S.G = c.G; S.c = c.bx; S.tid = c.tid; S.A = (const char*)(ws + WS_MERGED); S.B = (const char*)(ws + WS_WOUT); S.ta = (size_t)256 * D * 2; S.tb = (size_t)256 * D * 2;
            EpiResid E{args.out};
            pg8::gemm_phase<EpiResid, SchedPlain, PG8_ALIGN, PG8_SP2>(c.lds, g, S, E);
            SEAM(pb + PH_OUT); }
        if (IN(pb + PH_LN1)) { PHASE_BEGIN ph_ln1_route(c, args, layer); __syncthreads(); ph_conv_moe(TASK_CTX(), args, layer); __syncthreads(); SEAM(pb + PH_LN1); }
        if (IN(pb + PH_SLOT)) { PHASE_BEGIN ph_slot(c, args, layer); __syncthreads(); SEAM(pb + PH_SLOT); }
        if (IN(pb + PH_MOE_GU)) { PHASE_BEGIN
            const int* texp = (const int*)(ws + WS_TEXP) + layer * 512;
            Gemm g{D, D, D}; SchedMoe S; S.nM = texp[255]; S.nN = 4; S.G = c.G; S.c = c.bx; S.tid = c.tid; S.A = (const char*)(ws + WS_XS); S.B = (const char*)(ws + WS_WGU); S.ta = (size_t)256 * D * 2; S.tb = (size_t)256 * D * 2; S.te = (size_t)1024 * D * 2; S.texp = texp;
            EpiGateUp E{(bf16*)(ws + WS_H)};
            pg8::gemm_phase<EpiGateUp, SchedMoe, PG8_ALIGN, PG8_SP2>(c.lds, g, S, E);
#ifdef REP_GEMM
            pg8::gemm_phase<EpiGateUp, SchedMoe, PG8_ALIGN, PG8_SP2>(c.lds, g, S, E);
#endif
            SEAM(pb + PH_MOE_GU); }
        if (IN(pb + PH_MOE_DN)) { PHASE_BEGIN
            const int* texp = (const int*)(ws + WS_TEXP) + layer * 512;
            Gemm g{FF, FF, FF}; SchedMoe S; S.nM = texp[255]; S.nN = 8; S.G = c.G; S.c = c.bx; S.tid = c.tid; S.A = (const char*)(ws + WS_H); S.B = (const char*)(ws + WS_WDN); S.ta = (size_t)256 * FF * 2; S.tb = (size_t)256 * FF * 2; S.te = (size_t)D * FF * 2; S.texp = texp;
            EpiStore<0> E{(bf16*)(ws + WS_YS), D};
            pg8::gemm_phase<EpiStore<0>, SchedMoe, PG8_ALIGN, PG8_SP2>(c.lds, g, S, E);
#ifdef REP_GEMM
            pg8::gemm_phase<EpiStore<0>, SchedMoe, PG8_ALIGN, PG8_SP2>(c.lds, g, S, E);
#endif
            SEAM(pb + PH_MOE_DN); }
        if (IN(pb + PH_LN2)) { PHASE_BEGIN ph_ln2(c, args, layer); __syncthreads(); SEAM(pb + PH_LN2); }
    }
#undef IN
#undef SEAM
}

#ifndef TRUNC_PH
#define TRUNC_PH NPH
#endif
#ifndef DUMP_MODE
#define DUMP_MODE 0
#endif
#if DUMP_MODE
__global__ void dump_k(float* out, const unsigned char* ws) {
    for (size_t i = (size_t)blockIdx.x * blockDim.x + threadIdx.x; i < (size_t)T * D; i += (size_t)gridDim.x * blockDim.x) {
        const int t = (int)(i / D), c = (int)(i % D); float v = 0.f;
#if DUMP_MODE == 1
        v = bf2f(((const bf16*)(ws + WS_PROJ))[(size_t)t * LDP + c * 5]);
#elif DUMP_MODE == 2
        if (c < 1024) v = bf2f(((const bf16*)(ws + WS_YRW))[(size_t)t * 1024 + c]); else v = bf2f(((const bf16*)(ws + WS_YNSA))[(size_t)t * 1024 + c - 1024]);
#elif DUMP_MODE == 3
        if (c < 1024) v = bf2f(((const bf16*)(ws + WS_YRET))[(size_t)t * 1024 + c]); else v = bf2f(((const bf16*)(ws + WS_MERGED))[(size_t)t * D + c]);
#elif DUMP_MODE == 4
        if (c < 1024) v = bf2f(((const bf16*)(ws + WS_YRET))[(size_t)t * 1024 + c]);
#elif DUMP_MODE == 5
        v = bf2f(((const bf16*)(ws + WS_GATES))[(size_t)t * NG + c * 3]);
#endif
        out[i] = (v == v && fabsf(v) < 1e30f) ? v : 0.f; }
}
#endif
extern "C" void kernel_launch(void* const* d_in, const int* in_sizes, int n_in, void* d_out, int out_size, void* d_ws, size_t ws_size, hipStream_t stream) {
    static int grid = 0;
    if (grid == 0) {
        if (n_in != 36 || out_size != T * D || ws_size < WS_END) { fprintf(stderr, "kernel_launch: unexpected shapes (n_in %d out %d ws %zu)\n", n_in, out_size, ws_size); grid = -1; return; }
        int dev = 0, cus = 0, per_cu = 0;
        if (hipGetDevice(&dev) != hipSuccess || hipDeviceGetAttribute(&cus, hipDeviceAttributeMultiprocessorCount, dev) != hipSuccess) { grid = -1; return; }
        if (hipFuncSetAttribute((const void*)fwd, hipFuncAttributeMaxDynamicSharedMemorySize, LDS_BYTES) != hipSuccess) { fprintf(stderr, "kernel_launch: hipFuncSetAttribute failed\n"); grid = -1; return; }
        if (hipOccupancyMaxActiveBlocksPerMultiprocessor(&per_cu, (const void*)fwd, 512, LDS_BYTES) != hipSuccess || per_cu < 1) fprintf(stderr, "kernel_launch: occupancy query says %d\n", per_cu);
        (void)hipGetLastError();
        grid = cus;
    }
    if (grid < 0) return;
    if (hipMemsetAsync((char*)d_ws + WS_CTL, 0, CTL_ZERO_BYTES, stream) != hipSuccess) return;
    Args a{};
    for (int i = 0; i < 36; ++i) a.in[i] = (const float*)d_in[i];
    a.out = (float*)d_out; a.ws = (unsigned char*)d_ws;
#if MK_ONE_LAUNCH
    a.ph_lo = 0; a.ph_hi = NPH;
    hipLaunchKernelGGL(fwd, dim3(grid), dim3(512), LDS_BYTES, stream, a);
#else
    for (int p = 0; p < TRUNC_PH; ++p) { a.ph_lo = p; a.ph_hi = p + 1; hipLaunchKernelGGL(fwd, dim3(grid), dim3(512), LDS_BYTES, stream, a); }
#if DUMP_MODE
    dump_k<<<2048, 256, 0, stream>>>((float*)d_out, (const unsigned char*)d_ws);
#endif
#endif
}
```

```cpp
#define MK_ONE_LAUNCH 1
#include <hip/hip_runtime.h>
#include <cstdio>
#include <cstdint>

#ifndef MK_ONE_LAUNCH
#define MK_ONE_LAUNCH 0
#endif

namespace pg8 {
#define PG8_LAS __attribute__((address_space(3)))
typedef unsigned short bf16_t;
typedef short bf16x8 __attribute__((ext_vector_type(8)));
typedef float f32x4 __attribute__((ext_vector_type(4)));
typedef unsigned u32x4 __attribute__((ext_vector_type(4)));
constexpr int BM = 256, BK = 64, HALF = 128, HTB = HALF * BK * 2  , STAGE_BYTES = 8 * HTB, NXCD = 8, WGM = 8;

__host__ __device__ __forceinline__ int lds_byte(int r, int c) { const int st = (r >> 4) * 2 + (c >> 5), rr = r & 15, cc = c & 31, ob = rr * 64 + cc * 2; return st * 1024 + (ob ^ (((ob >> 9) & 1) << 5)); }
__host__ __device__ __forceinline__ void stage_rc(int b, int& R, int& C) { const int st = b / 1024, sb = b % 1024, swz = sb ^ (((sb >> 9) & 1) << 5); R = (st >> 1) * 16 + swz / 64; C = (st & 1) * 32 + (swz % 64) / 2; }
__host__ __device__ __forceinline__ int perm32(int rho) { const int n = rho >> 4, i = rho & 15; return 8 * (i >> 2) + 4 * n + (i & 3); }

struct Unit { int pm, pn, aux; const char* a; const char* b; };
struct Gemm { int K, lda, ldb; };

struct TileOrder {
    int nM, nN, nwg;
    __device__ void init(int nM_, int nN_) { nM = nM_; nN = nN_; nwg = nM * nN; }
    __device__ bool tile(long L, int& pm, int& pn) const {
        if (L >= nwg) return false;
        int wgid = (int)L; { const int q = nwg / NXCD, r = nwg % NXCD, xcd = wgid % NXCD, off = wgid / NXCD; wgid = (xcd < r ? xcd * (q + 1) : r * (q + 1) + (xcd - r) * q) + off; }
        const int nig = WGM * nN, gid = wgid / nig, fm = gid * WGM, gsz = (nM - fm) < WGM ? (nM - fm) : WGM;
        pm = fm + ((wgid % nig) % gsz); pn = (wgid % nig) / gsz; return true;
    }
};

typedef float f32x2_t __attribute__((ext_vector_type(2))); typedef __bf16 bf16x2_t __attribute__((ext_vector_type(2)));
__device__ __forceinline__ unsigned cvt_pk_bf16(float lo, float hi) { f32x2_t v = {lo, hi}; bf16x2_t b = __builtin_convertvector(v, bf16x2_t); return __builtin_bit_cast(unsigned, b); }

template <class Epi, class Sched, bool ALIGN_EPI = false, bool SP2 = false>
__device__ __forceinline__ void gemm_phase(PG8_LAS unsigned char* lds, const Gemm g, const Sched& S, const Epi& E) {
    const int tid = S.tid, wid = __builtin_amdgcn_readfirstlane(tid >> 6), lane = tid & 63, wr = wid >> 2, wc = wid & 3, fr = lane & 15, fq = lane >> 4;
    const int K = g.K, nt = K / BK;
    unsigned voffA[2], voffB[2];
#pragma unroll
    for (int i = 0; i < 2; ++i) { int R, C; stage_rc(tid * 16 + i * 8192, R, C); const int Rb = Epi::PERM ? ((R & ~31) + perm32(R & 31)) : R;
        voffA[i] = (unsigned)(R * g.lda + C) * 2u; voffB[i] = (unsigned)(Rb * g.ldb + C) * 2u; }
    const size_t kstep = (size_t)(BK * 2);
    const size_t hstepA = (size_t)HALF * g.lda * 2, hstepB = (size_t)HALF * g.ldb * 2;
    const unsigned ldsw = (unsigned)wid * 1024u;
    const int aoff = lds_byte(wr * 64 + fr, fq * 8), boff = lds_byte(wc * 32 + fr, fq * 8);
#define PG8_SA(b, h) (((b) * 2 + (h)) * HTB)
#define PG8_SB(b, h) ((4 + (b) * 2 + (h)) * HTB)
#define PG8_STAGE(bufoff, gbase, voff) do { _Pragma("unroll") for (int _i = 0; _i < 2; ++_i) \
        __builtin_amdgcn_global_load_lds((const unsigned*)((const char*)(gbase) + (voff)[_i]), (PG8_LAS unsigned*)(lds + (bufoff) + ldsw + _i * 8192), 16, 0, 0); } while (0)
#define PG8_LDA(dst, b, h) do { _Pragma("unroll") for (int m = 0; m < 4; ++m) _Pragma("unroll") for (int k = 0; k < 2; ++k) dst[m][k] = *(const PG8_LAS bf16x8*)(lds + PG8_SA(b, h) + aoff + m * 2048 + k * 1024); } while (0)
#define PG8_LDB(dst, b, h) do { _Pragma("unroll") for (int n = 0; n < 2; ++n) _Pragma("unroll") for (int k = 0; k < 2; ++k) dst[n][k] = *(const PG8_LAS bf16x8*)(lds + PG8_SB(b, h) + boff + n * 2048 + k * 1024); } while (0)
#define PG8_MMA(ai, bj, At, Bt) do { __builtin_amdgcn_s_setprio(1); _Pragma("unroll") for (int m = 0; m < 4; ++m) _Pragma("unroll") for (int n = 0; n < 2; ++n) _Pragma("unroll") for (int k = 0; k < 2; ++k) \
        acc[ai][bj][m][n] = __builtin_amdgcn_mfma_f32_16x16x32_bf16(Bt[n][k], At[m][k], acc[ai][bj][m][n], 0, 0, 0); __builtin_amdgcn_s_setprio(0); } while (0)
#define PG8_WAIT_V(n) asm volatile("s_waitcnt vmcnt(" #n ")" ::: "memory")
#define PG8_WAIT_L(n) asm volatile("s_waitcnt lgkmcnt(" #n ")" ::: "memory")
#define PG8_BAR __builtin_amdgcn_s_barrier()
#define PG8_SCHED __builtin_amdgcn_sched_barrier(0)
    Unit cur, nxt; int ui = 0;
    if (!S.next(0, cur)) return;
    f32x4 acc[2][2][4][2];
#pragma unroll
    for (int a = 0; a < 2; ++a)
#pragma unroll
        for (int b = 0; b < 2; ++b)
#pragma unroll
            for (int m = 0; m < 4; ++m)
#pragma unroll
                for (int n = 0; n < 2; ++n) acc[a][b][m][n] = (f32x4){0.f, 0.f, 0.f, 0.f};
    bf16x8 At[4][2], B0[2][2], B1[2][2];
    const char* cA = cur.a; const char* cB = cur.b;
    if constexpr (SP2) {
        PG8_STAGE(PG8_SB(0, 0), cB, voffB); PG8_STAGE(PG8_SB(0, 1), cB + hstepB, voffB); PG8_STAGE(PG8_SA(0, 0), cA, voffA); PG8_STAGE(PG8_SA(0, 1), cA + hstepA, voffA);
        if (wr == 1) PG8_BAR;
        PG8_WAIT_V(2); PG8_BAR;
        PG8_STAGE(PG8_SB(1, 0), cB + kstep, voffB); PG8_STAGE(PG8_SA(1, 0), cA + kstep, voffA); PG8_STAGE(PG8_SB(1, 1), cB + hstepB + kstep, voffB);
        PG8_WAIT_V(6); PG8_BAR;
    } else {
        PG8_STAGE(PG8_SB(0, 0), cB, voffB); PG8_STAGE(PG8_SA(0, 0), cA, voffA); PG8_STAGE(PG8_SB(0, 1), cB + hstepB, voffB); PG8_STAGE(PG8_SA(0, 1), cA + hstepA, voffA);
        if (wr == 1) PG8_BAR;
        PG8_WAIT_V(4); PG8_BAR;
        PG8_STAGE(PG8_SB(1, 0), cB + kstep, voffB); PG8_STAGE(PG8_SA(1, 0), cA + kstep, voffA); PG8_STAGE(PG8_SB(1, 1), cB + hstepB + kstep, voffB);
        PG8_WAIT_V(6); PG8_BAR;
    }
    for (;;) {
        const bool has_next = S.next(ui + 1, nxt);
        const char* nA = has_next ? nxt.a : cA; const char* nB = has_next ? nxt.b : cB;
        for (int t = 0; t < nt; t += 2) {
            const bool last = (t == nt - 2);
            const char* a1 = cA + (size_t)(t + 1) * kstep;
            const char* a2 = last ? nA : cA + (size_t)(t + 2) * kstep; const char* b2 = last ? nB : cB + (size_t)(t + 2) * kstep;
            const char* a3 = a2 + kstep; const char* b3 = b2 + kstep;
            if constexpr (SP2) {
            PG8_LDB(B0, 0, 0); PG8_LDB(B1, 0, 1); PG8_SCHED; PG8_LDA(At, 0, 0); PG8_STAGE(PG8_SA(1, 1), a1 + hstepA, voffA);
            PG8_WAIT_V(8); PG8_WAIT_L(0); PG8_BAR; PG8_MMA(0, 0, At, B0); PG8_MMA(0, 1, At, B1); PG8_BAR; PG8_SCHED;
            PG8_LDA(At, 0, 1); PG8_STAGE(PG8_SB(0, 0), b2, voffB); PG8_STAGE(PG8_SB(0, 1), b2 + hstepB, voffB); PG8_STAGE(PG8_SA(0, 0), a2, voffA);
            PG8_WAIT_V(8); PG8_WAIT_L(0); PG8_BAR; PG8_MMA(1, 0, At, B0); PG8_MMA(1, 1, At, B1); PG8_BAR; PG8_SCHED;
            PG8_LDB(B0, 1, 0); PG8_LDB(B1, 1, 1); PG8_SCHED; PG8_LDA(At, 1, 0); PG8_STAGE(PG8_SA(0, 1), a2 + hstepA, voffA);
            PG8_WAIT_V(8); PG8_WAIT_L(0); PG8_BAR; PG8_MMA(0, 0, At, B0); PG8_MMA(0, 1, At, B1); PG8_BAR; PG8_SCHED;
            PG8_LDA(At, 1, 1); PG8_STAGE(PG8_SB(1, 0), b3, voffB); PG8_STAGE(PG8_SB(1, 1), b3 + hstepB, voffB); PG8_STAGE(PG8_SA(1, 0), a3, voffA);
            PG8_WAIT_V(8); PG8_WAIT_L(0); PG8_BAR; PG8_MMA(1, 0, At, B0); PG8_MMA(1, 1, At, B1); PG8_BAR; PG8_SCHED;
            } else {
            PG8_LDB(B0, 0, 0); PG8_SCHED; PG8_LDA(At, 0, 0); PG8_STAGE(PG8_SA(1, 1), a1 + hstepA, voffA);
            PG8_WAIT_L(8); PG8_BAR; PG8_WAIT_L(0); PG8_MMA(0, 0, At, B0); PG8_BAR; PG8_SCHED;
            PG8_LDB(B1, 0, 1); PG8_STAGE(PG8_SB(0, 0), b2, voffB);
            PG8_BAR; PG8_WAIT_L(0); PG8_MMA(0, 1, At, B1); PG8_BAR;
            PG8_LDA(At, 0, 1); PG8_STAGE(PG8_SA(0, 0), a2, voffA);
            PG8_BAR; PG8_WAIT_L(0); PG8_MMA(1, 0, At, B0); PG8_BAR; PG8_SCHED;
            PG8_STAGE(PG8_SB(0, 1), b2 + hstepB, voffB);
            PG8_WAIT_V(6); PG8_BAR; PG8_MMA(1, 1, At, B1); PG8_BAR;
            PG8_LDB(B0, 1, 0); PG8_SCHED; PG8_LDA(At, 1, 0); PG8_STAGE(PG8_SA(0, 1), a2 + hstepA, voffA);
            PG8_WAIT_L(8); PG8_BAR; PG8_WAIT_L(0); PG8_MMA(0, 0, At, B0); PG8_BAR; PG8_SCHED;
            PG8_LDB(B1, 1, 1); PG8_STAGE(PG8_SB(1, 0), b3, voffB);
            PG8_BAR; PG8_WAIT_L(0); PG8_MMA(0, 1, At, B1); PG8_BAR;
            PG8_LDA(At, 1, 1); PG8_STAGE(PG8_SA(1, 0), a3, voffA);
            PG8_BAR; PG8_WAIT_L(0); PG8_MMA(1, 0, At, B0); PG8_BAR; PG8_SCHED;
            PG8_STAGE(PG8_SB(1, 1), b3 + hstepB, voffB);
            PG8_WAIT_V(6); PG8_BAR; PG8_MMA(1, 1, At, B1); PG8_BAR;
            }
        }
        if constexpr (ALIGN_EPI) { if (wr == 0) PG8_BAR; }
        E(acc, cur, wr, wc, fr, fq);
        if (!has_next) break;
#pragma unroll
        for (int a = 0; a < 2; ++a)
#pragma unroll
            for (int b = 0; b < 2; ++b)
#pragma unroll
                for (int m = 0; m < 4; ++m)
#pragma unroll
                    for (int n = 0; n < 2; ++n) acc[a][b][m][n] = (f32x4){0.f, 0.f, 0.f, 0.f};
        cur = nxt; cA = nA; cB = nB; ++ui;
        if constexpr (ALIGN_EPI) { if (wr == 1) PG8_BAR; }
    }
    PG8_WAIT_V(0);
    if constexpr (!ALIGN_EPI) { if (wr == 0) PG8_BAR; }
    PG8_BAR;
    #undef PG8_SA
#undef PG8_SB
#undef PG8_STAGE
#undef PG8_LDA
#undef PG8_LDB
#undef PG8_MMA
#undef PG8_WAIT_V
#undef PG8_WAIT_L
#undef PG8_BAR
#undef PG8_SCHED
}
}

#ifndef PG8_SP2
#define PG8_SP2 true
#endif
#ifndef PG8_ALIGN
#define PG8_ALIGN true
#endif

constexpr int T = 16384, D = 2048, DEPTH = 2;
constexpr int RWW = 1024;
constexpr int NCMP = 1023, NSELB = 256;
constexpr int NEXP = 32, FF = 512;
constexpr int LDP = 10496;
constexpr int NG = 6144;
constexpr int PC_RW_R = 0, PC_RW_K = 1024, PC_RW_V = 2048, PC_NQ = 3072, PC_KC = 4096, PC_VC = 4352, PC_KS = 4608, PC_VS = 4864, PC_KW = 5120, PC_VW = 5376,
              PC_RQ = 5632, PC_RK = 6656, PC_RV = 7680, PC_RG = 8704, PC_XW = 9728, PC_XA = 9824, PC_XG = 9920, PC_XV = 10176, PC_GATE = 10240;
constexpr float DN_ALPHA = 1.41421356237f, LN_EPS = 1e-5f;

constexpr size_t MiB = 1u << 20;
constexpr size_t WS_CTL = 0, CTL_ZERO_BYTES = 1 * MiB;
constexpr size_t WS_TEXP = 1 * MiB, WS_TOKE = WS_TEXP + 65536, WS_TOKW = WS_TOKE + 131072, WS_SLOT = WS_TOKW + 131072;
constexpr size_t WS_KCMPB = 2 * MiB, WS_VCMPT = 3 * MiB, WS_RKB = 4 * MiB, WS_COS = 8 * MiB, WS_SIN = 12 * MiB;
constexpr size_t WS_WIN = 16 * MiB, WS_WG = 57 * MiB, WS_WBR = 81 * MiB, WS_WOUT = 93 * MiB;
constexpr size_t WS_XB = 112 * MiB, WS_VF = 176 * MiB, WS_PROJ = 208 * MiB;
constexpr size_t WS_RW_R = 536 * MiB, WS_RW_K = 568 * MiB, WS_RW_V = 600 * MiB, WS_RW_KK = 632 * MiB, WS_RW_B = 664 * MiB, WS_RW_W = 696 * MiB, WS_RW_G = 760 * MiB;
constexpr size_t WS_YRW = 800 * MiB, WS_YNSA = 832 * MiB, WS_YRET = 864 * MiB;
constexpr size_t WS_RWP = 896 * MiB, WS_RWU = 912 * MiB, WS_RWS = 928 * MiB, WS_RETKV = 944 * MiB, WS_KFS = 1008 * MiB, WS_VFS = 1016 * MiB, WS_KFW = 1024 * MiB, WS_VFW = 1032 * MiB, WS_END = 1040 * MiB;
constexpr size_t WS_GATES = 536 * MiB, WS_MERGED = 728 * MiB;
constexpr size_t WS_WGU = 208 * MiB, WS_WDN = 336 * MiB, WS_XS = 400 * MiB, WS_H = 560 * MiB, WS_YS = 600 * MiB;
static_assert(WS_PROJ + (size_t)T * LDP * 2 <= WS_RW_R && WS_GATES + (size_t)T * NG * 2 <= WS_MERGED && WS_MERGED + (size_t)T * D * 2 <= WS_YRW, "ws map");
static_assert(WS_XS + (size_t)160 * 256 * D * 2 <= WS_H && WS_H + (size_t)160 * 256 * FF * 2 <= WS_YS && WS_YS + (size_t)160 * 256 * D * 2 <= WS_RW_G, "ws map moe");
constexpr int CW_TMO = 0, CW_CNT = 1024, CW_CUR = 1088, CW_BAR = 4096;
constexpr int LDS_BYTES = 147456, LDS_BARW = LDS_BYTES - 64;

#define GAS __attribute__((address_space(1)))
#define LAS __attribute__((address_space(3)))
typedef unsigned short bf16;
typedef float f32x4 __attribute__((ext_vector_type(4)));
typedef unsigned u32x4 __attribute__((ext_vector_type(4)));
#define LDS_WAIT() asm volatile("s_waitcnt lgkmcnt(0)" ::: "memory")
#define VM_WAIT() asm volatile("s_waitcnt vmcnt(0)" ::: "memory")

__device__ __forceinline__ float bf2f(unsigned short b) { return __uint_as_float(((unsigned)b) << 16); }
__device__ __forceinline__ unsigned f2bf(float f) { unsigned u = __float_as_uint(f); return (u + 0x7fffu + ((u >> 16) & 1u)) >> 16; }
__device__ __forceinline__ unsigned pk2(float lo, float hi) { return f2bf(lo) | (f2bf(hi) << 16); }
__device__ __forceinline__ float bflo(unsigned w) { return __uint_as_float(w << 16); }
__device__ __forceinline__ float bfhi(unsigned w) { return __uint_as_float(w & 0xffff0000u); }
__device__ __forceinline__ float wave_sum(float v) {
#pragma unroll
    for (int o = 1; o < 64; o <<= 1) v += __shfl_xor(v, o);
    return v;
}
__device__ __forceinline__ float wave_max(float v) {
#pragma unroll
    for (int o = 1; o < 64; o <<= 1) v = fmaxf(v, __shfl_xor(v, o));
    return v;
}
__device__ __forceinline__ int wave_min_i(int v) {
#pragma unroll
    for (int o = 1; o < 64; o <<= 1) { const int w = __shfl_xor(v, o); v = w < v ? w : v; }
    return v;
}
__device__ __forceinline__ float sigm(float x) { return 1.f / (1.f + expf(-x)); }
__device__ __forceinline__ float sigm_fast(float x) { return __builtin_amdgcn_rcpf(1.f + __builtin_amdgcn_exp2f(-1.4426950408889634f * x)); }

__device__ const double INV_FREQ[64] = {1.00000000000000000e+00, 8.63988449483968579e-01, 7.46476040841712152e-01, 6.44946677103762411e-01, 5.57226479550717357e-01, 4.81437242078434580e-01, 4.15956216307184767e-01, 3.59381366380462752e-01, 3.10501349512486036e-01, 2.68269579527972590e-01, 2.31781818060089240e-01, 2.00256813604311801e-01, 1.73019573884589412e-01, 1.49486913370923374e-01, 1.29154966501488389e-01, 1.11588399250774864e-01, 9.64110880490750138e-02, 8.32980664765826800e-02, 7.19685673001152076e-02, 6.21800108732091794e-02, 5.37228111832403141e-02, 4.64158883361278016e-02, 4.01027913949520837e-02, 3.46483485573036779e-02, 2.99357729472049007e-02, 2.58641620527596990e-02, 2.23463372691659473e-02, 1.93069772888325060e-02, 1.66810053720005923e-02, 1.44121959671885402e-02, 1.24519708473503302e-02, 1.07583589854217902e-02, 9.29509789880649494e-03, 8.03085722139152032e-03, 6.93856787873718770e-03, 5.99484250318940964e-03, 5.17947467923121282e-03, 4.47500629725045354e-03, 3.86635375219241198e-03, 3.34048498351324471e-03, 2.88614044143008968e-03, 2.49359200498416086e-03, 2.15443469003188427e-03, 1.86140668735512152e-03, 1.60823387766704205e-03, 1.38949549437313892e-03, 1.20050805774840792e-03, 1.03722509540705695e-03, 8.96150501946605012e-04, 7.74263682681127744e-04, 6.68954878691414585e-04, 5.77969288415331340e-04, 4.99358789347314927e-04, 4.31440226144378508e-04, 3.72759372031494166e-04, 3.22059791872108224e-04, 2.78255940220712632e-04, 2.40409918350997456e-04, 2.07711392596645640e-04, 1.79460244029731636e-04, 1.55051577983262559e-04, 1.33962772451801717e-04, 1.15742288059205792e-04, 1.00000000000000005e-04};
__device__ const float RET_LOGG[8] = {-0.0317486983145803f, -0.015748356968139168f, -0.007843177461025893f, -0.003913899321136329f, -0.0019550348358033506f, -0.0009770396478266127f, -0.0004884004981088745f, -0.0002441704321739145f};

#define XB_TMO      128
#define XB_XCNT(j)  (256  + 64 * (j))
#define XB_XSUB(j)  (1280 + 64 * (j))
#define XB_XGEN(j)  (2304 + 64 * (j))
#define XB_TOP      3328
#define XB_TOPGEN   3392
#define XCD_BAR_WORDS 3456
#define XB_SPIN_CAP (1u << 18)

__device__ __forceinline__ unsigned xb_ld(unsigned* p)              { return __hip_atomic_load(p, __ATOMIC_RELAXED, __HIP_MEMORY_SCOPE_AGENT); }
__device__ __forceinline__ unsigned xb_add(unsigned* p, unsigned v) { return __hip_atomic_fetch_add(p, v, __ATOMIC_RELAXED, __HIP_MEMORY_SCOPE_AGENT); }
__device__ __forceinline__ unsigned xb_xcc_id() { return (unsigned)__builtin_amdgcn_s_getreg((3 << 11) | 20) & 0xFu; }
#define XB_SPIN(cond, bar) do { unsigned _sp = 0; while (cond) { __builtin_amdgcn_s_sleep(1); \
    if ((++_sp & 255u) == 0u) { if (xb_ld(&(bar)[XB_TMO])) break; if (_sp > XB_SPIN_CAP) { atomicAdd(&(bar)[XB_TMO], 1u); break; } } } } while (0)

struct XcdBarrier {
    unsigned* bar; unsigned x;
    volatile LAS unsigned* st;
};
__device__ __forceinline__ XcdBarrier xcd_barrier_post(unsigned* bar, volatile LAS unsigned* st) {
    XcdBarrier b; b.bar = bar; b.x = xb_xcc_id(); b.st = st;
    if (threadIdx.x == 0) (void)xb_add(&bar[XB_XCNT(b.x)], 1u);
    return b;
}
__device__ __forceinline__ void xcd_barrier_complete(unsigned* bar, unsigned x, unsigned& nloc, unsigned& nx) {
    const unsigned G = gridDim.x * gridDim.y * gridDim.z;
    unsigned sum, cnt, mine, sp = 0u;
    for (;;) {
        sum = 0u; cnt = 0u; mine = 0u;
#pragma unroll
        for (unsigned j = 0; j < 16; ++j) { const unsigned c = xb_ld(&bar[XB_XCNT(j)]); sum += c; cnt += (c > 0u) ? 1u : 0u; mine = (j == x) ? c : mine; }
        if (sum == G) break;
        __builtin_amdgcn_s_sleep(1);
        if ((++sp & 255u) == 0u) { if (xb_ld(&bar[XB_TMO])) break; if (sp > XB_SPIN_CAP) { atomicAdd(&bar[XB_TMO], 1u); break; } }
    }
    nloc = mine > 0u ? mine : 1u; nx = cnt > 0u ? cnt : 1u;
}
__device__ __forceinline__ void xcd_barrier(const XcdBarrier& b) {
    asm volatile("s_waitcnt vmcnt(0)" ::: "memory");
    __syncthreads();
    if (threadIdx.x == 0) {
        unsigned* bar = b.bar;
        __builtin_amdgcn_s_waitcnt(0);
        unsigned nloc = b.st[0], nx = b.st[1];
        if (nloc == 0u) { xcd_barrier_complete(bar, b.x, nloc, nx); b.st[0] = nloc; b.st[1] = nx; }
        const unsigned old = xb_add(&bar[XB_XSUB(b.x)], 1u);
        const unsigned gen = old / nloc;
        if (old + 1u == (gen + 1u) * nloc) {
            __builtin_amdgcn_fence(__ATOMIC_RELEASE, "agent");
            asm volatile("s_waitcnt vmcnt(0)" ::: "memory");
            const unsigned og = xb_add(&bar[XB_TOP], 1u);
            const unsigned tg = og / nx;
            if (og + 1u == (tg + 1u) * nx) xb_add(&bar[XB_TOPGEN], 1u);
            else XB_SPIN(xb_ld(&bar[XB_TOPGEN]) == tg, bar);
            __builtin_amdgcn_fence(__ATOMIC_ACQUIRE, "agent");
            xb_add(&bar[XB_XGEN(b.x)], 1u);
            asm volatile("s_waitcnt vmcnt(0)" ::: "memory");
        } else {
            XB_SPIN(xb_ld(&bar[XB_XGEN(b.x)]) == gen, bar);
            __builtin_amdgcn_fence(__ATOMIC_ACQUIRE, "agent");
            asm volatile("s_waitcnt vmcnt(0)" ::: "memory");
        }
    }
    __syncthreads();
}

struct Args { const float* in[36]; float* out; unsigned char* ws; int ph_lo, ph_hi; };
constexpr int LDS_PTAB = LDS_BYTES - 512;
struct PA { unsigned char* ws; float* out; const LAS unsigned* tab;
    __device__ __forceinline__ const float* in(int i) const { const unsigned lo = __builtin_amdgcn_readfirstlane(tab[2 * i]), hi = __builtin_amdgcn_readfirstlane(tab[2 * i + 1]);
        return (const float*)(((unsigned long long)hi << 32) | lo); } };

using pg8::Unit; using pg8::Gemm; using pg8::TileOrder;
struct SchedPlain {
    TileOrder to; int G, c, tid; const char* A; const char* B; size_t ta, tb;
    __device__ __forceinline__ bool next(int i, Unit& u) const {
        if (!to.tile((long)i * G + c, u.pm, u.pn)) return false;
        u.a = A + (size_t)u.pm * ta; u.b = B + (size_t)u.pn * tb; u.aux = 0; return true; }
};
struct SchedBranch {
    TileOrder to; int G, c, tid; const char* A0; const char* B0; size_t sa, sb, ta, tb;
    __device__ __forceinline__ bool next(int i, Unit& u) const {
        const int br = i % 3;
        if (!to.tile((long)(i / 3) * G + c, u.pm, u.pn)) return false;
        u.a = A0 + (size_t)br * sa + (size_t)u.pm * ta; u.b = B0 + (size_t)br * sb + (size_t)u.pn * tb; u.aux = br; return true; }
};
struct SchedMoe {
    int nM, nN, G, c, tid; const char* A; const char* B; size_t ta, tb, te; const int* texp;
    __device__ __forceinline__ bool next(int i, Unit& u) const {
        const long L = (long)i * G + c; if (L >= (long)nM * nN) return false;
        u.pm = (int)(L % nM); u.pn = (int)(L / nM); const int e = texp[u.pm];
        u.a = A + (size_t)u.pm * ta; u.b = B + (size_t)e * te + (size_t)u.pn * tb; u.aux = e; return true; }
};
template <int ACT  > struct EpiStore {
    static constexpr bool PERM = true;
    bf16* O; int ldc;
    __device__ __forceinline__ void operator()(const f32x4 (&acc)[2][2][4][2], const Unit& u, int wr, int wc, int fr, int fq) const {
        const int row0 = u.pm * 256 + wr * 64 + fr, col0 = u.pn * 256 + wc * 32 + 8 * fq;
#pragma unroll
        for (int ai = 0; ai < 2; ++ai)
#pragma unroll
            for (int m = 0; m < 4; ++m) { bf16* rowp = O + (size_t)(row0 + ai * 128 + m * 16) * ldc + col0;
#pragma unroll
                for (int bj = 0; bj < 2; ++bj) { f32x4 v0 = acc[ai][bj][m][0], v1 = acc[ai][bj][m][1];
                    if (ACT == 1) {
#pragma unroll
                        for (int j = 0; j < 4; ++j) { v0[j] = sigm_fast(v0[j]); v1[j] = sigm_fast(v1[j]); } }
                    u32x4 w; w.x = pg8::cvt_pk_bf16(v0[0], v0[1]); w.y = pg8::cvt_pk_bf16(v0[2], v0[3]); w.z = pg8::cvt_pk_bf16(v1[0], v1[1]); w.w = pg8::cvt_pk_bf16(v1[2], v1[3]);
                    *(u32x4*)(rowp + bj * 128) = w; __builtin_amdgcn_sched_barrier(0); } }
    }
};
struct EpiBranch {
    static constexpr bool PERM = true;
    bf16* Mg; const bf16* Gt;
    __device__ __forceinline__ void operator()(const f32x4 (&acc)[2][2][4][2], const Unit& u, int wr, int wc, int fr, int fq) const {
        const int row0 = u.pm * 256 + wr * 64 + fr, col0 = u.pn * 256 + wc * 32 + 8 * fq, br = u.aux;
#pragma unroll
        for (int ai = 0; ai < 2; ++ai)
#pragma unroll
            for (int m = 0; m < 4; ++m) { const size_t r = (size_t)(row0 + ai * 128 + m * 16);
#pragma unroll
                for (int bj = 0; bj < 2; ++bj) { const int col = col0 + bj * 128;
                    const u32x4 gw = *(const u32x4*)(Gt + r * NG + br * 2048 + col);
                    f32x4 v0 = acc[ai][bj][m][0], v1 = acc[ai][bj][m][1];
                    v0[0] *= bflo(gw.x); v0[1] *= bfhi(gw.x); v0[2] *= bflo(gw.y); v0[3] *= bfhi(gw.y); v1[0] *= bflo(gw.z); v1[1] *= bfhi(gw.z); v1[2] *= bflo(gw.w); v1[3] *= bfhi(gw.w);
                    bf16* mp = Mg + r * D + col;
                    if (br != 0) { const u32x4 ow = *(const u32x4*)mp;
                        v0[0] += bflo(ow.x); v0[1] += bfhi(ow.x); v0[2] += bflo(ow.y); v0[3] += bfhi(ow.y); v1[0] += bflo(ow.z); v1[1] += bfhi(ow.z); v1[2] += bflo(ow.w); v1[3] += bfhi(ow.w); }
                    u32x4 w; w.x = pg8::cvt_pk_bf16(v0[0], v0[1]); w.y = pg8::cvt_pk_bf16(v0[2], v0[3]); w.z = pg8::cvt_pk_bf16(v1[0], v1[1]); w.w = pg8::cvt_pk_bf16(v1[2], v1[3]);
                    *(u32x4*)mp = w; __builtin_amdgcn_sched_barrier(0); } }
    }
};
struct EpiResid {
    static constexpr bool PERM = true;
    float* X;
    __device__ __forceinline__ void operator()(const f32x4 (&acc)[2][2][4][2], const Unit& u, int wr, int wc, int fr, int fq) const {
        const int row0 = u.pm * 256 + wr * 64 + fr, col0 = u.pn * 256 + wc * 32 + 8 * fq;
#pragma unroll
        for (int ai = 0; ai < 2; ++ai)
#pragma unroll
            for (int m = 0; m < 4; ++m) { float* rowp = X + (size_t)(row0 + ai * 128 + m * 16) * D + col0;
#pragma unroll
                for (int bj = 0; bj < 2; ++bj) { f32x4* p = (f32x4*)(rowp + bj * 128);
                    const f32x4 x0 = p[0], x1 = p[1];
                    p[0] = x0 * DN_ALPHA + acc[ai][bj][m][0]; p[1] = x1 * DN_ALPHA + acc[ai][bj][m][1]; __builtin_amdgcn_sched_barrier(0); } }
    }
};
struct EpiGateUp {
    static constexpr bool PERM = true;
    bf16* H;
    __device__ __forceinline__ void operator()(const f32x4 (&acc)[2][2][4][2], const Unit& u, int wr, int wc, int fr, int fq) const {
        const int row0 = u.pm * 256 + wr * 64 + fr, col0 = u.pn * 128 + wc * 32 + 8 * fq;
#pragma unroll
        for (int ai = 0; ai < 2; ++ai)
#pragma unroll
            for (int m = 0; m < 4; ++m) { bf16* rowp = H + (size_t)(row0 + ai * 128 + m * 16) * FF + col0;
                f32x4 h0, h1;
#pragma unroll
                for (int j = 0; j < 4; ++j) { const float g0 = acc[ai][0][m][0][j], g1 = acc[ai][0][m][1][j];
                    h0[j] = g0 * sigm_fast(g0) * acc[ai][1][m][0][j]; h1[j] = g1 * sigm_fast(g1) * acc[ai][1][m][1][j]; }
                u32x4 w; w.x = pg8::cvt_pk_bf16(h0[0], h0[1]); w.y = pg8::cvt_pk_bf16(h0[2], h0[3]); w.z = pg8::cvt_pk_bf16(h1[0], h1[1]); w.w = pg8::cvt_pk_bf16(h1[2], h1[3]);
                *(u32x4*)rowp = w; }
    }
};

struct Ctx { LAS unsigned char* lds; int tid, lane, wave, G, bx, gw, NGW; };

template <class SRC>
__device__ __forceinline__ void transpose_task(const Ctx& c, const SRC& src, int ldsrc, int K, bf16* dst, int ndst) {
    LAS float* scr = (LAS float*)(c.lds + c.wave * 8704);
    const int nblk = ndst / 32, items = (K / 64) * nblk, lane = c.lane;
    for (int it = c.gw; it < items; it += c.NGW) {
        const int kb = it / nblk, nb = it % nblk, k0 = 64 * kb, n0 = 32 * nb;
        const float* sp = src(n0 + (lane & 31));
#pragma unroll 8
        for (int i = 0; i < 32; ++i) { const int kk = 2 * i + (lane >> 5); scr[kk * 33 + (lane & 31)] = sp ? sp[(size_t)(k0 + kk) * ldsrc] : 0.f; }
        LDS_WAIT();
        const int cc = lane & 7;
#pragma unroll
        for (int j = 0; j < 4; ++j) { const int n = (lane >> 3) + 8 * j; const LAS float* s = scr + (8 * cc) * 33 + n;
            u32x4 o; o.x = pk2(s[0 * 33], s[1 * 33]); o.y = pk2(s[2 * 33], s[3 * 33]); o.z = pk2(s[4 * 33], s[5 * 33]); o.w = pk2(s[6 * 33], s[7 * 33]);
            *(u32x4*)(dst + (size_t)(n0 + n) * K + k0 + 8 * cc) = o; }
        LDS_WAIT();
    }
}
struct SrcWin { const float* W; int layer;
    __device__ __forceinline__ const float* operator()(int n) const {
        const int rw = layer ? 3584 : 3520; int sc;
        if (n < 3072) sc = n; else if (n < 5632) sc = rw + (n - 3072); else if (n < 9728) sc = rw + 2608 + (n - 5632); else if (n < 10176) sc = 3072 + (n - 9728);
        else if (n < 10240) sc = layer ? 3520 + (n - 10176) : -1; else if (n < 10288) sc = rw + 2560 + (n - 10240); else sc = -1;
        return sc >= 0 ? W + sc : nullptr; } };
struct SrcOff { const float* W; __device__ __forceinline__ const float* operator()(int n) const { return W + n; } };
struct SrcGU { const float* Wg; const float* Wu;
    __device__ __forceinline__ const float* operator()(int nn) const { const int e = nn >> 10, r1 = nn & 1023, pn = r1 >> 8, rr = r1 & 255;
        const size_t du = (size_t)((const char*)Wu - (const char*)Wg);
        return (const float*)((const char*)Wg + (rr < 128 ? (size_t)0 : du)) + (size_t)e * D * FF + 128 * pn + (rr & 127); } };
struct SrcDN { const float* Wd;
    __device__ __forceinline__ const float* operator()(int nn) const { const int e = nn >> 11, n = nn & 2047; return Wd + (size_t)e * FF * D + n; } };

__device__ __forceinline__ void ph_conv(const Ctx& c, const PA& a, int layer) {
    unsigned char* ws = a.ws;
    const float* Win = layer ? a.in(2) : a.in(1); const int ldw = layer ? 16432 : 16368, rw = layer ? 3584 : 3520;
    transpose_task(c, SrcWin{Win, layer}, ldw, D, (bf16*)(ws + WS_WIN), LDP);
    transpose_task(c, SrcOff{Win + rw + 2608 + 4096}, ldw, D, (bf16*)(ws + WS_WG), NG);
    transpose_task(c, SrcOff{a.in(21) + (size_t)layer * RWW * D}, D, RWW, (bf16*)(ws + WS_WBR), D);
    transpose_task(c, SrcOff{a.in(22) + (size_t)layer * RWW * D}, D, RWW, (bf16*)(ws + WS_WBR) + (size_t)D * RWW, D);
    transpose_task(c, SrcOff{a.in(23) + (size_t)layer * RWW * D}, D, RWW, (bf16*)(ws + WS_WBR) + (size_t)2 * D * RWW, D);
    transpose_task(c, SrcOff{a.in(24) + (size_t)layer * D * D}, D, D, (bf16*)(ws + WS_WOUT), D);
    if (layer == 0) {
        const f32x4* x4 = (const f32x4*)a.in(0); f32x4* o4 = (f32x4*)a.out; uint2* xb = (uint2*)(ws + WS_XB);
        for (size_t i = (size_t)c.bx * 512 + c.tid; i < (size_t)T * D / 4; i += (size_t)c.G * 512) { const f32x4 v = x4[i]; o4[i] = v; xb[i] = make_uint2(pk2(v[0], v[1]), pk2(v[2], v[3])); }
        float* cs = (float*)(ws + WS_COS); float* sn = (float*)(ws + WS_SIN);
        for (int i = c.bx * 512 + c.tid; i < T * 64; i += c.G * 512) { const int t = i >> 6, j = i & 63;
            const double rev = (double)t * INV_FREQ[j] * 0.15915494309189533577; const float fr = (float)(rev - __builtin_rint(rev));
            cs[i] = __builtin_amdgcn_cosf(fr); sn[i] = __builtin_amdgcn_sinf(fr); }
    }
}
__device__ __forceinline__ void ph_conv_moe(const Ctx& c, const PA& a, int layer) {
    unsigned char* ws = a.ws; const size_t lo = (size_t)layer * NEXP * D * FF;
    transpose_task(c, SrcGU{a.in(31) + lo, a.in(32) + lo}, FF, D, (bf16*)(ws + WS_WGU), NEXP * 1024);
    transpose_task(c, SrcDN{a.in(33) + lo}, D, FF, (bf16*)(ws + WS_WDN), NEXP * D);
}

__device__ __forceinline__ float softplusf_(float x) { return fmaxf(x, 0.f) + log1pf(expf(-fabsf(x))); }
__device__ __forceinline__ void prep_rwkv(const Ctx& c, const PA& a, int layer) {
    unsigned char* ws = a.ws; const bf16* proj = (const bf16*)(ws + WS_PROJ);
    LAS float* sh_r = (LAS float*)c.lds; LAS float* sh_k = sh_r + 8 * 1024; LAS float* sh_v = sh_k + 8 * 1024; LAS float* sh_x = sh_v + 8 * 1024;
    bf16* oR = (bf16*)(ws + WS_RW_R); bf16* oK = (bf16*)(ws + WS_RW_K); bf16* oV = (bf16*)(ws + WS_RW_V); bf16* oKK = (bf16*)(ws + WS_RW_KK); bf16* oB = (bf16*)(ws + WS_RW_B);
    float* oW = (float*)(ws + WS_RW_W); bf16* oG = (bf16*)(ws + WS_RW_G); bf16* VF = (bf16*)(ws + WS_VF); float* rkb = (float*)(ws + WS_RKB);
    const int lane = c.lane, w = c.wave, tid = c.tid;
    for (int it = c.bx; it < T / 8; it += c.G) {
        const int t = it * 8 + w;
        const bf16* prow = proj + (size_t)t * LDP; const bf16* pprev = prow - LDP;
        const float* mu = a.in(layer ? 4 : 3);
#pragma unroll
        for (int i = 0; i < 6; ++i) { const int c8 = (lane + 64 * i) * 8;
            const u32x4 p = *(const u32x4*)(prow + c8); u32x4 q = (u32x4){0u, 0u, 0u, 0u}; if (t > 0) q = *(const u32x4*)(pprev + c8);
            const f32x4 m0 = *(const f32x4*)(mu + c8), m1 = *(const f32x4*)(mu + c8 + 4);
            float pv[8] = {bflo(p.x), bfhi(p.x), bflo(p.y), bfhi(p.y), bflo(p.z), bfhi(p.z), bflo(p.w), bfhi(p.w)};
            float qv[8] = {bflo(q.x), bfhi(q.x), bflo(q.y), bfhi(q.y), bflo(q.z), bfhi(q.z), bflo(q.w), bfhi(q.w)};
            LAS float* dstp = (c8 < 1024 ? sh_r + w * 1024 + c8 : (c8 < 2048 ? sh_k + w * 1024 + (c8 - 1024) : sh_v + w * 1024 + (c8 - 2048)));
#pragma unroll
            for (int j = 0; j < 8; ++j) { const float mm = j < 4 ? m0[j] : m1[j - 4]; dstp[j] = pv[j] + (qv[j] - pv[j]) * mm; } }
        { const int i8 = lane * 8; int sc, mi, fn;
            if (i8 < 96) { sc = PC_XW + i8; mi = 3072 + i8; fn = 1; } else if (i8 < 192) { sc = PC_XA + (i8 - 96); mi = 3168 + (i8 - 96); fn = 0; }
            else if (i8 < 448) { sc = PC_XG + (i8 - 192); mi = 3264 + (i8 - 192); fn = 2; } else { sc = PC_XV + (i8 - 448); mi = 3520 + (i8 - 448); fn = layer ? 0 : 3; }
            const u32x4 p = *(const u32x4*)(prow + sc); u32x4 q = (u32x4){0u, 0u, 0u, 0u}; if (t > 0) q = *(const u32x4*)(pprev + sc);
            float pv[8] = {bflo(p.x), bfhi(p.x), bflo(p.y), bfhi(p.y), bflo(p.z), bfhi(p.z), bflo(p.w), bfhi(p.w)};
            float qv[8] = {bflo(q.x), bfhi(q.x), bflo(q.y), bfhi(q.y), bflo(q.z), bfhi(q.z), bflo(q.w), bfhi(q.w)};
#pragma unroll
            for (int j = 0; j < 8; ++j) { float s = 0.f;
                if (fn != 3) { const float mm = mu[mi + j]; s = pv[j] + (qv[j] - pv[j]) * mm; if (fn == 1) s = tanhf(s); else if (fn == 2) s = sigm(s); }
                sh_x[w * 512 + i8 + j] = s; } }
        __syncthreads();
        float sw[8][2], sa[8][2], sg[8][2], sv[8][2];
#pragma unroll
        for (int k = 0; k < 8; ++k) { sw[k][0] = sw[k][1] = sa[k][0] = sa[k][1] = sg[k][0] = sg[k][1] = sv[k][0] = sv[k][1] = 0.f; }
        { const float* w_up = a.in(6) + (size_t)layer * 96 * 1024; const float* a_up = a.in(8) + (size_t)layer * 96 * 1024;
        for (int k = 0; k < 96; ++k) { const float u0 = w_up[k * 1024 + tid], u1 = w_up[k * 1024 + tid + 512], b0 = a_up[k * 1024 + tid], b1 = a_up[k * 1024 + tid + 512];
#pragma unroll
            for (int tk = 0; tk < 8; ++tk) { const float x = sh_x[tk * 512 + k], y = sh_x[tk * 512 + 96 + k]; sw[tk][0] += x * u0; sw[tk][1] += x * u1; sa[tk][0] += y * b0; sa[tk][1] += y * b1; } } }
        { const float* g_up = a.in(11) + (size_t)layer * 256 * 1024;
        for (int k = 0; k < 256; ++k) { const float u0 = g_up[k * 1024 + tid], u1 = g_up[k * 1024 + tid + 512];
#pragma unroll
            for (int tk = 0; tk < 8; ++tk) { const float x = sh_x[tk * 512 + 192 + k]; sg[tk][0] += x * u0; sg[tk][1] += x * u1; } } }
        if (layer) { const float* v_up = a.in(10);
        for (int k = 0; k < 64; ++k) { const float u0 = v_up[k * 1024 + tid], u1 = v_up[k * 1024 + tid + 512];
#pragma unroll
            for (int tk = 0; tk < 8; ++tk) { const float x = sh_x[tk * 512 + 448 + k]; sv[tk][0] += x * u0; sv[tk][1] += x * u1; } } }
#pragma unroll
        for (int ci = 0; ci < 2; ++ci) { const int col = tid + 512 * ci, head = w + 8 * ci;
            const float kkc = a.in(12)[layer * 1024 + col], kac = a.in(13)[layer * 1024 + col], rkc = a.in(14)[layer * 1024 + col], w0c = a.in(5)[layer * 1024 + col], a0c = a.in(7)[layer * 1024 + col], v0c = layer ? a.in(9)[col] : 0.f;
#pragma unroll
            for (int tk = 0; tk < 8; ++tk) { const int tt = it * 8 + tk; const size_t o = (size_t)tt * 1024 + col;
                const float k0 = sh_k[tk * 1024 + col], r = sh_r[tk * 1024 + col], v0 = sh_v[tk * 1024 + col];
                const float kkraw = k0 * kkc, n2 = wave_sum(kkraw * kkraw), kkn = kkraw / fmaxf(sqrtf(n2), 1e-12f);
                const float aa = sigm(a0c + sa[tk][ci]), bb = kkn * aa, kf = k0 * (1.f + (aa - 1.f) * kac);
                const float z = w0c + sw[tk][ci], wl = -softplusf_(-z) - 0.5f, dec = expf(-expf(wl));
                float vv = v0;
                if (layer) { const float vf = bf2f(VF[o]); vv = v0 + (vf - v0) * sigm(v0c + sv[tk][ci]); } else VF[o] = (bf16)f2bf(v0);
                const float rk = wave_sum(r * kf * rkc);
                if (lane == 0) rkb[tt * 16 + head] = rk;
                oR[o] = (bf16)f2bf(r); oK[o] = (bf16)f2bf(kf); oV[o] = (bf16)f2bf(vv); oKK[o] = (bf16)f2bf(kkn); oB[o] = (bf16)f2bf(bb); oW[o] = dec; oG[o] = (bf16)f2bf(sg[tk][ci]); } }
        __syncthreads();
    }
}
__device__ __forceinline__ float gelu_tanh(float x) { return 0.5f * x * (1.f + tanhf(0.7978845608028654f * (x + 0.044715f * x * x * x))); }
__device__ __forceinline__ void prep_cmp(const Ctx& c, const PA& a, int layer) {
    unsigned char* ws = a.ws; const bf16* proj = (const bf16*)(ws + WS_PROJ);
    LAS float* sh_in = (LAS float*)c.lds; LAS float* sh_h = sh_in + 4 * 2048;
    const int tid = c.tid;
    for (int it = c.bx; it < NCMP * 2; it += c.G) {
        const int cb = it >> 1, kv = it & 1, col0 = kv ? PC_VC : PC_KC, lk = layer * 2 + kv;
        const float* pe = a.in(17) + (size_t)lk * 2048; const float* w1 = a.in(18) + (size_t)lk * 2048 * 128; const float* b1 = a.in(19) + lk * 128; const float* w2 = a.in(20) + (size_t)lk * 128 * 64;
        for (int idx = tid; idx < 8192; idx += 512) { const int g = idx >> 11, r = idx & 2047, l = r >> 6, d = r & 63;
            sh_in[idx] = bf2f(proj[(size_t)(16 * cb + l) * LDP + col0 + g * 64 + d]) + pe[r]; }
        __syncthreads();
        { const int g = tid >> 7, j = tid & 127; float acc = b1[j]; const LAS float* in = sh_in + g * 2048;
#pragma unroll 8
            for (int i = 0; i < 2048; ++i) acc += in[i] * w1[i * 128 + j];
            sh_h[tid] = gelu_tanh(acc); }
        __syncthreads();
        if (tid < 256) { const int g = tid >> 6, d = tid & 63; float o = 0.f;
#pragma unroll 8
            for (int j = 0; j < 128; ++j) o += sh_h[g * 128 + j] * w2[j * 64 + d];
            { const int blk = cb >> 6, kc = cb & 63;
                if (kv == 0) { const int j = kc >> 4, rr = kc & 15, ks = d >> 5, qq = (d & 31) >> 3, i = d & 7;
                    ((bf16*)(ws + WS_KCMPB))[((((size_t)g * 16 + blk) * 8 + 2 * j + ks) * 64 + qq * 16 + rr) * 8 + i] = (bf16)f2bf(o);
                    if (cb == 0) ((bf16*)(ws + WS_KCMPB))[((((size_t)g * 16 + 15) * 8 + 2 * 3 + ks) * 64 + qq * 16 + 15) * 8 + i] = 0; }
                else { const int ks = kc >> 5, kk = kc & 31, hh = kk >> 4, qq = (kk & 15) >> 2, i = (kk & 3) + 4 * hh, mt = d >> 4, rr = d & 15;
                    ((bf16*)(ws + WS_VCMPT))[((((size_t)g * 16 + blk) * 8 + 2 * mt + ks) * 64 + qq * 16 + rr) * 8 + i] = (bf16)f2bf(o);
                    if (cb == 0) ((bf16*)(ws + WS_VCMPT))[((((size_t)g * 16 + 15) * 8 + 2 * mt + 1) * 64 + 3 * 16 + rr) * 8 + 7] = 0; } } }
        __syncthreads();
    }
}
__device__ __forceinline__ void prep_rope(const Ctx& c, const PA& a) {
    unsigned char* ws = a.ws; bf16* proj = (bf16*)(ws + WS_PROJ); const float* cs = (const float*)(ws + WS_COS); const float* sn = (const float*)(ws + WS_SIN);
    for (int i = c.bx * 512 + c.tid; i < T * 8 * 64; i += c.G * 512) { const int j = i & 63, h = (i >> 6) & 7, t = i >> 9;
        const float co = cs[t * 64 + j], si = sn[t * 64 + j];
        bf16* q = proj + (size_t)t * LDP + PC_RQ + h * 128 + j; bf16* k = proj + (size_t)t * LDP + PC_RK + h * 128 + j;
        const float q1 = bf2f(q[0]), q2 = bf2f(q[64]), k1 = bf2f(k[0]), k2 = bf2f(k[64]);
        q[0] = (bf16)f2bf(q1 * co - q2 * si); q[64] = (bf16)f2bf(q1 * si + q2 * co);
        k[0] = (bf16)f2bf((k1 * co - k2 * si) * 0.08838834764831845f); k[64] = (bf16)f2bf((k1 * si + k2 * co) * 0.08838834764831845f); }
}

constexpr int RW_NC = 64, RW_CL = 256, RW_TS = 8;
__device__ __forceinline__ void rw_stage(const unsigned char* ws, LAS float* tile, int t0, int h, int lane, bool need_r) {
    const unsigned e0 = (unsigned)(t0 * 1024 + h * 64 + lane);
#pragma unroll
    for (int s = 0; s < RW_TS; ++s) { const unsigned e = e0 + (unsigned)s * 1024u; LAS float* tp = tile + s * 384 + lane;
        tp[0] = bf2f(*(const bf16*)(ws + ((unsigned)WS_RW_KK + e * 2u))); tp[64] = bf2f(*(const bf16*)(ws + ((unsigned)WS_RW_B + e * 2u))); tp[128] = *(const float*)(ws + ((unsigned)WS_RW_W + e * 4u));
        tp[192] = bf2f(*(const bf16*)(ws + ((unsigned)WS_RW_K + e * 2u))); tp[256] = need_r ? bf2f(*(const bf16*)(ws + ((unsigned)WS_RW_R + e * 2u))) : 0.f; tp[320] = bf2f(*(const bf16*)(ws + ((unsigned)WS_RW_V + e * 2u))); }
}
#define RW_STEP_UPDATE(tp, vi) { \
    float s0 = 0.f, s1 = 0.f, s2 = 0.f, s3 = 0.f; \
    _Pragma("unroll") for (int jj = 0; jj < 16; ++jj) { const f32x4 k4 = *(const LAS f32x4*)((tp) + 4 * jj); s0 += S[4 * jj] * k4[0]; s1 += S[4 * jj + 1] * k4[1]; s2 += S[4 * jj + 2] * k4[2]; s3 += S[4 * jj + 3] * k4[3]; } \
    const float sk = (s0 + s1) + (s2 + s3); \
    _Pragma("unroll") for (int jj = 0; jj < 16; ++jj) { const f32x4 b4 = *(const LAS f32x4*)((tp) + 64 + 4 * jj), w4 = *(const LAS f32x4*)((tp) + 128 + 4 * jj), k4 = *(const LAS f32x4*)((tp) + 192 + 4 * jj); \
        _Pragma("unroll") for (int q = 0; q < 4; ++q) S[4 * jj + q] = S[4 * jj + q] * w4[q] + ((vi) * k4[q] - sk * b4[q]); } }

__device__ __forceinline__ void rw_pass1(const Ctx& c, const PA& a) {
    const unsigned char* ws = a.ws; LAS float* tile = (LAS float*)(c.lds + c.wave * (RW_TS * 384 * 4));
    const int lane = c.lane;
    for (int task = c.gw; task < 16 * RW_NC * 2; task += c.NGW) {
        const int kind = task & 1, hc = task >> 1, h = hc / RW_NC, ch = hc % RW_NC;
        float S[64]; int lz = kind ? 64 : lane; asm volatile("" : "+v"(lz));
#pragma unroll
        for (int j = 0; j < 64; ++j) S[j] = (j == lz) ? 1.f : 0.f;
        for (int t0 = ch * RW_CL; t0 < (ch + 1) * RW_CL; t0 += RW_TS) {
            rw_stage(ws, tile, t0, h, lane, false);
            LDS_WAIT();
#pragma unroll 1
            for (int s = 0; s < RW_TS; ++s) { const LAS float* tp = tile + s * 384; const float vi = kind ? tp[320 + lane] : 0.f; RW_STEP_UPDATE(tp, vi); }
            LDS_WAIT();
        }
        float* out = (float*)(a.ws + (kind ? WS_RWU : WS_RWP)) + ((size_t)hc * 64 + lane) * 64;
#pragma unroll
        for (int jj = 0; jj < 16; ++jj) *(f32x4*)(out + 4 * jj) = (f32x4){S[4 * jj], S[4 * jj + 1], S[4 * jj + 2], S[4 * jj + 3]};
    }
}
__device__ __forceinline__ void rw_pass2(const Ctx& c, const PA& a) {
    const float* P = (const float*)(a.ws + WS_RWP); const float* U = (const float*)(a.ws + WS_RWU); float* Si = (float*)(a.ws + WS_RWS);
    const int lane = c.lane;
    for (int task = c.gw; task < 16 * 64; task += c.NGW) { const int h = task >> 6, i = task & 63;
        float s = 0.f;
        for (int ch = 0; ch < RW_NC; ++ch) { const size_t hc = (size_t)h * RW_NC + ch;
            Si[(hc * 64 + i) * 64 + lane] = s;
            float acc = U[(hc * 64 + i) * 64 + lane]; const float* Pc = P + hc * 4096 + lane;
#pragma unroll
            for (int i2 = 0; i2 < 64; ++i2) acc += __shfl(s, i2) * Pc[i2 * 64];
            s = acc; }
    }
}
__device__ __forceinline__ void rw_pass3(const Ctx& c, const PA& a, int layer) {
    const unsigned char* ws = a.ws; LAS float* tile = (LAS float*)(c.lds + c.wave * (RW_TS * 384 * 4));
    const float* Si = (const float*)(ws + WS_RWS); const float* rkb = (const float*)(ws + WS_RKB); const bf16* G = (const bf16*)(ws + WS_RW_G); bf16* Y = (bf16*)(a.ws + WS_YRW);
    const float* lng = a.in(15) + layer * 1024; const float* lnb = a.in(16) + layer * 1024;
    const int lane = c.lane;
    for (int task = c.gw; task < 16 * RW_NC; task += c.NGW) {
        const int h = task / RW_NC, ch = task % RW_NC, col = h * 64 + lane;
        const float lg = lng[col], lb = lnb[col];
        float S[64]; const float* sp = Si + ((size_t)task * 64 + lane) * 64;
#pragma unroll
        for (int jj = 0; jj < 16; ++jj) { const f32x4 v = *(const f32x4*)(sp + 4 * jj); S[4 * jj] = v[0]; S[4 * jj + 1] = v[1]; S[4 * jj + 2] = v[2]; S[4 * jj + 3] = v[3]; }
        for (int t0 = ch * RW_CL; t0 < (ch + 1) * RW_CL; t0 += RW_TS) {
            rw_stage(ws, tile, t0, h, lane, true);
            LDS_WAIT();
#pragma unroll 1
            for (int s = 0; s < RW_TS; ++s) { const LAS float* tp = tile + s * 384; const float vi = tp[320 + lane]; RW_STEP_UPDATE(tp, vi);
                float y0 = 0.f, y1 = 0.f, y2 = 0.f, y3 = 0.f;
#pragma unroll
                for (int jj = 0; jj < 16; ++jj) { const f32x4 r4 = *(const LAS f32x4*)(tp + 256 + 4 * jj); y0 += S[4 * jj] * r4[0]; y1 += S[4 * jj + 1] * r4[1]; y2 += S[4 * jj + 2] * r4[2]; y3 += S[4 * jj + 3] * r4[3]; }
                const float y = (y0 + y1) + (y2 + y3), mean = wave_sum(y) * (1.f / 64.f), dlt = y - mean, var = wave_sum(dlt * dlt) * (1.f / 64.f);
                const float yn = dlt * (1.f / sqrtf(var + 64e-5f)); const int t = t0 + s; const size_t o = (size_t)t * 1024 + col;
                Y[o] = (bf16)f2bf((yn * lg + lb + rkb[t * 16 + h] * vi) * bf2f(G[o])); }
            LDS_WAIT();
        }
    }
}

__device__ __forceinline__ void ret_kv(const Ctx& c, const PA& a) {
    const bf16* proj = (const bf16*)(a.ws + WS_PROJ); float* KV = (float*)(a.ws + WS_RETKV);
    const int dv = c.tid & 127, dkg = c.tid >> 7;
    for (int it = c.bx; it < 128 * 8; it += c.G) { const int ch = it >> 3, h = it & 7; const float lg = RET_LOGG[h];
        float acc[32];
#pragma unroll
        for (int q = 0; q < 32; ++q) acc[q] = 0.f;
        for (int i = 0; i < 128; ++i) { const bf16* row = proj + (size_t)(ch * 128 + i) * LDP;
            const float vv = bf2f(row[PC_RV + h * 128 + dv]) * expf(lg * (float)(127 - i));
            const u32x4* kp = (const u32x4*)(row + PC_RK + h * 128 + 32 * dkg);
#pragma unroll
            for (int q4 = 0; q4 < 4; ++q4) { const u32x4 kw = kp[q4];
                acc[8 * q4 + 0] += bflo(kw.x) * vv; acc[8 * q4 + 1] += bfhi(kw.x) * vv; acc[8 * q4 + 2] += bflo(kw.y) * vv; acc[8 * q4 + 3] += bfhi(kw.y) * vv;
                acc[8 * q4 + 4] += bflo(kw.z) * vv; acc[8 * q4 + 5] += bfhi(kw.z) * vv; acc[8 * q4 + 6] += bflo(kw.w) * vv; acc[8 * q4 + 7] += bfhi(kw.w) * vv; } }
        float* o = KV + ((size_t)it * 128 + 32 * dkg) * 128 + dv;
#pragma unroll
        for (int q = 0; q < 32; ++q) o[q * 128] = acc[q];
    }
}
__device__ __forceinline__ void ret_prefix(const Ctx& c, const PA& a) {
    float* KV = (float*)(a.ws + WS_RETKV);
    for (int i = c.bx * 512 + c.tid; i < 8 * 16384; i += c.G * 512) { const int h = i >> 14, e = i & 16383; const float cd = expf(RET_LOGG[h] * 128.f);
        float r = 0.f;
        for (int ch = 0; ch < 128; ++ch) { float* p = KV + ((size_t)(ch * 8 + h) << 14) + e; const float tmp = *p; *p = r; r = r * cd + tmp; } }
}
__device__ __forceinline__ void ret_out(const Ctx& c, const PA& a) {
    const bf16* proj = (const bf16*)(a.ws + WS_PROJ); const float* KV = (const float*)(a.ws + WS_RETKV); bf16* Y = (bf16*)(a.ws + WS_YRET);
    constexpr int RS = 130;
    LAS bf16* sq = (LAS bf16*)c.lds; LAS bf16* sk = sq + 128 * RS; LAS bf16* sv = sk + 128 * RS; LAS float* att = (LAS float*)(sv + 128 * RS);
    const int tid = c.tid, lane = c.lane, w = c.wave;
    for (int it = c.bx; it < 128 * 8; it += c.G) { const int ch = it >> 3, h = it & 7; const float lg = RET_LOGG[h];
        for (int idx = tid; idx < 128 * 64; idx += 512) { const int i = idx >> 6, d2 = (idx & 63) * 2; const bf16* row = proj + (size_t)(ch * 128 + i) * LDP + h * 128 + d2;
            *(LAS unsigned*)(sq + i * RS + d2) = *(const unsigned*)(row + PC_RQ); *(LAS unsigned*)(sk + i * RS + d2) = *(const unsigned*)(row + PC_RK); *(LAS unsigned*)(sv + i * RS + d2) = *(const unsigned*)(row + PC_RV); }
        __syncthreads();
        for (int half = 0; half < 2; ++half) {
            { const int s = tid & 127, ig = tid >> 7;
                float ac[16];
#pragma unroll
                for (int r = 0; r < 16; ++r) ac[r] = 0.f;
                for (int d2 = 0; d2 < 128; d2 += 2) { const unsigned kw = *(const LAS unsigned*)(sk + s * RS + d2); const float k0 = bflo(kw), k1 = bfhi(kw);
#pragma unroll
                    for (int r = 0; r < 16; ++r) { const unsigned qw = *(const LAS unsigned*)(sq + (64 * half + 16 * ig + r) * RS + d2); ac[r] += bflo(qw) * k0 + bfhi(qw) * k1; } }
#pragma unroll
                for (int r = 0; r < 16; ++r) { const int i = 64 * half + 16 * ig + r; att[(16 * ig + r) * 128 + s] = (i >= s) ? ac[r] * expf(lg * (float)(i - s)) : 0.f; } }
            __syncthreads();
            float o[16];
            { const int dv = tid & 127, ig = tid >> 7;
#pragma unroll
                for (int r = 0; r < 16; ++r) o[r] = 0.f;
                for (int dk = 0; dk < 128; ++dk) { const float rv = KV[((size_t)it * 128 + dk) * 128 + dv];
#pragma unroll
                    for (int r = 0; r < 16; ++r) o[r] += bf2f(sq[(64 * half + 16 * ig + r) * RS + dk]) * rv; }
#pragma unroll
                for (int r = 0; r < 16; ++r) o[r] *= expf(lg * (float)(64 * half + 16 * ig + r + 1));
                for (int s = 0; s < 128; ++s) { const float vv = bf2f(sv[s * RS + dv]);
#pragma unroll
                    for (int r = 0; r < 16; ++r) o[r] += att[(16 * ig + r) * 128 + s] * vv; } }
            __syncthreads();
            { const int dv = tid & 127, ig = tid >> 7;
#pragma unroll
                for (int r = 0; r < 16; ++r) att[(16 * ig + r) * 128 + dv] = o[r]; }
            __syncthreads();
            for (int rr = 0; rr < 8; ++rr) { const int ip = w * 8 + rr, t = ch * 128 + 64 * half + ip;
                const float x0 = att[ip * 128 + lane], x1 = att[ip * 128 + 64 + lane];
                const float mean = wave_sum(x0 + x1) * (1.f / 128.f), d0 = x0 - mean, d1 = x1 - mean, var = wave_sum(d0 * d0 + d1 * d1) * (1.f / 128.f), rs = 1.f / sqrtf(var + 1e-5f);
                const bf16* grow = proj + (size_t)t * LDP + PC_RG + h * 128; const float g0 = bf2f(grow[lane]), g1 = bf2f(grow[64 + lane]);
                Y[(size_t)t * 1024 + h * 128 + lane] = (bf16)f2bf(g0 * sigm(g0) * d0 * rs); Y[(size_t)t * 1024 + h * 128 + 64 + lane] = (bf16)f2bf(g1 * sigm(g1) * d1 * rs); }
            __syncthreads();
        }
    }
}


typedef short bf16x8 __attribute__((ext_vector_type(8)));
typedef short bf16x4 __attribute__((ext_vector_type(4)));
constexpr float NSA_C = 0.125f * 1.4426950408889634f;
struct NsaSrc { const bf16* kf; const bf16* vf; };

__device__ __forceinline__ void nsa_loadK(const NsaSrc& src, int key0, bf16x8 (&kf)[4][2], int lane) {
    const bf16* kp = src.kf + (size_t)(key0 >> 6) * 4096 + lane * 8;
#pragma unroll
    for (int j = 0; j < 4; ++j) { kf[j][0] = *(const bf16x8*)(kp + (2 * j) * 512); kf[j][1] = *(const bf16x8*)(kp + (2 * j + 1) * 512); }
}
__device__ __forceinline__ void nsa_loadV(const NsaSrc& src, int key0, bf16x8 (&vf)[4][2], int lane) {
    const bf16* vp = src.vf + (size_t)(key0 >> 6) * 4096 + lane * 8;
#pragma unroll
    for (int mt = 0; mt < 4; ++mt) { vf[mt][0] = *(const bf16x8*)(vp + (2 * mt) * 512); vf[mt][1] = *(const bf16x8*)(vp + (2 * mt + 1) * 512); }
}
__device__ __forceinline__ void nsa_qk(const bf16x8 (&kf)[4][2], const bf16x8 (&qf)[2], f32x4 (&st)[4]) {
#pragma unroll
    for (int j = 0; j < 4; ++j) { st[j] = (f32x4){0.f, 0.f, 0.f, 0.f};
        st[j] = __builtin_amdgcn_mfma_f32_16x16x32_bf16(kf[j][0], qf[0], st[j], 0, 0, 0); st[j] = __builtin_amdgcn_mfma_f32_16x16x32_bf16(kf[j][1], qf[1], st[j], 0, 0, 0); }
}
template <int MODE>
__device__ __forceinline__ void nsa_rest(f32x4 (&st)[4], const bf16x8 (&vf)[4][2], int key0, int lo, int hi, f32x4 (&O)[4], float& m, float& l, float inv, int r, int q, LAS float* impA, LAS float* impB) {
    float mx = -1.0e30f;
#pragma unroll
    for (int j = 0; j < 4; ++j)
#pragma unroll
        for (int i = 0; i < 4; ++i) { const int key = key0 + 16 * j + 4 * q + i; const bool ok = key >= lo && key <= hi; st[j][i] = ok ? st[j][i] : -1.0e30f; mx = fmaxf(mx, st[j][i]); }
    float mn = m;
    if (MODE != 2) { mx = fmaxf(mx, __shfl_xor(mx, 16)); mx = fmaxf(mx, __shfl_xor(mx, 32)); mn = fmaxf(m, mx); }
    float ps = 0.f;
#pragma unroll
    for (int j = 0; j < 4; ++j)
#pragma unroll
        for (int i = 0; i < 4; ++i) { const float e = st[j][i] > -1.0e29f ? __builtin_amdgcn_exp2f(NSA_C * (st[j][i] - mn)) : 0.f; st[j][i] = MODE == 2 ? e * inv : e; ps += e; }
    if (MODE != 2) { ps += __shfl_xor(ps, 16); ps += __shfl_xor(ps, 32);
        const float sc = __builtin_amdgcn_exp2f(NSA_C * (m - mn)); l = l * sc + ps; m = mn;
        if (MODE == 1) {
#pragma unroll
            for (int mt = 0; mt < 4; ++mt) O[mt] = O[mt] * sc; } }
    if (MODE == 2) {
#pragma unroll
        for (int j = 0; j < 4; ++j) { float a = (st[j][0] + st[j][1]) + (st[j][2] + st[j][3]), b = st[j][3];
            a += __shfl_xor(a, 1); a += __shfl_xor(a, 2); b += __shfl_xor(b, 1); b += __shfl_xor(b, 2);
            if (r == 0) { const int J = (key0 >> 2) + 4 * j + q; impA[J] = a; impB[J] = b; } } }
    if (MODE != 0) {
        bf16x8 pf[2];
#pragma unroll
        for (int ks = 0; ks < 2; ++ks) { const unsigned w0 = pg8::cvt_pk_bf16(st[2 * ks][0], st[2 * ks][1]), w1 = pg8::cvt_pk_bf16(st[2 * ks][2], st[2 * ks][3]),
                                                        w2 = pg8::cvt_pk_bf16(st[2 * ks + 1][0], st[2 * ks + 1][1]), w3 = pg8::cvt_pk_bf16(st[2 * ks + 1][2], st[2 * ks + 1][3]);
            const u32x4 w = (u32x4){w0, w1, w2, w3}; pf[ks] = __builtin_bit_cast(bf16x8, w); }
#pragma unroll
        for (int mt = 0; mt < 4; ++mt) {
#pragma unroll
            for (int ks = 0; ks < 2; ++ks) O[mt] = __builtin_amdgcn_mfma_f32_16x16x32_bf16(vf[mt][ks], pf[ks], O[mt], 0, 0, 0); } }
}
#define NSA_LOOP(MODE, SRC, NBLK, KEY0, LO, HI, INV) do { const int nblk_ = (NBLK); if (nblk_ > 0) { bf16x8 kf_[4][2], vf_[4][2]; f32x4 st_[4]; nsa_loadK(SRC, KEY0(0), kf_, lane); \
    _Pragma("unroll 1") for (int b_ = 0; b_ < nblk_; ++b_) { const int k0_ = KEY0(b_); if (MODE != 0) nsa_loadV(SRC, k0_, vf_, lane); \
        nsa_qk(kf_, qf, st_); __builtin_amdgcn_sched_barrier(0); \
        if (b_ + 1 < nblk_) nsa_loadK(SRC, KEY0(b_ + 1), kf_, lane);     \
        nsa_rest<MODE>(st_, vf_, k0_, LO, HI, O, m, l, INV, r, q, impA, impB); } } } while (0)
constexpr int NSA2_WLDS = 4096;
__device__ __forceinline__ void nsa_attn2(const Ctx& c, const PA& a) {
    const unsigned char* ws = a.ws; const bf16* proj = (const bf16*)(ws + WS_PROJ); bf16* Y = (bf16*)(a.ws + WS_YNSA);
    LAS float* impA = (LAS float*)(c.lds + c.wave * NSA2_WLDS); LAS float* impB = impA + 256; LAS int* KST = (LAS int*)(impB + 256);
    const int lane = c.lane, r = lane & 15, q = lane >> 4;
    for (int task = c.gw; task < T * 4; task += c.NGW) { const int t = task >> 2, g = task & 3;
        const bf16* prow = proj + (size_t)t * LDP;
        bf16x8 qf[2]; qf[0] = (bf16x8){0, 0, 0, 0, 0, 0, 0, 0}; qf[1] = qf[0];
        float gt0 = 0.f, gt1 = 0.f, gt2 = 0.f;
        if (r < 4) { const bf16* qp = prow + PC_NQ + (g * 4 + r) * 64 + 8 * q; qf[0] = *(const bf16x8*)qp; qf[1] = *(const bf16x8*)(qp + 32);
            const bf16* gp = prow + PC_GATE + (g * 4 + r) * 3; gt0 = sigm(bf2f(gp[0])); gt1 = sigm(bf2f(gp[1])); gt2 = sigm(bf2f(gp[2])); }
        const int cur = t >> 6, ncv = t >= 31 ? ((t - 31) >> 4) + 1 : 0;
#pragma unroll
        for (int i = 0; i < 4; ++i) { impA[lane + 64 * i] = 0.f; impB[lane + 64 * i] = 0.f; }
        LDS_WAIT();
        f32x4 yacc[4], O[4];
#pragma unroll
        for (int mt = 0; mt < 4; ++mt) yacc[mt] = (f32x4){0.f, 0.f, 0.f, 0.f};
        if (ncv > 0) {
            NsaSrc sc; sc.kf = (const bf16*)(ws + WS_KCMPB) + (size_t)g * 16 * 4096; sc.vf = (const bf16*)(ws + WS_VCMPT) + (size_t)g * 16 * 4096;
            const int nb = (ncv + 63) >> 6; float m = -1.0e30f, l = 0.f;
#define K0_CMP(b) (64 * (b))
            NSA_LOOP(0, sc, nb, K0_CMP, 0, ncv - 1, 0.f);
            const float inv = 1.f / l;
#pragma unroll
            for (int mt = 0; mt < 4; ++mt) O[mt] = (f32x4){0.f, 0.f, 0.f, 0.f};
            NSA_LOOP(2, sc, nb, K0_CMP, 0, ncv - 1, inv);
#pragma unroll
            for (int mt = 0; mt < 4; ++mt) yacc[mt] = O[mt] * gt0;
        }
        LDS_WAIT();
        float scv[4];
#pragma unroll
        for (int mm = 0; mm < 4; ++mm) { const int j = 4 * lane + mm; float s = -1.0e30f;
            if (j <= cur) { s = impA[j] + (j > 0 ? impB[j - 1] : 0.f); if (j == 0 || j == cur || j == cur - 1) s += 1.0e4f; }
            scv[mm] = s; }
        int nsel = 0;
        for (int itk = 0; itk < 16; ++itk) {
            float lv = scv[0]; int lj = 4 * lane;
            if (scv[1] > lv) { lv = scv[1]; lj = 4 * lane + 1; } if (scv[2] > lv) { lv = scv[2]; lj = 4 * lane + 2; } if (scv[3] > lv) { lv = scv[3]; lj = 4 * lane + 3; }
            const float vmax = wave_max(lv); if (vmax < -5.0e29f) break;
            const int jmin = wave_min_i(lv == vmax ? lj : (1 << 30));
            if (lane == 0) KST[itk] = jmin * 64;
            if ((jmin >> 2) == lane) { const int mm = jmin & 3; if (mm == 0) scv[0] = -3.0e38f; else if (mm == 1) scv[1] = -3.0e38f; else if (mm == 2) scv[2] = -3.0e38f; else scv[3] = -3.0e38f; }
            ++nsel; }
        LDS_WAIT();
        { NsaSrc ss; ss.kf = (const bf16*)(ws + WS_KFS) + (size_t)g * 256 * 4096; ss.vf = (const bf16*)(ws + WS_VFS) + (size_t)g * 256 * 4096;
            float m = -1.0e30f, l = 0.f;
#pragma unroll
            for (int mt = 0; mt < 4; ++mt) O[mt] = (f32x4){0.f, 0.f, 0.f, 0.f};
#define K0_SEL(b) (KST[b])
            NSA_LOOP(1, ss, nsel, K0_SEL, 0, t, 0.f);
            const float sc = gt1 / l;
#pragma unroll
            for (int mt = 0; mt < 4; ++mt) yacc[mt] += O[mt] * sc; }
        { NsaSrc sw; sw.kf = (const bf16*)(ws + WS_KFW) + (size_t)g * 256 * 4096; sw.vf = (const bf16*)(ws + WS_VFW) + (size_t)g * 256 * 4096;
            float m = -1.0e30f, l = 0.f; const int wlo = t - 511 > 0 ? t - 511 : 0;
#pragma unroll
            for (int mt = 0; mt < 4; ++mt) O[mt] = (f32x4){0.f, 0.f, 0.f, 0.f};
            const int jb0 = wlo >> 6;
#define K0_WIN(b) (64 * (jb0 + (b)))
            NSA_LOOP(1, sw, cur - jb0 + 1, K0_WIN, wlo, t, 0.f);
            const float sc = gt2 / l;
#pragma unroll
            for (int mt = 0; mt < 4; ++mt) yacc[mt] += O[mt] * sc; }
        if (r < 4) {
#pragma unroll
            for (int mt = 0; mt < 4; ++mt) { uint2 w; w.x = pg8::cvt_pk_bf16(yacc[mt][0], yacc[mt][1]); w.y = pg8::cvt_pk_bf16(yacc[mt][2], yacc[mt][3]);
                *(uint2*)(Y + (size_t)t * 1024 + (g * 4 + r) * 64 + 16 * mt + 4 * q) = w; } }
    }
}
__device__ __forceinline__ void prep_tiles(const Ctx& c, const PA& a) {
    const bf16* proj = (const bf16*)(a.ws + WS_PROJ);
    LAS bf16* tile = (LAS bf16*)(c.lds + c.wave * 8704);
    const int lane = c.lane, r = lane & 15, q = lane >> 4;
    for (int it = c.gw; it < 4 * 4 * 256; it += c.NGW) { const int blk = it & 255, g = (it >> 8) & 3, ten = it >> 10;
        const int scol = (ten == 0 ? PC_KS : (ten == 1 ? PC_VS : (ten == 2 ? PC_KW : PC_VW))) + g * 64;
        const u32x4* sp = (const u32x4*)(proj + (size_t)(blk * 64 + lane) * LDP + scol);
#pragma unroll
        for (int i = 0; i < 8; ++i) { const u32x4 v = sp[i]; LAS unsigned* tp = (LAS unsigned*)(tile + lane * 66 + 8 * i); tp[0] = v.x; tp[1] = v.y; tp[2] = v.z; tp[3] = v.w; }
        LDS_WAIT();
        bf16* dst = (bf16*)(a.ws + (ten == 0 ? WS_KFS : (ten == 1 ? WS_VFS : (ten == 2 ? WS_KFW : WS_VFW)))) + ((size_t)(g * 256 + blk) * 8) * 512 + lane * 8;
        if ((ten & 1) == 0) {
#pragma unroll
            for (int j = 0; j < 4; ++j)
#pragma unroll
                for (int ks = 0; ks < 2; ++ks) { const LAS unsigned* tp = (const LAS unsigned*)(tile + (16 * j + r) * 66 + 32 * ks + 8 * q);
                    *(u32x4*)(dst + (2 * j + ks) * 512) = (u32x4){tp[0], tp[1], tp[2], tp[3]}; }
        } else {
#pragma unroll
            for (int mt = 0; mt < 4; ++mt)
#pragma unroll
                for (int ks = 0; ks < 2; ++ks) { unsigned w[4];
#pragma unroll
                    for (int h = 0; h < 2; ++h)
#pragma unroll
                        for (int i2 = 0; i2 < 2; ++i2) { const int k0 = 32 * ks + 16 * h + 4 * q + 2 * i2;
                            w[2 * h + i2] = (unsigned)tile[k0 * 66 + 16 * mt + r] | ((unsigned)tile[(k0 + 1) * 66 + 16 * mt + r] << 16); }
                    *(u32x4*)(dst + (2 * mt + ks) * 512) = (u32x4){w[0], w[1], w[2], w[3]}; }
        }
        LDS_WAIT();
    }
}

__device__ __forceinline__ void ln_row(f32x4 (&v)[8], const float* gam, const float* bet, int lane) {
    float s = 0.f;
#pragma unroll
    for (int j = 0; j < 8; ++j) s += (v[j][0] + v[j][1]) + (v[j][2] + v[j][3]);
    const float mean = wave_sum(s) * (1.f / D); float s2 = 0.f;
#pragma unroll
    for (int j = 0; j < 8; ++j) { v[j] = v[j] - mean; s2 += (v[j][0] * v[j][0] + v[j][1] * v[j][1]) + (v[j][2] * v[j][2] + v[j][3] * v[j][3]); }
    const float rstd = 1.f / sqrtf(wave_sum(s2) * (1.f / D) + LN_EPS);
#pragma unroll
    for (int j = 0; j < 8; ++j) { const f32x4 g4 = *(const f32x4*)(gam + 4 * (lane + 64 * j)), b4 = *(const f32x4*)(bet + 4 * (lane + 64 * j)); v[j] = v[j] * rstd * g4 + b4; }
}
__device__ __forceinline__ void ph_ln1_route(const Ctx& c, const PA& a, int layer) {
    unsigned char* ws = a.ws; float* X = a.out; uint2* xb = (uint2*)(ws + WS_XB);
    const float* gam = a.in(25) + layer * D; const float* bet = a.in(26) + layer * D;
    const float* wg = a.in(27) + (size_t)layer * D * 4; const float* bg = a.in(28) + layer * 4; const float* we = a.in(29) + (size_t)layer * D * 32; const float* be = a.in(30) + layer * 32;
    int* toke = (int*)(ws + WS_TOKE); float* tokw = (float*)(ws + WS_TOKW); unsigned* cnt = (unsigned*)(ws + WS_CTL) + CW_CNT + layer * 128;
    LAS float* lg = (LAS float*)(c.lds + c.wave * 256);
    const int lane = c.lane;
    for (int t = c.gw; t < T; t += c.NGW) {
        f32x4* row = (f32x4*)(X + (size_t)t * D); f32x4 v[8];
#pragma unroll
        for (int j = 0; j < 8; ++j) v[j] = row[lane + 64 * j];
        ln_row(v, gam, bet, lane);
#pragma unroll
        for (int j = 0; j < 8; ++j) { row[lane + 64 * j] = v[j]; xb[(size_t)t * (D / 4) + lane + 64 * j] = make_uint2(pk2(v[j][0], v[j][1]), pk2(v[j][2], v[j][3])); }
        LAS float* xr = (LAS float*)(c.lds + 4096 + c.wave * 8192);
#pragma unroll
        for (int j = 0; j < 8; ++j) *(LAS f32x4*)(xr + 4 * (lane + 64 * j)) = v[j];
        LDS_WAIT();
        f32x4 ag = (f32x4){0.f, 0.f, 0.f, 0.f}; f32x4 ae[8];
#pragma unroll
        for (int q = 0; q < 8; ++q) ae[q] = (f32x4){0.f, 0.f, 0.f, 0.f};
#pragma unroll 2
        for (int i = 0; i < 32; ++i) { const int d = lane + 64 * i; const float x = xr[d];
            ag += *(const f32x4*)(wg + (size_t)d * 4) * x;
            const f32x4* wp = (const f32x4*)(we + (size_t)d * 32);
#pragma unroll
            for (int e4 = 0; e4 < 8; ++e4) ae[e4] += wp[e4] * x; }
#pragma unroll
        for (int q = 0; q < 4; ++q) ag[q] = wave_sum(ag[q]) + bg[q];
#pragma unroll
        for (int e4 = 0; e4 < 8; ++e4)
#pragma unroll
            for (int q = 0; q < 4; ++q) ae[e4][q] = wave_sum(ae[e4][q]);
        if (lane == 0) {
#pragma unroll
            for (int e4 = 0; e4 < 8; ++e4)
#pragma unroll
                for (int q = 0; q < 4; ++q) lg[e4 * 4 + q] = ae[e4][q] + be[e4 * 4 + q]; }
        LDS_WAIT();
        int grp = 0; float gm = ag[0];
        if (ag[1] > gm) { gm = ag[1]; grp = 1; } if (ag[2] > gm) { gm = ag[2]; grp = 2; } if (ag[3] > gm) { gm = ag[3]; grp = 3; }
        const float gw_ = 1.f / (expf(ag[0] - gm) + expf(ag[1] - gm) + expf(ag[2] - gm) + expf(ag[3] - gm));
        float v0 = -3.0e38f, v1 = -3.0e38f; int i0 = 0, i1 = 0;
        for (int i = 0; i < 8; ++i) { const float x = lg[grp * 8 + i];
            if (x > v0) { v1 = v0; i1 = i0; v0 = x; i0 = i; } else if (x > v1) { v1 = x; i1 = i; } }
        const float e1 = expf(v1 - v0), p0 = 1.f / (1.f + e1), p1 = e1 * p0;
        if (lane == 0) { toke[2 * t] = grp * 8 + i0; toke[2 * t + 1] = grp * 8 + i1; tokw[2 * t] = p0 * gw_; tokw[2 * t + 1] = p1 * gw_;
            __hip_atomic_fetch_add(cnt + grp * 8 + i0, 1u, __ATOMIC_RELAXED, __HIP_MEMORY_SCOPE_AGENT); __hip_atomic_fetch_add(cnt + grp * 8 + i1, 1u, __ATOMIC_RELAXED, __HIP_MEMORY_SCOPE_AGENT); }
        LDS_WAIT();
    }
}
__device__ __forceinline__ void ph_slot(const Ctx& c, const PA& a, int layer) {
    unsigned char* ws = a.ws; unsigned* cnt = (unsigned*)(ws + WS_CTL) + CW_CNT + layer * 128; unsigned* cur = (unsigned*)(ws + WS_CTL) + CW_CUR + layer * 128;
    int* texp = (int*)(ws + WS_TEXP) + layer * 512; const int* toke = (const int*)(ws + WS_TOKE); int* slot = (int*)(ws + WS_SLOT);
    LAS int* pst = (LAS int*)c.lds;
    if (c.tid == 0) { int off = 0, nt = 0;
#pragma unroll 1
        for (int e = 0; e < NEXP; ++e) { const int n = (int)__hip_atomic_load(cnt + e, __ATOMIC_RELAXED, __HIP_MEMORY_SCOPE_AGENT), tl = (n + 255) >> 8;
            pst[e] = off; off += tl * 256;
            if (c.bx == 0) for (int q = 0; q < tl; ++q) texp[nt + q] = e;
            nt += tl; }
        if (c.bx == 0) texp[255] = nt; }
    __syncthreads();
    const u32x4* xb = (const u32x4*)(ws + WS_XB); u32x4* xs = (u32x4*)(ws + WS_XS);
    for (int as = c.gw; as < 2 * T; as += c.NGW) { const int t = as >> 1, e = toke[as]; int s = 0;
        if (c.lane == 0) s = pst[e] + (int)__hip_atomic_fetch_add(cur + e, 1u, __ATOMIC_RELAXED, __HIP_MEMORY_SCOPE_AGENT);
        s = __shfl(s, 0);
        if (c.lane == 0) slot[as] = s;
#pragma unroll
        for (int j = 0; j < 4; ++j) xs[(size_t)s * 256 + c.lane + 64 * j] = xb[(size_t)t * 256 + c.lane + 64 * j]; }
}
__device__ __forceinline__ void ph_ln2(const Ctx& c, const PA& a, int layer) {
    unsigned char* ws = a.ws; float* X = a.out; uint2* xb = (uint2*)(ws + WS_XB); const uint2* ys = (const uint2*)(ws + WS_YS);
    const float* gam = a.in(34) + layer * D; const float* bet = a.in(35) + layer * D; const int* slot = (const int*)(ws + WS_SLOT); const float* tokw = (const float*)(ws + WS_TOKW);
    const int lane = c.lane;
    for (int t = c.gw; t < T; t += c.NGW) {
        const int s0 = slot[2 * t], s1 = slot[2 * t + 1]; const float w0 = tokw[2 * t], w1 = tokw[2 * t + 1];
        f32x4* row = (f32x4*)(X + (size_t)t * D); f32x4 v[8];
#pragma unroll
        for (int j = 0; j < 8; ++j) { const uint2 y0 = ys[(size_t)s0 * 512 + lane + 64 * j], y1 = ys[(size_t)s1 * 512 + lane + 64 * j]; const f32x4 x = row[lane + 64 * j];
            v[j][0] = x[0] * DN_ALPHA + w0 * bflo(y0.x) + w1 * bflo(y1.x); v[j][1] = x[1] * DN_ALPHA + w0 * bfhi(y0.x) + w1 * bfhi(y1.x);
            v[j][2] = x[2] * DN_ALPHA + w0 * bflo(y0.y) + w1 * bflo(y1.y); v[j][3] = x[3] * DN_ALPHA + w0 * bfhi(y0.y) + w1 * bfhi(y1.y); }
        ln_row(v, gam, bet, lane);
#pragma unroll
        for (int j = 0; j < 8; ++j) { row[lane + 64 * j] = v[j]; xb[(size_t)t * (D / 4) + lane + 64 * j] = make_uint2(pk2(v[j][0], v[j][1]), pk2(v[j][2], v[j][3])); }
    }
}

enum { PH_CONV = 0, PH_INPROJ, PH_PREP, PH_SCAN1, PH_SCAN2, PH_SCAN3, PH_GATES, PH_BRANCH, PH_OUT, PH_LN1, PH_SLOT, PH_MOE_GU, PH_MOE_DN, PH_LN2, NPH_L };
constexpr int NPH = NPH_L * DEPTH;

__device__ __forceinline__ Ctx mkctx(LAS unsigned char* lds, int wv) {
    int ln; asm volatile("v_mbcnt_lo_u32_b32 %0, -1, 0\n\tv_mbcnt_hi_u32_b32 %0, -1, %0" : "=v"(ln));
    int tid = wv * 64 + ln, bx = blockIdx.x, G = gridDim.x;
    asm volatile("" : "+s"(bx)); asm volatile("" : "+s"(G));
    Ctx c; c.lds = lds; c.tid = tid; c.lane = tid & 63; c.wave = __builtin_amdgcn_readfirstlane(tid >> 6); c.G = G; c.bx = bx; c.gw = bx * 8 + c.wave; c.NGW = G * 8; return c;
}
__global__ void __launch_bounds__(512, 2) fwd(Args args0) {
    extern __shared__ __attribute__((aligned(16))) unsigned char lds_raw[];
    LAS unsigned char* const lds0 = (LAS unsigned char*)lds_raw;
    const int lo = args0.ph_lo, hi = args0.ph_hi;
    const int wv0 = __builtin_amdgcn_readfirstlane(threadIdx.x >> 6);
    if (threadIdx.x < 36) ((LAS unsigned long long*)(lds0 + LDS_PTAB))[threadIdx.x] = (unsigned long long)args0.in[threadIdx.x];
    __syncthreads();
#if MK_ONE_LAUNCH
    volatile LAS unsigned* barw = (volatile LAS unsigned*)(lds0 + LDS_BARW);
    if (threadIdx.x == 0) { barw[0] = 0u; barw[1] = 0u; barw[2] = 0u; barw[3] = 0u; }
    __syncthreads();
    XcdBarrier bar = xcd_barrier_post((unsigned*)(args0.ws + WS_CTL) + CW_BAR, barw);
#define SEAM(p) do { if ((p) + 1 < hi) xcd_barrier(bar); } while (0)
#else
#define SEAM(p) do { } while (0)
#endif
#ifndef ONLY_PHASE
#define ONLY_PHASE -1
#endif
#define PHASE_BEGIN PA args; { unsigned char* w_ = args0.ws; asm volatile("" : "+s"(w_)); args.ws = w_; float* o_ = args0.out; asm volatile("" : "+s"(o_)); args.out = o_; args.tab = (const LAS unsigned*)(lds0 + LDS_PTAB); } unsigned char* const ws = args.ws; const Ctx c = mkctx(lds0, wv0); (void)ws; (void)c;
#define TASK_CTX() mkctx(lds0, wv0)
#define IN(p) ((ONLY_PHASE < 0 || ONLY_PHASE == ((p) - pb)) && lo <= (p) && (p) < hi)
    for (int layer = 0; layer < DEPTH; ++layer) {
        const int pb = layer * NPH_L;
        if (IN(pb + PH_CONV)) { PHASE_BEGIN ph_conv(c, args, layer); __syncthreads(); SEAM(pb + PH_CONV); }
        if (IN(pb + PH_INPROJ)) { PHASE_BEGIN
            Gemm g{D, D, D}; SchedPlain S; S.to.init(T / 256, LDP / 256); S.G = c.G; S.c = c.bx; S.tid = c.tid; S.A = (const char*)(ws + WS_XB); S.B = (const char*)(ws + WS_WIN); S.ta = (size_t)256 * D * 2; S.tb = (size_t)256 * D * 2;
            EpiStore<0> E{(bf16*)(ws + WS_PROJ), LDP};
            pg8::gemm_phase<EpiStore<0>, SchedPlain, PG8_ALIGN, PG8_SP2>(c.lds, g, S, E);
#ifdef REP_GEMM
            pg8::gemm_phase<EpiStore<0>, SchedPlain, PG8_ALIGN, PG8_SP2>(c.lds, g, S, E);
#endif
            SEAM(pb + PH_INPROJ); }
        if (IN(pb + PH_PREP)) { PHASE_BEGIN prep_rwkv(c, args, layer); __syncthreads(); prep_cmp(TASK_CTX(), args, layer); prep_rope(TASK_CTX(), args); prep_tiles(TASK_CTX(), args); __syncthreads(); SEAM(pb + PH_PREP); }
        if (IN(pb + PH_SCAN1)) { PHASE_BEGIN rw_pass1(c, args); ret_kv(TASK_CTX(), args); __syncthreads(); nsa_attn2(TASK_CTX(), args); __syncthreads();
 SEAM(pb + PH_SCAN1); }
        if (IN(pb + PH_SCAN2)) { PHASE_BEGIN rw_pass2(c, args); ret_prefix(TASK_CTX(), args); __syncthreads(); SEAM(pb + PH_SCAN2); }
        if (IN(pb + PH_SCAN3)) { PHASE_BEGIN rw_pass3(c, args, layer); __syncthreads(); ret_out(TASK_CTX(), args); __syncthreads(); SEAM(pb + PH_SCAN3); }
        if (IN(pb + PH_GATES)) { PHASE_BEGIN
            Gemm g{D, D, D}; SchedPlain S; S.to.init(T / 256, NG / 256); S.G = c.G; S.c = c.bx; S.tid = c.tid; S.A = (const char*)(ws + WS_XB); S.B = (const char*)(ws + WS_WG); S.ta = (size_t)256 * D * 2; S.tb = (size_t)256 * D * 2;
            EpiStore<1> E{(bf16*)(ws + WS_GATES), NG};
            pg8::gemm_phase<EpiStore<1>, SchedPlain, PG8_ALIGN, PG8_SP2>(c.lds, g, S, E);
#ifdef REP_GEMM
            pg8::gemm_phase<EpiStore<1>, SchedPlain, PG8_ALIGN, PG8_SP2>(c.lds, g, S, E);
#endif
            SEAM(pb + PH_GATES); }
        if (IN(pb + PH_BRANCH)) { PHASE_BEGIN
            Gemm g{RWW, RWW, RWW}; SchedBranch S; S.to.init(T / 256, D / 256); S.G = c.G; S.c = c.bx; S.tid = c.tid;
            S.A0 = (const char*)(ws + WS_YRW); S.sa = WS_YNSA - WS_YRW; static_assert(WS_YRET - WS_YNSA == WS_YNSA - WS_YRW, "y buffers equally spaced");
            S.B0 = (const char*)(ws + WS_WBR); S.sb = (size_t)D * RWW * 2; S.ta = (size_t)256 * RWW * 2; S.tb = (size_t)256 * RWW * 2;
            EpiBranch E{(bf16*)(ws + WS_MERGED), (const bf16*)(ws + WS_GATES)};
            pg8::gemm_phase<EpiBranch, SchedBranch, PG8_ALIGN, PG8_SP2>(c.lds, g, S, E);
#ifdef REP_GEMM
            pg8::gemm_phase<EpiBranch, SchedBranch, PG8_ALIGN, PG8_SP2>(c.lds, g, S, E);
#endif
            SEAM(pb + PH_BRANCH); }
        if (IN(pb + PH_OUT)) { PHASE_BEGIN
            Gemm g{D, D, D}; SchedPlain S; S.to.init(T / 256, D / 256); S.G = c.G; S.c = c.bx; S.tid = c.tid; S.A = (const char*)(ws + WS_MERGED); S.B = (const char*)(ws + WS_WOUT); S.ta = (size_t)256 * D * 2; S.tb = (size_t)256 * D * 2;
            EpiResid E{args.out};
            pg8::gemm_phase<EpiResid, SchedPlain, PG8_ALIGN, PG8_SP2>(c.lds, g, S, E);
            SEAM(pb + PH_OUT); }
        if (IN(pb + PH_LN1)) { PHASE_BEGIN ph_ln1_route(c, args, layer); __syncthreads(); ph_conv_moe(TASK_CTX(), args, layer); __syncthreads(); SEAM(pb + PH_LN1); }
        if (IN(pb + PH_SLOT)) { PHASE_BEGIN ph_slot(c, args, layer); __syncthreads(); SEAM(pb + PH_SLOT); }
        if (IN(pb + PH_MOE_GU)) { PHASE_BEGIN
            const int* texp = (const int*)(ws + WS_TEXP) + layer * 512;
            Gemm g{D, D, D}; SchedMoe S; S.nM = texp[255]; S.nN = 4; S.G = c.G; S.c = c.bx; S.tid = c.tid; S.A = (const char*)(ws + WS_XS); S.B = (const char*)(ws + WS_WGU); S.ta = (size_t)256 * D * 2; S.tb = (size_t)256 * D * 2; S.te = (size_t)1024 * D * 2; S.texp = texp;
            EpiGateUp E{(bf16*)(ws + WS_H)};
            pg8::gemm_phase<EpiGateUp, SchedMoe, PG8_ALIGN, PG8_SP2>(c.lds, g, S, E);
#ifdef REP_GEMM
            pg8::gemm_phase<EpiGateUp, SchedMoe, PG8_ALIGN, PG8_SP2>(c.lds, g, S, E);
#endif
            SEAM(pb + PH_MOE_GU); }
        if (IN(pb + PH_MOE_DN)) { PHASE_BEGIN
            const int* texp = (const int*)(ws + WS_TEXP) + layer * 512;
            Gemm g{FF, FF, FF}; SchedMoe S; S.nM = texp[255]; S.nN = 8; S.G = c.G; S.c = c.bx; S.tid = c.tid; S.A = (const char*)(ws + WS_H); S.B = (const char*)(ws + WS_WDN); S.ta = (size_t)256 * FF * 2; S.tb = (size_t)256 * FF * 2; S.te = (size_t)D * FF * 2; S.texp = texp;
            EpiStore<0> E{(bf16*)(ws + WS_YS), D};
            pg8::gemm_phase<EpiStore<0>, SchedMoe, PG8_ALIGN, PG8_SP2>(c.lds, g, S, E);
#ifdef REP_GEMM
            pg8::gemm_phase<EpiStore<0>, SchedMoe, PG8_ALIGN, PG8_SP2>(c.lds, g, S, E);
#endif
            SEAM(pb + PH_MOE_DN); }
        if (IN(pb + PH_LN2)) { PHASE_BEGIN ph_ln2(c, args, layer); __syncthreads(); SEAM(pb + PH_LN2); }
    }
#undef IN
#undef SEAM
}

#ifndef TRUNC_PH
#define TRUNC_PH NPH
#endif
#ifndef DUMP_MODE
#define DUMP_MODE 0
#endif
#if DUMP_MODE
__global__ void dump_k(float* out, const unsigned char* ws) {
    for (size_t i = (size_t)blockIdx.x * blockDim.x + threadIdx.x; i < (size_t)T * D; i += (size_t)gridDim.x * blockDim.x) {
        const int t = (int)(i / D), c = (int)(i % D); float v = 0.f;
#if DUMP_MODE == 1
        v = bf2f(((const bf16*)(ws + WS_PROJ))[(size_t)t * LDP + c * 5]);
#elif DUMP_MODE == 2
        if (c < 1024) v = bf2f(((const bf16*)(ws + WS_YRW))[(size_t)t * 1024 + c]); else v = bf2f(((const bf16*)(ws + WS_YNSA))[(size_t)t * 1024 + c - 1024]);
#elif DUMP_MODE == 3
        if (c < 1024) v = bf2f(((const bf16*)(ws + WS_YRET))[(size_t)t * 1024 + c]); else v = bf2f(((const bf16*)(ws + WS_MERGED))[(size_t)t * D + c]);
#elif DUMP_MODE == 4
        if (c < 1024) v = bf2f(((const bf16*)(ws + WS_YRET))[(size_t)t * 1024 + c]);
#elif DUMP_MODE == 5
        v = bf2f(((const bf16*)(ws + WS_GATES))[(size_t)t * NG + c * 3]);
#endif
        out[i] = (v == v && fabsf(v) < 1e30f) ? v : 0.f; }
}
#endif
extern "C" void kernel_launch(void* const* d_in, const int* in_sizes, int n_in, void* d_out, int out_size, void* d_ws, size_t ws_size, hipStream_t stream) {
    static int grid = 0;
    if (grid == 0) {
        if (n_in != 36 || out_size != T * D || ws_size < WS_END) { fprintf(stderr, "kernel_launch: unexpected shapes (n_in %d out %d ws %zu)\n", n_in, out_size, ws_size); grid = -1; return; }
        int dev = 0, cus = 0, per_cu = 0;
        if (hipGetDevice(&dev) != hipSuccess || hipDeviceGetAttribute(&cus, hipDeviceAttributeMultiprocessorCount, dev) != hipSuccess) { grid = -1; return; }
        if (hipFuncSetAttribute((const void*)fwd, hipFuncAttributeMaxDynamicSharedMemorySize, LDS_BYTES) != hipSuccess) { fprintf(stderr, "kernel_launch: hipFuncSetAttribute failed\n"); grid = -1; return; }
        if (hipOccupancyMaxActiveBlocksPerMultiprocessor(&per_cu, (const void*)fwd, 512, LDS_BYTES) != hipSuccess || per_cu < 1) fprintf(stderr, "kernel_launch: occupancy query says %d\n", per_cu);
        (void)hipGetLastError();
        grid = cus;
    }
    if (grid < 0) return;
    if (hipMemsetAsync((char*)d_ws + WS_CTL, 0, CTL_ZERO_BYTES, stream) != hipSuccess) return;
    Args a{};
    for (int i = 0; i < 36; ++i) a.in[i] = (const float*)d_in[i];
    a.out = (float*)d_out; a.ws = (unsigned char*)d_ws;
#if MK_ONE_LAUNCH
    a.ph_lo = 0; a.ph_hi = NPH;
    hipLaunchKernelGGL(fwd, dim3(grid), dim3(512), LDS_BYTES, stream, a);
#else
    for (int p = 0; p < TRUNC_PH; ++p) { a.ph_lo = p; a.ph_hi = p + 1; hipLaunchKernelGGL(fwd, dim3(grid), dim3(512), LDS_BYTES, stream, a); }
#if DUMP_MODE
    dump_k<<<2048, 256, 0, stream>>>((float*)d_out, (const unsigned char*)d_ws);
#endif
#endif
}
```

```cpp
#define MK_ONE_LAUNCH 1
#include <hip/hip_runtime.h>
#include <cstdio>
#include <cstdint>

#ifndef MK_ONE_LAUNCH
#define MK_ONE_LAUNCH 0
#endif

namespace pg8 {
#define PG8_LAS __attribute__((address_space(3)))
typedef unsigned short bf16_t;
typedef short bf16x8 __attribute__((ext_vector_type(8)));
typedef float f32x4 __attribute__((ext_vector_type(4)));
typedef unsigned u32x4 __attribute__((ext_vector_type(4)));
constexpr int BM = 256, BK = 64, HALF = 128, HTB = HALF * BK * 2  , STAGE_BYTES = 8 * HTB, NXCD = 8, WGM = 8;

__host__ __device__ __forceinline__ int lds_byte(int r, int c) { const int st = (r >> 4) * 2 + (c >> 5), rr = r & 15, cc = c & 31, ob = rr * 64 + cc * 2; return st * 1024 + (ob ^ (((ob >> 9) & 1) << 5)); }
__host__ __device__ __forceinline__ void stage_rc(int b, int& R, int& C) { const int st = b / 1024, sb = b % 1024, swz = sb ^ (((sb >> 9) & 1) << 5); R = (st >> 1) * 16 + swz / 64; C = (st & 1) * 32 + (swz % 64) / 2; }
__host__ __device__ __forceinline__ int perm32(int rho) { const int n = rho >> 4, i = rho & 15; return 8 * (i >> 2) + 4 * n + (i & 3); }

struct Unit { int pm, pn, aux; const char* a; const char* b; };
struct Gemm { int K, lda, ldb; };

struct TileOrder {
    int nM, nN, nwg;
    __device__ void init(int nM_, int nN_) { nM = nM_; nN = nN_; nwg = nM * nN; }
    __device__ bool tile(long L, int& pm, int& pn) const {
        if (L >= nwg) return false;
        int wgid = (int)L; { const int q = nwg / NXCD, r = nwg % NXCD, xcd = wgid % NXCD, off = wgid / NXCD; wgid = (xcd < r ? xcd * (q + 1) : r * (q + 1) + (xcd - r) * q) + off; }
        const int nig = WGM * nN, gid = wgid / nig, fm = gid * WGM, gsz = (nM - fm) < WGM ? (nM - fm) : WGM;
        pm = fm + ((wgid % nig) % gsz); pn = (wgid % nig) / gsz; return true;
    }
};

typedef float f32x2_t __attribute__((ext_vector_type(2))); typedef __bf16 bf16x2_t __attribute__((ext_vector_type(2)));
__device__ __forceinline__ unsigned cvt_pk_bf16(float lo, float hi) { f32x2_t v = {lo, hi}; bf16x2_t b = __builtin_convertvector(v, bf16x2_t); return __builtin_bit_cast(unsigned, b); }

template <class Epi, class Sched, bool ALIGN_EPI = false, bool SP2 = false>
__device__ __forceinline__ void gemm_phase(PG8_LAS unsigned char* lds, const Gemm g, const Sched& S, const Epi& E) {
    const int tid = S.tid, wid = __builtin_amdgcn_readfirstlane(tid >> 6), lane = tid & 63, wr = wid >> 2, wc = wid & 3, fr = lane & 15, fq = lane >> 4;
    const int K = g.K, nt = K / BK;
    unsigned voffA[2], voffB[2];
#pragma unroll
    for (int i = 0; i < 2; ++i) { int R, C; stage_rc(tid * 16 + i * 8192, R, C); const int Rb = Epi::PERM ? ((R & ~31) + perm32(R & 31)) : R;
        voffA[i] = (unsigned)(R * g.lda + C) * 2u; voffB[i] = (unsigned)(Rb * g.ldb + C) * 2u; }
    const size_t kstep = (size_t)(BK * 2);
    const size_t hstepA = (size_t)HALF * g.lda * 2, hstepB = (size_t)HALF * g.ldb * 2;
    const unsigned ldsw = (unsigned)wid * 1024u;
    const int aoff = lds_byte(wr * 64 + fr, fq * 8), boff = lds_byte(wc * 32 + fr, fq * 8);
#define PG8_SA(b, h) (((b) * 2 + (h)) * HTB)
#define PG8_SB(b, h) ((4 + (b) * 2 + (h)) * HTB)
#define PG8_STAGE(bufoff, gbase, voff) do { _Pragma("unroll") for (int _i = 0; _i < 2; ++_i) \
        __builtin_amdgcn_global_load_lds((const unsigned*)((const char*)(gbase) + (voff)[_i]), (PG8_LAS unsigned*)(lds + (bufoff) + ldsw + _i * 8192), 16, 0, 0); } while (0)
#define PG8_LDA(dst, b, h) do { _Pragma("unroll") for (int m = 0; m < 4; ++m) _Pragma("unroll") for (int k = 0; k < 2; ++k) dst[m][k] = *(const PG8_LAS bf16x8*)(lds + PG8_SA(b, h) + aoff + m * 2048 + k * 1024); } while (0)
#define PG8_LDB(dst, b, h) do { _Pragma("unroll") for (int n = 0; n < 2; ++n) _Pragma("unroll") for (int k = 0; k < 2; ++k) dst[n][k] = *(const PG8_LAS bf16x8*)(lds + PG8_SB(b, h) + boff + n * 2048 + k * 1024); } while (0)
#define PG8_MMA(ai, bj, At, Bt) do { __builtin_amdgcn_s_setprio(1); _Pragma("unroll") for (int m = 0; m < 4; ++m) _Pragma("unroll") for (int n = 0; n < 2; ++n) _Pragma("unroll") for (int k = 0; k < 2; ++k) \
        acc[ai][bj][m][n] = __builtin_amdgcn_mfma_f32_16x16x32_bf16(Bt[n][k], At[m][k], acc[ai][bj][m][n], 0, 0, 0); __builtin_amdgcn_s_setprio(0); } while (0)
#define PG8_WAIT_V(n) asm volatile("s_waitcnt vmcnt(" #n ")" ::: "memory")
#define PG8_WAIT_L(n) asm volatile("s_waitcnt lgkmcnt(" #n ")" ::: "memory")
#define PG8_BAR __builtin_amdgcn_s_barrier()
#define PG8_SCHED __builtin_amdgcn_sched_barrier(0)
    Unit cur, nxt; int ui = 0;
    if (!S.next(0, cur)) return;
    f32x4 acc[2][2][4][2];
#pragma unroll
    for (int a = 0; a < 2; ++a)
#pragma unroll
        for (int b = 0; b < 2; ++b)
#pragma unroll
            for (int m = 0; m < 4; ++m)
#pragma unroll
                for (int n = 0; n < 2; ++n) acc[a][b][m][n] = (f32x4){0.f, 0.f, 0.f, 0.f};
    bf16x8 At[4][2], B0[2][2], B1[2][2];
    const char* cA = cur.a; const char* cB = cur.b;
    if constexpr (SP2) {
        PG8_STAGE(PG8_SB(0, 0), cB, voffB); PG8_STAGE(PG8_SB(0, 1), cB + hstepB, voffB); PG8_STAGE(PG8_SA(0, 0), cA, voffA); PG8_STAGE(PG8_SA(0, 1), cA + hstepA, voffA);
        if (wr == 1) PG8_BAR;
        PG8_WAIT_V(2); PG8_BAR;
        PG8_STAGE(PG8_SB(1, 0), cB + kstep, voffB); PG8_STAGE(PG8_SA(1, 0), cA + kstep, voffA); PG8_STAGE(PG8_SB(1, 1), cB + hstepB + kstep, voffB);
        PG8_WAIT_V(6); PG8_BAR;
    } else {
        PG8_STAGE(PG8_SB(0, 0), cB, voffB); PG8_STAGE(PG8_SA(0, 0), cA, voffA); PG8_STAGE(PG8_SB(0, 1), cB + hstepB, voffB); PG8_STAGE(PG8_SA(0, 1), cA + hstepA, voffA);
        if (wr == 1) PG8_BAR;
        PG8_WAIT_V(4); PG8_BAR;
        PG8_STAGE(PG8_SB(1, 0), cB + kstep, voffB); PG8_STAGE(PG8_SA(1, 0), cA + kstep, voffA); PG8_STAGE(PG8_SB(1, 1), cB + hstepB + kstep, voffB);
        PG8_WAIT_V(6); PG8_BAR;
    }
    for (;;) {
        const bool has_next = S.next(ui + 1, nxt);
        const char* nA = has_next ? nxt.a : cA; const char* nB = has_next ? nxt.b : cB;
        for (int t = 0; t < nt; t += 2) {
            const bool last = (t == nt - 2);
            const char* a1 = cA + (size_t)(t + 1) * kstep;
            const char* a2 = last ? nA : cA + (size_t)(t + 2) * kstep; const char* b2 = last ? nB : cB + (size_t)(t + 2) * kstep;
            const char* a3 = a2 + kstep; const char* b3 = b2 + kstep;
            if constexpr (SP2) {
            PG8_LDB(B0, 0, 0); PG8_LDB(B1, 0, 1); PG8_SCHED; PG8_LDA(At, 0, 0); PG8_STAGE(PG8_SA(1, 1), a1 + hstepA, voffA);
            PG8_WAIT_V(8); PG8_WAIT_L(0); PG8_BAR; PG8_MMA(0, 0, At, B0); PG8_MMA(0, 1, At, B1); PG8_BAR; PG8_SCHED;
            PG8_LDA(At, 0, 1); PG8_STAGE(PG8_SB(0, 0), b2, voffB); PG8_STAGE(PG8_SB(0, 1), b2 + hstepB, voffB); PG8_STAGE(PG8_SA(0, 0), a2, voffA);
            PG8_WAIT_V(8); PG8_WAIT_L(0); PG8_BAR; PG8_MMA(1, 0, At, B0); PG8_MMA(1, 1, At, B1); PG8_BAR; PG8_SCHED;
            PG8_LDB(B0, 1, 0); PG8_LDB(B1, 1, 1); PG8_SCHED; PG8_LDA(At, 1, 0); PG8_STAGE(PG8_SA(0, 1), a2 + hstepA, voffA);
            PG8_WAIT_V(8); PG8_WAIT_L(0); PG8_BAR; PG8_MMA(0, 0, At, B0); PG8_MMA(0, 1, At, B1); PG8_BAR; PG8_SCHED;
            PG8_LDA(At, 1, 1); PG8_STAGE(PG8_SB(1, 0), b3, voffB); PG8_STAGE(PG8_SB(1, 1), b3 + hstepB, voffB); PG8_STAGE(PG8_SA(1, 0), a3, voffA);
            PG8_WAIT_V(8); PG8_WAIT_L(0); PG8_BAR; PG8_MMA(1, 0, At, B0); PG8_MMA(1, 1, At, B1); PG8_BAR; PG8_SCHED;
            } else {
            PG8_LDB(B0, 0, 0); PG8_SCHED; PG8_LDA(At, 0, 0); PG8_STAGE(PG8_SA(1, 1), a1 + hstepA, voffA);
            PG8_WAIT_L(8); PG8_BAR; PG8_WAIT_L(0); PG8_MMA(0, 0, At, B0); PG8_BAR; PG8_SCHED;
            PG8_LDB(B1, 0, 1); PG8_STAGE(PG8_SB(0, 0), b2, voffB);
            PG8_BAR; PG8_WAIT_L(0); PG8_MMA(0, 1, At, B1); PG8_BAR;
            PG8_LDA(At, 0, 1); PG8_STAGE(PG8_SA(0, 0), a2, voffA);
            PG8_BAR; PG8_WAIT_L(0); PG8_MMA(1, 0, At, B0); PG8_BAR; PG8_SCHED;
            PG8_STAGE(PG8_SB(0, 1), b2 + hstepB, voffB);
            PG8_WAIT_V(6); PG8_BAR; PG8_MMA(1, 1, At, B1); PG8_BAR;
            PG8_LDB(B0, 1, 0); PG8_SCHED; PG8_LDA(At, 1, 0); PG8_STAGE(PG8_SA(0, 1), a2 + hstepA, voffA);
            PG8_WAIT_L(8); PG8_BAR; PG8_WAIT_L(0); PG8_MMA(0, 0, At, B0); PG8_BAR; PG8_SCHED;
            PG8_LDB(B1, 1, 1); PG8_STAGE(PG8_SB(1, 0), b3, voffB);
            PG8_BAR; PG8_WAIT_L(0); PG8_MMA(0, 1, At, B1); PG8_BAR;
            PG8_LDA(At, 1, 1); PG8_STAGE(PG8_SA(1, 0), a3, voffA);
            PG8_BAR; PG8_WAIT_L(0); PG8_MMA(1, 0, At, B0); PG8_BAR; PG8_SCHED;
            PG8_STAGE(PG8_SB(1, 1), b3 + hstepB, voffB);
            PG8_WAIT_V(6); PG8_BAR; PG8_MMA(1, 1, At, B1); PG8_BAR;
            }
        }
        if constexpr (ALIGN_EPI) { if (wr == 0) PG8_BAR; }
        E(acc, cur, wr, wc, fr, fq);
        if (!has_next) break;
#pragma unroll
        for (int a = 0; a < 2; ++a)
#pragma unroll
            for (int b = 0; b < 2; ++b)
#pragma unroll
                for (int m = 0; m < 4; ++m)
#pragma unroll
                    for (int n = 0; n < 2; ++n) acc[a][b][m][n] = (f32x4){0.f, 0.f, 0.f, 0.f};
        cur = nxt; cA = nA; cB = nB; ++ui;
        if constexpr (ALIGN_EPI) { if (wr == 1) PG8_BAR; }
    }
    PG8_WAIT_V(0);
    if constexpr (!ALIGN_EPI) { if (wr == 0) PG8_BAR; }
    PG8_BAR;
    #undef PG8_SA
#undef PG8_SB
#undef PG8_STAGE
#undef PG8_LDA
#undef PG8_LDB
#undef PG8_MMA
#undef PG8_WAIT_V
#undef PG8_WAIT_L
#undef PG8_BAR
#undef PG8_SCHED
}
}

#ifndef PG8_SP2
#define PG8_SP2 true
#endif
#ifndef PG8_ALIGN
#define PG8_ALIGN true
#endif

constexpr int T = 16384, D = 2048, DEPTH = 2;
constexpr int RWW = 1024;
constexpr int NCMP = 1023, NSELB = 256;
constexpr int NEXP = 32, FF = 512;
constexpr int LDP = 10496;
constexpr int NG = 6144;
constexpr int PC_RW_R = 0, PC_RW_K = 1024, PC_RW_V = 2048, PC_NQ = 3072, PC_KC = 4096, PC_VC = 4352, PC_KS = 4608, PC_VS = 4864, PC_KW = 5120, PC_VW = 5376,
              PC_RQ = 5632, PC_RK = 6656, PC_RV = 7680, PC_RG = 8704, PC_XW = 9728, PC_XA = 9824, PC_XG = 9920, PC_XV = 10176, PC_GATE = 10240;
constexpr float DN_ALPHA = 1.41421356237f, LN_EPS = 1e-5f;

constexpr size_t MiB = 1u << 20;
constexpr size_t WS_CTL = 0, CTL_ZERO_BYTES = 1 * MiB;
constexpr size_t WS_TEXP = 1 * MiB, WS_TOKE = WS_TEXP + 65536, WS_TOKW = WS_TOKE + 131072, WS_SLOT = WS_TOKW + 131072;
constexpr size_t WS_KCMPB = 2 * MiB, WS_VCMPT = 3 * MiB, WS_RKB = 4 * MiB, WS_COS = 8 * MiB, WS_SIN = 12 * MiB;
constexpr size_t WS_WIN = 16 * MiB, WS_WG = 57 * MiB, WS_WBR = 81 * MiB, WS_WOUT = 93 * MiB;
constexpr size_t WS_XB = 112 * MiB, WS_VF = 176 * MiB, WS_PROJ = 208 * MiB;
constexpr size_t WS_RW_R = 536 * MiB, WS_RW_K = 568 * MiB, WS_RW_V = 600 * MiB, WS_RW_KK = 632 * MiB, WS_RW_B = 664 * MiB, WS_RW_W = 696 * MiB, WS_RW_G = 760 * MiB;
constexpr size_t WS_YRW = 800 * MiB, WS_YNSA = 832 * MiB, WS_YRET = 864 * MiB;
constexpr size_t WS_RWP = 896 * MiB, WS_RWU = 912 * MiB, WS_RWS = 928 * MiB, WS_RETKV = 944 * MiB, WS_KFS = 1008 * MiB, WS_VFS = 1016 * MiB, WS_KFW = 1024 * MiB, WS_VFW = 1032 * MiB, WS_END = 1040 * MiB;
constexpr size_t WS_GATES = 536 * MiB, WS_MERGED = 728 * MiB;
constexpr size_t WS_WGU = 208 * MiB, WS_WDN = 336 * MiB, WS_XS = 400 * MiB, WS_H = 560 * MiB, WS_YS = 600 * MiB;
static_assert(WS_PROJ + (size_t)T * LDP * 2 <= WS_RW_R && WS_GATES + (size_t)T * NG * 2 <= WS_MERGED && WS_MERGED + (size_t)T * D * 2 <= WS_YRW, "ws map");
static_assert(WS_XS + (size_t)160 * 256 * D * 2 <= WS_H && WS_H + (size_t)160 * 256 * FF * 2 <= WS_YS && WS_YS + (size_t)160 * 256 * D * 2 <= WS_RW_G, "ws map moe");
constexpr int CW_TMO = 0, CW_CNT = 1024, CW_CUR = 1088, CW_BAR = 4096;
constexpr int LDS_BYTES = 147456, LDS_BARW = LDS_BYTES - 64;

#define GAS __attribute__((address_space(1)))
#define LAS __attribute__((address_space(3)))
typedef unsigned short bf16;
typedef float f32x4 __attribute__((ext_vector_type(4)));
typedef unsigned u32x4 __attribute__((ext_vector_type(4)));
#define LDS_WAIT() asm volatile("s_waitcnt lgkmcnt(0)" ::: "memory")
#define VM_WAIT() asm volatile("s_waitcnt vmcnt(0)" ::: "memory")

__device__ __forceinline__ float bf2f(unsigned short b) { return __uint_as_float(((unsigned)b) << 16); }
__device__ __forceinline__ unsigned f2bf(float f) { unsigned u = __float_as_uint(f); return (u + 0x7fffu + ((u >> 16) & 1u)) >> 16; }
__device__ __forceinline__ unsigned pk2(float lo, float hi) { return f2bf(lo) | (f2bf(hi) << 16); }
__device__ __forceinline__ float bflo(unsigned w) { return __uint_as_float(w << 16); }
__device__ __forceinline__ float bfhi(unsigned w) { return __uint_as_float(w & 0xffff0000u); }
__device__ __forceinline__ float wave_sum(float v) {
#pragma unroll
    for (int o = 1; o < 64; o <<= 1) v += __shfl_xor(v, o);
    return v;
}
__device__ __forceinline__ float wave_max(float v) {
#pragma unroll
    for (int o = 1; o < 64; o <<= 1) v = fmaxf(v, __shfl_xor(v, o));
    return v;
}
__device__ __forceinline__ int wave_min_i(int v) {
#pragma unroll
    for (int o = 1; o < 64; o <<= 1) { const int w = __shfl_xor(v, o); v = w < v ? w : v; }
    return v;
}
__device__ __forceinline__ float sigm(float x) { return 1.f / (1.f + expf(-x)); }
__device__ __forceinline__ float sigm_fast(float x) { return __builtin_amdgcn_rcpf(1.f + __builtin_amdgcn_exp2f(-1.4426950408889634f * x)); }

__device__ const double INV_FREQ[64] = {1.00000000000000000e+00, 8.63988449483968579e-01, 7.46476040841712152e-01, 6.44946677103762411e-01, 5.57226479550717357e-01, 4.81437242078434580e-01, 4.15956216307184767e-01, 3.59381366380462752e-01, 3.10501349512486036e-01, 2.68269579527972590e-01, 2.31781818060089240e-01, 2.00256813604311801e-01, 1.73019573884589412e-01, 1.49486913370923374e-01, 1.29154966501488389e-01, 1.11588399250774864e-01, 9.64110880490750138e-02, 8.32980664765826800e-02, 7.19685673001152076e-02, 6.21800108732091794e-02, 5.37228111832403141e-02, 4.64158883361278016e-02, 4.01027913949520837e-02, 3.46483485573036779e-02, 2.99357729472049007e-02, 2.58641620527596990e-02, 2.23463372691659473e-02, 1.93069772888325060e-02, 1.66810053720005923e-02, 1.44121959671885402e-02, 1.24519708473503302e-02, 1.07583589854217902e-02, 9.29509789880649494e-03, 8.03085722139152032e-03, 6.93856787873718770e-03, 5.99484250318940964e-03, 5.17947467923121282e-03, 4.47500629725045354e-03, 3.86635375219241198e-03, 3.34048498351324471e-03, 2.88614044143008968e-03, 2.49359200498416086e-03, 2.15443469003188427e-03, 1.86140668735512152e-03, 1.60823387766704205e-03, 1.38949549437313892e-03, 1.20050805774840792e-03, 1.03722509540705695e-03, 8.96150501946605012e-04, 7.74263682681127744e-04, 6.68954878691414585e-04, 5.77969288415331340e-04, 4.99358789347314927e-04, 4.31440226144378508e-04, 3.72759372031494166e-04, 3.22059791872108224e-04, 2.78255940220712632e-04, 2.40409918350997456e-04, 2.07711392596645640e-04, 1.79460244029731636e-04, 1.55051577983262559e-04, 1.33962772451801717e-04, 1.15742288059205792e-04, 1.00000000000000005e-04};
__device__ const float RET_LOGG[8] = {-0.0317486983145803f, -0.015748356968139168f, -0.007843177461025893f, -0.003913899321136329f, -0.0019550348358033506f, -0.0009770396478266127f, -0.0004884004981088745f, -0.0002441704321739145f};

#define XB_TMO      128
#define XB_XCNT(j)  (256  + 64 * (j))
#define XB_XSUB(j)  (1280 + 64 * (j))
#define XB_XGEN(j)  (2304 + 64 * (j))
#define XB_TOP      3328
#define XB_TOPGEN   3392
#define XCD_BAR_WORDS 3456
#define XB_SPIN_CAP (1u << 18)

__device__ __forceinline__ unsigned xb_ld(unsigned* p)              { return __hip_atomic_load(p, __ATOMIC_RELAXED, __HIP_MEMORY_SCOPE_AGENT); }
__device__ __forceinline__ unsigned xb_add(unsigned* p, unsigned v) { return __hip_atomic_fetch_add(p, v, __ATOMIC_RELAXED, __HIP_MEMORY_SCOPE_AGENT); }
__device__ __forceinline__ unsigned xb_xcc_id() { return (unsigned)__builtin_amdgcn_s_getreg((3 << 11) | 20) & 0xFu; }
#define XB_SPIN(cond, bar) do { unsigned _sp = 0; while (cond) { __builtin_amdgcn_s_sleep(1); \
    if ((++_sp & 255u) == 0u) { if (xb_ld(&(bar)[XB_TMO])) break; if (_sp > XB_SPIN_CAP) { atomicAdd(&(bar)[XB_TMO], 1u); break; } } } } while (0)

struct XcdBarrier {
    unsigned* bar; unsigned x;
    volatile LAS unsigned* st;
};
__device__ __forceinline__ XcdBarrier xcd_barrier_post(unsigned* bar, volatile LAS unsigned* st) {
    XcdBarrier b; b.bar = bar; b.x = xb_xcc_id(); b.st = st;
    if (threadIdx.x == 0) (void)xb_add(&bar[XB_XCNT(b.x)], 1u);
    return b;
}
__device__ __forceinline__ void xcd_barrier_complete(unsigned* bar, unsigned x, unsigned& nloc, unsigned& nx) {
    const unsigned G = gridDim.x * gridDim.y * gridDim.z;
    unsigned sum, cnt, mine, sp = 0u;
    for (;;) {
        sum = 0u; cnt = 0u; mine = 0u;
#pragma unroll
        for (unsigned j = 0; j < 16; ++j) { const unsigned c = xb_ld(&bar[XB_XCNT(j)]); sum += c; cnt += (c > 0u) ? 1u : 0u; mine = (j == x) ? c : mine; }
        if (sum == G) break;
        __builtin_amdgcn_s_sleep(1);
        if ((++sp & 255u) == 0u) { if (xb_ld(&bar[XB_TMO])) break; if (sp > XB_SPIN_CAP) { atomicAdd(&bar[XB_TMO], 1u); break; } }
    }
    nloc = mine > 0u ? mine : 1u; nx = cnt > 0u ? cnt : 1u;
}
__device__ __forceinline__ void xcd_barrier(const XcdBarrier& b) {
    asm volatile("s_waitcnt vmcnt(0)" ::: "memory");
    __syncthreads();
    if (threadIdx.x == 0) {
        unsigned* bar = b.bar;
        __builtin_amdgcn_s_waitcnt(0);
        unsigned nloc = b.st[0], nx = b.st[1];
        if (nloc == 0u) { xcd_barrier_complete(bar, b.x, nloc, nx); b.st[0] = nloc; b.st[1] = nx; }
        const unsigned old = xb_add(&bar[XB_XSUB(b.x)], 1u);
        const unsigned gen = old / nloc;
        if (old + 1u == (gen + 1u) * nloc) {
            __builtin_amdgcn_fence(__ATOMIC_RELEASE, "agent");
            asm volatile("s_waitcnt vmcnt(0)" ::: "memory");
            const unsigned og = xb_add(&bar[XB_TOP], 1u);
            const unsigned tg = og / nx;
            if (og + 1u == (tg + 1u) * nx) xb_add(&bar[XB_TOPGEN], 1u);
            else XB_SPIN(xb_ld(&bar[XB_TOPGEN]) == tg, bar);
            __builtin_amdgcn_fence(__ATOMIC_ACQUIRE, "agent");
            xb_add(&bar[XB_XGEN(b.x)], 1u);
            asm volatile("s_waitcnt vmcnt(0)" ::: "memory");
        } else {
            XB_SPIN(xb_ld(&bar[XB_XGEN(b.x)]) == gen, bar);
            __builtin_amdgcn_fence(__ATOMIC_ACQUIRE, "agent");
            asm volatile("s_waitcnt vmcnt(0)" ::: "memory");
        }
    }
    __syncthreads();
}

#if defined(__HIP_DEVICE_COMPILE__)
#define ASSUME_GLOBAL(p) do { __builtin_assume(!__builtin_amdgcn_is_shared((const __attribute__((address_space(0))) void*)(p))); __builtin_assume(!__builtin_amdgcn_is_private((const __attribute__((address_space(0))) void*)(p))); } while (0)
#else
#define ASSUME_GLOBAL(p) do { } while (0)
#endif
struct Args { const float* in[36]; float* out; unsigned char* ws; int ph_lo, ph_hi; };
constexpr int LDS_PTAB = LDS_BYTES - 512;
struct PA { unsigned char* ws; float* out; const LAS unsigned* tab;
    __device__ __forceinline__ const float* in(int i) const { const unsigned lo = __builtin_amdgcn_readfirstlane(tab[2 * i]), hi = __builtin_amdgcn_readfirstlane(tab[2 * i + 1]);
        return (const float*)(const GAS float*)(((unsigned long long)hi << 32) | lo); } };

using pg8::Unit; using pg8::Gemm; using pg8::TileOrder;
struct SchedPlain {
    TileOrder to; int G, c, tid; const char* A; const char* B; size_t ta, tb;
    __device__ __forceinline__ bool next(int i, Unit& u) const {
        if (!to.tile((long)i * G + c, u.pm, u.pn)) return false;
        u.a = A + (size_t)u.pm * ta; u.b = B + (size_t)u.pn * tb; u.aux = 0; return true; }
};
struct SchedBranch {
    TileOrder to; int G, c, tid; const char* A0; const char* B0; size_t sa, sb, ta, tb;
    __device__ __forceinline__ bool next(int i, Unit& u) const {
        const int br = i % 3;
        if (!to.tile((long)(i / 3) * G + c, u.pm, u.pn)) return false;
        u.a = A0 + (size_t)br * sa + (size_t)u.pm * ta; u.b = B0 + (size_t)br * sb + (size_t)u.pn * tb; u.aux = br; return true; }
};
struct SchedMoe {
    int nM, nN, G, c, tid; const char* A; const char* B; size_t ta, tb, te; const int* texp;
    __device__ __forceinline__ bool next(int i, Unit& u) const {
        const long L = (long)i * G + c; if (L >= (long)nM * nN) return false;
        u.pm = (int)(L % nM); u.pn = (int)(L / nM); const int e = texp[u.pm];
        u.a = A + (size_t)u.pm * ta; u.b = B + (size_t)e * te + (size_t)u.pn * tb; u.aux = e; return true; }
};
template <int ACT  > struct EpiStore {
    static constexpr bool PERM = true;
    bf16* O; int ldc;
    __device__ __forceinline__ void operator()(const f32x4 (&acc)[2][2][4][2], const Unit& u, int wr, int wc, int fr, int fq) const {
        const int row0 = u.pm * 256 + wr * 64 + fr, col0 = u.pn * 256 + wc * 32 + 8 * fq;
#pragma unroll
        for (int ai = 0; ai < 2; ++ai)
#pragma unroll
            for (int m = 0; m < 4; ++m) { bf16* rowp = O + (size_t)(row0 + ai * 128 + m * 16) * ldc + col0;
#pragma unroll
                for (int bj = 0; bj < 2; ++bj) { f32x4 v0 = acc[ai][bj][m][0], v1 = acc[ai][bj][m][1];
                    if (ACT == 1) {
#pragma unroll
                        for (int j = 0; j < 4; ++j) { v0[j] = sigm_fast(v0[j]); v1[j] = sigm_fast(v1[j]); } }
                    u32x4 w; w.x = pg8::cvt_pk_bf16(v0[0], v0[1]); w.y = pg8::cvt_pk_bf16(v0[2], v0[3]); w.z = pg8::cvt_pk_bf16(v1[0], v1[1]); w.w = pg8::cvt_pk_bf16(v1[2], v1[3]);
                    *(u32x4*)(rowp + bj * 128) = w; __builtin_amdgcn_sched_barrier(0); } }
    }
};
struct EpiBranch {
    static constexpr bool PERM = true;
    bf16* Mg; const bf16* Gt;
    __device__ __forceinline__ void operator()(const f32x4 (&acc)[2][2][4][2], const Unit& u, int wr, int wc, int fr, int fq) const {
        const int row0 = u.pm * 256 + wr * 64 + fr, col0 = u.pn * 256 + wc * 32 + 8 * fq, br = u.aux;
#pragma unroll
        for (int ai = 0; ai < 2; ++ai)
#pragma unroll
            for (int m = 0; m < 4; ++m) { const size_t r = (size_t)(row0 + ai * 128 + m * 16);
#pragma unroll
                for (int bj = 0; bj < 2; ++bj) { const int col = col0 + bj * 128;
                    const u32x4 gw = *(const u32x4*)(Gt + r * NG + br * 2048 + col);
                    f32x4 v0 = acc[ai][bj][m][0], v1 = acc[ai][bj][m][1];
                    v0[0] *= bflo(gw.x); v0[1] *= bfhi(gw.x); v0[2] *= bflo(gw.y); v0[3] *= bfhi(gw.y); v1[0] *= bflo(gw.z); v1[1] *= bfhi(gw.z); v1[2] *= bflo(gw.w); v1[3] *= bfhi(gw.w);
                    bf16* mp = Mg + r * D + col;
                    if (br != 0) { const u32x4 ow = *(const u32x4*)mp;
                        v0[0] += bflo(ow.x); v0[1] += bfhi(ow.x); v0[2] += bflo(ow.y); v0[3] += bfhi(ow.y); v1[0] += bflo(ow.z); v1[1] += bfhi(ow.z); v1[2] += bflo(ow.w); v1[3] += bfhi(ow.w); }
                    u32x4 w; w.x = pg8::cvt_pk_bf16(v0[0], v0[1]); w.y = pg8::cvt_pk_bf16(v0[2], v0[3]); w.z = pg8::cvt_pk_bf16(v1[0], v1[1]); w.w = pg8::cvt_pk_bf16(v1[2], v1[3]);
                    *(u32x4*)mp = w; __builtin_amdgcn_sched_barrier(0); } }
    }
};
struct EpiResid {
    static constexpr bool PERM = true;
    float* X;
    __device__ __forceinline__ void operator()(const f32x4 (&acc)[2][2][4][2], const Unit& u, int wr, int wc, int fr, int fq) const {
        const int row0 = u.pm * 256 + wr * 64 + fr, col0 = u.pn * 256 + wc * 32 + 8 * fq;
#pragma unroll
        for (int ai = 0; ai < 2; ++ai)
#pragma unroll
            for (int m = 0; m < 4; ++m) { float* rowp = X + (size_t)(row0 + ai * 128 + m * 16) * D + col0;
#pragma unroll
                for (int bj = 0; bj < 2; ++bj) { f32x4* p = (f32x4*)(rowp + bj * 128);
                    const f32x4 x0 = p[0], x1 = p[1];
                    p[0] = x0 * DN_ALPHA + acc[ai][bj][m][0]; p[1] = x1 * DN_ALPHA + acc[ai][bj][m][1]; __builtin_amdgcn_sched_barrier(0); } }
    }
};
struct EpiGateUp {
    static constexpr bool PERM = true;
    bf16* H;
    __device__ __forceinline__ void operator()(const f32x4 (&acc)[2][2][4][2], const Unit& u, int wr, int wc, int fr, int fq) const {
        const int row0 = u.pm * 256 + wr * 64 + fr, col0 = u.pn * 128 + wc * 32 + 8 * fq;
#pragma unroll
        for (int ai = 0; ai < 2; ++ai)
#pragma unroll
            for (int m = 0; m < 4; ++m) { bf16* rowp = H + (size_t)(row0 + ai * 128 + m * 16) * FF + col0;
                f32x4 h0, h1;
#pragma unroll
                for (int j = 0; j < 4; ++j) { const float g0 = acc[ai][0][m][0][j], g1 = acc[ai][0][m][1][j];
                    h0[j] = g0 * sigm_fast(g0) * acc[ai][1][m][0][j]; h1[j] = g1 * sigm_fast(g1) * acc[ai][1][m][1][j]; }
                u32x4 w; w.x = pg8::cvt_pk_bf16(h0[0], h0[1]); w.y = pg8::cvt_pk_bf16(h0[2], h0[3]); w.z = pg8::cvt_pk_bf16(h1[0], h1[1]); w.w = pg8::cvt_pk_bf16(h1[2], h1[3]);
                *(u32x4*)rowp = w; }
    }
};

struct Ctx { LAS unsigned char* lds; int tid, lane, wave, G, bx, gw, NGW; };

template <class SRC>
__device__ __forceinline__ void transpose_task(const Ctx& c, const SRC& src, int ldsrc, int K, bf16* dst, int ndst) {
    LAS float* scr = (LAS float*)(c.lds + c.wave * 8704);
    const int nblk = ndst / 32, items = (K / 64) * nblk, lane = c.lane;
    for (int it = c.gw; it < items; it += c.NGW) {
        const int kb = it / nblk, nb = it % nblk, k0 = 64 * kb, n0 = 32 * nb;
        const float* sp = src(n0 + (lane & 31));
#pragma unroll 8
        for (int i = 0; i < 32; ++i) { const int kk = 2 * i + (lane >> 5); scr[kk * 33 + (lane & 31)] = sp ? sp[(size_t)(k0 + kk) * ldsrc] : 0.f; }
        LDS_WAIT();
        const int cc = lane & 7;
#pragma unroll
        for (int j = 0; j < 4; ++j) { const int n = (lane >> 3) + 8 * j; const LAS float* s = scr + (8 * cc) * 33 + n;
            u32x4 o; o.x = pk2(s[0 * 33], s[1 * 33]); o.y = pk2(s[2 * 33], s[3 * 33]); o.z = pk2(s[4 * 33], s[5 * 33]); o.w = pk2(s[6 * 33], s[7 * 33]);
            *(u32x4*)(dst + (size_t)(n0 + n) * K + k0 + 8 * cc) = o; }
        LDS_WAIT();
    }
}
struct SrcWin { const float* W; int layer;
    __device__ __forceinline__ const float* operator()(int n) const {
        const int rw = layer ? 3584 : 3520; int sc;
        if (n < 3072) sc = n; else if (n < 5632) sc = rw + (n - 3072); else if (n < 9728) sc = rw + 2608 + (n - 5632); else if (n < 10176) sc = 3072 + (n - 9728);
        else if (n < 10240) sc = layer ? 3520 + (n - 10176) : -1; else if (n < 10288) sc = rw + 2560 + (n - 10240); else sc = -1;
        return sc >= 0 ? W + sc : nullptr; } };
struct SrcOff { const float* W; __device__ __forceinline__ const float* operator()(int n) const { return W + n; } };
struct SrcGU { const float* Wg; const float* Wu;
    __device__ __forceinline__ const float* operator()(int nn) const { const int e = nn >> 10, r1 = nn & 1023, pn = r1 >> 8, rr = r1 & 255;
        const size_t du = (size_t)((const char*)Wu - (const char*)Wg);
        return (const float*)((const char*)Wg + (rr < 128 ? (size_t)0 : du)) + (size_t)e * D * FF + 128 * pn + (rr & 127); } };
struct SrcDN { const float* Wd;
    __device__ __forceinline__ const float* operator()(int nn) const { const int e = nn >> 11, n = nn & 2047; return Wd + (size_t)e * FF * D + n; } };

__device__ __forceinline__ void ph_conv(const Ctx& c, const PA& a, int layer) {
    unsigned char* ws = a.ws;
    const float* Win = layer ? a.in(2) : a.in(1); const int ldw = layer ? 16432 : 16368, rw = layer ? 3584 : 3520;
    transpose_task(c, SrcWin{Win, layer}, ldw, D, (bf16*)(ws + WS_WIN), LDP);
    transpose_task(c, SrcOff{Win + rw + 2608 + 4096}, ldw, D, (bf16*)(ws + WS_WG), NG);
    transpose_task(c, SrcOff{a.in(21) + (size_t)layer * RWW * D}, D, RWW, (bf16*)(ws + WS_WBR), D);
    transpose_task(c, SrcOff{a.in(22) + (size_t)layer * RWW * D}, D, RWW, (bf16*)(ws + WS_WBR) + (size_t)D * RWW, D);
    transpose_task(c, SrcOff{a.in(23) + (size_t)layer * RWW * D}, D, RWW, (bf16*)(ws + WS_WBR) + (size_t)2 * D * RWW, D);
    transpose_task(c, SrcOff{a.in(24) + (size_t)layer * D * D}, D, D, (bf16*)(ws + WS_WOUT), D);
    if (layer == 0) {
        const f32x4* x4 = (const f32x4*)a.in(0); f32x4* o4 = (f32x4*)a.out; uint2* xb = (uint2*)(ws + WS_XB);
        for (size_t i = (size_t)c.bx * 512 + c.tid; i < (size_t)T * D / 4; i += (size_t)c.G * 512) { const f32x4 v = x4[i]; o4[i] = v; xb[i] = make_uint2(pk2(v[0], v[1]), pk2(v[2], v[3])); }
        float* cs = (float*)(ws + WS_COS); float* sn = (float*)(ws + WS_SIN);
        for (int i = c.bx * 512 + c.tid; i < T * 64; i += c.G * 512) { const int t = i >> 6, j = i & 63;
            const double rev = (double)t * INV_FREQ[j] * 0.15915494309189533577; const float fr = (float)(rev - __builtin_rint(rev));
            cs[i] = __builtin_amdgcn_cosf(fr); sn[i] = __builtin_amdgcn_sinf(fr); }
    }
}
__device__ __forceinline__ void ph_conv_moe(const Ctx& c, const PA& a, int layer) {
    unsigned char* ws = a.ws; const size_t lo = (size_t)layer * NEXP * D * FF;
    transpose_task(c, SrcGU{a.in(31) + lo, a.in(32) + lo}, FF, D, (bf16*)(ws + WS_WGU), NEXP * 1024);
    transpose_task(c, SrcDN{a.in(33) + lo}, D, FF, (bf16*)(ws + WS_WDN), NEXP * D);
}

__device__ __forceinline__ float softplusf_(float x) { return fmaxf(x, 0.f) + log1pf(expf(-fabsf(x))); }
__device__ __forceinline__ void prep_rwkv(const Ctx& c, const PA& a, int layer) {
    unsigned char* ws = a.ws; const bf16* proj = (const bf16*)(ws + WS_PROJ);
    LAS float* sh_r = (LAS float*)c.lds; LAS float* sh_k = sh_r + 8 * 1024; LAS float* sh_v = sh_k + 8 * 1024; LAS float* sh_x = sh_v + 8 * 1024;
    bf16* oR = (bf16*)(ws + WS_RW_R); bf16* oK = (bf16*)(ws + WS_RW_K); bf16* oV = (bf16*)(ws + WS_RW_V); bf16* oKK = (bf16*)(ws + WS_RW_KK); bf16* oB = (bf16*)(ws + WS_RW_B);
    float* oW = (float*)(ws + WS_RW_W); bf16* oG = (bf16*)(ws + WS_RW_G); bf16* VF = (bf16*)(ws + WS_VF); float* rkb = (float*)(ws + WS_RKB);
    const int lane = c.lane, w = c.wave, tid = c.tid;
    for (int it = c.bx; it < T / 8; it += c.G) {
        const int t = it * 8 + w;
        const bf16* prow = proj + (size_t)t * LDP; const bf16* pprev = prow - LDP;
        const float* mu = a.in(layer ? 4 : 3);
#pragma unroll
        for (int i = 0; i < 6; ++i) { const int c8 = (lane + 64 * i) * 8;
            const u32x4 p = *(const u32x4*)(prow + c8); u32x4 q = (u32x4){0u, 0u, 0u, 0u}; if (t > 0) q = *(const u32x4*)(pprev + c8);
            const f32x4 m0 = *(const f32x4*)(mu + c8), m1 = *(const f32x4*)(mu + c8 + 4);
            float pv[8] = {bflo(p.x), bfhi(p.x), bflo(p.y), bfhi(p.y), bflo(p.z), bfhi(p.z), bflo(p.w), bfhi(p.w)};
            float qv[8] = {bflo(q.x), bfhi(q.x), bflo(q.y), bfhi(q.y), bflo(q.z), bfhi(q.z), bflo(q.w), bfhi(q.w)};
            LAS float* dstp = (c8 < 1024 ? sh_r + w * 1024 + c8 : (c8 < 2048 ? sh_k + w * 1024 + (c8 - 1024) : sh_v + w * 1024 + (c8 - 2048)));
#pragma unroll
            for (int j = 0; j < 8; ++j) { const float mm = j < 4 ? m0[j] : m1[j - 4]; dstp[j] = pv[j] + (qv[j] - pv[j]) * mm; } }
        { const int i8 = lane * 8; int sc, mi, fn;
            if (i8 < 96) { sc = PC_XW + i8; mi = 3072 + i8; fn = 1; } else if (i8 < 192) { sc = PC_XA + (i8 - 96); mi = 3168 + (i8 - 96); fn = 0; }
            else if (i8 < 448) { sc = PC_XG + (i8 - 192); mi = 3264 + (i8 - 192); fn = 2; } else { sc = PC_XV + (i8 - 448); mi = 3520 + (i8 - 448); fn = layer ? 0 : 3; }
            const u32x4 p = *(const u32x4*)(prow + sc); u32x4 q = (u32x4){0u, 0u, 0u, 0u}; if (t > 0) q = *(const u32x4*)(pprev + sc);
            float pv[8] = {bflo(p.x), bfhi(p.x), bflo(p.y), bfhi(p.y), bflo(p.z), bfhi(p.z), bflo(p.w), bfhi(p.w)};
            float qv[8] = {bflo(q.x), bfhi(q.x), bflo(q.y), bfhi(q.y), bflo(q.z), bfhi(q.z), bflo(q.w), bfhi(q.w)};
#pragma unroll
            for (int j = 0; j < 8; ++j) { float s = 0.f;
                if (fn != 3) { const float mm = mu[mi + j]; s = pv[j] + (qv[j] - pv[j]) * mm; if (fn == 1) s = tanhf(s); else if (fn == 2) s = sigm(s); }
                sh_x[w * 512 + i8 + j] = s; } }
        __syncthreads();
        float sw[8][2], sa[8][2], sg[8][2], sv[8][2];
#pragma unroll
        for (int k = 0; k < 8; ++k) { sw[k][0] = sw[k][1] = sa[k][0] = sa[k][1] = sg[k][0] = sg[k][1] = sv[k][0] = sv[k][1] = 0.f; }
        { const float* w_up = a.in(6) + (size_t)layer * 96 * 1024; const float* a_up = a.in(8) + (size_t)layer * 96 * 1024;
        for (int k = 0; k < 96; ++k) { const float u0 = w_up[k * 1024 + tid], u1 = w_up[k * 1024 + tid + 512], b0 = a_up[k * 1024 + tid], b1 = a_up[k * 1024 + tid + 512];
#pragma unroll
            for (int tk = 0; tk < 8; ++tk) { const float x = sh_x[tk * 512 + k], y = sh_x[tk * 512 + 96 + k]; sw[tk][0] += x * u0; sw[tk][1] += x * u1; sa[tk][0] += y * b0; sa[tk][1] += y * b1; } } }
        { const float* g_up = a.in(11) + (size_t)layer * 256 * 1024;
        for (int k = 0; k < 256; ++k) { const float u0 = g_up[k * 1024 + tid], u1 = g_up[k * 1024 + tid + 512];
#pragma unroll
            for (int tk = 0; tk < 8; ++tk) { const float x = sh_x[tk * 512 + 192 + k]; sg[tk][0] += x * u0; sg[tk][1] += x * u1; } } }
        if (layer) { const float* v_up = a.in(10);
        for (int k = 0; k < 64; ++k) { const float u0 = v_up[k * 1024 + tid], u1 = v_up[k * 1024 + tid + 512];
#pragma unroll
            for (int tk = 0; tk < 8; ++tk) { const float x = sh_x[tk * 512 + 448 + k]; sv[tk][0] += x * u0; sv[tk][1] += x * u1; } } }
#pragma unroll
        for (int ci = 0; ci < 2; ++ci) { const int col = tid + 512 * ci, head = w + 8 * ci;
            const float kkc = a.in(12)[layer * 1024 + col], kac = a.in(13)[layer * 1024 + col], rkc = a.in(14)[layer * 1024 + col], w0c = a.in(5)[layer * 1024 + col], a0c = a.in(7)[layer * 1024 + col], v0c = layer ? a.in(9)[col] : 0.f;
#pragma unroll
            for (int tk = 0; tk < 8; ++tk) { const int tt = it * 8 + tk; const size_t o = (size_t)tt * 1024 + col;
                const float k0 = sh_k[tk * 1024 + col], r = sh_r[tk * 1024 + col], v0 = sh_v[tk * 1024 + col];
                const float kkraw = k0 * kkc, n2 = wave_sum(kkraw * kkraw), kkn = kkraw / fmaxf(sqrtf(n2), 1e-12f);
                const float aa = sigm(a0c + sa[tk][ci]), bb = kkn * aa, kf = k0 * (1.f + (aa - 1.f) * kac);
                const float z = w0c + sw[tk][ci], wl = -softplusf_(-z) - 0.5f, dec = expf(-expf(wl));
                float vv = v0;
                if (layer) { const float vf = bf2f(VF[o]); vv = v0 + (vf - v0) * sigm(v0c + sv[tk][ci]); } else VF[o] = (bf16)f2bf(v0);
                const float rk = wave_sum(r * kf * rkc);
                if (lane == 0) rkb[tt * 16 + head] = rk;
                oR[o] = (bf16)f2bf(r); oK[o] = (bf16)f2bf(kf); oV[o] = (bf16)f2bf(vv); oKK[o] = (bf16)f2bf(kkn); oB[o] = (bf16)f2bf(bb); oW[o] = dec; oG[o] = (bf16)f2bf(sg[tk][ci]); } }
        __syncthreads();
    }
}
__device__ __forceinline__ float gelu_tanh(float x) { return 0.5f * x * (1.f + tanhf(0.7978845608028654f * (x + 0.044715f * x * x * x))); }
__device__ __forceinline__ void prep_cmp(const Ctx& c, const PA& a, int layer) {
    unsigned char* ws = a.ws; const bf16* proj = (const bf16*)(ws + WS_PROJ);
    LAS float* sh_in = (LAS float*)c.lds; LAS float* sh_h = sh_in + 4 * 2048;
    const int tid = c.tid;
    for (int it = c.bx; it < NCMP * 2; it += c.G) {
        const int cb = it >> 1, kv = it & 1, col0 = kv ? PC_VC : PC_KC, lk = layer * 2 + kv;
        const float* pe = a.in(17) + (size_t)lk * 2048; const float* w1 = a.in(18) + (size_t)lk * 2048 * 128; const float* b1 = a.in(19) + lk * 128; const float* w2 = a.in(20) + (size_t)lk * 128 * 64;
        for (int idx = tid; idx < 8192; idx += 512) { const int g = idx >> 11, r = idx & 2047, l = r >> 6, d = r & 63;
            sh_in[idx] = bf2f(proj[(size_t)(16 * cb + l) * LDP + col0 + g * 64 + d]) + pe[r]; }
        __syncthreads();
        { const int g = tid >> 7, j = tid & 127; float acc = b1[j]; const LAS float* in = sh_in + g * 2048;
#pragma unroll 8
            for (int i = 0; i < 2048; ++i) acc += in[i] * w1[i * 128 + j];
            sh_h[tid] = gelu_tanh(acc); }
        __syncthreads();
        if (tid < 256) { const int g = tid >> 6, d = tid & 63; float o = 0.f;
#pragma unroll 8
            for (int j = 0; j < 128; ++j) o += sh_h[g * 128 + j] * w2[j * 64 + d];
            { const int blk = cb >> 6, kc = cb & 63;
                if (kv == 0) { const int j = kc >> 4, rr = kc & 15, ks = d >> 5, qq = (d & 31) >> 3, i = d & 7;
                    ((bf16*)(ws + WS_KCMPB))[((((size_t)g * 16 + blk) * 8 + 2 * j + ks) * 64 + qq * 16 + rr) * 8 + i] = (bf16)f2bf(o);
                    if (cb == 0) ((bf16*)(ws + WS_KCMPB))[((((size_t)g * 16 + 15) * 8 + 2 * 3 + ks) * 64 + qq * 16 + 15) * 8 + i] = 0; }
                else { const int ks = kc >> 5, kk = kc & 31, hh = kk >> 4, qq = (kk & 15) >> 2, i = (kk & 3) + 4 * hh, mt = d >> 4, rr = d & 15;
                    ((bf16*)(ws + WS_VCMPT))[((((size_t)g * 16 + blk) * 8 + 2 * mt + ks) * 64 + qq * 16 + rr) * 8 + i] = (bf16)f2bf(o);
                    if (cb == 0) ((bf16*)(ws + WS_VCMPT))[((((size_t)g * 16 + 15) * 8 + 2 * mt + 1) * 64 + 3 * 16 + rr) * 8 + 7] = 0; } } }
        __syncthreads();
    }
}
__device__ __forceinline__ void prep_rope(const Ctx& c, const PA& a) {
    unsigned char* ws = a.ws; bf16* proj = (bf16*)(ws + WS_PROJ); const float* cs = (const float*)(ws + WS_COS); const float* sn = (const float*)(ws + WS_SIN);
    for (int i = c.bx * 512 + c.tid; i < T * 8 * 64; i += c.G * 512) { const int j = i & 63, h = (i >> 6) & 7, t = i >> 9;
        const float co = cs[t * 64 + j], si = sn[t * 64 + j];
        bf16* q = proj + (size_t)t * LDP + PC_RQ + h * 128 + j; bf16* k = proj + (size_t)t * LDP + PC_RK + h * 128 + j;
        const float q1 = bf2f(q[0]), q2 = bf2f(q[64]), k1 = bf2f(k[0]), k2 = bf2f(k[64]);
        q[0] = (bf16)f2bf(q1 * co - q2 * si); q[64] = (bf16)f2bf(q1 * si + q2 * co);
        k[0] = (bf16)f2bf((k1 * co - k2 * si) * 0.08838834764831845f); k[64] = (bf16)f2bf((k1 * si + k2 * co) * 0.08838834764831845f); }
}

constexpr int RW_NC = 64, RW_CL = 256, RW_TS = 8;
__device__ __forceinline__ void rw_stage(const unsigned char* ws, LAS float* tile, int t0, int h, int lane, bool need_r) {
    const unsigned e0 = (unsigned)(t0 * 1024 + h * 64 + lane);
#pragma unroll
    for (int s = 0; s < RW_TS; ++s) { const unsigned e = e0 + (unsigned)s * 1024u; LAS float* tp = tile + s * 384 + lane;
        tp[0] = bf2f(*(const bf16*)(ws + ((unsigned)WS_RW_KK + e * 2u))); tp[64] = bf2f(*(const bf16*)(ws + ((unsigned)WS_RW_B + e * 2u))); tp[128] = *(const float*)(ws + ((unsigned)WS_RW_W + e * 4u));
        tp[192] = bf2f(*(const bf16*)(ws + ((unsigned)WS_RW_K + e * 2u))); tp[256] = need_r ? bf2f(*(const bf16*)(ws + ((unsigned)WS_RW_R + e * 2u))) : 0.f; tp[320] = bf2f(*(const bf16*)(ws + ((unsigned)WS_RW_V + e * 2u))); }
}
#define RW_STEP_UPDATE(tp, vi) { \
    float s0 = 0.f, s1 = 0.f, s2 = 0.f, s3 = 0.f; \
    _Pragma("unroll") for (int jj = 0; jj < 16; ++jj) { const f32x4 k4 = *(const LAS f32x4*)((tp) + 4 * jj); s0 += S[4 * jj] * k4[0]; s1 += S[4 * jj + 1] * k4[1]; s2 += S[4 * jj + 2] * k4[2]; s3 += S[4 * jj + 3] * k4[3]; } \
    const float sk = (s0 + s1) + (s2 + s3); \
    _Pragma("unroll") for (int jj = 0; jj < 16; ++jj) { const f32x4 b4 = *(const LAS f32x4*)((tp) + 64 + 4 * jj), w4 = *(const LAS f32x4*)((tp) + 128 + 4 * jj), k4 = *(const LAS f32x4*)((tp) + 192 + 4 * jj); \
        _Pragma("unroll") for (int q = 0; q < 4; ++q) S[4 * jj + q] = S[4 * jj + q] * w4[q] + ((vi) * k4[q] - sk * b4[q]); } }

__device__ __forceinline__ void rw_pass1(const Ctx& c, const PA& a) {
    const unsigned char* ws = a.ws; LAS float* tile = (LAS float*)(c.lds + c.wave * (RW_TS * 384 * 4));
    const int lane = c.lane;
    for (int task = c.gw; task < 16 * RW_NC * 2; task += c.NGW) {
        const int kind = task & 1, hc = task >> 1, h = hc / RW_NC, ch = hc % RW_NC;
        float S[64]; int lz = kind ? 64 : lane; asm volatile("" : "+v"(lz));
#pragma unroll
        for (int j = 0; j < 64; ++j) S[j] = (j == lz) ? 1.f : 0.f;
        for (int t0 = ch * RW_CL; t0 < (ch + 1) * RW_CL; t0 += RW_TS) {
            rw_stage(ws, tile, t0, h, lane, false);
            LDS_WAIT();
#pragma unroll 1
            for (int s = 0; s < RW_TS; ++s) { const LAS float* tp = tile + s * 384; const float vi = kind ? tp[320 + lane] : 0.f; RW_STEP_UPDATE(tp, vi); }
            LDS_WAIT();
        }
        float* out = (float*)(a.ws + (kind ? WS_RWU : WS_RWP)) + ((size_t)hc * 64 + lane) * 64;
#pragma unroll
        for (int jj = 0; jj < 16; ++jj) *(f32x4*)(out + 4 * jj) = (f32x4){S[4 * jj], S[4 * jj + 1], S[4 * jj + 2], S[4 * jj + 3]};
    }
}
__device__ __forceinline__ void rw_pass2(const Ctx& c, const PA& a) {
    const float* P = (const float*)(a.ws + WS_RWP); const float* U = (const float*)(a.ws + WS_RWU); float* Si = (float*)(a.ws + WS_RWS);
    const int lane = c.lane;
    for (int task = c.gw; task < 16 * 64; task += c.NGW) { const int h = task >> 6, i = task & 63;
        float s = 0.f;
        for (int ch = 0; ch < RW_NC; ++ch) { const size_t hc = (size_t)h * RW_NC + ch;
            Si[(hc * 64 + i) * 64 + lane] = s;
            float acc = U[(hc * 64 + i) * 64 + lane]; const float* Pc = P + hc * 4096 + lane;
#pragma unroll
            for (int i2 = 0; i2 < 64; ++i2) acc += __shfl(s, i2) * Pc[i2 * 64];
            s = acc; }
    }
}
__device__ __forceinline__ void rw_pass3(const Ctx& c, const PA& a, int layer) {
    const unsigned char* ws = a.ws; LAS float* tile = (LAS float*)(c.lds + c.wave * (RW_TS * 384 * 4));
    const float* Si = (const float*)(ws + WS_RWS); const float* rkb = (const float*)(ws + WS_RKB); const bf16* G = (const bf16*)(ws + WS_RW_G); bf16* Y = (bf16*)(a.ws + WS_YRW);
    const float* lng = a.in(15) + layer * 1024; const float* lnb = a.in(16) + layer * 1024;
    const int lane = c.lane;
    for (int task = c.gw; task < 16 * RW_NC; task += c.NGW) {
        const int h = task / RW_NC, ch = task % RW_NC, col = h * 64 + lane;
        const float lg = lng[col], lb = lnb[col];
        float S[64]; const float* sp = Si + ((size_t)task * 64 + lane) * 64;
#pragma unroll
        for (int jj = 0; jj < 16; ++jj) { const f32x4 v = *(const f32x4*)(sp + 4 * jj); S[4 * jj] = v[0]; S[4 * jj + 1] = v[1]; S[4 * jj + 2] = v[2]; S[4 * jj + 3] = v[3]; }
        for (int t0 = ch * RW_CL; t0 < (ch + 1) * RW_CL; t0 += RW_TS) {
            rw_stage(ws, tile, t0, h, lane, true);
            LDS_WAIT();
#pragma unroll 1
            for (int s = 0; s < RW_TS; ++s) { const LAS float* tp = tile + s * 384; const float vi = tp[320 + lane]; RW_STEP_UPDATE(tp, vi);
                float y0 = 0.f, y1 = 0.f, y2 = 0.f, y3 = 0.f;
#pragma unroll
                for (int jj = 0; jj < 16; ++jj) { const f32x4 r4 = *(const LAS f32x4*)(tp + 256 + 4 * jj); y0 += S[4 * jj] * r4[0]; y1 += S[4 * jj + 1] * r4[1]; y2 += S[4 * jj + 2] * r4[2]; y3 += S[4 * jj + 3] * r4[3]; }
                const float y = (y0 + y1) + (y2 + y3), mean = wave_sum(y) * (1.f / 64.f), dlt = y - mean, var = wave_sum(dlt * dlt) * (1.f / 64.f);
                const float yn = dlt * (1.f / sqrtf(var + 64e-5f)); const int t = t0 + s; const size_t o = (size_t)t * 1024 + col;
                Y[o] = (bf16)f2bf((yn * lg + lb + rkb[t * 16 + h] * vi) * bf2f(G[o])); }
            LDS_WAIT();
        }
    }
}

__device__ __forceinline__ void ret_kv(const Ctx& c, const PA& a) {
    const bf16* proj = (const bf16*)(a.ws + WS_PROJ); float* KV = (float*)(a.ws + WS_RETKV);
    const int dv = c.tid & 127, dkg = c.tid >> 7;
    for (int it = c.bx; it < 128 * 8; it += c.G) { const int ch = it >> 3, h = it & 7; const float lg = RET_LOGG[h];
        float acc[32];
#pragma unroll
        for (int q = 0; q < 32; ++q) acc[q] = 0.f;
        for (int i = 0; i < 128; ++i) { const bf16* row = proj + (size_t)(ch * 128 + i) * LDP;
            const float vv = bf2f(row[PC_RV + h * 128 + dv]) * expf(lg * (float)(127 - i));
            const u32x4* kp = (const u32x4*)(row + PC_RK + h * 128 + 32 * dkg);
#pragma unroll
            for (int q4 = 0; q4 < 4; ++q4) { const u32x4 kw = kp[q4];
                acc[8 * q4 + 0] += bflo(kw.x) * vv; acc[8 * q4 + 1] += bfhi(kw.x) * vv; acc[8 * q4 + 2] += bflo(kw.y) * vv; acc[8 * q4 + 3] += bfhi(kw.y) * vv;
                acc[8 * q4 + 4] += bflo(kw.z) * vv; acc[8 * q4 + 5] += bfhi(kw.z) * vv; acc[8 * q4 + 6] += bflo(kw.w) * vv; acc[8 * q4 + 7] += bfhi(kw.w) * vv; } }
        float* o = KV + ((size_t)it * 128 + 32 * dkg) * 128 + dv;
#pragma unroll
        for (int q = 0; q < 32; ++q) o[q * 128] = acc[q];
    }
}
__device__ __forceinline__ void ret_prefix(const Ctx& c, const PA& a) {
    float* KV = (float*)(a.ws + WS_RETKV);
    for (int i = c.bx * 512 + c.tid; i < 8 * 16384; i += c.G * 512) { const int h = i >> 14, e = i & 16383; const float cd = expf(RET_LOGG[h] * 128.f);
        float r = 0.f;
        for (int ch = 0; ch < 128; ++ch) { float* p = KV + ((size_t)(ch * 8 + h) << 14) + e; const float tmp = *p; *p = r; r = r * cd + tmp; } }
}
__device__ __forceinline__ void ret_out(const Ctx& c, const PA& a) {
    const bf16* proj = (const bf16*)(a.ws + WS_PROJ); const float* KV = (const float*)(a.ws + WS_RETKV); bf16* Y = (bf16*)(a.ws + WS_YRET);
    constexpr int RS = 130;
    LAS bf16* sq = (LAS bf16*)c.lds; LAS bf16* sk = sq + 128 * RS; LAS bf16* sv = sk + 128 * RS; LAS float* att = (LAS float*)(sv + 128 * RS);
    const int tid = c.tid, lane = c.lane, w = c.wave;
    for (int it = c.bx; it < 128 * 8; it += c.G) { const int ch = it >> 3, h = it & 7; const float lg = RET_LOGG[h];
        for (int idx = tid; idx < 128 * 64; idx += 512) { const int i = idx >> 6, d2 = (idx & 63) * 2; const bf16* row = proj + (size_t)(ch * 128 + i) * LDP + h * 128 + d2;
            *(LAS unsigned*)(sq + i * RS + d2) = *(const unsigned*)(row + PC_RQ); *(LAS unsigned*)(sk + i * RS + d2) = *(const unsigned*)(row + PC_RK); *(LAS unsigned*)(sv + i * RS + d2) = *(const unsigned*)(row + PC_RV); }
        __syncthreads();
        for (int half = 0; half < 2; ++half) {
            { const int s = tid & 127, ig = tid >> 7;
                float ac[16];
#pragma unroll
                for (int r = 0; r < 16; ++r) ac[r] = 0.f;
                for (int d2 = 0; d2 < 128; d2 += 2) { const unsigned kw = *(const LAS unsigned*)(sk + s * RS + d2); const float k0 = bflo(kw), k1 = bfhi(kw);
#pragma unroll
                    for (int r = 0; r < 16; ++r) { const unsigned qw = *(const LAS unsigned*)(sq + (64 * half + 16 * ig + r) * RS + d2); ac[r] += bflo(qw) * k0 + bfhi(qw) * k1; } }
#pragma unroll
                for (int r = 0; r < 16; ++r) { const int i = 64 * half + 16 * ig + r; att[(16 * ig + r) * 128 + s] = (i >= s) ? ac[r] * expf(lg * (float)(i - s)) : 0.f; } }
            __syncthreads();
            float o[16];
            { const int dv = tid & 127, ig = tid >> 7;
#pragma unroll
                for (int r = 0; r < 16; ++r) o[r] = 0.f;
                for (int dk = 0; dk < 128; ++dk) { const float rv = KV[((size_t)it * 128 + dk) * 128 + dv];
#pragma unroll
                    for (int r = 0; r < 16; ++r) o[r] += bf2f(sq[(64 * half + 16 * ig + r) * RS + dk]) * rv; }
#pragma unroll
                for (int r = 0; r < 16; ++r) o[r] *= expf(lg * (float)(64 * half + 16 * ig + r + 1));
                for (int s = 0; s < 128; ++s) { const float vv = bf2f(sv[s * RS + dv]);
#pragma unroll
                    for (int r = 0; r < 16; ++r) o[r] += att[(16 * ig + r) * 128 + s] * vv; } }
            __syncthreads();
            { const int dv = tid & 127, ig = tid >> 7;
#pragma unroll
                for (int r = 0; r < 16; ++r) att[(16 * ig + r) * 128 + dv] = o[r]; }
            __syncthreads();
            for (int rr = 0; rr < 8; ++rr) { const int ip = w * 8 + rr, t = ch * 128 + 64 * half + ip;
                const float x0 = att[ip * 128 + lane], x1 = att[ip * 128 + 64 + lane];
                const float mean = wave_sum(x0 + x1) * (1.f / 128.f), d0 = x0 - mean, d1 = x1 - mean, var = wave_sum(d0 * d0 + d1 * d1) * (1.f / 128.f), rs = 1.f / sqrtf(var + 1e-5f);
                const bf16* grow = proj + (size_t)t * LDP + PC_RG + h * 128; const float g0 = bf2f(grow[lane]), g1 = bf2f(grow[64 + lane]);
                Y[(size_t)t * 1024 + h * 128 + lane] = (bf16)f2bf(g0 * sigm(g0) * d0 * rs); Y[(size_t)t * 1024 + h * 128 + 64 + lane] = (bf16)f2bf(g1 * sigm(g1) * d1 * rs); }
            __syncthreads();
        }
    }
}


typedef short bf16x8 __attribute__((ext_vector_type(8)));
typedef short bf16x4 __attribute__((ext_vector_type(4)));
constexpr float NSA_C = 0.125f * 1.4426950408889634f;
struct NsaSrc { const bf16* kf; const bf16* vf; };

__device__ __forceinline__ void nsa_loadK(const NsaSrc& src, int key0, bf16x8 (&kf)[4][2], int lane) {
    const bf16* kp = src.kf + (size_t)(key0 >> 6) * 4096 + lane * 8;
#pragma unroll
    for (int j = 0; j < 4; ++j) { kf[j][0] = *(const bf16x8*)(kp + (2 * j) * 512); kf[j][1] = *(const bf16x8*)(kp + (2 * j + 1) * 512); }
}
__device__ __forceinline__ void nsa_loadV(const NsaSrc& src, int key0, bf16x8 (&vf)[4][2], int lane) {
    const bf16* vp = src.vf + (size_t)(key0 >> 6) * 4096 + lane * 8;
#pragma unroll
    for (int mt = 0; mt < 4; ++mt) { vf[mt][0] = *(const bf16x8*)(vp + (2 * mt) * 512); vf[mt][1] = *(const bf16x8*)(vp + (2 * mt + 1) * 512); }
}
__device__ __forceinline__ void nsa_qk(const bf16x8 (&kf)[4][2], const bf16x8 (&qf)[2], f32x4 (&st)[4]) {
#pragma unroll
    for (int j = 0; j < 4; ++j) { st[j] = (f32x4){0.f, 0.f, 0.f, 0.f};
        st[j] = __builtin_amdgcn_mfma_f32_16x16x32_bf16(kf[j][0], qf[0], st[j], 0, 0, 0); st[j] = __builtin_amdgcn_mfma_f32_16x16x32_bf16(kf[j][1], qf[1], st[j], 0, 0, 0); }
}
template <int MODE>
__device__ __forceinline__ void nsa_rest(f32x4 (&st)[4], const bf16x8 (&vf)[4][2], int key0, int lo, int hi, f32x4 (&O)[4], float& m, float& l, float inv, int r, int q, LAS float* impA, LAS float* impB) {
    float mx = -1.0e30f;
#pragma unroll
    for (int j = 0; j < 4; ++j)
#pragma unroll
        for (int i = 0; i < 4; ++i) { const int key = key0 + 16 * j + 4 * q + i; const bool ok = key >= lo && key <= hi; st[j][i] = ok ? st[j][i] : -1.0e30f; mx = fmaxf(mx, st[j][i]); }
    float mn = m;
    if (MODE != 2) { mx = fmaxf(mx, __shfl_xor(mx, 16)); mx = fmaxf(mx, __shfl_xor(mx, 32)); mn = fmaxf(m, mx); }
    float ps = 0.f;
#pragma unroll
    for (int j = 0; j < 4; ++j)
#pragma unroll
        for (int i = 0; i < 4; ++i) { const float e = st[j][i] > -1.0e29f ? __builtin_amdgcn_exp2f(NSA_C * (st[j][i] - mn)) : 0.f; st[j][i] = MODE == 2 ? e * inv : e; ps += e; }
    if (MODE != 2) { ps += __shfl_xor(ps, 16); ps += __shfl_xor(ps, 32);
        const float sc = __builtin_amdgcn_exp2f(NSA_C * (m - mn)); l = l * sc + ps; m = mn;
        if (MODE == 1) {
#pragma unroll
            for (int mt = 0; mt < 4; ++mt) O[mt] = O[mt] * sc; } }
    if (MODE == 2) {
#pragma unroll
        for (int j = 0; j < 4; ++j) { float a = (st[j][0] + st[j][1]) + (st[j][2] + st[j][3]), b = st[j][3];
            a += __shfl_xor(a, 1); a += __shfl_xor(a, 2); b += __shfl_xor(b, 1); b += __shfl_xor(b, 2);
            if (r == 0) { const int J = (key0 >> 2) + 4 * j + q; impA[J] = a; impB[J] = b; } } }
    if (MODE != 0) {
        bf16x8 pf[2];
#pragma unroll
        for (int ks = 0; ks < 2; ++ks) { const unsigned w0 = pg8::cvt_pk_bf16(st[2 * ks][0], st[2 * ks][1]), w1 = pg8::cvt_pk_bf16(st[2 * ks][2], st[2 * ks][3]),
                                                        w2 = pg8::cvt_pk_bf16(st[2 * ks + 1][0], st[2 * ks + 1][1]), w3 = pg8::cvt_pk_bf16(st[2 * ks + 1][2], st[2 * ks + 1][3]);
            const u32x4 w = (u32x4){w0, w1, w2, w3}; pf[ks] = __builtin_bit_cast(bf16x8, w); }
#pragma unroll
        for (int mt = 0; mt < 4; ++mt) {
#pragma unroll
            for (int ks = 0; ks < 2; ++ks) O[mt] = __builtin_amdgcn_mfma_f32_16x16x32_bf16(vf[mt][ks], pf[ks], O[mt], 0, 0, 0); } }
}
#define NSA_LOOP(MODE, SRC, NBLK, KEY0, LO, HI, INV) do { const int nblk_ = (NBLK); if (nblk_ > 0) { bf16x8 kf_[4][2], vf_[4][2]; f32x4 st_[4]; nsa_loadK(SRC, KEY0(0), kf_, lane); \
    _Pragma("unroll 1") for (int b_ = 0; b_ < nblk_; ++b_) { const int k0_ = KEY0(b_); if (MODE != 0) nsa_loadV(SRC, k0_, vf_, lane); \
        nsa_qk(kf_, qf, st_); __builtin_amdgcn_sched_barrier(0); \
        if (b_ + 1 < nblk_) nsa_loadK(SRC, KEY0(b_ + 1), kf_, lane);     \
        nsa_rest<MODE>(st_, vf_, k0_, LO, HI, O, m, l, INV, r, q, impA, impB); } } } while (0)
constexpr int NSA2_WLDS = 4096;
__device__ __forceinline__ void nsa_attn2(const Ctx& c, const PA& a) {
    const unsigned char* ws = a.ws; const bf16* proj = (const bf16*)(ws + WS_PROJ); bf16* Y = (bf16*)(a.ws + WS_YNSA);
    LAS float* impA = (LAS float*)(c.lds + c.wave * NSA2_WLDS); LAS float* impB = impA + 256; LAS int* KST = (LAS int*)(impB + 256);
    const int lane = c.lane, r = lane & 15, q = lane >> 4;
    const bool xdeal = (c.G & 7) == 0; const int xg = c.bx & 7, tw = xdeal ? (c.bx >> 3) * 8 + c.wave : c.gw, ntw = xdeal ? (c.G >> 3) * 8 : c.NGW, ntask = xdeal ? T / 2 : T * 4;
    for (int task = tw; task < ntask; task += ntw) { const int t = xdeal ? 2 * task + (xg >> 2) : task >> 2, g = xdeal ? (xg & 3) : (task & 3);
        const bf16* prow = proj + (size_t)t * LDP;
        bf16x8 qf[2]; qf[0] = (bf16x8){0, 0, 0, 0, 0, 0, 0, 0}; qf[1] = qf[0];
        float gt0 = 0.f, gt1 = 0.f, gt2 = 0.f;
        if (r < 4) { const bf16* qp = prow + PC_NQ + (g * 4 + r) * 64 + 8 * q; qf[0] = *(const bf16x8*)qp; qf[1] = *(const bf16x8*)(qp + 32);
            const bf16* gp = prow + PC_GATE + (g * 4 + r) * 3; gt0 = sigm(bf2f(gp[0])); gt1 = sigm(bf2f(gp[1])); gt2 = sigm(bf2f(gp[2])); }
        const int cur = t >> 6, ncv = t >= 31 ? ((t - 31) >> 4) + 1 : 0;
#pragma unroll
        for (int i = 0; i < 4; ++i) { impA[lane + 64 * i] = 0.f; impB[lane + 64 * i] = 0.f; }
        LDS_WAIT();
        f32x4 yacc[4], O[4];
#pragma unroll
        for (int mt = 0; mt < 4; ++mt) yacc[mt] = (f32x4){0.f, 0.f, 0.f, 0.f};
        if (ncv > 0) {
            NsaSrc sc; sc.kf = (const bf16*)(ws + WS_KCMPB) + (size_t)g * 16 * 4096; sc.vf = (const bf16*)(ws + WS_VCMPT) + (size_t)g * 16 * 4096;
            const int nb = (ncv + 63) >> 6; float m = -1.0e30f, l = 0.f;
#define K0_CMP(b) (64 * (b))
            NSA_LOOP(0, sc, nb, K0_CMP, 0, ncv - 1, 0.f);
            const float inv = 1.f / l;
#pragma unroll
            for (int mt = 0; mt < 4; ++mt) O[mt] = (f32x4){0.f, 0.f, 0.f, 0.f};
            NSA_LOOP(2, sc, nb, K0_CMP, 0, ncv - 1, inv);
#pragma unroll
            for (int mt = 0; mt < 4; ++mt) yacc[mt] = O[mt] * gt0;
        }
        LDS_WAIT();
        float scv[4];
#pragma unroll
        for (int mm = 0; mm < 4; ++mm) { const int j = 4 * lane + mm; float s = -1.0e30f;
            if (j <= cur) { s = impA[j] + (j > 0 ? impB[j - 1] : 0.f); if (j == 0 || j == cur || j == cur - 1) s += 1.0e4f; }
            scv[mm] = s; }
        int nsel = 0;
        for (int itk = 0; itk < 16; ++itk) {
            float lv = scv[0]; int lj = 4 * lane;
            if (scv[1] > lv) { lv = scv[1]; lj = 4 * lane + 1; } if (scv[2] > lv) { lv = scv[2]; lj = 4 * lane + 2; } if (scv[3] > lv) { lv = scv[3]; lj = 4 * lane + 3; }
            const float vmax = wave_max(lv); if (vmax < -5.0e29f) break;
            const int jmin = wave_min_i(lv == vmax ? lj : (1 << 30));
            if (lane == 0) KST[itk] = jmin * 64;
            if ((jmin >> 2) == lane) { const int mm = jmin & 3; if (mm == 0) scv[0] = -3.0e38f; else if (mm == 1) scv[1] = -3.0e38f; else if (mm == 2) scv[2] = -3.0e38f; else scv[3] = -3.0e38f; }
            ++nsel; }
        LDS_WAIT();
        { NsaSrc ss; ss.kf = (const bf16*)(ws + WS_KFS) + (size_t)g * 256 * 4096; ss.vf = (const bf16*)(ws + WS_VFS) + (size_t)g * 256 * 4096;
            float m = -1.0e30f, l = 0.f;
#pragma unroll
            for (int mt = 0; mt < 4; ++mt) O[mt] = (f32x4){0.f, 0.f, 0.f, 0.f};
#define K0_SEL(b) (KST[b])
            NSA_LOOP(1, ss, nsel, K0_SEL, 0, t, 0.f);
            const float sc = gt1 / l;
#pragma unroll
            for (int mt = 0; mt < 4; ++mt) yacc[mt] += O[mt] * sc; }
        { NsaSrc sw; sw.kf = (const bf16*)(ws + WS_KFW) + (size_t)g * 256 * 4096; sw.vf = (const bf16*)(ws + WS_VFW) + (size_t)g * 256 * 4096;
            float m = -1.0e30f, l = 0.f; const int wlo = t - 511 > 0 ? t - 511 : 0;
#pragma unroll
            for (int mt = 0; mt < 4; ++mt) O[mt] = (f32x4){0.f, 0.f, 0.f, 0.f};
            const int jb0 = wlo >> 6;
#define K0_WIN(b) (64 * (jb0 + (b)))
            NSA_LOOP(1, sw, cur - jb0 + 1, K0_WIN, wlo, t, 0.f);
            const float sc = gt2 / l;
#pragma unroll
            for (int mt = 0; mt < 4; ++mt) yacc[mt] += O[mt] * sc; }
        if (r < 4) {
#pragma unroll
            for (int mt = 0; mt < 4; ++mt) { uint2 w; w.x = pg8::cvt_pk_bf16(yacc[mt][0], yacc[mt][1]); w.y = pg8::cvt_pk_bf16(yacc[mt][2], yacc[mt][3]);
                *(uint2*)(Y + (size_t)t * 1024 + (g * 4 + r) * 64 + 16 * mt + 4 * q) = w; } }
    }
}
__device__ __forceinline__ void prep_tiles(const Ctx& c, const PA& a) {
    const bf16* proj = (const bf16*)(a.ws + WS_PROJ);
    LAS bf16* tile = (LAS bf16*)(c.lds + c.wave * 8704);
    const int lane = c.lane, r = lane & 15, q = lane >> 4;
    for (int it = c.gw; it < 4 * 4 * 256; it += c.NGW) { const int blk = it & 255, g = (it >> 8) & 3, ten = it >> 10;
        const int scol = (ten == 0 ? PC_KS : (ten == 1 ? PC_VS : (ten == 2 ? PC_KW : PC_VW))) + g * 64;
        const u32x4* sp = (const u32x4*)(proj + (size_t)(blk * 64 + lane) * LDP + scol);
#pragma unroll
        for (int i = 0; i < 8; ++i) { const u32x4 v = sp[i]; LAS unsigned* tp = (LAS unsigned*)(tile + lane * 66 + 8 * i); tp[0] = v.x; tp[1] = v.y; tp[2] = v.z; tp[3] = v.w; }
        LDS_WAIT();
        bf16* dst = (bf16*)(a.ws + (ten == 0 ? WS_KFS : (ten == 1 ? WS_VFS : (ten == 2 ? WS_KFW : WS_VFW)))) + ((size_t)(g * 256 + blk) * 8) * 512 + lane * 8;
        if ((ten & 1) == 0) {
#pragma unroll
            for (int j = 0; j < 4; ++j)
#pragma unroll
                for (int ks = 0; ks < 2; ++ks) { const LAS unsigned* tp = (const LAS unsigned*)(tile + (16 * j + r) * 66 + 32 * ks + 8 * q);
                    *(u32x4*)(dst + (2 * j + ks) * 512) = (u32x4){tp[0], tp[1], tp[2], tp[3]}; }
        } else {
#pragma unroll
            for (int mt = 0; mt < 4; ++mt)
#pragma unroll
                for (int ks = 0; ks < 2; ++ks) { unsigned w[4];
#pragma unroll
                    for (int h = 0; h < 2; ++h)
#pragma unroll
                        for (int i2 = 0; i2 < 2; ++i2) { const int k0 = 32 * ks + 16 * h + 4 * q + 2 * i2;
                            w[2 * h + i2] = (unsigned)tile[k0 * 66 + 16 * mt + r] | ((unsigned)tile[(k0 + 1) * 66 + 16 * mt + r] << 16); }
                    *(u32x4*)(dst + (2 * mt + ks) * 512) = (u32x4){w[0], w[1], w[2], w[3]}; }
        }
        LDS_WAIT();
    }
}

__device__ __forceinline__ void ln_row(f32x4 (&v)[8], const float* gam, const float* bet, int lane) {
    float s = 0.f;
#pragma unroll
    for (int j = 0; j < 8; ++j) s += (v[j][0] + v[j][1]) + (v[j][2] + v[j][3]);
    const float mean = wave_sum(s) * (1.f / D); float s2 = 0.f;
#pragma unroll
    for (int j = 0; j < 8; ++j) { v[j] = v[j] - mean; s2 += (v[j][0] * v[j][0] + v[j][1] * v[j][1]) + (v[j][2] * v[j][2] + v[j][3] * v[j][3]); }
    const float rstd = 1.f / sqrtf(wave_sum(s2) * (1.f / D) + LN_EPS);
#pragma unroll
    for (int j = 0; j < 8; ++j) { const f32x4 g4 = *(const f32x4*)(gam + 4 * (lane + 64 * j)), b4 = *(const f32x4*)(bet + 4 * (lane + 64 * j)); v[j] = v[j] * rstd * g4 + b4; }
}
__device__ __forceinline__ void ph_ln1_route(const Ctx& c, const PA& a, int layer) {
    unsigned char* ws = a.ws; float* X = a.out; uint2* xb = (uint2*)(ws + WS_XB);
    const float* gam = a.in(25) + layer * D; const float* bet = a.in(26) + layer * D;
    const float* wg = a.in(27) + (size_t)layer * D * 4; const float* bg = a.in(28) + layer * 4; const float* we = a.in(29) + (size_t)layer * D * 32; const float* be = a.in(30) + layer * 32;
    int* toke = (int*)(ws + WS_TOKE); float* tokw = (float*)(ws + WS_TOKW); unsigned* cnt = (unsigned*)(ws + WS_CTL) + CW_CNT + layer * 128;
    LAS float* lg = (LAS float*)(c.lds + c.wave * 256);
    const int lane = c.lane;
    for (int t = c.gw; t < T; t += c.NGW) {
        f32x4* row = (f32x4*)(X + (size_t)t * D); f32x4 v[8];
#pragma unroll
        for (int j = 0; j < 8; ++j) v[j] = row[lane + 64 * j];
        ln_row(v, gam, bet, lane);
#pragma unroll
        for (int j = 0; j < 8; ++j) { row[lane + 64 * j] = v[j]; xb[(size_t)t * (D / 4) + lane + 64 * j] = make_uint2(pk2(v[j][0], v[j][1]), pk2(v[j][2], v[j][3])); }
        LAS float* xr = (LAS float*)(c.lds + 4096 + c.wave * 8192);
#pragma unroll
        for (int j = 0; j < 8; ++j) *(LAS f32x4*)(xr + 4 * (lane + 64 * j)) = v[j];
        LDS_WAIT();
        f32x4 ag = (f32x4){0.f, 0.f, 0.f, 0.f}; f32x4 ae[8];
#pragma unroll
        for (int q = 0; q < 8; ++q) ae[q] = (f32x4){0.f, 0.f, 0.f, 0.f};
#pragma unroll 2
        for (int i = 0; i < 32; ++i) { const int d = lane + 64 * i; const float x = xr[d];
            ag += *(const f32x4*)(wg + (size_t)d * 4) * x;
            const f32x4* wp = (const f32x4*)(we + (size_t)d * 32);
#pragma unroll
            for (int e4 = 0; e4 < 8; ++e4) ae[e4] += wp[e4] * x; }
#pragma unroll
        for (int q = 0; q < 4; ++q) ag[q] = wave_sum(ag[q]) + bg[q];
#pragma unroll
        for (int e4 = 0; e4 < 8; ++e4)
#pragma unroll
            for (int q = 0; q < 4; ++q) ae[e4][q] = wave_sum(ae[e4][q]);
        if (lane == 0) {
#pragma unroll
            for (int e4 = 0; e4 < 8; ++e4)
#pragma unroll
                for (int q = 0; q < 4; ++q) lg[e4 * 4 + q] = ae[e4][q] + be[e4 * 4 + q]; }
        LDS_WAIT();
        int grp = 0; float gm = ag[0];
        if (ag[1] > gm) { gm = ag[1]; grp = 1; } if (ag[2] > gm) { gm = ag[2]; grp = 2; } if (ag[3] > gm) { gm = ag[3]; grp = 3; }
        const float gw_ = 1.f / (expf(ag[0] - gm) + expf(ag[1] - gm) + expf(ag[2] - gm) + expf(ag[3] - gm));
        float v0 = -3.0e38f, v1 = -3.0e38f; int i0 = 0, i1 = 0;
        for (int i = 0; i < 8; ++i) { const float x = lg[grp * 8 + i];
            if (x > v0) { v1 = v0; i1 = i0; v0 = x; i0 = i; } else if (x > v1) { v1 = x; i1 = i; } }
        const float e1 = expf(v1 - v0), p0 = 1.f / (1.f + e1), p1 = e1 * p0;
        if (lane == 0) { toke[2 * t] = grp * 8 + i0; toke[2 * t + 1] = grp * 8 + i1; tokw[2 * t] = p0 * gw_; tokw[2 * t + 1] = p1 * gw_;
            __hip_atomic_fetch_add(cnt + grp * 8 + i0, 1u, __ATOMIC_RELAXED, __HIP_MEMORY_SCOPE_AGENT); __hip_atomic_fetch_add(cnt + grp * 8 + i1, 1u, __ATOMIC_RELAXED, __HIP_MEMORY_SCOPE_AGENT); }
        LDS_WAIT();
    }
}
__device__ __forceinline__ void ph_slot(const Ctx& c, const PA& a, int layer) {
    unsigned char* ws = a.ws; unsigned* cnt = (unsigned*)(ws + WS_CTL) + CW_CNT + layer * 128; unsigned* cur = (unsigned*)(ws + WS_CTL) + CW_CUR + layer * 128;
    int* texp = (int*)(ws + WS_TEXP) + layer * 512; const int* toke = (const int*)(ws + WS_TOKE); int* slot = (int*)(ws + WS_SLOT);
    LAS int* pst = (LAS int*)c.lds;
    if (c.tid == 0) { int off = 0, nt = 0;
#pragma unroll 1
        for (int e = 0; e < NEXP; ++e) { const int n = (int)__hip_atomic_load(cnt + e, __ATOMIC_RELAXED, __HIP_MEMORY_SCOPE_AGENT), tl = (n + 255) >> 8;
            pst[e] = off; off += tl * 256;
            if (c.bx == 0) for (int q = 0; q < tl; ++q) texp[nt + q] = e;
            nt += tl; }
        if (c.bx == 0) texp[255] = nt; }
    __syncthreads();
    const u32x4* xb = (const u32x4*)(ws + WS_XB); u32x4* xs = (u32x4*)(ws + WS_XS);
    for (int as = c.gw; as < 2 * T; as += c.NGW) { const int t = as >> 1, e = toke[as]; int s = 0;
        if (c.lane == 0) s = pst[e] + (int)__hip_atomic_fetch_add(cur + e, 1u, __ATOMIC_RELAXED, __HIP_MEMORY_SCOPE_AGENT);
        s = __shfl(s, 0);
        if (c.lane == 0) slot[as] = s;
#pragma unroll
        for (int j = 0; j < 4; ++j) xs[(size_t)s * 256 + c.lane + 64 * j] = xb[(size_t)t * 256 + c.lane + 64 * j]; }
}
__device__ __forceinline__ void ph_ln2(const Ctx& c, const PA& a, int layer) {
    unsigned char* ws = a.ws; float* X = a.out; uint2* xb = (uint2*)(ws + WS_XB); const uint2* ys = (const uint2*)(ws + WS_YS);
    const float* gam = a.in(34) + layer * D; const float* bet = a.in(35) + layer * D; const int* slot = (const int*)(ws + WS_SLOT); const float* tokw = (const float*)(ws + WS_TOKW);
    const int lane = c.lane;
    for (int t = c.gw; t < T; t += c.NGW) {
        const int s0 = slot[2 * t], s1 = slot[2 * t + 1]; const float w0 = tokw[2 * t], w1 = tokw[2 * t + 1];
        f32x4* row = (f32x4*)(X + (size_t)t * D); f32x4 v[8];
#pragma unroll
        for (int j = 0; j < 8; ++j) { const uint2 y0 = ys[(size_t)s0 * 512 + lane + 64 * j], y1 = ys[(size_t)s1 * 512 + lane + 64 * j]; const f32x4 x = row[lane + 64 * j];
            v[j][0] = x[0] * DN_ALPHA + w0 * bflo(y0.x) + w1 * bflo(y1.x); v[j][1] = x[1] * DN_ALPHA + w0 * bfhi(y0.x) + w1 * bfhi(y1.x);
            v[j][2] = x[2] * DN_ALPHA + w0 * bflo(y0.y) + w1 * bflo(y1.y); v[j][3] = x[3] * DN_ALPHA + w0 * bfhi(y0.y) + w1 * bfhi(y1.y); }
        ln_row(v, gam, bet, lane);
#pragma unroll
        for (int j = 0; j < 8; ++j) { row[lane + 64 * j] = v[j]; xb[(size_t)t * (D / 4) + lane + 64 * j] = make_uint2(pk2(v[j][0], v[j][1]), pk2(v[j][2], v[j][3])); }
    }
}

enum { PH_CONV = 0, PH_INPROJ, PH_PREP, PH_SCAN1, PH_SCAN2, PH_SCAN3, PH_GATES, PH_BRANCH, PH_OUT, PH_LN1, PH_SLOT, PH_MOE_GU, PH_MOE_DN, PH_LN2, NPH_L };
constexpr int NPH = NPH_L * DEPTH;

__device__ __forceinline__ Ctx mkctx(LAS unsigned char* lds, int wv) {
    int ln; asm volatile("v_mbcnt_lo_u32_b32 %0, -1, 0\n\tv_mbcnt_hi_u32_b32 %0, -1, %0" : "=v"(ln));
    int tid = wv * 64 + ln, bx = blockIdx.x, G = gridDim.x;
    asm volatile("" : "+s"(bx)); asm volatile("" : "+s"(G));
    Ctx c; c.lds = lds; c.tid = tid; c.lane = tid & 63; c.wave = __builtin_amdgcn_readfirstlane(tid >> 6); c.G = G; c.bx = bx; c.gw = bx * 8 + c.wave; c.NGW = G * 8; return c;
}
__global__ void __launch_bounds__(512, 2) fwd(Args args0) {
    extern __shared__ __attribute__((aligned(16))) unsigned char lds_raw[];
    LAS unsigned char* const lds0 = (LAS unsigned char*)lds_raw;
    const int lo = args0.ph_lo, hi = args0.ph_hi;
    const int wv0 = __builtin_amdgcn_readfirstlane(threadIdx.x >> 6);
    if (threadIdx.x < 36) ((LAS unsigned long long*)(lds0 + LDS_PTAB))[threadIdx.x] = (unsigned long long)args0.in[threadIdx.x];
    __syncthreads();
#if MK_ONE_LAUNCH
    volatile LAS unsigned* barw = (volatile LAS unsigned*)(lds0 + LDS_BARW);
    if (threadIdx.x == 0) { barw[0] = 0u; barw[1] = 0u; barw[2] = 0u; barw[3] = 0u; }
    __syncthreads();
    XcdBarrier bar = xcd_barrier_post((unsigned*)(args0.ws + WS_CTL) + CW_BAR, barw);
#define SEAM(p) do { if ((p) + 1 < hi) xcd_barrier(bar); } while (0)
#else
#define SEAM(p) do { } while (0)
#endif
#ifndef ONLY_PHASE
#define ONLY_PHASE -1
#endif
#define PHASE_BEGIN PA args; { unsigned long long w_ = (unsigned long long)args0.ws; asm volatile("" : "+s"(w_)); args.ws = (unsigned char*)(GAS unsigned char*)w_; unsigned long long o_ = (unsigned long long)args0.out; asm volatile("" : "+s"(o_)); args.out = (float*)(GAS float*)o_; args.tab = (const LAS unsigned*)(lds0 + LDS_PTAB); } unsigned char* const ws = args.ws; const Ctx c = mkctx(lds0, wv0); (void)ws; (void)c;
#define TASK_CTX() mkctx(lds0, wv0)
#define IN(p) ((ONLY_PHASE < 0 || ONLY_PHASE == ((p) - pb)) && lo <= (p) && (p) < hi)
    for (int layer = 0; layer < DEPTH; ++layer) {
        const int pb = layer * NPH_L;
        if (IN(pb + PH_CONV)) { PHASE_BEGIN ph_conv(c, args, layer); __syncthreads(); SEAM(pb + PH_CONV); }
        if (IN(pb + PH_INPROJ)) { PHASE_BEGIN
            Gemm g{D, D, D}; SchedPlain S; S.to.init(T / 256, LDP / 256); S.G = c.G; S.c = c.bx; S.tid = c.tid; S.A = (const char*)(ws + WS_XB); S.B = (const char*)(ws + WS_WIN); S.ta = (size_t)256 * D * 2; S.tb = (size_t)256 * D * 2;
            EpiStore<0> E{(bf16*)(ws + WS_PROJ), LDP};
            pg8::gemm_phase<EpiStore<0>, SchedPlain, PG8_ALIGN, PG8_SP2>(c.lds, g, S, E);
#ifdef REP_GEMM
            pg8::gemm_phase<EpiStore<0>, SchedPlain, PG8_ALIGN, PG8_SP2>(c.lds, g, S, E);
#endif
            SEAM(pb + PH_INPROJ); }
        if (IN(pb + PH_PREP)) { PHASE_BEGIN prep_rwkv(c, args, layer); __syncthreads();
#ifdef REP_RW
            prep_rwkv(TASK_CTX(), args, layer); __syncthreads();
#endif
 prep_cmp(TASK_CTX(), args, layer); prep_rope(TASK_CTX(), args); prep_tiles(TASK_CTX(), args); __syncthreads(); SEAM(pb + PH_PREP); }
        if (IN(pb + PH_SCAN1)) { PHASE_BEGIN rw_pass1(c, args);
#ifdef REP_RW
            rw_pass1(TASK_CTX(), args);
#endif
 ret_kv(TASK_CTX(), args); __syncthreads();
#ifdef REP_RET
            ret_kv(TASK_CTX(), args); __syncthreads();
#endif
 nsa_attn2(TASK_CTX(), args); __syncthreads();
 SEAM(pb + PH_SCAN1); }
        if (IN(pb + PH_SCAN2)) { PHASE_BEGIN rw_pass2(c, args);
#ifdef REP_RW
            rw_pass2(TASK_CTX(), args);
#endif
 ret_prefix(TASK_CTX(), args); __syncthreads(); SEAM(pb + PH_SCAN2); }
        if (IN(pb + PH_SCAN3)) { PHASE_BEGIN rw_pass3(c, args, layer); __syncthreads();
#ifdef REP_RW
            rw_pass3(TASK_CTX(), args, layer); __syncthreads();
#endif
 ret_out(TASK_CTX(), args); __syncthreads();
#ifdef REP_RET
            ret_out(TASK_CTX(), args); __syncthreads();
#endif
 SEAM(pb + PH_SCAN3); }
        if (IN(pb + PH_GATES)) { PHASE_BEGIN
            Gemm g{D, D, D}; SchedPlain S; S.to.init(T / 256, NG / 256); S.G = c.G; S.c = c.bx; S.tid = c.tid; S.A = (const char*)(ws + WS_XB); S.B = (const char*)(ws + WS_WG); S.ta = (size_t)256 * D * 2; S.tb = (size_t)256 * D * 2;
            EpiStore<1> E{(bf16*)(ws + WS_GATES), NG};
            pg8::gemm_phase<EpiStore<1>, SchedPlain, PG8_ALIGN, PG8_SP2>(c.lds, g, S, E);
#ifdef REP_GEMM
            pg8::gemm_phase<EpiStore<1>, SchedPlain, PG8_ALIGN, PG8_SP2>(c.lds, g, S, E);
#endif
            SEAM(pb + PH_GATES); }
        if (IN(pb + PH_BRANCH)) { PHASE_BEGIN
            Gemm g{RWW, RWW, RWW}; SchedBranch S; S.to.init(T / 256, D / 256); S.G = c.G; S.c = c.bx; S.tid = c.tid;
            S.A0 = (const char*)(ws + WS_YRW); S.sa = WS_YNSA - WS_YRW; static_assert(WS_YRET - WS_YNSA == WS_YNSA - WS_YRW, "y buffers equally spaced");
            S.B0 = (const char*)(ws + WS_WBR); S.sb = (size_t)D * RWW * 2; S.ta = (size_t)256 * RWW * 2; S.tb = (size_t)256 * RWW * 2;
            EpiBranch E{(bf16*)(ws + WS_MERGED), (const bf16*)(ws + WS_GATES)};
            pg8::gemm_phase<EpiBranch, SchedBranch, PG8_ALIGN, PG8_SP2>(c.lds, g, S, E);
            SEAM(pb + PH_BRANCH); }
        if (IN(pb + PH_OUT)) { PHASE_BEGIN
            Gemm g{D, D, D}; SchedPlain S; S.to.init(T / 256, D / 256); S.G = c.G; S.c = c.bx; S.tid = c.tid; S.A = (const char*)(ws + WS_MERGED); S.B = (const char*)(ws + WS_WOUT); S.ta = (size_t)256 * D * 2; S.tb = (size_t)256 * D * 2;
            EpiResid E{args.out};
            pg8::gemm_phase<EpiResid, SchedPlain, PG8_ALIGN, PG8_SP2>(c.lds, g, S, E);
            SEAM(pb + PH_OUT); }
        if (IN(pb + PH_LN1)) { PHASE_BEGIN ph_ln1_route(c, args, layer); __syncthreads(); ph_conv_moe(TASK_CTX(), args, layer); __syncthreads(); SEAM(pb + PH_LN1); }
        if (IN(pb + PH_SLOT)) { PHASE_BEGIN ph_slot(c, args, layer); __syncthreads(); SEAM(pb + PH_SLOT); }
        if (IN(pb + PH_MOE_GU)) { PHASE_BEGIN
            const int* texp = (const int*)(ws + WS_TEXP) + layer * 512;
            Gemm g{D, D, D}; SchedMoe S; S.nM = texp[255]; S.nN = 4; S.G = c.G; S.c = c.bx; S.tid = c.tid; S.A = (const char*)(ws + WS_XS); S.B = (const char*)(ws + WS_WGU); S.ta = (size_t)256 * D * 2; S.tb = (size_t)256 * D * 2; S.te = (size_t)1024 * D * 2; S.texp = texp;
            EpiGateUp E{(bf16*)(ws + WS_H)};
            pg8::gemm_phase<EpiGateUp, SchedMoe, PG8_ALIGN, PG8_SP2>(c.lds, g, S, E);
#ifdef REP_GEMM
            pg8::gemm_phase<EpiGateUp, SchedMoe, PG8_ALIGN, PG8_SP2>(c.lds, g, S, E);
#endif
            SEAM(pb + PH_MOE_GU); }
        if (IN(pb + PH_MOE_DN)) { PHASE_BEGIN
            const int* texp = (const int*)(ws + WS_TEXP) + layer * 512;
            Gemm g{FF, FF, FF}; SchedMoe S; S.nM = texp[255]; S.nN = 8; S.G = c.G; S.c = c.bx; S.tid = c.tid; S.A = (const char*)(ws + WS_H); S.B = (const char*)(ws + WS_WDN); S.ta = (size_t)256 * FF * 2; S.tb = (size_t)256 * FF * 2; S.te = (size_t)D * FF * 2; S.texp = texp;
            EpiStore<0> E{(bf16*)(ws + WS_YS), D};
            pg8::gemm_phase<EpiStore<0>, SchedMoe, PG8_ALIGN, PG8_SP2>(c.lds, g, S, E);
#ifdef REP_GEMM
            pg8::gemm_phase<EpiStore<0>, SchedMoe, PG8_ALIGN, PG8_SP2>(c.lds, g, S, E);
#endif
            SEAM(pb + PH_MOE_DN); }
        if (IN(pb + PH_LN2)) { PHASE_BEGIN ph_ln2(c, args, layer); __syncthreads(); SEAM(pb + PH_LN2); }
    }
#undef IN
#undef SEAM
}

#ifndef TRUNC_PH
#define TRUNC_PH NPH
#endif
#ifndef DUMP_MODE
#define DUMP_MODE 0
#endif
#if DUMP_MODE
__global__ void dump_k(float* out, const unsigned char* ws) {
    for (size_t i = (size_t)blockIdx.x * blockDim.x + threadIdx.x; i < (size_t)T * D; i += (size_t)gridDim.x * blockDim.x) {
        const int t = (int)(i / D), c = (int)(i % D); float v = 0.f;
#if DUMP_MODE == 1
        v = bf2f(((const bf16*)(ws + WS_PROJ))[(size_t)t * LDP + c * 5]);
#elif DUMP_MODE == 2
        if (c < 1024) v = bf2f(((const bf16*)(ws + WS_YRW))[(size_t)t * 1024 + c]); else v = bf2f(((const bf16*)(ws + WS_YNSA))[(size_t)t * 1024 + c - 1024]);
#elif DUMP_MODE == 3
        if (c < 1024) v = bf2f(((const bf16*)(ws + WS_YRET))[(size_t)t * 1024 + c]); else v = bf2f(((const bf16*)(ws + WS_MERGED))[(size_t)t * D + c]);
#elif DUMP_MODE == 4
        if (c < 1024) v = bf2f(((const bf16*)(ws + WS_YRET))[(size_t)t * 1024 + c]);
#elif DUMP_MODE == 5
        v = bf2f(((const bf16*)(ws + WS_GATES))[(size_t)t * NG + c * 3]);
#endif
        out[i] = (v == v && fabsf(v) < 1e30f) ? v : 0.f; }
}
#endif
extern "C" void kernel_launch(void* const* d_in, const int* in_sizes, int n_in, void* d_out, int out_size, void* d_ws, size_t ws_size, hipStream_t stream) {
    static int grid = 0;
    if (grid == 0) {
        if (n_in != 36 || out_size != T * D || ws_size < WS_END) { fprintf(stderr, "kernel_launch: unexpected shapes (n_in %d out %d ws %zu)\n", n_in, out_size, ws_size); grid = -1; return; }
        int dev = 0, cus = 0, per_cu = 0;
        if (hipGetDevice(&dev) != hipSuccess || hipDeviceGetAttribute(&cus, hipDeviceAttributeMultiprocessorCount, dev) != hipSuccess) { grid = -1; return; }
        if (hipFuncSetAttribute((const void*)fwd, hipFuncAttributeMaxDynamicSharedMemorySize, LDS_BYTES) != hipSuccess) { fprintf(stderr, "kernel_launch: hipFuncSetAttribute failed\n"); grid = -1; return; }
        if (hipOccupancyMaxActiveBlocksPerMultiprocessor(&per_cu, (const void*)fwd, 512, LDS_BYTES) != hipSuccess || per_cu < 1) fprintf(stderr, "kernel_launch: occupancy query says %d\n", per_cu);
        (void)hipGetLastError();
        grid = cus;
    }
    if (grid < 0) return;
    if (hipMemsetAsync((char*)d_ws + WS_CTL, 0, CTL_ZERO_BYTES, stream) != hipSuccess) return;
    Args a{};
    for (int i = 0; i < 36; ++i) a.in[i] = (const float*)d_in[i];
    a.out = (float*)d_out; a.ws = (unsigned char*)d_ws;
#if MK_ONE_LAUNCH
    a.ph_lo = 0; a.ph_hi = NPH;
    hipLaunchKernelGGL(fwd, dim3(grid), dim3(512), LDS_BYTES, stream, a);
#else
    for (int p = 0; p < TRUNC_PH; ++p) { a.ph_lo = p; a.ph_hi = p + 1; hipLaunchKernelGGL(fwd, dim3(grid), dim3(512), LDS_BYTES, stream, a); }
#if DUMP_MODE
    dump_k<<<2048, 256, 0, stream>>>((float*)d_out, (const unsigned char*)d_ws);
#endif
#endif
}
```

```cpp
#define MK_ONE_LAUNCH 1
#include <hip/hip_runtime.h>
#include <cstdio>
#include <cstdint>

#ifndef MK_ONE_LAUNCH
#define MK_ONE_LAUNCH 0
#endif

namespace pg8 {
#define PG8_LAS __attribute__((address_space(3)))
typedef unsigned short bf16_t;
typedef short bf16x8 __attribute__((ext_vector_type(8)));
typedef float f32x4 __attribute__((ext_vector_type(4)));
typedef unsigned u32x4 __attribute__((ext_vector_type(4)));
constexpr int BM = 256, BK = 64, HALF = 128, HTB = HALF * BK * 2  , STAGE_BYTES = 8 * HTB, NXCD = 8, WGM = 8;

__host__ __device__ __forceinline__ int lds_byte(int r, int c) { const int st = (r >> 4) * 2 + (c >> 5), rr = r & 15, cc = c & 31, ob = rr * 64 + cc * 2; return st * 1024 + (ob ^ (((ob >> 9) & 1) << 5)); }
__host__ __device__ __forceinline__ void stage_rc(int b, int& R, int& C) { const int st = b / 1024, sb = b % 1024, swz = sb ^ (((sb >> 9) & 1) << 5); R = (st >> 1) * 16 + swz / 64; C = (st & 1) * 32 + (swz % 64) / 2; }
__host__ __device__ __forceinline__ int perm32(int rho) { const int n = rho >> 4, i = rho & 15; return 8 * (i >> 2) + 4 * n + (i & 3); }

struct Unit { int pm, pn, aux; const char* a; const char* b; };
struct Gemm { int K, lda, ldb; };

struct TileOrder {
    int nM, nN, nwg;
    __device__ void init(int nM_, int nN_) { nM = nM_; nN = nN_; nwg = nM * nN; }
    __device__ bool tile(long L, int& pm, int& pn) const {
        if (L >= nwg) return false;
        int wgid = (int)L; { const int q = nwg / NXCD, r = nwg % NXCD, xcd = wgid % NXCD, off = wgid / NXCD; wgid = (xcd < r ? xcd * (q + 1) : r * (q + 1) + (xcd - r) * q) + off; }
        const int nig = WGM * nN, gid = wgid / nig, fm = gid * WGM, gsz = (nM - fm) < WGM ? (nM - fm) : WGM;
        pm = fm + ((wgid % nig) % gsz); pn = (wgid % nig) / gsz; return true;
    }
};

typedef float f32x2_t __attribute__((ext_vector_type(2))); typedef __bf16 bf16x2_t __attribute__((ext_vector_type(2)));
__device__ __forceinline__ unsigned cvt_pk_bf16(float lo, float hi) { f32x2_t v = {lo, hi}; bf16x2_t b = __builtin_convertvector(v, bf16x2_t); return __builtin_bit_cast(unsigned, b); }

template <class Epi, class Sched, bool ALIGN_EPI = false, bool SP2 = false>
__device__ __forceinline__ void gemm_phase(PG8_LAS unsigned char* lds, const Gemm g, const Sched& S, const Epi& E) {
    const int tid = S.tid, wid = __builtin_amdgcn_readfirstlane(tid >> 6), lane = tid & 63, wr = wid >> 2, wc = wid & 3, fr = lane & 15, fq = lane >> 4;
    const int K = g.K, nt = K / BK;
    unsigned voffA[2], voffB[2];
#pragma unroll
    for (int i = 0; i < 2; ++i) { int R, C; stage_rc(tid * 16 + i * 8192, R, C); const int Rb = Epi::PERM ? ((R & ~31) + perm32(R & 31)) : R;
        voffA[i] = (unsigned)(R * g.lda + C) * 2u; voffB[i] = (unsigned)(Rb * g.ldb + C) * 2u; }
    const size_t kstep = (size_t)(BK * 2);
    const size_t hstepA = (size_t)HALF * g.lda * 2, hstepB = (size_t)HALF * g.ldb * 2;
    const unsigned ldsw = (unsigned)wid * 1024u;
    const int aoff = lds_byte(wr * 64 + fr, fq * 8), boff = lds_byte(wc * 32 + fr, fq * 8);
#define PG8_SA(b, h) (((b) * 2 + (h)) * HTB)
#define PG8_SB(b, h) ((4 + (b) * 2 + (h)) * HTB)
#define PG8_STAGE(bufoff, gbase, voff) do { _Pragma("unroll") for (int _i = 0; _i < 2; ++_i) \
        __builtin_amdgcn_global_load_lds((const unsigned*)((const char*)(gbase) + (voff)[_i]), (PG8_LAS unsigned*)(lds + (bufoff) + ldsw + _i * 8192), 16, 0, 0); } while (0)
#define PG8_LDA(dst, b, h) do { _Pragma("unroll") for (int m = 0; m < 4; ++m) _Pragma("unroll") for (int k = 0; k < 2; ++k) dst[m][k] = *(const PG8_LAS bf16x8*)(lds + PG8_SA(b, h) + aoff + m * 2048 + k * 1024); } while (0)
#define PG8_LDB(dst, b, h) do { _Pragma("unroll") for (int n = 0; n < 2; ++n) _Pragma("unroll") for (int k = 0; k < 2; ++k) dst[n][k] = *(const PG8_LAS bf16x8*)(lds + PG8_SB(b, h) + boff + n * 2048 + k * 1024); } while (0)
#define PG8_MMA(ai, bj, At, Bt) do { __builtin_amdgcn_s_setprio(1); _Pragma("unroll") for (int m = 0; m < 4; ++m) _Pragma("unroll") for (int n = 0; n < 2; ++n) _Pragma("unroll") for (int k = 0; k < 2; ++k) \
        acc[ai][bj][m][n] = __builtin_amdgcn_mfma_f32_16x16x32_bf16(Bt[n][k], At[m][k], acc[ai][bj][m][n], 0, 0, 0); __builtin_amdgcn_s_setprio(0); } while (0)
#define PG8_WAIT_V(n) asm volatile("s_waitcnt vmcnt(" #n ")" ::: "memory")
#define PG8_WAIT_L(n) asm volatile("s_waitcnt lgkmcnt(" #n ")" ::: "memory")
#define PG8_BAR __builtin_amdgcn_s_barrier()
#define PG8_SCHED __builtin_amdgcn_sched_barrier(0)
    Unit cur, nxt; int ui = 0;
    if (!S.next(0, cur)) return;
    f32x4 acc[2][2][4][2];
#pragma unroll
    for (int a = 0; a < 2; ++a)
#pragma unroll
        for (int b = 0; b < 2; ++b)
#pragma unroll
            for (int m = 0; m < 4; ++m)
#pragma unroll
                for (int n = 0; n < 2; ++n) acc[a][b][m][n] = (f32x4){0.f, 0.f, 0.f, 0.f};
    bf16x8 At[4][2], B0[2][2], B1[2][2];
    const char* cA = cur.a; const char* cB = cur.b;
    if constexpr (SP2) {
        PG8_STAGE(PG8_SB(0, 0), cB, voffB); PG8_STAGE(PG8_SB(0, 1), cB + hstepB, voffB); PG8_STAGE(PG8_SA(0, 0), cA, voffA); PG8_STAGE(PG8_SA(0, 1), cA + hstepA, voffA);
        if (wr == 1) PG8_BAR;
        PG8_WAIT_V(2); PG8_BAR;
        PG8_STAGE(PG8_SB(1, 0), cB + kstep, voffB); PG8_STAGE(PG8_SA(1, 0), cA + kstep, voffA); PG8_STAGE(PG8_SB(1, 1), cB + hstepB + kstep, voffB);
        PG8_WAIT_V(6); PG8_BAR;
    } else {
        PG8_STAGE(PG8_SB(0, 0), cB, voffB); PG8_STAGE(PG8_SA(0, 0), cA, voffA); PG8_STAGE(PG8_SB(0, 1), cB + hstepB, voffB); PG8_STAGE(PG8_SA(0, 1), cA + hstepA, voffA);
        if (wr == 1) PG8_BAR;
        PG8_WAIT_V(4); PG8_BAR;
        PG8_STAGE(PG8_SB(1, 0), cB + kstep, voffB); PG8_STAGE(PG8_SA(1, 0), cA + kstep, voffA); PG8_STAGE(PG8_SB(1, 1), cB + hstepB + kstep, voffB);
        PG8_WAIT_V(6); PG8_BAR;
    }
    for (;;) {
        const bool has_next = S.next(ui + 1, nxt);
        const char* nA = has_next ? nxt.a : cA; const char* nB = has_next ? nxt.b : cB;
        for (int t = 0; t < nt; t += 2) {
            const bool last = (t == nt - 2);
            const char* a1 = cA + (size_t)(t + 1) * kstep;
            const char* a2 = last ? nA : cA + (size_t)(t + 2) * kstep; const char* b2 = last ? nB : cB + (size_t)(t + 2) * kstep;
            const char* a3 = a2 + kstep; const char* b3 = b2 + kstep;
            if constexpr (SP2) {
            PG8_LDB(B0, 0, 0); PG8_LDB(B1, 0, 1); PG8_SCHED; PG8_LDA(At, 0, 0); PG8_STAGE(PG8_SA(1, 1), a1 + hstepA, voffA);
            PG8_WAIT_V(8); PG8_WAIT_L(0); PG8_BAR; PG8_MMA(0, 0, At, B0); PG8_MMA(0, 1, At, B1); PG8_BAR; PG8_SCHED;
            PG8_LDA(At, 0, 1); PG8_STAGE(PG8_SB(0, 0), b2, voffB); PG8_STAGE(PG8_SB(0, 1), b2 + hstepB, voffB); PG8_STAGE(PG8_SA(0, 0), a2, voffA);
            PG8_WAIT_V(8); PG8_WAIT_L(0); PG8_BAR; PG8_MMA(1, 0, At, B0); PG8_MMA(1, 1, At, B1); PG8_BAR; PG8_SCHED;
            PG8_LDB(B0, 1, 0); PG8_LDB(B1, 1, 1); PG8_SCHED; PG8_LDA(At, 1, 0); PG8_STAGE(PG8_SA(0, 1), a2 + hstepA, voffA);
            PG8_WAIT_V(8); PG8_WAIT_L(0); PG8_BAR; PG8_MMA(0, 0, At, B0); PG8_MMA(0, 1, At, B1); PG8_BAR; PG8_SCHED;
            PG8_LDA(At, 1, 1); PG8_STAGE(PG8_SB(1, 0), b3, voffB); PG8_STAGE(PG8_SB(1, 1), b3 + hstepB, voffB); PG8_STAGE(PG8_SA(1, 0), a3, voffA);
            PG8_WAIT_V(8); PG8_WAIT_L(0); PG8_BAR; PG8_MMA(1, 0, At, B0); PG8_MMA(1, 1, At, B1); PG8_BAR; PG8_SCHED;
            } else {
            PG8_LDB(B0, 0, 0); PG8_SCHED; PG8_LDA(At, 0, 0); PG8_STAGE(PG8_SA(1, 1), a1 + hstepA, voffA);
            PG8_WAIT_L(8); PG8_BAR; PG8_WAIT_L(0); PG8_MMA(0, 0, At, B0); PG8_BAR; PG8_SCHED;
            PG8_LDB(B1, 0, 1); PG8_STAGE(PG8_SB(0, 0), b2, voffB);
            PG8_BAR; PG8_WAIT_L(0); PG8_MMA(0, 1, At, B1); PG8_BAR;
            PG8_LDA(At, 0, 1); PG8_STAGE(PG8_SA(0, 0), a2, voffA);
            PG8_BAR; PG8_WAIT_L(0); PG8_MMA(1, 0, At, B0); PG8_BAR; PG8_SCHED;
            PG8_STAGE(PG8_SB(0, 1), b2 + hstepB, voffB);
            PG8_WAIT_V(6); PG8_BAR; PG8_MMA(1, 1, At, B1); PG8_BAR;
            PG8_LDB(B0, 1, 0); PG8_SCHED; PG8_LDA(At, 1, 0); PG8_STAGE(PG8_SA(0, 1), a2 + hstepA, voffA);
            PG8_WAIT_L(8); PG8_BAR; PG8_WAIT_L(0); PG8_MMA(0, 0, At, B0); PG8_BAR; PG8_SCHED;
            PG8_LDB(B1, 1, 1); PG8_STAGE(PG8_SB(1, 0), b3, voffB);
            PG8_BAR; PG8_WAIT_L(0); PG8_MMA(0, 1, At, B1); PG8_BAR;
            PG8_LDA(At, 1, 1); PG8_STAGE(PG8_SA(1, 0), a3, voffA);
            PG8_BAR; PG8_WAIT_L(0); PG8_MMA(1, 0, At, B0); PG8_BAR; PG8_SCHED;
            PG8_STAGE(PG8_SB(1, 1), b3 + hstepB, voffB);
            PG8_WAIT_V(6); PG8_BAR; PG8_MMA(1, 1, At, B1); PG8_BAR;
            }
        }
        if constexpr (ALIGN_EPI) { if (wr == 0) PG8_BAR; }
        E(acc, cur, wr, wc, fr, fq);
        if (!has_next) break;
#pragma unroll
        for (int a = 0; a < 2; ++a)
#pragma unroll
            for (int b = 0; b < 2; ++b)
#pragma unroll
                for (int m = 0; m < 4; ++m)
#pragma unroll
                    for (int n = 0; n < 2; ++n) acc[a][b][m][n] = (f32x4){0.f, 0.f, 0.f, 0.f};
        cur = nxt; cA = nA; cB = nB; ++ui;
        if constexpr (ALIGN_EPI) { if (wr == 1) PG8_BAR; }
    }
    PG8_WAIT_V(0);
    if constexpr (!ALIGN_EPI) { if (wr == 0) PG8_BAR; }
    PG8_BAR;
    #undef PG8_SA
#undef PG8_SB
#undef PG8_STAGE
#undef PG8_LDA
#undef PG8_LDB
#undef PG8_MMA
#undef PG8_WAIT_V
#undef PG8_WAIT_L
#undef PG8_BAR
#undef PG8_SCHED
}
}

#ifndef PG8_SP2
#define PG8_SP2 true
#endif
#ifndef PG8_ALIGN
#define PG8_ALIGN true
#endif

constexpr int T = 16384, D = 2048, DEPTH = 2;
constexpr int RWW = 1024;
constexpr int NCMP = 1023, NSELB = 256;
constexpr int NEXP = 32, FF = 512;
constexpr int LDP = 10496;
constexpr int NG = 6144;
constexpr int PC_RW_R = 0, PC_RW_K = 1024, PC_RW_V = 2048, PC_NQ = 3072, PC_KC = 4096, PC_VC = 4352, PC_KS = 4608, PC_VS = 4864, PC_KW = 5120, PC_VW = 5376,
              PC_RQ = 5632, PC_RK = 6656, PC_RV = 7680, PC_RG = 8704, PC_XW = 9728, PC_XA = 9824, PC_XG = 9920, PC_XV = 10176, PC_GATE = 10240;
constexpr float DN_ALPHA = 1.41421356237f, LN_EPS = 1e-5f;

constexpr size_t MiB = 1u << 20;
constexpr size_t WS_CTL = 0, CTL_ZERO_BYTES = 1 * MiB;
constexpr size_t WS_TEXP = 1 * MiB, WS_TOKE = WS_TEXP + 65536, WS_TOKW = WS_TOKE + 131072, WS_SLOT = WS_TOKW + 131072;
constexpr size_t WS_KCMPB = 2 * MiB, WS_VCMPT = 3 * MiB, WS_RKB = 4 * MiB, WS_COS = 8 * MiB, WS_SIN = 12 * MiB;
constexpr size_t WS_WIN = 16 * MiB, WS_WG = 57 * MiB, WS_WBR = 81 * MiB, WS_WOUT = 93 * MiB;
constexpr size_t WS_XB = 112 * MiB, WS_VF = 176 * MiB, WS_PROJ = 208 * MiB;
constexpr size_t WS_RW_R = 536 * MiB, WS_RW_K = 568 * MiB, WS_RW_V = 600 * MiB, WS_RW_KK = 632 * MiB, WS_RW_B = 664 * MiB, WS_RW_W = 696 * MiB, WS_RW_G = 760 * MiB;
constexpr size_t WS_YRW = 800 * MiB, WS_YNSA = 832 * MiB, WS_YRET = 864 * MiB;
constexpr size_t WS_RWP = 896 * MiB, WS_RWU = 912 * MiB, WS_RWS = 928 * MiB, WS_RETKV = 944 * MiB, WS_KFS = 1008 * MiB, WS_VFS = 1016 * MiB, WS_KFW = 1024 * MiB, WS_VFW = 1032 * MiB, WS_END = 1040 * MiB;
constexpr size_t WS_GATES = 536 * MiB, WS_MERGED = 728 * MiB;
constexpr size_t WS_WGU = 208 * MiB, WS_WDN = 336 * MiB, WS_XS = 400 * MiB, WS_H = 560 * MiB, WS_YS = 600 * MiB;
static_assert(WS_PROJ + (size_t)T * LDP * 2 <= WS_RW_R && WS_GATES + (size_t)T * NG * 2 <= WS_MERGED && WS_MERGED + (size_t)T * D * 2 <= WS_YRW, "ws map");
static_assert(WS_XS + (size_t)160 * 256 * D * 2 <= WS_H && WS_H + (size_t)160 * 256 * FF * 2 <= WS_YS && WS_YS + (size_t)160 * 256 * D * 2 <= WS_RW_G, "ws map moe");
constexpr int CW_TMO = 0, CW_CNT = 1024, CW_CUR = 1088, CW_BAR = 4096;
constexpr int LDS_BYTES = 147456, LDS_BARW = LDS_BYTES - 64;

#define GAS __attribute__((address_space(1)))
#define LAS __attribute__((address_space(3)))
typedef unsigned short bf16;
typedef float f32x4 __attribute__((ext_vector_type(4)));
typedef unsigned u32x4 __attribute__((ext_vector_type(4)));
#define LDS_WAIT() asm volatile("s_waitcnt lgkmcnt(0)" ::: "memory")
#define VM_WAIT() asm volatile("s_waitcnt vmcnt(0)" ::: "memory")

__device__ __forceinline__ float bf2f(unsigned short b) { return __uint_as_float(((unsigned)b) << 16); }
__device__ __forceinline__ unsigned f2bf(float f) { unsigned u = __float_as_uint(f); return (u + 0x7fffu + ((u >> 16) & 1u)) >> 16; }
__device__ __forceinline__ unsigned pk2(float lo, float hi) { return f2bf(lo) | (f2bf(hi) << 16); }
__device__ __forceinline__ float bflo(unsigned w) { return __uint_as_float(w << 16); }
__device__ __forceinline__ float bfhi(unsigned w) { return __uint_as_float(w & 0xffff0000u); }
__device__ __forceinline__ float wave_sum(float v) {
#pragma unroll
    for (int o = 1; o < 64; o <<= 1) v += __shfl_xor(v, o);
    return v;
}
__device__ __forceinline__ float wave_max(float v) {
#pragma unroll
    for (int o = 1; o < 64; o <<= 1) v = fmaxf(v, __shfl_xor(v, o));
    return v;
}
__device__ __forceinline__ int wave_min_i(int v) {
#pragma unroll
    for (int o = 1; o < 64; o <<= 1) { const int w = __shfl_xor(v, o); v = w < v ? w : v; }
    return v;
}
__device__ __forceinline__ float sigm(float x) { return 1.f / (1.f + expf(-x)); }
__device__ __forceinline__ float sigm_fast(float x) { return __builtin_amdgcn_rcpf(1.f + __builtin_amdgcn_exp2f(-1.4426950408889634f * x)); }

__device__ const double INV_FREQ[64] = {1.00000000000000000e+00, 8.63988449483968579e-01, 7.46476040841712152e-01, 6.44946677103762411e-01, 5.57226479550717357e-01, 4.81437242078434580e-01, 4.15956216307184767e-01, 3.59381366380462752e-01, 3.10501349512486036e-01, 2.68269579527972590e-01, 2.31781818060089240e-01, 2.00256813604311801e-01, 1.73019573884589412e-01, 1.49486913370923374e-01, 1.29154966501488389e-01, 1.11588399250774864e-01, 9.64110880490750138e-02, 8.32980664765826800e-02, 7.19685673001152076e-02, 6.21800108732091794e-02, 5.37228111832403141e-02, 4.64158883361278016e-02, 4.01027913949520837e-02, 3.46483485573036779e-02, 2.99357729472049007e-02, 2.58641620527596990e-02, 2.23463372691659473e-02, 1.93069772888325060e-02, 1.66810053720005923e-02, 1.44121959671885402e-02, 1.24519708473503302e-02, 1.07583589854217902e-02, 9.29509789880649494e-03, 8.03085722139152032e-03, 6.93856787873718770e-03, 5.99484250318940964e-03, 5.17947467923121282e-03, 4.47500629725045354e-03, 3.86635375219241198e-03, 3.34048498351324471e-03, 2.88614044143008968e-03, 2.49359200498416086e-03, 2.15443469003188427e-03, 1.86140668735512152e-03, 1.60823387766704205e-03, 1.38949549437313892e-03, 1.20050805774840792e-03, 1.03722509540705695e-03, 8.96150501946605012e-04, 7.74263682681127744e-04, 6.68954878691414585e-04, 5.77969288415331340e-04, 4.99358789347314927e-04, 4.31440226144378508e-04, 3.72759372031494166e-04, 3.22059791872108224e-04, 2.78255940220712632e-04, 2.40409918350997456e-04, 2.07711392596645640e-04, 1.79460244029731636e-04, 1.55051577983262559e-04, 1.33962772451801717e-04, 1.15742288059205792e-04, 1.00000000000000005e-04};
__device__ const float RET_LOGG[8] = {-0.0317486983145803f, -0.015748356968139168f, -0.007843177461025893f, -0.003913899321136329f, -0.0019550348358033506f, -0.0009770396478266127f, -0.0004884004981088745f, -0.0002441704321739145f};

#define XB_TMO      128
#define XB_XCNT(j)  (256  + 64 * (j))
#define XB_XSUB(j)  (1280 + 64 * (j))
#define XB_XGEN(j)  (2304 + 64 * (j))
#define XB_TOP      3328
#define XB_TOPGEN   3392
#define XCD_BAR_WORDS 3456
#define XB_SPIN_CAP (1u << 18)

__device__ __forceinline__ unsigned xb_ld(unsigned* p)              { return __hip_atomic_load(p, __ATOMIC_RELAXED, __HIP_MEMORY_SCOPE_AGENT); }
__device__ __forceinline__ unsigned xb_add(unsigned* p, unsigned v) { return __hip_atomic_fetch_add(p, v, __ATOMIC_RELAXED, __HIP_MEMORY_SCOPE_AGENT); }
__device__ __forceinline__ unsigned xb_xcc_id() { return (unsigned)__builtin_amdgcn_s_getreg((3 << 11) | 20) & 0xFu; }
#define XB_SPIN(cond, bar) do { unsigned _sp = 0; while (cond) { __builtin_amdgcn_s_sleep(1); \
    if ((++_sp & 255u) == 0u) { if (xb_ld(&(bar)[XB_TMO])) break; if (_sp > XB_SPIN_CAP) { atomicAdd(&(bar)[XB_TMO], 1u); break; } } } } while (0)

struct XcdBarrier {
    unsigned* bar; unsigned x;
    volatile LAS unsigned* st;
};
__device__ __forceinline__ XcdBarrier xcd_barrier_post(unsigned* bar, volatile LAS unsigned* st) {
    XcdBarrier b; b.bar = bar; b.x = xb_xcc_id(); b.st = st;
    if (threadIdx.x == 0) (void)xb_add(&bar[XB_XCNT(b.x)], 1u);
    return b;
}
__device__ __forceinline__ void xcd_barrier_complete(unsigned* bar, unsigned x, unsigned& nloc, unsigned& nx) {
    const unsigned G = gridDim.x * gridDim.y * gridDim.z;
    unsigned sum, cnt, mine, sp = 0u;
    for (;;) {
        sum = 0u; cnt = 0u; mine = 0u;
#pragma unroll
        for (unsigned j = 0; j < 16; ++j) { const unsigned c = xb_ld(&bar[XB_XCNT(j)]); sum += c; cnt += (c > 0u) ? 1u : 0u; mine = (j == x) ? c : mine; }
        if (sum == G) break;
        __builtin_amdgcn_s_sleep(1);
        if ((++sp & 255u) == 0u) { if (xb_ld(&bar[XB_TMO])) break; if (sp > XB_SPIN_CAP) { atomicAdd(&bar[XB_TMO], 1u); break; } }
    }
    nloc = mine > 0u ? mine : 1u; nx = cnt > 0u ? cnt : 1u;
}
__device__ __forceinline__ void xcd_barrier(const XcdBarrier& b) {
    asm volatile("s_waitcnt vmcnt(0)" ::: "memory");
    __syncthreads();
    if (threadIdx.x == 0) {
        unsigned* bar = b.bar;
        __builtin_amdgcn_s_waitcnt(0);
        unsigned nloc = b.st[0], nx = b.st[1];
        if (nloc == 0u) { xcd_barrier_complete(bar, b.x, nloc, nx); b.st[0] = nloc; b.st[1] = nx; }
        const unsigned old = xb_add(&bar[XB_XSUB(b.x)], 1u);
        const unsigned gen = old / nloc;
        if (old + 1u == (gen + 1u) * nloc) {
            __builtin_amdgcn_fence(__ATOMIC_RELEASE, "agent");
            asm volatile("s_waitcnt vmcnt(0)" ::: "memory");
            const unsigned og = xb_add(&bar[XB_TOP], 1u);
            const unsigned tg = og / nx;
            if (og + 1u == (tg + 1u) * nx) xb_add(&bar[XB_TOPGEN], 1u);
            else XB_SPIN(xb_ld(&bar[XB_TOPGEN]) == tg, bar);
            __builtin_amdgcn_fence(__ATOMIC_ACQUIRE, "agent");
            xb_add(&bar[XB_XGEN(b.x)], 1u);
            asm volatile("s_waitcnt vmcnt(0)" ::: "memory");
        } else {
            XB_SPIN(xb_ld(&bar[XB_XGEN(b.x)]) == gen, bar);
            __builtin_amdgcn_fence(__ATOMIC_ACQUIRE, "agent");
            asm volatile("s_waitcnt vmcnt(0)" ::: "memory");
        }
    }
    __syncthreads();
}

#if defined(__HIP_DEVICE_COMPILE__)
#define ASSUME_GLOBAL(p) do { __builtin_assume(!__builtin_amdgcn_is_shared((const __attribute__((address_space(0))) void*)(p))); __builtin_assume(!__builtin_amdgcn_is_private((const __attribute__((address_space(0))) void*)(p))); } while (0)
#else
#define ASSUME_GLOBAL(p) do { } while (0)
#endif
struct Args { const float* in[36]; float* out; unsigned char* ws; int ph_lo, ph_hi; };
constexpr int LDS_PTAB = LDS_BYTES - 512;
struct PA { unsigned char* ws; float* out; const LAS unsigned* tab;
    __device__ __forceinline__ const float* in(int i) const { const unsigned lo = __builtin_amdgcn_readfirstlane(tab[2 * i]), hi = __builtin_amdgcn_readfirstlane(tab[2 * i + 1]);
        return (const float*)(const GAS float*)(((unsigned long long)hi << 32) | lo); } };

using pg8::Unit; using pg8::Gemm; using pg8::TileOrder;
struct SchedPlain {
    TileOrder to; int G, c, tid; const char* A; const char* B; size_t ta, tb;
    __device__ __forceinline__ bool next(int i, Unit& u) const {
        if (!to.tile((long)i * G + c, u.pm, u.pn)) return false;
        u.a = A + (size_t)u.pm * ta; u.b = B + (size_t)u.pn * tb; u.aux = 0; return true; }
};
struct SchedBranch {
    TileOrder to; int G, c, tid; const char* A0; const char* B0; size_t sa, sb, ta, tb;
    __device__ __forceinline__ bool next(int i, Unit& u) const {
        const int br = i % 3;
        if (!to.tile((long)(i / 3) * G + c, u.pm, u.pn)) return false;
        u.a = A0 + (size_t)br * sa + (size_t)u.pm * ta; u.b = B0 + (size_t)br * sb + (size_t)u.pn * tb; u.aux = br; return true; }
};
struct SchedMoe {
    int nM, nN, G, c, tid; const char* A; const char* B; size_t ta, tb, te; const int* texp;
    __device__ __forceinline__ bool next(int i, Unit& u) const {
        const long L = (long)i * G + c; if (L >= (long)nM * nN) return false;
        u.pm = (int)(L % nM); u.pn = (int)(L / nM); const int e = texp[u.pm];
        u.a = A + (size_t)u.pm * ta; u.b = B + (size_t)e * te + (size_t)u.pn * tb; u.aux = e; return true; }
};
template <int ACT  > struct EpiStore {
    static constexpr bool PERM = true;
    bf16* O; int ldc;
    __device__ __forceinline__ void operator()(const f32x4 (&acc)[2][2][4][2], const Unit& u, int wr, int wc, int fr, int fq) const {
        const int row0 = u.pm * 256 + wr * 64 + fr, col0 = u.pn * 256 + wc * 32 + 8 * fq;
#pragma unroll
        for (int ai = 0; ai < 2; ++ai)
#pragma unroll
            for (int m = 0; m < 4; ++m) { bf16* rowp = O + (size_t)(row0 + ai * 128 + m * 16) * ldc + col0;
#pragma unroll
                for (int bj = 0; bj < 2; ++bj) { f32x4 v0 = acc[ai][bj][m][0], v1 = acc[ai][bj][m][1];
                    if (ACT == 1) {
#pragma unroll
                        for (int j = 0; j < 4; ++j) { v0[j] = sigm_fast(v0[j]); v1[j] = sigm_fast(v1[j]); } }
                    u32x4 w; w.x = pg8::cvt_pk_bf16(v0[0], v0[1]); w.y = pg8::cvt_pk_bf16(v0[2], v0[3]); w.z = pg8::cvt_pk_bf16(v1[0], v1[1]); w.w = pg8::cvt_pk_bf16(v1[2], v1[3]);
                    *(u32x4*)(rowp + bj * 128) = w; __builtin_amdgcn_sched_barrier(0); } }
    }
};
struct EpiBranch {
    static constexpr bool PERM = true;
    bf16* Mg; const bf16* Gt;
    __device__ __forceinline__ void operator()(const f32x4 (&acc)[2][2][4][2], const Unit& u, int wr, int wc, int fr, int fq) const {
        const int row0 = u.pm * 256 + wr * 64 + fr, col0 = u.pn * 256 + wc * 32 + 8 * fq, br = u.aux;
#pragma unroll
        for (int ai = 0; ai < 2; ++ai)
#pragma unroll
            for (int m = 0; m < 4; ++m) { const size_t r = (size_t)(row0 + ai * 128 + m * 16);
#pragma unroll
                for (int bj = 0; bj < 2; ++bj) { const int col = col0 + bj * 128;
                    const u32x4 gw = *(const u32x4*)(Gt + r * NG + br * 2048 + col);
                    f32x4 v0 = acc[ai][bj][m][0], v1 = acc[ai][bj][m][1];
                    v0[0] *= bflo(gw.x); v0[1] *= bfhi(gw.x); v0[2] *= bflo(gw.y); v0[3] *= bfhi(gw.y); v1[0] *= bflo(gw.z); v1[1] *= bfhi(gw.z); v1[2] *= bflo(gw.w); v1[3] *= bfhi(gw.w);
                    bf16* mp = Mg + r * D + col;
                    if (br != 0) { const u32x4 ow = *(const u32x4*)mp;
                        v0[0] += bflo(ow.x); v0[1] += bfhi(ow.x); v0[2] += bflo(ow.y); v0[3] += bfhi(ow.y); v1[0] += bflo(ow.z); v1[1] += bfhi(ow.z); v1[2] += bflo(ow.w); v1[3] += bfhi(ow.w); }
                    u32x4 w; w.x = pg8::cvt_pk_bf16(v0[0], v0[1]); w.y = pg8::cvt_pk_bf16(v0[2], v0[3]); w.z = pg8::cvt_pk_bf16(v1[0], v1[1]); w.w = pg8::cvt_pk_bf16(v1[2], v1[3]);
                    *(u32x4*)mp = w; __builtin_amdgcn_sched_barrier(0); } }
    }
};
struct EpiResid {
    static constexpr bool PERM = true;
    float* X;
    __device__ __forceinline__ void operator()(const f32x4 (&acc)[2][2][4][2], const Unit& u, int wr, int wc, int fr, int fq) const {
        const int row0 = u.pm * 256 + wr * 64 + fr, col0 = u.pn * 256 + wc * 32 + 8 * fq;
#pragma unroll
        for (int ai = 0; ai < 2; ++ai)
#pragma unroll
            for (int m = 0; m < 4; ++m) { float* rowp = X + (size_t)(row0 + ai * 128 + m * 16) * D + col0;
#pragma unroll
                for (int bj = 0; bj < 2; ++bj) { f32x4* p = (f32x4*)(rowp + bj * 128);
                    const f32x4 x0 = p[0], x1 = p[1];
                    p[0] = x0 * DN_ALPHA + acc[ai][bj][m][0]; p[1] = x1 * DN_ALPHA + acc[ai][bj][m][1]; __builtin_amdgcn_sched_barrier(0); } }
    }
};
struct EpiGateUp {
    static constexpr bool PERM = true;
    bf16* H;
    __device__ __forceinline__ void operator()(const f32x4 (&acc)[2][2][4][2], const Unit& u, int wr, int wc, int fr, int fq) const {
        const int row0 = u.pm * 256 + wr * 64 + fr, col0 = u.pn * 128 + wc * 32 + 8 * fq;
#pragma unroll
        for (int ai = 0; ai < 2; ++ai)
#pragma unroll
            for (int m = 0; m < 4; ++m) { bf16* rowp = H + (size_t)(row0 + ai * 128 + m * 16) * FF + col0;
                f32x4 h0, h1;
#pragma unroll
                for (int j = 0; j < 4; ++j) { const float g0 = acc[ai][0][m][0][j], g1 = acc[ai][0][m][1][j];
                    h0[j] = g0 * sigm_fast(g0) * acc[ai][1][m][0][j]; h1[j] = g1 * sigm_fast(g1) * acc[ai][1][m][1][j]; }
                u32x4 w; w.x = pg8::cvt_pk_bf16(h0[0], h0[1]); w.y = pg8::cvt_pk_bf16(h0[2], h0[3]); w.z = pg8::cvt_pk_bf16(h1[0], h1[1]); w.w = pg8::cvt_pk_bf16(h1[2], h1[3]);
                *(u32x4*)rowp = w; }
    }
};

struct Ctx { LAS unsigned char* lds; int tid, lane, wave, G, bx, gw, NGW; };

template <class SRC>
__device__ __forceinline__ void transpose_task(const Ctx& c, const SRC& src, int ldsrc, int K, bf16* dst, int ndst) {
    LAS float* scr = (LAS float*)(c.lds + c.wave * 8704);
    const int nblk = ndst / 32, items = (K / 64) * nblk, lane = c.lane;
    for (int it = c.gw; it < items; it += c.NGW) {
        const int kb = it / nblk, nb = it % nblk, k0 = 64 * kb, n0 = 32 * nb;
        const float* sp = src(n0 + (lane & 31));
#pragma unroll 8
        for (int i = 0; i < 32; ++i) { const int kk = 2 * i + (lane >> 5); scr[kk * 33 + (lane & 31)] = sp ? sp[(size_t)(k0 + kk) * ldsrc] : 0.f; }
        LDS_WAIT();
        const int cc = lane & 7;
#pragma unroll
        for (int j = 0; j < 4; ++j) { const int n = (lane >> 3) + 8 * j; const LAS float* s = scr + (8 * cc) * 33 + n;
            u32x4 o; o.x = pk2(s[0 * 33], s[1 * 33]); o.y = pk2(s[2 * 33], s[3 * 33]); o.z = pk2(s[4 * 33], s[5 * 33]); o.w = pk2(s[6 * 33], s[7 * 33]);
            *(u32x4*)(dst + (size_t)(n0 + n) * K + k0 + 8 * cc) = o; }
        LDS_WAIT();
    }
}
struct SrcWin { const float* W; int layer;
    __device__ __forceinline__ const float* operator()(int n) const {
        const int rw = layer ? 3584 : 3520; int sc;
        if (n < 3072) sc = n; else if (n < 5632) sc = rw + (n - 3072); else if (n < 9728) sc = rw + 2608 + (n - 5632); else if (n < 10176) sc = 3072 + (n - 9728);
        else if (n < 10240) sc = layer ? 3520 + (n - 10176) : -1; else if (n < 10288) sc = rw + 2560 + (n - 10240); else sc = -1;
        return sc >= 0 ? W + sc : nullptr; } };
struct SrcOff { const float* W; __device__ __forceinline__ const float* operator()(int n) const { return W + n; } };
struct SrcGU { const float* Wg; const float* Wu;
    __device__ __forceinline__ const float* operator()(int nn) const { const int e = nn >> 10, r1 = nn & 1023, pn = r1 >> 8, rr = r1 & 255;
        const size_t du = (size_t)((const char*)Wu - (const char*)Wg);
        return (const float*)((const char*)Wg + (rr < 128 ? (size_t)0 : du)) + (size_t)e * D * FF + 128 * pn + (rr & 127); } };
struct SrcDN { const float* Wd;
    __device__ __forceinline__ const float* operator()(int nn) const { const int e = nn >> 11, n = nn & 2047; return Wd + (size_t)e * FF * D + n; } };

__device__ __forceinline__ void ph_conv(const Ctx& c, const PA& a, int layer) {
    unsigned char* ws = a.ws;
    const float* Win = layer ? a.in(2) : a.in(1); const int ldw = layer ? 16432 : 16368, rw = layer ? 3584 : 3520;
    transpose_task(c, SrcWin{Win, layer}, ldw, D, (bf16*)(ws + WS_WIN), LDP);
    transpose_task(c, SrcOff{Win + rw + 2608 + 4096}, ldw, D, (bf16*)(ws + WS_WG), NG);
    transpose_task(c, SrcOff{a.in(21) + (size_t)layer * RWW * D}, D, RWW, (bf16*)(ws + WS_WBR), D);
    transpose_task(c, SrcOff{a.in(22) + (size_t)layer * RWW * D}, D, RWW, (bf16*)(ws + WS_WBR) + (size_t)D * RWW, D);
    transpose_task(c, SrcOff{a.in(23) + (size_t)layer * RWW * D}, D, RWW, (bf16*)(ws + WS_WBR) + (size_t)2 * D * RWW, D);
    transpose_task(c, SrcOff{a.in(24) + (size_t)layer * D * D}, D, D, (bf16*)(ws + WS_WOUT), D);
    if (layer == 0) {
        const f32x4* x4 = (const f32x4*)a.in(0); f32x4* o4 = (f32x4*)a.out; uint2* xb = (uint2*)(ws + WS_XB);
        for (size_t i = (size_t)c.bx * 512 + c.tid; i < (size_t)T * D / 4; i += (size_t)c.G * 512) { const f32x4 v = x4[i]; o4[i] = v; xb[i] = make_uint2(pk2(v[0], v[1]), pk2(v[2], v[3])); }
        float* cs = (float*)(ws + WS_COS); float* sn = (float*)(ws + WS_SIN);
        for (int i = c.bx * 512 + c.tid; i < T * 64; i += c.G * 512) { const int t = i >> 6, j = i & 63;
            const double rev = (double)t * INV_FREQ[j] * 0.15915494309189533577; const float fr = (float)(rev - __builtin_rint(rev));
            cs[i] = __builtin_amdgcn_cosf(fr); sn[i] = __builtin_amdgcn_sinf(fr); }
    }
}
__device__ __forceinline__ void ph_conv_moe(const Ctx& c, const PA& a, int layer) {
    unsigned char* ws = a.ws; const size_t lo = (size_t)layer * NEXP * D * FF;
    transpose_task(c, SrcGU{a.in(31) + lo, a.in(32) + lo}, FF, D, (bf16*)(ws + WS_WGU), NEXP * 1024);
    transpose_task(c, SrcDN{a.in(33) + lo}, D, FF, (bf16*)(ws + WS_WDN), NEXP * D);
}

__device__ __forceinline__ float softplusf_(float x) { return fmaxf(x, 0.f) + log1pf(expf(-fabsf(x))); }
__device__ __forceinline__ void prep_rwkv(const Ctx& c, const PA& a, int layer) {
    unsigned char* ws = a.ws; const bf16* proj = (const bf16*)(ws + WS_PROJ);
    LAS float* sh_r = (LAS float*)c.lds; LAS float* sh_k = sh_r + 8 * 1024; LAS float* sh_v = sh_k + 8 * 1024; LAS float* sh_x = sh_v + 8 * 1024;
    bf16* oR = (bf16*)(ws + WS_RW_R); bf16* oK = (bf16*)(ws + WS_RW_K); bf16* oV = (bf16*)(ws + WS_RW_V); bf16* oKK = (bf16*)(ws + WS_RW_KK); bf16* oB = (bf16*)(ws + WS_RW_B);
    float* oW = (float*)(ws + WS_RW_W); bf16* oG = (bf16*)(ws + WS_RW_G); bf16* VF = (bf16*)(ws + WS_VF); float* rkb = (float*)(ws + WS_RKB);
    const int lane = c.lane, w = c.wave, tid = c.tid;
    for (int it = c.bx; it < T / 8; it += c.G) {
        const int t = it * 8 + w;
        const bf16* prow = proj + (size_t)t * LDP; const bf16* pprev = prow - LDP;
        const float* mu = a.in(layer ? 4 : 3);
#pragma unroll
        for (int i = 0; i < 6; ++i) { const int c8 = (lane + 64 * i) * 8;
            const u32x4 p = *(const u32x4*)(prow + c8); u32x4 q = (u32x4){0u, 0u, 0u, 0u}; if (t > 0) q = *(const u32x4*)(pprev + c8);
            const f32x4 m0 = *(const f32x4*)(mu + c8), m1 = *(const f32x4*)(mu + c8 + 4);
            float pv[8] = {bflo(p.x), bfhi(p.x), bflo(p.y), bfhi(p.y), bflo(p.z), bfhi(p.z), bflo(p.w), bfhi(p.w)};
            float qv[8] = {bflo(q.x), bfhi(q.x), bflo(q.y), bfhi(q.y), bflo(q.z), bfhi(q.z), bflo(q.w), bfhi(q.w)};
            LAS float* dstp = (c8 < 1024 ? sh_r + w * 1024 + c8 : (c8 < 2048 ? sh_k + w * 1024 + (c8 - 1024) : sh_v + w * 1024 + (c8 - 2048)));
#pragma unroll
            for (int j = 0; j < 8; ++j) { const float mm = j < 4 ? m0[j] : m1[j - 4]; dstp[j] = pv[j] + (qv[j] - pv[j]) * mm; } }
        { const int i8 = lane * 8; int sc, mi, fn;
            if (i8 < 96) { sc = PC_XW + i8; mi = 3072 + i8; fn = 1; } else if (i8 < 192) { sc = PC_XA + (i8 - 96); mi = 3168 + (i8 - 96); fn = 0; }
            else if (i8 < 448) { sc = PC_XG + (i8 - 192); mi = 3264 + (i8 - 192); fn = 2; } else { sc = PC_XV + (i8 - 448); mi = 3520 + (i8 - 448); fn = layer ? 0 : 3; }
            const u32x4 p = *(const u32x4*)(prow + sc); u32x4 q = (u32x4){0u, 0u, 0u, 0u}; if (t > 0) q = *(const u32x4*)(pprev + sc);
            float pv[8] = {bflo(p.x), bfhi(p.x), bflo(p.y), bfhi(p.y), bflo(p.z), bfhi(p.z), bflo(p.w), bfhi(p.w)};
            float qv[8] = {bflo(q.x), bfhi(q.x), bflo(q.y), bfhi(q.y), bflo(q.z), bfhi(q.z), bflo(q.w), bfhi(q.w)};
#pragma unroll
            for (int j = 0; j < 8; ++j) { float s = 0.f;
                if (fn != 3) { const float mm = mu[mi + j]; s = pv[j] + (qv[j] - pv[j]) * mm; if (fn == 1) s = tanhf(s); else if (fn == 2) s = sigm(s); }
                sh_x[w * 512 + i8 + j] = s; } }
        __syncthreads();
        float sw[8][2], sa[8][2], sg[8][2], sv[8][2];
#pragma unroll
        for (int k = 0; k < 8; ++k) { sw[k][0] = sw[k][1] = sa[k][0] = sa[k][1] = sg[k][0] = sg[k][1] = sv[k][0] = sv[k][1] = 0.f; }
        { const float* w_up = a.in(6) + (size_t)layer * 96 * 1024; const float* a_up = a.in(8) + (size_t)layer * 96 * 1024;
        for (int k = 0; k < 96; ++k) { const float u0 = w_up[k * 1024 + tid], u1 = w_up[k * 1024 + tid + 512], b0 = a_up[k * 1024 + tid], b1 = a_up[k * 1024 + tid + 512];
#pragma unroll
            for (int tk = 0; tk < 8; ++tk) { const float x = sh_x[tk * 512 + k], y = sh_x[tk * 512 + 96 + k]; sw[tk][0] += x * u0; sw[tk][1] += x * u1; sa[tk][0] += y * b0; sa[tk][1] += y * b1; } } }
        { const float* g_up = a.in(11) + (size_t)layer * 256 * 1024;
        for (int k = 0; k < 256; ++k) { const float u0 = g_up[k * 1024 + tid], u1 = g_up[k * 1024 + tid + 512];
#pragma unroll
            for (int tk = 0; tk < 8; ++tk) { const float x = sh_x[tk * 512 + 192 + k]; sg[tk][0] += x * u0; sg[tk][1] += x * u1; } } }
        if (layer) { const float* v_up = a.in(10);
        for (int k = 0; k < 64; ++k) { const float u0 = v_up[k * 1024 + tid], u1 = v_up[k * 1024 + tid + 512];
#pragma unroll
            for (int tk = 0; tk < 8; ++tk) { const float x = sh_x[tk * 512 + 448 + k]; sv[tk][0] += x * u0; sv[tk][1] += x * u1; } } }
#pragma unroll
        for (int ci = 0; ci < 2; ++ci) { const int col = tid + 512 * ci, head = w + 8 * ci;
            const float kkc = a.in(12)[layer * 1024 + col], kac = a.in(13)[layer * 1024 + col], rkc = a.in(14)[layer * 1024 + col], w0c = a.in(5)[layer * 1024 + col], a0c = a.in(7)[layer * 1024 + col], v0c = layer ? a.in(9)[col] : 0.f;
#pragma unroll
            for (int tk = 0; tk < 8; ++tk) { const int tt = it * 8 + tk; const size_t o = (size_t)tt * 1024 + col;
                const float k0 = sh_k[tk * 1024 + col], r = sh_r[tk * 1024 + col], v0 = sh_v[tk * 1024 + col];
                const float kkraw = k0 * kkc, n2 = wave_sum(kkraw * kkraw), kkn = kkraw / fmaxf(sqrtf(n2), 1e-12f);
                const float aa = sigm(a0c + sa[tk][ci]), bb = kkn * aa, kf = k0 * (1.f + (aa - 1.f) * kac);
                const float z = w0c + sw[tk][ci], wl = -softplusf_(-z) - 0.5f, dec = expf(-expf(wl));
                float vv = v0;
                if (layer) { const float vf = bf2f(VF[o]); vv = v0 + (vf - v0) * sigm(v0c + sv[tk][ci]); } else VF[o] = (bf16)f2bf(v0);
                const float rk = wave_sum(r * kf * rkc);
                if (lane == 0) rkb[tt * 16 + head] = rk;
                oR[o] = (bf16)f2bf(r); oK[o] = (bf16)f2bf(kf); oV[o] = (bf16)f2bf(vv); oKK[o] = (bf16)f2bf(kkn); oB[o] = (bf16)f2bf(bb); oW[o] = dec; oG[o] = (bf16)f2bf(sg[tk][ci]); } }
        __syncthreads();
    }
}
__device__ __forceinline__ float gelu_tanh(float x) { return 0.5f * x * (1.f + tanhf(0.7978845608028654f * (x + 0.044715f * x * x * x))); }
__device__ __forceinline__ void prep_cmp(const Ctx& c, const PA& a, int layer) {
    unsigned char* ws = a.ws; const bf16* proj = (const bf16*)(ws + WS_PROJ);
    LAS float* sh_in = (LAS float*)c.lds; LAS float* sh_h = sh_in + 4 * 2048;
    const int tid = c.tid;
    for (int it = c.bx; it < NCMP * 2; it += c.G) {
        const int cb = it >> 1, kv = it & 1, col0 = kv ? PC_VC : PC_KC, lk = layer * 2 + kv;
        const float* pe = a.in(17) + (size_t)lk * 2048; const float* w1 = a.in(18) + (size_t)lk * 2048 * 128; const float* b1 = a.in(19) + lk * 128; const float* w2 = a.in(20) + (size_t)lk * 128 * 64;
        for (int idx = tid; idx < 8192; idx += 512) { const int g = idx >> 11, r = idx & 2047, l = r >> 6, d = r & 63;
            sh_in[idx] = bf2f(proj[(size_t)(16 * cb + l) * LDP + col0 + g * 64 + d]) + pe[r]; }
        __syncthreads();
        { const int g = tid >> 7, j = tid & 127; float acc = b1[j]; const LAS float* in = sh_in + g * 2048;
#pragma unroll 8
            for (int i = 0; i < 2048; ++i) acc += in[i] * w1[i * 128 + j];
            sh_h[tid] = gelu_tanh(acc); }
        __syncthreads();
        if (tid < 256) { const int g = tid >> 6, d = tid & 63; float o = 0.f;
#pragma unroll 8
            for (int j = 0; j < 128; ++j) o += sh_h[g * 128 + j] * w2[j * 64 + d];
            { const int blk = cb >> 6, kc = cb & 63;
                if (kv == 0) { const int j = kc >> 4, rr = kc & 15, ks = d >> 5, qq = (d & 31) >> 3, i = d & 7;
                    ((bf16*)(ws + WS_KCMPB))[((((size_t)g * 16 + blk) * 8 + 2 * j + ks) * 64 + qq * 16 + rr) * 8 + i] = (bf16)f2bf(o);
                    if (cb == 0) ((bf16*)(ws + WS_KCMPB))[((((size_t)g * 16 + 15) * 8 + 2 * 3 + ks) * 64 + qq * 16 + 15) * 8 + i] = 0; }
                else { const int ks = kc >> 5, kk = kc & 31, hh = kk >> 4, qq = (kk & 15) >> 2, i = (kk & 3) + 4 * hh, mt = d >> 4, rr = d & 15;
                    ((bf16*)(ws + WS_VCMPT))[((((size_t)g * 16 + blk) * 8 + 2 * mt + ks) * 64 + qq * 16 + rr) * 8 + i] = (bf16)f2bf(o);
                    if (cb == 0) ((bf16*)(ws + WS_VCMPT))[((((size_t)g * 16 + 15) * 8 + 2 * mt + 1) * 64 + 3 * 16 + rr) * 8 + 7] = 0; } } }
        __syncthreads();
    }
}
__device__ __forceinline__ void prep_rope(const Ctx& c, const PA& a) {
    unsigned char* ws = a.ws; bf16* proj = (bf16*)(ws + WS_PROJ); const float* cs = (const float*)(ws + WS_COS); const float* sn = (const float*)(ws + WS_SIN);
    for (int i = c.bx * 512 + c.tid; i < T * 8 * 64; i += c.G * 512) { const int j = i & 63, h = (i >> 6) & 7, t = i >> 9;
        const float co = cs[t * 64 + j], si = sn[t * 64 + j];
        bf16* q = proj + (size_t)t * LDP + PC_RQ + h * 128 + j; bf16* k = proj + (size_t)t * LDP + PC_RK + h * 128 + j;
        const float q1 = bf2f(q[0]), q2 = bf2f(q[64]), k1 = bf2f(k[0]), k2 = bf2f(k[64]);
        q[0] = (bf16)f2bf(q1 * co - q2 * si); q[64] = (bf16)f2bf(q1 * si + q2 * co);
        k[0] = (bf16)f2bf((k1 * co - k2 * si) * 0.08838834764831845f); k[64] = (bf16)f2bf((k1 * si + k2 * co) * 0.08838834764831845f); }
}

constexpr int RW_NC = 64, RW_CL = 256, RW_TS = 8;
__device__ __forceinline__ void rw_stage(const unsigned char* ws, LAS float* tile, int t0, int h, int lane, bool need_r) {
    const unsigned e0 = (unsigned)(t0 * 1024 + h * 64 + lane);
#pragma unroll
    for (int s = 0; s < RW_TS; ++s) { const unsigned e = e0 + (unsigned)s * 1024u; LAS float* tp = tile + s * 384 + lane;
        tp[0] = bf2f(*(const bf16*)(ws + ((unsigned)WS_RW_KK + e * 2u))); tp[64] = bf2f(*(const bf16*)(ws + ((unsigned)WS_RW_B + e * 2u))); tp[128] = *(const float*)(ws + ((unsigned)WS_RW_W + e * 4u));
        tp[192] = bf2f(*(const bf16*)(ws + ((unsigned)WS_RW_K + e * 2u))); tp[256] = need_r ? bf2f(*(const bf16*)(ws + ((unsigned)WS_RW_R + e * 2u))) : 0.f; tp[320] = bf2f(*(const bf16*)(ws + ((unsigned)WS_RW_V + e * 2u))); }
}
#define RW_STEP_UPDATE(tp, vi) { \
    float s0 = 0.f, s1 = 0.f, s2 = 0.f, s3 = 0.f; \
    _Pragma("unroll") for (int jj = 0; jj < 16; ++jj) { const f32x4 k4 = *(const LAS f32x4*)((tp) + 4 * jj); s0 += S[4 * jj] * k4[0]; s1 += S[4 * jj + 1] * k4[1]; s2 += S[4 * jj + 2] * k4[2]; s3 += S[4 * jj + 3] * k4[3]; } \
    const float sk = (s0 + s1) + (s2 + s3); \
    _Pragma("unroll") for (int jj = 0; jj < 16; ++jj) { const f32x4 b4 = *(const LAS f32x4*)((tp) + 64 + 4 * jj), w4 = *(const LAS f32x4*)((tp) + 128 + 4 * jj), k4 = *(const LAS f32x4*)((tp) + 192 + 4 * jj); \
        _Pragma("unroll") for (int q = 0; q < 4; ++q) S[4 * jj + q] = S[4 * jj + q] * w4[q] + ((vi) * k4[q] - sk * b4[q]); } }

__device__ __forceinline__ void rw_pass1(const Ctx& c, const PA& a) {
    const unsigned char* ws = a.ws; LAS float* tile = (LAS float*)(c.lds + c.wave * (RW_TS * 384 * 4));
    const int lane = c.lane;
    for (int task = c.gw; task < 16 * RW_NC * 2; task += c.NGW) {
        const int kind = task & 1, hc = task >> 1, h = hc / RW_NC, ch = hc % RW_NC;
        float S[64]; int lz = kind ? 64 : lane; asm volatile("" : "+v"(lz));
#pragma unroll
        for (int j = 0; j < 64; ++j) S[j] = (j == lz) ? 1.f : 0.f;
        for (int t0 = ch * RW_CL; t0 < (ch + 1) * RW_CL; t0 += RW_TS) {
            rw_stage(ws, tile, t0, h, lane, false);
            LDS_WAIT();
#pragma unroll 1
            for (int s = 0; s < RW_TS; ++s) { const LAS float* tp = tile + s * 384; const float vi = kind ? tp[320 + lane] : 0.f; RW_STEP_UPDATE(tp, vi); }
            LDS_WAIT();
        }
        float* out = (float*)(a.ws + (kind ? WS_RWU : WS_RWP)) + ((size_t)hc * 64 + lane) * 64;
#pragma unroll
        for (int jj = 0; jj < 16; ++jj) *(f32x4*)(out + 4 * jj) = (f32x4){S[4 * jj], S[4 * jj + 1], S[4 * jj + 2], S[4 * jj + 3]};
    }
}
__device__ __forceinline__ void rw_pass2(const Ctx& c, const PA& a) {
    const float* P = (const float*)(a.ws + WS_RWP); const float* U = (const float*)(a.ws + WS_RWU); float* Si = (float*)(a.ws + WS_RWS);
    const int lane = c.lane;
    for (int task = c.gw; task < 16 * 64; task += c.NGW) { const int h = task >> 6, i = task & 63;
        float s = 0.f;
        for (int ch = 0; ch < RW_NC; ++ch) { const size_t hc = (size_t)h * RW_NC + ch;
            Si[(hc * 64 + i) * 64 + lane] = s;
            float acc = U[(hc * 64 + i) * 64 + lane]; const float* Pc = P + hc * 4096 + lane;
#pragma unroll
            for (int i2 = 0; i2 < 64; ++i2) acc += __shfl(s, i2) * Pc[i2 * 64];
            s = acc; }
    }
}
__device__ __forceinline__ void rw_pass3(const Ctx& c, const PA& a, int layer) {
    const unsigned char* ws = a.ws; LAS float* tile = (LAS float*)(c.lds + c.wave * (RW_TS * 384 * 4));
    const float* Si = (const float*)(ws + WS_RWS); const float* rkb = (const float*)(ws + WS_RKB); const bf16* G = (const bf16*)(ws + WS_RW_G); bf16* Y = (bf16*)(a.ws + WS_YRW);
    const float* lng = a.in(15) + layer * 1024; const float* lnb = a.in(16) + layer * 1024;
    const int lane = c.lane;
    for (int task = c.gw; task < 16 * RW_NC; task += c.NGW) {
        const int h = task / RW_NC, ch = task % RW_NC, col = h * 64 + lane;
        const float lg = lng[col], lb = lnb[col];
        float S[64]; const float* sp = Si + ((size_t)task * 64 + lane) * 64;
#pragma unroll
        for (int jj = 0; jj < 16; ++jj) { const f32x4 v = *(const f32x4*)(sp + 4 * jj); S[4 * jj] = v[0]; S[4 * jj + 1] = v[1]; S[4 * jj + 2] = v[2]; S[4 * jj + 3] = v[3]; }
        for (int t0 = ch * RW_CL; t0 < (ch + 1) * RW_CL; t0 += RW_TS) {
            rw_stage(ws, tile, t0, h, lane, true);
            LDS_WAIT();
#pragma unroll 1
            for (int s = 0; s < RW_TS; ++s) { const LAS float* tp = tile + s * 384; const float vi = tp[320 + lane]; RW_STEP_UPDATE(tp, vi);
                float y0 = 0.f, y1 = 0.f, y2 = 0.f, y3 = 0.f;
#pragma unroll
                for (int jj = 0; jj < 16; ++jj) { const f32x4 r4 = *(const LAS f32x4*)(tp + 256 + 4 * jj); y0 += S[4 * jj] * r4[0]; y1 += S[4 * jj + 1] * r4[1]; y2 += S[4 * jj + 2] * r4[2]; y3 += S[4 * jj + 3] * r4[3]; }
                const float y = (y0 + y1) + (y2 + y3), mean = wave_sum(y) * (1.f / 64.f), dlt = y - mean, var = wave_sum(dlt * dlt) * (1.f / 64.f);
                const float yn = dlt * (1.f / sqrtf(var + 64e-5f)); const int t = t0 + s; const size_t o = (size_t)t * 1024 + col;
                Y[o] = (bf16)f2bf((yn * lg + lb + rkb[t * 16 + h] * vi) * bf2f(G[o])); }
            LDS_WAIT();
        }
    }
}

__device__ __forceinline__ void ret_kv(const Ctx& c, const PA& a) {
    const bf16* proj = (const bf16*)(a.ws + WS_PROJ); float* KV = (float*)(a.ws + WS_RETKV);
    const int dv = c.tid & 127, dkg = c.tid >> 7;
    for (int it = c.bx; it < 128 * 8; it += c.G) { const int ch = it >> 3, h = it & 7; const float lg = RET_LOGG[h];
        float acc[32];
#pragma unroll
        for (int q = 0; q < 32; ++q) acc[q] = 0.f;
        for (int i = 0; i < 128; ++i) { const bf16* row = proj + (size_t)(ch * 128 + i) * LDP;
            const float vv = bf2f(row[PC_RV + h * 128 + dv]) * expf(lg * (float)(127 - i));
            const u32x4* kp = (const u32x4*)(row + PC_RK + h * 128 + 32 * dkg);
#pragma unroll
            for (int q4 = 0; q4 < 4; ++q4) { const u32x4 kw = kp[q4];
                acc[8 * q4 + 0] += bflo(kw.x) * vv; acc[8 * q4 + 1] += bfhi(kw.x) * vv; acc[8 * q4 + 2] += bflo(kw.y) * vv; acc[8 * q4 + 3] += bfhi(kw.y) * vv;
                acc[8 * q4 + 4] += bflo(kw.z) * vv; acc[8 * q4 + 5] += bfhi(kw.z) * vv; acc[8 * q4 + 6] += bflo(kw.w) * vv; acc[8 * q4 + 7] += bfhi(kw.w) * vv; } }
        float* o = KV + ((size_t)it * 128 + 32 * dkg) * 128 + dv;
#pragma unroll
        for (int q = 0; q < 32; ++q) o[q * 128] = acc[q];
    }
}
__device__ __forceinline__ void ret_prefix(const Ctx& c, const PA& a) {
    float* KV = (float*)(a.ws + WS_RETKV);
    for (int i = c.bx * 512 + c.tid; i < 8 * 16384; i += c.G * 512) { const int h = i >> 14, e = i & 16383; const float cd = expf(RET_LOGG[h] * 128.f);
        float r = 0.f;
        for (int ch = 0; ch < 128; ++ch) { float* p = KV + ((size_t)(ch * 8 + h) << 14) + e; const float tmp = *p; *p = r; r = r * cd + tmp; } }
}
__device__ __forceinline__ void ret_out(const Ctx& c, const PA& a) {
    const bf16* proj = (const bf16*)(a.ws + WS_PROJ); const float* KV = (const float*)(a.ws + WS_RETKV); bf16* Y = (bf16*)(a.ws + WS_YRET);
    constexpr int RS = 130;
    LAS bf16* sq = (LAS bf16*)c.lds; LAS bf16* sk = sq + 128 * RS; LAS bf16* sv = sk + 128 * RS; LAS float* att = (LAS float*)(sv + 128 * RS);
    const int tid = c.tid, lane = c.lane, w = c.wave;
    for (int it = c.bx; it < 128 * 8; it += c.G) { const int ch = it >> 3, h = it & 7; const float lg = RET_LOGG[h];
        for (int idx = tid; idx < 128 * 64; idx += 512) { const int i = idx >> 6, d2 = (idx & 63) * 2; const bf16* row = proj + (size_t)(ch * 128 + i) * LDP + h * 128 + d2;
            *(LAS unsigned*)(sq + i * RS + d2) = *(const unsigned*)(row + PC_RQ); *(LAS unsigned*)(sk + i * RS + d2) = *(const unsigned*)(row + PC_RK); *(LAS unsigned*)(sv + i * RS + d2) = *(const unsigned*)(row + PC_RV); }
        __syncthreads();
        for (int half = 0; half < 2; ++half) {
            { const int s = tid & 127, ig = tid >> 7;
                float ac[16];
#pragma unroll
                for (int r = 0; r < 16; ++r) ac[r] = 0.f;
                for (int d2 = 0; d2 < 128; d2 += 2) { const unsigned kw = *(const LAS unsigned*)(sk + s * RS + d2); const float k0 = bflo(kw), k1 = bfhi(kw);
#pragma unroll
                    for (int r = 0; r < 16; ++r) { const unsigned qw = *(const LAS unsigned*)(sq + (64 * half + 16 * ig + r) * RS + d2); ac[r] += bflo(qw) * k0 + bfhi(qw) * k1; } }
#pragma unroll
                for (int r = 0; r < 16; ++r) { const int i = 64 * half + 16 * ig + r; att[(16 * ig + r) * 128 + s] = (i >= s) ? ac[r] * expf(lg * (float)(i - s)) : 0.f; } }
            __syncthreads();
            float o[16];
            { const int dv = tid & 127, ig = tid >> 7;
#pragma unroll
                for (int r = 0; r < 16; ++r) o[r] = 0.f;
                for (int dk = 0; dk < 128; ++dk) { const float rv = KV[((size_t)it * 128 + dk) * 128 + dv];
#pragma unroll
                    for (int r = 0; r < 16; ++r) o[r] += bf2f(sq[(64 * half + 16 * ig + r) * RS + dk]) * rv; }
#pragma unroll
                for (int r = 0; r < 16; ++r) o[r] *= expf(lg * (float)(64 * half + 16 * ig + r + 1));
                for (int s = 0; s < 128; ++s) { const float vv = bf2f(sv[s * RS + dv]);
#pragma unroll
                    for (int r = 0; r < 16; ++r) o[r] += att[(16 * ig + r) * 128 + s] * vv; } }
            __syncthreads();
            { const int dv = tid & 127, ig = tid >> 7;
#pragma unroll
                for (int r = 0; r < 16; ++r) att[(16 * ig + r) * 128 + dv] = o[r]; }
            __syncthreads();
            for (int rr = 0; rr < 8; ++rr) { const int ip = w * 8 + rr, t = ch * 128 + 64 * half + ip;
                const float x0 = att[ip * 128 + lane], x1 = att[ip * 128 + 64 + lane];
                const float mean = wave_sum(x0 + x1) * (1.f / 128.f), d0 = x0 - mean, d1 = x1 - mean, var = wave_sum(d0 * d0 + d1 * d1) * (1.f / 128.f), rs = 1.f / sqrtf(var + 1e-5f);
                const bf16* grow = proj + (size_t)t * LDP + PC_RG + h * 128; const float g0 = bf2f(grow[lane]), g1 = bf2f(grow[64 + lane]);
                Y[(size_t)t * 1024 + h * 128 + lane] = (bf16)f2bf(g0 * sigm(g0) * d0 * rs); Y[(size_t)t * 1024 + h * 128 + 64 + lane] = (bf16)f2bf(g1 * sigm(g1) * d1 * rs); }
            __syncthreads();
        }
    }
}


typedef short bf16x8 __attribute__((ext_vector_type(8)));
typedef short bf16x4 __attribute__((ext_vector_type(4)));
constexpr float NSA_C = 0.125f * 1.4426950408889634f;
struct NsaSrc { const bf16* kf; const bf16* vf; };

__device__ __forceinline__ void nsa_loadK(const NsaSrc& src, int key0, bf16x8 (&kf)[4][2], int lane) {
    const bf16* kp = src.kf + (size_t)(key0 >> 6) * 4096 + lane * 8;
#pragma unroll
    for (int j = 0; j < 4; ++j) { kf[j][0] = *(const bf16x8*)(kp + (2 * j) * 512); kf[j][1] = *(const bf16x8*)(kp + (2 * j + 1) * 512); }
}
__device__ __forceinline__ void nsa_loadV(const NsaSrc& src, int key0, bf16x8 (&vf)[4][2], int lane) {
    const bf16* vp = src.vf + (size_t)(key0 >> 6) * 4096 + lane * 8;
#pragma unroll
    for (int mt = 0; mt < 4; ++mt) { vf[mt][0] = *(const bf16x8*)(vp + (2 * mt) * 512); vf[mt][1] = *(const bf16x8*)(vp + (2 * mt + 1) * 512); }
}
__device__ __forceinline__ void nsa_qk(const bf16x8 (&kf)[4][2], const bf16x8 (&qf)[2], f32x4 (&st)[4]) {
#pragma unroll
    for (int j = 0; j < 4; ++j) { st[j] = (f32x4){0.f, 0.f, 0.f, 0.f};
        st[j] = __builtin_amdgcn_mfma_f32_16x16x32_bf16(kf[j][0], qf[0], st[j], 0, 0, 0); st[j] = __builtin_amdgcn_mfma_f32_16x16x32_bf16(kf[j][1], qf[1], st[j], 0, 0, 0); }
}
template <int MODE>
__device__ __forceinline__ void nsa_rest(f32x4 (&st)[4], const bf16x8 (&vf)[4][2], int key0, int lo, int hi, f32x4 (&O)[4], float& m, float& l, float inv, int r, int q, LAS float* impA, LAS float* impB) {
    float mx = -1.0e30f;
#pragma unroll
    for (int j = 0; j < 4; ++j)
#pragma unroll
        for (int i = 0; i < 4; ++i) { const int key = key0 + 16 * j + 4 * q + i; const bool ok = key >= lo && key <= hi; st[j][i] = ok ? st[j][i] : -1.0e30f; mx = fmaxf(mx, st[j][i]); }
    float mn = m;
    if (MODE != 2) { mx = fmaxf(mx, __shfl_xor(mx, 16)); mx = fmaxf(mx, __shfl_xor(mx, 32)); mn = fmaxf(m, mx); }
    float ps = 0.f;
#pragma unroll
    for (int j = 0; j < 4; ++j)
#pragma unroll
        for (int i = 0; i < 4; ++i) { const float e = st[j][i] > -1.0e29f ? __builtin_amdgcn_exp2f(NSA_C * (st[j][i] - mn)) : 0.f; st[j][i] = MODE == 2 ? e * inv : e; ps += e; }
    if (MODE != 2) { ps += __shfl_xor(ps, 16); ps += __shfl_xor(ps, 32);
        const float sc = __builtin_amdgcn_exp2f(NSA_C * (m - mn)); l = l * sc + ps; m = mn;
        if (MODE == 1) {
#pragma unroll
            for (int mt = 0; mt < 4; ++mt) O[mt] = O[mt] * sc; } }
    if (MODE == 2) {
#pragma unroll
        for (int j = 0; j < 4; ++j) { float a = (st[j][0] + st[j][1]) + (st[j][2] + st[j][3]), b = st[j][3];
            a += __shfl_xor(a, 1); a += __shfl_xor(a, 2); b += __shfl_xor(b, 1); b += __shfl_xor(b, 2);
            if ((r & 3) == 0) { const int J = (r >> 2) * 256 + (key0 >> 2) + 4 * j + q; impA[J] = a; impB[J] = b; } } }
    if (MODE != 0) {
        bf16x8 pf[2];
#pragma unroll
        for (int ks = 0; ks < 2; ++ks) { const unsigned w0 = pg8::cvt_pk_bf16(st[2 * ks][0], st[2 * ks][1]), w1 = pg8::cvt_pk_bf16(st[2 * ks][2], st[2 * ks][3]),
                                                        w2 = pg8::cvt_pk_bf16(st[2 * ks + 1][0], st[2 * ks + 1][1]), w3 = pg8::cvt_pk_bf16(st[2 * ks + 1][2], st[2 * ks + 1][3]);
            const u32x4 w = (u32x4){w0, w1, w2, w3}; pf[ks] = __builtin_bit_cast(bf16x8, w); }
#pragma unroll
        for (int mt = 0; mt < 4; ++mt) {
#pragma unroll
            for (int ks = 0; ks < 2; ++ks) O[mt] = __builtin_amdgcn_mfma_f32_16x16x32_bf16(vf[mt][ks], pf[ks], O[mt], 0, 0, 0); } }
}
#define NSA_LOOP(MODE, SRC, NBLK, KEY0, LO, HI, INV) do { const int nblk_ = (NBLK); if (nblk_ > 0) { bf16x8 kf_[4][2], vf_[4][2]; f32x4 st_[4]; nsa_loadK(SRC, KEY0(0), kf_, lane); \
    _Pragma("unroll 1") for (int b_ = 0; b_ < nblk_; ++b_) { const int k0_ = KEY0(b_); if (MODE != 0) nsa_loadV(SRC, k0_, vf_, lane); \
        nsa_qk(kf_, qf, st_); __builtin_amdgcn_sched_barrier(0); \
        if (b_ + 1 < nblk_) nsa_loadK(SRC, KEY0(b_ + 1), kf_, lane);     \
        nsa_rest<MODE>(st_, vf_, k0_, LO, HI, O, m, l, INV, r, q, impA, impB); } } } while (0)
constexpr int NSA2_WLDS = 8704;
__device__ __forceinline__ void nsa_attn2(const Ctx& c, const PA& a) {
    const unsigned char* ws = a.ws; const bf16* proj = (const bf16*)(ws + WS_PROJ); bf16* Y = (bf16*)(a.ws + WS_YNSA);
    LAS float* impA = (LAS float*)(c.lds + c.wave * NSA2_WLDS); LAS float* impB = impA + 1024; LAS int* KST = (LAS int*)(impB + 1024);
    const int lane = c.lane, r = lane & 15, q = lane >> 4, tk = r >> 2, hh = r & 3;
    const bool xdeal = (c.G & 7) == 0; const int xg = c.bx & 7, tw = xdeal ? (c.bx >> 3) * 8 + c.wave : c.gw, ntw = xdeal ? (c.G >> 3) * 8 : c.NGW, ntask = xdeal ? T / 8 : T;
    for (int task = tw; task < ntask; task += ntw) { const int tq = xdeal ? 2 * task + (xg >> 2) : task >> 2, g = xdeal ? (xg & 3) : (task & 3), t0 = 4 * tq, tcol = t0 + tk;
        const bf16* prow = proj + (size_t)tcol * LDP;
        bf16x8 qf[2]; { const bf16* qp = prow + PC_NQ + (g * 4 + hh) * 64 + 8 * q; qf[0] = *(const bf16x8*)qp; qf[1] = *(const bf16x8*)(qp + 32); }
        float gt0, gt1, gt2; { const bf16* gp = prow + PC_GATE + (g * 4 + hh) * 3; gt0 = sigm(bf2f(gp[0])); gt1 = sigm(bf2f(gp[1])); gt2 = sigm(bf2f(gp[2])); }
        const int cur = t0 >> 6, ncv = tcol >= 31 ? ((tcol - 31) >> 4) + 1 : 0, ncvmax = t0 + 3 >= 31 ? ((t0 + 3 - 31) >> 4) + 1 : 0;
#pragma unroll
        for (int i = 0; i < 16; ++i) { impA[lane + 64 * i] = 0.f; impB[lane + 64 * i] = 0.f; }
        LDS_WAIT();
        f32x4 yacc[4], O[4];
#pragma unroll
        for (int mt = 0; mt < 4; ++mt) yacc[mt] = (f32x4){0.f, 0.f, 0.f, 0.f};
        if (ncvmax > 0) {
            NsaSrc sc; sc.kf = (const bf16*)(ws + WS_KCMPB) + (size_t)g * 16 * 4096; sc.vf = (const bf16*)(ws + WS_VCMPT) + (size_t)g * 16 * 4096;
            const int nb = (ncvmax + 63) >> 6; float m = -1.0e30f, l = 0.f;
#define K0_CMP(b) (64 * (b))
            NSA_LOOP(0, sc, nb, K0_CMP, 0, ncv - 1, 0.f);
            const float inv = l > 0.f ? 1.f / l : 0.f;
#pragma unroll
            for (int mt = 0; mt < 4; ++mt) O[mt] = (f32x4){0.f, 0.f, 0.f, 0.f};
            NSA_LOOP(2, sc, nb, K0_CMP, 0, ncv - 1, inv);
#pragma unroll
            for (int mt = 0; mt < 4; ++mt) yacc[mt] = O[mt] * gt0;
        }
        LDS_WAIT();
        NsaSrc ss; ss.kf = (const bf16*)(ws + WS_KFS) + (size_t)g * 256 * 4096; ss.vf = (const bf16*)(ws + WS_VFS) + (size_t)g * 256 * 4096;
#pragma unroll 1
        for (int k = 0; k < 4; ++k) {
            float scv[4];
#pragma unroll
            for (int mm = 0; mm < 4; ++mm) { const int j = 4 * lane + mm; float s = -1.0e30f;
                if (j <= cur) { s = impA[k * 256 + j] + (j > 0 ? impB[k * 256 + j - 1] : 0.f); if (j == 0 || j == cur || j == cur - 1) s += 1.0e4f; }
                scv[mm] = s; }
            int nsel = 0;
            for (int itk = 0; itk < 16; ++itk) {
                float lv = scv[0]; int lj = 4 * lane;
                if (scv[1] > lv) { lv = scv[1]; lj = 4 * lane + 1; } if (scv[2] > lv) { lv = scv[2]; lj = 4 * lane + 2; } if (scv[3] > lv) { lv = scv[3]; lj = 4 * lane + 3; }
                const float vmax = wave_max(lv); if (vmax < -5.0e29f) break;
                const int jmin = wave_min_i(lv == vmax ? lj : (1 << 30));
                if (lane == 0) KST[itk] = jmin * 64;
                if ((jmin >> 2) == lane) { const int mm = jmin & 3; if (mm == 0) scv[0] = -3.0e38f; else if (mm == 1) scv[1] = -3.0e38f; else if (mm == 2) scv[2] = -3.0e38f; else scv[3] = -3.0e38f; }
                ++nsel; }
            LDS_WAIT();
            { const bool mine = tk == k; const bf16x8 z8 = (bf16x8){0, 0, 0, 0, 0, 0, 0, 0}; bf16x8 qs[2]; qs[0] = mine ? qf[0] : z8; qs[1] = mine ? qf[1] : z8;
                float m = -1.0e30f, l = 0.f;
#pragma unroll
                for (int mt = 0; mt < 4; ++mt) O[mt] = (f32x4){0.f, 0.f, 0.f, 0.f};
#define K0_SEL(b) (KST[b])
#define qf qs
                NSA_LOOP(1, ss, nsel, K0_SEL, 0, t0 + k, 0.f);
#undef qf
                const float sc = mine ? gt1 / l : 0.f;
#pragma unroll
                for (int mt = 0; mt < 4; ++mt) yacc[mt] += O[mt] * sc; }
            LDS_WAIT();
        }
        { NsaSrc sw; sw.kf = (const bf16*)(ws + WS_KFW) + (size_t)g * 256 * 4096; sw.vf = (const bf16*)(ws + WS_VFW) + (size_t)g * 256 * 4096;
            float m = -1.0e30f, l = 0.f; const int wlo = tcol - 511 > 0 ? tcol - 511 : 0, ulo = t0 - 511 > 0 ? t0 - 511 : 0;
#pragma unroll
            for (int mt = 0; mt < 4; ++mt) O[mt] = (f32x4){0.f, 0.f, 0.f, 0.f};
            const int jb0 = ulo >> 6;
#define K0_WIN(b) (64 * (jb0 + (b)))
            NSA_LOOP(1, sw, cur - jb0 + 1, K0_WIN, wlo, tcol, 0.f);
            const float sc = gt2 / l;
#pragma unroll
            for (int mt = 0; mt < 4; ++mt) yacc[mt] += O[mt] * sc; }
#pragma unroll
        for (int mt = 0; mt < 4; ++mt) { uint2 w; w.x = pg8::cvt_pk_bf16(yacc[mt][0], yacc[mt][1]); w.y = pg8::cvt_pk_bf16(yacc[mt][2], yacc[mt][3]);
            *(uint2*)(Y + (size_t)tcol * 1024 + (g * 4 + hh) * 64 + 16 * mt + 4 * q) = w; }
    }
}
__device__ __forceinline__ void prep_tiles(const Ctx& c, const PA& a) {
    const bf16* proj = (const bf16*)(a.ws + WS_PROJ);
    LAS bf16* tile = (LAS bf16*)(c.lds + c.wave * 8704);
    const int lane = c.lane, r = lane & 15, q = lane >> 4;
    for (int it = c.gw; it < 4 * 4 * 256; it += c.NGW) { const int blk = it & 255, g = (it >> 8) & 3, ten = it >> 10;
        const int scol = (ten == 0 ? PC_KS : (ten == 1 ? PC_VS : (ten == 2 ? PC_KW : PC_VW))) + g * 64;
        const u32x4* sp = (const u32x4*)(proj + (size_t)(blk * 64 + lane) * LDP + scol);
#pragma unroll
        for (int i = 0; i < 8; ++i) { const u32x4 v = sp[i]; LAS unsigned* tp = (LAS unsigned*)(tile + lane * 66 + 8 * i); tp[0] = v.x; tp[1] = v.y; tp[2] = v.z; tp[3] = v.w; }
        LDS_WAIT();
        bf16* dst = (bf16*)(a.ws + (ten == 0 ? WS_KFS : (ten == 1 ? WS_VFS : (ten == 2 ? WS_KFW : WS_VFW)))) + ((size_t)(g * 256 + blk) * 8) * 512 + lane * 8;
        if ((ten & 1) == 0) {
#pragma unroll
            for (int j = 0; j < 4; ++j)
#pragma unroll
                for (int ks = 0; ks < 2; ++ks) { const LAS unsigned* tp = (const LAS unsigned*)(tile + (16 * j + r) * 66 + 32 * ks + 8 * q);
                    *(u32x4*)(dst + (2 * j + ks) * 512) = (u32x4){tp[0], tp[1], tp[2], tp[3]}; }
        } else {
#pragma unroll
            for (int mt = 0; mt < 4; ++mt)
#pragma unroll
                for (int ks = 0; ks < 2; ++ks) { unsigned w[4];
#pragma unroll
                    for (int h = 0; h < 2; ++h)
#pragma unroll
                        for (int i2 = 0; i2 < 2; ++i2) { const int k0 = 32 * ks + 16 * h + 4 * q + 2 * i2;
                            w[2 * h + i2] = (unsigned)tile[k0 * 66 + 16 * mt + r] | ((unsigned)tile[(k0 + 1) * 66 + 16 * mt + r] << 16); }
                    *(u32x4*)(dst + (2 * mt + ks) * 512) = (u32x4){w[0], w[1], w[2], w[3]}; }
        }
        LDS_WAIT();
    }
}

__device__ __forceinline__ void ln_row(f32x4 (&v)[8], const float* gam, const float* bet, int lane) {
    float s = 0.f;
#pragma unroll
    for (int j = 0; j < 8; ++j) s += (v[j][0] + v[j][1]) + (v[j][2] + v[j][3]);
    const float mean = wave_sum(s) * (1.f / D); float s2 = 0.f;
#pragma unroll
    for (int j = 0; j < 8; ++j) { v[j] = v[j] - mean; s2 += (v[j][0] * v[j][0] + v[j][1] * v[j][1]) + (v[j][2] * v[j][2] + v[j][3] * v[j][3]); }
    const float rstd = 1.f / sqrtf(wave_sum(s2) * (1.f / D) + LN_EPS);
#pragma unroll
    for (int j = 0; j < 8; ++j) { const f32x4 g4 = *(const f32x4*)(gam + 4 * (lane + 64 * j)), b4 = *(const f32x4*)(bet + 4 * (lane + 64 * j)); v[j] = v[j] * rstd * g4 + b4; }
}
__device__ __forceinline__ void ph_ln1_route(const Ctx& c, const PA& a, int layer) {
    unsigned char* ws = a.ws; float* X = a.out; uint2* xb = (uint2*)(ws + WS_XB);
    const float* gam = a.in(25) + layer * D; const float* bet = a.in(26) + layer * D;
    const float* wg = a.in(27) + (size_t)layer * D * 4; const float* bg = a.in(28) + layer * 4; const float* we = a.in(29) + (size_t)layer * D * 32; const float* be = a.in(30) + layer * 32;
    int* toke = (int*)(ws + WS_TOKE); float* tokw = (float*)(ws + WS_TOKW); unsigned* cnt = (unsigned*)(ws + WS_CTL) + CW_CNT + layer * 128;
    LAS float* lg = (LAS float*)(c.lds + c.wave * 256);
    const int lane = c.lane;
    for (int t = c.gw; t < T; t += c.NGW) {
        f32x4* row = (f32x4*)(X + (size_t)t * D); f32x4 v[8];
#pragma unroll
        for (int j = 0; j < 8; ++j) v[j] = row[lane + 64 * j];
        ln_row(v, gam, bet, lane);
#pragma unroll
        for (int j = 0; j < 8; ++j) { row[lane + 64 * j] = v[j]; xb[(size_t)t * (D / 4) + lane + 64 * j] = make_uint2(pk2(v[j][0], v[j][1]), pk2(v[j][2], v[j][3])); }
        LAS float* xr = (LAS float*)(c.lds + 4096 + c.wave * 8192);
#pragma unroll
        for (int j = 0; j < 8; ++j) *(LAS f32x4*)(xr + 4 * (lane + 64 * j)) = v[j];
        LDS_WAIT();
        f32x4 ag = (f32x4){0.f, 0.f, 0.f, 0.f}; f32x4 ae[8];
#pragma unroll
        for (int q = 0; q < 8; ++q) ae[q] = (f32x4){0.f, 0.f, 0.f, 0.f};
#pragma unroll 2
        for (int i = 0; i < 32; ++i) { const int d = lane + 64 * i; const float x = xr[d];
            ag += *(const f32x4*)(wg + (size_t)d * 4) * x;
            const f32x4* wp = (const f32x4*)(we + (size_t)d * 32);
#pragma unroll
            for (int e4 = 0; e4 < 8; ++e4) ae[e4] += wp[e4] * x; }
#pragma unroll
        for (int q = 0; q < 4; ++q) ag[q] = wave_sum(ag[q]) + bg[q];
#pragma unroll
        for (int e4 = 0; e4 < 8; ++e4)
#pragma unroll
            for (int q = 0; q < 4; ++q) ae[e4][q] = wave_sum(ae[e4][q]);
        if (lane == 0) {
#pragma unroll
            for (int e4 = 0; e4 < 8; ++e4)
#pragma unroll
                for (int q = 0; q < 4; ++q) lg[e4 * 4 + q] = ae[e4][q] + be[e4 * 4 + q]; }
        LDS_WAIT();
        int grp = 0; float gm = ag[0];
        if (ag[1] > gm) { gm = ag[1]; grp = 1; } if (ag[2] > gm) { gm = ag[2]; grp = 2; } if (ag[3] > gm) { gm = ag[3]; grp = 3; }
        const float gw_ = 1.f / (expf(ag[0] - gm) + expf(ag[1] - gm) + expf(ag[2] - gm) + expf(ag[3] - gm));
        float v0 = -3.0e38f, v1 = -3.0e38f; int i0 = 0, i1 = 0;
        for (int i = 0; i < 8; ++i) { const float x = lg[grp * 8 + i];
            if (x > v0) { v1 = v0; i1 = i0; v0 = x; i0 = i; } else if (x > v1) { v1 = x; i1 = i; } }
        const float e1 = expf(v1 - v0), p0 = 1.f / (1.f + e1), p1 = e1 * p0;
        if (lane == 0) { toke[2 * t] = grp * 8 + i0; toke[2 * t + 1] = grp * 8 + i1; tokw[2 * t] = p0 * gw_; tokw[2 * t + 1] = p1 * gw_;
            __hip_atomic_fetch_add(cnt + grp * 8 + i0, 1u, __ATOMIC_RELAXED, __HIP_MEMORY_SCOPE_AGENT); __hip_atomic_fetch_add(cnt + grp * 8 + i1, 1u, __ATOMIC_RELAXED, __HIP_MEMORY_SCOPE_AGENT); }
        LDS_WAIT();
    }
}
__device__ __forceinline__ void ph_slot(const Ctx& c, const PA& a, int layer) {
    unsigned char* ws = a.ws; unsigned* cnt = (unsigned*)(ws + WS_CTL) + CW_CNT + layer * 128; unsigned* cur = (unsigned*)(ws + WS_CTL) + CW_CUR + layer * 128;
    int* texp = (int*)(ws + WS_TEXP) + layer * 512; const int* toke = (const int*)(ws + WS_TOKE); int* slot = (int*)(ws + WS_SLOT);
    LAS int* pst = (LAS int*)c.lds;
    if (c.tid == 0) { int off = 0, nt = 0;
#pragma unroll 1
        for (int e = 0; e < NEXP; ++e) { const int n = (int)__hip_atomic_load(cnt + e, __ATOMIC_RELAXED, __HIP_MEMORY_SCOPE_AGENT), tl = (n + 255) >> 8;
            pst[e] = off; off += tl * 256;
            if (c.bx == 0) for (int q = 0; q < tl; ++q) texp[nt + q] = e;
            nt += tl; }
        if (c.bx == 0) texp[255] = nt; }
    __syncthreads();
    const u32x4* xb = (const u32x4*)(ws + WS_XB); u32x4* xs = (u32x4*)(ws + WS_XS);
    for (int as = c.gw; as < 2 * T; as += c.NGW) { const int t = as >> 1, e = toke[as]; int s = 0;
        if (c.lane == 0) s = pst[e] + (int)__hip_atomic_fetch_add(cur + e, 1u, __ATOMIC_RELAXED, __HIP_MEMORY_SCOPE_AGENT);
        s = __shfl(s, 0);
        if (c.lane == 0) slot[as] = s;
#pragma unroll
        for (int j = 0; j < 4; ++j) xs[(size_t)s * 256 + c.lane + 64 * j] = xb[(size_t)t * 256 + c.lane + 64 * j]; }
}
__device__ __forceinline__ void ph_ln2(const Ctx& c, const PA& a, int layer) {
    unsigned char* ws = a.ws; float* X = a.out; uint2* xb = (uint2*)(ws + WS_XB); const uint2* ys = (const uint2*)(ws + WS_YS);
    const float* gam = a.in(34) + layer * D; const float* bet = a.in(35) + layer * D; const int* slot = (const int*)(ws + WS_SLOT); const float* tokw = (const float*)(ws + WS_TOKW);
    const int lane = c.lane;
    for (int t = c.gw; t < T; t += c.NGW) {
        const int s0 = slot[2 * t], s1 = slot[2 * t + 1]; const float w0 = tokw[2 * t], w1 = tokw[2 * t + 1];
        f32x4* row = (f32x4*)(X + (size_t)t * D); f32x4 v[8];
#pragma unroll
        for (int j = 0; j < 8; ++j) { const uint2 y0 = ys[(size_t)s0 * 512 + lane + 64 * j], y1 = ys[(size_t)s1 * 512 + lane + 64 * j]; const f32x4 x = row[lane + 64 * j];
            v[j][0] = x[0] * DN_ALPHA + w0 * bflo(y0.x) + w1 * bflo(y1.x); v[j][1] = x[1] * DN_ALPHA + w0 * bfhi(y0.x) + w1 * bfhi(y1.x);
            v[j][2] = x[2] * DN_ALPHA + w0 * bflo(y0.y) + w1 * bflo(y1.y); v[j][3] = x[3] * DN_ALPHA + w0 * bfhi(y0.y) + w1 * bfhi(y1.y); }
        ln_row(v, gam, bet, lane);
#pragma unroll
        for (int j = 0; j < 8; ++j) { row[lane + 64 * j] = v[j]; xb[(size_t)t * (D / 4) + lane + 64 * j] = make_uint2(pk2(v[j][0], v[j][1]), pk2(v[j][2], v[j][3])); }
    }
}

enum { PH_CONV = 0, PH_INPROJ, PH_PREP, PH_SCAN1, PH_SCAN2, PH_SCAN3, PH_GATES, PH_BRANCH, PH_OUT, PH_LN1, PH_SLOT, PH_MOE_GU, PH_MOE_DN, PH_LN2, NPH_L };
constexpr int NPH = NPH_L * DEPTH;

__device__ __forceinline__ Ctx mkctx(LAS unsigned char* lds, int wv) {
    int ln; asm volatile("v_mbcnt_lo_u32_b32 %0, -1, 0\n\tv_mbcnt_hi_u32_b32 %0, -1, %0" : "=v"(ln));
    int tid = wv * 64 + ln, bx = blockIdx.x, G = gridDim.x;
    asm volatile("" : "+s"(bx)); asm volatile("" : "+s"(G));
    Ctx c; c.lds = lds; c.tid = tid; c.lane = tid & 63; c.wave = __builtin_amdgcn_readfirstlane(tid >> 6); c.G = G; c.bx = bx; c.gw = bx * 8 + c.wave; c.NGW = G * 8; return c;
}
__global__ void __launch_bounds__(512, 2) fwd(Args args0) {
    extern __shared__ __attribute__((aligned(16))) unsigned char lds_raw[];
    LAS unsigned char* const lds0 = (LAS unsigned char*)lds_raw;
    const int lo = args0.ph_lo, hi = args0.ph_hi;
    const int wv0 = __builtin_amdgcn_readfirstlane(threadIdx.x >> 6);
    if (threadIdx.x < 36) ((LAS unsigned long long*)(lds0 + LDS_PTAB))[threadIdx.x] = (unsigned long long)args0.in[threadIdx.x];
    __syncthreads();
#if MK_ONE_LAUNCH
    volatile LAS unsigned* barw = (volatile LAS unsigned*)(lds0 + LDS_BARW);
    if (threadIdx.x == 0) { barw[0] = 0u; barw[1] = 0u; barw[2] = 0u; barw[3] = 0u; }
    __syncthreads();
    XcdBarrier bar = xcd_barrier_post((unsigned*)(args0.ws + WS_CTL) + CW_BAR, barw);
#define SEAM(p) do { if ((p) + 1 < hi) xcd_barrier(bar); } while (0)
#else
#define SEAM(p) do { } while (0)
#endif
#ifndef ONLY_PHASE
#define ONLY_PHASE -1
#endif
#define PHASE_BEGIN PA args; { unsigned long long w_ = (unsigned long long)args0.ws; asm volatile("" : "+s"(w_)); args.ws = (unsigned char*)(GAS unsigned char*)w_; unsigned long long o_ = (unsigned long long)args0.out; asm volatile("" : "+s"(o_)); args.out = (float*)(GAS float*)o_; args.tab = (const LAS unsigned*)(lds0 + LDS_PTAB); } unsigned char* const ws = args.ws; const Ctx c = mkctx(lds0, wv0); (void)ws; (void)c;
#define TASK_CTX() mkctx(lds0, wv0)
#define IN(p) ((ONLY_PHASE < 0 || ONLY_PHASE == ((p) - pb)) && lo <= (p) && (p) < hi)
    for (int layer = 0; layer < DEPTH; ++layer) {
        const int pb = layer * NPH_L;
        if (IN(pb + PH_CONV)) { PHASE_BEGIN ph_conv(c, args, layer); __syncthreads(); SEAM(pb + PH_CONV); }
        if (IN(pb + PH_INPROJ)) { PHASE_BEGIN
            Gemm g{D, D, D}; SchedPlain S; S.to.init(T / 256, LDP / 256); S.G = c.G; S.c = c.bx; S.tid = c.tid; S.A = (const char*)(ws + WS_XB); S.B = (const char*)(ws + WS_WIN); S.ta = (size_t)256 * D * 2; S.tb = (size_t)256 * D * 2;
            EpiStore<0> E{(bf16*)(ws + WS_PROJ), LDP};
            pg8::gemm_phase<EpiStore<0>, SchedPlain, PG8_ALIGN, PG8_SP2>(c.lds, g, S, E);
#ifdef REP_GEMM
            pg8::gemm_phase<EpiStore<0>, SchedPlain, PG8_ALIGN, PG8_SP2>(c.lds, g, S, E);
#endif
            SEAM(pb + PH_INPROJ); }
        if (IN(pb + PH_PREP)) { PHASE_BEGIN prep_rwkv(c, args, layer); __syncthreads();
#ifdef REP_RW
            prep_rwkv(TASK_CTX(), args, layer); __syncthreads();
#endif
 prep_cmp(TASK_CTX(), args, layer); prep_rope(TASK_CTX(), args); prep_tiles(TASK_CTX(), args); __syncthreads(); SEAM(pb + PH_PREP); }
        if (IN(pb + PH_SCAN1)) { PHASE_BEGIN rw_pass1(c, args);
#ifdef REP_RW
            rw_pass1(TASK_CTX(), args);
#endif
 ret_kv(TASK_CTX(), args); __syncthreads();
#ifdef REP_RET
            ret_kv(TASK_CTX(), args); __syncthreads();
#endif
 nsa_attn2(TASK_CTX(), args); __syncthreads();
 SEAM(pb + PH_SCAN1); }
        if (IN(pb + PH_SCAN2)) { PHASE_BEGIN rw_pass2(c, args);
#ifdef REP_RW
            rw_pass2(TASK_CTX(), args);
#endif
 ret_prefix(TASK_CTX(), args); __syncthreads(); SEAM(pb + PH_SCAN2); }
        if (IN(pb + PH_SCAN3)) { PHASE_BEGIN rw_pass3(c, args, layer); __syncthreads();
#ifdef REP_RW
            rw_pass3(TASK_CTX(), args, layer); __syncthreads();
#endif
 ret_out(TASK_CTX(), args); __syncthreads();
#ifdef REP_RET
            ret_out(TASK_CTX(), args); __syncthreads();
#endif
 SEAM(pb + PH_SCAN3); }
        if (IN(pb + PH_GATES)) { PHASE_BEGIN
            Gemm g{D, D, D}; SchedPlain S; S.to.init(T / 256, NG / 256); S.G = c.G; S.c = c.bx; S.tid = c.tid; S.A = (const char*)(ws + WS_XB); S.B = (const char*)(ws + WS_WG); S.ta = (size_t)256 * D * 2; S.tb = (size_t)256 * D * 2;
            EpiStore<1> E{(bf16*)(ws + WS_GATES), NG};
            pg8::gemm_phase<EpiStore<1>, SchedPlain, PG8_ALIGN, PG8_SP2>(c.lds, g, S, E);
#ifdef REP_GEMM
            pg8::gemm_phase<EpiStore<1>, SchedPlain, PG8_ALIGN, PG8_SP2>(c.lds, g, S, E);
#endif
            SEAM(pb + PH_GATES); }
        if (IN(pb + PH_BRANCH)) { PHASE_BEGIN
            Gemm g{RWW, RWW, RWW}; SchedBranch S; S.to.init(T / 256, D / 256); S.G = c.G; S.c = c.bx; S.tid = c.tid;
            S.A0 = (const char*)(ws + WS_YRW); S.sa = WS_YNSA - WS_YRW; static_assert(WS_YRET - WS_YNSA == WS_YNSA - WS_YRW, "y buffers equally spaced");
            S.B0 = (const char*)(ws + WS_WBR); S.sb = (size_t)D * RWW * 2; S.ta = (size_t)256 * RWW * 2; S.tb = (size_t)256 * RWW * 2;
            EpiBranch E{(bf16*)(ws + WS_MERGED), (const bf16*)(ws + WS_GATES)};
            pg8::gemm_phase<EpiBranch, SchedBranch, PG8_ALIGN, PG8_SP2>(c.lds, g, S, E);
            SEAM(pb + PH_BRANCH); }
        if (IN(pb + PH_OUT)) { PHASE_BEGIN
            Gemm g{D, D, D}; SchedPlain S; S.to.init(T / 256, D / 256); S.G = c.G; S.c = c.bx; S.tid = c.tid; S.A = (const char*)(ws + WS_MERGED); S.B = (const char*)(ws + WS_WOUT); S.ta = (size_t)256 * D * 2; S.tb = (size_t)256 * D * 2;
            EpiResid E{args.out};
            pg8::gemm_phase<EpiResid, SchedPlain, PG8_ALIGN, PG8_SP2>(c.lds, g, S, E);
            SEAM(pb + PH_OUT); }
        if (IN(pb + PH_LN1)) { PHASE_BEGIN ph_ln1_route(c, args, layer); __syncthreads(); ph_conv_moe(TASK_CTX(), args, layer); __syncthreads(); SEAM(pb + PH_LN1); }
        if (IN(pb + PH_SLOT)) { PHASE_BEGIN ph_slot(c, args, layer); __syncthreads(); SEAM(pb + PH_SLOT); }
        if (IN(pb + PH_MOE_GU)) { PHASE_BEGIN
            const int* texp = (const int*)(ws + WS_TEXP) + layer * 512;
            Gemm g{D, D, D}; SchedMoe S; S.nM = texp[255]; S.nN = 4; S.G = c.G; S.c = c.bx; S.tid = c.tid; S.A = (const char*)(ws + WS_XS); S.B = (const char*)(ws + WS_WGU); S.ta = (size_t)256 * D * 2; S.tb = (size_t)256 * D * 2; S.te = (size_t)1024 * D * 2; S.texp = texp;
            EpiGateUp E{(bf16*)(ws + WS_H)};
            pg8::gemm_phase<EpiGateUp, SchedMoe, PG8_ALIGN, PG8_SP2>(c.lds, g, S, E);
#ifdef REP_GEMM
            pg8::gemm_phase<EpiGateUp, SchedMoe, PG8_ALIGN, PG8_SP2>(c.lds, g, S, E);
#endif
            SEAM(pb + PH_MOE_GU); }
        if (IN(pb + PH_MOE_DN)) { PHASE_BEGIN
            const int* texp = (const int*)(ws + WS_TEXP) + layer * 512;
            Gemm g{FF, FF, FF}; SchedMoe S; S.nM = texp[255]; S.nN = 8; S.G = c.G; S.c = c.bx; S.tid = c.tid; S.A = (const char*)(ws + WS_H); S.B = (const char*)(ws + WS_WDN); S.ta = (size_t)256 * FF * 2; S.tb = (size_t)256 * FF * 2; S.te = (size_t)D * FF * 2; S.texp = texp;
            EpiStore<0> E{(bf16*)(ws + WS_YS), D};
            pg8::gemm_phase<EpiStore<0>, SchedMoe, PG8_ALIGN, PG8_SP2>(c.lds, g, S, E);
#ifdef REP_GEMM
            pg8::gemm_phase<EpiStore<0>, SchedMoe, PG8_ALIGN, PG8_SP2>(c.lds, g, S, E);
#endif
            SEAM(pb + PH_MOE_DN); }
        if (IN(pb + PH_LN2)) { PHASE_BEGIN ph_ln2(c, args, layer); __syncthreads(); SEAM(pb + PH_LN2); }
    }
#undef IN
#undef SEAM
}

#ifndef TRUNC_PH
#define TRUNC_PH NPH
#endif
#ifndef DUMP_MODE
#define DUMP_MODE 0
#endif
#if DUMP_MODE
__global__ void dump_k(float* out, const unsigned char* ws) {
    for (size_t i = (size_t)blockIdx.x * blockDim.x + threadIdx.x; i < (size_t)T * D; i += (size_t)gridDim.x * blockDim.x) {
        const int t = (int)(i / D), c = (int)(i % D); float v = 0.f;
#if DUMP_MODE == 1
        v = bf2f(((const bf16*)(ws + WS_PROJ))[(size_t)t * LDP + c * 5]);
#elif DUMP_MODE == 2
        if (c < 1024) v = bf2f(((const bf16*)(ws + WS_YRW))[(size_t)t * 1024 + c]); else v = bf2f(((const bf16*)(ws + WS_YNSA))[(size_t)t * 1024 + c - 1024]);
#elif DUMP_MODE == 3
        if (c < 1024) v = bf2f(((const bf16*)(ws + WS_YRET))[(size_t)t * 1024 + c]); else v = bf2f(((const bf16*)(ws + WS_MERGED))[(size_t)t * D + c]);
#elif DUMP_MODE == 4
        if (c < 1024) v = bf2f(((const bf16*)(ws + WS_YRET))[(size_t)t * 1024 + c]);
#elif DUMP_MODE == 5
        v = bf2f(((const bf16*)(ws + WS_GATES))[(size_t)t * NG + c * 3]);
#endif
        out[i] = (v == v && fabsf(v) < 1e30f) ? v : 0.f; }
}
#endif
extern "C" void kernel_launch(void* const* d_in, const int* in_sizes, int n_in, void* d_out, int out_size, void* d_ws, size_t ws_size, hipStream_t stream) {
    static int grid = 0;
    if (grid == 0) {
        if (n_in != 36 || out_size != T * D || ws_size < WS_END) { fprintf(stderr, "kernel_launch: unexpected shapes (n_in %d out %d ws %zu)\n", n_in, out_size, ws_size); grid = -1; return; }
        int dev = 0, cus = 0, per_cu = 0;
        if (hipGetDevice(&dev) != hipSuccess || hipDeviceGetAttribute(&cus, hipDeviceAttributeMultiprocessorCount, dev) != hipSuccess) { grid = -1; return; }
        if (hipFuncSetAttribute((const void*)fwd, hipFuncAttributeMaxDynamicSharedMemorySize, LDS_BYTES) != hipSuccess) { fprintf(stderr, "kernel_launch: hipFuncSetAttribute failed\n"); grid = -1; return; }
        if (hipOccupancyMaxActiveBlocksPerMultiprocessor(&per_cu, (const void*)fwd, 512, LDS_BYTES) != hipSuccess || per_cu < 1) fprintf(stderr, "kernel_launch: occupancy query says %d\n", per_cu);
        (void)hipGetLastError();
        grid = cus;
    }
    if (grid < 0) return;
    if (hipMemsetAsync((char*)d_ws + WS_CTL, 0, CTL_ZERO_BYTES, stream) != hipSuccess) return;
    Args a{};
    for (int i = 0; i < 36; ++i) a.in[i] = (const float*)d_in[i];
    a.out = (float*)d_out; a.ws = (unsigned char*)d_ws;
#if MK_ONE_LAUNCH
    a.ph_lo = 0; a.ph_hi = NPH;
    hipLaunchKernelGGL(fwd, dim3(grid), dim3(512), LDS_BYTES, stream, a);
#else
    for (int p = 0; p < TRUNC_PH; ++p) { a.ph_lo = p; a.ph_hi = p + 1; hipLaunchKernelGGL(fwd, dim3(grid), dim3(512), LDS_BYTES, stream, a); }
#if DUMP_MODE
    dump_k<<<2048, 256, 0, stream>>>((float*)d_out, (const unsigned char*)d_ws);
#endif
#endif
}
```

```cpp
#define MK_ONE_LAUNCH 1
#include <hip/hip_runtime.h>
#include <cstdio>
#include <cstdint>

#ifndef MK_ONE_LAUNCH
#define MK_ONE_LAUNCH 0
#endif

namespace pg8 {
#define PG8_LAS __attribute__((address_space(3)))
typedef unsigned short bf16_t;
typedef short bf16x8 __attribute__((ext_vector_type(8)));
typedef float f32x4 __attribute__((ext_vector_type(4)));
typedef unsigned u32x4 __attribute__((ext_vector_type(4)));
constexpr int BM = 256, BK = 64, HALF = 128, HTB = HALF * BK * 2  , STAGE_BYTES = 8 * HTB, NXCD = 8, WGM = 8;

__host__ __device__ __forceinline__ int lds_byte(int r, int c) { const int st = (r >> 4) * 2 + (c >> 5), rr = r & 15, cc = c & 31, ob = rr * 64 + cc * 2; return st * 1024 + (ob ^ (((ob >> 9) & 1) << 5)); }
__host__ __device__ __forceinline__ void stage_rc(int b, int& R, int& C) { const int st = b / 1024, sb = b % 1024, swz = sb ^ (((sb >> 9) & 1) << 5); R = (st >> 1) * 16 + swz / 64; C = (st & 1) * 32 + (swz % 64) / 2; }
__host__ __device__ __forceinline__ int perm32(int rho) { const int n = rho >> 4, i = rho & 15; return 8 * (i >> 2) + 4 * n + (i & 3); }

struct Unit { int pm, pn, aux; const char* a; const char* b; };
struct Gemm { int K, lda, ldb; };

struct TileOrder {
    int nM, nN, nwg;
    __device__ void init(int nM_, int nN_) { nM = nM_; nN = nN_; nwg = nM * nN; }
    __device__ bool tile(long L, int& pm, int& pn) const {
        if (L >= nwg) return false;
        int wgid = (int)L; { const int q = nwg / NXCD, r = nwg % NXCD, xcd = wgid % NXCD, off = wgid / NXCD; wgid = (xcd < r ? xcd * (q + 1) : r * (q + 1) + (xcd - r) * q) + off; }
        const int nig = WGM * nN, gid = wgid / nig, fm = gid * WGM, gsz = (nM - fm) < WGM ? (nM - fm) : WGM;
        pm = fm + ((wgid % nig) % gsz); pn = (wgid % nig) / gsz; return true;
    }
};

typedef float f32x2_t __attribute__((ext_vector_type(2))); typedef __bf16 bf16x2_t __attribute__((ext_vector_type(2)));
__device__ __forceinline__ unsigned cvt_pk_bf16(float lo, float hi) { f32x2_t v = {lo, hi}; bf16x2_t b = __builtin_convertvector(v, bf16x2_t); return __builtin_bit_cast(unsigned, b); }

template <class Epi, class Sched, bool ALIGN_EPI = false, bool SP2 = false>
__device__ __forceinline__ void gemm_phase(PG8_LAS unsigned char* lds, const Gemm g, const Sched& S, const Epi& E) {
    const int tid = S.tid, wid = __builtin_amdgcn_readfirstlane(tid >> 6), lane = tid & 63, wr = wid >> 2, wc = wid & 3, fr = lane & 15, fq = lane >> 4;
    const int K = g.K, nt = K / BK;
    unsigned voffA[2], voffB[2];
#pragma unroll
    for (int i = 0; i < 2; ++i) { int R, C; stage_rc(tid * 16 + i * 8192, R, C); const int Rb = Epi::PERM ? ((R & ~31) + perm32(R & 31)) : R;
        voffA[i] = (unsigned)(R * g.lda + C) * 2u; voffB[i] = (unsigned)(Rb * g.ldb + C) * 2u; }
    const size_t kstep = (size_t)(BK * 2);
    const size_t hstepA = (size_t)HALF * g.lda * 2, hstepB = (size_t)HALF * g.ldb * 2;
    const unsigned ldsw = (unsigned)wid * 1024u;
    const int aoff = lds_byte(wr * 64 + fr, fq * 8), boff = lds_byte(wc * 32 + fr, fq * 8);
#define PG8_SA(b, h) (((b) * 2 + (h)) * HTB)
#define PG8_SB(b, h) ((4 + (b) * 2 + (h)) * HTB)
#define PG8_STAGE(bufoff, gbase, voff) do { _Pragma("unroll") for (int _i = 0; _i < 2; ++_i) \
        __builtin_amdgcn_global_load_lds((const unsigned*)((const char*)(gbase) + (voff)[_i]), (PG8_LAS unsigned*)(lds + (bufoff) + ldsw + _i * 8192), 16, 0, 0); } while (0)
#define PG8_LDA(dst, b, h) do { _Pragma("unroll") for (int m = 0; m < 4; ++m) _Pragma("unroll") for (int k = 0; k < 2; ++k) dst[m][k] = *(const PG8_LAS bf16x8*)(lds + PG8_SA(b, h) + aoff + m * 2048 + k * 1024); } while (0)
#define PG8_LDB(dst, b, h) do { _Pragma("unroll") for (int n = 0; n < 2; ++n) _Pragma("unroll") for (int k = 0; k < 2; ++k) dst[n][k] = *(const PG8_LAS bf16x8*)(lds + PG8_SB(b, h) + boff + n * 2048 + k * 1024); } while (0)
#define PG8_MMA(ai, bj, At, Bt) do { __builtin_amdgcn_s_setprio(1); _Pragma("unroll") for (int m = 0; m < 4; ++m) _Pragma("unroll") for (int n = 0; n < 2; ++n) _Pragma("unroll") for (int k = 0; k < 2; ++k) \
        acc[ai][bj][m][n] = __builtin_amdgcn_mfma_f32_16x16x32_bf16(Bt[n][k], At[m][k], acc[ai][bj][m][n], 0, 0, 0); __builtin_amdgcn_s_setprio(0); } while (0)
#define PG8_WAIT_V(n) asm volatile("s_waitcnt vmcnt(" #n ")" ::: "memory")
#define PG8_WAIT_L(n) asm volatile("s_waitcnt lgkmcnt(" #n ")" ::: "memory")
#define PG8_BAR __builtin_amdgcn_s_barrier()
#define PG8_SCHED __builtin_amdgcn_sched_barrier(0)
    Unit cur, nxt; int ui = 0;
    if (!S.next(0, cur)) return;
    f32x4 acc[2][2][4][2];
#pragma unroll
    for (int a = 0; a < 2; ++a)
#pragma unroll
        for (int b = 0; b < 2; ++b)
#pragma unroll
            for (int m = 0; m < 4; ++m)
#pragma unroll
                for (int n = 0; n < 2; ++n) acc[a][b][m][n] = (f32x4){0.f, 0.f, 0.f, 0.f};
    bf16x8 At[4][2], B0[2][2], B1[2][2];
    const char* cA = cur.a; const char* cB = cur.b;
    if constexpr (SP2) {
        PG8_STAGE(PG8_SB(0, 0), cB, voffB); PG8_STAGE(PG8_SB(0, 1), cB + hstepB, voffB); PG8_STAGE(PG8_SA(0, 0), cA, voffA); PG8_STAGE(PG8_SA(0, 1), cA + hstepA, voffA);
        if (wr == 1) PG8_BAR;
        PG8_WAIT_V(2); PG8_BAR;
        PG8_STAGE(PG8_SB(1, 0), cB + kstep, voffB); PG8_STAGE(PG8_SA(1, 0), cA + kstep, voffA); PG8_STAGE(PG8_SB(1, 1), cB + hstepB + kstep, voffB);
        PG8_WAIT_V(6); PG8_BAR;
    } else {
        PG8_STAGE(PG8_SB(0, 0), cB, voffB); PG8_STAGE(PG8_SA(0, 0), cA, voffA); PG8_STAGE(PG8_SB(0, 1), cB + hstepB, voffB); PG8_STAGE(PG8_SA(0, 1), cA + hstepA, voffA);
        if (wr == 1) PG8_BAR;
        PG8_WAIT_V(4); PG8_BAR;
        PG8_STAGE(PG8_SB(1, 0), cB + kstep, voffB); PG8_STAGE(PG8_SA(1, 0), cA + kstep, voffA); PG8_STAGE(PG8_SB(1, 1), cB + hstepB + kstep, voffB);
        PG8_WAIT_V(6); PG8_BAR;
    }
    for (;;) {
        const bool has_next = S.next(ui + 1, nxt);
        const char* nA = has_next ? nxt.a : cA; const char* nB = has_next ? nxt.b : cB;
        for (int t = 0; t < nt; t += 2) {
            const bool last = (t == nt - 2);
            const char* a1 = cA + (size_t)(t + 1) * kstep;
            const char* a2 = last ? nA : cA + (size_t)(t + 2) * kstep; const char* b2 = last ? nB : cB + (size_t)(t + 2) * kstep;
            const char* a3 = a2 + kstep; const char* b3 = b2 + kstep;
            if constexpr (SP2) {
            PG8_LDB(B0, 0, 0); PG8_LDB(B1, 0, 1); PG8_SCHED; PG8_LDA(At, 0, 0); PG8_STAGE(PG8_SA(1, 1), a1 + hstepA, voffA);
            PG8_WAIT_V(8); PG8_WAIT_L(0); PG8_BAR; PG8_MMA(0, 0, At, B0); PG8_MMA(0, 1, At, B1); PG8_BAR; PG8_SCHED;
            PG8_LDA(At, 0, 1); PG8_STAGE(PG8_SB(0, 0), b2, voffB); PG8_STAGE(PG8_SB(0, 1), b2 + hstepB, voffB); PG8_STAGE(PG8_SA(0, 0), a2, voffA);
            PG8_WAIT_V(8); PG8_WAIT_L(0); PG8_BAR; PG8_MMA(1, 0, At, B0); PG8_MMA(1, 1, At, B1); PG8_BAR; PG8_SCHED;
            PG8_LDB(B0, 1, 0); PG8_LDB(B1, 1, 1); PG8_SCHED; PG8_LDA(At, 1, 0); PG8_STAGE(PG8_SA(0, 1), a2 + hstepA, voffA);
            PG8_WAIT_V(8); PG8_WAIT_L(0); PG8_BAR; PG8_MMA(0, 0, At, B0); PG8_MMA(0, 1, At, B1); PG8_BAR; PG8_SCHED;
            PG8_LDA(At, 1, 1); PG8_STAGE(PG8_SB(1, 0), b3, voffB); PG8_STAGE(PG8_SB(1, 1), b3 + hstepB, voffB); PG8_STAGE(PG8_SA(1, 0), a3, voffA);
            PG8_WAIT_V(8); PG8_WAIT_L(0); PG8_BAR; PG8_MMA(1, 0, At, B0); PG8_MMA(1, 1, At, B1); PG8_BAR; PG8_SCHED;
            } else {
            PG8_LDB(B0, 0, 0); PG8_SCHED; PG8_LDA(At, 0, 0); PG8_STAGE(PG8_SA(1, 1), a1 + hstepA, voffA);
            PG8_WAIT_L(8); PG8_BAR; PG8_WAIT_L(0); PG8_MMA(0, 0, At, B0); PG8_BAR; PG8_SCHED;
            PG8_LDB(B1, 0, 1); PG8_STAGE(PG8_SB(0, 0), b2, voffB);
            PG8_BAR; PG8_WAIT_L(0); PG8_MMA(0, 1, At, B1); PG8_BAR;
            PG8_LDA(At, 0, 1); PG8_STAGE(PG8_SA(0, 0), a2, voffA);
            PG8_BAR; PG8_WAIT_L(0); PG8_MMA(1, 0, At, B0); PG8_BAR; PG8_SCHED;
            PG8_STAGE(PG8_SB(0, 1), b2 + hstepB, voffB);
            PG8_WAIT_V(6); PG8_BAR; PG8_MMA(1, 1, At, B1); PG8_BAR;
            PG8_LDB(B0, 1, 0); PG8_SCHED; PG8_LDA(At, 1, 0); PG8_STAGE(PG8_SA(0, 1), a2 + hstepA, voffA);
            PG8_WAIT_L(8); PG8_BAR; PG8_WAIT_L(0); PG8_MMA(0, 0, At, B0); PG8_BAR; PG8_SCHED;
            PG8_LDB(B1, 1, 1); PG8_STAGE(PG8_SB(1, 0), b3, voffB);
            PG8_BAR; PG8_WAIT_L(0); PG8_MMA(0, 1, At, B1); PG8_BAR;
            PG8_LDA(At, 1, 1); PG8_STAGE(PG8_SA(1, 0), a3, voffA);
            PG8_BAR; PG8_WAIT_L(0); PG8_MMA(1, 0, At, B0); PG8_BAR; PG8_SCHED;
            PG8_STAGE(PG8_SB(1, 1), b3 + hstepB, voffB);
            PG8_WAIT_V(6); PG8_BAR; PG8_MMA(1, 1, At, B1); PG8_BAR;
            }
        }
        if constexpr (ALIGN_EPI) { if (wr == 0) PG8_BAR; }
        E(acc, cur, wr, wc, fr, fq);
        if (!has_next) break;
#pragma unroll
        for (int a = 0; a < 2; ++a)
#pragma unroll
            for (int b = 0; b < 2; ++b)
#pragma unroll
                for (int m = 0; m < 4; ++m)
#pragma unroll
                    for (int n = 0; n < 2; ++n) acc[a][b][m][n] = (f32x4){0.f, 0.f, 0.f, 0.f};
        cur = nxt; cA = nA; cB = nB; ++ui;
        if constexpr (ALIGN_EPI) { if (wr == 1) PG8_BAR; }
    }
    PG8_WAIT_V(0);
    if constexpr (!ALIGN_EPI) { if (wr == 0) PG8_BAR; }
    PG8_BAR;
    #undef PG8_SA
#undef PG8_SB
#undef PG8_STAGE
#undef PG8_LDA
#undef PG8_LDB
#undef PG8_MMA
#undef PG8_WAIT_V
#undef PG8_WAIT_L
#undef PG8_BAR
#undef PG8_SCHED
}
}

#ifndef PG8_SP2
#define PG8_SP2 true
#endif
#ifndef PG8_ALIGN
#define PG8_ALIGN true
#endif

constexpr int T = 16384, D = 2048, DEPTH = 2;
constexpr int RWW = 1024;
constexpr int NCMP = 1023, NSELB = 256;
constexpr int NEXP = 32, FF = 512;
constexpr int LDP = 10496;
constexpr int NG = 6144;
constexpr int PC_RW_R = 0, PC_RW_K = 1024, PC_RW_V = 2048, PC_NQ = 3072, PC_KC = 4096, PC_VC = 4352, PC_KS = 4608, PC_VS = 4864, PC_KW = 5120, PC_VW = 5376,
              PC_RQ = 5632, PC_RK = 6656, PC_RV = 7680, PC_RG = 8704, PC_XW = 9728, PC_XA = 9824, PC_XG = 9920, PC_XV = 10176, PC_GATE = 10240;
constexpr float DN_ALPHA = 1.41421356237f, LN_EPS = 1e-5f;

constexpr size_t MiB = 1u << 20;
constexpr size_t WS_CTL = 0, CTL_ZERO_BYTES = 1 * MiB;
constexpr size_t WS_TEXP = 1 * MiB, WS_TOKE = WS_TEXP + 65536, WS_TOKW = WS_TOKE + 131072, WS_SLOT = WS_TOKW + 131072;
constexpr size_t WS_KCMPB = 2 * MiB, WS_VCMPT = 3 * MiB, WS_RKB = 4 * MiB, WS_COS = 8 * MiB, WS_SIN = 12 * MiB;
constexpr size_t WS_WIN = 16 * MiB, WS_WG = 57 * MiB, WS_WBR = 81 * MiB, WS_WOUT = 93 * MiB;
constexpr size_t WS_XB = 112 * MiB, WS_VF = 176 * MiB, WS_PROJ = 208 * MiB;
constexpr size_t WS_RW_R = 536 * MiB, WS_RW_K = 568 * MiB, WS_RW_V = 600 * MiB, WS_RW_KK = 632 * MiB, WS_RW_B = 664 * MiB, WS_RW_W = 696 * MiB, WS_RW_G = 760 * MiB;
constexpr size_t WS_YRW = 800 * MiB, WS_YNSA = 832 * MiB, WS_YRET = 864 * MiB;
constexpr size_t WS_RWP = 896 * MiB, WS_RWU = 912 * MiB, WS_RWS = 928 * MiB, WS_RETKV = 944 * MiB, WS_KFS = 1008 * MiB, WS_VFS = 1016 * MiB, WS_KFW = 1024 * MiB, WS_VFW = 1032 * MiB, WS_VFR = 1040 * MiB, WS_KTR = 1072 * MiB, WS_RT = 1104 * MiB, WS_END = 1136 * MiB;
constexpr size_t WS_GATES = 536 * MiB, WS_MERGED = 728 * MiB;
constexpr size_t WS_WGU = 208 * MiB, WS_WDN = 336 * MiB, WS_XS = 400 * MiB, WS_H = 560 * MiB, WS_YS = 600 * MiB;
static_assert(WS_PROJ + (size_t)T * LDP * 2 <= WS_RW_R && WS_GATES + (size_t)T * NG * 2 <= WS_MERGED && WS_MERGED + (size_t)T * D * 2 <= WS_YRW, "ws map");
static_assert(WS_XS + (size_t)160 * 256 * D * 2 <= WS_H && WS_H + (size_t)160 * 256 * FF * 2 <= WS_YS && WS_YS + (size_t)160 * 256 * D * 2 <= WS_RW_G, "ws map moe");
constexpr int CW_TMO = 0, CW_CNT = 1024, CW_CUR = 1088, CW_BAR = 4096;
constexpr int LDS_BYTES = 147456, LDS_BARW = LDS_BYTES - 64;

#define GAS __attribute__((address_space(1)))
#define LAS __attribute__((address_space(3)))
typedef unsigned short bf16;
typedef float f32x4 __attribute__((ext_vector_type(4)));
typedef unsigned u32x4 __attribute__((ext_vector_type(4)));
typedef short bf16x8 __attribute__((ext_vector_type(8)));
typedef short bf16x4 __attribute__((ext_vector_type(4)));
#define LDS_WAIT() asm volatile("s_waitcnt lgkmcnt(0)" ::: "memory")
#define VM_WAIT() asm volatile("s_waitcnt vmcnt(0)" ::: "memory")

__device__ __forceinline__ float bf2f(unsigned short b) { return __uint_as_float(((unsigned)b) << 16); }
__device__ __forceinline__ unsigned f2bf(float f) { unsigned u = __float_as_uint(f); return (u + 0x7fffu + ((u >> 16) & 1u)) >> 16; }
__device__ __forceinline__ unsigned pk2(float lo, float hi) { return f2bf(lo) | (f2bf(hi) << 16); }
__device__ __forceinline__ float bflo(unsigned w) { return __uint_as_float(w << 16); }
__device__ __forceinline__ float bfhi(unsigned w) { return __uint_as_float(w & 0xffff0000u); }
__device__ __forceinline__ float wave_sum(float v) {
#pragma unroll
    for (int o = 1; o < 64; o <<= 1) v += __shfl_xor(v, o);
    return v;
}
__device__ __forceinline__ float wave_max(float v) {
#pragma unroll
    for (int o = 1; o < 64; o <<= 1) v = fmaxf(v, __shfl_xor(v, o));
    return v;
}
__device__ __forceinline__ int wave_min_i(int v) {
#pragma unroll
    for (int o = 1; o < 64; o <<= 1) { const int w = __shfl_xor(v, o); v = w < v ? w : v; }
    return v;
}
__device__ __forceinline__ float sigm(float x) { return 1.f / (1.f + expf(-x)); }
__device__ __forceinline__ float sigm_fast(float x) { return __builtin_amdgcn_rcpf(1.f + __builtin_amdgcn_exp2f(-1.4426950408889634f * x)); }

__device__ const double INV_FREQ[64] = {1.00000000000000000e+00, 8.63988449483968579e-01, 7.46476040841712152e-01, 6.44946677103762411e-01, 5.57226479550717357e-01, 4.81437242078434580e-01, 4.15956216307184767e-01, 3.59381366380462752e-01, 3.10501349512486036e-01, 2.68269579527972590e-01, 2.31781818060089240e-01, 2.00256813604311801e-01, 1.73019573884589412e-01, 1.49486913370923374e-01, 1.29154966501488389e-01, 1.11588399250774864e-01, 9.64110880490750138e-02, 8.32980664765826800e-02, 7.19685673001152076e-02, 6.21800108732091794e-02, 5.37228111832403141e-02, 4.64158883361278016e-02, 4.01027913949520837e-02, 3.46483485573036779e-02, 2.99357729472049007e-02, 2.58641620527596990e-02, 2.23463372691659473e-02, 1.93069772888325060e-02, 1.66810053720005923e-02, 1.44121959671885402e-02, 1.24519708473503302e-02, 1.07583589854217902e-02, 9.29509789880649494e-03, 8.03085722139152032e-03, 6.93856787873718770e-03, 5.99484250318940964e-03, 5.17947467923121282e-03, 4.47500629725045354e-03, 3.86635375219241198e-03, 3.34048498351324471e-03, 2.88614044143008968e-03, 2.49359200498416086e-03, 2.15443469003188427e-03, 1.86140668735512152e-03, 1.60823387766704205e-03, 1.38949549437313892e-03, 1.20050805774840792e-03, 1.03722509540705695e-03, 8.96150501946605012e-04, 7.74263682681127744e-04, 6.68954878691414585e-04, 5.77969288415331340e-04, 4.99358789347314927e-04, 4.31440226144378508e-04, 3.72759372031494166e-04, 3.22059791872108224e-04, 2.78255940220712632e-04, 2.40409918350997456e-04, 2.07711392596645640e-04, 1.79460244029731636e-04, 1.55051577983262559e-04, 1.33962772451801717e-04, 1.15742288059205792e-04, 1.00000000000000005e-04};
__device__ const float RET_LOGG[8] = {-0.0317486983145803f, -0.015748356968139168f, -0.007843177461025893f, -0.003913899321136329f, -0.0019550348358033506f, -0.0009770396478266127f, -0.0004884004981088745f, -0.0002441704321739145f};

#define XB_TMO      128
#define XB_XCNT(j)  (256  + 64 * (j))
#define XB_XSUB(j)  (1280 + 64 * (j))
#define XB_XGEN(j)  (2304 + 64 * (j))
#define XB_TOP      3328
#define XB_TOPGEN   3392
#define XCD_BAR_WORDS 3456
#define XB_SPIN_CAP (1u << 18)

__device__ __forceinline__ unsigned xb_ld(unsigned* p)              { return __hip_atomic_load(p, __ATOMIC_RELAXED, __HIP_MEMORY_SCOPE_AGENT); }
__device__ __forceinline__ unsigned xb_add(unsigned* p, unsigned v) { return __hip_atomic_fetch_add(p, v, __ATOMIC_RELAXED, __HIP_MEMORY_SCOPE_AGENT); }
__device__ __forceinline__ unsigned xb_xcc_id() { return (unsigned)__builtin_amdgcn_s_getreg((3 << 11) | 20) & 0xFu; }
#define XB_SPIN(cond, bar) do { unsigned _sp = 0; while (cond) { __builtin_amdgcn_s_sleep(1); \
    if ((++_sp & 255u) == 0u) { if (xb_ld(&(bar)[XB_TMO])) break; if (_sp > XB_SPIN_CAP) { atomicAdd(&(bar)[XB_TMO], 1u); break; } } } } while (0)

struct XcdBarrier {
    unsigned* bar; unsigned x;
    volatile LAS unsigned* st;
};
__device__ __forceinline__ XcdBarrier xcd_barrier_post(unsigned* bar, volatile LAS unsigned* st) {
    XcdBarrier b; b.bar = bar; b.x = xb_xcc_id(); b.st = st;
    if (threadIdx.x == 0) (void)xb_add(&bar[XB_XCNT(b.x)], 1u);
    return b;
}
__device__ __forceinline__ void xcd_barrier_complete(unsigned* bar, unsigned x, unsigned& nloc, unsigned& nx) {
    const unsigned G = gridDim.x * gridDim.y * gridDim.z;
    unsigned sum, cnt, mine, sp = 0u;
    for (;;) {
        sum = 0u; cnt = 0u; mine = 0u;
#pragma unroll
        for (unsigned j = 0; j < 16; ++j) { const unsigned c = xb_ld(&bar[XB_XCNT(j)]); sum += c; cnt += (c > 0u) ? 1u : 0u; mine = (j == x) ? c : mine; }
        if (sum == G) break;
        __builtin_amdgcn_s_sleep(1);
        if ((++sp & 255u) == 0u) { if (xb_ld(&bar[XB_TMO])) break; if (sp > XB_SPIN_CAP) { atomicAdd(&bar[XB_TMO], 1u); break; } }
    }
    nloc = mine > 0u ? mine : 1u; nx = cnt > 0u ? cnt : 1u;
}
__device__ __forceinline__ void xcd_barrier(const XcdBarrier& b) {
    asm volatile("s_waitcnt vmcnt(0)" ::: "memory");
    __syncthreads();
    if (threadIdx.x == 0) {
        unsigned* bar = b.bar;
        __builtin_amdgcn_s_waitcnt(0);
        unsigned nloc = b.st[0], nx = b.st[1];
        if (nloc == 0u) { xcd_barrier_complete(bar, b.x, nloc, nx); b.st[0] = nloc; b.st[1] = nx; }
        const unsigned old = xb_add(&bar[XB_XSUB(b.x)], 1u);
        const unsigned gen = old / nloc;
        if (old + 1u == (gen + 1u) * nloc) {
            __builtin_amdgcn_fence(__ATOMIC_RELEASE, "agent");
            asm volatile("s_waitcnt vmcnt(0)" ::: "memory");
            const unsigned og = xb_add(&bar[XB_TOP], 1u);
            const unsigned tg = og / nx;
            if (og + 1u == (tg + 1u) * nx) xb_add(&bar[XB_TOPGEN], 1u);
            else XB_SPIN(xb_ld(&bar[XB_TOPGEN]) == tg, bar);
            __builtin_amdgcn_fence(__ATOMIC_ACQUIRE, "agent");
            xb_add(&bar[XB_XGEN(b.x)], 1u);
            asm volatile("s_waitcnt vmcnt(0)" ::: "memory");
        } else {
            XB_SPIN(xb_ld(&bar[XB_XGEN(b.x)]) == gen, bar);
            __builtin_amdgcn_fence(__ATOMIC_ACQUIRE, "agent");
            asm volatile("s_waitcnt vmcnt(0)" ::: "memory");
        }
    }
    __syncthreads();
}

#if defined(__HIP_DEVICE_COMPILE__)
#define ASSUME_GLOBAL(p) do { __builtin_assume(!__builtin_amdgcn_is_shared((const __attribute__((address_space(0))) void*)(p))); __builtin_assume(!__builtin_amdgcn_is_private((const __attribute__((address_space(0))) void*)(p))); } while (0)
#else
#define ASSUME_GLOBAL(p) do { } while (0)
#endif
struct Args { const float* in[36]; float* out; unsigned char* ws; int ph_lo, ph_hi; };
constexpr int LDS_PTAB = LDS_BYTES - 512;
struct PA { unsigned char* ws; float* out; const LAS unsigned* tab;
    __device__ __forceinline__ const float* in(int i) const { const unsigned lo = __builtin_amdgcn_readfirstlane(tab[2 * i]), hi = __builtin_amdgcn_readfirstlane(tab[2 * i + 1]);
        return (const float*)(const GAS float*)(((unsigned long long)hi << 32) | lo); } };

using pg8::Unit; using pg8::Gemm; using pg8::TileOrder;
struct SchedPlain {
    TileOrder to; int G, c, tid; const char* A; const char* B; size_t ta, tb;
    __device__ __forceinline__ bool next(int i, Unit& u) const {
        if (!to.tile((long)i * G + c, u.pm, u.pn)) return false;
        u.a = A + (size_t)u.pm * ta; u.b = B + (size_t)u.pn * tb; u.aux = 0; return true; }
};
struct SchedBranch {
    TileOrder to; int G, c, tid; const char* A0; const char* B0; size_t sa, sb, ta, tb;
    __device__ __forceinline__ bool next(int i, Unit& u) const {
        const int br = i % 3;
        if (!to.tile((long)(i / 3) * G + c, u.pm, u.pn)) return false;
        u.a = A0 + (size_t)br * sa + (size_t)u.pm * ta; u.b = B0 + (size_t)br * sb + (size_t)u.pn * tb; u.aux = br; return true; }
};
struct SchedMoe {
    int nM, nN, G, c, tid; const char* A; const char* B; size_t ta, tb, te; const int* texp;
    __device__ __forceinline__ bool next(int i, Unit& u) const {
        const long L = (long)i * G + c; if (L >= (long)nM * nN) return false;
        u.pm = (int)(L % nM); u.pn = (int)(L / nM); const int e = texp[u.pm];
        u.a = A + (size_t)u.pm * ta; u.b = B + (size_t)e * te + (size_t)u.pn * tb; u.aux = e; return true; }
};
template <int ACT  > struct EpiStore {
    static constexpr bool PERM = true;
    bf16* O; int ldc;
    __device__ __forceinline__ void operator()(const f32x4 (&acc)[2][2][4][2], const Unit& u, int wr, int wc, int fr, int fq) const {
        const int row0 = u.pm * 256 + wr * 64 + fr, col0 = u.pn * 256 + wc * 32 + 8 * fq;
#pragma unroll
        for (int ai = 0; ai < 2; ++ai)
#pragma unroll
            for (int m = 0; m < 4; ++m) { bf16* rowp = O + (size_t)(row0 + ai * 128 + m * 16) * ldc + col0;
#pragma unroll
                for (int bj = 0; bj < 2; ++bj) { f32x4 v0 = acc[ai][bj][m][0], v1 = acc[ai][bj][m][1];
                    if (ACT == 1) {
#pragma unroll
                        for (int j = 0; j < 4; ++j) { v0[j] = sigm_fast(v0[j]); v1[j] = sigm_fast(v1[j]); } }
                    u32x4 w; w.x = pg8::cvt_pk_bf16(v0[0], v0[1]); w.y = pg8::cvt_pk_bf16(v0[2], v0[3]); w.z = pg8::cvt_pk_bf16(v1[0], v1[1]); w.w = pg8::cvt_pk_bf16(v1[2], v1[3]);
                    *(u32x4*)(rowp + bj * 128) = w; __builtin_amdgcn_sched_barrier(0); } }
    }
};
struct EpiBranch {
    static constexpr bool PERM = true;
    bf16* Mg; const bf16* Gt;
    __device__ __forceinline__ void operator()(const f32x4 (&acc)[2][2][4][2], const Unit& u, int wr, int wc, int fr, int fq) const {
        const int row0 = u.pm * 256 + wr * 64 + fr, col0 = u.pn * 256 + wc * 32 + 8 * fq, br = u.aux;
#pragma unroll
        for (int ai = 0; ai < 2; ++ai)
#pragma unroll
            for (int m = 0; m < 4; ++m) { const size_t r = (size_t)(row0 + ai * 128 + m * 16);
#pragma unroll
                for (int bj = 0; bj < 2; ++bj) { const int col = col0 + bj * 128;
                    const u32x4 gw = *(const u32x4*)(Gt + r * NG + br * 2048 + col);
                    f32x4 v0 = acc[ai][bj][m][0], v1 = acc[ai][bj][m][1];
                    v0[0] *= bflo(gw.x); v0[1] *= bfhi(gw.x); v0[2] *= bflo(gw.y); v0[3] *= bfhi(gw.y); v1[0] *= bflo(gw.z); v1[1] *= bfhi(gw.z); v1[2] *= bflo(gw.w); v1[3] *= bfhi(gw.w);
                    bf16* mp = Mg + r * D + col;
                    if (br != 0) { const u32x4 ow = *(const u32x4*)mp;
                        v0[0] += bflo(ow.x); v0[1] += bfhi(ow.x); v0[2] += bflo(ow.y); v0[3] += bfhi(ow.y); v1[0] += bflo(ow.z); v1[1] += bfhi(ow.z); v1[2] += bflo(ow.w); v1[3] += bfhi(ow.w); }
                    u32x4 w; w.x = pg8::cvt_pk_bf16(v0[0], v0[1]); w.y = pg8::cvt_pk_bf16(v0[2], v0[3]); w.z = pg8::cvt_pk_bf16(v1[0], v1[1]); w.w = pg8::cvt_pk_bf16(v1[2], v1[3]);
                    *(u32x4*)mp = w; __builtin_amdgcn_sched_barrier(0); } }
    }
};
struct EpiResid {
    static constexpr bool PERM = true;
    float* X;
    __device__ __forceinline__ void operator()(const f32x4 (&acc)[2][2][4][2], const Unit& u, int wr, int wc, int fr, int fq) const {
        const int row0 = u.pm * 256 + wr * 64 + fr, col0 = u.pn * 256 + wc * 32 + 8 * fq;
#pragma unroll
        for (int ai = 0; ai < 2; ++ai)
#pragma unroll
            for (int m = 0; m < 4; ++m) { float* rowp = X + (size_t)(row0 + ai * 128 + m * 16) * D + col0;
#pragma unroll
                for (int bj = 0; bj < 2; ++bj) { f32x4* p = (f32x4*)(rowp + bj * 128);
                    const f32x4 x0 = p[0], x1 = p[1];
                    p[0] = x0 * DN_ALPHA + acc[ai][bj][m][0]; p[1] = x1 * DN_ALPHA + acc[ai][bj][m][1]; __builtin_amdgcn_sched_barrier(0); } }
    }
};
struct EpiGateUp {
    static constexpr bool PERM = true;
    bf16* H;
    __device__ __forceinline__ void operator()(const f32x4 (&acc)[2][2][4][2], const Unit& u, int wr, int wc, int fr, int fq) const {
        const int row0 = u.pm * 256 + wr * 64 + fr, col0 = u.pn * 128 + wc * 32 + 8 * fq;
#pragma unroll
        for (int ai = 0; ai < 2; ++ai)
#pragma unroll
            for (int m = 0; m < 4; ++m) { bf16* rowp = H + (size_t)(row0 + ai * 128 + m * 16) * FF + col0;
                f32x4 h0, h1;
#pragma unroll
                for (int j = 0; j < 4; ++j) { const float g0 = acc[ai][0][m][0][j], g1 = acc[ai][0][m][1][j];
                    h0[j] = g0 * sigm_fast(g0) * acc[ai][1][m][0][j]; h1[j] = g1 * sigm_fast(g1) * acc[ai][1][m][1][j]; }
                u32x4 w; w.x = pg8::cvt_pk_bf16(h0[0], h0[1]); w.y = pg8::cvt_pk_bf16(h0[2], h0[3]); w.z = pg8::cvt_pk_bf16(h1[0], h1[1]); w.w = pg8::cvt_pk_bf16(h1[2], h1[3]);
                *(u32x4*)rowp = w; }
    }
};

struct Ctx { LAS unsigned char* lds; int tid, lane, wave, G, bx, gw, NGW; };

template <class SRC>
__device__ __forceinline__ void transpose_task(const Ctx& c, const SRC& src, int ldsrc, int K, bf16* dst, int ndst) {
    LAS float* scr = (LAS float*)(c.lds + c.wave * 8704);
    const int nblk = ndst / 32, items = (K / 64) * nblk, lane = c.lane;
    for (int it = c.gw; it < items; it += c.NGW) {
        const int kb = it / nblk, nb = it % nblk, k0 = 64 * kb, n0 = 32 * nb;
        const float* sp = src(n0 + (lane & 31));
#pragma unroll 8
        for (int i = 0; i < 32; ++i) { const int kk = 2 * i + (lane >> 5); scr[kk * 33 + (lane & 31)] = sp ? sp[(size_t)(k0 + kk) * ldsrc] : 0.f; }
        LDS_WAIT();
        const int cc = lane & 7;
#pragma unroll
        for (int j = 0; j < 4; ++j) { const int n = (lane >> 3) + 8 * j; const LAS float* s = scr + (8 * cc) * 33 + n;
            u32x4 o; o.x = pk2(s[0 * 33], s[1 * 33]); o.y = pk2(s[2 * 33], s[3 * 33]); o.z = pk2(s[4 * 33], s[5 * 33]); o.w = pk2(s[6 * 33], s[7 * 33]);
            *(u32x4*)(dst + (size_t)(n0 + n) * K + k0 + 8 * cc) = o; }
        LDS_WAIT();
    }
}
struct SrcWin { const float* W; int layer;
    __device__ __forceinline__ const float* operator()(int n) const {
        const int rw = layer ? 3584 : 3520; int sc;
        if (n < 3072) sc = n; else if (n < 5632) sc = rw + (n - 3072); else if (n < 9728) sc = rw + 2608 + (n - 5632); else if (n < 10176) sc = 3072 + (n - 9728);
        else if (n < 10240) sc = layer ? 3520 + (n - 10176) : -1; else if (n < 10288) sc = rw + 2560 + (n - 10240); else sc = -1;
        return sc >= 0 ? W + sc : nullptr; } };
struct SrcOff { const float* W; __device__ __forceinline__ const float* operator()(int n) const { return W + n; } };
struct SrcGU { const float* Wg; const float* Wu;
    __device__ __forceinline__ const float* operator()(int nn) const { const int e = nn >> 10, r1 = nn & 1023, pn = r1 >> 8, rr = r1 & 255;
        const size_t du = (size_t)((const char*)Wu - (const char*)Wg);
        return (const float*)((const char*)Wg + (rr < 128 ? (size_t)0 : du)) + (size_t)e * D * FF + 128 * pn + (rr & 127); } };
struct SrcDN { const float* Wd;
    __device__ __forceinline__ const float* operator()(int nn) const { const int e = nn >> 11, n = nn & 2047; return Wd + (size_t)e * FF * D + n; } };

__device__ __forceinline__ void ph_conv(const Ctx& c, const PA& a, int layer) {
    unsigned char* ws = a.ws;
    const float* Win = layer ? a.in(2) : a.in(1); const int ldw = layer ? 16432 : 16368, rw = layer ? 3584 : 3520;
    transpose_task(c, SrcWin{Win, layer}, ldw, D, (bf16*)(ws + WS_WIN), LDP);
    transpose_task(c, SrcOff{Win + rw + 2608 + 4096}, ldw, D, (bf16*)(ws + WS_WG), NG);
    transpose_task(c, SrcOff{a.in(21) + (size_t)layer * RWW * D}, D, RWW, (bf16*)(ws + WS_WBR), D);
    transpose_task(c, SrcOff{a.in(22) + (size_t)layer * RWW * D}, D, RWW, (bf16*)(ws + WS_WBR) + (size_t)D * RWW, D);
    transpose_task(c, SrcOff{a.in(23) + (size_t)layer * RWW * D}, D, RWW, (bf16*)(ws + WS_WBR) + (size_t)2 * D * RWW, D);
    transpose_task(c, SrcOff{a.in(24) + (size_t)layer * D * D}, D, D, (bf16*)(ws + WS_WOUT), D);
    if (layer == 0) {
        const f32x4* x4 = (const f32x4*)a.in(0); f32x4* o4 = (f32x4*)a.out; uint2* xb = (uint2*)(ws + WS_XB);
        for (size_t i = (size_t)c.bx * 512 + c.tid; i < (size_t)T * D / 4; i += (size_t)c.G * 512) { const f32x4 v = x4[i]; o4[i] = v; xb[i] = make_uint2(pk2(v[0], v[1]), pk2(v[2], v[3])); }
        float* cs = (float*)(ws + WS_COS); float* sn = (float*)(ws + WS_SIN);
        for (int i = c.bx * 512 + c.tid; i < T * 64; i += c.G * 512) { const int t = i >> 6, j = i & 63;
            const double rev = (double)t * INV_FREQ[j] * 0.15915494309189533577; const float fr = (float)(rev - __builtin_rint(rev));
            cs[i] = __builtin_amdgcn_cosf(fr); sn[i] = __builtin_amdgcn_sinf(fr); }
    }
}
__device__ __forceinline__ void ph_conv_moe(const Ctx& c, const PA& a, int layer) {
    unsigned char* ws = a.ws; const size_t lo = (size_t)layer * NEXP * D * FF;
    transpose_task(c, SrcGU{a.in(31) + lo, a.in(32) + lo}, FF, D, (bf16*)(ws + WS_WGU), NEXP * 1024);
    transpose_task(c, SrcDN{a.in(33) + lo}, D, FF, (bf16*)(ws + WS_WDN), NEXP * D);
}

__device__ __forceinline__ float softplusf_(float x) { return fmaxf(x, 0.f) + log1pf(expf(-fabsf(x))); }
__device__ __forceinline__ void prep_rwkv(const Ctx& c, const PA& a, int layer) {
    unsigned char* ws = a.ws; const bf16* proj = (const bf16*)(ws + WS_PROJ);
    LAS float* sh_r = (LAS float*)c.lds; LAS float* sh_k = sh_r + 8 * 1024; LAS float* sh_v = sh_k + 8 * 1024; LAS float* sh_x = sh_v + 8 * 1024;
    bf16* oR = (bf16*)(ws + WS_RW_R); bf16* oK = (bf16*)(ws + WS_RW_K); bf16* oV = (bf16*)(ws + WS_RW_V); bf16* oKK = (bf16*)(ws + WS_RW_KK); bf16* oB = (bf16*)(ws + WS_RW_B);
    float* oW = (float*)(ws + WS_RW_W); bf16* oG = (bf16*)(ws + WS_RW_G); bf16* VF = (bf16*)(ws + WS_VF); float* rkb = (float*)(ws + WS_RKB);
    const int lane = c.lane, w = c.wave, tid = c.tid;
    for (int it = c.bx; it < T / 8; it += c.G) {
        const int t = it * 8 + w;
        const bf16* prow = proj + (size_t)t * LDP; const bf16* pprev = prow - LDP;
        const float* mu = a.in(layer ? 4 : 3);
#pragma unroll
        for (int i = 0; i < 6; ++i) { const int c8 = (lane + 64 * i) * 8;
            const u32x4 p = *(const u32x4*)(prow + c8); u32x4 q = (u32x4){0u, 0u, 0u, 0u}; if (t > 0) q = *(const u32x4*)(pprev + c8);
            const f32x4 m0 = *(const f32x4*)(mu + c8), m1 = *(const f32x4*)(mu + c8 + 4);
            float pv[8] = {bflo(p.x), bfhi(p.x), bflo(p.y), bfhi(p.y), bflo(p.z), bfhi(p.z), bflo(p.w), bfhi(p.w)};
            float qv[8] = {bflo(q.x), bfhi(q.x), bflo(q.y), bfhi(q.y), bflo(q.z), bfhi(q.z), bflo(q.w), bfhi(q.w)};
            LAS float* dstp = (c8 < 1024 ? sh_r + w * 1024 + c8 : (c8 < 2048 ? sh_k + w * 1024 + (c8 - 1024) : sh_v + w * 1024 + (c8 - 2048)));
#pragma unroll
            for (int j = 0; j < 8; ++j) { const float mm = j < 4 ? m0[j] : m1[j - 4]; dstp[j] = pv[j] + (qv[j] - pv[j]) * mm; } }
        { const int i8 = lane * 8; int sc, mi, fn;
            if (i8 < 96) { sc = PC_XW + i8; mi = 3072 + i8; fn = 1; } else if (i8 < 192) { sc = PC_XA + (i8 - 96); mi = 3168 + (i8 - 96); fn = 0; }
            else if (i8 < 448) { sc = PC_XG + (i8 - 192); mi = 3264 + (i8 - 192); fn = 2; } else { sc = PC_XV + (i8 - 448); mi = 3520 + (i8 - 448); fn = layer ? 0 : 3; }
            const u32x4 p = *(const u32x4*)(prow + sc); u32x4 q = (u32x4){0u, 0u, 0u, 0u}; if (t > 0) q = *(const u32x4*)(pprev + sc);
            float pv[8] = {bflo(p.x), bfhi(p.x), bflo(p.y), bfhi(p.y), bflo(p.z), bfhi(p.z), bflo(p.w), bfhi(p.w)};
            float qv[8] = {bflo(q.x), bfhi(q.x), bflo(q.y), bfhi(q.y), bflo(q.z), bfhi(q.z), bflo(q.w), bfhi(q.w)};
#pragma unroll
            for (int j = 0; j < 8; ++j) { float s = 0.f;
                if (fn != 3) { const float mm = mu[mi + j]; s = pv[j] + (qv[j] - pv[j]) * mm; if (fn == 1) s = tanhf(s); else if (fn == 2) s = sigm(s); }
                sh_x[w * 512 + i8 + j] = s; } }
        __syncthreads();
        float sw[8][2], sa[8][2], sg[8][2], sv[8][2];
#pragma unroll
        for (int k = 0; k < 8; ++k) { sw[k][0] = sw[k][1] = sa[k][0] = sa[k][1] = sg[k][0] = sg[k][1] = sv[k][0] = sv[k][1] = 0.f; }
        { const float* w_up = a.in(6) + (size_t)layer * 96 * 1024; const float* a_up = a.in(8) + (size_t)layer * 96 * 1024;
#pragma unroll 8
        for (int k = 0; k < 96; ++k) { const float u0 = w_up[k * 1024 + tid], u1 = w_up[k * 1024 + tid + 512], b0 = a_up[k * 1024 + tid], b1 = a_up[k * 1024 + tid + 512];
#pragma unroll
            for (int tk = 0; tk < 8; ++tk) { const float x = sh_x[tk * 512 + k], y = sh_x[tk * 512 + 96 + k]; sw[tk][0] += x * u0; sw[tk][1] += x * u1; sa[tk][0] += y * b0; sa[tk][1] += y * b1; } } }
        { const float* g_up = a.in(11) + (size_t)layer * 256 * 1024;
#pragma unroll 8
        for (int k = 0; k < 256; ++k) { const float u0 = g_up[k * 1024 + tid], u1 = g_up[k * 1024 + tid + 512];
#pragma unroll
            for (int tk = 0; tk < 8; ++tk) { const float x = sh_x[tk * 512 + 192 + k]; sg[tk][0] += x * u0; sg[tk][1] += x * u1; } } }
        if (layer) { const float* v_up = a.in(10);
#pragma unroll 8
        for (int k = 0; k < 64; ++k) { const float u0 = v_up[k * 1024 + tid], u1 = v_up[k * 1024 + tid + 512];
#pragma unroll
            for (int tk = 0; tk < 8; ++tk) { const float x = sh_x[tk * 512 + 448 + k]; sv[tk][0] += x * u0; sv[tk][1] += x * u1; } } }
#pragma unroll
        for (int ci = 0; ci < 2; ++ci) { const int col = tid + 512 * ci, head = w + 8 * ci;
            const float kkc = a.in(12)[layer * 1024 + col], kac = a.in(13)[layer * 1024 + col], rkc = a.in(14)[layer * 1024 + col], w0c = a.in(5)[layer * 1024 + col], a0c = a.in(7)[layer * 1024 + col], v0c = layer ? a.in(9)[col] : 0.f;
#pragma unroll
            for (int tk = 0; tk < 8; ++tk) { const int tt = it * 8 + tk; const size_t o = (size_t)tt * 1024 + col;
                const float k0 = sh_k[tk * 1024 + col], r = sh_r[tk * 1024 + col], v0 = sh_v[tk * 1024 + col];
                const float kkraw = k0 * kkc, n2 = wave_sum(kkraw * kkraw), kkn = kkraw / fmaxf(sqrtf(n2), 1e-12f);
                const float aa = sigm(a0c + sa[tk][ci]), bb = kkn * aa, kf = k0 * (1.f + (aa - 1.f) * kac);
                const float z = w0c + sw[tk][ci], wl = -softplusf_(-z) - 0.5f, dec = expf(-expf(wl));
                float vv = v0;
                if (layer) { const float vf = bf2f(VF[o]); vv = v0 + (vf - v0) * sigm(v0c + sv[tk][ci]); } else VF[o] = (bf16)f2bf(v0);
                const float rk = wave_sum(r * kf * rkc);
                if (lane == 0) rkb[tt * 16 + head] = rk;
                oR[o] = (bf16)f2bf(r); oK[o] = (bf16)f2bf(kf); oV[o] = (bf16)f2bf(vv); oKK[o] = (bf16)f2bf(kkn); oB[o] = (bf16)f2bf(bb); oW[o] = dec; oG[o] = (bf16)f2bf(sg[tk][ci]); } }
        __syncthreads();
    }
}
__device__ __forceinline__ float gelu_tanh(float x) { return 0.5f * x * (1.f + tanhf(0.7978845608028654f * (x + 0.044715f * x * x * x))); }
__device__ __forceinline__ void prep_cmp(const Ctx& c, const PA& a, int layer) {
    unsigned char* ws = a.ws; const bf16* proj = (const bf16*)(ws + WS_PROJ);
    LAS float* sh_in = (LAS float*)c.lds; LAS float* sh_h = sh_in + 4 * 2048;
    const int tid = c.tid;
    for (int it = c.bx; it < NCMP * 2; it += c.G) {
        const int cb = it >> 1, kv = it & 1, col0 = kv ? PC_VC : PC_KC, lk = layer * 2 + kv;
        const float* pe = a.in(17) + (size_t)lk * 2048; const float* w1 = a.in(18) + (size_t)lk * 2048 * 128; const float* b1 = a.in(19) + lk * 128; const float* w2 = a.in(20) + (size_t)lk * 128 * 64;
        for (int idx = tid; idx < 8192; idx += 512) { const int g = idx >> 11, r = idx & 2047, l = r >> 6, d = r & 63;
            sh_in[idx] = bf2f(proj[(size_t)(16 * cb + l) * LDP + col0 + g * 64 + d]) + pe[r]; }
        __syncthreads();
        { const int g = tid >> 7, j = tid & 127; float acc = b1[j]; const LAS float* in = sh_in + g * 2048;
#pragma unroll 8
            for (int i = 0; i < 2048; ++i) acc += in[i] * w1[i * 128 + j];
            sh_h[tid] = gelu_tanh(acc); }
        __syncthreads();
        if (tid < 256) { const int g = tid >> 6, d = tid & 63; float o = 0.f;
#pragma unroll 8
            for (int j = 0; j < 128; ++j) o += sh_h[g * 128 + j] * w2[j * 64 + d];
            { const int blk = cb >> 6, kc = cb & 63;
                if (kv == 0) { const int j = kc >> 4, rr = kc & 15, ks = d >> 5, qq = (d & 31) >> 3, i = d & 7;
                    ((bf16*)(ws + WS_KCMPB))[((((size_t)g * 16 + blk) * 8 + 2 * j + ks) * 64 + qq * 16 + rr) * 8 + i] = (bf16)f2bf(o);
                    if (cb == 0) ((bf16*)(ws + WS_KCMPB))[((((size_t)g * 16 + 15) * 8 + 2 * 3 + ks) * 64 + qq * 16 + 15) * 8 + i] = 0; }
                else { const int ks = kc >> 5, kk = kc & 31, hh = kk >> 4, qq = (kk & 15) >> 2, i = (kk & 3) + 4 * hh, mt = d >> 4, rr = d & 15;
                    ((bf16*)(ws + WS_VCMPT))[((((size_t)g * 16 + blk) * 8 + 2 * mt + ks) * 64 + qq * 16 + rr) * 8 + i] = (bf16)f2bf(o);
                    if (cb == 0) ((bf16*)(ws + WS_VCMPT))[((((size_t)g * 16 + 15) * 8 + 2 * mt + 1) * 64 + 3 * 16 + rr) * 8 + 7] = 0; } } }
        __syncthreads();
    }
}
__device__ __forceinline__ void prep_rope(const Ctx& c, const PA& a) {
    unsigned char* ws = a.ws; bf16* proj = (bf16*)(ws + WS_PROJ); const float* cs = (const float*)(ws + WS_COS); const float* sn = (const float*)(ws + WS_SIN);
    for (int i = c.bx * 512 + c.tid; i < T * 8 * 64; i += c.G * 512) { const int j = i & 63, h = (i >> 6) & 7, t = i >> 9;
        const float co = cs[t * 64 + j], si = sn[t * 64 + j];
        bf16* q = proj + (size_t)t * LDP + PC_RQ + h * 128 + j;
        const float q1 = bf2f(q[0]), q2 = bf2f(q[64]);
        q[0] = (bf16)f2bf(q1 * co - q2 * si); q[64] = (bf16)f2bf(q1 * si + q2 * co); }
}

constexpr int RW_NC = 64, RW_CL = 256, RW_TS = 8;
typedef float f32x2 __attribute__((ext_vector_type(2)));
__device__ __forceinline__ void rw_put8(LAS float* d, u32x4 v) { *(LAS f32x4*)d = (f32x4){bflo(v.x), bfhi(v.x), bflo(v.y), bfhi(v.y)}; *(LAS f32x4*)(d + 4) = (f32x4){bflo(v.z), bfhi(v.z), bflo(v.w), bfhi(v.w)}; }
__device__ __forceinline__ void rw_stage(const unsigned char* ws, LAS float* tile, int t0, int h, int lane, bool need_r) {
    const unsigned e = (unsigned)((t0 + (lane >> 3)) * 1024 + h * 64 + 8 * (lane & 7)); LAS float* tp = tile + (lane >> 3) * 384 + 8 * (lane & 7);
    const u32x4 vkk = *(const u32x4*)(ws + ((unsigned)WS_RW_KK + e * 2u)), vb = *(const u32x4*)(ws + ((unsigned)WS_RW_B + e * 2u)), vk = *(const u32x4*)(ws + ((unsigned)WS_RW_K + e * 2u)), vv = *(const u32x4*)(ws + ((unsigned)WS_RW_V + e * 2u));
    const f32x4 w0 = *(const f32x4*)(ws + ((unsigned)WS_RW_W + e * 4u)), w1 = *(const f32x4*)(ws + ((unsigned)WS_RW_W + e * 4u + 16u));
    u32x4 vr = (u32x4){0u, 0u, 0u, 0u}; if (need_r) vr = *(const u32x4*)(ws + ((unsigned)WS_RW_R + e * 2u));
    rw_put8(tp, vkk); rw_put8(tp + 64, vb); *(LAS f32x4*)(tp + 128) = w0; *(LAS f32x4*)(tp + 132) = w1; rw_put8(tp + 192, vk); rw_put8(tp + 256, vr); rw_put8(tp + 320, vv);
}
#define RW_LD4(p) (*(const LAS f32x4*)(p))
__device__ __forceinline__ void rw_step(f32x2 (&S)[32], const LAS float* tp, float vi) {
    f32x4 kk[16];
#pragma unroll
    for (int i = 0; i < 16; ++i) kk[i] = RW_LD4(tp + 4 * i);
    __builtin_amdgcn_sched_barrier(0);
    f32x2 d0 = (f32x2){0.f, 0.f}, d1 = d0;
#pragma unroll
    for (int i = 0; i < 16; ++i) { d0 += S[2 * i] * (f32x2){kk[i][0], kk[i][1]}; d1 += S[2 * i + 1] * (f32x2){kk[i][2], kk[i][3]}; }
    const float sk = (d0[0] + d0[1]) + (d1[0] + d1[1]); const f32x2 nsk = (f32x2){-sk, -sk}, vi2 = (f32x2){vi, vi};
#pragma unroll
    for (int c = 0; c < 4; ++c) { f32x4 b4[4], w4[4], k4[4];
#pragma unroll
        for (int i = 0; i < 4; ++i) { b4[i] = RW_LD4(tp + 64 + 16 * c + 4 * i); w4[i] = RW_LD4(tp + 128 + 16 * c + 4 * i); k4[i] = RW_LD4(tp + 192 + 16 * c + 4 * i); }
        __builtin_amdgcn_sched_barrier(0);
#pragma unroll
        for (int i = 0; i < 4; ++i) { const int p = 8 * c + 2 * i;
            S[p] = S[p] * (f32x2){w4[i][0], w4[i][1]} + (vi2 * (f32x2){k4[i][0], k4[i][1]} + nsk * (f32x2){b4[i][0], b4[i][1]});
            S[p + 1] = S[p + 1] * (f32x2){w4[i][2], w4[i][3]} + (vi2 * (f32x2){k4[i][2], k4[i][3]} + nsk * (f32x2){b4[i][2], b4[i][3]}); }
        __builtin_amdgcn_sched_barrier(0); }
}
__device__ __forceinline__ float rw_dot_r(const f32x2 (&S)[32], const LAS float* tp) {
    f32x4 r4[16];
#pragma unroll
    for (int i = 0; i < 16; ++i) r4[i] = RW_LD4(tp + 256 + 4 * i);
    __builtin_amdgcn_sched_barrier(0);
    f32x2 d0 = (f32x2){0.f, 0.f}, d1 = d0;
#pragma unroll
    for (int i = 0; i < 16; ++i) { d0 += S[2 * i] * (f32x2){r4[i][0], r4[i][1]}; d1 += S[2 * i + 1] * (f32x2){r4[i][2], r4[i][3]}; }
    return (d0[0] + d0[1]) + (d1[0] + d1[1]);
}

__device__ __forceinline__ void rw_pass1(const Ctx& c, const PA& a) {
    const unsigned char* ws = a.ws; LAS float* tile = (LAS float*)(c.lds + c.wave * (RW_TS * 384 * 4));
    const int lane = c.lane;
    for (int task = c.gw; task < 16 * RW_NC * 2; task += c.NGW) {
        const int kind = task & 1, hc = task >> 1, h = hc / RW_NC, ch = hc % RW_NC;
        f32x2 S[32]; int lz = kind ? 64 : lane; asm volatile("" : "+v"(lz));
#pragma unroll
        for (int j = 0; j < 32; ++j) S[j] = (f32x2){(2 * j == lz) ? 1.f : 0.f, (2 * j + 1 == lz) ? 1.f : 0.f};
        for (int t0 = ch * RW_CL; t0 < (ch + 1) * RW_CL; t0 += RW_TS) {
            rw_stage(ws, tile, t0, h, lane, false);
            LDS_WAIT();
#pragma unroll 1
            for (int s = 0; s < RW_TS; ++s) { const LAS float* tp = tile + s * 384; const float vi = kind ? tp[320 + lane] : 0.f; rw_step(S, tp, vi); }
            LDS_WAIT();
        }
        float* out = (float*)(a.ws + (kind ? WS_RWU : WS_RWP)) + ((size_t)hc * 64 + lane) * 64;
#pragma unroll
        for (int jj = 0; jj < 16; ++jj) *(f32x4*)(out + 4 * jj) = (f32x4){S[2 * jj][0], S[2 * jj][1], S[2 * jj + 1][0], S[2 * jj + 1][1]};
    }
}
__device__ __forceinline__ void rw_pass2(const Ctx& c, const PA& a) {
    const float* P = (const float*)(a.ws + WS_RWP); const float* U = (const float*)(a.ws + WS_RWU); float* Si = (float*)(a.ws + WS_RWS);
    const int lane = c.lane;
    for (int task = c.gw; task < 16 * 64; task += c.NGW) { const int h = task >> 6, i = task & 63;
        float s = 0.f;
        for (int ch = 0; ch < RW_NC; ++ch) { const size_t hc = (size_t)h * RW_NC + ch;
            Si[(hc * 64 + i) * 64 + lane] = s;
            float acc = U[(hc * 64 + i) * 64 + lane]; const float* Pc = P + hc * 4096 + lane;
#pragma unroll
            for (int i2 = 0; i2 < 64; ++i2) acc += __shfl(s, i2) * Pc[i2 * 64];
            s = acc; }
    }
}
__device__ __forceinline__ void rw_pass3(const Ctx& c, const PA& a, int layer) {
    const unsigned char* ws = a.ws; LAS float* tile = (LAS float*)(c.lds + c.wave * 17408); LAS float* tg = tile + 3072; LAS float* ty = tg + 512; LAS float* trk = ty + 512; LAS float* tst = trk + 8;
    const float* Si = (const float*)(ws + WS_RWS); const float* rkb = (const float*)(ws + WS_RKB); bf16* Y = (bf16*)(a.ws + WS_YRW);
    const float* lng = a.in(15) + layer * 1024; const float* lnb = a.in(16) + layer * 1024;
    const int lane = c.lane;
    for (int task = c.gw; task < 16 * RW_NC; task += c.NGW) {
        const int h = task / RW_NC, ch = task % RW_NC, col = h * 64 + lane;
        const float lg = lng[col], lb = lnb[col];
        f32x2 S[32]; const float* sp = Si + ((size_t)task * 64 + lane) * 64;
#pragma unroll
        for (int jj = 0; jj < 16; ++jj) { const f32x4 v = *(const f32x4*)(sp + 4 * jj); S[2 * jj] = (f32x2){v[0], v[1]}; S[2 * jj + 1] = (f32x2){v[2], v[3]}; }
        for (int t0 = ch * RW_CL; t0 < (ch + 1) * RW_CL; t0 += RW_TS) {
            rw_stage(ws, tile, t0, h, lane, true);
            { const unsigned e = (unsigned)((t0 + (lane >> 3)) * 1024 + h * 64 + 8 * (lane & 7)); rw_put8(tg + (lane >> 3) * 64 + 8 * (lane & 7), *(const u32x4*)(ws + ((unsigned)WS_RW_G + e * 2u)));
                if (lane < 8) trk[lane] = rkb[(t0 + lane) * 16 + h]; }
            LDS_WAIT();
#pragma unroll 1
            for (int s = 0; s < RW_TS; ++s) { const LAS float* tp = tile + s * 384; const float vi = tp[320 + lane]; rw_step(S, tp, vi); ty[s * 64 + lane] = rw_dot_r(S, tp); }
            LDS_WAIT();
            { const LAS float* yp = ty + (lane >> 3) * 64 + 8 * (lane & 7); const f32x4 y0 = *(const LAS f32x4*)yp, y1 = *(const LAS f32x4*)(yp + 4);
                float sm = ((y0[0] + y0[1]) + (y0[2] + y0[3])) + ((y1[0] + y1[1]) + (y1[2] + y1[3]));
                sm += __shfl_xor(sm, 1); sm += __shfl_xor(sm, 2); sm += __shfl_xor(sm, 4); const float mean = sm * (1.f / 64.f);
                const f32x4 d0 = y0 - mean, d1 = y1 - mean; float sq = ((d0[0] * d0[0] + d0[1] * d0[1]) + (d0[2] * d0[2] + d0[3] * d0[3])) + ((d1[0] * d1[0] + d1[1] * d1[1]) + (d1[2] * d1[2] + d1[3] * d1[3]));
                sq += __shfl_xor(sq, 1); sq += __shfl_xor(sq, 2); sq += __shfl_xor(sq, 4);
                if ((lane & 7) == 0) { tst[2 * (lane >> 3)] = mean; tst[2 * (lane >> 3) + 1] = 1.f / sqrtf(sq * (1.f / 64.f) + 64e-5f); } }
            LDS_WAIT();
#pragma unroll
            for (int s = 0; s < RW_TS; ++s) { const float y = ty[s * 64 + lane], vi = tile[s * 384 + 320 + lane], yn = (y - tst[2 * s]) * tst[2 * s + 1];
                Y[(size_t)(t0 + s) * 1024 + col] = (bf16)f2bf((yn * lg + lb + trk[s] * vi) * tg[s * 64 + lane]); }
            LDS_WAIT();
        }
    }
}

__device__ __forceinline__ int ret_tok(int ks, int q, int i) { return 32 * ks + 4 * q + (i & 3) + ((i >> 2) << 4); }
__device__ __forceinline__ void prep_ret_frags(const Ctx& c, const PA& a) {
    unsigned char* ws = a.ws; bf16* proj = (bf16*)(ws + WS_PROJ); const float* cs = (const float*)(ws + WS_COS); const float* sn = (const float*)(ws + WS_SIN);
    LAS float* tile = (LAS float*)(c.lds + c.wave * 16896);
    const int lane = c.lane, r = lane & 15, q = lane >> 4;
    for (int it = c.gw; it < 8 * 128 * 4 * 2; it += c.NGW) { const int ten = it & 1, ks = (it >> 1) & 3, ch = (it >> 3) & 127, h = it >> 10; const int tb = ch * 128 + 32 * ks;
        if (ten == 0) {
#pragma unroll
            for (int i = 0; i < 8; ++i) { const int id = lane + 64 * i, row = id >> 4, c8 = (id & 15) * 8; const u32x4 v = *(const u32x4*)(proj + (size_t)(tb + row) * LDP + PC_RV + h * 128 + c8);
                LAS float* tp = tile + row * 132 + c8; *(LAS f32x4*)tp = (f32x4){bflo(v.x), bfhi(v.x), bflo(v.y), bfhi(v.y)}; *(LAS f32x4*)(tp + 4) = (f32x4){bflo(v.z), bfhi(v.z), bflo(v.w), bfhi(v.w)}; }
        } else {
#pragma unroll
            for (int i = 0; i < 4; ++i) { const int id = lane + 64 * i, row = id >> 3, c8 = (id & 7) * 8; bf16* kp = proj + (size_t)(tb + row) * LDP + PC_RK + h * 128 + c8;
                const u32x4 lo = *(const u32x4*)kp, hi = *(const u32x4*)(kp + 64);
                const f32x4 c0 = *(const f32x4*)(cs + (size_t)(tb + row) * 64 + c8), c1 = *(const f32x4*)(cs + (size_t)(tb + row) * 64 + c8 + 4), s0 = *(const f32x4*)(sn + (size_t)(tb + row) * 64 + c8), s1 = *(const f32x4*)(sn + (size_t)(tb + row) * 64 + c8 + 4);
                const float k1[8] = {bflo(lo.x), bfhi(lo.x), bflo(lo.y), bfhi(lo.y), bflo(lo.z), bfhi(lo.z), bflo(lo.w), bfhi(lo.w)}, k2[8] = {bflo(hi.x), bfhi(hi.x), bflo(hi.y), bfhi(hi.y), bflo(hi.z), bfhi(hi.z), bflo(hi.w), bfhi(hi.w)};
                float o1[8], o2[8];
#pragma unroll
                for (int j = 0; j < 8; ++j) { const float co = j < 4 ? c0[j] : c1[j - 4], si = j < 4 ? s0[j] : s1[j - 4];
                    o1[j] = bf2f((bf16)f2bf((k1[j] * co - k2[j] * si) * 0.08838834764831845f)); o2[j] = bf2f((bf16)f2bf((k1[j] * si + k2[j] * co) * 0.08838834764831845f)); }
                *(u32x4*)kp = (u32x4){pk2(o1[0], o1[1]), pk2(o1[2], o1[3]), pk2(o1[4], o1[5]), pk2(o1[6], o1[7])}; *(u32x4*)(kp + 64) = (u32x4){pk2(o2[0], o2[1]), pk2(o2[2], o2[3]), pk2(o2[4], o2[5]), pk2(o2[6], o2[7])};
                LAS float* tp = tile + row * 132 + c8;
                *(LAS f32x4*)tp = (f32x4){o1[0], o1[1], o1[2], o1[3]}; *(LAS f32x4*)(tp + 4) = (f32x4){o1[4], o1[5], o1[6], o1[7]}; *(LAS f32x4*)(tp + 64) = (f32x4){o2[0], o2[1], o2[2], o2[3]}; *(LAS f32x4*)(tp + 68) = (f32x4){o2[4], o2[5], o2[6], o2[7]}; }
        }
        LDS_WAIT();
        bf16* dst = (bf16*)(ws + (ten == 0 ? WS_VFR : WS_KTR)) + (((size_t)(h * 128 + ch) * 8) * 4 + ks) * 512 + lane * 8;
        float dec[8];
#pragma unroll
        for (int i = 0; i < 8; ++i) { const int tl = ret_tok(0, q, i); dec[i] = ten ? expf(RET_LOGG[h] * (float)(127 - (32 * ks + tl))) : 1.f; }
#pragma unroll
        for (int mt = 0; mt < 8; ++mt) { float v[8];
#pragma unroll
            for (int i = 0; i < 8; ++i) v[i] = tile[ret_tok(0, q, i) * 132 + 16 * mt + r] * dec[i];
            *(u32x4*)(dst + (size_t)mt * 4 * 512) = (u32x4){pk2(v[0], v[1]), pk2(v[2], v[3]), pk2(v[4], v[5]), pk2(v[6], v[7])}; }
        LDS_WAIT();
    }
}
__device__ __forceinline__ void ret_kv(const Ctx& c, const PA& a) {
    const bf16* VF = (const bf16*)(a.ws + WS_VFR); const bf16* KT = (const bf16*)(a.ws + WS_KTR); float* KV = (float*)(a.ws + WS_RETKV);
    const int lane = c.lane, r = lane & 15, q = lane >> 4, w = c.wave;
    for (int it = c.bx; it < 128 * 8; it += c.G) { const int ch = it >> 3, h = it & 7; const size_t fb = ((size_t)(h * 128 + ch) * 8) * 4 * 512 + lane * 8;
        f32x4 acc[8];
#pragma unroll
        for (int mt = 0; mt < 8; ++mt) acc[mt] = (f32x4){0.f, 0.f, 0.f, 0.f};
#pragma unroll
        for (int ks = 0; ks < 4; ++ks) { const bf16x8 kb = *(const bf16x8*)(KT + fb + (size_t)(w * 4 + ks) * 512);
#pragma unroll
            for (int mt = 0; mt < 8; ++mt) { const bf16x8 va = *(const bf16x8*)(VF + fb + (size_t)(mt * 4 + ks) * 512); acc[mt] = __builtin_amdgcn_mfma_f32_16x16x32_bf16(va, kb, acc[mt], 0, 0, 0); } }
        float* o = KV + ((size_t)it * 128) * 128 + 16 * w + r;
#pragma unroll
        for (int mt = 0; mt < 8; ++mt)
#pragma unroll
            for (int i = 0; i < 4; ++i) o[(size_t)(16 * mt + 4 * q + i) * 128] = acc[mt][i];
    }
}
__device__ __forceinline__ void ret_prefix(const Ctx& c, const PA& a) {
    const float* KV = (const float*)(a.ws + WS_RETKV); bf16* RT = (bf16*)(a.ws + WS_RT);
    for (int i = c.bx * 512 + c.tid; i < 8 * 16384; i += c.G * 512) { const int h = i >> 14, e = i & 16383; const float cd = expf(RET_LOGG[h] * 128.f);
        float rr = 0.f;
        for (int c0 = 0; c0 < 128; c0 += 16) { float tmp[16];
#pragma unroll
            for (int k = 0; k < 16; ++k) tmp[k] = KV[((size_t)((c0 + k) * 8 + h) << 14) + e];
#pragma unroll
            for (int k = 0; k < 16; ++k) { RT[((size_t)((c0 + k) * 8 + h) << 14) + e] = (bf16)f2bf(rr); rr = rr * cd + tmp[k]; } } }
}
__device__ __forceinline__ void ret_out(const Ctx& c, const PA& a) {
    const bf16* proj = (const bf16*)(a.ws + WS_PROJ); const bf16* VF = (const bf16*)(a.ws + WS_VFR); const bf16* RT = (const bf16*)(a.ws + WS_RT); bf16* Y = (bf16*)(a.ws + WS_YRET);
    const int lane = c.lane, r = lane & 15, q = lane >> 4, w = c.wave;
    for (int it = c.bx; it < 128 * 8; it += c.G) { const int ch = it >> 3, h = it & 7; const float lg2 = RET_LOGG[h] * 1.4426950408889634f;
        const int iq = 16 * w + r, tq = ch * 128 + iq;
        bf16x8 qb[4];
#pragma unroll
        for (int ks = 0; ks < 4; ++ks) qb[ks] = *(const bf16x8*)(proj + (size_t)tq * LDP + PC_RQ + h * 128 + 32 * ks + 8 * q);
        f32x4 oi[8], oc[8];
#pragma unroll
        for (int mt = 0; mt < 8; ++mt) { oi[mt] = (f32x4){0.f, 0.f, 0.f, 0.f}; oc[mt] = oi[mt]; }
        const size_t fb = ((size_t)(h * 128 + ch) * 8) * 4 * 512 + lane * 8;
#pragma unroll
        for (int ks = 0; ks < 4; ++ks) if (2 * ks <= w) { f32x4 st[2];
#pragma unroll
            for (int jj = 0; jj < 2; ++jj) { const int j = 2 * ks + jj; st[jj] = (f32x4){0.f, 0.f, 0.f, 0.f};
                if (j <= w) { const bf16* kp = proj + (size_t)(ch * 128 + 16 * j + r) * LDP + PC_RK + h * 128 + 8 * q;
#pragma unroll
                    for (int k2 = 0; k2 < 4; ++k2) st[jj] = __builtin_amdgcn_mfma_f32_16x16x32_bf16(*(const bf16x8*)(kp + 32 * k2), qb[k2], st[jj], 0, 0, 0);
#pragma unroll
                    for (int i = 0; i < 4; ++i) { const int d = iq - (16 * j + 4 * q + i); st[jj][i] = d >= 0 ? st[jj][i] * __builtin_amdgcn_exp2f(lg2 * (float)d) : 0.f; } } }
            const u32x4 pw = (u32x4){pg8::cvt_pk_bf16(st[0][0], st[0][1]), pg8::cvt_pk_bf16(st[0][2], st[0][3]), pg8::cvt_pk_bf16(st[1][0], st[1][1]), pg8::cvt_pk_bf16(st[1][2], st[1][3])};
            const bf16x8 pf = __builtin_bit_cast(bf16x8, pw);
#pragma unroll
            for (int mt = 0; mt < 8; ++mt) oi[mt] = __builtin_amdgcn_mfma_f32_16x16x32_bf16(*(const bf16x8*)(VF + fb + (size_t)(mt * 4 + ks) * 512), pf, oi[mt], 0, 0, 0);
            __builtin_amdgcn_sched_barrier(0); }
        const bf16* rp = RT + ((size_t)it * 128 + r) * 128 + 8 * q;
#pragma unroll
        for (int mt = 0; mt < 8; ++mt)
#pragma unroll
            for (int ks = 0; ks < 4; ++ks) { oc[mt] = __builtin_amdgcn_mfma_f32_16x16x32_bf16(*(const bf16x8*)(rp + (size_t)(16 * mt) * 128 + 32 * ks), qb[ks], oc[mt], 0, 0, 0); if (ks == 3 && (mt & 1)) __builtin_amdgcn_sched_barrier(0); }
        const float qd = __builtin_amdgcn_exp2f(lg2 * (float)(iq + 1));
        float sm = 0.f;
#pragma unroll
        for (int mt = 0; mt < 8; ++mt) { oi[mt] = oi[mt] + oc[mt] * qd; sm += (oi[mt][0] + oi[mt][1]) + (oi[mt][2] + oi[mt][3]); }
        sm += __shfl_xor(sm, 16); sm += __shfl_xor(sm, 32); const float mean = sm * (1.f / 128.f); float sq = 0.f;
#pragma unroll
        for (int mt = 0; mt < 8; ++mt) { oi[mt] = oi[mt] - mean; sq += (oi[mt][0] * oi[mt][0] + oi[mt][1] * oi[mt][1]) + (oi[mt][2] * oi[mt][2] + oi[mt][3] * oi[mt][3]); }
        sq += __shfl_xor(sq, 16); sq += __shfl_xor(sq, 32); const float rs = 1.f / sqrtf(sq * (1.f / 128.f) + 1e-5f);
        const bf16* gp = proj + (size_t)tq * LDP + PC_RG + h * 128 + 4 * q; bf16* yp = Y + (size_t)tq * 1024 + h * 128 + 4 * q;
#pragma unroll
        for (int mt = 0; mt < 8; ++mt) { const uint2 gw = *(const uint2*)(gp + 16 * mt); const float g0 = bflo(gw.x), g1 = bfhi(gw.x), g2 = bflo(gw.y), g3 = bfhi(gw.y);
            uint2 o; o.x = pg8::cvt_pk_bf16(g0 * sigm(g0) * oi[mt][0] * rs, g1 * sigm(g1) * oi[mt][1] * rs); o.y = pg8::cvt_pk_bf16(g2 * sigm(g2) * oi[mt][2] * rs, g3 * sigm(g3) * oi[mt][3] * rs);
            *(uint2*)(yp + 16 * mt) = o; }
    }
}


constexpr float NSA_C = 0.125f * 1.4426950408889634f;
struct NsaSrc { const bf16* kf; const bf16* vf; };

__device__ __forceinline__ void nsa_loadK(const NsaSrc& src, int key0, bf16x8 (&kf)[4][2], int lane) {
    const bf16* kp = src.kf + (size_t)(key0 >> 6) * 4096 + lane * 8;
#pragma unroll
    for (int j = 0; j < 4; ++j) { kf[j][0] = *(const bf16x8*)(kp + (2 * j) * 512); kf[j][1] = *(const bf16x8*)(kp + (2 * j + 1) * 512); }
}
__device__ __forceinline__ void nsa_loadV(const NsaSrc& src, int key0, bf16x8 (&vf)[4][2], int lane) {
    const bf16* vp = src.vf + (size_t)(key0 >> 6) * 4096 + lane * 8;
#pragma unroll
    for (int mt = 0; mt < 4; ++mt) { vf[mt][0] = *(const bf16x8*)(vp + (2 * mt) * 512); vf[mt][1] = *(const bf16x8*)(vp + (2 * mt + 1) * 512); }
}
__device__ __forceinline__ void nsa_qk(const bf16x8 (&kf)[4][2], const bf16x8 (&qf)[2], f32x4 (&st)[4]) {
#pragma unroll
    for (int j = 0; j < 4; ++j) { st[j] = (f32x4){0.f, 0.f, 0.f, 0.f};
        st[j] = __builtin_amdgcn_mfma_f32_16x16x32_bf16(kf[j][0], qf[0], st[j], 0, 0, 0); st[j] = __builtin_amdgcn_mfma_f32_16x16x32_bf16(kf[j][1], qf[1], st[j], 0, 0, 0); }
}
template <int MODE>
__device__ __forceinline__ void nsa_rest(f32x4 (&st)[4], const bf16x8 (&vf)[4][2], int key0, int lo, int hi, f32x4 (&O)[4], float& m, float& l, float inv, int r, int q, LAS float* impA, LAS float* impB) {
    float mx = -1.0e30f;
#pragma unroll
    for (int j = 0; j < 4; ++j)
#pragma unroll
        for (int i = 0; i < 4; ++i) { const int key = key0 + 16 * j + 4 * q + i; const bool ok = key >= lo && key <= hi; st[j][i] = ok ? st[j][i] : -1.0e30f; mx = fmaxf(mx, st[j][i]); }
    float mn = m;
    if (MODE != 2) { mx = fmaxf(mx, __shfl_xor(mx, 16)); mx = fmaxf(mx, __shfl_xor(mx, 32)); mn = fmaxf(m, mx); }
    float ps = 0.f;
#pragma unroll
    for (int j = 0; j < 4; ++j)
#pragma unroll
        for (int i = 0; i < 4; ++i) { const float e = st[j][i] > -1.0e29f ? __builtin_amdgcn_exp2f(NSA_C * (st[j][i] - mn)) : 0.f; st[j][i] = MODE == 2 ? e * inv : e; ps += e; }
    if (MODE != 2) { ps += __shfl_xor(ps, 16); ps += __shfl_xor(ps, 32);
        const float sc = __builtin_amdgcn_exp2f(NSA_C * (m - mn)); l = l * sc + ps; m = mn;
        if (MODE == 1) {
#pragma unroll
            for (int mt = 0; mt < 4; ++mt) O[mt] = O[mt] * sc; } }
    if (MODE == 2) {
#pragma unroll
        for (int j = 0; j < 4; ++j) { float a = (st[j][0] + st[j][1]) + (st[j][2] + st[j][3]), b = st[j][3];
            a += __shfl_xor(a, 1); a += __shfl_xor(a, 2); b += __shfl_xor(b, 1); b += __shfl_xor(b, 2);
            if ((r & 3) == 0) { const int J = (r >> 2) * 256 + (key0 >> 2) + 4 * j + q; impA[J] = a; impB[J] = b; } } }
    if (MODE != 0) {
        bf16x8 pf[2];
#pragma unroll
        for (int ks = 0; ks < 2; ++ks) { const unsigned w0 = pg8::cvt_pk_bf16(st[2 * ks][0], st[2 * ks][1]), w1 = pg8::cvt_pk_bf16(st[2 * ks][2], st[2 * ks][3]),
                                                        w2 = pg8::cvt_pk_bf16(st[2 * ks + 1][0], st[2 * ks + 1][1]), w3 = pg8::cvt_pk_bf16(st[2 * ks + 1][2], st[2 * ks + 1][3]);
            const u32x4 w = (u32x4){w0, w1, w2, w3}; pf[ks] = __builtin_bit_cast(bf16x8, w); }
#pragma unroll
        for (int mt = 0; mt < 4; ++mt) {
#pragma unroll
            for (int ks = 0; ks < 2; ++ks) O[mt] = __builtin_amdgcn_mfma_f32_16x16x32_bf16(vf[mt][ks], pf[ks], O[mt], 0, 0, 0); } }
}
#define NSA_LOOP(MODE, SRC, NBLK, KEY0, LO, HI, INV) do { const int nblk_ = (NBLK); if (nblk_ > 0) { bf16x8 kf_[4][2], vf_[4][2]; f32x4 st_[4]; nsa_loadK(SRC, KEY0(0), kf_, lane); \
    _Pragma("unroll 1") for (int b_ = 0; b_ < nblk_; ++b_) { const int k0_ = KEY0(b_); if (MODE != 0) nsa_loadV(SRC, k0_, vf_, lane); \
        nsa_qk(kf_, qf, st_); __builtin_amdgcn_sched_barrier(0); \
        if (b_ + 1 < nblk_) nsa_loadK(SRC, KEY0(b_ + 1), kf_, lane);     \
        nsa_rest<MODE>(st_, vf_, k0_, LO, HI, O, m, l, INV, r, q, impA, impB); } } } while (0)
constexpr int NSA2_WLDS = 8704;
__device__ __forceinline__ void nsa_attn2(const Ctx& c, const PA& a) {
    const unsigned char* ws = a.ws; const bf16* proj = (const bf16*)(ws + WS_PROJ); bf16* Y = (bf16*)(a.ws + WS_YNSA);
    LAS float* impA = (LAS float*)(c.lds + c.wave * NSA2_WLDS); LAS float* impB = impA + 1024; LAS int* KST = (LAS int*)(impB + 1024);
    const int lane = c.lane, r = lane & 15, q = lane >> 4, tk = r >> 2, hh = r & 3;
    const bool xdeal = (c.G & 7) == 0; const int xg = c.bx & 7, tw = xdeal ? (c.bx >> 3) * 8 + c.wave : c.gw, ntw = xdeal ? (c.G >> 3) * 8 : c.NGW, ntask = xdeal ? T / 8 : T;
    for (int task = tw; task < ntask; task += ntw) { const int tq = xdeal ? 2 * task + (xg >> 2) : task >> 2, g = xdeal ? (xg & 3) : (task & 3), t0 = 4 * tq, tcol = t0 + tk;
        const bf16* prow = proj + (size_t)tcol * LDP;
        bf16x8 qf[2]; { const bf16* qp = prow + PC_NQ + (g * 4 + hh) * 64 + 8 * q; qf[0] = *(const bf16x8*)qp; qf[1] = *(const bf16x8*)(qp + 32); }
        float gt0, gt1, gt2; { const bf16* gp = prow + PC_GATE + (g * 4 + hh) * 3; gt0 = sigm(bf2f(gp[0])); gt1 = sigm(bf2f(gp[1])); gt2 = sigm(bf2f(gp[2])); }
        const int cur = t0 >> 6, ncv = tcol >= 31 ? ((tcol - 31) >> 4) + 1 : 0, ncvmax = t0 + 3 >= 31 ? ((t0 + 3 - 31) >> 4) + 1 : 0;
#pragma unroll
        for (int i = 0; i < 16; ++i) { impA[lane + 64 * i] = 0.f; impB[lane + 64 * i] = 0.f; }
        LDS_WAIT();
        f32x4 yacc[4], O[4];
#pragma unroll
        for (int mt = 0; mt < 4; ++mt) yacc[mt] = (f32x4){0.f, 0.f, 0.f, 0.f};
        if (ncvmax > 0) {
            NsaSrc sc; sc.kf = (const bf16*)(ws + WS_KCMPB) + (size_t)g * 16 * 4096; sc.vf = (const bf16*)(ws + WS_VCMPT) + (size_t)g * 16 * 4096;
            const int nb = (ncvmax + 63) >> 6; float m = -1.0e30f, l = 0.f;
#define K0_CMP(b) (64 * (b))
            NSA_LOOP(0, sc, nb, K0_CMP, 0, ncv - 1, 0.f);
            const float inv = l > 0.f ? 1.f / l : 0.f;
#pragma unroll
            for (int mt = 0; mt < 4; ++mt) O[mt] = (f32x4){0.f, 0.f, 0.f, 0.f};
            NSA_LOOP(2, sc, nb, K0_CMP, 0, ncv - 1, inv);
#pragma unroll
            for (int mt = 0; mt < 4; ++mt) yacc[mt] = O[mt] * gt0;
        }
        LDS_WAIT();
        NsaSrc ss; ss.kf = (const bf16*)(ws + WS_KFS) + (size_t)g * 256 * 4096; ss.vf = (const bf16*)(ws + WS_VFS) + (size_t)g * 256 * 4096;
#pragma unroll 1
        for (int k = 0; k < 4; ++k) {
            float scv[4];
#pragma unroll
            for (int mm = 0; mm < 4; ++mm) { const int j = 4 * lane + mm; float s = -1.0e30f;
                if (j <= cur) { s = impA[k * 256 + j] + (j > 0 ? impB[k * 256 + j - 1] : 0.f); if (j == 0 || j == cur || j == cur - 1) s += 1.0e4f; }
                scv[mm] = s; }
            int nsel = 0;
            for (int itk = 0; itk < 16; ++itk) {
                float lv = scv[0]; int lj = 4 * lane;
                if (scv[1] > lv) { lv = scv[1]; lj = 4 * lane + 1; } if (scv[2] > lv) { lv = scv[2]; lj = 4 * lane + 2; } if (scv[3] > lv) { lv = scv[3]; lj = 4 * lane + 3; }
                const float vmax = wave_max(lv); if (vmax < -5.0e29f) break;
                const int jmin = wave_min_i(lv == vmax ? lj : (1 << 30));
                if (lane == 0) KST[itk] = jmin * 64;
                if ((jmin >> 2) == lane) { const int mm = jmin & 3; if (mm == 0) scv[0] = -3.0e38f; else if (mm == 1) scv[1] = -3.0e38f; else if (mm == 2) scv[2] = -3.0e38f; else scv[3] = -3.0e38f; }
                ++nsel; }
            LDS_WAIT();
            { const bool mine = tk == k; const bf16x8 z8 = (bf16x8){0, 0, 0, 0, 0, 0, 0, 0}; bf16x8 qs[2]; qs[0] = mine ? qf[0] : z8; qs[1] = mine ? qf[1] : z8;
                float m = -1.0e30f, l = 0.f;
#pragma unroll
                for (int mt = 0; mt < 4; ++mt) O[mt] = (f32x4){0.f, 0.f, 0.f, 0.f};
#define K0_SEL(b) (KST[b])
#define qf qs
                NSA_LOOP(1, ss, nsel, K0_SEL, 0, t0 + k, 0.f);
#undef qf
                const float sc = mine ? gt1 / l : 0.f;
#pragma unroll
                for (int mt = 0; mt < 4; ++mt) yacc[mt] += O[mt] * sc; }
            LDS_WAIT();
        }
        { NsaSrc sw; sw.kf = (const bf16*)(ws + WS_KFW) + (size_t)g * 256 * 4096; sw.vf = (const bf16*)(ws + WS_VFW) + (size_t)g * 256 * 4096;
            float m = -1.0e30f, l = 0.f; const int wlo = tcol - 511 > 0 ? tcol - 511 : 0, ulo = t0 - 511 > 0 ? t0 - 511 : 0;
#pragma unroll
            for (int mt = 0; mt < 4; ++mt) O[mt] = (f32x4){0.f, 0.f, 0.f, 0.f};
            const int jb0 = ulo >> 6;
#define K0_WIN(b) (64 * (jb0 + (b)))
            NSA_LOOP(1, sw, cur - jb0 + 1, K0_WIN, wlo, tcol, 0.f);
            const float sc = gt2 / l;
#pragma unroll
            for (int mt = 0; mt < 4; ++mt) yacc[mt] += O[mt] * sc; }
#pragma unroll
        for (int mt = 0; mt < 4; ++mt) { uint2 w; w.x = pg8::cvt_pk_bf16(yacc[mt][0], yacc[mt][1]); w.y = pg8::cvt_pk_bf16(yacc[mt][2], yacc[mt][3]);
            *(uint2*)(Y + (size_t)tcol * 1024 + (g * 4 + hh) * 64 + 16 * mt + 4 * q) = w; }
    }
}
__device__ __forceinline__ void prep_tiles(const Ctx& c, const PA& a) {
    const bf16* proj = (const bf16*)(a.ws + WS_PROJ);
    LAS bf16* tile = (LAS bf16*)(c.lds + c.wave * 8704);
    const int lane = c.lane, r = lane & 15, q = lane >> 4;
    for (int it = c.gw; it < 4 * 4 * 256; it += c.NGW) { const int blk = it & 255, g = (it >> 8) & 3, ten = it >> 10;
        const int scol = (ten == 0 ? PC_KS : (ten == 1 ? PC_VS : (ten == 2 ? PC_KW : PC_VW))) + g * 64;
        const u32x4* sp = (const u32x4*)(proj + (size_t)(blk * 64 + lane) * LDP + scol);
#pragma unroll
        for (int i = 0; i < 8; ++i) { const u32x4 v = sp[i]; LAS unsigned* tp = (LAS unsigned*)(tile + lane * 66 + 8 * i); tp[0] = v.x; tp[1] = v.y; tp[2] = v.z; tp[3] = v.w; }
        LDS_WAIT();
        bf16* dst = (bf16*)(a.ws + (ten == 0 ? WS_KFS : (ten == 1 ? WS_VFS : (ten == 2 ? WS_KFW : WS_VFW)))) + ((size_t)(g * 256 + blk) * 8) * 512 + lane * 8;
        if ((ten & 1) == 0) {
#pragma unroll
            for (int j = 0; j < 4; ++j)
#pragma unroll
                for (int ks = 0; ks < 2; ++ks) { const LAS unsigned* tp = (const LAS unsigned*)(tile + (16 * j + r) * 66 + 32 * ks + 8 * q);
                    *(u32x4*)(dst + (2 * j + ks) * 512) = (u32x4){tp[0], tp[1], tp[2], tp[3]}; }
        } else {
#pragma unroll
            for (int mt = 0; mt < 4; ++mt)
#pragma unroll
                for (int ks = 0; ks < 2; ++ks) { unsigned w[4];
#pragma unroll
                    for (int h = 0; h < 2; ++h)
#pragma unroll
                        for (int i2 = 0; i2 < 2; ++i2) { const int k0 = 32 * ks + 16 * h + 4 * q + 2 * i2;
                            w[2 * h + i2] = (unsigned)tile[k0 * 66 + 16 * mt + r] | ((unsigned)tile[(k0 + 1) * 66 + 16 * mt + r] << 16); }
                    *(u32x4*)(dst + (2 * mt + ks) * 512) = (u32x4){w[0], w[1], w[2], w[3]}; }
        }
        LDS_WAIT();
    }
}

__device__ __forceinline__ void ln_row(f32x4 (&v)[8], const float* gam, const float* bet, int lane) {
    float s = 0.f;
#pragma unroll
    for (int j = 0; j < 8; ++j) s += (v[j][0] + v[j][1]) + (v[j][2] + v[j][3]);
    const float mean = wave_sum(s) * (1.f / D); float s2 = 0.f;
#pragma unroll
    for (int j = 0; j < 8; ++j) { v[j] = v[j] - mean; s2 += (v[j][0] * v[j][0] + v[j][1] * v[j][1]) + (v[j][2] * v[j][2] + v[j][3] * v[j][3]); }
    const float rstd = 1.f / sqrtf(wave_sum(s2) * (1.f / D) + LN_EPS);
#pragma unroll
    for (int j = 0; j < 8; ++j) { const f32x4 g4 = *(const f32x4*)(gam + 4 * (lane + 64 * j)), b4 = *(const f32x4*)(bet + 4 * (lane + 64 * j)); v[j] = v[j] * rstd * g4 + b4; }
}
__device__ __forceinline__ void ph_ln1_route(const Ctx& c, const PA& a, int layer) {
    unsigned char* ws = a.ws; float* X = a.out; uint2* xb = (uint2*)(ws + WS_XB);
    const float* gam = a.in(25) + layer * D; const float* bet = a.in(26) + layer * D;
    const float* wg = a.in(27) + (size_t)layer * D * 4; const float* bg = a.in(28) + layer * 4; const float* we = a.in(29) + (size_t)layer * D * 32; const float* be = a.in(30) + layer * 32;
    int* toke = (int*)(ws + WS_TOKE); float* tokw = (float*)(ws + WS_TOKW); unsigned* cnt = (unsigned*)(ws + WS_CTL) + CW_CNT + layer * 128;
    LAS float* lg = (LAS float*)(c.lds + c.wave * 256);
    const int lane = c.lane;
    for (int t = c.gw; t < T; t += c.NGW) {
        f32x4* row = (f32x4*)(X + (size_t)t * D); f32x4 v[8];
#pragma unroll
        for (int j = 0; j < 8; ++j) v[j] = row[lane + 64 * j];
        ln_row(v, gam, bet, lane);
#pragma unroll
        for (int j = 0; j < 8; ++j) { row[lane + 64 * j] = v[j]; xb[(size_t)t * (D / 4) + lane + 64 * j] = make_uint2(pk2(v[j][0], v[j][1]), pk2(v[j][2], v[j][3])); }
        LAS float* xr = (LAS float*)(c.lds + 4096 + c.wave * 8192);
#pragma unroll
        for (int j = 0; j < 8; ++j) *(LAS f32x4*)(xr + 4 * (lane + 64 * j)) = v[j];
        LDS_WAIT();
        f32x4 ag = (f32x4){0.f, 0.f, 0.f, 0.f}; f32x4 ae[8];
#pragma unroll
        for (int q = 0; q < 8; ++q) ae[q] = (f32x4){0.f, 0.f, 0.f, 0.f};
#pragma unroll 2
        for (int i = 0; i < 32; ++i) { const int d = lane + 64 * i; const float x = xr[d];
            ag += *(const f32x4*)(wg + (size_t)d * 4) * x;
            const f32x4* wp = (const f32x4*)(we + (size_t)d * 32);
#pragma unroll
            for (int e4 = 0; e4 < 8; ++e4) ae[e4] += wp[e4] * x; }
#pragma unroll
        for (int q = 0; q < 4; ++q) ag[q] = wave_sum(ag[q]) + bg[q];
#pragma unroll
        for (int e4 = 0; e4 < 8; ++e4)
#pragma unroll
            for (int q = 0; q < 4; ++q) ae[e4][q] = wave_sum(ae[e4][q]);
        if (lane == 0) {
#pragma unroll
            for (int e4 = 0; e4 < 8; ++e4)
#pragma unroll
                for (int q = 0; q < 4; ++q) lg[e4 * 4 + q] = ae[e4][q] + be[e4 * 4 + q]; }
        LDS_WAIT();
        int grp = 0; float gm = ag[0];
        if (ag[1] > gm) { gm = ag[1]; grp = 1; } if (ag[2] > gm) { gm = ag[2]; grp = 2; } if (ag[3] > gm) { gm = ag[3]; grp = 3; }
        const float gw_ = 1.f / (expf(ag[0] - gm) + expf(ag[1] - gm) + expf(ag[2] - gm) + expf(ag[3] - gm));
        float v0 = -3.0e38f, v1 = -3.0e38f; int i0 = 0, i1 = 0;
        for (int i = 0; i < 8; ++i) { const float x = lg[grp * 8 + i];
            if (x > v0) { v1 = v0; i1 = i0; v0 = x; i0 = i; } else if (x > v1) { v1 = x; i1 = i; } }
        const float e1 = expf(v1 - v0), p0 = 1.f / (1.f + e1), p1 = e1 * p0;
        if (lane == 0) { toke[2 * t] = grp * 8 + i0; toke[2 * t + 1] = grp * 8 + i1; tokw[2 * t] = p0 * gw_; tokw[2 * t + 1] = p1 * gw_;
            __hip_atomic_fetch_add(cnt + grp * 8 + i0, 1u, __ATOMIC_RELAXED, __HIP_MEMORY_SCOPE_AGENT); __hip_atomic_fetch_add(cnt + grp * 8 + i1, 1u, __ATOMIC_RELAXED, __HIP_MEMORY_SCOPE_AGENT); }
        LDS_WAIT();
    }
}
__device__ __forceinline__ void ph_slot(const Ctx& c, const PA& a, int layer) {
    unsigned char* ws = a.ws; unsigned* cnt = (unsigned*)(ws + WS_CTL) + CW_CNT + layer * 128; unsigned* cur = (unsigned*)(ws + WS_CTL) + CW_CUR + layer * 128;
    int* texp = (int*)(ws + WS_TEXP) + layer * 512; const int* toke = (const int*)(ws + WS_TOKE); int* slot = (int*)(ws + WS_SLOT);
    LAS int* pst = (LAS int*)c.lds;
    if (c.tid == 0) { int off = 0, nt = 0;
#pragma unroll 1
        for (int e = 0; e < NEXP; ++e) { const int n = (int)__hip_atomic_load(cnt + e, __ATOMIC_RELAXED, __HIP_MEMORY_SCOPE_AGENT), tl = (n + 255) >> 8;
            pst[e] = off; off += tl * 256;
            if (c.bx == 0) for (int q = 0; q < tl; ++q) texp[nt + q] = e;
            nt += tl; }
        if (c.bx == 0) texp[255] = nt; }
    __syncthreads();
    const u32x4* xb = (const u32x4*)(ws + WS_XB); u32x4* xs = (u32x4*)(ws + WS_XS);
    for (int as = c.gw; as < 2 * T; as += c.NGW) { const int t = as >> 1, e = toke[as]; int s = 0;
        if (c.lane == 0) s = pst[e] + (int)__hip_atomic_fetch_add(cur + e, 1u, __ATOMIC_RELAXED, __HIP_MEMORY_SCOPE_AGENT);
        s = __shfl(s, 0);
        if (c.lane == 0) slot[as] = s;
#pragma unroll
        for (int j = 0; j < 4; ++j) xs[(size_t)s * 256 + c.lane + 64 * j] = xb[(size_t)t * 256 + c.lane + 64 * j]; }
}
__device__ __forceinline__ void ph_ln2(const Ctx& c, const PA& a, int layer) {
    unsigned char* ws = a.ws; float* X = a.out; uint2* xb = (uint2*)(ws + WS_XB); const uint2* ys = (const uint2*)(ws + WS_YS);
    const float* gam = a.in(34) + layer * D; const float* bet = a.in(35) + layer * D; const int* slot = (const int*)(ws + WS_SLOT); const float* tokw = (const float*)(ws + WS_TOKW);
    const int lane = c.lane;
    for (int t = c.gw; t < T; t += c.NGW) {
        const int s0 = slot[2 * t], s1 = slot[2 * t + 1]; const float w0 = tokw[2 * t], w1 = tokw[2 * t + 1];
        f32x4* row = (f32x4*)(X + (size_t)t * D); f32x4 v[8];
#pragma unroll
        for (int j = 0; j < 8; ++j) { const uint2 y0 = ys[(size_t)s0 * 512 + lane + 64 * j], y1 = ys[(size_t)s1 * 512 + lane + 64 * j]; const f32x4 x = row[lane + 64 * j];
            v[j][0] = x[0] * DN_ALPHA + w0 * bflo(y0.x) + w1 * bflo(y1.x); v[j][1] = x[1] * DN_ALPHA + w0 * bfhi(y0.x) + w1 * bfhi(y1.x);
            v[j][2] = x[2] * DN_ALPHA + w0 * bflo(y0.y) + w1 * bflo(y1.y); v[j][3] = x[3] * DN_ALPHA + w0 * bfhi(y0.y) + w1 * bfhi(y1.y); }
        ln_row(v, gam, bet, lane);
#pragma unroll
        for (int j = 0; j < 8; ++j) { row[lane + 64 * j] = v[j]; xb[(size_t)t * (D / 4) + lane + 64 * j] = make_uint2(pk2(v[j][0], v[j][1]), pk2(v[j][2], v[j][3])); }
    }
}

enum { PH_CONV = 0, PH_INPROJ, PH_PREP, PH_SCAN1, PH_SCAN2, PH_SCAN3, PH_GATES, PH_BRANCH, PH_OUT, PH_LN1, PH_SLOT, PH_MOE_GU, PH_MOE_DN, PH_LN2, NPH_L };
constexpr int NPH = NPH_L * DEPTH;

__device__ __forceinline__ Ctx mkctx(LAS unsigned char* lds, int wv) {
    int ln; asm volatile("v_mbcnt_lo_u32_b32 %0, -1, 0\n\tv_mbcnt_hi_u32_b32 %0, -1, %0" : "=v"(ln));
    int tid = wv * 64 + ln, bx = blockIdx.x, G = gridDim.x;
    asm volatile("" : "+s"(bx)); asm volatile("" : "+s"(G));
    Ctx c; c.lds = lds; c.tid = tid; c.lane = tid & 63; c.wave = __builtin_amdgcn_readfirstlane(tid >> 6); c.G = G; c.bx = bx; c.gw = bx * 8 + c.wave; c.NGW = G * 8; return c;
}
__global__ void __launch_bounds__(512, 2) fwd(Args args0) {
    extern __shared__ __attribute__((aligned(16))) unsigned char lds_raw[];
    LAS unsigned char* const lds0 = (LAS unsigned char*)lds_raw;
    const int lo = args0.ph_lo, hi = args0.ph_hi;
    const int wv0 = __builtin_amdgcn_readfirstlane(threadIdx.x >> 6);
    if (threadIdx.x < 36) ((LAS unsigned long long*)(lds0 + LDS_PTAB))[threadIdx.x] = (unsigned long long)args0.in[threadIdx.x];
    __syncthreads();
#if MK_ONE_LAUNCH
    volatile LAS unsigned* barw = (volatile LAS unsigned*)(lds0 + LDS_BARW);
    if (threadIdx.x == 0) { barw[0] = 0u; barw[1] = 0u; barw[2] = 0u; barw[3] = 0u; }
    __syncthreads();
    XcdBarrier bar = xcd_barrier_post((unsigned*)(args0.ws + WS_CTL) + CW_BAR, barw);
#define SEAM(p) do { if ((p) + 1 < hi) xcd_barrier(bar); } while (0)
#else
#define SEAM(p) do { } while (0)
#endif
#ifndef ONLY_PHASE
#define ONLY_PHASE -1
#endif
#define PHASE_BEGIN PA args; { unsigned long long w_ = (unsigned long long)args0.ws; asm volatile("" : "+s"(w_)); args.ws = (unsigned char*)(GAS unsigned char*)w_; unsigned long long o_ = (unsigned long long)args0.out; asm volatile("" : "+s"(o_)); args.out = (float*)(GAS float*)o_; args.tab = (const LAS unsigned*)(lds0 + LDS_PTAB); } unsigned char* const ws = args.ws; const Ctx c = mkctx(lds0, wv0); (void)ws; (void)c;
#define TASK_CTX() mkctx(lds0, wv0)
#define IN(p) ((ONLY_PHASE < 0 || ONLY_PHASE == ((p) - pb)) && lo <= (p) && (p) < hi)
    for (int layer = 0; layer < DEPTH; ++layer) {
        const int pb = layer * NPH_L;
        if (IN(pb + PH_CONV)) { PHASE_BEGIN ph_conv(c, args, layer); __syncthreads(); SEAM(pb + PH_CONV); }
        if (IN(pb + PH_INPROJ)) { PHASE_BEGIN
            Gemm g{D, D, D}; SchedPlain S; S.to.init(T / 256, LDP / 256); S.G = c.G; S.c = c.bx; S.tid = c.tid; S.A = (const char*)(ws + WS_XB); S.B = (const char*)(ws + WS_WIN); S.ta = (size_t)256 * D * 2; S.tb = (size_t)256 * D * 2;
            EpiStore<0> E{(bf16*)(ws + WS_PROJ), LDP};
            pg8::gemm_phase<EpiStore<0>, SchedPlain, PG8_ALIGN, PG8_SP2>(c.lds, g, S, E);
#ifdef REP_GEMM
            pg8::gemm_phase<EpiStore<0>, SchedPlain, PG8_ALIGN, PG8_SP2>(c.lds, g, S, E);
#endif
            SEAM(pb + PH_INPROJ); }
        if (IN(pb + PH_PREP)) { PHASE_BEGIN prep_rwkv(c, args, layer); __syncthreads();
#if defined(REP_RW) || defined(REP_PREP)
            prep_rwkv(TASK_CTX(), args, layer); __syncthreads();
#endif
 prep_cmp(TASK_CTX(), args, layer); prep_rope(TASK_CTX(), args); prep_tiles(TASK_CTX(), args); __syncthreads(); prep_ret_frags(TASK_CTX(), args); __syncthreads(); SEAM(pb + PH_PREP); }
        if (IN(pb + PH_SCAN1)) { PHASE_BEGIN rw_pass1(c, args);
#if defined(REP_RW) || defined(REP_P1)
            rw_pass1(TASK_CTX(), args);
#endif
 ret_kv(TASK_CTX(), args); __syncthreads();
#ifdef REP_RET
            ret_kv(TASK_CTX(), args); __syncthreads();
#endif
 nsa_attn2(TASK_CTX(), args); __syncthreads();
 SEAM(pb + PH_SCAN1); }
        if (IN(pb + PH_SCAN2)) { PHASE_BEGIN rw_pass2(c, args);
#if defined(REP_RW) || defined(REP_P2)
            rw_pass2(TASK_CTX(), args);
#endif
 ret_prefix(TASK_CTX(), args); __syncthreads(); SEAM(pb + PH_SCAN2); }
        if (IN(pb + PH_SCAN3)) { PHASE_BEGIN rw_pass3(c, args, layer); __syncthreads();
#if defined(REP_RW) || defined(REP_P3)
            rw_pass3(TASK_CTX(), args, layer); __syncthreads();
#endif
 ret_out(TASK_CTX(), args); __syncthreads();
#ifdef REP_RET
            ret_out(TASK_CTX(), args); __syncthreads();
#endif
 SEAM(pb + PH_SCAN3); }
        if (IN(pb + PH_GATES)) { PHASE_BEGIN
            Gemm g{D, D, D}; SchedPlain S; S.to.init(T / 256, NG / 256); S.G = c.G; S.c = c.bx; S.tid = c.tid; S.A = (const char*)(ws + WS_XB); S.B = (const char*)(ws + WS_WG); S.ta = (size_t)256 * D * 2; S.tb = (size_t)256 * D * 2;
            EpiStore<1> E{(bf16*)(ws + WS_GATES), NG};
            pg8::gemm_phase<EpiStore<1>, SchedPlain, PG8_ALIGN, PG8_SP2>(c.lds, g, S, E);
#ifdef REP_GEMM
            pg8::gemm_phase<EpiStore<1>, SchedPlain, PG8_ALIGN, PG8_SP2>(c.lds, g, S, E);
#endif
            SEAM(pb + PH_GATES); }
        if (IN(pb + PH_BRANCH)) { PHASE_BEGIN
            Gemm g{RWW, RWW, RWW}; SchedBranch S; S.to.init(T / 256, D / 256); S.G = c.G; S.c = c.bx; S.tid = c.tid;
            S.A0 = (const char*)(ws + WS_YRW); S.sa = WS_YNSA - WS_YRW; static_assert(WS_YRET - WS_YNSA == WS_YNSA - WS_YRW, "y buffers equally spaced");
            S.B0 = (const char*)(ws + WS_WBR); S.sb = (size_t)D * RWW * 2; S.ta = (size_t)256 * RWW * 2; S.tb = (size_t)256 * RWW * 2;
            EpiBranch E{(bf16*)(ws + WS_MERGED), (const bf16*)(ws + WS_GATES)};
            pg8::gemm_phase<EpiBranch, SchedBranch, PG8_ALIGN, PG8_SP2>(c.lds, g, S, E);
            SEAM(pb + PH_BRANCH); }
        if (IN(pb + PH_OUT)) { PHASE_BEGIN
            Gemm g{D, D, D}; SchedPlain S; S.to.init(T / 256, D / 256); S.G = c.G; S.c = c.bx; S.tid = c.tid; S.A = (const char*)(ws + WS_MERGED); S.B = (const char*)(ws + WS_WOUT); S.ta = (size_t)256 * D * 2; S.tb = (size_t)256 * D * 2;
            EpiResid E{args.out};
            pg8::gemm_phase<EpiResid, SchedPlain, PG8_ALIGN, PG8_SP2>(c.lds, g, S, E);
            SEAM(pb + PH_OUT); }
        if (IN(pb + PH_LN1)) { PHASE_BEGIN ph_ln1_route(c, args, layer); __syncthreads(); ph_conv_moe(TASK_CTX(), args, layer); __syncthreads(); SEAM(pb + PH_LN1); }
        if (IN(pb + PH_SLOT)) { PHASE_BEGIN ph_slot(c, args, layer); __syncthreads(); SEAM(pb + PH_SLOT); }
        if (IN(pb + PH_MOE_GU)) { PHASE_BEGIN
            const int* texp = (const int*)(ws + WS_TEXP) + layer * 512;
            Gemm g{D, D, D}; SchedMoe S; S.nM = texp[255]; S.nN = 4; S.G = c.G; S.c = c.bx; S.tid = c.tid; S.A = (const char*)(ws + WS_XS); S.B = (const char*)(ws + WS_WGU); S.ta = (size_t)256 * D * 2; S.tb = (size_t)256 * D * 2; S.te = (size_t)1024 * D * 2; S.texp = texp;
            EpiGateUp E{(bf16*)(ws + WS_H)};
            pg8::gemm_phase<EpiGateUp, SchedMoe, PG8_ALIGN, PG8_SP2>(c.lds, g, S, E);
#ifdef REP_GEMM
            pg8::gemm_phase<EpiGateUp, SchedMoe, PG8_ALIGN, PG8_SP2>(c.lds, g, S, E);
#endif
            SEAM(pb + PH_MOE_GU); }
        if (IN(pb + PH_MOE_DN)) { PHASE_BEGIN
            const int* texp = (const int*)(ws + WS_TEXP) + layer * 512;
            Gemm g{FF, FF, FF}; SchedMoe S; S.nM = texp[255]; S.nN = 8; S.G = c.G; S.c = c.bx; S.tid = c.tid; S.A = (const char*)(ws + WS_H); S.B = (const char*)(ws + WS_WDN); S.ta = (size_t)256 * FF * 2; S.tb = (size_t)256 * FF * 2; S.te = (size_t)D * FF * 2; S.texp = texp;
            EpiStore<0> E{(bf16*)(ws + WS_YS), D};
            pg8::gemm_phase<EpiStore<0>, SchedMoe, PG8_ALIGN, PG8_SP2>(c.lds, g, S, E);
#ifdef REP_GEMM
            pg8::gemm_phase<EpiStore<0>, SchedMoe, PG8_ALIGN, PG8_SP2>(c.lds, g, S, E);
#endif
            SEAM(pb + PH_MOE_DN); }
        if (IN(pb + PH_LN2)) { PHASE_BEGIN ph_ln2(c, args, layer); __syncthreads(); SEAM(pb + PH_LN2); }
    }
#undef IN
#undef SEAM
}

#ifndef TRUNC_PH
#define TRUNC_PH NPH
#endif
#ifndef DUMP_MODE
#define DUMP_MODE 0
#endif
#if DUMP_MODE
__global__ void dump_k(float* out, const unsigned char* ws) {
    for (size_t i = (size_t)blockIdx.x * blockDim.x + threadIdx.x; i < (size_t)T * D; i += (size_t)gridDim.x * blockDim.x) {
        const int t = (int)(i / D), c = (int)(i % D); float v = 0.f;
#if DUMP_MODE == 1
        v = bf2f(((const bf16*)(ws + WS_PROJ))[(size_t)t * LDP + c * 5]);
#elif DUMP_MODE == 2
        if (c < 1024) v = bf2f(((const bf16*)(ws + WS_YRW))[(size_t)t * 1024 + c]); else v = bf2f(((const bf16*)(ws + WS_YNSA))[(size_t)t * 1024 + c - 1024]);
#elif DUMP_MODE == 3
        if (c < 1024) v = bf2f(((const bf16*)(ws + WS_YRET))[(size_t)t * 1024 + c]); else v = bf2f(((const bf16*)(ws + WS_MERGED))[(size_t)t * D + c]);
#elif DUMP_MODE == 4
        if (c < 1024) v = bf2f(((const bf16*)(ws + WS_YRET))[(size_t)t * 1024 + c]);
#elif DUMP_MODE == 5
        v = bf2f(((const bf16*)(ws + WS_GATES))[(size_t)t * NG + c * 3]);
#endif
        out[i] = (v == v && fabsf(v) < 1e30f) ? v : 0.f; }
}
#endif
extern "C" void kernel_launch(void* const* d_in, const int* in_sizes, int n_in, void* d_out, int out_size, void* d_ws, size_t ws_size, hipStream_t stream) {
    static int grid = 0;
    if (grid == 0) {
        if (n_in != 36 || out_size != T * D || ws_size < WS_END) { fprintf(stderr, "kernel_launch: unexpected shapes (n_in %d out %d ws %zu)\n", n_in, out_size, ws_size); grid = -1; return; }
        int dev = 0, cus = 0, per_cu = 0;
        if (hipGetDevice(&dev) != hipSuccess || hipDeviceGetAttribute(&cus, hipDeviceAttributeMultiprocessorCount, dev) != hipSuccess) { grid = -1; return; }
        if (hipFuncSetAttribute((const void*)fwd, hipFuncAttributeMaxDynamicSharedMemorySize, LDS_BYTES) != hipSuccess) { fprintf(stderr, "kernel_launch: hipFuncSetAttribute failed\n"); grid = -1; return; }
        if (hipOccupancyMaxActiveBlocksPerMultiprocessor(&per_cu, (const void*)fwd, 512, LDS_BYTES) != hipSuccess || per_cu < 1) fprintf(stderr, "kernel_launch: occupancy query says %d\n", per_cu);
        (void)hipGetLastError();
        grid = cus;
    }
    if (grid < 0) return;
    if (hipMemsetAsync((char*)d_ws + WS_CTL, 0, CTL_ZERO_BYTES, stream) != hipSuccess) return;
    Args a{};
    for (int i = 0; i < 36; ++i) a.in[i] = (const float*)d_in[i];
    a.out = (float*)d_out; a.ws = (unsigned char*)d_ws;
#if MK_ONE_LAUNCH
    a.ph_lo = 0; a.ph_hi = NPH;
    hipLaunchKernelGGL(fwd, dim3(grid), dim3(512), LDS_BYTES, stream, a);
#else
    for (int p = 0; p < TRUNC_PH; ++p) { a.ph_lo = p; a.ph_hi = p + 1; hipLaunchKernelGGL(fwd, dim3(grid), dim3(512), LDS_BYTES, stream, a); }
#if DUMP_MODE
    dump_k<<<2048, 256, 0, stream>>>((float*)d_out, (const unsigned char*)d_ws);
#endif
#endif
}
```

```cpp
#define MK_ONE_LAUNCH 1
#include <hip/hip_runtime.h>
#include <cstdio>
#include <cstdint>

#ifndef MK_ONE_LAUNCH
#define MK_ONE_LAUNCH 0
#endif

namespace pg8 {
#define PG8_LAS __attribute__((address_space(3)))
typedef unsigned short bf16_t;
typedef short bf16x8 __attribute__((ext_vector_type(8)));
typedef float f32x4 __attribute__((ext_vector_type(4)));
typedef unsigned u32x4 __attribute__((ext_vector_type(4)));
constexpr int BM = 256, BK = 64, HALF = 128, HTB = HALF * BK * 2  , STAGE_BYTES = 8 * HTB, NXCD = 8, WGM = 8;

__host__ __device__ __forceinline__ int lds_byte(int r, int c) { const int st = (r >> 4) * 2 + (c >> 5), rr = r & 15, cc = c & 31, ob = rr * 64 + cc * 2; return st * 1024 + (ob ^ (((ob >> 9) & 1) << 5)); }
__host__ __device__ __forceinline__ void stage_rc(int b, int& R, int& C) { const int st = b / 1024, sb = b % 1024, swz = sb ^ (((sb >> 9) & 1) << 5); R = (st >> 1) * 16 + swz / 64; C = (st & 1) * 32 + (swz % 64) / 2; }
__host__ __device__ __forceinline__ int perm32(int rho) { const int n = rho >> 4, i = rho & 15; return 8 * (i >> 2) + 4 * n + (i & 3); }

struct Unit { int pm, pn, aux; const char* a; const char* b; };
struct Gemm { int K, lda, ldb; };

struct TileOrder {
    int nM, nN, nwg;
    __device__ void init(int nM_, int nN_) { nM = nM_; nN = nN_; nwg = nM * nN; }
    __device__ bool tile(long L, int& pm, int& pn) const {
        if (L >= nwg) return false;
        int wgid = (int)L; { const int q = nwg / NXCD, r = nwg % NXCD, xcd = wgid % NXCD, off = wgid / NXCD; wgid = (xcd < r ? xcd * (q + 1) : r * (q + 1) + (xcd - r) * q) + off; }
        const int nig = WGM * nN, gid = wgid / nig, fm = gid * WGM, gsz = (nM - fm) < WGM ? (nM - fm) : WGM;
        pm = fm + ((wgid % nig) % gsz); pn = (wgid % nig) / gsz; return true;
    }
};

typedef float f32x2_t __attribute__((ext_vector_type(2))); typedef __bf16 bf16x2_t __attribute__((ext_vector_type(2)));
__device__ __forceinline__ unsigned cvt_pk_bf16(float lo, float hi) { f32x2_t v = {lo, hi}; bf16x2_t b = __builtin_convertvector(v, bf16x2_t); return __builtin_bit_cast(unsigned, b); }

template <class Epi, class Sched, bool ALIGN_EPI = false, bool SP2 = false>
__device__ __forceinline__ void gemm_phase(PG8_LAS unsigned char* lds, const Gemm g, const Sched& S, const Epi& E) {
    const int tid = S.tid, wid = __builtin_amdgcn_readfirstlane(tid >> 6), lane = tid & 63, wr = wid >> 2, wc = wid & 3, fr = lane & 15, fq = lane >> 4;
    const int K = g.K, nt = K / BK;
    unsigned voffA[2], voffB[2];
#pragma unroll
    for (int i = 0; i < 2; ++i) { int R, C; stage_rc(tid * 16 + i * 8192, R, C); const int Rb = Epi::PERM ? ((R & ~31) + perm32(R & 31)) : R;
        voffA[i] = (unsigned)(R * g.lda + C) * 2u; voffB[i] = (unsigned)(Rb * g.ldb + C) * 2u; }
    const size_t kstep = (size_t)(BK * 2);
    const size_t hstepA = (size_t)HALF * g.lda * 2, hstepB = (size_t)HALF * g.ldb * 2;
    const unsigned ldsw = (unsigned)wid * 1024u;
    const int aoff = lds_byte(wr * 64 + fr, fq * 8), boff = lds_byte(wc * 32 + fr, fq * 8);
#define PG8_SA(b, h) (((b) * 2 + (h)) * HTB)
#define PG8_SB(b, h) ((4 + (b) * 2 + (h)) * HTB)
#define PG8_STAGE(bufoff, gbase, voff) do { _Pragma("unroll") for (int _i = 0; _i < 2; ++_i) \
        __builtin_amdgcn_global_load_lds((const unsigned*)((const char*)(gbase) + (voff)[_i]), (PG8_LAS unsigned*)(lds + (bufoff) + ldsw + _i * 8192), 16, 0, 0); } while (0)
#define PG8_LDA(dst, b, h) do { _Pragma("unroll") for (int m = 0; m < 4; ++m) _Pragma("unroll") for (int k = 0; k < 2; ++k) dst[m][k] = *(const PG8_LAS bf16x8*)(lds + PG8_SA(b, h) + aoff + m * 2048 + k * 1024); } while (0)
#define PG8_LDB(dst, b, h) do { _Pragma("unroll") for (int n = 0; n < 2; ++n) _Pragma("unroll") for (int k = 0; k < 2; ++k) dst[n][k] = *(const PG8_LAS bf16x8*)(lds + PG8_SB(b, h) + boff + n * 2048 + k * 1024); } while (0)
#define PG8_MMA(ai, bj, At, Bt) do { __builtin_amdgcn_s_setprio(1); _Pragma("unroll") for (int m = 0; m < 4; ++m) _Pragma("unroll") for (int n = 0; n < 2; ++n) _Pragma("unroll") for (int k = 0; k < 2; ++k) \
        acc[ai][bj][m][n] = __builtin_amdgcn_mfma_f32_16x16x32_bf16(Bt[n][k], At[m][k], acc[ai][bj][m][n], 0, 0, 0); __builtin_amdgcn_s_setprio(0); } while (0)
#define PG8_WAIT_V(n) asm volatile("s_waitcnt vmcnt(" #n ")" ::: "memory")
#define PG8_WAIT_L(n) asm volatile("s_waitcnt lgkmcnt(" #n ")" ::: "memory")
#define PG8_BAR __builtin_amdgcn_s_barrier()
#define PG8_SCHED __builtin_amdgcn_sched_barrier(0)
    Unit cur, nxt; int ui = 0;
    if (!S.next(0, cur)) return;
    f32x4 acc[2][2][4][2];
#pragma unroll
    for (int a = 0; a < 2; ++a)
#pragma unroll
        for (int b = 0; b < 2; ++b)
#pragma unroll
            for (int m = 0; m < 4; ++m)
#pragma unroll
                for (int n = 0; n < 2; ++n) acc[a][b][m][n] = (f32x4){0.f, 0.f, 0.f, 0.f};
    bf16x8 At[4][2], B0[2][2], B1[2][2];
    const char* cA = cur.a; const char* cB = cur.b;
    if constexpr (SP2) {
        PG8_STAGE(PG8_SB(0, 0), cB, voffB); PG8_STAGE(PG8_SB(0, 1), cB + hstepB, voffB); PG8_STAGE(PG8_SA(0, 0), cA, voffA); PG8_STAGE(PG8_SA(0, 1), cA + hstepA, voffA);
        if (wr == 1) PG8_BAR;
        PG8_WAIT_V(2); PG8_BAR;
        PG8_STAGE(PG8_SB(1, 0), cB + kstep, voffB); PG8_STAGE(PG8_SA(1, 0), cA + kstep, voffA); PG8_STAGE(PG8_SB(1, 1), cB + hstepB + kstep, voffB);
        PG8_WAIT_V(6); PG8_BAR;
    } else {
        PG8_STAGE(PG8_SB(0, 0), cB, voffB); PG8_STAGE(PG8_SA(0, 0), cA, voffA); PG8_STAGE(PG8_SB(0, 1), cB + hstepB, voffB); PG8_STAGE(PG8_SA(0, 1), cA + hstepA, voffA);
        if (wr == 1) PG8_BAR;
        PG8_WAIT_V(4); PG8_BAR;
        PG8_STAGE(PG8_SB(1, 0), cB + kstep, voffB); PG8_STAGE(PG8_SA(1, 0), cA + kstep, voffA); PG8_STAGE(PG8_SB(1, 1), cB + hstepB + kstep, voffB);
        PG8_WAIT_V(6); PG8_BAR;
    }
    for (;;) {
        const bool has_next = S.next(ui + 1, nxt);
        const char* nA = has_next ? nxt.a : cA; const char* nB = has_next ? nxt.b : cB;
        for (int t = 0; t < nt; t += 2) {
            const bool last = (t == nt - 2);
            const char* a1 = cA + (size_t)(t + 1) * kstep;
            const char* a2 = last ? nA : cA + (size_t)(t + 2) * kstep; const char* b2 = last ? nB : cB + (size_t)(t + 2) * kstep;
            const char* a3 = a2 + kstep; const char* b3 = b2 + kstep;
            if constexpr (SP2) {
            PG8_LDB(B0, 0, 0); PG8_LDB(B1, 0, 1); PG8_SCHED; PG8_LDA(At, 0, 0); PG8_STAGE(PG8_SA(1, 1), a1 + hstepA, voffA);
            PG8_WAIT_V(8); PG8_WAIT_L(0); PG8_BAR; PG8_MMA(0, 0, At, B0); PG8_MMA(0, 1, At, B1); PG8_BAR; PG8_SCHED;
            PG8_LDA(At, 0, 1); PG8_STAGE(PG8_SB(0, 0), b2, voffB); PG8_STAGE(PG8_SB(0, 1), b2 + hstepB, voffB); PG8_STAGE(PG8_SA(0, 0), a2, voffA);
            PG8_WAIT_V(8); PG8_WAIT_L(0); PG8_BAR; PG8_MMA(1, 0, At, B0); PG8_MMA(1, 1, At, B1); PG8_BAR; PG8_SCHED;
            PG8_LDB(B0, 1, 0); PG8_LDB(B1, 1, 1); PG8_SCHED; PG8_LDA(At, 1, 0); PG8_STAGE(PG8_SA(0, 1), a2 + hstepA, voffA);
            PG8_WAIT_V(8); PG8_WAIT_L(0); PG8_BAR; PG8_MMA(0, 0, At, B0); PG8_MMA(0, 1, At, B1); PG8_BAR; PG8_SCHED;
            PG8_LDA(At, 1, 1); PG8_STAGE(PG8_SB(1, 0), b3, voffB); PG8_STAGE(PG8_SB(1, 1), b3 + hstepB, voffB); PG8_STAGE(PG8_SA(1, 0), a3, voffA);
            PG8_WAIT_V(8); PG8_WAIT_L(0); PG8_BAR; PG8_MMA(1, 0, At, B0); PG8_MMA(1, 1, At, B1); PG8_BAR; PG8_SCHED;
            } else {
            PG8_LDB(B0, 0, 0); PG8_SCHED; PG8_LDA(At, 0, 0); PG8_STAGE(PG8_SA(1, 1), a1 + hstepA, voffA);
            PG8_WAIT_L(8); PG8_BAR; PG8_WAIT_L(0); PG8_MMA(0, 0, At, B0); PG8_BAR; PG8_SCHED;
            PG8_LDB(B1, 0, 1); PG8_STAGE(PG8_SB(0, 0), b2, voffB);
            PG8_BAR; PG8_WAIT_L(0); PG8_MMA(0, 1, At, B1); PG8_BAR;
            PG8_LDA(At, 0, 1); PG8_STAGE(PG8_SA(0, 0), a2, voffA);
            PG8_BAR; PG8_WAIT_L(0); PG8_MMA(1, 0, At, B0); PG8_BAR; PG8_SCHED;
            PG8_STAGE(PG8_SB(0, 1), b2 + hstepB, voffB);
            PG8_WAIT_V(6); PG8_BAR; PG8_MMA(1, 1, At, B1); PG8_BAR;
            PG8_LDB(B0, 1, 0); PG8_SCHED; PG8_LDA(At, 1, 0); PG8_STAGE(PG8_SA(0, 1), a2 + hstepA, voffA);
            PG8_WAIT_L(8); PG8_BAR; PG8_WAIT_L(0); PG8_MMA(0, 0, At, B0); PG8_BAR; PG8_SCHED;
            PG8_LDB(B1, 1, 1); PG8_STAGE(PG8_SB(1, 0), b3, voffB);
            PG8_BAR; PG8_WAIT_L(0); PG8_MMA(0, 1, At, B1); PG8_BAR;
            PG8_LDA(At, 1, 1); PG8_STAGE(PG8_SA(1, 0), a3, voffA);
            PG8_BAR; PG8_WAIT_L(0); PG8_MMA(1, 0, At, B0); PG8_BAR; PG8_SCHED;
            PG8_STAGE(PG8_SB(1, 1), b3 + hstepB, voffB);
            PG8_WAIT_V(6); PG8_BAR; PG8_MMA(1, 1, At, B1); PG8_BAR;
            }
        }
        if constexpr (ALIGN_EPI) { if (wr == 0) PG8_BAR; }
        if constexpr (Epi::CHAIN) E.chain(acc, cur, wr, wc, fr, fq);
        else E(acc, cur, wr, wc, fr, fq);
        if (!has_next) break;
        if constexpr (!Epi::CHAIN)
#pragma unroll
        for (int a = 0; a < 2; ++a)
#pragma unroll
            for (int b = 0; b < 2; ++b)
#pragma unroll
                for (int m = 0; m < 4; ++m)
#pragma unroll
                    for (int n = 0; n < 2; ++n) acc[a][b][m][n] = (f32x4){0.f, 0.f, 0.f, 0.f};
        cur = nxt; cA = nA; cB = nB; ++ui;
        if constexpr (ALIGN_EPI) { if (wr == 1) PG8_BAR; }
    }
    PG8_WAIT_V(0);
    if constexpr (!ALIGN_EPI) { if (wr == 0) PG8_BAR; }
    PG8_BAR;
    #undef PG8_SA
#undef PG8_SB
#undef PG8_STAGE
#undef PG8_LDA
#undef PG8_LDB
#undef PG8_MMA
#undef PG8_WAIT_V
#undef PG8_WAIT_L
#undef PG8_BAR
#undef PG8_SCHED
}
}

#ifndef PG8_SP2
#define PG8_SP2 true
#endif
#ifndef PG8_ALIGN
#define PG8_ALIGN true
#endif

constexpr int T = 16384, D = 2048, DEPTH = 2;
constexpr int RWW = 1024;
constexpr int NCMP = 1023, NSELB = 256;
constexpr int NEXP = 32, FF = 512;
constexpr int LDP = 10496;
constexpr int NG = 6144;
constexpr int PC_RW_R = 0, PC_RW_K = 1024, PC_RW_V = 2048, PC_NQ = 3072, PC_KC = 4096, PC_VC = 4352, PC_KS = 4608, PC_VS = 4864, PC_KW = 5120, PC_VW = 5376,
              PC_RQ = 5632, PC_RK = 6656, PC_RV = 7680, PC_RG = 8704, PC_XW = 9728, PC_XA = 9824, PC_XG = 9920, PC_XV = 10176, PC_GATE = 10240;
constexpr float DN_ALPHA = 1.41421356237f, LN_EPS = 1e-5f;

constexpr size_t MiB = 1u << 20;
constexpr size_t WS_CTL = 0, CTL_ZERO_BYTES = 1 * MiB;
constexpr size_t WS_TEXP = 1 * MiB, WS_TOKE = WS_TEXP + 65536, WS_TOKW = WS_TOKE + 131072, WS_SLOT = WS_TOKW + 131072;
constexpr size_t WS_KCMPB = 2 * MiB, WS_VCMPT = 3 * MiB, WS_KF8 = 4 * MiB  , WS_COS = 8 * MiB, WS_SIN = 12 * MiB;
constexpr size_t WS_WIN = 16 * MiB, WS_WG = 57 * MiB, WS_WBR = 81 * MiB, WS_WOUT = 93 * MiB;
constexpr size_t WS_W1T = 103 * MiB, WS_WLORA = 101 * MiB, WS_ALORA = 896 * MiB;
constexpr size_t WS_XB = 112 * MiB, WS_VF = 176 * MiB, WS_PROJ = 208 * MiB;
constexpr size_t WS_RW_R = 536 * MiB, WS_RW_K = 568 * MiB, WS_RW_V = 600 * MiB, WS_RW_KK = 632 * MiB, WS_RW_B = 664 * MiB, WS_RW_W = 696 * MiB, WS_RW_G = 760 * MiB;
constexpr size_t WS_YRW = 800 * MiB, WS_YNSA = 832 * MiB, WS_YRET = 864 * MiB;
constexpr size_t WS_RWP = 896 * MiB, WS_RWU = 912 * MiB, WS_RWS = 928 * MiB, WS_RETKV = 944 * MiB, WS_KFS = 1008 * MiB, WS_VFS = 1016 * MiB, WS_KFW = 1024 * MiB, WS_VFW = 1032 * MiB, WS_VFR = 1040 * MiB, WS_KTR = 1072 * MiB, WS_RT = 1104 * MiB, WS_VF8 = 1136 * MiB  , WS_GPART = 1140 * MiB  , WS_VW8 = 1152 * MiB  , WS_VC8 = 1156 * MiB  , WS_END = 1157 * MiB;
constexpr size_t WS_GATES = 536 * MiB, WS_MERGED = 728 * MiB;
constexpr size_t WS_WGU = 208 * MiB, WS_WDN = 336 * MiB, WS_XS = 400 * MiB, WS_H = 560 * MiB, WS_YS = 600 * MiB;
static_assert(WS_PROJ + (size_t)T * LDP * 2 <= WS_RW_R && WS_GATES + (size_t)T * NG * 2 <= WS_MERGED && WS_MERGED + (size_t)T * D * 2 <= WS_YRW, "ws map");
static_assert(WS_XS + (size_t)160 * 256 * D * 2 <= WS_H && WS_H + (size_t)160 * 256 * FF * 2 <= WS_YS && WS_YS + (size_t)160 * 256 * D * 2 <= WS_RW_G, "ws map moe");
constexpr int CW_TMO = 0, CW_CNT = 1024, CW_CUR = 1088, CW_BAR = 4096, CW_NSAQ = 16384, CW_KMAX = 20480;
constexpr int LDS_BYTES = 147456, LDS_BARW = LDS_BYTES - 64;

#define GAS __attribute__((address_space(1)))
#define LAS __attribute__((address_space(3)))
typedef unsigned short bf16;
typedef float f32x4 __attribute__((ext_vector_type(4)));
typedef unsigned u32x4 __attribute__((ext_vector_type(4)));
typedef short bf16x8 __attribute__((ext_vector_type(8)));
typedef short bf16x4 __attribute__((ext_vector_type(4)));
#define LDS_WAIT() asm volatile("s_waitcnt lgkmcnt(0)" ::: "memory")
#define VM_WAIT() asm volatile("s_waitcnt vmcnt(0)" ::: "memory")

__device__ __forceinline__ float bf2f(unsigned short b) { return __uint_as_float(((unsigned)b) << 16); }
__device__ __forceinline__ unsigned f2bf(float f) { unsigned u = __float_as_uint(f); return (u + 0x7fffu + ((u >> 16) & 1u)) >> 16; }
__device__ __forceinline__ unsigned pk2(float lo, float hi) { return f2bf(lo) | (f2bf(hi) << 16); }
__device__ __forceinline__ float bflo(unsigned w) { return __uint_as_float(w << 16); }
__device__ __forceinline__ float bfhi(unsigned w) { return __uint_as_float(w & 0xffff0000u); }
#define DPP_I(v, ctrl) __builtin_amdgcn_update_dpp(0, (v), (ctrl), 0xf, 0xf, true)
#define DPP_F(v, ctrl) __int_as_float(__builtin_amdgcn_update_dpp(0, __float_as_int(v), (ctrl), 0xf, 0xf, true))
constexpr int DPP_X1 = 0xB1, DPP_X2 = 0x4E, DPP_HMIR = 0x141, DPP_ROR4 = 0x124, DPP_ROR8 = 0x128;
__device__ __forceinline__ float sum_x16_32(float v) { auto a = __builtin_amdgcn_permlane16_swap(__float_as_uint(v), __float_as_uint(v), false, false); v = __uint_as_float(a[0]) + __uint_as_float(a[1]);
    auto b = __builtin_amdgcn_permlane32_swap(__float_as_uint(v), __float_as_uint(v), false, false); return __uint_as_float(b[0]) + __uint_as_float(b[1]); }
__device__ __forceinline__ float max_x16_32(float v) { auto a = __builtin_amdgcn_permlane16_swap(__float_as_uint(v), __float_as_uint(v), false, false); v = fmaxf(__uint_as_float(a[0]), __uint_as_float(a[1]));
    auto b = __builtin_amdgcn_permlane32_swap(__float_as_uint(v), __float_as_uint(v), false, false); return fmaxf(__uint_as_float(b[0]), __uint_as_float(b[1])); }
__device__ __forceinline__ int min_x16_32(int v) { auto a = __builtin_amdgcn_permlane16_swap((unsigned)v, (unsigned)v, false, false); v = (int)a[0] < (int)a[1] ? (int)a[0] : (int)a[1];
    auto b = __builtin_amdgcn_permlane32_swap((unsigned)v, (unsigned)v, false, false); return (int)b[0] < (int)b[1] ? (int)b[0] : (int)b[1]; }
__device__ __forceinline__ float sum_x1_2(float v) { v += DPP_F(v, DPP_X1); v += DPP_F(v, DPP_X2); return v; }
__device__ __forceinline__ float sum_x1_2_4(float v) { v = sum_x1_2(v); v += DPP_F(v, DPP_HMIR); return v; }
__device__ __forceinline__ float wave_sum(float v) { v = sum_x1_2(v); v += DPP_F(v, DPP_ROR4); v += DPP_F(v, DPP_ROR8); return sum_x16_32(v); }
__device__ __forceinline__ float wave_max(float v) { v = fmaxf(v, DPP_F(v, DPP_X1)); v = fmaxf(v, DPP_F(v, DPP_X2)); v = fmaxf(v, DPP_F(v, DPP_ROR4)); v = fmaxf(v, DPP_F(v, DPP_ROR8)); return max_x16_32(v); }
__device__ __forceinline__ int wave_min_i(int v) { int w;
    w = DPP_I(v, DPP_X1); v = w < v ? w : v; w = DPP_I(v, DPP_X2); v = w < v ? w : v; w = DPP_I(v, DPP_ROR4); v = w < v ? w : v; w = DPP_I(v, DPP_ROR8); v = w < v ? w : v; return min_x16_32(v); }
__device__ __forceinline__ float sigm(float x) { return 1.f / (1.f + expf(-x)); }
__device__ __forceinline__ float sigm_fast(float x) { return __builtin_amdgcn_rcpf(1.f + __builtin_amdgcn_exp2f(-1.4426950408889634f * x)); }

__device__ const double INV_FREQ[64] = {1.00000000000000000e+00, 8.63988449483968579e-01, 7.46476040841712152e-01, 6.44946677103762411e-01, 5.57226479550717357e-01, 4.81437242078434580e-01, 4.15956216307184767e-01, 3.59381366380462752e-01, 3.10501349512486036e-01, 2.68269579527972590e-01, 2.31781818060089240e-01, 2.00256813604311801e-01, 1.73019573884589412e-01, 1.49486913370923374e-01, 1.29154966501488389e-01, 1.11588399250774864e-01, 9.64110880490750138e-02, 8.32980664765826800e-02, 7.19685673001152076e-02, 6.21800108732091794e-02, 5.37228111832403141e-02, 4.64158883361278016e-02, 4.01027913949520837e-02, 3.46483485573036779e-02, 2.99357729472049007e-02, 2.58641620527596990e-02, 2.23463372691659473e-02, 1.93069772888325060e-02, 1.66810053720005923e-02, 1.44121959671885402e-02, 1.24519708473503302e-02, 1.07583589854217902e-02, 9.29509789880649494e-03, 8.03085722139152032e-03, 6.93856787873718770e-03, 5.99484250318940964e-03, 5.17947467923121282e-03, 4.47500629725045354e-03, 3.86635375219241198e-03, 3.34048498351324471e-03, 2.88614044143008968e-03, 2.49359200498416086e-03, 2.15443469003188427e-03, 1.86140668735512152e-03, 1.60823387766704205e-03, 1.38949549437313892e-03, 1.20050805774840792e-03, 1.03722509540705695e-03, 8.96150501946605012e-04, 7.74263682681127744e-04, 6.68954878691414585e-04, 5.77969288415331340e-04, 4.99358789347314927e-04, 4.31440226144378508e-04, 3.72759372031494166e-04, 3.22059791872108224e-04, 2.78255940220712632e-04, 2.40409918350997456e-04, 2.07711392596645640e-04, 1.79460244029731636e-04, 1.55051577983262559e-04, 1.33962772451801717e-04, 1.15742288059205792e-04, 1.00000000000000005e-04};
__device__ const float RET_LOGG[8] = {-0.0317486983145803f, -0.015748356968139168f, -0.007843177461025893f, -0.003913899321136329f, -0.0019550348358033506f, -0.0009770396478266127f, -0.0004884004981088745f, -0.0002441704321739145f};

#define XB_TMO      128
#define XB_XCNT(j)  (256  + 64 * (j))
#define XB_XSUB(j)  (1280 + 64 * (j))
#define XB_XGEN(j)  (2304 + 64 * (j))
#define XB_TOP      3328
#define XB_TOPGEN   3392
#define XCD_BAR_WORDS 3456
#define XB_SPIN_CAP (1u << 18)

__device__ __forceinline__ unsigned xb_ld(unsigned* p)              { return __hip_atomic_load(p, __ATOMIC_RELAXED, __HIP_MEMORY_SCOPE_AGENT); }
__device__ __forceinline__ unsigned xb_add(unsigned* p, unsigned v) { return __hip_atomic_fetch_add(p, v, __ATOMIC_RELAXED, __HIP_MEMORY_SCOPE_AGENT); }
__device__ __forceinline__ unsigned xb_xcc_id() { return (unsigned)__builtin_amdgcn_s_getreg((3 << 11) | 20) & 0xFu; }
#define XB_SPIN(cond, bar) do { unsigned _sp = 0; while (cond) { __builtin_amdgcn_s_sleep(1); \
    if ((++_sp & 255u) == 0u) { if (xb_ld(&(bar)[XB_TMO])) break; if (_sp > XB_SPIN_CAP) { atomicAdd(&(bar)[XB_TMO], 1u); break; } } } } while (0)

struct XcdBarrier {
    unsigned* bar; unsigned x;
    volatile LAS unsigned* st;
};
__device__ __forceinline__ XcdBarrier xcd_barrier_post(unsigned* bar, volatile LAS unsigned* st) {
    XcdBarrier b; b.bar = bar; b.x = xb_xcc_id(); b.st = st;
    if (threadIdx.x == 0) (void)xb_add(&bar[XB_XCNT(b.x)], 1u);
    return b;
}
__device__ __forceinline__ void xcd_barrier_complete(unsigned* bar, unsigned x, unsigned& nloc, unsigned& nx) {
    const unsigned G = gridDim.x * gridDim.y * gridDim.z;
    unsigned sum, cnt, mine, sp = 0u;
    for (;;) {
        sum = 0u; cnt = 0u; mine = 0u;
#pragma unroll
        for (unsigned j = 0; j < 16; ++j) { const unsigned c = xb_ld(&bar[XB_XCNT(j)]); sum += c; cnt += (c > 0u) ? 1u : 0u; mine = (j == x) ? c : mine; }
        if (sum == G) break;
        __builtin_amdgcn_s_sleep(1);
        if ((++sp & 255u) == 0u) { if (xb_ld(&bar[XB_TMO])) break; if (sp > XB_SPIN_CAP) { atomicAdd(&bar[XB_TMO], 1u); break; } }
    }
    nloc = mine > 0u ? mine : 1u; nx = cnt > 0u ? cnt : 1u;
}
__device__ __forceinline__ void xcd_barrier(const XcdBarrier& b) {
    asm volatile("s_waitcnt vmcnt(0)" ::: "memory");
    __syncthreads();
    if (threadIdx.x == 0) {
        unsigned* bar = b.bar;
        __builtin_amdgcn_s_waitcnt(0);
        unsigned nloc = b.st[0], nx = b.st[1];
        if (nloc == 0u) { xcd_barrier_complete(bar, b.x, nloc, nx); b.st[0] = nloc; b.st[1] = nx; }
        const unsigned old = xb_add(&bar[XB_XSUB(b.x)], 1u);
        const unsigned gen = old / nloc;
        if (old + 1u == (gen + 1u) * nloc) {
            __builtin_amdgcn_fence(__ATOMIC_RELEASE, "agent");
            asm volatile("s_waitcnt vmcnt(0)" ::: "memory");
            const unsigned og = xb_add(&bar[XB_TOP], 1u);
            const unsigned tg = og / nx;
            if (og + 1u == (tg + 1u) * nx) xb_add(&bar[XB_TOPGEN], 1u);
            else XB_SPIN(xb_ld(&bar[XB_TOPGEN]) == tg, bar);
            __builtin_amdgcn_fence(__ATOMIC_ACQUIRE, "agent");
            xb_add(&bar[XB_XGEN(b.x)], 1u);
            asm volatile("s_waitcnt vmcnt(0)" ::: "memory");
        } else {
            XB_SPIN(xb_ld(&bar[XB_XGEN(b.x)]) == gen, bar);
            __builtin_amdgcn_fence(__ATOMIC_ACQUIRE, "agent");
            asm volatile("s_waitcnt vmcnt(0)" ::: "memory");
        }
    }
    __syncthreads();
}

#if defined(__HIP_DEVICE_COMPILE__)
#define ASSUME_GLOBAL(p) do { __builtin_assume(!__builtin_amdgcn_is_shared((const __attribute__((address_space(0))) void*)(p))); __builtin_assume(!__builtin_amdgcn_is_private((const __attribute__((address_space(0))) void*)(p))); } while (0)
#else
#define ASSUME_GLOBAL(p) do { } while (0)
#endif
struct Args { const float* in[36]; float* out; unsigned char* ws; int ph_lo, ph_hi; };
constexpr int LDS_PTAB = LDS_BYTES - 512;
struct PA { unsigned char* ws; float* out; const LAS unsigned* tab;
    __device__ __forceinline__ const float* in(int i) const { const unsigned lo = __builtin_amdgcn_readfirstlane(tab[2 * i]), hi = __builtin_amdgcn_readfirstlane(tab[2 * i + 1]);
        return (const float*)(const GAS float*)(((unsigned long long)hi << 32) | lo); } };

__device__ __forceinline__ void un8(const u32x4 p, float (&o)[8]) { o[0] = bflo(p.x); o[1] = bfhi(p.x); o[2] = bflo(p.y); o[3] = bfhi(p.y); o[4] = bflo(p.z); o[5] = bfhi(p.z); o[6] = bflo(p.w); o[7] = bfhi(p.w); }
__device__ __forceinline__ u32x4 pk8(const float (&v)[8]) { return (u32x4){pk2(v[0], v[1]), pk2(v[2], v[3]), pk2(v[4], v[5]), pk2(v[6], v[7])}; }
using pg8::Unit; using pg8::Gemm; using pg8::TileOrder;
struct SchedPlain {
    TileOrder to; int G, c, tid; const char* A; const char* B; size_t ta, tb;
    __device__ __forceinline__ bool next(int i, Unit& u) const {
        if (!to.tile((long)i * G + c, u.pm, u.pn)) return false;
        u.a = A + (size_t)u.pm * ta; u.b = B + (size_t)u.pn * tb; u.aux = 0; return true; }
};
struct SchedSplitK {
    int G, c, tid, n; const char* A; const char* B; size_t ta, kb;
    __device__ __forceinline__ bool next(int i, Unit& u) const { const long L = (long)i * G + c; if (L >= n) return false;
        u.pm = (int)(L >> 2); u.pn = 0; u.aux = (int)(L & 3); u.a = A + (size_t)u.pm * ta + (size_t)u.aux * kb; u.b = B + (size_t)u.aux * kb; return true; }
};
struct EpiPart48 {
    static constexpr bool PERM = true, CHAIN = false;
    float* P;
    __device__ __forceinline__ void operator()(const f32x4 (&acc)[2][2][4][2], const Unit& u, int wr, int wc, int fr, int fq) const {
        const int col = wc * 32 + 8 * fq, row0 = u.pm * 256 + wr * 64 + fr;
        if (col < 48) {
#pragma unroll
            for (int ai = 0; ai < 2; ++ai)
#pragma unroll
                for (int m = 0; m < 4; ++m) { float* p = P + ((size_t)u.aux * T + row0 + ai * 128 + m * 16) * 48 + col; *(f32x4*)p = acc[ai][0][m][0]; *(f32x4*)(p + 4) = acc[ai][0][m][1]; } }
    }
};
struct SchedBranch {
    TileOrder to; int G, c, tid; const char* A0; const char* B0; size_t sa, sb, ta, tb;
    __device__ __forceinline__ bool next(int i, Unit& u) const {
        const int br = i % 3;
        if (!to.tile((long)(i / 3) * G + c, u.pm, u.pn)) return false;
        u.a = A0 + (size_t)br * sa + (size_t)u.pm * ta; u.b = B0 + (size_t)br * sb + (size_t)u.pn * tb; u.aux = br; return true; }
};
struct SchedMoe {
    int nM, nN, G, c, tid; const char* A; const char* B; size_t ta, tb, te; const int* texp;
    __device__ __forceinline__ bool next(int i, Unit& u) const {
        const long L = (long)i * G + c; if (L >= (long)nM * nN) return false;
        u.pm = (int)(L % nM); u.pn = (int)(L / nM); const int e = texp[u.pm];
        u.a = A + (size_t)u.pm * ta; u.b = B + (size_t)e * te + (size_t)u.pn * tb; u.aux = e; return true; }
};
template <int ACT  > struct EpiStore {
    static constexpr bool PERM = true, CHAIN = false;
    bf16* O; int ldc;
    __device__ __forceinline__ void operator()(const f32x4 (&acc)[2][2][4][2], const Unit& u, int wr, int wc, int fr, int fq) const {
        const int row0 = u.pm * 256 + wr * 64 + fr, col0 = u.pn * 256 + wc * 32 + 8 * fq;
#pragma unroll
        for (int ai = 0; ai < 2; ++ai)
#pragma unroll
            for (int m = 0; m < 4; ++m) { bf16* rowp = O + (size_t)(row0 + ai * 128 + m * 16) * ldc + col0;
#pragma unroll
                for (int bj = 0; bj < 2; ++bj) { f32x4 v0 = acc[ai][bj][m][0], v1 = acc[ai][bj][m][1];
                    if (ACT == 1) {
#pragma unroll
                        for (int j = 0; j < 4; ++j) { v0[j] = sigm_fast(v0[j]); v1[j] = sigm_fast(v1[j]); } }
                    u32x4 w; w.x = pg8::cvt_pk_bf16(v0[0], v0[1]); w.y = pg8::cvt_pk_bf16(v0[2], v0[3]); w.z = pg8::cvt_pk_bf16(v1[0], v1[1]); w.w = pg8::cvt_pk_bf16(v1[2], v1[3]);
                    *(u32x4*)(rowp + bj * 128) = w; __builtin_amdgcn_sched_barrier(0); } }
    }
};
struct EpiBranch {
    static constexpr bool PERM = true, CHAIN = true;
    bf16* Mg; const bf16* Gt;
    __device__ __forceinline__ void chain(f32x4 (&acc)[2][2][4][2], const Unit& u, int wr, int wc, int fr, int fq) const {
        const int row0 = u.pm * 256 + wr * 64 + fr, col0 = u.pn * 256 + wc * 32 + 8 * fq, br = u.aux;
#pragma unroll
        for (int ai = 0; ai < 2; ++ai)
#pragma unroll
            for (int m = 0; m < 4; ++m) { const size_t r = (size_t)(row0 + ai * 128 + m * 16);
#pragma unroll
                for (int bj = 0; bj < 2; ++bj) { const int col = col0 + bj * 128; float g[8]; un8(*(const u32x4*)(Gt + r * NG + br * 2048 + col), g);
                    if (br < 2) { float gn[8]; un8(*(const u32x4*)(Gt + r * NG + (br + 1) * 2048 + col), gn);
#pragma unroll
                        for (int j = 0; j < 8; ++j) g[j] = fmaxf(g[j], 1e-18f) * __builtin_amdgcn_rcpf(fmaxf(gn[j], 1e-18f)); }
                    else {
#pragma unroll
                        for (int j = 0; j < 8; ++j) g[j] = fmaxf(g[j], 1e-18f); }
                    f32x4& v0 = acc[ai][bj][m][0]; f32x4& v1 = acc[ai][bj][m][1];
                    v0[0] *= g[0]; v0[1] *= g[1]; v0[2] *= g[2]; v0[3] *= g[3]; v1[0] *= g[4]; v1[1] *= g[5]; v1[2] *= g[6]; v1[3] *= g[7];
                    if (br == 2) { u32x4 w; w.x = pg8::cvt_pk_bf16(v0[0], v0[1]); w.y = pg8::cvt_pk_bf16(v0[2], v0[3]); w.z = pg8::cvt_pk_bf16(v1[0], v1[1]); w.w = pg8::cvt_pk_bf16(v1[2], v1[3]);
                        *(u32x4*)(Mg + r * D + col) = w; v0 = (f32x4){0.f, 0.f, 0.f, 0.f}; v1 = v0; }
                    __builtin_amdgcn_sched_barrier(0); } }
    }
    __device__ __forceinline__ void operator()(const f32x4 (&)[2][2][4][2], const Unit&, int, int, int, int) const {}
};
struct EpiResid {
    static constexpr bool PERM = true, CHAIN = false;
    float* X;
    __device__ __forceinline__ void operator()(const f32x4 (&acc)[2][2][4][2], const Unit& u, int wr, int wc, int fr, int fq) const {
        const int row0 = u.pm * 256 + wr * 64 + fr, col0 = u.pn * 256 + wc * 32 + 8 * fq;
#pragma unroll
        for (int ai = 0; ai < 2; ++ai)
#pragma unroll
            for (int m = 0; m < 4; ++m) { float* rowp = X + (size_t)(row0 + ai * 128 + m * 16) * D + col0;
#pragma unroll
                for (int bj = 0; bj < 2; ++bj) { f32x4* p = (f32x4*)(rowp + bj * 128);
                    const f32x4 x0 = p[0], x1 = p[1];
                    p[0] = x0 * DN_ALPHA + acc[ai][bj][m][0]; p[1] = x1 * DN_ALPHA + acc[ai][bj][m][1]; __builtin_amdgcn_sched_barrier(0); } }
    }
};
struct EpiGateUp {
    static constexpr bool PERM = true, CHAIN = false;
    bf16* H;
    __device__ __forceinline__ void operator()(const f32x4 (&acc)[2][2][4][2], const Unit& u, int wr, int wc, int fr, int fq) const {
        const int row0 = u.pm * 256 + wr * 64 + fr, col0 = u.pn * 128 + wc * 32 + 8 * fq;
#pragma unroll
        for (int ai = 0; ai < 2; ++ai)
#pragma unroll
            for (int m = 0; m < 4; ++m) { bf16* rowp = H + (size_t)(row0 + ai * 128 + m * 16) * FF + col0;
                f32x4 h0, h1;
#pragma unroll
                for (int j = 0; j < 4; ++j) { const float g0 = acc[ai][0][m][0][j], g1 = acc[ai][0][m][1][j];
                    h0[j] = g0 * sigm_fast(g0) * acc[ai][1][m][0][j]; h1[j] = g1 * sigm_fast(g1) * acc[ai][1][m][1][j]; }
                u32x4 w; w.x = pg8::cvt_pk_bf16(h0[0], h0[1]); w.y = pg8::cvt_pk_bf16(h0[2], h0[3]); w.z = pg8::cvt_pk_bf16(h1[0], h1[1]); w.w = pg8::cvt_pk_bf16(h1[2], h1[3]);
                *(u32x4*)rowp = w; }
    }
};

struct Ctx { LAS unsigned char* lds; int tid, lane, wave, G, bx, gw, NGW; };

template <class SRC>
__device__ __forceinline__ void transpose_task(const Ctx& c, const SRC& src, int ldsrc, int K, bf16* dst, int ndst) {
    LAS float* scr = (LAS float*)(c.lds + c.wave * 16640);
    const int nblk = ndst / 64, items = (K / 64) * nblk, lane = c.lane;
    for (int it = c.gw; it < items; it += c.NGW) {
        const int kb = it / nblk, nb = it % nblk, k0 = 64 * kb, n0 = 64 * nb;
        const int nn = n0 + 4 * (lane & 15); const float* sp = src(nn); const int kl = src.klim(nn); const bool al = sp && ((((size_t)sp) & 15) == 0) && ((ldsrc & 3) == 0);
        f32x4 v[16];
#pragma unroll
        for (int i = 0; i < 16; ++i) { const int kk = 4 * i + (lane >> 4); v[i] = (f32x4){0.f, 0.f, 0.f, 0.f};
            if (sp && k0 + kk < kl) { const float* p = sp + (size_t)(k0 + kk) * ldsrc; if (al) v[i] = *(const f32x4*)p; else v[i] = (f32x4){p[0], p[1], p[2], p[3]}; } }
#pragma unroll
        for (int i = 0; i < 16; ++i) { LAS float* tp = scr + (4 * i + (lane >> 4)) * 65 + 4 * (lane & 15); tp[0] = v[i][0]; tp[1] = v[i][1]; tp[2] = v[i][2]; tp[3] = v[i][3]; }
        LDS_WAIT();
        const int cc = lane & 7;
#pragma unroll
        for (int j = 0; j < 8; ++j) { const int n = (lane >> 3) + 8 * j; const LAS float* s = scr + (8 * cc) * 65 + n;
            u32x4 o; o.x = pk2(s[0 * 65], s[1 * 65]); o.y = pk2(s[2 * 65], s[3 * 65]); o.z = pk2(s[4 * 65], s[5 * 65]); o.w = pk2(s[6 * 65], s[7 * 65]);
            *(u32x4*)(dst + (size_t)(n0 + n) * K + k0 + 8 * cc) = o; }
        LDS_WAIT();
    }
}
struct SrcWin { const float* W; int layer; __device__ __forceinline__ int klim(int) const { return 1 << 30; }
    __device__ __forceinline__ const float* operator()(int n) const {
        const int rw = layer ? 3584 : 3520; int sc;
        if (n < 3072) sc = n; else if (n < 5632) sc = rw + (n - 3072); else if (n < 9728) sc = rw + 2608 + (n - 5632); else if (n < 10176) sc = 3072 + (n - 9728);
        else if (n < 10240) sc = layer ? 3520 + (n - 10176) : -1; else if (n < 10288) sc = rw + 2560 + (n - 10240); else sc = -1;
        return sc >= 0 ? W + sc : nullptr; } };
struct SrcOff { const float* W; __device__ __forceinline__ int klim(int) const { return 1 << 30; } __device__ __forceinline__ const float* operator()(int n) const { return W + n; } };
struct SrcGU { const float* Wg; const float* Wu; __device__ __forceinline__ int klim(int) const { return 1 << 30; }
    __device__ __forceinline__ const float* operator()(int nn) const { const int e = nn >> 10, r1 = nn & 1023, pn = r1 >> 8, rr = r1 & 255;
        const size_t du = (size_t)((const char*)Wu - (const char*)Wg);
        return (const float*)((const char*)Wg + (rr < 128 ? (size_t)0 : du)) + (size_t)e * D * FF + 128 * pn + (rr & 127); } };
struct SrcDN { const float* Wd; __device__ __forceinline__ int klim(int) const { return 1 << 30; }
    __device__ __forceinline__ const float* operator()(int nn) const { const int e = nn >> 11, n = nn & 2047; return Wd + (size_t)e * FF * D + n; } };

struct SrcLora { const float* w; const float* a_; const float* g; const float* v;
    __device__ __forceinline__ const float* operator()(int n) const { const int blk = n >> 10, cc = n & 1023; const size_t b0 = (size_t)w, d1 = (size_t)a_ - b0, d2 = (size_t)g - b0, d3 = (size_t)v - b0; if (blk == 3 && v == nullptr) return nullptr; const size_t off = blk == 0 ? 0 : (blk == 1 ? d1 : (blk == 2 ? d2 : d3)); return (const float*)(b0 + off) + cc; }
    __device__ __forceinline__ int klim(int n) const { const int blk = n >> 10; return blk < 2 ? 96 : (blk == 2 ? 256 : 64); } };
__device__ __forceinline__ void ph_conv(const Ctx& c, const PA& a, int layer) {
    unsigned char* ws = a.ws;
    const float* Win = layer ? a.in(2) : a.in(1); const int ldw = layer ? 16432 : 16368, rw = layer ? 3584 : 3520;
    transpose_task(c, SrcWin{Win, layer}, ldw, D, (bf16*)(ws + WS_WIN), LDP);
    transpose_task(c, SrcOff{Win + rw + 2608 + 4096}, ldw, D, (bf16*)(ws + WS_WG), NG);
    transpose_task(c, SrcOff{a.in(21) + (size_t)layer * RWW * D}, D, RWW, (bf16*)(ws + WS_WBR), D);
    transpose_task(c, SrcOff{a.in(22) + (size_t)layer * RWW * D}, D, RWW, (bf16*)(ws + WS_WBR) + (size_t)D * RWW, D);
    transpose_task(c, SrcOff{a.in(23) + (size_t)layer * RWW * D}, D, RWW, (bf16*)(ws + WS_WBR) + (size_t)2 * D * RWW, D);
    transpose_task(c, SrcOff{a.in(24) + (size_t)layer * D * D}, D, D, (bf16*)(ws + WS_WOUT), D);
    transpose_task(c, SrcOff{a.in(18) + (size_t)(layer * 2) * 2048 * 128}, 128, 2048, (bf16*)(ws + WS_W1T), 128);
    transpose_task(c, SrcOff{a.in(18) + (size_t)(layer * 2 + 1) * 2048 * 128}, 128, 2048, (bf16*)(ws + WS_W1T) + (size_t)128 * 2048, 128);
    transpose_task(c, SrcLora{a.in(6) + (size_t)layer * 96 * 1024, a.in(8) + (size_t)layer * 96 * 1024, a.in(11) + (size_t)layer * 256 * 1024, layer ? a.in(10) : nullptr}, 1024, 256, (bf16*)(ws + WS_WLORA), 4096);
    if (layer == 0) {
        const f32x4* x4 = (const f32x4*)a.in(0); f32x4* o4 = (f32x4*)a.out; uint2* xb = (uint2*)(ws + WS_XB);
        for (size_t i = (size_t)c.bx * 512 + c.tid; i < (size_t)T * D / 4; i += (size_t)c.G * 512) { const f32x4 v = x4[i]; o4[i] = v; xb[i] = make_uint2(pk2(v[0], v[1]), pk2(v[2], v[3])); }
        float* cs = (float*)(ws + WS_COS); float* sn = (float*)(ws + WS_SIN);
        for (int i = c.bx * 512 + c.tid; i < T * 64; i += c.G * 512) { const int t = i >> 6, j = i & 63;
            const double rev = (double)t * INV_FREQ[j] * 0.15915494309189533577; const float fr = (float)(rev - __builtin_rint(rev));
            cs[i] = __builtin_amdgcn_cosf(fr); sn[i] = __builtin_amdgcn_sinf(fr); }
    }
}
__device__ __forceinline__ void ph_conv_moe(const Ctx& c, const PA& a, int layer) {
    unsigned char* ws = a.ws; const size_t lo = (size_t)layer * NEXP * D * FF;
    transpose_task(c, SrcGU{a.in(31) + lo, a.in(32) + lo}, FF, D, (bf16*)(ws + WS_WGU), NEXP * 1024);
    transpose_task(c, SrcDN{a.in(33) + lo}, D, FF, (bf16*)(ws + WS_WDN), NEXP * D);
}

__device__ __forceinline__ float softplusf_(float x) { return fmaxf(x, 0.f) + log1pf(expf(-fabsf(x))); }
__device__ __forceinline__ void prep_rwkv(const Ctx& c, const PA& a, int layer) {
    unsigned char* ws = a.ws; const bf16* proj = (const bf16*)(ws + WS_PROJ);
    bf16* oR = (bf16*)(ws + WS_RW_R); bf16* oK = (bf16*)(ws + WS_RW_K); bf16* oV = (bf16*)(ws + WS_RW_V); bf16* oKK = (bf16*)(ws + WS_RW_KK); bf16* VF = (bf16*)(ws + WS_VF); bf16* AL = (bf16*)(ws + WS_ALORA);
    const float* mu = a.in(layer ? 4 : 3); const float* k_k = a.in(12) + layer * 1024;
    const int lane = c.lane;
    for (int t = c.gw; t < T; t += c.NGW) {
        const bf16* prow = proj + (size_t)t * LDP; const bf16* pprev = prow - LDP; const size_t o = (size_t)t * 1024 + 16 * lane;
#pragma unroll
        for (int piece = 0; piece < 3; ++piece) { float sh[16];
#pragma unroll
            for (int hf = 0; hf < 2; ++hf) { const int c8 = piece * 1024 + 16 * lane + 8 * hf; float pv[8], qv[8]; un8(*(const u32x4*)(prow + c8), pv);
                if (t > 0) un8(*(const u32x4*)(pprev + c8), qv); else { for (int j = 0; j < 8; ++j) qv[j] = 0.f; }
                const f32x4 m0 = *(const f32x4*)(mu + c8), m1 = *(const f32x4*)(mu + c8 + 4);
#pragma unroll
                for (int j = 0; j < 8; ++j) sh[8 * hf + j] = pv[j] + (qv[j] - pv[j]) * (j < 4 ? m0[j] : m1[j - 4]); }
            float lo8[8], hi8[8];
#pragma unroll
            for (int j = 0; j < 8; ++j) { lo8[j] = sh[j]; hi8[j] = sh[8 + j]; }
            bf16* dst = piece == 0 ? oR : (piece == 1 ? oK : oV);
            *(u32x4*)(dst + o) = pk8(lo8); *(u32x4*)(dst + o + 8) = pk8(hi8);
            if (piece == 2 && layer == 0) { *(u32x4*)(VF + o) = pk8(lo8); *(u32x4*)(VF + o + 8) = pk8(hi8); }
            if (piece == 1) { float n2 = 0.f;
#pragma unroll
                for (int j = 0; j < 16; ++j) { sh[j] *= k_k[16 * lane + j]; n2 += sh[j] * sh[j]; }
                n2 = sum_x1_2(n2); const float inv = 1.f / fmaxf(sqrtf(n2), 1e-12f);
#pragma unroll
                for (int j = 0; j < 8; ++j) { lo8[j] = sh[j] * inv; hi8[j] = sh[8 + j] * inv; }
                *(u32x4*)(oKK + o) = pk8(lo8); *(u32x4*)(oKK + o + 8) = pk8(hi8); } }
        { const int i8 = lane * 8; int sc, mi, fn, dc;
            if (i8 < 96) { sc = PC_XW + i8; mi = 3072 + i8; fn = 1; dc = i8; } else if (i8 < 192) { sc = PC_XA + (i8 - 96); mi = 3168 + (i8 - 96); fn = 0; dc = 256 + (i8 - 96); }
            else if (i8 < 448) { sc = PC_XG + (i8 - 192); mi = 3264 + (i8 - 192); fn = 2; dc = 512 + (i8 - 192); } else { sc = PC_XV + (i8 - 448); mi = 3520 + (i8 - 448); fn = layer ? 0 : 3; dc = 768 + (i8 - 448); }
            float pv[8], qv[8], ov[8]; un8(*(const u32x4*)(prow + sc), pv); if (t > 0) un8(*(const u32x4*)(pprev + sc), qv); else { for (int j = 0; j < 8; ++j) qv[j] = 0.f; }
#pragma unroll
            for (int j = 0; j < 8; ++j) { float s = 0.f;
                if (fn != 3) { const float mm = mu[mi + j]; s = pv[j] + (qv[j] - pv[j]) * mm; if (fn == 1) s = tanhf(s); else if (fn == 2) s = sigm(s); }
                ov[j] = s; }
            *(u32x4*)(AL + (size_t)t * 1024 + dc) = pk8(ov);
            const int zc = lane < 20 ? 96 + 8 * lane : (lane < 40 ? 352 + 8 * (lane - 20) : 832 + 8 * (lane - 40));
            { unsigned z0 = 0u; asm volatile("" : "+v"(z0)); *(u32x4*)(AL + (size_t)t * 1024 + zc) = (u32x4){z0, z0, z0, z0}; } }
    }
}
__device__ __forceinline__ float ex2(float x) { return __builtin_amdgcn_exp2f(x); }
__device__ __forceinline__ void un4(const uint2 p, float (&o)[4]) { o[0] = bflo(p.x); o[1] = bfhi(p.x); o[2] = bflo(p.y); o[3] = bfhi(p.y); }
struct EpiLora {
    static constexpr bool PERM = true, CHAIN = false;
    unsigned char* ws; PA pa; int layer;
#define EPL_ROWS(...) _Pragma("unroll") for (int bj = 0; bj < 2; ++bj) _Pragma("unroll") for (int hf = 0; hf < 2; ++hf) { const int col = col0 + bj * 128 + 4 * hf; PRE _Pragma("unroll") for (int ai = 0; ai < 2; ++ai) _Pragma("unroll") for (int m = 0; m < 4; ++m) { \
        const size_t o = (size_t)(row0 + ai * 128 + m * 16) * 1024 + col; const f32x4 x = acc[ai][bj][m][hf]; __VA_ARGS__ __builtin_amdgcn_sched_barrier(0); } }
    __device__ __forceinline__ void operator()(const f32x4 (&acc)[2][2][4][2], const Unit& u, int wr, int wc, int fr, int fq) const {
        const int blk = u.pn >> 2, row0 = u.pm * 256 + wr * 64 + fr, col0 = (u.pn & 3) * 256 + wc * 32 + 8 * fq;
        if (blk == 0) {
#define PRE const f32x4 p = *(const f32x4*)(pa.in(5) + layer * 1024 + col);
            EPL_ROWS({ f32x4 d;
                _Pragma("unroll") for (int j = 0; j < 4; ++j) { const float z = -(x[j] + p[j]), sp = fmaxf(z, 0.f) + 0.6931471805599453f * __builtin_amdgcn_logf(1.f + ex2(-1.4426950408889634f * fabsf(z)));
                    d[j] = ex2(-1.4426950408889634f * ex2(1.4426950408889634f * (-sp - 0.5f))); }
                *(f32x4*)((float*)(ws + WS_RW_W) + o) = d; })
#undef PRE
        } else if (blk == 1) {
#define PRE const f32x4 p = *(const f32x4*)(pa.in(7) + layer * 1024 + col), qa = *(const f32x4*)(pa.in(13) + layer * 1024 + col);
            EPL_ROWS({ float kk[4], k0[4]; un4(*(const uint2*)((const bf16*)(ws + WS_RW_KK) + o), kk); un4(*(const uint2*)((const bf16*)(ws + WS_RW_K) + o), k0); float bb[4], kf[4];
                _Pragma("unroll") for (int j = 0; j < 4; ++j) { const float aa = sigm_fast(x[j] + p[j]); bb[j] = kk[j] * aa; kf[j] = k0[j] * (1.f + (aa - 1.f) * qa[j]); }
                *(uint2*)((bf16*)(ws + WS_RW_B) + o) = make_uint2(pk2(bb[0], bb[1]), pk2(bb[2], bb[3])); *(uint2*)((bf16*)(ws + WS_RW_K) + o) = make_uint2(pk2(kf[0], kf[1]), pk2(kf[2], kf[3])); })
#undef PRE
        } else if (blk == 2) {
#define PRE
            EPL_ROWS({ *(uint2*)((bf16*)(ws + WS_RW_G) + o) = make_uint2(pg8::cvt_pk_bf16(x[0], x[1]), pg8::cvt_pk_bf16(x[2], x[3])); })
#undef PRE
        } else {
#define PRE const f32x4 p = *(const f32x4*)(pa.in(9) + col);
            EPL_ROWS({ float v0[4], vf[4], vv[4]; un4(*(const uint2*)((const bf16*)(ws + WS_RW_V) + o), v0); un4(*(const uint2*)((const bf16*)(ws + WS_VF) + o), vf);
                _Pragma("unroll") for (int j = 0; j < 4; ++j) vv[j] = v0[j] + (vf[j] - v0[j]) * sigm_fast(x[j] + p[j]);
                *(uint2*)((bf16*)(ws + WS_RW_V) + o) = make_uint2(pk2(vv[0], vv[1]), pk2(vv[2], vv[3])); })
#undef PRE
        }
    }
#undef EPL_ROWS
};
struct SchedLora { TileOrder to; int G, c, tid; const char* A; const char* B;
    __device__ __forceinline__ bool next(int i, Unit& u) const {
        if (!to.tile((long)i * G + c, u.pm, u.pn)) return false;
        u.a = A + (size_t)u.pm * 256 * 1024 * 2 + (size_t)(u.pn >> 2) * 256 * 2; u.b = B + (size_t)u.pn * 256 * 256 * 2; u.aux = 0; return true; }
};
__device__ __forceinline__ float gelu_tanh(float x) { return 0.5f * x * (1.f + tanhf(0.7978845608028654f * (x + 0.044715f * x * x * x))); }
__device__ __forceinline__ void prep_cmp(const Ctx& c, const PA& a, int layer) {
    unsigned char* ws = a.ws; const bf16* proj = (const bf16*)(ws + WS_PROJ);
    constexpr int RS = 2056;
    LAS bf16* sh_in = (LAS bf16*)c.lds; LAS float* sh_h = (LAS float*)(c.lds + 16 * RS * 2);
    const int tid = c.tid, lane = c.lane, r = lane & 15, q = lane >> 4, w = c.wave;
    for (int it = c.bx; it < 256 * 2; it += c.G) {
        const int cg = it >> 1, kv = it & 1, col0 = kv ? PC_VC : PC_KC, lk = layer * 2 + kv;
        const float* pe = a.in(17) + (size_t)lk * 2048;
        for (int idx = tid; idx < 16 * 2048 / 8; idx += 512) { const int row = idx >> 8, r8 = (idx & 255) * 8, cb = 4 * cg + (row >> 2), g = row & 3, l = r8 >> 6, d = r8 & 63;
            int tok = 16 * cb + l; tok = tok > T - 1 ? T - 1 : tok;
            float v[8]; un8(*(const u32x4*)(proj + (size_t)tok * LDP + col0 + g * 64 + d), v); const f32x4 p0 = *(const f32x4*)(pe + r8), p1 = *(const f32x4*)(pe + r8 + 4);
#pragma unroll
            for (int j = 0; j < 8; ++j) v[j] += j < 4 ? p0[j] : p1[j - 4];
            *(LAS u32x4*)(sh_in + row * RS + r8) = pk8(v); }
        __syncthreads();
        { const bf16* wt = (const bf16*)(ws + WS_W1T) + ((size_t)(kv * 128 + 16 * w + r)) * 2048 + 8 * q; const LAS bf16* ap = sh_in + r * RS + 8 * q;
            f32x4 acc = (f32x4){0.f, 0.f, 0.f, 0.f};
#pragma unroll 8
            for (int ks = 0; ks < 64; ++ks) acc = __builtin_amdgcn_mfma_f32_16x16x32_bf16(*(const LAS bf16x8*)(ap + 32 * ks), *(const bf16x8*)(wt + 32 * ks), acc, 0, 0, 0);
            const float bj = a.in(19)[lk * 128 + 16 * w + r];
#pragma unroll
            for (int i = 0; i < 4; ++i) sh_h[(4 * q + i) * 128 + 16 * w + r] = gelu_tanh(acc[i] + bj); }
        __syncthreads();
        const float* w2 = a.in(20) + (size_t)lk * 128 * 64;
        for (int oidx = tid; oidx < 16 * 64; oidx += 512) { const int row = oidx >> 6, d = oidx & 63, cb = 4 * cg + (row >> 2), g = row & 3; float o = 0.f;
#pragma unroll 16
            for (int j = 0; j < 128; ++j) o += sh_h[row * 128 + j] * w2[j * 64 + d];
            if (kv == 0) { const float ob = bf2f((bf16)f2bf(o)), n2 = wave_sum(ob * ob); if (c.lane == 0 && cb < NCMP) atomicMax((unsigned*)(ws + WS_CTL) + CW_KMAX + layer * 64 + 8 + g, __float_as_uint(sqrtf(n2))); }
            if (cb < NCMP) {
            const int blk = cb >> 6, kc = cb & 63;
            if (kv == 0) { const int j2 = kc >> 4, rr = kc & 15, ks = d >> 5, qq = (d & 31) >> 3, i = d & 7;
                ((bf16*)(ws + WS_KCMPB))[((((size_t)g * 16 + blk) * 8 + 2 * j2 + ks) * 64 + qq * 16 + rr) * 8 + i] = (bf16)f2bf(o);
                if (cb == 0) ((bf16*)(ws + WS_KCMPB))[((((size_t)g * 16 + 15) * 8 + 2 * 3 + ks) * 64 + qq * 16 + 15) * 8 + i] = 0; }
            else { const int ks = kc >> 5, kk = kc & 31, hh = kk >> 4, qq = (kk & 15) >> 2, i = (kk & 3) + 4 * hh, mt = d >> 4, rr = d & 15;
                ((bf16*)(ws + WS_VCMPT))[((((size_t)g * 16 + blk) * 8 + 2 * mt + ks) * 64 + qq * 16 + rr) * 8 + i] = (bf16)f2bf(o);
                (ws + WS_VC8)[((((size_t)g * 16 + blk) * 4 + mt) * 64 + qq * 16 + rr) * 16 + ks * 8 + i] = (unsigned char)(__builtin_amdgcn_cvt_pk_fp8_f32(4.f * o, 4.f * o, 0, false) & 0xff);
                if (cb == 0) { ((bf16*)(ws + WS_VCMPT))[((((size_t)g * 16 + 15) * 8 + 2 * mt + 1) * 64 + 3 * 16 + rr) * 8 + 7] = 0; (ws + WS_VC8)[((((size_t)g * 16 + 15) * 4 + mt) * 64 + 3 * 16 + rr) * 16 + 15] = 0; } } } }
        __syncthreads();
    }
}
__device__ __forceinline__ void prep_rope(const Ctx& c, const PA& a) {
    unsigned char* ws = a.ws; bf16* proj = (bf16*)(ws + WS_PROJ); const float* cs = (const float*)(ws + WS_COS); const float* sn = (const float*)(ws + WS_SIN);
    for (int i = c.bx * 512 + c.tid; i < T * 8 * 8; i += c.G * 512) { const int j8 = (i & 7) * 8, h = (i >> 3) & 7, t = i >> 6;
        bf16* qp = proj + (size_t)t * LDP + PC_RQ + h * 128 + j8; float q1[8], q2[8], o1[8], o2[8]; un8(*(const u32x4*)qp, q1); un8(*(const u32x4*)(qp + 64), q2);
        const f32x4 c0 = *(const f32x4*)(cs + (size_t)t * 64 + j8), c1 = *(const f32x4*)(cs + (size_t)t * 64 + j8 + 4), s0 = *(const f32x4*)(sn + (size_t)t * 64 + j8), s1 = *(const f32x4*)(sn + (size_t)t * 64 + j8 + 4);
#pragma unroll
        for (int j = 0; j < 8; ++j) { const float co = j < 4 ? c0[j] : c1[j - 4], si = j < 4 ? s0[j] : s1[j - 4]; o1[j] = q1[j] * co - q2[j] * si; o2[j] = q1[j] * si + q2[j] * co; }
        *(u32x4*)qp = pk8(o1); *(u32x4*)(qp + 64) = pk8(o2); }
}

constexpr int RW_NC = 64, RW_CL = 256, RW_TS = 8;
typedef float f32x2 __attribute__((ext_vector_type(2)));
__device__ __forceinline__ void rw_put8(LAS float* d, u32x4 v) { *(LAS f32x4*)d = (f32x4){bflo(v.x), bfhi(v.x), bflo(v.y), bfhi(v.y)}; *(LAS f32x4*)(d + 4) = (f32x4){bflo(v.z), bfhi(v.z), bflo(v.w), bfhi(v.w)}; }
struct RwRegs { u32x4 kk, b, k, v, r, g; f32x4 w0, w1; };
__device__ __forceinline__ void rw_stage_load(const unsigned char* ws, RwRegs& R, int t0, int h, int lane, bool need_r) {
    const unsigned e = (unsigned)((t0 + (lane >> 3)) * 1024 + h * 64 + 8 * (lane & 7));
    R.kk = *(const u32x4*)(ws + ((unsigned)WS_RW_KK + e * 2u)); R.b = *(const u32x4*)(ws + ((unsigned)WS_RW_B + e * 2u)); R.k = *(const u32x4*)(ws + ((unsigned)WS_RW_K + e * 2u)); R.v = *(const u32x4*)(ws + ((unsigned)WS_RW_V + e * 2u));
    R.w0 = *(const f32x4*)(ws + ((unsigned)WS_RW_W + e * 4u)); R.w1 = *(const f32x4*)(ws + ((unsigned)WS_RW_W + e * 4u + 16u));
    R.r = (u32x4){0u, 0u, 0u, 0u}; R.g = R.r; if (need_r) { R.r = *(const u32x4*)(ws + ((unsigned)WS_RW_R + e * 2u)); R.g = *(const u32x4*)(ws + ((unsigned)WS_RW_G + e * 2u)); }
}
__device__ __forceinline__ void rw_stage_store(LAS float* tile, const RwRegs& R, int lane) {
    LAS float* tp = tile + (lane >> 3) * 384 + 8 * (lane & 7);
    rw_put8(tp, R.kk); rw_put8(tp + 64, R.b); *(LAS f32x4*)(tp + 128) = R.w0; *(LAS f32x4*)(tp + 132) = R.w1; rw_put8(tp + 192, R.k); rw_put8(tp + 256, R.r); rw_put8(tp + 320, R.v);
}
#define RW_LD4(p) (*(const LAS f32x4*)(p))
__device__ __forceinline__ void rw_step(f32x2 (&S)[32], const LAS float* tp, float vi) {
    f32x4 kk[16];
#pragma unroll
    for (int i = 0; i < 16; ++i) kk[i] = RW_LD4(tp + 4 * i);
    f32x4 b4[2][4], w4[2][4], k4[2][4];
#pragma unroll
    for (int i = 0; i < 4; ++i) { b4[0][i] = RW_LD4(tp + 64 + 4 * i); w4[0][i] = RW_LD4(tp + 128 + 4 * i); k4[0][i] = RW_LD4(tp + 192 + 4 * i); }
    __builtin_amdgcn_sched_barrier(0);
    f32x2 d0 = (f32x2){0.f, 0.f}, d1 = d0;
#pragma unroll
    for (int i = 0; i < 16; ++i) { d0 += S[2 * i] * (f32x2){kk[i][0], kk[i][1]}; d1 += S[2 * i + 1] * (f32x2){kk[i][2], kk[i][3]}; }
    const float sk = (d0[0] + d0[1]) + (d1[0] + d1[1]); const f32x2 nsk = (f32x2){-sk, -sk}, vi2 = (f32x2){vi, vi};
#pragma unroll
    for (int c = 0; c < 4; ++c) { const int cb = c & 1, nb = cb ^ 1;
        if (c + 1 < 4) {
#pragma unroll
            for (int i = 0; i < 4; ++i) { b4[nb][i] = RW_LD4(tp + 64 + 16 * (c + 1) + 4 * i); w4[nb][i] = RW_LD4(tp + 128 + 16 * (c + 1) + 4 * i); k4[nb][i] = RW_LD4(tp + 192 + 16 * (c + 1) + 4 * i); } }
        __builtin_amdgcn_sched_barrier(0);
#pragma unroll
        for (int i = 0; i < 4; ++i) { const int p = 8 * c + 2 * i;
            S[p] = S[p] * (f32x2){w4[cb][i][0], w4[cb][i][1]} + (vi2 * (f32x2){k4[cb][i][0], k4[cb][i][1]} + nsk * (f32x2){b4[cb][i][0], b4[cb][i][1]});
            S[p + 1] = S[p + 1] * (f32x2){w4[cb][i][2], w4[cb][i][3]} + (vi2 * (f32x2){k4[cb][i][2], k4[cb][i][3]} + nsk * (f32x2){b4[cb][i][2], b4[cb][i][3]}); }
        __builtin_amdgcn_sched_barrier(0); }
}
__device__ __forceinline__ float rw_dot_r(const f32x2 (&S)[32], const LAS float* tp) {
    f32x4 r4[16];
#pragma unroll
    for (int i = 0; i < 16; ++i) r4[i] = RW_LD4(tp + 256 + 4 * i);
    __builtin_amdgcn_sched_barrier(0);
    f32x2 d0 = (f32x2){0.f, 0.f}, d1 = d0;
#pragma unroll
    for (int i = 0; i < 16; ++i) { d0 += S[2 * i] * (f32x2){r4[i][0], r4[i][1]}; d1 += S[2 * i + 1] * (f32x2){r4[i][2], r4[i][3]}; }
    return (d0[0] + d0[1]) + (d1[0] + d1[1]);
}

__device__ __forceinline__ void rw_step_dual(f32x2 (&SP)[32], f32x2 (&SU)[32], const LAS float* tp, float vi) {
    f32x2 p0 = (f32x2){0.f, 0.f}, p1 = p0, u0 = p0, u1 = p0;
#pragma unroll
    for (int h2 = 0; h2 < 2; ++h2) { f32x4 kk[8];
#pragma unroll
        for (int i = 0; i < 8; ++i) kk[i] = RW_LD4(tp + 32 * h2 + 4 * i);
        __builtin_amdgcn_sched_barrier(0);
#pragma unroll
        for (int i = 0; i < 8; ++i) { const int p = 16 * h2 + 2 * i; const f32x2 ka = (f32x2){kk[i][0], kk[i][1]}, kb = (f32x2){kk[i][2], kk[i][3]};
            p0 += SP[p] * ka; p1 += SP[p + 1] * kb; u0 += SU[p] * ka; u1 += SU[p + 1] * kb; }
        __builtin_amdgcn_sched_barrier(0); }
    const float skp = (p0[0] + p0[1]) + (p1[0] + p1[1]), sku = (u0[0] + u0[1]) + (u1[0] + u1[1]); const f32x2 nsp = (f32x2){-skp, -skp}, nsu = (f32x2){-sku, -sku}, vi2 = (f32x2){vi, vi};
#pragma unroll
    for (int c = 0; c < 8; ++c) { f32x4 b4[2], w4[2], k4[2];
#pragma unroll
        for (int i = 0; i < 2; ++i) { b4[i] = RW_LD4(tp + 64 + 8 * c + 4 * i); w4[i] = RW_LD4(tp + 128 + 8 * c + 4 * i); k4[i] = RW_LD4(tp + 192 + 8 * c + 4 * i); }
        __builtin_amdgcn_sched_barrier(0);
#pragma unroll
        for (int i = 0; i < 2; ++i) { const int p = 4 * c + 2 * i;
            const f32x2 ba = (f32x2){b4[i][0], b4[i][1]}, bb = (f32x2){b4[i][2], b4[i][3]}, wa = (f32x2){w4[i][0], w4[i][1]}, wb = (f32x2){w4[i][2], w4[i][3]}, ka = (f32x2){k4[i][0], k4[i][1]}, kb = (f32x2){k4[i][2], k4[i][3]};
            SP[p] = SP[p] * wa + nsp * ba; SP[p + 1] = SP[p + 1] * wb + nsp * bb;
            SU[p] = SU[p] * wa + (vi2 * ka + nsu * ba); SU[p + 1] = SU[p + 1] * wb + (vi2 * kb + nsu * bb); }
        __builtin_amdgcn_sched_barrier(0); }
}
__device__ __forceinline__ void rw_pass1(const Ctx& c, const PA& a) {
    const unsigned char* ws = a.ws; LAS float* tile = (LAS float*)(c.lds + c.wave * (2 * RW_TS * 384 * 4));
    const int lane = c.lane;
    if (c.wave >= 4) return;
    for (int task = c.bx * 4 + c.wave; task < 16 * RW_NC; task += c.G * 4) {
        const int h = task / RW_NC, ch = task % RW_NC;
        f32x2 SP[32], SU[32]; int lz = lane; asm volatile("" : "+v"(lz));
#pragma unroll
        for (int j = 0; j < 32; ++j) { SP[j] = (f32x2){(2 * j == lz) ? 1.f : 0.f, (2 * j + 1 == lz) ? 1.f : 0.f}; SU[j] = (f32x2){0.f, 0.f}; }
        { RwRegs R; rw_stage_load(ws, R, ch * RW_CL, h, lane, false); rw_stage_store(tile, R, lane); }
        for (int ti = 0; ti < RW_CL / RW_TS; ++ti) { const int t0 = ch * RW_CL + ti * RW_TS; LAS float* tcur = tile + (ti & 1) * 3072; LAS float* tnxt = tile + ((ti + 1) & 1) * 3072;
            RwRegs R; if (ti + 1 < RW_CL / RW_TS) rw_stage_load(ws, R, t0 + RW_TS, h, lane, false);
            LDS_WAIT();
#pragma unroll 1
            for (int s = 0; s < RW_TS; ++s) { const LAS float* tp = tcur + s * 384; rw_step_dual(SP, SU, tp, tp[320 + lane]); }
            if (ti + 1 < RW_CL / RW_TS) rw_stage_store(tnxt, R, lane);
            LDS_WAIT();
        }
        float* op = (float*)(a.ws + WS_RWP) + ((size_t)task * 64 + lane) * 64; float* ou = (float*)(a.ws + WS_RWU) + ((size_t)task * 64 + lane) * 64;
#pragma unroll
        for (int jj = 0; jj < 16; ++jj) { *(f32x4*)(op + 4 * jj) = (f32x4){SP[2 * jj][0], SP[2 * jj][1], SP[2 * jj + 1][0], SP[2 * jj + 1][1]}; *(f32x4*)(ou + 4 * jj) = (f32x4){SU[2 * jj][0], SU[2 * jj][1], SU[2 * jj + 1][0], SU[2 * jj + 1][1]}; }
    }
}
#define RDL(v, l) __int_as_float(__builtin_amdgcn_readlane(__float_as_int(v), (l)))
__device__ __forceinline__ void rw_pass2(const Ctx& c, const PA& a) {
    const float* P = (const float*)(a.ws + WS_RWP); const float* U = (const float*)(a.ws + WS_RWU); float* Si = (float*)(a.ws + WS_RWS);
    LAS float* pb = (LAS float*)c.lds;
    const int lane = c.lane, w = c.wave, tid = c.tid;
    for (int unit = c.bx; unit < 256; unit += c.G) { const int h = unit >> 4, i = (unit & 15) * 4 + (w & 3); const size_t hc0 = (size_t)h * RW_NC;
        { const f32x4* src = (const f32x4*)(P + hc0 * 4096) + tid * 2; *(LAS f32x4*)(pb + tid * 8) = src[0]; *(LAS f32x4*)(pb + tid * 8 + 4) = src[1]; }
        float s = 0.f, u = U[(hc0 * 64 + i) * 64 + lane];
        __syncthreads();
        for (int ch = 0; ch < RW_NC; ++ch) { const LAS float* pc = pb + (ch & 1) * 4096 + lane;
            f32x4 n0 = (f32x4){0.f, 0.f, 0.f, 0.f}, n1 = n0; float un = 0.f;
            if (ch + 1 < RW_NC) { const f32x4* src = (const f32x4*)(P + (hc0 + ch + 1) * 4096) + tid * 2; n0 = src[0]; n1 = src[1]; un = U[((hc0 + ch + 1) * 64 + i) * 64 + lane]; }
            if (w < 4) { Si[((hc0 + ch) * 64 + i) * 64 + lane] = s;
                float a0 = u, a1 = 0.f, a2 = 0.f, a3 = 0.f;
#pragma unroll
                for (int i2 = 0; i2 < 64; i2 += 4) { a0 += RDL(s, i2) * pc[i2 * 64]; a1 += RDL(s, i2 + 1) * pc[(i2 + 1) * 64]; a2 += RDL(s, i2 + 2) * pc[(i2 + 2) * 64]; a3 += RDL(s, i2 + 3) * pc[(i2 + 3) * 64]; }
                s = (a0 + a1) + (a2 + a3); }
            { LAS float* dst = pb + ((ch + 1) & 1) * 4096 + tid * 8; *(LAS f32x4*)dst = n0; *(LAS f32x4*)(dst + 4) = n1; }
            u = un;
            __syncthreads(); }
    }
}
__device__ __forceinline__ void rw_pass3(const Ctx& c, const PA& a, int layer) {
    const unsigned char* ws = a.ws; LAS float* tile = (LAS float*)(c.lds + c.wave * 28800); LAS float* tg = tile + 6144; LAS float* ty = tg + 512; LAS float* trk = ty + 512; LAS float* tst = trk + 8;
    const float* Si = (const float*)(ws + WS_RWS); bf16* Y = (bf16*)(a.ws + WS_YRW); const float* r_k = a.in(14) + layer * 1024;
    const float* lng = a.in(15) + layer * 1024; const float* lnb = a.in(16) + layer * 1024;
    const int lane = c.lane;
    if (c.wave >= 4) return;
    for (int task = c.bx * 4 + c.wave; task < 16 * RW_NC; task += c.G * 4) {
        const int h = task / RW_NC, ch = task % RW_NC, col = h * 64 + lane;
        const float lg = lng[col], lb = lnb[col]; const f32x4 rk0 = *(const f32x4*)(r_k + h * 64 + 8 * (lane & 7)), rk1 = *(const f32x4*)(r_k + h * 64 + 8 * (lane & 7) + 4);
        f32x2 S[32]; const float* sp = Si + ((size_t)task * 64 + lane) * 64;
#pragma unroll
        for (int jj = 0; jj < 16; ++jj) { const f32x4 v = *(const f32x4*)(sp + 4 * jj); S[2 * jj] = (f32x2){v[0], v[1]}; S[2 * jj + 1] = (f32x2){v[2], v[3]}; }
        { RwRegs R; rw_stage_load(ws, R, ch * RW_CL, h, lane, true); rw_stage_store(tile, R, lane); rw_put8(tg + (lane >> 3) * 64 + 8 * (lane & 7), R.g); }
        for (int ti = 0; ti < RW_CL / RW_TS; ++ti) { const int t0 = ch * RW_CL + ti * RW_TS; LAS float* tcur = tile + (ti & 1) * 3072; LAS float* tnxt = tile + ((ti + 1) & 1) * 3072;
            RwRegs R; if (ti + 1 < RW_CL / RW_TS) rw_stage_load(ws, R, t0 + RW_TS, h, lane, true);
            LDS_WAIT();
            { const LAS float* rp = tcur + (lane >> 3) * 384 + 256 + 8 * (lane & 7); const LAS float* kp = tcur + (lane >> 3) * 384 + 192 + 8 * (lane & 7);
                const f32x4 r0 = *(const LAS f32x4*)rp, r1 = *(const LAS f32x4*)(rp + 4), k0 = *(const LAS f32x4*)kp, k1 = *(const LAS f32x4*)(kp + 4);
                float sm = ((r0[0] * k0[0] * rk0[0] + r0[1] * k0[1] * rk0[1]) + (r0[2] * k0[2] * rk0[2] + r0[3] * k0[3] * rk0[3])) + ((r1[0] * k1[0] * rk1[0] + r1[1] * k1[1] * rk1[1]) + (r1[2] * k1[2] * rk1[2] + r1[3] * k1[3] * rk1[3]));
                sm = sum_x1_2_4(sm); if ((lane & 7) == 0) trk[lane >> 3] = sm; }
#pragma unroll 1
            for (int s = 0; s < RW_TS; ++s) { const LAS float* tp = tcur + s * 384; const float vi = tp[320 + lane]; rw_step(S, tp, vi); ty[s * 64 + lane] = rw_dot_r(S, tp); }
            LDS_WAIT();
            { const LAS float* yp = ty + (lane >> 3) * 64 + 8 * (lane & 7); const f32x4 y0 = *(const LAS f32x4*)yp, y1 = *(const LAS f32x4*)(yp + 4);
                float sm = ((y0[0] + y0[1]) + (y0[2] + y0[3])) + ((y1[0] + y1[1]) + (y1[2] + y1[3]));
                sm = sum_x1_2_4(sm); const float mean = sm * (1.f / 64.f);
                const f32x4 d0 = y0 - mean, d1 = y1 - mean; float sq = ((d0[0] * d0[0] + d0[1] * d0[1]) + (d0[2] * d0[2] + d0[3] * d0[3])) + ((d1[0] * d1[0] + d1[1] * d1[1]) + (d1[2] * d1[2] + d1[3] * d1[3]));
                sq = sum_x1_2_4(sq);
                if ((lane & 7) == 0) { tst[2 * (lane >> 3)] = mean; tst[2 * (lane >> 3) + 1] = 1.f / sqrtf(sq * (1.f / 64.f) + 64e-5f); } }
            LDS_WAIT();
#pragma unroll
            for (int s = 0; s < RW_TS; ++s) { const float y = ty[s * 64 + lane], vi = tcur[s * 384 + 320 + lane], yn = (y - tst[2 * s]) * tst[2 * s + 1];
                Y[(size_t)(t0 + s) * 1024 + col] = (bf16)f2bf((yn * lg + lb + trk[s] * vi) * tg[s * 64 + lane]); }
            LDS_WAIT();
            if (ti + 1 < RW_CL / RW_TS) { rw_stage_store(tnxt, R, lane); rw_put8(tg + (lane >> 3) * 64 + 8 * (lane & 7), R.g); }
            LDS_WAIT();
        }
    }
}

__device__ __forceinline__ int ret_tok(int ks, int q, int i) { return 32 * ks + 4 * q + (i & 3) + ((i >> 2) << 4); }
__device__ __forceinline__ void prep_ret_frags(const Ctx& c, const PA& a, bool vonly = false) {
    unsigned char* ws = a.ws; bf16* proj = (bf16*)(ws + WS_PROJ); const float* cs = (const float*)(ws + WS_COS); const float* sn = (const float*)(ws + WS_SIN);
    LAS float* tile = (LAS float*)(c.lds + c.wave * 16896);
    const int lane = c.lane, r = lane & 15, q = lane >> 4;
    for (int it = c.gw; it < 8 * 128 * 4 * 2; it += c.NGW) { if (vonly && (it & 1)) continue; const int ten = it & 1, ks = (it >> 1) & 3, ch = (it >> 3) & 127, h = it >> 10; const int tb = ch * 128 + 32 * ks;
        if (ten == 0) {
#pragma unroll
            for (int i = 0; i < 8; ++i) { const int id = lane + 64 * i, row = id >> 4, c8 = (id & 15) * 8; const u32x4 v = *(const u32x4*)(proj + (size_t)(tb + row) * LDP + PC_RV + h * 128 + c8);
                LAS float* tp = tile + row * 132 + c8; *(LAS f32x4*)tp = (f32x4){bflo(v.x), bfhi(v.x), bflo(v.y), bfhi(v.y)}; *(LAS f32x4*)(tp + 4) = (f32x4){bflo(v.z), bfhi(v.z), bflo(v.w), bfhi(v.w)}; }
        } else {
#pragma unroll
            for (int i = 0; i < 4; ++i) { const int id = lane + 64 * i, row = id >> 3, c8 = (id & 7) * 8; bf16* kp = proj + (size_t)(tb + row) * LDP + PC_RK + h * 128 + c8;
                const u32x4 lo = *(const u32x4*)kp, hi = *(const u32x4*)(kp + 64);
                const f32x4 c0 = *(const f32x4*)(cs + (size_t)(tb + row) * 64 + c8), c1 = *(const f32x4*)(cs + (size_t)(tb + row) * 64 + c8 + 4), s0 = *(const f32x4*)(sn + (size_t)(tb + row) * 64 + c8), s1 = *(const f32x4*)(sn + (size_t)(tb + row) * 64 + c8 + 4);
                const float k1[8] = {bflo(lo.x), bfhi(lo.x), bflo(lo.y), bfhi(lo.y), bflo(lo.z), bfhi(lo.z), bflo(lo.w), bfhi(lo.w)}, k2[8] = {bflo(hi.x), bfhi(hi.x), bflo(hi.y), bfhi(hi.y), bflo(hi.z), bfhi(hi.z), bflo(hi.w), bfhi(hi.w)};
                float o1[8], o2[8];
#pragma unroll
                for (int j = 0; j < 8; ++j) { const float co = j < 4 ? c0[j] : c1[j - 4], si = j < 4 ? s0[j] : s1[j - 4];
                    o1[j] = bf2f((bf16)f2bf((k1[j] * co - k2[j] * si) * 0.08838834764831845f)); o2[j] = bf2f((bf16)f2bf((k1[j] * si + k2[j] * co) * 0.08838834764831845f)); }
                *(u32x4*)kp = (u32x4){pk2(o1[0], o1[1]), pk2(o1[2], o1[3]), pk2(o1[4], o1[5]), pk2(o1[6], o1[7])}; *(u32x4*)(kp + 64) = (u32x4){pk2(o2[0], o2[1]), pk2(o2[2], o2[3]), pk2(o2[4], o2[5]), pk2(o2[6], o2[7])};
                LAS float* tp = tile + row * 132 + c8;
                *(LAS f32x4*)tp = (f32x4){o1[0], o1[1], o1[2], o1[3]}; *(LAS f32x4*)(tp + 4) = (f32x4){o1[4], o1[5], o1[6], o1[7]}; *(LAS f32x4*)(tp + 64) = (f32x4){o2[0], o2[1], o2[2], o2[3]}; *(LAS f32x4*)(tp + 68) = (f32x4){o2[4], o2[5], o2[6], o2[7]}; }
        }
        LDS_WAIT();
        bf16* dst = (bf16*)(ws + (ten == 0 ? WS_VFR : WS_KTR)) + (((size_t)(h * 128 + ch) * 4 + ks) * 8) * 512 + lane * 8;
        float dec[8];
#pragma unroll
        for (int i = 0; i < 8; ++i) { const int tl = ret_tok(0, q, i); dec[i] = ten ? expf(RET_LOGG[h] * (float)(127 - (32 * ks + tl))) : 1.f; }
#pragma unroll
        for (int mt = 0; mt < 8; ++mt) { float v[8];
#pragma unroll
            for (int i = 0; i < 8; ++i) v[i] = tile[ret_tok(0, q, i) * 132 + 16 * mt + r] * dec[i];
            *(u32x4*)(dst + (size_t)mt * 512) = (u32x4){pk2(v[0], v[1]), pk2(v[2], v[3]), pk2(v[4], v[5]), pk2(v[6], v[7])}; }
        LDS_WAIT();
    }
}
__device__ __forceinline__ void ret_kv(const Ctx& c, const PA& a) {
    const bf16* VF = (const bf16*)(a.ws + WS_VFR); const bf16* KT = (const bf16*)(a.ws + WS_KTR); float* KV = (float*)(a.ws + WS_RETKV);
    const int lane = c.lane, r = lane & 15, q = lane >> 4;
    for (int task = c.gw; task < 128 * 8 * 8; task += c.NGW) { const int it = task >> 3, w = task & 7, ch = it >> 3, h = it & 7; const size_t fb = ((size_t)(h * 128 + ch) * 8) * 4 * 512 + lane * 8;
        f32x4 acc[8];
#pragma unroll
        for (int mt = 0; mt < 8; ++mt) acc[mt] = (f32x4){0.f, 0.f, 0.f, 0.f};
#pragma unroll
        for (int ks = 0; ks < 4; ++ks) { const bf16x8 kb = *(const bf16x8*)(KT + fb + (size_t)(ks * 8 + w) * 512);
#pragma unroll
            for (int mt = 0; mt < 8; ++mt) { const bf16x8 va = *(const bf16x8*)(VF + fb + (size_t)(ks * 8 + mt) * 512); acc[mt] = __builtin_amdgcn_mfma_f32_16x16x32_bf16(kb, va, acc[mt], 0, 0, 0); } }
        float* o = KV + ((size_t)it * 128 + r) * 128 + 16 * w + 4 * q;
#pragma unroll
        for (int mt = 0; mt < 8; ++mt) *(f32x4*)(o + (size_t)(16 * mt) * 128) = acc[mt];
    }
}
__device__ __forceinline__ void ret_prefix(const Ctx& c, const PA& a) {
    const float* KV = (const float*)(a.ws + WS_RETKV); bf16* RT = (bf16*)(a.ws + WS_RT);
    typedef float f32x2_ __attribute__((ext_vector_type(2)));
    for (int i = c.bx * 512 + c.tid; i < 8 * 8192; i += c.G * 512) { const int h = i >> 13, e = (i & 8191) * 2; const float cd = expf(RET_LOGG[h] * 128.f);
        float r0 = 0.f, r1 = 0.f;
        for (int c0 = 0; c0 < 128; c0 += 16) { f32x2_ tmp[16];
#pragma unroll
            for (int k = 0; k < 16; ++k) tmp[k] = *(const f32x2_*)(KV + ((size_t)((c0 + k) * 8 + h) << 14) + e);
#pragma unroll
            for (int k = 0; k < 16; ++k) { *(unsigned*)(RT + ((size_t)((c0 + k) * 8 + h) << 14) + e) = pk2(r0, r1); r0 = r0 * cd + tmp[k][0]; r1 = r1 * cd + tmp[k][1]; } } }
}
__device__ __forceinline__ void ret_out(const Ctx& c, const PA& a, int wv_first, int wv_count) {
    const bf16* proj = (const bf16*)(a.ws + WS_PROJ); const bf16* VF = (const bf16*)(a.ws + WS_VFR); const bf16* RT = (const bf16*)(a.ws + WS_RT); bf16* Y = (bf16*)(a.ws + WS_YRET);
    const int lane = c.lane, r = lane & 15, q = lane >> 4;
    if (c.wave < wv_first) return;
    for (int task = c.bx * wv_count + (c.wave - wv_first); task < 128 * 8 * 8; task += c.G * wv_count) { const int it = task >> 3, w = task & 7, ch = it >> 3, h = it & 7; const float lg2 = RET_LOGG[h] * 1.4426950408889634f;
        const int iq = 16 * w + r, tq = ch * 128 + iq;
        bf16x8 qb[4];
#pragma unroll
        for (int ks = 0; ks < 4; ++ks) qb[ks] = *(const bf16x8*)(proj + (size_t)tq * LDP + PC_RQ + h * 128 + 32 * ks + 8 * q);
        f32x4 oi[8], oc[8];
#pragma unroll
        for (int mt = 0; mt < 8; ++mt) { oi[mt] = (f32x4){0.f, 0.f, 0.f, 0.f}; oc[mt] = oi[mt]; }
        const size_t fb = ((size_t)(h * 128 + ch) * 8) * 4 * 512 + lane * 8;
#pragma unroll
        for (int ks = 0; ks < 4; ++ks) if (2 * ks <= w) { f32x4 st[2];
#pragma unroll
            for (int jj = 0; jj < 2; ++jj) { const int j = 2 * ks + jj; st[jj] = (f32x4){0.f, 0.f, 0.f, 0.f};
                if (j <= w) { const bf16* kp = proj + (size_t)(ch * 128 + 16 * j + r) * LDP + PC_RK + h * 128 + 8 * q;
#pragma unroll
                    for (int k2 = 0; k2 < 4; ++k2) st[jj] = __builtin_amdgcn_mfma_f32_16x16x32_bf16(*(const bf16x8*)(kp + 32 * k2), qb[k2], st[jj], 0, 0, 0);
#pragma unroll
                    for (int i = 0; i < 4; ++i) { const int d = iq - (16 * j + 4 * q + i); st[jj][i] = d >= 0 ? st[jj][i] * __builtin_amdgcn_exp2f(lg2 * (float)d) : 0.f; } } }
            const u32x4 pw = (u32x4){pg8::cvt_pk_bf16(st[0][0], st[0][1]), pg8::cvt_pk_bf16(st[0][2], st[0][3]), pg8::cvt_pk_bf16(st[1][0], st[1][1]), pg8::cvt_pk_bf16(st[1][2], st[1][3])};
            const bf16x8 pf = __builtin_bit_cast(bf16x8, pw);
#pragma unroll
            for (int mt = 0; mt < 8; ++mt) oi[mt] = __builtin_amdgcn_mfma_f32_16x16x32_bf16(*(const bf16x8*)(VF + fb + (size_t)(ks * 8 + mt) * 512), pf, oi[mt], 0, 0, 0);
            __builtin_amdgcn_sched_barrier(0); }
        const bf16* rp = RT + ((size_t)it * 128 + r) * 128 + 8 * q;
#pragma unroll
        for (int mt = 0; mt < 8; ++mt)
#pragma unroll
            for (int ks = 0; ks < 4; ++ks) { oc[mt] = __builtin_amdgcn_mfma_f32_16x16x32_bf16(*(const bf16x8*)(rp + (size_t)(16 * mt) * 128 + 32 * ks), qb[ks], oc[mt], 0, 0, 0); if (ks == 3 && (mt & 1)) __builtin_amdgcn_sched_barrier(0); }
        const float qd = __builtin_amdgcn_exp2f(lg2 * (float)(iq + 1));
        float sm = 0.f;
#pragma unroll
        for (int mt = 0; mt < 8; ++mt) { oi[mt] = oi[mt] + oc[mt] * qd; sm += (oi[mt][0] + oi[mt][1]) + (oi[mt][2] + oi[mt][3]); }
        sm = sum_x16_32(sm); const float mean = sm * (1.f / 128.f); float sq = 0.f;
#pragma unroll
        for (int mt = 0; mt < 8; ++mt) { oi[mt] = oi[mt] - mean; sq += (oi[mt][0] * oi[mt][0] + oi[mt][1] * oi[mt][1]) + (oi[mt][2] * oi[mt][2] + oi[mt][3] * oi[mt][3]); }
        sq = sum_x16_32(sq); const float rs = 1.f / sqrtf(sq * (1.f / 128.f) + 1e-5f);
        const bf16* gp = proj + (size_t)tq * LDP + PC_RG + h * 128 + 4 * q; bf16* yp = Y + (size_t)tq * 1024 + h * 128 + 4 * q;
#pragma unroll
        for (int mt = 0; mt < 8; ++mt) { const uint2 gw = *(const uint2*)(gp + 16 * mt); const float g0 = bflo(gw.x), g1 = bfhi(gw.x), g2 = bflo(gw.y), g3 = bfhi(gw.y);
            uint2 o; o.x = pg8::cvt_pk_bf16(g0 * sigm(g0) * oi[mt][0] * rs, g1 * sigm(g1) * oi[mt][1] * rs); o.y = pg8::cvt_pk_bf16(g2 * sigm(g2) * oi[mt][2] * rs, g3 * sigm(g3) * oi[mt][3] * rs);
            *(uint2*)(yp + 16 * mt) = o; }
    }
}


constexpr float NSA_C = 0.125f * 1.4426950408889634f;
constexpr float NSA_C8 = NSA_C * (1.f / 16.f);
struct NsaSrc { const bf16* kf; const bf16* vf; };

__device__ __forceinline__ void nsa_loadK(const NsaSrc& src, int key0, bf16x8 (&kf)[4][2], int lane) {
    const bf16* kp = src.kf + (size_t)(key0 >> 6) * 4096 + lane * 8;
#pragma unroll
    for (int j = 0; j < 4; ++j) { kf[j][0] = *(const bf16x8*)(kp + (2 * j) * 512); kf[j][1] = *(const bf16x8*)(kp + (2 * j + 1) * 512); }
}
__device__ __forceinline__ void nsa_loadV(const NsaSrc& src, int key0, bf16x8 (&vf)[4][2], int lane) {
    const bf16* vp = src.vf + (size_t)(key0 >> 6) * 4096 + lane * 8;
#pragma unroll
    for (int mt = 0; mt < 4; ++mt) { vf[mt][0] = *(const bf16x8*)(vp + (2 * mt) * 512); vf[mt][1] = *(const bf16x8*)(vp + (2 * mt + 1) * 512); }
}
__device__ __forceinline__ void nsa_qk(const bf16x8 (&kf)[4][2], const bf16x8 (&qf)[2], f32x4 (&st)[4]) {
#pragma unroll
    for (int j = 0; j < 4; ++j) { st[j] = (f32x4){0.f, 0.f, 0.f, 0.f};
        st[j] = __builtin_amdgcn_mfma_f32_16x16x32_bf16(kf[j][0], qf[0], st[j], 0, 0, 0); st[j] = __builtin_amdgcn_mfma_f32_16x16x32_bf16(kf[j][1], qf[1], st[j], 0, 0, 0); }
}
template <int MODE, bool MASKED>
__device__ __forceinline__ void nsa_rest(f32x4 (&st)[4], const bf16x8 (&vf)[4][2], int key0, int lo, int hi, f32x4 (&O)[4], float& m, float& l, float inv, int r, int q, LAS float* impA, LAS float* impB) {
    const float cm = NSA_C * m; float ps = 0.f;
#pragma unroll
    for (int j = 0; j < 4; ++j)
#pragma unroll
        for (int i = 0; i < 4; ++i) { float e = __builtin_amdgcn_exp2f(NSA_C * st[j][i] - cm);
            if (MASKED) { const int key = key0 + 16 * j + 4 * q + i; e = (key >= lo && key <= hi) ? e : 0.f; }
            st[j][i] = MODE == 2 ? e * inv : e; ps += e; }
    if (MODE != 2) l += ps;
    if (MODE == 2) {
#pragma unroll
        for (int j = 0; j < 4; ++j) { float a = (st[j][0] + st[j][1]) + (st[j][2] + st[j][3]), b = st[j][3];
            a = sum_x1_2(a); b = sum_x1_2(b);
            if ((r & 3) == 0) { const int J = (r >> 2) * 260 + (key0 >> 2) + 4 * j + q; atomicAdd((float*)(impA + J), a); atomicAdd((float*)(impA + J + 1), b); } } }
    if (MODE != 0) {
        bf16x8 pf[2];
#pragma unroll
        for (int ks = 0; ks < 2; ++ks) { const unsigned w0 = pg8::cvt_pk_bf16(st[2 * ks][0], st[2 * ks][1]), w1 = pg8::cvt_pk_bf16(st[2 * ks][2], st[2 * ks][3]),
                                                        w2 = pg8::cvt_pk_bf16(st[2 * ks + 1][0], st[2 * ks + 1][1]), w3 = pg8::cvt_pk_bf16(st[2 * ks + 1][2], st[2 * ks + 1][3]);
            const u32x4 w = (u32x4){w0, w1, w2, w3}; pf[ks] = __builtin_bit_cast(bf16x8, w); }
#pragma unroll
        for (int mt = 0; mt < 4; ++mt) {
#pragma unroll
            for (int ks = 0; ks < 2; ++ks) O[mt] = __builtin_amdgcn_mfma_f32_16x16x32_bf16(vf[mt][ks], pf[ks], O[mt], 0, 0, 0); } }
}
#define NSA_REST_(MODE, ST, VF, K0, LO, HI, LOU, HIU, INV) do { if ((K0) >= (LOU) && (K0) + 63 <= (HIU)) nsa_rest<MODE, false>(ST, VF, K0, LO, HI, O, m, l, INV, r, q, impA, impB);     \
        else nsa_rest<MODE, true>(ST, VF, K0, LO, HI, O, m, l, INV, r, q, impA, impB); } while (0)
#define NSA_LOOP(MODE, SRC, NBLK, KEY0, LO, HI, LOU, HIU, INV) do { const int nblk_ = (NBLK); if (nblk_ > 0) { bf16x8 kf_[4][2], vf_[4][2]; f32x4 st_[4]; nsa_loadK(SRC, KEY0(0), kf_, lane); \
    _Pragma("unroll 1") for (int b_ = 0; b_ < nblk_; ++b_) { const int k0_ = KEY0(b_); if (MODE != 0) nsa_loadV(SRC, k0_, vf_, lane); \
        nsa_qk(kf_, qf, st_); __builtin_amdgcn_sched_barrier(0); \
        if (b_ + 1 < nblk_) nsa_loadK(SRC, KEY0(b_ + 1), kf_, lane);     \
        NSA_REST_(MODE, st_, vf_, k0_, LO, HI, LOU, HIU, INV); } } } while (0)
typedef unsigned u32x2 __attribute__((ext_vector_type(2)));
__device__ __forceinline__ unsigned pack4_fp8(float a, float b, float c, float d) { int w = 0; w = __builtin_amdgcn_cvt_pk_fp8_f32(a, b, w, false); w = __builtin_amdgcn_cvt_pk_fp8_f32(c, d, w, true); return (unsigned)w; }
__device__ __forceinline__ void nsa_loadK8(const unsigned char* kf8, int key0, u32x4 (&k8)[4], int lane) {
    const unsigned char* kp = kf8 + (size_t)(key0 >> 6) * 4096 + lane * 16;
#pragma unroll
    for (int j = 0; j < 4; ++j) k8[j] = *(const u32x4*)(kp + j * 1024);
}
__device__ __forceinline__ void nsa_qk8(const u32x4 (&k8)[4], const long (&q8)[2], f32x4 (&st)[4]) {
#pragma unroll
    for (int j = 0; j < 4; ++j) st[j] = __builtin_amdgcn_mfma_f32_16x16x32_fp8_fp8(__builtin_bit_cast(long, (u32x2){k8[j].x, k8[j].y}), q8[0], (f32x4){0.f, 0.f, 0.f, 0.f}, 0, 0, 0);
#pragma unroll
    for (int j = 0; j < 4; ++j) st[j] = __builtin_amdgcn_mfma_f32_16x16x32_fp8_fp8(__builtin_bit_cast(long, (u32x2){k8[j].z, k8[j].w}), q8[1], st[j], 0, 0, 0);
}
__device__ __forceinline__ void nsa_loadV8(const unsigned char* vf8, int key0, u32x4 (&v8)[4], int lane) {
    const unsigned char* vp = vf8 + (size_t)(key0 >> 6) * 4096 + lane * 16;
#pragma unroll
    for (int mt = 0; mt < 4; ++mt) v8[mt] = *(const u32x4*)(vp + mt * 1024);
}
__device__ __forceinline__ void nsa_rest_dense(const f32x4 (&st)[4], const u32x4 (&v8)[4], f32x4 (&O)[4], float cm, float& l, int s4) {
    const bool i0 = s4 == 0, i1 = s4 == 1, i2 = s4 == 2, i3 = s4 == 3;
    const f32x4 x = i0 ? st[0] : (i1 ? st[1] : (i2 ? st[2] : st[3]));
    const float e0 = fminf(__builtin_amdgcn_exp2f(NSA_C8 * x[0] - cm), 416.f), e1 = fminf(__builtin_amdgcn_exp2f(NSA_C8 * x[1] - cm), 416.f), e2 = fminf(__builtin_amdgcn_exp2f(NSA_C8 * x[2] - cm), 416.f), e3 = fminf(__builtin_amdgcn_exp2f(NSA_C8 * x[3] - cm), 416.f);
    l += (e0 + e1) + (e2 + e3);
    const unsigned w = pack4_fp8(e0, e1, e2, e3);
    const long p0 = __builtin_bit_cast(long, (u32x2){i0 ? w : 0u, i1 ? w : 0u}), p1 = __builtin_bit_cast(long, (u32x2){i2 ? w : 0u, i3 ? w : 0u});
#pragma unroll
    for (int mt = 0; mt < 4; ++mt) O[mt] = __builtin_amdgcn_mfma_f32_16x16x32_fp8_fp8(__builtin_bit_cast(long, (u32x2){v8[mt].x, v8[mt].y}), p0, O[mt], 0, 0, 0);
#pragma unroll
    for (int mt = 0; mt < 4; ++mt) O[mt] = __builtin_amdgcn_mfma_f32_16x16x32_fp8_fp8(__builtin_bit_cast(long, (u32x2){v8[mt].z, v8[mt].w}), p1, O[mt], 0, 0, 0);
}
__device__ __forceinline__ void nsa_v8_to_bf16(const u32x4 (&v8)[4], bf16x8 (&vf)[4][2]) {
    typedef float f32x2v __attribute__((ext_vector_type(2)));
#pragma unroll
    for (int mt = 0; mt < 4; ++mt)
#pragma unroll
        for (int ks = 0; ks < 2; ++ks) { const int d0 = (int)v8[mt][2 * ks], d1 = (int)v8[mt][2 * ks + 1];
            const f32x2v a = __builtin_amdgcn_cvt_pk_f32_fp8(d0, false), b = __builtin_amdgcn_cvt_pk_f32_fp8(d0, true), c2 = __builtin_amdgcn_cvt_pk_f32_fp8(d1, false), d = __builtin_amdgcn_cvt_pk_f32_fp8(d1, true);
            const u32x4 w = (u32x4){pg8::cvt_pk_bf16(a.x, a.y), pg8::cvt_pk_bf16(b.x, b.y), pg8::cvt_pk_bf16(c2.x, c2.y), pg8::cvt_pk_bf16(d.x, d.y)}; vf[mt][ks] = __builtin_bit_cast(bf16x8, w); }
}
#define NSA_LOOP_V8(MODE, SRC, V8, NBLK, KEY0, LO, HI, LOU, HIU, INV) do { const int nblk_ = (NBLK); if (nblk_ > 0) { bf16x8 kf_[4][2], vf_[4][2]; u32x4 v8_[4]; f32x4 st_[4]; nsa_loadK(SRC, KEY0(0), kf_, lane); \
    _Pragma("unroll 1") for (int b_ = 0; b_ < nblk_; ++b_) { const int k0_ = KEY0(b_); nsa_loadV8(V8, k0_, v8_, lane); \
        nsa_qk(kf_, qf, st_); __builtin_amdgcn_sched_barrier(0); \
        if (b_ + 1 < nblk_) nsa_loadK(SRC, KEY0(b_ + 1), kf_, lane); \
        nsa_v8_to_bf16(v8_, vf_); \
        NSA_REST_(MODE, st_, vf_, k0_, LO, HI, LOU, HIU, INV); } } } while (0)
#define NSA_LOOP_DENSE(K8, V8, NBLK, KEY0, QD, CM, L, S4, KF, VA) do { const int nblk_ = (NBLK); if (nblk_ > 0) { u32x4 vb_[4]; f32x4 st_[4];     \
    _Pragma("unroll 1") for (int b_ = 0; b_ < nblk_; b_ += 2) { \
        if (b_ + 1 < nblk_) nsa_loadV8(V8, KEY0(b_ + 1), vb_, lane); \
        nsa_qk8(KF, QD, st_); __builtin_amdgcn_sched_barrier(0); \
        if (b_ + 1 < nblk_) nsa_loadK8(K8, KEY0(b_ + 1), KF, lane); \
        nsa_rest_dense(st_, VA, O, CM, L, S4); \
        if (b_ + 1 >= nblk_) break; \
        __builtin_amdgcn_sched_barrier(0); \
        if (b_ + 2 < nblk_) nsa_loadV8(V8, KEY0(b_ + 2), VA, lane); \
        nsa_qk8(KF, QD, st_); __builtin_amdgcn_sched_barrier(0); \
        if (b_ + 2 < nblk_) nsa_loadK8(K8, KEY0(b_ + 2), KF, lane); \
        nsa_rest_dense(st_, vb_, O, CM, L, S4); __builtin_amdgcn_sched_barrier(0); } } } while (0)
__device__ __forceinline__ float lane_get(float v, int src) { return __int_as_float(__builtin_amdgcn_ds_bpermute(src << 2, __float_as_int(v))); }
constexpr int NSA2_WLDS = 4352;
__device__ __forceinline__ void nsa_attn2(const Ctx& c, const PA& a, int layer) {
    const unsigned char* ws = a.ws; const bf16* proj = (const bf16*)(ws + WS_PROJ); bf16* Y = (bf16*)(a.ws + WS_YNSA);
    LAS float* impA = (LAS float*)(c.lds + (c.wave < 4 ? c.wave * 24576 : 4 * 24576 + (c.wave - 4) * NSA2_WLDS));     LAS float* impB = impA; LAS int* KST = (LAS int*)(impA + 1040);
    const int lane = c.lane, r = lane & 15, q = lane >> 4, tk = r >> 2, hh = r & 3;
    const bool xdeal = (c.G & 7) == 0; const int xg = c.bx & 7, ntask = xdeal ? T / 8 : T; unsigned* qctr = (unsigned*)(a.ws + WS_CTL) + CW_NSAQ + (xdeal ? xg : 0) * 64 + layer * 1024;
    unsigned tk_ = 0; if (lane == 0) tk_ = __hip_atomic_fetch_add(qctr, 1u, __ATOMIC_RELAXED, __HIP_MEMORY_SCOPE_AGENT);
    for (;;) { const int task = (int)__builtin_amdgcn_readfirstlane(tk_); if (task >= ntask) break;
        if (lane == 0) tk_ = __hip_atomic_fetch_add(qctr, 1u, __ATOMIC_RELAXED, __HIP_MEMORY_SCOPE_AGENT);
        const int rt = ntask - 1 - task, tq = xdeal ? 2 * rt + (xg >> 2) : rt >> 2, g = xdeal ? (xg & 3) : (rt & 3), t0 = 4 * tq, tcol = t0 + tk;
        const bf16* prow = proj + (size_t)tcol * LDP;
        bf16x8 qf[2]; { const bf16* qp = prow + PC_NQ + (g * 4 + hh) * 64 + 8 * q; qf[0] = *(const bf16x8*)qp; qf[1] = *(const bf16x8*)(qp + 32); }
        float gt0, gt1, gt2; { const bf16* gp = prow + PC_GATE + (g * 4 + hh) * 3; gt0 = sigm(bf2f(gp[0])); gt1 = sigm(bf2f(gp[1])); gt2 = sigm(bf2f(gp[2])); }
        float qn; { float f0[8], f1[8], sq = 0.f; un8(__builtin_bit_cast(u32x4, qf[0]), f0); un8(__builtin_bit_cast(u32x4, qf[1]), f1);
#pragma unroll
            for (int i = 0; i < 8; ++i) sq += f0[i] * f0[i] + f1[i] * f1[i];
            qn = sqrtf(sum_x16_32(sq)); }
        float kmx[3]; { const unsigned* kw = (const unsigned*)(ws + WS_CTL) + CW_KMAX + layer * 64 + g;
            kmx[0] = __uint_as_float(kw[0]); kmx[1] = __uint_as_float(kw[4]); kmx[2] = __uint_as_float(kw[8]); }
        const int cur = t0 >> 6, ncv = tcol >= 31 ? ((tcol - 31) >> 4) + 1 : 0, ncvmax = t0 + 3 >= 31 ? ((t0 + 3 - 31) >> 4) + 1 : 0;
#pragma unroll
        for (int i = 0; i < 17; ++i) if (lane + 64 * i < 1040) impA[lane + 64 * i] = 0.f;
        LDS_WAIT();
        f32x4 yacc[4], O[4];
#pragma unroll
        for (int mt = 0; mt < 4; ++mt) yacc[mt] = (f32x4){0.f, 0.f, 0.f, 0.f};
        if (ncvmax > 0) {
            NsaSrc sc; sc.kf = (const bf16*)(ws + WS_KCMPB) + (size_t)g * 16 * 4096; sc.vf = (const bf16*)(ws + WS_VCMPT) + (size_t)g * 16 * 4096;
            const int nb = (ncvmax + 63) >> 6; float m = qn * kmx[2], l = 0.f;
#define K0_CMP(b) (64 * (b))
            const int ncvmin = t0 >= 31 ? ((t0 - 31) >> 4) + 1 : 0;
            NSA_LOOP(0, sc, nb, K0_CMP, 0, ncv - 1, 0, ncvmin - 1, 0.f);
            l = sum_x16_32(l); const float inv = l > 0.f ? 1.f / l : 0.f;
#pragma unroll
            for (int mt = 0; mt < 4; ++mt) O[mt] = (f32x4){0.f, 0.f, 0.f, 0.f};
            { const unsigned char* vc8 = ws + WS_VC8 + (size_t)g * 16 * 4096; NSA_LOOP_V8(2, sc, vc8, nb, K0_CMP, 0, ncv - 1, 0, ncvmin - 1, inv); }
#pragma unroll
            for (int mt = 0; mt < 4; ++mt) yacc[mt] = O[mt] * (0.25f * gt0);
        }
        LDS_WAIT();
        const unsigned char* ss8 = ws + WS_KF8 + (size_t)g * 256 * 4096; const unsigned char* sv8 = ws + WS_VF8 + (size_t)g * 256 * 4096;
        NsaSrc ss; ss.kf = (const bf16*)(ws + WS_KFS) + (size_t)g * 256 * 4096; ss.vf = (const bf16*)(ws + WS_VFS) + (size_t)g * 256 * 4096;
        f32x4 Oj[4]; const float mj = qn * kmx[0]; float lj = 0.f; const int nf = cur >= 2 ? 3 : cur + 1;
        { float m = mj, l = 0.f;
#pragma unroll
            for (int mt = 0; mt < 4; ++mt) O[mt] = (f32x4){0.f, 0.f, 0.f, 0.f};
#define K0_FRC(b) (64 * ((b) == 0 ? 0 : cur - (nf - 1) + (b)))
            NSA_LOOP(1, ss, nf, K0_FRC, 0, tcol, 0, t0, 0.f);
#pragma unroll
            for (int mt = 0; mt < 4; ++mt) Oj[mt] = O[mt];
            lj = l; }
        const float ljs = sum_x16_32(lj);
#pragma unroll 1
        for (int k = 0; k < 4; ++k) {
            const int hd = r >> 2, s4 = r & 3;
            bf16x8 qd[2]; { const bf16* qp = proj + (size_t)(t0 + k) * LDP + PC_NQ + (g * 4 + hd) * 64 + 8 * q; qd[0] = *(const bf16x8*)qp; qd[1] = *(const bf16x8*)(qp + 32); }
            u32x4 kfp[4], vap[4];
            float scv[4];
#pragma unroll
            for (int mm = 0; mm < 4; ++mm) { const int j = 4 * lane + mm; float s = -1.0e30f;
                if (j <= cur && !(j == 0 || j == cur || j == cur - 1)) s = impA[k * 260 + j];
                scv[mm] = s; }
            int nsel = 0;
            for (int itk = 0; itk < 16 - nf; ++itk) {
                float lv = scv[0]; int lj2 = 4 * lane;
                if (scv[1] > lv) { lv = scv[1]; lj2 = 4 * lane + 1; } if (scv[2] > lv) { lv = scv[2]; lj2 = 4 * lane + 2; } if (scv[3] > lv) { lv = scv[3]; lj2 = 4 * lane + 3; }
                const float vmax = wave_max(lv); if (vmax < -5.0e29f) break;
                const int jmin = wave_min_i(lv == vmax ? lj2 : (1 << 30));
                if (lane == 0) KST[itk] = jmin * 64;
                if (itk == 0) { const int k0f = __builtin_amdgcn_readfirstlane(jmin) * 64; nsa_loadK8(ss8, k0f, kfp, lane); nsa_loadV8(sv8, k0f, vap, lane); }
                if ((jmin >> 2) == lane) { const int mm = jmin & 3; if (mm == 0) scv[0] = -3.0e38f; else if (mm == 1) scv[1] = -3.0e38f; else if (mm == 2) scv[2] = -3.0e38f; else scv[3] = -3.0e38f; }
                ++nsel; }
            LDS_WAIT();
            { const bool mine = tk == k; const int srcl = (lane & 48) | (hh << 2) | tk;
                long q8[2];
#pragma unroll
                for (int ks = 0; ks < 2; ++ks) { float f[8]; un8(__builtin_bit_cast(u32x4, qd[ks]), f); q8[ks] = __builtin_bit_cast(long, (u32x2){pack4_fp8(4.f * f[0], 4.f * f[1], 4.f * f[2], 4.f * f[3]), pack4_fp8(4.f * f[4], 4.f * f[5], 4.f * f[6], 4.f * f[7])}); }
                const int srck = (lane & 48) | (k << 2) | hd;
                const float ljk = lane_get(ljs, srck), nj = (float)(129 + t0 + k - 64 * cur);
                const float kap = ljk > 0.f ? fminf(fmaxf(1.f + __builtin_amdgcn_logf(nj) - __builtin_amdgcn_logf(ljk), 0.f), 100.f) : 0.f, sk = __builtin_amdgcn_exp2f(-kap);
                const float cmd = NSA_C * lane_get(mj, srck) - kap;
                float ld = 0.f;
#pragma unroll
                for (int mt = 0; mt < 4; ++mt) O[mt] = (f32x4){0.f, 0.f, 0.f, 0.f};
#define K0_SEL(b) (__builtin_amdgcn_readfirstlane(KST[b]))
                NSA_LOOP_DENSE(ss8, sv8, nsel, K0_SEL, q8, cmd, ld, s4, kfp, vap);
                ld = sum_x16_32(sum_x1_2(ld)) * sk;
                const float l = ljs + lane_get(ld, srcl), sc = mine ? gt1 / l : 0.f;
#pragma unroll
                for (int mt = 0; mt < 4; ++mt)
#pragma unroll
                    for (int i = 0; i < 4; ++i) { const float od = lane_get(sum_x1_2(O[mt][i]) * (0.25f * sk), srcl);        yacc[mt][i] += (Oj[mt][i] + od) * sc; } }
            LDS_WAIT();
        }
        { NsaSrc sw; sw.kf = (const bf16*)(ws + WS_KFW) + (size_t)g * 256 * 4096; sw.vf = (const bf16*)(ws + WS_VFW) + (size_t)g * 256 * 4096;
            { const bf16* qp = prow + PC_NQ + (g * 4 + hh) * 64 + 8 * q; qf[0] = *(const bf16x8*)qp; qf[1] = *(const bf16x8*)(qp + 32); }
            float m = qn * kmx[1], l = 0.f; const int wlo = tcol - 511 > 0 ? tcol - 511 : 0, ulo = t0 - 511 > 0 ? t0 - 511 : 0;
#pragma unroll
            for (int mt = 0; mt < 4; ++mt) O[mt] = (f32x4){0.f, 0.f, 0.f, 0.f};
            const int jb0 = ulo >> 6;
#define K0_WIN(b) (64 * (jb0 + (b)))
            { const unsigned char* vw8 = ws + WS_VW8 + (size_t)g * 256 * 4096; NSA_LOOP_V8(1, sw, vw8, cur - jb0 + 1, K0_WIN, wlo, tcol, (t0 + 3 - 511 > 0 ? t0 + 3 - 511 : 0), t0, 0.f); }
            l = sum_x16_32(l); const float sc = 0.25f * gt2 / l;
#pragma unroll
            for (int mt = 0; mt < 4; ++mt) yacc[mt] += O[mt] * sc; }
#pragma unroll
        for (int mt = 0; mt < 4; ++mt) { uint2 w; w.x = pg8::cvt_pk_bf16(yacc[mt][0], yacc[mt][1]); w.y = pg8::cvt_pk_bf16(yacc[mt][2], yacc[mt][3]);
            *(uint2*)(Y + (size_t)tcol * 1024 + (g * 4 + hh) * 64 + 16 * mt + 4 * q) = w; }
    }
}
__device__ __forceinline__ void prep_tiles(const Ctx& c, const PA& a, int layer) {
    const bf16* proj = (const bf16*)(a.ws + WS_PROJ);
    LAS bf16* tile = (LAS bf16*)(c.lds + c.wave * 8704);
    const int lane = c.lane, r = lane & 15, q = lane >> 4;
    for (int it = c.gw; it < 4 * 4 * 256; it += c.NGW) { const int blk = it & 255, g = (it >> 8) & 3, ten = it >> 10;
        const int scol = (ten == 0 ? PC_KS : (ten == 1 ? PC_VS : (ten == 2 ? PC_KW : PC_VW))) + g * 64;
        const u32x4* sp = (const u32x4*)(proj + (size_t)(blk * 64 + lane) * LDP + scol);
        float nq_ = 0.f;
#pragma unroll
        for (int i = 0; i < 8; ++i) { const u32x4 v = sp[i]; LAS unsigned* tp = (LAS unsigned*)(tile + lane * 66 + 8 * i); tp[0] = v.x; tp[1] = v.y; tp[2] = v.z; tp[3] = v.w;
            float f[8]; un8(v, f);
#pragma unroll
            for (int j = 0; j < 8; ++j) nq_ += f[j] * f[j]; }
        if ((ten & 1) == 0) { const float nm = wave_max(sqrtf(nq_)); if (lane == 0) atomicMax((unsigned*)(a.ws + WS_CTL) + CW_KMAX + layer * 64 + (ten >> 1) * 4 + g, __float_as_uint(nm)); }
        LDS_WAIT();
        bf16* dst = (bf16*)(a.ws + (ten == 0 ? WS_KFS : (ten == 1 ? WS_VFS : (ten == 2 ? WS_KFW : WS_VFW)))) + ((size_t)(g * 256 + blk) * 8) * 512 + lane * 8;
        if (ten == 0) {
            unsigned char* d8 = a.ws + WS_KF8 + ((size_t)(g * 256 + blk) * 4) * 1024 + lane * 16;
#pragma unroll
            for (int j = 0; j < 4; ++j) { unsigned w[4];
#pragma unroll
                for (int ks = 0; ks < 2; ++ks) { const LAS unsigned* tp = (const LAS unsigned*)(tile + (16 * j + r) * 66 + 32 * ks + 8 * q); float f[8]; un8((u32x4){tp[0], tp[1], tp[2], tp[3]}, f);
                    w[2 * ks] = pack4_fp8(4.f * f[0], 4.f * f[1], 4.f * f[2], 4.f * f[3]); w[2 * ks + 1] = pack4_fp8(4.f * f[4], 4.f * f[5], 4.f * f[6], 4.f * f[7]); }
                *(u32x4*)(d8 + j * 1024) = (u32x4){w[0], w[1], w[2], w[3]}; } }
        if (ten & 1) {
            unsigned char* d8 = a.ws + (ten == 1 ? WS_VF8 : WS_VW8) + ((size_t)(g * 256 + blk) * 4) * 1024 + lane * 16;
#pragma unroll
            for (int mt = 0; mt < 4; ++mt) { unsigned w[4];
#pragma unroll
                for (int ks = 0; ks < 2; ++ks)
#pragma unroll
                    for (int h = 0; h < 2; ++h) { const int k0 = 32 * ks + 16 * h + 4 * q; const LAS bf16* tp = tile + k0 * 66 + 16 * mt + r;
                        w[2 * ks + h] = pack4_fp8(4.f * bf2f(tp[0]), 4.f * bf2f(tp[66]), 4.f * bf2f(tp[132]), 4.f * bf2f(tp[198])); }
                *(u32x4*)(d8 + mt * 1024) = (u32x4){w[0], w[1], w[2], w[3]}; } }
        if ((ten & 1) == 0) {
#pragma unroll
            for (int j = 0; j < 4; ++j)
#pragma unroll
                for (int ks = 0; ks < 2; ++ks) { const LAS unsigned* tp = (const LAS unsigned*)(tile + (16 * j + r) * 66 + 32 * ks + 8 * q);
                    *(u32x4*)(dst + (2 * j + ks) * 512) = (u32x4){tp[0], tp[1], tp[2], tp[3]}; }
        } else {
#pragma unroll
            for (int mt = 0; mt < 4; ++mt)
#pragma unroll
                for (int ks = 0; ks < 2; ++ks) { unsigned w[4];
#pragma unroll
                    for (int h = 0; h < 2; ++h)
#pragma unroll
                        for (int i2 = 0; i2 < 2; ++i2) { const int k0 = 32 * ks + 16 * h + 4 * q + 2 * i2;
                            w[2 * h + i2] = (unsigned)tile[k0 * 66 + 16 * mt + r] | ((unsigned)tile[(k0 + 1) * 66 + 16 * mt + r] << 16); }
                    *(u32x4*)(dst + (2 * mt + ks) * 512) = (u32x4){w[0], w[1], w[2], w[3]}; }
        }
        LDS_WAIT();
    }
}

__device__ __forceinline__ void ln_row(f32x4 (&v)[8], const float* gam, const float* bet, int lane) {
    float s = 0.f;
#pragma unroll
    for (int j = 0; j < 8; ++j) s += (v[j][0] + v[j][1]) + (v[j][2] + v[j][3]);
    const float mean = wave_sum(s) * (1.f / D); float s2 = 0.f;
#pragma unroll
    for (int j = 0; j < 8; ++j) { v[j] = v[j] - mean; s2 += (v[j][0] * v[j][0] + v[j][1] * v[j][1]) + (v[j][2] * v[j][2] + v[j][3] * v[j][3]); }
    const float rstd = 1.f / sqrtf(wave_sum(s2) * (1.f / D) + LN_EPS);
#pragma unroll
    for (int j = 0; j < 8; ++j) { const f32x4 g4 = *(const f32x4*)(gam + 4 * (lane + 64 * j)), b4 = *(const f32x4*)(bet + 4 * (lane + 64 * j)); v[j] = v[j] * rstd * g4 + b4; }
}
__device__ __forceinline__ void ph_ln1(const Ctx& c, const PA& a, int layer) {
    unsigned char* ws = a.ws; float* X = a.out; uint2* xb = (uint2*)(ws + WS_XB); const int lane = c.lane;
    for (int it = c.bx; it < T / 8; it += c.G) { const int t = it * 8 + c.wave;
        f32x4* row = (f32x4*)(X + (size_t)t * D); f32x4 v[8];
#pragma unroll
        for (int j = 0; j < 8; ++j) v[j] = row[lane + 64 * j];
        ln_row(v, a.in(25) + layer * D, a.in(26) + layer * D, lane);
#pragma unroll
        for (int j = 0; j < 8; ++j) { row[lane + 64 * j] = v[j]; xb[(size_t)t * (D / 4) + lane + 64 * j] = make_uint2(pk2(v[j][0], v[j][1]), pk2(v[j][2], v[j][3])); } }
}
__device__ __forceinline__ void ph_route(const Ctx& c, const PA& a, int layer) {
    unsigned char* ws = a.ws; const float* X = a.out;
    LAS float* lg = (LAS float*)(c.lds + c.wave * 256); LAS float* xr = (LAS float*)(c.lds + 4096 + c.wave * 8192); LAS float* wb = (LAS float*)(c.lds + 4096 + 65536);
    const int lane = c.lane, tid = c.tid, r0 = tid >> 3, p0_ = tid & 7;
    for (int it = c.bx; it < T / 8; it += c.G) { const int t = it * 8 + c.wave;
        const float* we = a.in(29) + (size_t)layer * D * 32; const float* wg = a.in(27) + (size_t)layer * D * 4;
        { const f32x4* row = (const f32x4*)(X + (size_t)t * D);
#pragma unroll
            for (int j = 0; j < 8; ++j) *(LAS f32x4*)(xr + 4 * (lane + 64 * j)) = row[lane + 64 * j];
#pragma unroll
            for (int i = 0; i < 4; ++i) *(LAS f32x4*)(wb + (r0 + 64 * i) * 36 + 4 + 4 * p0_) = *(const f32x4*)(we + (size_t)(r0 + 64 * i) * 32 + 4 * p0_);
            if (tid < 256) *(LAS f32x4*)(wb + tid * 36) = *(const f32x4*)(wg + (size_t)tid * 4); }
        __syncthreads();
        f32x4 acc[9];
#pragma unroll
        for (int q = 0; q < 9; ++q) acc[q] = (f32x4){0.f, 0.f, 0.f, 0.f};
#pragma unroll 1
        for (int ck = 0; ck < 8; ++ck) { const LAS float* wc = wb + (ck & 1) * 9216; LAS float* wn = wb + ((ck + 1) & 1) * 9216;
            const int d0 = ck + 1 < 8 ? 256 * (ck + 1) : 0;
            const f32x4 ne0 = *(const f32x4*)(we + (size_t)(d0 + r0) * 32 + 4 * p0_), ne1 = *(const f32x4*)(we + (size_t)(d0 + r0 + 64) * 32 + 4 * p0_),
                        ne2 = *(const f32x4*)(we + (size_t)(d0 + r0 + 128) * 32 + 4 * p0_), ne3 = *(const f32x4*)(we + (size_t)(d0 + r0 + 192) * 32 + 4 * p0_), ng = *(const f32x4*)(wg + (size_t)(d0 + (tid & 255)) * 4);
#pragma unroll
            for (int i = 0; i < 4; ++i) { const int dl = lane + 64 * i; const float x = xr[256 * ck + dl]; const LAS float* wr = wc + dl * 36;
#pragma unroll
                for (int q = 0; q < 9; ++q) acc[q] += *(const LAS f32x4*)(wr + 4 * q) * x;
                __builtin_amdgcn_sched_barrier(0); }
            *(LAS f32x4*)(wn + r0 * 36 + 4 + 4 * p0_) = ne0; *(LAS f32x4*)(wn + (r0 + 64) * 36 + 4 + 4 * p0_) = ne1; *(LAS f32x4*)(wn + (r0 + 128) * 36 + 4 + 4 * p0_) = ne2; *(LAS f32x4*)(wn + (r0 + 192) * 36 + 4 + 4 * p0_) = ne3;
            if (tid < 256) *(LAS f32x4*)(wn + tid * 36) = ng;
            __syncthreads(); }
        f32x4 ag = acc[0];
#pragma unroll
        for (int q = 0; q < 4; ++q) ag[q] = wave_sum(ag[q]) + a.in(28)[layer * 4 + q];
#pragma unroll
        for (int e4 = 0; e4 < 8; ++e4)
#pragma unroll
            for (int q = 0; q < 4; ++q) acc[1 + e4][q] = wave_sum(acc[1 + e4][q]);
        if (lane == 0) {
#pragma unroll
            for (int e4 = 0; e4 < 8; ++e4)
#pragma unroll
                for (int q = 0; q < 4; ++q) lg[e4 * 4 + q] = acc[1 + e4][q] + a.in(30)[layer * 32 + e4 * 4 + q]; }
        LDS_WAIT();
        int grp = 0; float gm = ag[0];
        if (ag[1] > gm) { gm = ag[1]; grp = 1; } if (ag[2] > gm) { gm = ag[2]; grp = 2; } if (ag[3] > gm) { gm = ag[3]; grp = 3; }
        const float gw_ = 1.f / (expf(ag[0] - gm) + expf(ag[1] - gm) + expf(ag[2] - gm) + expf(ag[3] - gm));
        float v0 = -3.0e38f, v1 = -3.0e38f; int i0 = 0, i1 = 0;
        for (int i = 0; i < 8; ++i) { const float x = lg[grp * 8 + i];
            if (x > v0) { v1 = v0; i1 = i0; v0 = x; i0 = i; } else if (x > v1) { v1 = x; i1 = i; } }
        const float e1 = expf(v1 - v0), p0 = 1.f / (1.f + e1), p1 = e1 * p0;
        if (lane == 0) { int* toke = (int*)(ws + WS_TOKE); float* tokw = (float*)(ws + WS_TOKW); unsigned* cnt = (unsigned*)(ws + WS_CTL) + CW_CNT + layer * 128; toke[2 * t] = grp * 8 + i0; toke[2 * t + 1] = grp * 8 + i1; tokw[2 * t] = p0 * gw_; tokw[2 * t + 1] = p1 * gw_;
            __hip_atomic_fetch_add(cnt + grp * 8 + i0, 1u, __ATOMIC_RELAXED, __HIP_MEMORY_SCOPE_AGENT); __hip_atomic_fetch_add(cnt + grp * 8 + i1, 1u, __ATOMIC_RELAXED, __HIP_MEMORY_SCOPE_AGENT); }
        __syncthreads();
    }
}
__device__ __forceinline__ void ph_slot(const Ctx& c, const PA& a, int layer) {
    unsigned char* ws = a.ws; unsigned* cnt = (unsigned*)(ws + WS_CTL) + CW_CNT + layer * 128; unsigned* cur = (unsigned*)(ws + WS_CTL) + CW_CUR + layer * 128;
    int* texp = (int*)(ws + WS_TEXP) + layer * 512; const int* toke = (const int*)(ws + WS_TOKE); int* slot = (int*)(ws + WS_SLOT);
    LAS int* pst = (LAS int*)c.lds;
    if (c.tid == 0) { int off = 0, nt = 0;
#pragma unroll 1
        for (int e = 0; e < NEXP; ++e) { const int n = (int)__hip_atomic_load(cnt + e, __ATOMIC_RELAXED, __HIP_MEMORY_SCOPE_AGENT), tl = (n + 255) >> 8;
            pst[e] = off; off += tl * 256;
            if (c.bx == 0) for (int q = 0; q < tl; ++q) texp[nt + q] = e;
            nt += tl; }
        if (c.bx == 0) texp[255] = nt; }
    __syncthreads();
    const u32x4* xb = (const u32x4*)(ws + WS_XB); u32x4* xs = (u32x4*)(ws + WS_XS);
    for (int a0 = c.gw * 16; a0 < 2 * T; a0 += c.NGW * 16) {
        int s = 0;
        if (c.lane < 16) { const int e = toke[a0 + c.lane]; s = pst[e] + (int)__hip_atomic_fetch_add(cur + e, 1u, __ATOMIC_RELAXED, __HIP_MEMORY_SCOPE_AGENT); slot[a0 + c.lane] = s; }
#pragma unroll 2
        for (int i = 0; i < 16; i += 2) { const int s0 = __builtin_amdgcn_readlane(s, i), s1 = __builtin_amdgcn_readlane(s, i + 1), t0 = (a0 + i) >> 1, t1 = (a0 + i + 1) >> 1;
            u32x4 v0[4], v1[4];
#pragma unroll
            for (int j = 0; j < 4; ++j) { v0[j] = xb[(size_t)t0 * 256 + c.lane + 64 * j]; v1[j] = xb[(size_t)t1 * 256 + c.lane + 64 * j]; }
#pragma unroll
            for (int j = 0; j < 4; ++j) { xs[(size_t)s0 * 256 + c.lane + 64 * j] = v0[j]; xs[(size_t)s1 * 256 + c.lane + 64 * j] = v1[j]; } } }
}
__device__ __forceinline__ void ph_ln2(const Ctx& c, const PA& a, int layer) {
    unsigned char* ws = a.ws; float* X = a.out; uint2* xb = (uint2*)(ws + WS_XB); const uint2* ys = (const uint2*)(ws + WS_YS);
    const float* gam = a.in(34) + layer * D; const float* bet = a.in(35) + layer * D; const int* slot = (const int*)(ws + WS_SLOT); const float* tokw = (const float*)(ws + WS_TOKW);
    const int lane = c.lane;
    for (int t = c.gw; t < T; t += c.NGW) {
        const int s0 = slot[2 * t], s1 = slot[2 * t + 1]; const float w0 = tokw[2 * t], w1 = tokw[2 * t + 1];
        f32x4* row = (f32x4*)(X + (size_t)t * D); f32x4 v[8];
#pragma unroll
        for (int j = 0; j < 8; ++j) { const uint2 y0 = ys[(size_t)s0 * 512 + lane + 64 * j], y1 = ys[(size_t)s1 * 512 + lane + 64 * j]; const f32x4 x = row[lane + 64 * j];
            v[j][0] = x[0] * DN_ALPHA + w0 * bflo(y0.x) + w1 * bflo(y1.x); v[j][1] = x[1] * DN_ALPHA + w0 * bfhi(y0.x) + w1 * bfhi(y1.x);
            v[j][2] = x[2] * DN_ALPHA + w0 * bflo(y0.y) + w1 * bflo(y1.y); v[j][3] = x[3] * DN_ALPHA + w0 * bfhi(y0.y) + w1 * bfhi(y1.y); }
        ln_row(v, gam, bet, lane);
#pragma unroll
        for (int j = 0; j < 8; ++j) { row[lane + 64 * j] = v[j]; xb[(size_t)t * (D / 4) + lane + 64 * j] = make_uint2(pk2(v[j][0], v[j][1]), pk2(v[j][2], v[j][3])); }
    }
}

enum { PH_CONV = 0, PH_INPROJ, PH_PREP, PH_LORA, PH_SCAN1, PH_SCAN2, PH_SCAN3, PH_GATES, PH_BRANCH, PH_OUT, PH_LN1, PH_SLOT, PH_MOE_GU, PH_MOE_DN, PH_LN2, NPH_L };
constexpr int NPH = NPH_L * DEPTH;

__device__ __forceinline__ Ctx mkctx(LAS unsigned char* lds, int wv) {
    int ln; asm volatile("v_mbcnt_lo_u32_b32 %0, -1, 0\n\tv_mbcnt_hi_u32_b32 %0, -1, %0" : "=v"(ln));
    int tid = wv * 64 + ln, bx = blockIdx.x, G = gridDim.x;
    asm volatile("" : "+s"(bx)); asm volatile("" : "+s"(G));
    Ctx c; c.lds = lds; c.tid = tid; c.lane = tid & 63; c.wave = __builtin_amdgcn_readfirstlane(tid >> 6); c.G = G; c.bx = bx; c.gw = bx * 8 + c.wave; c.NGW = G * 8; return c;
}
__global__ void __launch_bounds__(512, 2) fwd(Args args0) {
    extern __shared__ __attribute__((aligned(16))) unsigned char lds_raw[];
    LAS unsigned char* const lds0 = (LAS unsigned char*)lds_raw;
    const int lo = args0.ph_lo, hi = args0.ph_hi;
    const int wv0 = __builtin_amdgcn_readfirstlane(threadIdx.x >> 6);
    if (threadIdx.x < 36) ((LAS unsigned long long*)(lds0 + LDS_PTAB))[threadIdx.x] = (unsigned long long)args0.in[threadIdx.x];
    __syncthreads();
#if MK_ONE_LAUNCH
    volatile LAS unsigned* barw = (volatile LAS unsigned*)(lds0 + LDS_BARW);
    if (threadIdx.x == 0) { barw[0] = 0u; barw[1] = 0u; barw[2] = 0u; barw[3] = 0u; }
    __syncthreads();
    XcdBarrier bar = xcd_barrier_post((unsigned*)(args0.ws + WS_CTL) + CW_BAR, barw);
#define SEAM(p) do { if ((p) + 1 < hi) xcd_barrier(bar); } while (0)
#else
#define SEAM(p) do { } while (0)
#endif
#ifndef ONLY_PHASE
#define ONLY_PHASE -1
#endif
#define PHASE_BEGIN PA args; { unsigned long long w_ = (unsigned long long)args0.ws; asm volatile("" : "+s"(w_)); args.ws = (unsigned char*)(GAS unsigned char*)w_; unsigned long long o_ = (unsigned long long)args0.out; asm volatile("" : "+s"(o_)); args.out = (float*)(GAS float*)o_; args.tab = (const LAS unsigned*)(lds0 + LDS_PTAB); } unsigned char* const ws = args.ws; const Ctx c = mkctx(lds0, wv0); (void)ws; (void)c;
#define TASK_CTX() mkctx(lds0, wv0)
#ifdef TIME_PHASE
    unsigned long long tp_a_ = 0ull, tp_b_ = 0ull;
#define TP_BEGIN(p) do { if ((TIME_PHASE >> ((p) % NPH_L)) & 1) tp_a_ = __builtin_amdgcn_s_memrealtime(); } while (0)
#define TP_END(p) do { if ((TIME_PHASE >> ((p) % NPH_L)) & 1) tp_b_ += __builtin_amdgcn_s_memrealtime() - tp_a_; } while (0)
#else
#define TP_BEGIN(p) do { } while (0)
#define TP_END(p) do { } while (0)
#endif
#define IN(p) ((ONLY_PHASE < 0 || ONLY_PHASE == ((p) - pb)) && lo <= (p) && (p) < hi)
    for (int layer = 0; layer < DEPTH; ++layer) {
        const int pb = layer * NPH_L;
        if (IN(pb + PH_CONV)) { TP_BEGIN(pb + PH_CONV); PHASE_BEGIN ph_conv(c, args, layer); __syncthreads(); SEAM(pb + PH_CONV); TP_END(pb + PH_CONV); }
        if (IN(pb + PH_INPROJ)) { TP_BEGIN(pb + PH_INPROJ); PHASE_BEGIN
            Gemm g{D, D, D}; SchedPlain S; S.to.init(T / 256, PC_GATE / 256); S.G = c.G; S.c = c.bx; S.tid = c.tid; S.A = (const char*)(ws + WS_XB); S.B = (const char*)(ws + WS_WIN); S.ta = (size_t)256 * D * 2; S.tb = (size_t)256 * D * 2;
            EpiStore<0> E{(bf16*)(ws + WS_PROJ), LDP};
            pg8::gemm_phase<EpiStore<0>, SchedPlain, PG8_ALIGN, PG8_SP2>(c.lds, g, S, E);
#ifdef REP_GEMM
            pg8::gemm_phase<EpiStore<0>, SchedPlain, PG8_ALIGN, PG8_SP2>(c.lds, g, S, E);
#endif
            { const Ctx c2 = TASK_CTX(); int k2_ = D / 4; asm volatile("" : "+s"(k2_)); Gemm g2{k2_, D, D}; SchedSplitK S2; S2.G = c2.G; S2.c = c2.bx; S2.tid = c2.tid; S2.n = (T / 256) * 4; S2.A = (const char*)(ws + WS_XB); S2.B = (const char*)(ws + WS_WIN) + (size_t)PC_GATE * D * 2; S2.ta = (size_t)256 * D * 2; S2.kb = (size_t)(D / 4) * 2;
                EpiPart48 E2{(float*)(ws + WS_GPART)};
                pg8::gemm_phase<EpiPart48, SchedSplitK, PG8_ALIGN, PG8_SP2>(c2.lds, g2, S2, E2); }
            SEAM(pb + PH_INPROJ); TP_END(pb + PH_INPROJ); }
        if (IN(pb + PH_PREP)) { TP_BEGIN(pb + PH_PREP); PHASE_BEGIN
            { const float* gpart = (const float*)(ws + WS_GPART); bf16* pj = (bf16*)(ws + WS_PROJ);
#pragma unroll 1
                for (int i = c.bx * 512 + c.tid; i < T * 48; i += c.G * 512) { const int t = i / 48, cc = i - t * 48;
                    const float sgl = (gpart[i] + gpart[(size_t)T * 48 + i]) + (gpart[(size_t)2 * T * 48 + i] + gpart[(size_t)3 * T * 48 + i]);
                    pj[(size_t)t * LDP + PC_GATE + cc] = (bf16)f2bf(sgl); } }
            prep_rwkv(TASK_CTX(), args, layer); __syncthreads();
#ifdef REP_PRW
            prep_rwkv(TASK_CTX(), args, layer); __syncthreads();
#endif
#ifdef REP_PCMP
            prep_cmp(TASK_CTX(), args, layer);
#endif
#ifdef REP_PTILES
            prep_tiles(TASK_CTX(), args, layer); __syncthreads();
#endif
 prep_cmp(TASK_CTX(), args, layer); prep_rope(TASK_CTX(), args); prep_ret_frags(TASK_CTX(), args); __syncthreads(); prep_tiles(TASK_CTX(), args, layer);
#ifdef REP_RETPREP
            prep_ret_frags(TASK_CTX(), args, true); prep_ret_frags(TASK_CTX(), args, true);
#endif
 __syncthreads(); SEAM(pb + PH_PREP); TP_END(pb + PH_PREP); }
        if (IN(pb + PH_LORA)) { TP_BEGIN(pb + PH_LORA); PHASE_BEGIN
            int kl_ = 256; asm volatile("" : "+s"(kl_));
            Gemm g{kl_, 1024, 256}; SchedLora S; S.to.init(T / 256, layer ? 16 : 12); S.G = c.G; S.c = c.bx; S.tid = c.tid; S.A = (const char*)(ws + WS_ALORA); S.B = (const char*)(ws + WS_WLORA);
            EpiLora E{ws, args, layer};
            pg8::gemm_phase<EpiLora, SchedLora, PG8_ALIGN, PG8_SP2>(c.lds, g, S, E);
            SEAM(pb + PH_LORA); TP_END(pb + PH_LORA); }
#ifdef TIME_P1
        if (IN(pb + PH_SCAN1)) { PHASE_BEGIN tp_a_ = __builtin_amdgcn_s_memrealtime(); rw_pass1(c, args);
#else
        if (IN(pb + PH_SCAN1)) { TP_BEGIN(pb + PH_SCAN1); PHASE_BEGIN rw_pass1(c, args);
#endif
#if defined(REP_RW) || defined(REP_P1)
            rw_pass1(TASK_CTX(), args);
#endif
 ret_kv(TASK_CTX(), args);
#ifdef TIME_P1
 tp_b_ += __builtin_amdgcn_s_memrealtime() - tp_a_;
#endif
 nsa_attn2(TASK_CTX(), args, layer); __syncthreads();

 SEAM(pb + PH_SCAN1); TP_END(pb + PH_SCAN1); }
        if (IN(pb + PH_SCAN2)) { TP_BEGIN(pb + PH_SCAN2); PHASE_BEGIN rw_pass2(c, args);
#if defined(REP_RW) || defined(REP_P2)
            rw_pass2(TASK_CTX(), args);
#endif
 ret_prefix(TASK_CTX(), args);
#ifdef REP_PFX
            ret_prefix(TASK_CTX(), args); ret_prefix(TASK_CTX(), args);
#endif
 __syncthreads(); SEAM(pb + PH_SCAN2); TP_END(pb + PH_SCAN2); }
        if (IN(pb + PH_SCAN3)) { TP_BEGIN(pb + PH_SCAN3); PHASE_BEGIN rw_pass3(c, args, layer); ret_out(TASK_CTX(), args, 4, 4); __syncthreads(); SEAM(pb + PH_SCAN3); TP_END(pb + PH_SCAN3); }
        if (IN(pb + PH_GATES)) { TP_BEGIN(pb + PH_GATES); PHASE_BEGIN
            Gemm g{D, D, D}; SchedPlain S; S.to.init(T / 256, NG / 256); S.G = c.G; S.c = c.bx; S.tid = c.tid; S.A = (const char*)(ws + WS_XB); S.B = (const char*)(ws + WS_WG); S.ta = (size_t)256 * D * 2; S.tb = (size_t)256 * D * 2;
            EpiStore<1> E{(bf16*)(ws + WS_GATES), NG};
            pg8::gemm_phase<EpiStore<1>, SchedPlain, PG8_ALIGN, PG8_SP2>(c.lds, g, S, E);
#ifdef REP_GEMM
            pg8::gemm_phase<EpiStore<1>, SchedPlain, PG8_ALIGN, PG8_SP2>(c.lds, g, S, E);
#endif
            SEAM(pb + PH_GATES); TP_END(pb + PH_GATES); }
        if (IN(pb + PH_BRANCH)) { TP_BEGIN(pb + PH_BRANCH); PHASE_BEGIN
            Gemm g{RWW, RWW, RWW}; SchedBranch S; S.to.init(T / 256, D / 256); S.G = c.G; S.c = c.bx; S.tid = c.tid;
            S.A0 = (const char*)(ws + WS_YRW); S.sa = WS_YNSA - WS_YRW; static_assert(WS_YRET - WS_YNSA == WS_YNSA - WS_YRW, "y buffers equally spaced");
            S.B0 = (const char*)(ws + WS_WBR); S.sb = (size_t)D * RWW * 2; S.ta = (size_t)256 * RWW * 2; S.tb = (size_t)256 * RWW * 2;
            EpiBranch E{(bf16*)(ws + WS_MERGED), (const bf16*)(ws + WS_GATES)};
            pg8::gemm_phase<EpiBranch, SchedBranch, PG8_ALIGN, PG8_SP2>(c.lds, g, S, E);
            SEAM(pb + PH_BRANCH); TP_END(pb + PH_BRANCH); }
        if (IN(pb + PH_OUT)) { TP_BEGIN(pb + PH_OUT); PHASE_BEGIN
            Gemm g{D, D, D}; SchedPlain S; S.to.init(T / 256, D / 256); S.G = c.G; S.c = c.bx; S.tid = c.tid; S.A = (const char*)(ws + WS_MERGED); S.B = (const char*)(ws + WS_WOUT); S.ta = (size_t)256 * D * 2; S.tb = (size_t)256 * D * 2;
            EpiResid E{args.out};
            pg8::gemm_phase<EpiResid, SchedPlain, PG8_ALIGN, PG8_SP2>(c.lds, g, S, E);
            SEAM(pb + PH_OUT); TP_END(pb + PH_OUT); }
        if (IN(pb + PH_LN1)) { TP_BEGIN(pb + PH_LN1); PHASE_BEGIN ph_ln1(c, args, layer); __syncthreads(); ph_route(TASK_CTX(), args, layer); __syncthreads(); ph_conv_moe(TASK_CTX(), args, layer); __syncthreads();
#ifdef REP_CMOE
            ph_conv_moe(TASK_CTX(), args, layer); __syncthreads();
#endif
            SEAM(pb + PH_LN1); TP_END(pb + PH_LN1); }
        if (IN(pb + PH_SLOT)) { TP_BEGIN(pb + PH_SLOT); PHASE_BEGIN ph_slot(c, args, layer); __syncthreads(); SEAM(pb + PH_SLOT); TP_END(pb + PH_SLOT); }
        if (IN(pb + PH_MOE_GU)) { TP_BEGIN(pb + PH_MOE_GU); PHASE_BEGIN
            const int* texp = (const int*)(ws + WS_TEXP) + layer * 512;
            Gemm g{D, D, D}; SchedMoe S; S.nM = texp[255]; S.nN = 4; S.G = c.G; S.c = c.bx; S.tid = c.tid; S.A = (const char*)(ws + WS_XS); S.B = (const char*)(ws + WS_WGU); S.ta = (size_t)256 * D * 2; S.tb = (size_t)256 * D * 2; S.te = (size_t)1024 * D * 2; S.texp = texp;
            EpiGateUp E{(bf16*)(ws + WS_H)};
            pg8::gemm_phase<EpiGateUp, SchedMoe, PG8_ALIGN, PG8_SP2>(c.lds, g, S, E);
#ifdef REP_GEMM
            pg8::gemm_phase<EpiGateUp, SchedMoe, PG8_ALIGN, PG8_SP2>(c.lds, g, S, E);
#endif
            SEAM(pb + PH_MOE_GU); TP_END(pb + PH_MOE_GU); }
        if (IN(pb + PH_MOE_DN)) { TP_BEGIN(pb + PH_MOE_DN); PHASE_BEGIN
            const int* texp = (const int*)(ws + WS_TEXP) + layer * 512;
            Gemm g{FF, FF, FF}; SchedMoe S; S.nM = texp[255]; S.nN = 8; S.G = c.G; S.c = c.bx; S.tid = c.tid; S.A = (const char*)(ws + WS_H); S.B = (const char*)(ws + WS_WDN); S.ta = (size_t)256 * FF * 2; S.tb = (size_t)256 * FF * 2; S.te = (size_t)D * FF * 2; S.texp = texp;
            EpiStore<0> E{(bf16*)(ws + WS_YS), D};
            pg8::gemm_phase<EpiStore<0>, SchedMoe, PG8_ALIGN, PG8_SP2>(c.lds, g, S, E);
#ifdef REP_GEMM
            pg8::gemm_phase<EpiStore<0>, SchedMoe, PG8_ALIGN, PG8_SP2>(c.lds, g, S, E);
#endif
            SEAM(pb + PH_MOE_DN); TP_END(pb + PH_MOE_DN); }
        if (IN(pb + PH_LN2)) { TP_BEGIN(pb + PH_LN2); PHASE_BEGIN ph_ln2(c, args, layer); __syncthreads(); SEAM(pb + PH_LN2); TP_END(pb + PH_LN2); }
    }
#ifdef TIME_PHASE
    if (blockIdx.x == 0) { const unsigned long long w0 = __builtin_amdgcn_s_memrealtime(), dw = tp_b_ * TIME_AMP; while (__builtin_amdgcn_s_memrealtime() - w0 < dw) __builtin_amdgcn_s_sleep(8); }
#endif
#undef IN
#undef SEAM
}

#ifndef TRUNC_PH
#define TRUNC_PH NPH
#endif
#ifndef DUMP_MODE
#define DUMP_MODE 0
#endif
#if DUMP_MODE
__global__ void dump_k(float* out, const unsigned char* ws) {
    for (size_t i = (size_t)blockIdx.x * blockDim.x + threadIdx.x; i < (size_t)T * D; i += (size_t)gridDim.x * blockDim.x) {
        const int t = (int)(i / D), c = (int)(i % D); float v = 0.f;
#if DUMP_MODE == 1
        v = bf2f(((const bf16*)(ws + WS_PROJ))[(size_t)t * LDP + c * 5]);
#elif DUMP_MODE == 2
        if (c < 1024) v = bf2f(((const bf16*)(ws + WS_YRW))[(size_t)t * 1024 + c]); else v = bf2f(((const bf16*)(ws + WS_YNSA))[(size_t)t * 1024 + c - 1024]);
#elif DUMP_MODE == 3
        if (c < 1024) v = bf2f(((const bf16*)(ws + WS_YRET))[(size_t)t * 1024 + c]); else v = bf2f(((const bf16*)(ws + WS_MERGED))[(size_t)t * D + c]);
#elif DUMP_MODE == 4
        if (c < 1024) v = bf2f(((const bf16*)(ws + WS_YRET))[(size_t)t * 1024 + c]);
#elif DUMP_MODE == 5
        v = bf2f(((const bf16*)(ws + WS_GATES))[(size_t)t * NG + c * 3]);
#endif
        out[i] = (v == v && fabsf(v) < 1e30f) ? v : 0.f; }
}
#endif
extern "C" void kernel_launch(void* const* d_in, const int* in_sizes, int n_in, void* d_out, int out_size, void* d_ws, size_t ws_size, hipStream_t stream) {
    static int grid = 0;
    if (grid == 0) {
        if (n_in != 36 || out_size != T * D || ws_size < WS_END) { fprintf(stderr, "kernel_launch: unexpected shapes (n_in %d out %d ws %zu)\n", n_in, out_size, ws_size); grid = -1; return; }
        int dev = 0, cus = 0, per_cu = 0;
        if (hipGetDevice(&dev) != hipSuccess || hipDeviceGetAttribute(&cus, hipDeviceAttributeMultiprocessorCount, dev) != hipSuccess) { grid = -1; return; }
        if (hipFuncSetAttribute((const void*)fwd, hipFuncAttributeMaxDynamicSharedMemorySize, LDS_BYTES) != hipSuccess) { fprintf(stderr, "kernel_launch: hipFuncSetAttribute failed\n"); grid = -1; return; }
        if (hipOccupancyMaxActiveBlocksPerMultiprocessor(&per_cu, (const void*)fwd, 512, LDS_BYTES) != hipSuccess || per_cu < 1) fprintf(stderr, "kernel_launch: occupancy query says %d\n", per_cu);
        (void)hipGetLastError();
        grid = cus;
    }
    if (grid < 0) return;
    if (hipMemsetAsync((char*)d_ws + WS_CTL, 0, CTL_ZERO_BYTES, stream) != hipSuccess) return;
    Args a{};
    for (int i = 0; i < 36; ++i) a.in[i] = (const float*)d_in[i];
    a.out = (float*)d_out; a.ws = (unsigned char*)d_ws;
#if MK_ONE_LAUNCH
    a.ph_lo = 0; a.ph_hi = NPH;
    hipLaunchKernelGGL(fwd, dim3(grid), dim3(512), LDS_BYTES, stream, a);
#else
    for (int p = 0; p < TRUNC_PH; ++p) { a.ph_lo = p; a.ph_hi = p + 1; hipLaunchKernelGGL(fwd, dim3(grid), dim3(512), LDS_BYTES, stream, a); }
#if DUMP_MODE
    dump_k<<<2048, 256, 0, stream>>>((float*)d_out, (const unsigned char*)d_ws);
#endif
#endif
}
```

```cpp
#define MK_ONE_LAUNCH 1
#include <hip/hip_runtime.h>
#include <cstdio>
#include <cstdint>

#ifndef MK_ONE_LAUNCH
#define MK_ONE_LAUNCH 0
#endif

namespace pg8 {
#define PG8_LAS __attribute__((address_space(3)))
typedef unsigned short bf16_t;
typedef short bf16x8 __attribute__((ext_vector_type(8)));
typedef float f32x4 __attribute__((ext_vector_type(4)));
typedef unsigned u32x4 __attribute__((ext_vector_type(4)));
constexpr int BM = 256, BK = 64, HALF = 128, HTB = HALF * BK * 2  , STAGE_BYTES = 8 * HTB, NXCD = 8, WGM = 8;

__host__ __device__ __forceinline__ int lds_byte(int r, int c) { const int st = (r >> 4) * 2 + (c >> 5), rr = r & 15, cc = c & 31, ob = rr * 64 + cc * 2; return st * 1024 + (ob ^ (((ob >> 9) & 1) << 5)); }
__host__ __device__ __forceinline__ void stage_rc(int b, int& R, int& C) { const int st = b / 1024, sb = b % 1024, swz = sb ^ (((sb >> 9) & 1) << 5); R = (st >> 1) * 16 + swz / 64; C = (st & 1) * 32 + (swz % 64) / 2; }
__host__ __device__ __forceinline__ int perm32(int rho) { const int n = rho >> 4, i = rho & 15; return 8 * (i >> 2) + 4 * n + (i & 3); }

struct Unit { int pm, pn, aux; const char* a; const char* b; };
struct Gemm { int K, lda, ldb; };

struct TileOrder {
    int nM, nN, nwg;
    __device__ void init(int nM_, int nN_) { nM = nM_; nN = nN_; nwg = nM * nN; }
    __device__ bool tile(long L, int& pm, int& pn) const {
        if (L >= nwg) return false;
        int wgid = (int)L; { const int q = nwg / NXCD, r = nwg % NXCD, xcd = wgid % NXCD, off = wgid / NXCD; wgid = (xcd < r ? xcd * (q + 1) : r * (q + 1) + (xcd - r) * q) + off; }
        const int nig = WGM * nN, gid = wgid / nig, fm = gid * WGM, gsz = (nM - fm) < WGM ? (nM - fm) : WGM;
        pm = fm + ((wgid % nig) % gsz); pn = (wgid % nig) / gsz; return true;
    }
};

typedef float f32x2_t __attribute__((ext_vector_type(2))); typedef __bf16 bf16x2_t __attribute__((ext_vector_type(2)));
__device__ __forceinline__ unsigned cvt_pk_bf16(float lo, float hi) { f32x2_t v = {lo, hi}; bf16x2_t b = __builtin_convertvector(v, bf16x2_t); return __builtin_bit_cast(unsigned, b); }

template <class Epi, class Sched, bool ALIGN_EPI = false, bool SP2 = false>
__device__ __forceinline__ void gemm_phase(PG8_LAS unsigned char* lds, const Gemm g, const Sched& S, const Epi& E) {
    const int tid = S.tid, wid = __builtin_amdgcn_readfirstlane(tid >> 6), lane = tid & 63, wr = wid >> 2, wc = wid & 3, fr = lane & 15, fq = lane >> 4;
    const int K = g.K, nt = K / BK;
    unsigned voffA[2], voffB[2];
#pragma unroll
    for (int i = 0; i < 2; ++i) { int R, C; stage_rc(tid * 16 + i * 8192, R, C); const int Rb = Epi::PERM ? ((R & ~31) + perm32(R & 31)) : R;
        voffA[i] = (unsigned)(R * g.lda + C) * 2u; voffB[i] = (unsigned)(Rb * g.ldb + C) * 2u; }
    const size_t kstep = (size_t)(BK * 2);
    const size_t hstepA = (size_t)HALF * g.lda * 2, hstepB = (size_t)HALF * g.ldb * 2;
    const unsigned ldsw = (unsigned)wid * 1024u;
    const int aoff = lds_byte(wr * 64 + fr, fq * 8), boff = lds_byte(wc * 32 + fr, fq * 8);
#define PG8_SA(b, h) (((b) * 2 + (h)) * HTB)
#define PG8_SB(b, h) ((4 + (b) * 2 + (h)) * HTB)
#define PG8_STAGE(bufoff, gbase, voff) do { _Pragma("unroll") for (int _i = 0; _i < 2; ++_i) \
        __builtin_amdgcn_global_load_lds((const unsigned*)((const char*)(gbase) + (voff)[_i]), (PG8_LAS unsigned*)(lds + (bufoff) + ldsw + _i * 8192), 16, 0, 0); } while (0)
#define PG8_LDA(dst, b, h) do { _Pragma("unroll") for (int m = 0; m < 4; ++m) _Pragma("unroll") for (int k = 0; k < 2; ++k) dst[m][k] = *(const PG8_LAS bf16x8*)(lds + PG8_SA(b, h) + aoff + m * 2048 + k * 1024); } while (0)
#define PG8_LDB(dst, b, h) do { _Pragma("unroll") for (int n = 0; n < 2; ++n) _Pragma("unroll") for (int k = 0; k < 2; ++k) dst[n][k] = *(const PG8_LAS bf16x8*)(lds + PG8_SB(b, h) + boff + n * 2048 + k * 1024); } while (0)
#define PG8_MMA(ai, bj, At, Bt) do { __builtin_amdgcn_s_setprio(1); _Pragma("unroll") for (int m = 0; m < 4; ++m) _Pragma("unroll") for (int n = 0; n < 2; ++n) _Pragma("unroll") for (int k = 0; k < 2; ++k) \
        acc[ai][bj][m][n] = __builtin_amdgcn_mfma_f32_16x16x32_bf16(Bt[n][k], At[m][k], acc[ai][bj][m][n], 0, 0, 0); __builtin_amdgcn_s_setprio(0); } while (0)
#define PG8_WAIT_V(n) asm volatile("s_waitcnt vmcnt(" #n ")" ::: "memory")
#define PG8_WAIT_L(n) asm volatile("s_waitcnt lgkmcnt(" #n ")" ::: "memory")
#define PG8_BAR __builtin_amdgcn_s_barrier()
#define PG8_SCHED __builtin_amdgcn_sched_barrier(0)
    Unit cur, nxt; int ui = 0;
    if (!S.next(0, cur)) return;
    f32x4 acc[2][2][4][2];
#pragma unroll
    for (int a = 0; a < 2; ++a)
#pragma unroll
        for (int b = 0; b < 2; ++b)
#pragma unroll
            for (int m = 0; m < 4; ++m)
#pragma unroll
                for (int n = 0; n < 2; ++n) acc[a][b][m][n] = (f32x4){0.f, 0.f, 0.f, 0.f};
    bf16x8 At[4][2], B0[2][2], B1[2][2];
    const char* cA = cur.a; const char* cB = cur.b;
    if constexpr (SP2) {
        PG8_STAGE(PG8_SB(0, 0), cB, voffB); PG8_STAGE(PG8_SB(0, 1), cB + hstepB, voffB); PG8_STAGE(PG8_SA(0, 0), cA, voffA); PG8_STAGE(PG8_SA(0, 1), cA + hstepA, voffA);
        if (wr == 1) PG8_BAR;
        PG8_WAIT_V(2); PG8_BAR;
        PG8_STAGE(PG8_SB(1, 0), cB + kstep, voffB); PG8_STAGE(PG8_SA(1, 0), cA + kstep, voffA); PG8_STAGE(PG8_SB(1, 1), cB + hstepB + kstep, voffB);
        PG8_WAIT_V(6); PG8_BAR;
    } else {
        PG8_STAGE(PG8_SB(0, 0), cB, voffB); PG8_STAGE(PG8_SA(0, 0), cA, voffA); PG8_STAGE(PG8_SB(0, 1), cB + hstepB, voffB); PG8_STAGE(PG8_SA(0, 1), cA + hstepA, voffA);
        if (wr == 1) PG8_BAR;
        PG8_WAIT_V(4); PG8_BAR;
        PG8_STAGE(PG8_SB(1, 0), cB + kstep, voffB); PG8_STAGE(PG8_SA(1, 0), cA + kstep, voffA); PG8_STAGE(PG8_SB(1, 1), cB + hstepB + kstep, voffB);
        PG8_WAIT_V(6); PG8_BAR;
    }
    for (;;) {
        const bool has_next = S.next(ui + 1, nxt);
        const char* nA = has_next ? nxt.a : cA; const char* nB = has_next ? nxt.b : cB;
        for (int t = 0; t < nt; t += 2) {
            const bool last = (t == nt - 2);
            const char* a1 = cA + (size_t)(t + 1) * kstep;
            const char* a2 = last ? nA : cA + (size_t)(t + 2) * kstep; const char* b2 = last ? nB : cB + (size_t)(t + 2) * kstep;
            const char* a3 = a2 + kstep; const char* b3 = b2 + kstep;
            if constexpr (SP2) {
            PG8_LDB(B0, 0, 0); PG8_LDB(B1, 0, 1); PG8_SCHED; PG8_LDA(At, 0, 0); PG8_STAGE(PG8_SA(1, 1), a1 + hstepA, voffA);
            PG8_WAIT_V(8); PG8_WAIT_L(0); PG8_BAR; PG8_MMA(0, 0, At, B0); PG8_MMA(0, 1, At, B1); PG8_BAR; PG8_SCHED;
            PG8_LDA(At, 0, 1); PG8_STAGE(PG8_SB(0, 0), b2, voffB); PG8_STAGE(PG8_SB(0, 1), b2 + hstepB, voffB); PG8_STAGE(PG8_SA(0, 0), a2, voffA);
            PG8_WAIT_V(8); PG8_WAIT_L(0); PG8_BAR; PG8_MMA(1, 0, At, B0); PG8_MMA(1, 1, At, B1); PG8_BAR; PG8_SCHED;
            PG8_LDB(B0, 1, 0); PG8_LDB(B1, 1, 1); PG8_SCHED; PG8_LDA(At, 1, 0); PG8_STAGE(PG8_SA(0, 1), a2 + hstepA, voffA);
            PG8_WAIT_V(8); PG8_WAIT_L(0); PG8_BAR; PG8_MMA(0, 0, At, B0); PG8_MMA(0, 1, At, B1); PG8_BAR; PG8_SCHED;
            PG8_LDA(At, 1, 1); PG8_STAGE(PG8_SB(1, 0), b3, voffB); PG8_STAGE(PG8_SB(1, 1), b3 + hstepB, voffB); PG8_STAGE(PG8_SA(1, 0), a3, voffA);
            PG8_WAIT_V(8); PG8_WAIT_L(0); PG8_BAR; PG8_MMA(1, 0, At, B0); PG8_MMA(1, 1, At, B1); PG8_BAR; PG8_SCHED;
            } else {
            PG8_LDB(B0, 0, 0); PG8_SCHED; PG8_LDA(At, 0, 0); PG8_STAGE(PG8_SA(1, 1), a1 + hstepA, voffA);
            PG8_WAIT_L(8); PG8_BAR; PG8_WAIT_L(0); PG8_MMA(0, 0, At, B0); PG8_BAR; PG8_SCHED;
            PG8_LDB(B1, 0, 1); PG8_STAGE(PG8_SB(0, 0), b2, voffB);
            PG8_BAR; PG8_WAIT_L(0); PG8_MMA(0, 1, At, B1); PG8_BAR;
            PG8_LDA(At, 0, 1); PG8_STAGE(PG8_SA(0, 0), a2, voffA);
            PG8_BAR; PG8_WAIT_L(0); PG8_MMA(1, 0, At, B0); PG8_BAR; PG8_SCHED;
            PG8_STAGE(PG8_SB(0, 1), b2 + hstepB, voffB);
            PG8_WAIT_V(6); PG8_BAR; PG8_MMA(1, 1, At, B1); PG8_BAR;
            PG8_LDB(B0, 1, 0); PG8_SCHED; PG8_LDA(At, 1, 0); PG8_STAGE(PG8_SA(0, 1), a2 + hstepA, voffA);
            PG8_WAIT_L(8); PG8_BAR; PG8_WAIT_L(0); PG8_MMA(0, 0, At, B0); PG8_BAR; PG8_SCHED;
            PG8_LDB(B1, 1, 1); PG8_STAGE(PG8_SB(1, 0), b3, voffB);
            PG8_BAR; PG8_WAIT_L(0); PG8_MMA(0, 1, At, B1); PG8_BAR;
            PG8_LDA(At, 1, 1); PG8_STAGE(PG8_SA(1, 0), a3, voffA);
            PG8_BAR; PG8_WAIT_L(0); PG8_MMA(1, 0, At, B0); PG8_BAR; PG8_SCHED;
            PG8_STAGE(PG8_SB(1, 1), b3 + hstepB, voffB);
            PG8_WAIT_V(6); PG8_BAR; PG8_MMA(1, 1, At, B1); PG8_BAR;
            }
        }
        if constexpr (ALIGN_EPI) { if (wr == 0) PG8_BAR; }
        if constexpr (Epi::CHAIN) E.chain(acc, cur, wr, wc, fr, fq);
        else E(acc, cur, wr, wc, fr, fq);
        if (!has_next) break;
        if constexpr (!Epi::CHAIN)
#pragma unroll
        for (int a = 0; a < 2; ++a)
#pragma unroll
            for (int b = 0; b < 2; ++b)
#pragma unroll
                for (int m = 0; m < 4; ++m)
#pragma unroll
                    for (int n = 0; n < 2; ++n) acc[a][b][m][n] = (f32x4){0.f, 0.f, 0.f, 0.f};
        cur = nxt; cA = nA; cB = nB; ++ui;
        if constexpr (ALIGN_EPI) { if (wr == 1) PG8_BAR; }
    }
    PG8_WAIT_V(0);
    if constexpr (!ALIGN_EPI) { if (wr == 0) PG8_BAR; }
    PG8_BAR;
    #undef PG8_SA
#undef PG8_SB
#undef PG8_STAGE
#undef PG8_LDA
#undef PG8_LDB
#undef PG8_MMA
#undef PG8_WAIT_V
#undef PG8_WAIT_L
#undef PG8_BAR
#undef PG8_SCHED
}
}

#ifndef PG8_SP2
#define PG8_SP2 true
#endif
#ifndef PG8_ALIGN
#define PG8_ALIGN true
#endif

constexpr int T = 16384, D = 2048, DEPTH = 2;
constexpr int RWW = 1024;
constexpr int NCMP = 1023, NSELB = 256;
constexpr int NEXP = 32, FF = 512;
constexpr int LDP = 10496;
constexpr int NG = 6144;
constexpr int PC_RW_R = 0, PC_RW_K = 1024, PC_RW_V = 2048, PC_NQ = 3072, PC_KC = 4096, PC_VC = 4352, PC_KS = 4608, PC_VS = 4864, PC_KW = 5120, PC_VW = 5376,
              PC_RQ = 5632, PC_RK = 6656, PC_RV = 7680, PC_RG = 8704, PC_XW = 9728, PC_XA = 9824, PC_XG = 9920, PC_XV = 10176, PC_GATE = 10240;
constexpr float DN_ALPHA = 1.41421356237f, LN_EPS = 1e-5f;

constexpr size_t MiB = 1u << 20;
constexpr size_t WS_CTL = 0, CTL_ZERO_BYTES = 1 * MiB;
constexpr size_t WS_TEXP = 1 * MiB, WS_TOKE = WS_TEXP + 65536, WS_TOKW = WS_TOKE + 131072, WS_SLOT = WS_TOKW + 131072;
constexpr size_t WS_KCMPB = 2 * MiB, WS_VCMPT = 3 * MiB, WS_KF8 = 4 * MiB  , WS_COS = 8 * MiB, WS_SIN = 12 * MiB;
constexpr size_t WS_WIN = 16 * MiB, WS_WG = 57 * MiB, WS_WBR = 81 * MiB, WS_WOUT = 93 * MiB;
constexpr size_t WS_W1T = 103 * MiB, WS_WLORA = 101 * MiB, WS_ALORA = 896 * MiB;
constexpr size_t WS_XB = 112 * MiB, WS_VF = 176 * MiB, WS_PROJ = 208 * MiB;
constexpr size_t WS_RW_R = 536 * MiB, WS_RW_K = 568 * MiB, WS_RW_V = 600 * MiB, WS_RW_KK = 632 * MiB, WS_RW_B = 664 * MiB, WS_RW_W = 696 * MiB, WS_RW_G = 760 * MiB;
constexpr size_t WS_YRW = 800 * MiB, WS_YNSA = 832 * MiB, WS_YRET = 864 * MiB;
constexpr size_t WS_RWP = 896 * MiB, WS_RWU = 912 * MiB, WS_RWS = 928 * MiB, WS_RETKV = 944 * MiB, WS_KFS = 1008 * MiB, WS_VFS = 1016 * MiB, WS_KFW = 1024 * MiB, WS_VFW = 1032 * MiB, WS_VFR = 1040 * MiB, WS_KTR = 1072 * MiB, WS_RT = 1104 * MiB, WS_VF8 = 1136 * MiB  , WS_GPART = 1140 * MiB  , WS_END = 1152 * MiB;
constexpr size_t WS_GATES = 536 * MiB, WS_MERGED = 728 * MiB;
constexpr size_t WS_WGU = 208 * MiB, WS_WDN = 336 * MiB, WS_XS = 400 * MiB, WS_H = 560 * MiB, WS_YS = 600 * MiB;
static_assert(WS_PROJ + (size_t)T * LDP * 2 <= WS_RW_R && WS_GATES + (size_t)T * NG * 2 <= WS_MERGED && WS_MERGED + (size_t)T * D * 2 <= WS_YRW, "ws map");
static_assert(WS_XS + (size_t)160 * 256 * D * 2 <= WS_H && WS_H + (size_t)160 * 256 * FF * 2 <= WS_YS && WS_YS + (size_t)160 * 256 * D * 2 <= WS_RW_G, "ws map moe");
constexpr int CW_TMO = 0, CW_CNT = 1024, CW_CUR = 1088, CW_BAR = 4096, CW_NSAQ = 16384, CW_KMAX = 20480;
constexpr int LDS_BYTES = 147456, LDS_BARW = LDS_BYTES - 64;

#define GAS __attribute__((address_space(1)))
#define LAS __attribute__((address_space(3)))
typedef unsigned short bf16;
typedef float f32x4 __attribute__((ext_vector_type(4)));
typedef unsigned u32x4 __attribute__((ext_vector_type(4)));
typedef short bf16x8 __attribute__((ext_vector_type(8)));
typedef short bf16x4 __attribute__((ext_vector_type(4)));
#define LDS_WAIT() asm volatile("s_waitcnt lgkmcnt(0)" ::: "memory")
#define VM_WAIT() asm volatile("s_waitcnt vmcnt(0)" ::: "memory")

__device__ __forceinline__ float bf2f(unsigned short b) { return __uint_as_float(((unsigned)b) << 16); }
__device__ __forceinline__ unsigned f2bf(float f) { unsigned u = __float_as_uint(f); return (u + 0x7fffu + ((u >> 16) & 1u)) >> 16; }
__device__ __forceinline__ unsigned pk2(float lo, float hi) { return f2bf(lo) | (f2bf(hi) << 16); }
__device__ __forceinline__ float bflo(unsigned w) { return __uint_as_float(w << 16); }
__device__ __forceinline__ float bfhi(unsigned w) { return __uint_as_float(w & 0xffff0000u); }
#define DPP_I(v, ctrl) __builtin_amdgcn_update_dpp(0, (v), (ctrl), 0xf, 0xf, true)
#define DPP_F(v, ctrl) __int_as_float(__builtin_amdgcn_update_dpp(0, __float_as_int(v), (ctrl), 0xf, 0xf, true))
constexpr int DPP_X1 = 0xB1, DPP_X2 = 0x4E, DPP_HMIR = 0x141, DPP_ROR4 = 0x124, DPP_ROR8 = 0x128;
__device__ __forceinline__ float sum_x16_32(float v) { auto a = __builtin_amdgcn_permlane16_swap(__float_as_uint(v), __float_as_uint(v), false, false); v = __uint_as_float(a[0]) + __uint_as_float(a[1]);
    auto b = __builtin_amdgcn_permlane32_swap(__float_as_uint(v), __float_as_uint(v), false, false); return __uint_as_float(b[0]) + __uint_as_float(b[1]); }
__device__ __forceinline__ float max_x16_32(float v) { auto a = __builtin_amdgcn_permlane16_swap(__float_as_uint(v), __float_as_uint(v), false, false); v = fmaxf(__uint_as_float(a[0]), __uint_as_float(a[1]));
    auto b = __builtin_amdgcn_permlane32_swap(__float_as_uint(v), __float_as_uint(v), false, false); return fmaxf(__uint_as_float(b[0]), __uint_as_float(b[1])); }
__device__ __forceinline__ int min_x16_32(int v) { auto a = __builtin_amdgcn_permlane16_swap((unsigned)v, (unsigned)v, false, false); v = (int)a[0] < (int)a[1] ? (int)a[0] : (int)a[1];
    auto b = __builtin_amdgcn_permlane32_swap((unsigned)v, (unsigned)v, false, false); return (int)b[0] < (int)b[1] ? (int)b[0] : (int)b[1]; }
__device__ __forceinline__ float sum_x1_2(float v) { v += DPP_F(v, DPP_X1); v += DPP_F(v, DPP_X2); return v; }
__device__ __forceinline__ float sum_x1_2_4(float v) { v = sum_x1_2(v); v += DPP_F(v, DPP_HMIR); return v; }
__device__ __forceinline__ float wave_sum(float v) { v = sum_x1_2(v); v += DPP_F(v, DPP_ROR4); v += DPP_F(v, DPP_ROR8); return sum_x16_32(v); }
__device__ __forceinline__ float wave_max(float v) { v = fmaxf(v, DPP_F(v, DPP_X1)); v = fmaxf(v, DPP_F(v, DPP_X2)); v = fmaxf(v, DPP_F(v, DPP_ROR4)); v = fmaxf(v, DPP_F(v, DPP_ROR8)); return max_x16_32(v); }
__device__ __forceinline__ int wave_min_i(int v) { int w;
    w = DPP_I(v, DPP_X1); v = w < v ? w : v; w = DPP_I(v, DPP_X2); v = w < v ? w : v; w = DPP_I(v, DPP_ROR4); v = w < v ? w : v; w = DPP_I(v, DPP_ROR8); v = w < v ? w : v; return min_x16_32(v); }
__device__ __forceinline__ float sigm(float x) { return 1.f / (1.f + expf(-x)); }
__device__ __forceinline__ float sigm_fast(float x) { return __builtin_amdgcn_rcpf(1.f + __builtin_amdgcn_exp2f(-1.4426950408889634f * x)); }

__device__ const double INV_FREQ[64] = {1.00000000000000000e+00, 8.63988449483968579e-01, 7.46476040841712152e-01, 6.44946677103762411e-01, 5.57226479550717357e-01, 4.81437242078434580e-01, 4.15956216307184767e-01, 3.59381366380462752e-01, 3.10501349512486036e-01, 2.68269579527972590e-01, 2.31781818060089240e-01, 2.00256813604311801e-01, 1.73019573884589412e-01, 1.49486913370923374e-01, 1.29154966501488389e-01, 1.11588399250774864e-01, 9.64110880490750138e-02, 8.32980664765826800e-02, 7.19685673001152076e-02, 6.21800108732091794e-02, 5.37228111832403141e-02, 4.64158883361278016e-02, 4.01027913949520837e-02, 3.46483485573036779e-02, 2.99357729472049007e-02, 2.58641620527596990e-02, 2.23463372691659473e-02, 1.93069772888325060e-02, 1.66810053720005923e-02, 1.44121959671885402e-02, 1.24519708473503302e-02, 1.07583589854217902e-02, 9.29509789880649494e-03, 8.03085722139152032e-03, 6.93856787873718770e-03, 5.99484250318940964e-03, 5.17947467923121282e-03, 4.47500629725045354e-03, 3.86635375219241198e-03, 3.34048498351324471e-03, 2.88614044143008968e-03, 2.49359200498416086e-03, 2.15443469003188427e-03, 1.86140668735512152e-03, 1.60823387766704205e-03, 1.38949549437313892e-03, 1.20050805774840792e-03, 1.03722509540705695e-03, 8.96150501946605012e-04, 7.74263682681127744e-04, 6.68954878691414585e-04, 5.77969288415331340e-04, 4.99358789347314927e-04, 4.31440226144378508e-04, 3.72759372031494166e-04, 3.22059791872108224e-04, 2.78255940220712632e-04, 2.40409918350997456e-04, 2.07711392596645640e-04, 1.79460244029731636e-04, 1.55051577983262559e-04, 1.33962772451801717e-04, 1.15742288059205792e-04, 1.00000000000000005e-04};
__device__ const float RET_LOGG[8] = {-0.0317486983145803f, -0.015748356968139168f, -0.007843177461025893f, -0.003913899321136329f, -0.0019550348358033506f, -0.0009770396478266127f, -0.0004884004981088745f, -0.0002441704321739145f};

#define XB_TMO      128
#define XB_XCNT(j)  (256  + 64 * (j))
#define XB_XSUB(j)  (1280 + 64 * (j))
#define XB_XGEN(j)  (2304 + 64 * (j))
#define XB_TOP      3328
#define XB_TOPGEN   3392
#define XCD_BAR_WORDS 3456
#define XB_SPIN_CAP (1u << 18)

__device__ __forceinline__ unsigned xb_ld(unsigned* p)              { return __hip_atomic_load(p, __ATOMIC_RELAXED, __HIP_MEMORY_SCOPE_AGENT); }
__device__ __forceinline__ unsigned xb_add(unsigned* p, unsigned v) { return __hip_atomic_fetch_add(p, v, __ATOMIC_RELAXED, __HIP_MEMORY_SCOPE_AGENT); }
__device__ __forceinline__ unsigned xb_xcc_id() { return (unsigned)__builtin_amdgcn_s_getreg((3 << 11) | 20) & 0xFu; }
#define XB_SPIN(cond, bar) do { unsigned _sp = 0; while (cond) { __builtin_amdgcn_s_sleep(1); \
    if ((++_sp & 255u) == 0u) { if (xb_ld(&(bar)[XB_TMO])) break; if (_sp > XB_SPIN_CAP) { atomicAdd(&(bar)[XB_TMO], 1u); break; } } } } while (0)

struct XcdBarrier {
    unsigned* bar; unsigned x;
    volatile LAS unsigned* st;
};
__device__ __forceinline__ XcdBarrier xcd_barrier_post(unsigned* bar, volatile LAS unsigned* st) {
    XcdBarrier b; b.bar = bar; b.x = xb_xcc_id(); b.st = st;
    if (threadIdx.x == 0) (void)xb_add(&bar[XB_XCNT(b.x)], 1u);
    return b;
}
__device__ __forceinline__ void xcd_barrier_complete(unsigned* bar, unsigned x, unsigned& nloc, unsigned& nx) {
    const unsigned G = gridDim.x * gridDim.y * gridDim.z;
    unsigned sum, cnt, mine, sp = 0u;
    for (;;) {
        sum = 0u; cnt = 0u; mine = 0u;
#pragma unroll
        for (unsigned j = 0; j < 16; ++j) { const unsigned c = xb_ld(&bar[XB_XCNT(j)]); sum += c; cnt += (c > 0u) ? 1u : 0u; mine = (j == x) ? c : mine; }
        if (sum == G) break;
        __builtin_amdgcn_s_sleep(1);
        if ((++sp & 255u) == 0u) { if (xb_ld(&bar[XB_TMO])) break; if (sp > XB_SPIN_CAP) { atomicAdd(&bar[XB_TMO], 1u); break; } }
    }
    nloc = mine > 0u ? mine : 1u; nx = cnt > 0u ? cnt : 1u;
}
__device__ __forceinline__ void xcd_barrier(const XcdBarrier& b) {
    asm volatile("s_waitcnt vmcnt(0)" ::: "memory");
    __syncthreads();
    if (threadIdx.x == 0) {
        unsigned* bar = b.bar;
        __builtin_amdgcn_s_waitcnt(0);
        unsigned nloc = b.st[0], nx = b.st[1];
        if (nloc == 0u) { xcd_barrier_complete(bar, b.x, nloc, nx); b.st[0] = nloc; b.st[1] = nx; }
        const unsigned old = xb_add(&bar[XB_XSUB(b.x)], 1u);
        const unsigned gen = old / nloc;
        if (old + 1u == (gen + 1u) * nloc) {
            __builtin_amdgcn_fence(__ATOMIC_RELEASE, "agent");
            asm volatile("s_waitcnt vmcnt(0)" ::: "memory");
            const unsigned og = xb_add(&bar[XB_TOP], 1u);
            const unsigned tg = og / nx;
            if (og + 1u == (tg + 1u) * nx) xb_add(&bar[XB_TOPGEN], 1u);
            else XB_SPIN(xb_ld(&bar[XB_TOPGEN]) == tg, bar);
            __builtin_amdgcn_fence(__ATOMIC_ACQUIRE, "agent");
            xb_add(&bar[XB_XGEN(b.x)], 1u);
            asm volatile("s_waitcnt vmcnt(0)" ::: "memory");
        } else {
            XB_SPIN(xb_ld(&bar[XB_XGEN(b.x)]) == gen, bar);
            __builtin_amdgcn_fence(__ATOMIC_ACQUIRE, "agent");
            asm volatile("s_waitcnt vmcnt(0)" ::: "memory");
        }
    }
    __syncthreads();
}

#if defined(__HIP_DEVICE_COMPILE__)
#define ASSUME_GLOBAL(p) do { __builtin_assume(!__builtin_amdgcn_is_shared((const __attribute__((address_space(0))) void*)(p))); __builtin_assume(!__builtin_amdgcn_is_private((const __attribute__((address_space(0))) void*)(p))); } while (0)
#else
#define ASSUME_GLOBAL(p) do { } while (0)
#endif
struct Args { const float* in[36]; float* out; unsigned char* ws; int ph_lo, ph_hi; };
constexpr int LDS_PTAB = LDS_BYTES - 512;
struct PA { unsigned char* ws; float* out; const LAS unsigned* tab;
    __device__ __forceinline__ const float* in(int i) const { const unsigned lo = __builtin_amdgcn_readfirstlane(tab[2 * i]), hi = __builtin_amdgcn_readfirstlane(tab[2 * i + 1]);
        return (const float*)(const GAS float*)(((unsigned long long)hi << 32) | lo); } };

__device__ __forceinline__ void un8(const u32x4 p, float (&o)[8]) { o[0] = bflo(p.x); o[1] = bfhi(p.x); o[2] = bflo(p.y); o[3] = bfhi(p.y); o[4] = bflo(p.z); o[5] = bfhi(p.z); o[6] = bflo(p.w); o[7] = bfhi(p.w); }
__device__ __forceinline__ u32x4 pk8(const float (&v)[8]) { return (u32x4){pk2(v[0], v[1]), pk2(v[2], v[3]), pk2(v[4], v[5]), pk2(v[6], v[7])}; }
using pg8::Unit; using pg8::Gemm; using pg8::TileOrder;
struct SchedPlain {
    TileOrder to; int G, c, tid; const char* A; const char* B; size_t ta, tb;
    __device__ __forceinline__ bool next(int i, Unit& u) const {
        if (!to.tile((long)i * G + c, u.pm, u.pn)) return false;
        u.a = A + (size_t)u.pm * ta; u.b = B + (size_t)u.pn * tb; u.aux = 0; return true; }
};
struct SchedSplitK {
    int G, c, tid, n; const char* A; const char* B; size_t ta, kb;
    __device__ __forceinline__ bool next(int i, Unit& u) const { const long L = (long)i * G + c; if (L >= n) return false;
        u.pm = (int)(L >> 2); u.pn = 0; u.aux = (int)(L & 3); u.a = A + (size_t)u.pm * ta + (size_t)u.aux * kb; u.b = B + (size_t)u.aux * kb; return true; }
};
struct EpiPart48 {
    static constexpr bool PERM = true, CHAIN = false;
    float* P;
    __device__ __forceinline__ void operator()(const f32x4 (&acc)[2][2][4][2], const Unit& u, int wr, int wc, int fr, int fq) const {
        const int col = wc * 32 + 8 * fq, row0 = u.pm * 256 + wr * 64 + fr;
        if (col < 48) {
#pragma unroll
            for (int ai = 0; ai < 2; ++ai)
#pragma unroll
                for (int m = 0; m < 4; ++m) { float* p = P + ((size_t)u.aux * T + row0 + ai * 128 + m * 16) * 48 + col; *(f32x4*)p = acc[ai][0][m][0]; *(f32x4*)(p + 4) = acc[ai][0][m][1]; } }
    }
};
struct SchedBranch {
    TileOrder to; int G, c, tid; const char* A0; const char* B0; size_t sa, sb, ta, tb;
    __device__ __forceinline__ bool next(int i, Unit& u) const {
        const int br = i % 3;
        if (!to.tile((long)(i / 3) * G + c, u.pm, u.pn)) return false;
        u.a = A0 + (size_t)br * sa + (size_t)u.pm * ta; u.b = B0 + (size_t)br * sb + (size_t)u.pn * tb; u.aux = br; return true; }
};
struct SchedMoe {
    int nM, nN, G, c, tid; const char* A; const char* B; size_t ta, tb, te; const int* texp;
    __device__ __forceinline__ bool next(int i, Unit& u) const {
        const long L = (long)i * G + c; if (L >= (long)nM * nN) return false;
        u.pm = (int)(L % nM); u.pn = (int)(L / nM); const int e = texp[u.pm];
        u.a = A + (size_t)u.pm * ta; u.b = B + (size_t)e * te + (size_t)u.pn * tb; u.aux = e; return true; }
};
template <int ACT  > struct EpiStore {
    static constexpr bool PERM = true, CHAIN = false;
    bf16* O; int ldc;
    __device__ __forceinline__ void operator()(const f32x4 (&acc)[2][2][4][2], const Unit& u, int wr, int wc, int fr, int fq) const {
        const int row0 = u.pm * 256 + wr * 64 + fr, col0 = u.pn * 256 + wc * 32 + 8 * fq;
#pragma unroll
        for (int ai = 0; ai < 2; ++ai)
#pragma unroll
            for (int m = 0; m < 4; ++m) { bf16* rowp = O + (size_t)(row0 + ai * 128 + m * 16) * ldc + col0;
#pragma unroll
                for (int bj = 0; bj < 2; ++bj) { f32x4 v0 = acc[ai][bj][m][0], v1 = acc[ai][bj][m][1];
                    if (ACT == 1) {
#pragma unroll
                        for (int j = 0; j < 4; ++j) { v0[j] = sigm_fast(v0[j]); v1[j] = sigm_fast(v1[j]); } }
                    u32x4 w; w.x = pg8::cvt_pk_bf16(v0[0], v0[1]); w.y = pg8::cvt_pk_bf16(v0[2], v0[3]); w.z = pg8::cvt_pk_bf16(v1[0], v1[1]); w.w = pg8::cvt_pk_bf16(v1[2], v1[3]);
                    *(u32x4*)(rowp + bj * 128) = w; __builtin_amdgcn_sched_barrier(0); } }
    }
};
struct EpiBranch {
    static constexpr bool PERM = true, CHAIN = true;
    bf16* Mg; const bf16* Gt;
    __device__ __forceinline__ void chain(f32x4 (&acc)[2][2][4][2], const Unit& u, int wr, int wc, int fr, int fq) const {
        const int row0 = u.pm * 256 + wr * 64 + fr, col0 = u.pn * 256 + wc * 32 + 8 * fq, br = u.aux;
#pragma unroll
        for (int ai = 0; ai < 2; ++ai)
#pragma unroll
            for (int m = 0; m < 4; ++m) { const size_t r = (size_t)(row0 + ai * 128 + m * 16);
#pragma unroll
                for (int bj = 0; bj < 2; ++bj) { const int col = col0 + bj * 128; float g[8]; un8(*(const u32x4*)(Gt + r * NG + br * 2048 + col), g);
                    if (br < 2) { float gn[8]; un8(*(const u32x4*)(Gt + r * NG + (br + 1) * 2048 + col), gn);
#pragma unroll
                        for (int j = 0; j < 8; ++j) g[j] = fmaxf(g[j], 1e-18f) * __builtin_amdgcn_rcpf(fmaxf(gn[j], 1e-18f)); }
                    else {
#pragma unroll
                        for (int j = 0; j < 8; ++j) g[j] = fmaxf(g[j], 1e-18f); }
                    f32x4& v0 = acc[ai][bj][m][0]; f32x4& v1 = acc[ai][bj][m][1];
                    v0[0] *= g[0]; v0[1] *= g[1]; v0[2] *= g[2]; v0[3] *= g[3]; v1[0] *= g[4]; v1[1] *= g[5]; v1[2] *= g[6]; v1[3] *= g[7];
                    if (br == 2) { u32x4 w; w.x = pg8::cvt_pk_bf16(v0[0], v0[1]); w.y = pg8::cvt_pk_bf16(v0[2], v0[3]); w.z = pg8::cvt_pk_bf16(v1[0], v1[1]); w.w = pg8::cvt_pk_bf16(v1[2], v1[3]);
                        *(u32x4*)(Mg + r * D + col) = w; v0 = (f32x4){0.f, 0.f, 0.f, 0.f}; v1 = v0; }
                    __builtin_amdgcn_sched_barrier(0); } }
    }
    __device__ __forceinline__ void operator()(const f32x4 (&)[2][2][4][2], const Unit&, int, int, int, int) const {}
};
struct EpiResid {
    static constexpr bool PERM = true, CHAIN = false;
    float* X;
    __device__ __forceinline__ void operator()(const f32x4 (&acc)[2][2][4][2], const Unit& u, int wr, int wc, int fr, int fq) const {
        const int row0 = u.pm * 256 + wr * 64 + fr, col0 = u.pn * 256 + wc * 32 + 8 * fq;
#pragma unroll
        for (int ai = 0; ai < 2; ++ai)
#pragma unroll
            for (int m = 0; m < 4; ++m) { float* rowp = X + (size_t)(row0 + ai * 128 + m * 16) * D + col0;
#pragma unroll
                for (int bj = 0; bj < 2; ++bj) { f32x4* p = (f32x4*)(rowp + bj * 128);
                    const f32x4 x0 = p[0], x1 = p[1];
                    p[0] = x0 * DN_ALPHA + acc[ai][bj][m][0]; p[1] = x1 * DN_ALPHA + acc[ai][bj][m][1]; __builtin_amdgcn_sched_barrier(0); } }
    }
};
struct EpiGateUp {
    static constexpr bool PERM = true, CHAIN = false;
    bf16* H;
    __device__ __forceinline__ void operator()(const f32x4 (&acc)[2][2][4][2], const Unit& u, int wr, int wc, int fr, int fq) const {
        const int row0 = u.pm * 256 + wr * 64 + fr, col0 = u.pn * 128 + wc * 32 + 8 * fq;
#pragma unroll
        for (int ai = 0; ai < 2; ++ai)
#pragma unroll
            for (int m = 0; m < 4; ++m) { bf16* rowp = H + (size_t)(row0 + ai * 128 + m * 16) * FF + col0;
                f32x4 h0, h1;
#pragma unroll
                for (int j = 0; j < 4; ++j) { const float g0 = acc[ai][0][m][0][j], g1 = acc[ai][0][m][1][j];
                    h0[j] = g0 * sigm_fast(g0) * acc[ai][1][m][0][j]; h1[j] = g1 * sigm_fast(g1) * acc[ai][1][m][1][j]; }
                u32x4 w; w.x = pg8::cvt_pk_bf16(h0[0], h0[1]); w.y = pg8::cvt_pk_bf16(h0[2], h0[3]); w.z = pg8::cvt_pk_bf16(h1[0], h1[1]); w.w = pg8::cvt_pk_bf16(h1[2], h1[3]);
                *(u32x4*)rowp = w; }
    }
};

struct Ctx { LAS unsigned char* lds; int tid, lane, wave, G, bx, gw, NGW; };

template <class SRC>
__device__ __forceinline__ void transpose_task(const Ctx& c, const SRC& src, int ldsrc, int K, bf16* dst, int ndst) {
    LAS float* scr = (LAS float*)(c.lds + c.wave * 16640);
    const int nblk = ndst / 64, items = (K / 64) * nblk, lane = c.lane;
    for (int it = c.gw; it < items; it += c.NGW) {
        const int kb = it / nblk, nb = it % nblk, k0 = 64 * kb, n0 = 64 * nb;
        const int nn = n0 + 4 * (lane & 15); const float* sp = src(nn); const int kl = src.klim(nn); const bool al = sp && ((((size_t)sp) & 15) == 0) && ((ldsrc & 3) == 0);
        f32x4 v[16];
#pragma unroll
        for (int i = 0; i < 16; ++i) { const int kk = 4 * i + (lane >> 4); v[i] = (f32x4){0.f, 0.f, 0.f, 0.f};
            if (sp && k0 + kk < kl) { const float* p = sp + (size_t)(k0 + kk) * ldsrc; if (al) v[i] = *(const f32x4*)p; else v[i] = (f32x4){p[0], p[1], p[2], p[3]}; } }
#pragma unroll
        for (int i = 0; i < 16; ++i) { LAS float* tp = scr + (4 * i + (lane >> 4)) * 65 + 4 * (lane & 15); tp[0] = v[i][0]; tp[1] = v[i][1]; tp[2] = v[i][2]; tp[3] = v[i][3]; }
        LDS_WAIT();
        const int cc = lane & 7;
#pragma unroll
        for (int j = 0; j < 8; ++j) { const int n = (lane >> 3) + 8 * j; const LAS float* s = scr + (8 * cc) * 65 + n;
            u32x4 o; o.x = pk2(s[0 * 65], s[1 * 65]); o.y = pk2(s[2 * 65], s[3 * 65]); o.z = pk2(s[4 * 65], s[5 * 65]); o.w = pk2(s[6 * 65], s[7 * 65]);
            *(u32x4*)(dst + (size_t)(n0 + n) * K + k0 + 8 * cc) = o; }
        LDS_WAIT();
    }
}
struct SrcWin { const float* W; int layer; __device__ __forceinline__ int klim(int) const { return 1 << 30; }
    __device__ __forceinline__ const float* operator()(int n) const {
        const int rw = layer ? 3584 : 3520; int sc;
        if (n < 3072) sc = n; else if (n < 5632) sc = rw + (n - 3072); else if (n < 9728) sc = rw + 2608 + (n - 5632); else if (n < 10176) sc = 3072 + (n - 9728);
        else if (n < 10240) sc = layer ? 3520 + (n - 10176) : -1; else if (n < 10288) sc = rw + 2560 + (n - 10240); else sc = -1;
        return sc >= 0 ? W + sc : nullptr; } };
struct SrcOff { const float* W; __device__ __forceinline__ int klim(int) const { return 1 << 30; } __device__ __forceinline__ const float* operator()(int n) const { return W + n; } };
struct SrcGU { const float* Wg; const float* Wu; __device__ __forceinline__ int klim(int) const { return 1 << 30; }
    __device__ __forceinline__ const float* operator()(int nn) const { const int e = nn >> 10, r1 = nn & 1023, pn = r1 >> 8, rr = r1 & 255;
        const size_t du = (size_t)((const char*)Wu - (const char*)Wg);
        return (const float*)((const char*)Wg + (rr < 128 ? (size_t)0 : du)) + (size_t)e * D * FF + 128 * pn + (rr & 127); } };
struct SrcDN { const float* Wd; __device__ __forceinline__ int klim(int) const { return 1 << 30; }
    __device__ __forceinline__ const float* operator()(int nn) const { const int e = nn >> 11, n = nn & 2047; return Wd + (size_t)e * FF * D + n; } };

struct SrcLora { const float* w; const float* a_; const float* g; const float* v;
    __device__ __forceinline__ const float* operator()(int n) const { const int blk = n >> 10, cc = n & 1023; const size_t b0 = (size_t)w, d1 = (size_t)a_ - b0, d2 = (size_t)g - b0, d3 = (size_t)v - b0; if (blk == 3 && v == nullptr) return nullptr; const size_t off = blk == 0 ? 0 : (blk == 1 ? d1 : (blk == 2 ? d2 : d3)); return (const float*)(b0 + off) + cc; }
    __device__ __forceinline__ int klim(int n) const { const int blk = n >> 10; return blk < 2 ? 96 : (blk == 2 ? 256 : 64); } };
__device__ __forceinline__ void ph_conv(const Ctx& c, const PA& a, int layer) {
    unsigned char* ws = a.ws;
    const float* Win = layer ? a.in(2) : a.in(1); const int ldw = layer ? 16432 : 16368, rw = layer ? 3584 : 3520;
    transpose_task(c, SrcWin{Win, layer}, ldw, D, (bf16*)(ws + WS_WIN), LDP);
    transpose_task(c, SrcOff{Win + rw + 2608 + 4096}, ldw, D, (bf16*)(ws + WS_WG), NG);
    transpose_task(c, SrcOff{a.in(21) + (size_t)layer * RWW * D}, D, RWW, (bf16*)(ws + WS_WBR), D);
    transpose_task(c, SrcOff{a.in(22) + (size_t)layer * RWW * D}, D, RWW, (bf16*)(ws + WS_WBR) + (size_t)D * RWW, D);
    transpose_task(c, SrcOff{a.in(23) + (size_t)layer * RWW * D}, D, RWW, (bf16*)(ws + WS_WBR) + (size_t)2 * D * RWW, D);
    transpose_task(c, SrcOff{a.in(24) + (size_t)layer * D * D}, D, D, (bf16*)(ws + WS_WOUT), D);
    transpose_task(c, SrcOff{a.in(18) + (size_t)(layer * 2) * 2048 * 128}, 128, 2048, (bf16*)(ws + WS_W1T), 128);
    transpose_task(c, SrcOff{a.in(18) + (size_t)(layer * 2 + 1) * 2048 * 128}, 128, 2048, (bf16*)(ws + WS_W1T) + (size_t)128 * 2048, 128);
    transpose_task(c, SrcLora{a.in(6) + (size_t)layer * 96 * 1024, a.in(8) + (size_t)layer * 96 * 1024, a.in(11) + (size_t)layer * 256 * 1024, layer ? a.in(10) : nullptr}, 1024, 256, (bf16*)(ws + WS_WLORA), 4096);
    if (layer == 0) {
        const f32x4* x4 = (const f32x4*)a.in(0); f32x4* o4 = (f32x4*)a.out; uint2* xb = (uint2*)(ws + WS_XB);
        for (size_t i = (size_t)c.bx * 512 + c.tid; i < (size_t)T * D / 4; i += (size_t)c.G * 512) { const f32x4 v = x4[i]; o4[i] = v; xb[i] = make_uint2(pk2(v[0], v[1]), pk2(v[2], v[3])); }
        float* cs = (float*)(ws + WS_COS); float* sn = (float*)(ws + WS_SIN);
        for (int i = c.bx * 512 + c.tid; i < T * 64; i += c.G * 512) { const int t = i >> 6, j = i & 63;
            const double rev = (double)t * INV_FREQ[j] * 0.15915494309189533577; const float fr = (float)(rev - __builtin_rint(rev));
            cs[i] = __builtin_amdgcn_cosf(fr); sn[i] = __builtin_amdgcn_sinf(fr); }
    }
}
__device__ __forceinline__ void ph_conv_moe(const Ctx& c, const PA& a, int layer) {
    unsigned char* ws = a.ws; const size_t lo = (size_t)layer * NEXP * D * FF;
    transpose_task(c, SrcGU{a.in(31) + lo, a.in(32) + lo}, FF, D, (bf16*)(ws + WS_WGU), NEXP * 1024);
    transpose_task(c, SrcDN{a.in(33) + lo}, D, FF, (bf16*)(ws + WS_WDN), NEXP * D);
}

__device__ __forceinline__ float softplusf_(float x) { return fmaxf(x, 0.f) + log1pf(expf(-fabsf(x))); }
__device__ __forceinline__ void prep_rwkv(const Ctx& c, const PA& a, int layer) {
    unsigned char* ws = a.ws; const bf16* proj = (const bf16*)(ws + WS_PROJ);
    bf16* oR = (bf16*)(ws + WS_RW_R); bf16* oK = (bf16*)(ws + WS_RW_K); bf16* oV = (bf16*)(ws + WS_RW_V); bf16* oKK = (bf16*)(ws + WS_RW_KK); bf16* VF = (bf16*)(ws + WS_VF); bf16* AL = (bf16*)(ws + WS_ALORA);
    const float* mu = a.in(layer ? 4 : 3); const float* k_k = a.in(12) + layer * 1024;
    const int lane = c.lane;
    for (int t = c.gw; t < T; t += c.NGW) {
        const bf16* prow = proj + (size_t)t * LDP; const bf16* pprev = prow - LDP; const size_t o = (size_t)t * 1024 + 16 * lane;
#pragma unroll
        for (int piece = 0; piece < 3; ++piece) { float sh[16];
#pragma unroll
            for (int hf = 0; hf < 2; ++hf) { const int c8 = piece * 1024 + 16 * lane + 8 * hf; float pv[8], qv[8]; un8(*(const u32x4*)(prow + c8), pv);
                if (t > 0) un8(*(const u32x4*)(pprev + c8), qv); else { for (int j = 0; j < 8; ++j) qv[j] = 0.f; }
                const f32x4 m0 = *(const f32x4*)(mu + c8), m1 = *(const f32x4*)(mu + c8 + 4);
#pragma unroll
                for (int j = 0; j < 8; ++j) sh[8 * hf + j] = pv[j] + (qv[j] - pv[j]) * (j < 4 ? m0[j] : m1[j - 4]); }
            float lo8[8], hi8[8];
#pragma unroll
            for (int j = 0; j < 8; ++j) { lo8[j] = sh[j]; hi8[j] = sh[8 + j]; }
            bf16* dst = piece == 0 ? oR : (piece == 1 ? oK : oV);
            *(u32x4*)(dst + o) = pk8(lo8); *(u32x4*)(dst + o + 8) = pk8(hi8);
            if (piece == 2 && layer == 0) { *(u32x4*)(VF + o) = pk8(lo8); *(u32x4*)(VF + o + 8) = pk8(hi8); }
            if (piece == 1) { float n2 = 0.f;
#pragma unroll
                for (int j = 0; j < 16; ++j) { sh[j] *= k_k[16 * lane + j]; n2 += sh[j] * sh[j]; }
                n2 = sum_x1_2(n2); const float inv = 1.f / fmaxf(sqrtf(n2), 1e-12f);
#pragma unroll
                for (int j = 0; j < 8; ++j) { lo8[j] = sh[j] * inv; hi8[j] = sh[8 + j] * inv; }
                *(u32x4*)(oKK + o) = pk8(lo8); *(u32x4*)(oKK + o + 8) = pk8(hi8); } }
        { const int i8 = lane * 8; int sc, mi, fn, dc;
            if (i8 < 96) { sc = PC_XW + i8; mi = 3072 + i8; fn = 1; dc = i8; } else if (i8 < 192) { sc = PC_XA + (i8 - 96); mi = 3168 + (i8 - 96); fn = 0; dc = 256 + (i8 - 96); }
            else if (i8 < 448) { sc = PC_XG + (i8 - 192); mi = 3264 + (i8 - 192); fn = 2; dc = 512 + (i8 - 192); } else { sc = PC_XV + (i8 - 448); mi = 3520 + (i8 - 448); fn = layer ? 0 : 3; dc = 768 + (i8 - 448); }
            float pv[8], qv[8], ov[8]; un8(*(const u32x4*)(prow + sc), pv); if (t > 0) un8(*(const u32x4*)(pprev + sc), qv); else { for (int j = 0; j < 8; ++j) qv[j] = 0.f; }
#pragma unroll
            for (int j = 0; j < 8; ++j) { float s = 0.f;
                if (fn != 3) { const float mm = mu[mi + j]; s = pv[j] + (qv[j] - pv[j]) * mm; if (fn == 1) s = tanhf(s); else if (fn == 2) s = sigm(s); }
                ov[j] = s; }
            *(u32x4*)(AL + (size_t)t * 1024 + dc) = pk8(ov);
            const int zc = lane < 20 ? 96 + 8 * lane : (lane < 40 ? 352 + 8 * (lane - 20) : 832 + 8 * (lane - 40));
            { unsigned z0 = 0u; asm volatile("" : "+v"(z0)); *(u32x4*)(AL + (size_t)t * 1024 + zc) = (u32x4){z0, z0, z0, z0}; } }
    }
}
__device__ __forceinline__ float ex2(float x) { return __builtin_amdgcn_exp2f(x); }
__device__ __forceinline__ void un4(const uint2 p, float (&o)[4]) { o[0] = bflo(p.x); o[1] = bfhi(p.x); o[2] = bflo(p.y); o[3] = bfhi(p.y); }
struct EpiLora {
    static constexpr bool PERM = true, CHAIN = false;
    unsigned char* ws; PA pa; int layer;
#define EPL_ROWS(...) _Pragma("unroll") for (int bj = 0; bj < 2; ++bj) _Pragma("unroll") for (int hf = 0; hf < 2; ++hf) { const int col = col0 + bj * 128 + 4 * hf; PRE _Pragma("unroll") for (int ai = 0; ai < 2; ++ai) _Pragma("unroll") for (int m = 0; m < 4; ++m) { \
        const size_t o = (size_t)(row0 + ai * 128 + m * 16) * 1024 + col; const f32x4 x = acc[ai][bj][m][hf]; __VA_ARGS__ __builtin_amdgcn_sched_barrier(0); } }
    __device__ __forceinline__ void operator()(const f32x4 (&acc)[2][2][4][2], const Unit& u, int wr, int wc, int fr, int fq) const {
        const int blk = u.pn >> 2, row0 = u.pm * 256 + wr * 64 + fr, col0 = (u.pn & 3) * 256 + wc * 32 + 8 * fq;
        if (blk == 0) {
#define PRE const f32x4 p = *(const f32x4*)(pa.in(5) + layer * 1024 + col);
            EPL_ROWS({ f32x4 d;
                _Pragma("unroll") for (int j = 0; j < 4; ++j) { const float z = -(x[j] + p[j]), sp = fmaxf(z, 0.f) + 0.6931471805599453f * __builtin_amdgcn_logf(1.f + ex2(-1.4426950408889634f * fabsf(z)));
                    d[j] = ex2(-1.4426950408889634f * ex2(1.4426950408889634f * (-sp - 0.5f))); }
                *(f32x4*)((float*)(ws + WS_RW_W) + o) = d; })
#undef PRE
        } else if (blk == 1) {
#define PRE const f32x4 p = *(const f32x4*)(pa.in(7) + layer * 1024 + col), qa = *(const f32x4*)(pa.in(13) + layer * 1024 + col);
            EPL_ROWS({ float kk[4], k0[4]; un4(*(const uint2*)((const bf16*)(ws + WS_RW_KK) + o), kk); un4(*(const uint2*)((const bf16*)(ws + WS_RW_K) + o), k0); float bb[4], kf[4];
                _Pragma("unroll") for (int j = 0; j < 4; ++j) { const float aa = sigm_fast(x[j] + p[j]); bb[j] = kk[j] * aa; kf[j] = k0[j] * (1.f + (aa - 1.f) * qa[j]); }
                *(uint2*)((bf16*)(ws + WS_RW_B) + o) = make_uint2(pk2(bb[0], bb[1]), pk2(bb[2], bb[3])); *(uint2*)((bf16*)(ws + WS_RW_K) + o) = make_uint2(pk2(kf[0], kf[1]), pk2(kf[2], kf[3])); })
#undef PRE
        } else if (blk == 2) {
#define PRE
            EPL_ROWS({ *(uint2*)((bf16*)(ws + WS_RW_G) + o) = make_uint2(pg8::cvt_pk_bf16(x[0], x[1]), pg8::cvt_pk_bf16(x[2], x[3])); })
#undef PRE
        } else {
#define PRE const f32x4 p = *(const f32x4*)(pa.in(9) + col);
            EPL_ROWS({ float v0[4], vf[4], vv[4]; un4(*(const uint2*)((const bf16*)(ws + WS_RW_V) + o), v0); un4(*(const uint2*)((const bf16*)(ws + WS_VF) + o), vf);
                _Pragma("unroll") for (int j = 0; j < 4; ++j) vv[j] = v0[j] + (vf[j] - v0[j]) * sigm_fast(x[j] + p[j]);
                *(uint2*)((bf16*)(ws + WS_RW_V) + o) = make_uint2(pk2(vv[0], vv[1]), pk2(vv[2], vv[3])); })
#undef PRE
        }
    }
#undef EPL_ROWS
};
struct SchedLora { TileOrder to; int G, c, tid; const char* A; const char* B;
    __device__ __forceinline__ bool next(int i, Unit& u) const {
        if (!to.tile((long)i * G + c, u.pm, u.pn)) return false;
        u.a = A + (size_t)u.pm * 256 * 1024 * 2 + (size_t)(u.pn >> 2) * 256 * 2; u.b = B + (size_t)u.pn * 256 * 256 * 2; u.aux = 0; return true; }
};
__device__ __forceinline__ float gelu_tanh(float x) { return 0.5f * x * (1.f + tanhf(0.7978845608028654f * (x + 0.044715f * x * x * x))); }
__device__ __forceinline__ void prep_cmp(const Ctx& c, const PA& a, int layer) {
    unsigned char* ws = a.ws; const bf16* proj = (const bf16*)(ws + WS_PROJ);
    constexpr int RS = 2056;
    LAS bf16* sh_in = (LAS bf16*)c.lds; LAS float* sh_h = (LAS float*)(c.lds + 16 * RS * 2);
    const int tid = c.tid, lane = c.lane, r = lane & 15, q = lane >> 4, w = c.wave;
    for (int it = c.bx; it < 256 * 2; it += c.G) {
        const int cg = it >> 1, kv = it & 1, col0 = kv ? PC_VC : PC_KC, lk = layer * 2 + kv;
        const float* pe = a.in(17) + (size_t)lk * 2048;
        for (int idx = tid; idx < 16 * 2048 / 8; idx += 512) { const int row = idx >> 8, r8 = (idx & 255) * 8, cb = 4 * cg + (row >> 2), g = row & 3, l = r8 >> 6, d = r8 & 63;
            int tok = 16 * cb + l; tok = tok > T - 1 ? T - 1 : tok;
            float v[8]; un8(*(const u32x4*)(proj + (size_t)tok * LDP + col0 + g * 64 + d), v); const f32x4 p0 = *(const f32x4*)(pe + r8), p1 = *(const f32x4*)(pe + r8 + 4);
#pragma unroll
            for (int j = 0; j < 8; ++j) v[j] += j < 4 ? p0[j] : p1[j - 4];
            *(LAS u32x4*)(sh_in + row * RS + r8) = pk8(v); }
        __syncthreads();
        { const bf16* wt = (const bf16*)(ws + WS_W1T) + ((size_t)(kv * 128 + 16 * w + r)) * 2048 + 8 * q; const LAS bf16* ap = sh_in + r * RS + 8 * q;
            f32x4 acc = (f32x4){0.f, 0.f, 0.f, 0.f};
#pragma unroll 8
            for (int ks = 0; ks < 64; ++ks) acc = __builtin_amdgcn_mfma_f32_16x16x32_bf16(*(const LAS bf16x8*)(ap + 32 * ks), *(const bf16x8*)(wt + 32 * ks), acc, 0, 0, 0);
            const float bj = a.in(19)[lk * 128 + 16 * w + r];
#pragma unroll
            for (int i = 0; i < 4; ++i) sh_h[(4 * q + i) * 128 + 16 * w + r] = gelu_tanh(acc[i] + bj); }
        __syncthreads();
        const float* w2 = a.in(20) + (size_t)lk * 128 * 64;
        for (int oidx = tid; oidx < 16 * 64; oidx += 512) { const int row = oidx >> 6, d = oidx & 63, cb = 4 * cg + (row >> 2), g = row & 3; float o = 0.f;
#pragma unroll 16
            for (int j = 0; j < 128; ++j) o += sh_h[row * 128 + j] * w2[j * 64 + d];
            if (kv == 0) { const float ob = bf2f((bf16)f2bf(o)), n2 = wave_sum(ob * ob); if (c.lane == 0 && cb < NCMP) atomicMax((unsigned*)(ws + WS_CTL) + CW_KMAX + layer * 64 + 8 + g, __float_as_uint(sqrtf(n2))); }
            if (cb < NCMP) {
            const int blk = cb >> 6, kc = cb & 63;
            if (kv == 0) { const int j2 = kc >> 4, rr = kc & 15, ks = d >> 5, qq = (d & 31) >> 3, i = d & 7;
                ((bf16*)(ws + WS_KCMPB))[((((size_t)g * 16 + blk) * 8 + 2 * j2 + ks) * 64 + qq * 16 + rr) * 8 + i] = (bf16)f2bf(o);
                if (cb == 0) ((bf16*)(ws + WS_KCMPB))[((((size_t)g * 16 + 15) * 8 + 2 * 3 + ks) * 64 + qq * 16 + 15) * 8 + i] = 0; }
            else { const int ks = kc >> 5, kk = kc & 31, hh = kk >> 4, qq = (kk & 15) >> 2, i = (kk & 3) + 4 * hh, mt = d >> 4, rr = d & 15;
                ((bf16*)(ws + WS_VCMPT))[((((size_t)g * 16 + blk) * 8 + 2 * mt + ks) * 64 + qq * 16 + rr) * 8 + i] = (bf16)f2bf(o);
                if (cb == 0) ((bf16*)(ws + WS_VCMPT))[((((size_t)g * 16 + 15) * 8 + 2 * mt + 1) * 64 + 3 * 16 + rr) * 8 + 7] = 0; } } }
        __syncthreads();
    }
}
__device__ __forceinline__ void prep_rope(const Ctx& c, const PA& a) {
    unsigned char* ws = a.ws; bf16* proj = (bf16*)(ws + WS_PROJ); const float* cs = (const float*)(ws + WS_COS); const float* sn = (const float*)(ws + WS_SIN);
    for (int i = c.bx * 512 + c.tid; i < T * 8 * 8; i += c.G * 512) { const int j8 = (i & 7) * 8, h = (i >> 3) & 7, t = i >> 6;
        bf16* qp = proj + (size_t)t * LDP + PC_RQ + h * 128 + j8; float q1[8], q2[8], o1[8], o2[8]; un8(*(const u32x4*)qp, q1); un8(*(const u32x4*)(qp + 64), q2);
        const f32x4 c0 = *(const f32x4*)(cs + (size_t)t * 64 + j8), c1 = *(const f32x4*)(cs + (size_t)t * 64 + j8 + 4), s0 = *(const f32x4*)(sn + (size_t)t * 64 + j8), s1 = *(const f32x4*)(sn + (size_t)t * 64 + j8 + 4);
#pragma unroll
        for (int j = 0; j < 8; ++j) { const float co = j < 4 ? c0[j] : c1[j - 4], si = j < 4 ? s0[j] : s1[j - 4]; o1[j] = q1[j] * co - q2[j] * si; o2[j] = q1[j] * si + q2[j] * co; }
        *(u32x4*)qp = pk8(o1); *(u32x4*)(qp + 64) = pk8(o2); }
}

constexpr int RW_NC = 64, RW_CL = 256, RW_TS = 8;
typedef float f32x2 __attribute__((ext_vector_type(2)));
__device__ __forceinline__ void rw_put8(LAS float* d, u32x4 v) { *(LAS f32x4*)d = (f32x4){bflo(v.x), bfhi(v.x), bflo(v.y), bfhi(v.y)}; *(LAS f32x4*)(d + 4) = (f32x4){bflo(v.z), bfhi(v.z), bflo(v.w), bfhi(v.w)}; }
struct RwRegs { u32x4 kk, b, k, v, r, g; f32x4 w0, w1; };
__device__ __forceinline__ void rw_stage_load(const unsigned char* ws, RwRegs& R, int t0, int h, int lane, bool need_r) {
    const unsigned e = (unsigned)((t0 + (lane >> 3)) * 1024 + h * 64 + 8 * (lane & 7));
    R.kk = *(const u32x4*)(ws + ((unsigned)WS_RW_KK + e * 2u)); R.b = *(const u32x4*)(ws + ((unsigned)WS_RW_B + e * 2u)); R.k = *(const u32x4*)(ws + ((unsigned)WS_RW_K + e * 2u)); R.v = *(const u32x4*)(ws + ((unsigned)WS_RW_V + e * 2u));
    R.w0 = *(const f32x4*)(ws + ((unsigned)WS_RW_W + e * 4u)); R.w1 = *(const f32x4*)(ws + ((unsigned)WS_RW_W + e * 4u + 16u));
    R.r = (u32x4){0u, 0u, 0u, 0u}; R.g = R.r; if (need_r) { R.r = *(const u32x4*)(ws + ((unsigned)WS_RW_R + e * 2u)); R.g = *(const u32x4*)(ws + ((unsigned)WS_RW_G + e * 2u)); }
}
__device__ __forceinline__ void rw_stage_store(LAS float* tile, const RwRegs& R, int lane) {
    LAS float* tp = tile + (lane >> 3) * 384 + 8 * (lane & 7);
    rw_put8(tp, R.kk); rw_put8(tp + 64, R.b); *(LAS f32x4*)(tp + 128) = R.w0; *(LAS f32x4*)(tp + 132) = R.w1; rw_put8(tp + 192, R.k); rw_put8(tp + 256, R.r); rw_put8(tp + 320, R.v);
}
#define RW_LD4(p) (*(const LAS f32x4*)(p))
__device__ __forceinline__ void rw_step(f32x2 (&S)[32], const LAS float* tp, float vi) {
    f32x4 kk[16];
#pragma unroll
    for (int i = 0; i < 16; ++i) kk[i] = RW_LD4(tp + 4 * i);
    f32x4 b4[2][4], w4[2][4], k4[2][4];
#pragma unroll
    for (int i = 0; i < 4; ++i) { b4[0][i] = RW_LD4(tp + 64 + 4 * i); w4[0][i] = RW_LD4(tp + 128 + 4 * i); k4[0][i] = RW_LD4(tp + 192 + 4 * i); }
    __builtin_amdgcn_sched_barrier(0);
    f32x2 d0 = (f32x2){0.f, 0.f}, d1 = d0;
#pragma unroll
    for (int i = 0; i < 16; ++i) { d0 += S[2 * i] * (f32x2){kk[i][0], kk[i][1]}; d1 += S[2 * i + 1] * (f32x2){kk[i][2], kk[i][3]}; }
    const float sk = (d0[0] + d0[1]) + (d1[0] + d1[1]); const f32x2 nsk = (f32x2){-sk, -sk}, vi2 = (f32x2){vi, vi};
#pragma unroll
    for (int c = 0; c < 4; ++c) { const int cb = c & 1, nb = cb ^ 1;
        if (c + 1 < 4) {
#pragma unroll
            for (int i = 0; i < 4; ++i) { b4[nb][i] = RW_LD4(tp + 64 + 16 * (c + 1) + 4 * i); w4[nb][i] = RW_LD4(tp + 128 + 16 * (c + 1) + 4 * i); k4[nb][i] = RW_LD4(tp + 192 + 16 * (c + 1) + 4 * i); } }
        __builtin_amdgcn_sched_barrier(0);
#pragma unroll
        for (int i = 0; i < 4; ++i) { const int p = 8 * c + 2 * i;
            S[p] = S[p] * (f32x2){w4[cb][i][0], w4[cb][i][1]} + (vi2 * (f32x2){k4[cb][i][0], k4[cb][i][1]} + nsk * (f32x2){b4[cb][i][0], b4[cb][i][1]});
            S[p + 1] = S[p + 1] * (f32x2){w4[cb][i][2], w4[cb][i][3]} + (vi2 * (f32x2){k4[cb][i][2], k4[cb][i][3]} + nsk * (f32x2){b4[cb][i][2], b4[cb][i][3]}); }
        __builtin_amdgcn_sched_barrier(0); }
}
__device__ __forceinline__ float rw_dot_r(const f32x2 (&S)[32], const LAS float* tp) {
    f32x4 r4[16];
#pragma unroll
    for (int i = 0; i < 16; ++i) r4[i] = RW_LD4(tp + 256 + 4 * i);
    __builtin_amdgcn_sched_barrier(0);
    f32x2 d0 = (f32x2){0.f, 0.f}, d1 = d0;
#pragma unroll
    for (int i = 0; i < 16; ++i) { d0 += S[2 * i] * (f32x2){r4[i][0], r4[i][1]}; d1 += S[2 * i + 1] * (f32x2){r4[i][2], r4[i][3]}; }
    return (d0[0] + d0[1]) + (d1[0] + d1[1]);
}

__device__ __forceinline__ void rw_step_dual(f32x2 (&SP)[32], f32x2 (&SU)[32], const LAS float* tp, float vi) {
    f32x2 p0 = (f32x2){0.f, 0.f}, p1 = p0, u0 = p0, u1 = p0;
#pragma unroll
    for (int h2 = 0; h2 < 2; ++h2) { f32x4 kk[8];
#pragma unroll
        for (int i = 0; i < 8; ++i) kk[i] = RW_LD4(tp + 32 * h2 + 4 * i);
        __builtin_amdgcn_sched_barrier(0);
#pragma unroll
        for (int i = 0; i < 8; ++i) { const int p = 16 * h2 + 2 * i; const f32x2 ka = (f32x2){kk[i][0], kk[i][1]}, kb = (f32x2){kk[i][2], kk[i][3]};
            p0 += SP[p] * ka; p1 += SP[p + 1] * kb; u0 += SU[p] * ka; u1 += SU[p + 1] * kb; }
        __builtin_amdgcn_sched_barrier(0); }
    const float skp = (p0[0] + p0[1]) + (p1[0] + p1[1]), sku = (u0[0] + u0[1]) + (u1[0] + u1[1]); const f32x2 nsp = (f32x2){-skp, -skp}, nsu = (f32x2){-sku, -sku}, vi2 = (f32x2){vi, vi};
#pragma unroll
    for (int c = 0; c < 8; ++c) { f32x4 b4[2], w4[2], k4[2];
#pragma unroll
        for (int i = 0; i < 2; ++i) { b4[i] = RW_LD4(tp + 64 + 8 * c + 4 * i); w4[i] = RW_LD4(tp + 128 + 8 * c + 4 * i); k4[i] = RW_LD4(tp + 192 + 8 * c + 4 * i); }
        __builtin_amdgcn_sched_barrier(0);
#pragma unroll
        for (int i = 0; i < 2; ++i) { const int p = 4 * c + 2 * i;
            const f32x2 ba = (f32x2){b4[i][0], b4[i][1]}, bb = (f32x2){b4[i][2], b4[i][3]}, wa = (f32x2){w4[i][0], w4[i][1]}, wb = (f32x2){w4[i][2], w4[i][3]}, ka = (f32x2){k4[i][0], k4[i][1]}, kb = (f32x2){k4[i][2], k4[i][3]};
            SP[p] = SP[p] * wa + nsp * ba; SP[p + 1] = SP[p + 1] * wb + nsp * bb;
            SU[p] = SU[p] * wa + (vi2 * ka + nsu * ba); SU[p + 1] = SU[p + 1] * wb + (vi2 * kb + nsu * bb); }
        __builtin_amdgcn_sched_barrier(0); }
}
__device__ __forceinline__ void rw_pass1(const Ctx& c, const PA& a) {
    const unsigned char* ws = a.ws; LAS float* tile = (LAS float*)(c.lds + c.wave * (2 * RW_TS * 384 * 4));
    const int lane = c.lane;
    if (c.wave >= 4) return;
    for (int task = c.bx * 4 + c.wave; task < 16 * RW_NC; task += c.G * 4) {
        const int h = task / RW_NC, ch = task % RW_NC;
        f32x2 SP[32], SU[32]; int lz = lane; asm volatile("" : "+v"(lz));
#pragma unroll
        for (int j = 0; j < 32; ++j) { SP[j] = (f32x2){(2 * j == lz) ? 1.f : 0.f, (2 * j + 1 == lz) ? 1.f : 0.f}; SU[j] = (f32x2){0.f, 0.f}; }
        { RwRegs R; rw_stage_load(ws, R, ch * RW_CL, h, lane, false); rw_stage_store(tile, R, lane); }
        for (int ti = 0; ti < RW_CL / RW_TS; ++ti) { const int t0 = ch * RW_CL + ti * RW_TS; LAS float* tcur = tile + (ti & 1) * 3072; LAS float* tnxt = tile + ((ti + 1) & 1) * 3072;
            RwRegs R; if (ti + 1 < RW_CL / RW_TS) rw_stage_load(ws, R, t0 + RW_TS, h, lane, false);
            LDS_WAIT();
#pragma unroll 1
            for (int s = 0; s < RW_TS; ++s) { const LAS float* tp = tcur + s * 384; rw_step_dual(SP, SU, tp, tp[320 + lane]); }
            if (ti + 1 < RW_CL / RW_TS) rw_stage_store(tnxt, R, lane);
            LDS_WAIT();
        }
        float* op = (float*)(a.ws + WS_RWP) + ((size_t)task * 64 + lane) * 64; float* ou = (float*)(a.ws + WS_RWU) + ((size_t)task * 64 + lane) * 64;
#pragma unroll
        for (int jj = 0; jj < 16; ++jj) { *(f32x4*)(op + 4 * jj) = (f32x4){SP[2 * jj][0], SP[2 * jj][1], SP[2 * jj + 1][0], SP[2 * jj + 1][1]}; *(f32x4*)(ou + 4 * jj) = (f32x4){SU[2 * jj][0], SU[2 * jj][1], SU[2 * jj + 1][0], SU[2 * jj + 1][1]}; }
    }
}
#define RDL(v, l) __int_as_float(__builtin_amdgcn_readlane(__float_as_int(v), (l)))
__device__ __forceinline__ void rw_pass2(const Ctx& c, const PA& a) {
    const float* P = (const float*)(a.ws + WS_RWP); const float* U = (const float*)(a.ws + WS_RWU); float* Si = (float*)(a.ws + WS_RWS);
    LAS float* pb = (LAS float*)c.lds;
    const int lane = c.lane, w = c.wave, tid = c.tid;
    for (int unit = c.bx; unit < 256; unit += c.G) { const int h = unit >> 4, i = (unit & 15) * 4 + (w & 3); const size_t hc0 = (size_t)h * RW_NC;
        { const f32x4* src = (const f32x4*)(P + hc0 * 4096) + tid * 2; *(LAS f32x4*)(pb + tid * 8) = src[0]; *(LAS f32x4*)(pb + tid * 8 + 4) = src[1]; }
        float s = 0.f, u = U[(hc0 * 64 + i) * 64 + lane];
        __syncthreads();
        for (int ch = 0; ch < RW_NC; ++ch) { const LAS float* pc = pb + (ch & 1) * 4096 + lane;
            f32x4 n0 = (f32x4){0.f, 0.f, 0.f, 0.f}, n1 = n0; float un = 0.f;
            if (ch + 1 < RW_NC) { const f32x4* src = (const f32x4*)(P + (hc0 + ch + 1) * 4096) + tid * 2; n0 = src[0]; n1 = src[1]; un = U[((hc0 + ch + 1) * 64 + i) * 64 + lane]; }
            if (w < 4) { Si[((hc0 + ch) * 64 + i) * 64 + lane] = s;
                float a0 = u, a1 = 0.f, a2 = 0.f, a3 = 0.f;
#pragma unroll
                for (int i2 = 0; i2 < 64; i2 += 4) { a0 += RDL(s, i2) * pc[i2 * 64]; a1 += RDL(s, i2 + 1) * pc[(i2 + 1) * 64]; a2 += RDL(s, i2 + 2) * pc[(i2 + 2) * 64]; a3 += RDL(s, i2 + 3) * pc[(i2 + 3) * 64]; }
                s = (a0 + a1) + (a2 + a3); }
            { LAS float* dst = pb + ((ch + 1) & 1) * 4096 + tid * 8; *(LAS f32x4*)dst = n0; *(LAS f32x4*)(dst + 4) = n1; }
            u = un;
            __syncthreads(); }
    }
}
__device__ __forceinline__ void rw_pass3(const Ctx& c, const PA& a, int layer) {
    const unsigned char* ws = a.ws; LAS float* tile = (LAS float*)(c.lds + c.wave * 28800); LAS float* tg = tile + 6144; LAS float* ty = tg + 512; LAS float* trk = ty + 512; LAS float* tst = trk + 8;
    const float* Si = (const float*)(ws + WS_RWS); bf16* Y = (bf16*)(a.ws + WS_YRW); const float* r_k = a.in(14) + layer * 1024;
    const float* lng = a.in(15) + layer * 1024; const float* lnb = a.in(16) + layer * 1024;
    const int lane = c.lane;
    if (c.wave >= 4) return;
    for (int task = c.bx * 4 + c.wave; task < 16 * RW_NC; task += c.G * 4) {
        const int h = task / RW_NC, ch = task % RW_NC, col = h * 64 + lane;
        const float lg = lng[col], lb = lnb[col]; const f32x4 rk0 = *(const f32x4*)(r_k + h * 64 + 8 * (lane & 7)), rk1 = *(const f32x4*)(r_k + h * 64 + 8 * (lane & 7) + 4);
        f32x2 S[32]; const float* sp = Si + ((size_t)task * 64 + lane) * 64;
#pragma unroll
        for (int jj = 0; jj < 16; ++jj) { const f32x4 v = *(const f32x4*)(sp + 4 * jj); S[2 * jj] = (f32x2){v[0], v[1]}; S[2 * jj + 1] = (f32x2){v[2], v[3]}; }
        { RwRegs R; rw_stage_load(ws, R, ch * RW_CL, h, lane, true); rw_stage_store(tile, R, lane); rw_put8(tg + (lane >> 3) * 64 + 8 * (lane & 7), R.g); }
        for (int ti = 0; ti < RW_CL / RW_TS; ++ti) { const int t0 = ch * RW_CL + ti * RW_TS; LAS float* tcur = tile + (ti & 1) * 3072; LAS float* tnxt = tile + ((ti + 1) & 1) * 3072;
            RwRegs R; if (ti + 1 < RW_CL / RW_TS) rw_stage_load(ws, R, t0 + RW_TS, h, lane, true);
            LDS_WAIT();
            { const LAS float* rp = tcur + (lane >> 3) * 384 + 256 + 8 * (lane & 7); const LAS float* kp = tcur + (lane >> 3) * 384 + 192 + 8 * (lane & 7);
                const f32x4 r0 = *(const LAS f32x4*)rp, r1 = *(const LAS f32x4*)(rp + 4), k0 = *(const LAS f32x4*)kp, k1 = *(const LAS f32x4*)(kp + 4);
                float sm = ((r0[0] * k0[0] * rk0[0] + r0[1] * k0[1] * rk0[1]) + (r0[2] * k0[2] * rk0[2] + r0[3] * k0[3] * rk0[3])) + ((r1[0] * k1[0] * rk1[0] + r1[1] * k1[1] * rk1[1]) + (r1[2] * k1[2] * rk1[2] + r1[3] * k1[3] * rk1[3]));
                sm = sum_x1_2_4(sm); if ((lane & 7) == 0) trk[lane >> 3] = sm; }
#pragma unroll 1
            for (int s = 0; s < RW_TS; ++s) { const LAS float* tp = tcur + s * 384; const float vi = tp[320 + lane]; rw_step(S, tp, vi); ty[s * 64 + lane] = rw_dot_r(S, tp); }
            LDS_WAIT();
            { const LAS float* yp = ty + (lane >> 3) * 64 + 8 * (lane & 7); const f32x4 y0 = *(const LAS f32x4*)yp, y1 = *(const LAS f32x4*)(yp + 4);
                float sm = ((y0[0] + y0[1]) + (y0[2] + y0[3])) + ((y1[0] + y1[1]) + (y1[2] + y1[3]));
                sm = sum_x1_2_4(sm); const float mean = sm * (1.f / 64.f);
                const f32x4 d0 = y0 - mean, d1 = y1 - mean; float sq = ((d0[0] * d0[0] + d0[1] * d0[1]) + (d0[2] * d0[2] + d0[3] * d0[3])) + ((d1[0] * d1[0] + d1[1] * d1[1]) + (d1[2] * d1[2] + d1[3] * d1[3]));
                sq = sum_x1_2_4(sq);
                if ((lane & 7) == 0) { tst[2 * (lane >> 3)] = mean; tst[2 * (lane >> 3) + 1] = 1.f / sqrtf(sq * (1.f / 64.f) + 64e-5f); } }
            LDS_WAIT();
#pragma unroll
            for (int s = 0; s < RW_TS; ++s) { const float y = ty[s * 64 + lane], vi = tcur[s * 384 + 320 + lane], yn = (y - tst[2 * s]) * tst[2 * s + 1];
                Y[(size_t)(t0 + s) * 1024 + col] = (bf16)f2bf((yn * lg + lb + trk[s] * vi) * tg[s * 64 + lane]); }
            LDS_WAIT();
            if (ti + 1 < RW_CL / RW_TS) { rw_stage_store(tnxt, R, lane); rw_put8(tg + (lane >> 3) * 64 + 8 * (lane & 7), R.g); }
            LDS_WAIT();
        }
    }
}

__device__ __forceinline__ int ret_tok(int ks, int q, int i) { return 32 * ks + 4 * q + (i & 3) + ((i >> 2) << 4); }
__device__ __forceinline__ void prep_ret_frags(const Ctx& c, const PA& a, bool vonly = false) {
    unsigned char* ws = a.ws; bf16* proj = (bf16*)(ws + WS_PROJ); const float* cs = (const float*)(ws + WS_COS); const float* sn = (const float*)(ws + WS_SIN);
    LAS float* tile = (LAS float*)(c.lds + c.wave * 16896);
    const int lane = c.lane, r = lane & 15, q = lane >> 4;
    for (int it = c.gw; it < 8 * 128 * 4 * 2; it += c.NGW) { if (vonly && (it & 1)) continue; const int ten = it & 1, ks = (it >> 1) & 3, ch = (it >> 3) & 127, h = it >> 10; const int tb = ch * 128 + 32 * ks;
        if (ten == 0) {
#pragma unroll
            for (int i = 0; i < 8; ++i) { const int id = lane + 64 * i, row = id >> 4, c8 = (id & 15) * 8; const u32x4 v = *(const u32x4*)(proj + (size_t)(tb + row) * LDP + PC_RV + h * 128 + c8);
                LAS float* tp = tile + row * 132 + c8; *(LAS f32x4*)tp = (f32x4){bflo(v.x), bfhi(v.x), bflo(v.y), bfhi(v.y)}; *(LAS f32x4*)(tp + 4) = (f32x4){bflo(v.z), bfhi(v.z), bflo(v.w), bfhi(v.w)}; }
        } else {
#pragma unroll
            for (int i = 0; i < 4; ++i) { const int id = lane + 64 * i, row = id >> 3, c8 = (id & 7) * 8; bf16* kp = proj + (size_t)(tb + row) * LDP + PC_RK + h * 128 + c8;
                const u32x4 lo = *(const u32x4*)kp, hi = *(const u32x4*)(kp + 64);
                const f32x4 c0 = *(const f32x4*)(cs + (size_t)(tb + row) * 64 + c8), c1 = *(const f32x4*)(cs + (size_t)(tb + row) * 64 + c8 + 4), s0 = *(const f32x4*)(sn + (size_t)(tb + row) * 64 + c8), s1 = *(const f32x4*)(sn + (size_t)(tb + row) * 64 + c8 + 4);
                const float k1[8] = {bflo(lo.x), bfhi(lo.x), bflo(lo.y), bfhi(lo.y), bflo(lo.z), bfhi(lo.z), bflo(lo.w), bfhi(lo.w)}, k2[8] = {bflo(hi.x), bfhi(hi.x), bflo(hi.y), bfhi(hi.y), bflo(hi.z), bfhi(hi.z), bflo(hi.w), bfhi(hi.w)};
                float o1[8], o2[8];
#pragma unroll
                for (int j = 0; j < 8; ++j) { const float co = j < 4 ? c0[j] : c1[j - 4], si = j < 4 ? s0[j] : s1[j - 4];
                    o1[j] = bf2f((bf16)f2bf((k1[j] * co - k2[j] * si) * 0.08838834764831845f)); o2[j] = bf2f((bf16)f2bf((k1[j] * si + k2[j] * co) * 0.08838834764831845f)); }
                *(u32x4*)kp = (u32x4){pk2(o1[0], o1[1]), pk2(o1[2], o1[3]), pk2(o1[4], o1[5]), pk2(o1[6], o1[7])}; *(u32x4*)(kp + 64) = (u32x4){pk2(o2[0], o2[1]), pk2(o2[2], o2[3]), pk2(o2[4], o2[5]), pk2(o2[6], o2[7])};
                LAS float* tp = tile + row * 132 + c8;
                *(LAS f32x4*)tp = (f32x4){o1[0], o1[1], o1[2], o1[3]}; *(LAS f32x4*)(tp + 4) = (f32x4){o1[4], o1[5], o1[6], o1[7]}; *(LAS f32x4*)(tp + 64) = (f32x4){o2[0], o2[1], o2[2], o2[3]}; *(LAS f32x4*)(tp + 68) = (f32x4){o2[4], o2[5], o2[6], o2[7]}; }
        }
        LDS_WAIT();
        bf16* dst = (bf16*)(ws + (ten == 0 ? WS_VFR : WS_KTR)) + (((size_t)(h * 128 + ch) * 4 + ks) * 8) * 512 + lane * 8;
        float dec[8];
#pragma unroll
        for (int i = 0; i < 8; ++i) { const int tl = ret_tok(0, q, i); dec[i] = ten ? expf(RET_LOGG[h] * (float)(127 - (32 * ks + tl))) : 1.f; }
#pragma unroll
        for (int mt = 0; mt < 8; ++mt) { float v[8];
#pragma unroll
            for (int i = 0; i < 8; ++i) v[i] = tile[ret_tok(0, q, i) * 132 + 16 * mt + r] * dec[i];
            *(u32x4*)(dst + (size_t)mt * 512) = (u32x4){pk2(v[0], v[1]), pk2(v[2], v[3]), pk2(v[4], v[5]), pk2(v[6], v[7])}; }
        LDS_WAIT();
    }
}
__device__ __forceinline__ void ret_kv(const Ctx& c, const PA& a) {
    const bf16* VF = (const bf16*)(a.ws + WS_VFR); const bf16* KT = (const bf16*)(a.ws + WS_KTR); float* KV = (float*)(a.ws + WS_RETKV);
    const int lane = c.lane, r = lane & 15, q = lane >> 4;
    for (int task = c.gw; task < 128 * 8 * 8; task += c.NGW) { const int it = task >> 3, w = task & 7, ch = it >> 3, h = it & 7; const size_t fb = ((size_t)(h * 128 + ch) * 8) * 4 * 512 + lane * 8;
        f32x4 acc[8];
#pragma unroll
        for (int mt = 0; mt < 8; ++mt) acc[mt] = (f32x4){0.f, 0.f, 0.f, 0.f};
#pragma unroll
        for (int ks = 0; ks < 4; ++ks) { const bf16x8 kb = *(const bf16x8*)(KT + fb + (size_t)(ks * 8 + w) * 512);
#pragma unroll
            for (int mt = 0; mt < 8; ++mt) { const bf16x8 va = *(const bf16x8*)(VF + fb + (size_t)(ks * 8 + mt) * 512); acc[mt] = __builtin_amdgcn_mfma_f32_16x16x32_bf16(kb, va, acc[mt], 0, 0, 0); } }
        float* o = KV + ((size_t)it * 128 + r) * 128 + 16 * w + 4 * q;
#pragma unroll
        for (int mt = 0; mt < 8; ++mt) *(f32x4*)(o + (size_t)(16 * mt) * 128) = acc[mt];
    }
}
__device__ __forceinline__ void ret_prefix(const Ctx& c, const PA& a) {
    const float* KV = (const float*)(a.ws + WS_RETKV); bf16* RT = (bf16*)(a.ws + WS_RT);
    typedef float f32x2_ __attribute__((ext_vector_type(2)));
    for (int i = c.bx * 512 + c.tid; i < 8 * 8192; i += c.G * 512) { const int h = i >> 13, e = (i & 8191) * 2; const float cd = expf(RET_LOGG[h] * 128.f);
        float r0 = 0.f, r1 = 0.f;
        for (int c0 = 0; c0 < 128; c0 += 16) { f32x2_ tmp[16];
#pragma unroll
            for (int k = 0; k < 16; ++k) tmp[k] = *(const f32x2_*)(KV + ((size_t)((c0 + k) * 8 + h) << 14) + e);
#pragma unroll
            for (int k = 0; k < 16; ++k) { *(unsigned*)(RT + ((size_t)((c0 + k) * 8 + h) << 14) + e) = pk2(r0, r1); r0 = r0 * cd + tmp[k][0]; r1 = r1 * cd + tmp[k][1]; } } }
}
__device__ __forceinline__ void ret_out(const Ctx& c, const PA& a, int wv_first, int wv_count) {
    const bf16* proj = (const bf16*)(a.ws + WS_PROJ); const bf16* VF = (const bf16*)(a.ws + WS_VFR); const bf16* RT = (const bf16*)(a.ws + WS_RT); bf16* Y = (bf16*)(a.ws + WS_YRET);
    const int lane = c.lane, r = lane & 15, q = lane >> 4;
    if (c.wave < wv_first) return;
    for (int task = c.bx * wv_count + (c.wave - wv_first); task < 128 * 8 * 8; task += c.G * wv_count) { const int it = task >> 3, w = task & 7, ch = it >> 3, h = it & 7; const float lg2 = RET_LOGG[h] * 1.4426950408889634f;
        const int iq = 16 * w + r, tq = ch * 128 + iq;
        bf16x8 qb[4];
#pragma unroll
        for (int ks = 0; ks < 4; ++ks) qb[ks] = *(const bf16x8*)(proj + (size_t)tq * LDP + PC_RQ + h * 128 + 32 * ks + 8 * q);
        f32x4 oi[8], oc[8];
#pragma unroll
        for (int mt = 0; mt < 8; ++mt) { oi[mt] = (f32x4){0.f, 0.f, 0.f, 0.f}; oc[mt] = oi[mt]; }
        const size_t fb = ((size_t)(h * 128 + ch) * 8) * 4 * 512 + lane * 8;
#pragma unroll
        for (int ks = 0; ks < 4; ++ks) if (2 * ks <= w) { f32x4 st[2];
#pragma unroll
            for (int jj = 0; jj < 2; ++jj) { const int j = 2 * ks + jj; st[jj] = (f32x4){0.f, 0.f, 0.f, 0.f};
                if (j <= w) { const bf16* kp = proj + (size_t)(ch * 128 + 16 * j + r) * LDP + PC_RK + h * 128 + 8 * q;
#pragma unroll
                    for (int k2 = 0; k2 < 4; ++k2) st[jj] = __builtin_amdgcn_mfma_f32_16x16x32_bf16(*(const bf16x8*)(kp + 32 * k2), qb[k2], st[jj], 0, 0, 0);
#pragma unroll
                    for (int i = 0; i < 4; ++i) { const int d = iq - (16 * j + 4 * q + i); st[jj][i] = d >= 0 ? st[jj][i] * __builtin_amdgcn_exp2f(lg2 * (float)d) : 0.f; } } }
            const u32x4 pw = (u32x4){pg8::cvt_pk_bf16(st[0][0], st[0][1]), pg8::cvt_pk_bf16(st[0][2], st[0][3]), pg8::cvt_pk_bf16(st[1][0], st[1][1]), pg8::cvt_pk_bf16(st[1][2], st[1][3])};
            const bf16x8 pf = __builtin_bit_cast(bf16x8, pw);
#pragma unroll
            for (int mt = 0; mt < 8; ++mt) oi[mt] = __builtin_amdgcn_mfma_f32_16x16x32_bf16(*(const bf16x8*)(VF + fb + (size_t)(ks * 8 + mt) * 512), pf, oi[mt], 0, 0, 0);
            __builtin_amdgcn_sched_barrier(0); }
        const bf16* rp = RT + ((size_t)it * 128 + r) * 128 + 8 * q;
#pragma unroll
        for (int mt = 0; mt < 8; ++mt)
#pragma unroll
            for (int ks = 0; ks < 4; ++ks) { oc[mt] = __builtin_amdgcn_mfma_f32_16x16x32_bf16(*(const bf16x8*)(rp + (size_t)(16 * mt) * 128 + 32 * ks), qb[ks], oc[mt], 0, 0, 0); if (ks == 3 && (mt & 1)) __builtin_amdgcn_sched_barrier(0); }
        const float qd = __builtin_amdgcn_exp2f(lg2 * (float)(iq + 1));
        float sm = 0.f;
#pragma unroll
        for (int mt = 0; mt < 8; ++mt) { oi[mt] = oi[mt] + oc[mt] * qd; sm += (oi[mt][0] + oi[mt][1]) + (oi[mt][2] + oi[mt][3]); }
        sm = sum_x16_32(sm); const float mean = sm * (1.f / 128.f); float sq = 0.f;
#pragma unroll
        for (int mt = 0; mt < 8; ++mt) { oi[mt] = oi[mt] - mean; sq += (oi[mt][0] * oi[mt][0] + oi[mt][1] * oi[mt][1]) + (oi[mt][2] * oi[mt][2] + oi[mt][3] * oi[mt][3]); }
        sq = sum_x16_32(sq); const float rs = 1.f / sqrtf(sq * (1.f / 128.f) + 1e-5f);
        const bf16* gp = proj + (size_t)tq * LDP + PC_RG + h * 128 + 4 * q; bf16* yp = Y + (size_t)tq * 1024 + h * 128 + 4 * q;
#pragma unroll
        for (int mt = 0; mt < 8; ++mt) { const uint2 gw = *(const uint2*)(gp + 16 * mt); const float g0 = bflo(gw.x), g1 = bfhi(gw.x), g2 = bflo(gw.y), g3 = bfhi(gw.y);
            uint2 o; o.x = pg8::cvt_pk_bf16(g0 * sigm(g0) * oi[mt][0] * rs, g1 * sigm(g1) * oi[mt][1] * rs); o.y = pg8::cvt_pk_bf16(g2 * sigm(g2) * oi[mt][2] * rs, g3 * sigm(g3) * oi[mt][3] * rs);
            *(uint2*)(yp + 16 * mt) = o; }
    }
}


constexpr float NSA_C = 0.125f * 1.4426950408889634f;
constexpr float NSA_C8 = NSA_C * (1.f / 16.f);
struct NsaSrc { const bf16* kf; const bf16* vf; };

__device__ __forceinline__ void nsa_loadK(const NsaSrc& src, int key0, bf16x8 (&kf)[4][2], int lane) {
    const bf16* kp = src.kf + (size_t)(key0 >> 6) * 4096 + lane * 8;
#pragma unroll
    for (int j = 0; j < 4; ++j) { kf[j][0] = *(const bf16x8*)(kp + (2 * j) * 512); kf[j][1] = *(const bf16x8*)(kp + (2 * j + 1) * 512); }
}
__device__ __forceinline__ void nsa_loadV(const NsaSrc& src, int key0, bf16x8 (&vf)[4][2], int lane) {
    const bf16* vp = src.vf + (size_t)(key0 >> 6) * 4096 + lane * 8;
#pragma unroll
    for (int mt = 0; mt < 4; ++mt) { vf[mt][0] = *(const bf16x8*)(vp + (2 * mt) * 512); vf[mt][1] = *(const bf16x8*)(vp + (2 * mt + 1) * 512); }
}
__device__ __forceinline__ void nsa_qk(const bf16x8 (&kf)[4][2], const bf16x8 (&qf)[2], f32x4 (&st)[4]) {
#pragma unroll
    for (int j = 0; j < 4; ++j) { st[j] = (f32x4){0.f, 0.f, 0.f, 0.f};
        st[j] = __builtin_amdgcn_mfma_f32_16x16x32_bf16(kf[j][0], qf[0], st[j], 0, 0, 0); st[j] = __builtin_amdgcn_mfma_f32_16x16x32_bf16(kf[j][1], qf[1], st[j], 0, 0, 0); }
}
template <int MODE, bool MASKED>
__device__ __forceinline__ void nsa_rest(f32x4 (&st)[4], const bf16x8 (&vf)[4][2], int key0, int lo, int hi, f32x4 (&O)[4], float& m, float& l, float inv, int r, int q, LAS float* impA, LAS float* impB) {
    const float cm = NSA_C * m; float ps = 0.f;
#pragma unroll
    for (int j = 0; j < 4; ++j)
#pragma unroll
        for (int i = 0; i < 4; ++i) { float e = __builtin_amdgcn_exp2f(NSA_C * st[j][i] - cm);
            if (MASKED) { const int key = key0 + 16 * j + 4 * q + i; e = (key >= lo && key <= hi) ? e : 0.f; }
            st[j][i] = MODE == 2 ? e * inv : e; ps += e; }
    if (MODE != 2) l += ps;
    if (MODE == 2) {
#pragma unroll
        for (int j = 0; j < 4; ++j) { float a = (st[j][0] + st[j][1]) + (st[j][2] + st[j][3]), b = st[j][3];
            a = sum_x1_2(a); b = sum_x1_2(b);
            if ((r & 3) == 0) { const int J = (r >> 2) * 260 + (key0 >> 2) + 4 * j + q; atomicAdd((float*)(impA + J), a); atomicAdd((float*)(impA + J + 1), b); } } }
    if (MODE != 0) {
        bf16x8 pf[2];
#pragma unroll
        for (int ks = 0; ks < 2; ++ks) { const unsigned w0 = pg8::cvt_pk_bf16(st[2 * ks][0], st[2 * ks][1]), w1 = pg8::cvt_pk_bf16(st[2 * ks][2], st[2 * ks][3]),
                                                        w2 = pg8::cvt_pk_bf16(st[2 * ks + 1][0], st[2 * ks + 1][1]), w3 = pg8::cvt_pk_bf16(st[2 * ks + 1][2], st[2 * ks + 1][3]);
            const u32x4 w = (u32x4){w0, w1, w2, w3}; pf[ks] = __builtin_bit_cast(bf16x8, w); }
#pragma unroll
        for (int mt = 0; mt < 4; ++mt) {
#pragma unroll
            for (int ks = 0; ks < 2; ++ks) O[mt] = __builtin_amdgcn_mfma_f32_16x16x32_bf16(vf[mt][ks], pf[ks], O[mt], 0, 0, 0); } }
}
#define NSA_REST_(MODE, ST, VF, K0, LO, HI, LOU, HIU, INV) do { if ((K0) >= (LOU) && (K0) + 63 <= (HIU)) nsa_rest<MODE, false>(ST, VF, K0, LO, HI, O, m, l, INV, r, q, impA, impB);     \
        else nsa_rest<MODE, true>(ST, VF, K0, LO, HI, O, m, l, INV, r, q, impA, impB); } while (0)
#define NSA_LOOP(MODE, SRC, NBLK, KEY0, LO, HI, LOU, HIU, INV) do { const int nblk_ = (NBLK); if (nblk_ > 0) { bf16x8 kf_[4][2], vf_[4][2]; f32x4 st_[4]; nsa_loadK(SRC, KEY0(0), kf_, lane); \
    _Pragma("unroll 1") for (int b_ = 0; b_ < nblk_; ++b_) { const int k0_ = KEY0(b_); if (MODE != 0) nsa_loadV(SRC, k0_, vf_, lane); \
        nsa_qk(kf_, qf, st_); __builtin_amdgcn_sched_barrier(0); \
        if (b_ + 1 < nblk_) nsa_loadK(SRC, KEY0(b_ + 1), kf_, lane);     \
        NSA_REST_(MODE, st_, vf_, k0_, LO, HI, LOU, HIU, INV); } } } while (0)
typedef unsigned u32x2 __attribute__((ext_vector_type(2)));
__device__ __forceinline__ unsigned pack4_fp8(float a, float b, float c, float d) { int w = 0; w = __builtin_amdgcn_cvt_pk_fp8_f32(a, b, w, false); w = __builtin_amdgcn_cvt_pk_fp8_f32(c, d, w, true); return (unsigned)w; }
__device__ __forceinline__ void nsa_loadK8(const unsigned char* kf8, int key0, u32x4 (&k8)[4], int lane) {
    const unsigned char* kp = kf8 + (size_t)(key0 >> 6) * 4096 + lane * 16;
#pragma unroll
    for (int j = 0; j < 4; ++j) k8[j] = *(const u32x4*)(kp + j * 1024);
}
__device__ __forceinline__ void nsa_qk8(const u32x4 (&k8)[4], const long (&q8)[2], f32x4 (&st)[4]) {
#pragma unroll
    for (int j = 0; j < 4; ++j) st[j] = __builtin_amdgcn_mfma_f32_16x16x32_fp8_fp8(__builtin_bit_cast(long, (u32x2){k8[j].x, k8[j].y}), q8[0], (f32x4){0.f, 0.f, 0.f, 0.f}, 0, 0, 0);
#pragma unroll
    for (int j = 0; j < 4; ++j) st[j] = __builtin_amdgcn_mfma_f32_16x16x32_fp8_fp8(__builtin_bit_cast(long, (u32x2){k8[j].z, k8[j].w}), q8[1], st[j], 0, 0, 0);
}
__device__ __forceinline__ void nsa_loadV8(const unsigned char* vf8, int key0, u32x4 (&v8)[4], int lane) {
    const unsigned char* vp = vf8 + (size_t)(key0 >> 6) * 4096 + lane * 16;
#pragma unroll
    for (int mt = 0; mt < 4; ++mt) v8[mt] = *(const u32x4*)(vp + mt * 1024);
}
__device__ __forceinline__ void nsa_rest_dense(const f32x4 (&st)[4], const u32x4 (&v8)[4], f32x4 (&O)[4], float cm, float& l, int s4) {
    const bool i0 = s4 == 0, i1 = s4 == 1, i2 = s4 == 2, i3 = s4 == 3;
    const f32x4 x = i0 ? st[0] : (i1 ? st[1] : (i2 ? st[2] : st[3]));
    const float e0 = fminf(__builtin_amdgcn_exp2f(NSA_C8 * x[0] - cm), 416.f), e1 = fminf(__builtin_amdgcn_exp2f(NSA_C8 * x[1] - cm), 416.f), e2 = fminf(__builtin_amdgcn_exp2f(NSA_C8 * x[2] - cm), 416.f), e3 = fminf(__builtin_amdgcn_exp2f(NSA_C8 * x[3] - cm), 416.f);
    l += (e0 + e1) + (e2 + e3);
    const unsigned w = pack4_fp8(e0, e1, e2, e3);
    const long p0 = __builtin_bit_cast(long, (u32x2){i0 ? w : 0u, i1 ? w : 0u}), p1 = __builtin_bit_cast(long, (u32x2){i2 ? w : 0u, i3 ? w : 0u});
#pragma unroll
    for (int mt = 0; mt < 4; ++mt) O[mt] = __builtin_amdgcn_mfma_f32_16x16x32_fp8_fp8(__builtin_bit_cast(long, (u32x2){v8[mt].x, v8[mt].y}), p0, O[mt], 0, 0, 0);
#pragma unroll
    for (int mt = 0; mt < 4; ++mt) O[mt] = __builtin_amdgcn_mfma_f32_16x16x32_fp8_fp8(__builtin_bit_cast(long, (u32x2){v8[mt].z, v8[mt].w}), p1, O[mt], 0, 0, 0);
}
#define NSA_LOOP_DENSE(K8, V8, NBLK, KEY0, QD, CM, L, S4, KF, VA) do { const int nblk_ = (NBLK); if (nblk_ > 0) { u32x4 vb_[4]; f32x4 st_[4];     \
    _Pragma("unroll 1") for (int b_ = 0; b_ < nblk_; b_ += 2) { \
        if (b_ + 1 < nblk_) nsa_loadV8(V8, KEY0(b_ + 1), vb_, lane); \
        nsa_qk8(KF, QD, st_); __builtin_amdgcn_sched_barrier(0); \
        if (b_ + 1 < nblk_) nsa_loadK8(K8, KEY0(b_ + 1), KF, lane); \
        nsa_rest_dense(st_, VA, O, CM, L, S4); \
        if (b_ + 1 >= nblk_) break; \
        __builtin_amdgcn_sched_barrier(0); \
        if (b_ + 2 < nblk_) nsa_loadV8(V8, KEY0(b_ + 2), VA, lane); \
        nsa_qk8(KF, QD, st_); __builtin_amdgcn_sched_barrier(0); \
        if (b_ + 2 < nblk_) nsa_loadK8(K8, KEY0(b_ + 2), KF, lane); \
        nsa_rest_dense(st_, vb_, O, CM, L, S4); __builtin_amdgcn_sched_barrier(0); } } } while (0)
__device__ __forceinline__ float lane_get(float v, int src) { return __int_as_float(__builtin_amdgcn_ds_bpermute(src << 2, __float_as_int(v))); }
constexpr int NSA2_WLDS = 4352;
#ifndef NSA_SPLIT
#define NSA_SPLIT 218
#endif
__device__ __forceinline__ void nsa_attn2(const Ctx& c, const PA& a, int layer, int part) {
    const unsigned char* ws = a.ws; const bf16* proj = (const bf16*)(ws + WS_PROJ); bf16* Y = (bf16*)(a.ws + WS_YNSA);
    LAS float* impA = (LAS float*)(c.lds + (part ? 4 * 28800 + (c.wave - 4) * NSA2_WLDS : (c.wave < 4 ? c.wave * 24576 : 4 * 24576 + (c.wave - 4) * NSA2_WLDS)));         LAS float* impB = impA; LAS int* KST = (LAS int*)(impA + 1040);
    const int lane = c.lane, r = lane & 15, q = lane >> 4, tk = r >> 2, hh = r & 3;
    const bool xdeal = (c.G & 7) == 0; const int xg = c.bx & 7, ntask = xdeal ? T / 8 : T; unsigned* qctr = (unsigned*)(a.ws + WS_CTL) + CW_NSAQ + (xdeal ? xg : 0) * 64 + layer * 1024 + part * 32;
    const int nsplit = (ntask * NSA_SPLIT) >> 8, tbeg = part ? nsplit : 0, tend = part ? ntask : nsplit;
    unsigned tk_ = 0; if (lane == 0) tk_ = __hip_atomic_fetch_add(qctr, 1u, __ATOMIC_RELAXED, __HIP_MEMORY_SCOPE_AGENT);
    for (;;) { const int task = tbeg + (int)__builtin_amdgcn_readfirstlane(tk_); if (task >= tend) break;
        if (lane == 0) tk_ = __hip_atomic_fetch_add(qctr, 1u, __ATOMIC_RELAXED, __HIP_MEMORY_SCOPE_AGENT);
        const int rt = ntask - 1 - task, tq = xdeal ? 2 * rt + (xg >> 2) : rt >> 2, g = xdeal ? (xg & 3) : (rt & 3), t0 = 4 * tq, tcol = t0 + tk;
        const bf16* prow = proj + (size_t)tcol * LDP;
        bf16x8 qf[2]; { const bf16* qp = prow + PC_NQ + (g * 4 + hh) * 64 + 8 * q; qf[0] = *(const bf16x8*)qp; qf[1] = *(const bf16x8*)(qp + 32); }
        float gt0, gt1, gt2; { const bf16* gp = prow + PC_GATE + (g * 4 + hh) * 3; gt0 = sigm(bf2f(gp[0])); gt1 = sigm(bf2f(gp[1])); gt2 = sigm(bf2f(gp[2])); }
        float qn; { float f0[8], f1[8], sq = 0.f; un8(__builtin_bit_cast(u32x4, qf[0]), f0); un8(__builtin_bit_cast(u32x4, qf[1]), f1);
#pragma unroll
            for (int i = 0; i < 8; ++i) sq += f0[i] * f0[i] + f1[i] * f1[i];
            qn = sqrtf(sum_x16_32(sq)); }
        float kmx[3]; { const unsigned* kw = (const unsigned*)(ws + WS_CTL) + CW_KMAX + layer * 64 + g;
            kmx[0] = __uint_as_float(kw[0]); kmx[1] = __uint_as_float(kw[4]); kmx[2] = __uint_as_float(kw[8]); }
        const int cur = t0 >> 6, ncv = tcol >= 31 ? ((tcol - 31) >> 4) + 1 : 0, ncvmax = t0 + 3 >= 31 ? ((t0 + 3 - 31) >> 4) + 1 : 0;
#pragma unroll
        for (int i = 0; i < 17; ++i) if (lane + 64 * i < 1040) impA[lane + 64 * i] = 0.f;
        LDS_WAIT();
        f32x4 yacc[4], O[4];
#pragma unroll
        for (int mt = 0; mt < 4; ++mt) yacc[mt] = (f32x4){0.f, 0.f, 0.f, 0.f};
        if (ncvmax > 0) {
            NsaSrc sc; sc.kf = (const bf16*)(ws + WS_KCMPB) + (size_t)g * 16 * 4096; sc.vf = (const bf16*)(ws + WS_VCMPT) + (size_t)g * 16 * 4096;
            const int nb = (ncvmax + 63) >> 6; float m = qn * kmx[2], l = 0.f;
#define K0_CMP(b) (64 * (b))
            const int ncvmin = t0 >= 31 ? ((t0 - 31) >> 4) + 1 : 0;
            NSA_LOOP(0, sc, nb, K0_CMP, 0, ncv - 1, 0, ncvmin - 1, 0.f);
            l = sum_x16_32(l); const float inv = l > 0.f ? 1.f / l : 0.f;
#pragma unroll
            for (int mt = 0; mt < 4; ++mt) O[mt] = (f32x4){0.f, 0.f, 0.f, 0.f};
            NSA_LOOP(2, sc, nb, K0_CMP, 0, ncv - 1, 0, ncvmin - 1, inv);
#pragma unroll
            for (int mt = 0; mt < 4; ++mt) yacc[mt] = O[mt] * gt0;
        }
        LDS_WAIT();
        const unsigned char* ss8 = ws + WS_KF8 + (size_t)g * 256 * 4096; const unsigned char* sv8 = ws + WS_VF8 + (size_t)g * 256 * 4096;
        NsaSrc ss; ss.kf = (const bf16*)(ws + WS_KFS) + (size_t)g * 256 * 4096; ss.vf = (const bf16*)(ws + WS_VFS) + (size_t)g * 256 * 4096;
        f32x4 Oj[4]; const float mj = qn * kmx[0]; float lj = 0.f; const int nf = cur >= 2 ? 3 : cur + 1;
        { float m = mj, l = 0.f;
#pragma unroll
            for (int mt = 0; mt < 4; ++mt) O[mt] = (f32x4){0.f, 0.f, 0.f, 0.f};
#define K0_FRC(b) (64 * ((b) == 0 ? 0 : cur - (nf - 1) + (b)))
            NSA_LOOP(1, ss, nf, K0_FRC, 0, tcol, 0, t0, 0.f);
#pragma unroll
            for (int mt = 0; mt < 4; ++mt) Oj[mt] = O[mt];
            lj = l; }
        const float ljs = sum_x16_32(lj);
#pragma unroll 1
        for (int k = 0; k < 4; ++k) {
            const int hd = r >> 2, s4 = r & 3;
            bf16x8 qd[2]; { const bf16* qp = proj + (size_t)(t0 + k) * LDP + PC_NQ + (g * 4 + hd) * 64 + 8 * q; qd[0] = *(const bf16x8*)qp; qd[1] = *(const bf16x8*)(qp + 32); }
            u32x4 kfp[4], vap[4];
            float scv[4];
#pragma unroll
            for (int mm = 0; mm < 4; ++mm) { const int j = 4 * lane + mm; float s = -1.0e30f;
                if (j <= cur && !(j == 0 || j == cur || j == cur - 1)) s = impA[k * 260 + j];
                scv[mm] = s; }
            int nsel = 0;
            for (int itk = 0; itk < 16 - nf; ++itk) {
                float lv = scv[0]; int lj2 = 4 * lane;
                if (scv[1] > lv) { lv = scv[1]; lj2 = 4 * lane + 1; } if (scv[2] > lv) { lv = scv[2]; lj2 = 4 * lane + 2; } if (scv[3] > lv) { lv = scv[3]; lj2 = 4 * lane + 3; }
                const float vmax = wave_max(lv); if (vmax < -5.0e29f) break;
                const int jmin = wave_min_i(lv == vmax ? lj2 : (1 << 30));
                if (lane == 0) KST[itk] = jmin * 64;
                if (itk == 0) { const int k0f = __builtin_amdgcn_readfirstlane(jmin) * 64; nsa_loadK8(ss8, k0f, kfp, lane); nsa_loadV8(sv8, k0f, vap, lane); }
                if ((jmin >> 2) == lane) { const int mm = jmin & 3; if (mm == 0) scv[0] = -3.0e38f; else if (mm == 1) scv[1] = -3.0e38f; else if (mm == 2) scv[2] = -3.0e38f; else scv[3] = -3.0e38f; }
                ++nsel; }
            LDS_WAIT();
            { const bool mine = tk == k; const int srcl = (lane & 48) | (hh << 2) | tk;
                long q8[2];
#pragma unroll
                for (int ks = 0; ks < 2; ++ks) { float f[8]; un8(__builtin_bit_cast(u32x4, qd[ks]), f); q8[ks] = __builtin_bit_cast(long, (u32x2){pack4_fp8(4.f * f[0], 4.f * f[1], 4.f * f[2], 4.f * f[3]), pack4_fp8(4.f * f[4], 4.f * f[5], 4.f * f[6], 4.f * f[7])}); }
                const int srck = (lane & 48) | (k << 2) | hd;
                const float ljk = lane_get(ljs, srck), nj = (float)(129 + t0 + k - 64 * cur);
                const float kap = ljk > 0.f ? fminf(fmaxf(1.f + __builtin_amdgcn_logf(nj) - __builtin_amdgcn_logf(ljk), 0.f), 100.f) : 0.f, sk = __builtin_amdgcn_exp2f(-kap);
                const float cmd = NSA_C * lane_get(mj, srck) - kap;
                float ld = 0.f;
#pragma unroll
                for (int mt = 0; mt < 4; ++mt) O[mt] = (f32x4){0.f, 0.f, 0.f, 0.f};
#define K0_SEL(b) (__builtin_amdgcn_readfirstlane(KST[b]))
                NSA_LOOP_DENSE(ss8, sv8, nsel, K0_SEL, q8, cmd, ld, s4, kfp, vap);
                ld = sum_x16_32(sum_x1_2(ld)) * sk;
                const float l = ljs + lane_get(ld, srcl), sc = mine ? gt1 / l : 0.f;
#pragma unroll
                for (int mt = 0; mt < 4; ++mt)
#pragma unroll
                    for (int i = 0; i < 4; ++i) { const float od = lane_get(sum_x1_2(O[mt][i]) * (0.25f * sk), srcl);        yacc[mt][i] += (Oj[mt][i] + od) * sc; } }
            LDS_WAIT();
        }
        { NsaSrc sw; sw.kf = (const bf16*)(ws + WS_KFW) + (size_t)g * 256 * 4096; sw.vf = (const bf16*)(ws + WS_VFW) + (size_t)g * 256 * 4096;
            { const bf16* qp = prow + PC_NQ + (g * 4 + hh) * 64 + 8 * q; qf[0] = *(const bf16x8*)qp; qf[1] = *(const bf16x8*)(qp + 32); }
            float m = qn * kmx[1], l = 0.f; const int wlo = tcol - 511 > 0 ? tcol - 511 : 0, ulo = t0 - 511 > 0 ? t0 - 511 : 0;
#pragma unroll
            for (int mt = 0; mt < 4; ++mt) O[mt] = (f32x4){0.f, 0.f, 0.f, 0.f};
            const int jb0 = ulo >> 6;
#define K0_WIN(b) (64 * (jb0 + (b)))
            NSA_LOOP(1, sw, cur - jb0 + 1, K0_WIN, wlo, tcol, (t0 + 3 - 511 > 0 ? t0 + 3 - 511 : 0), t0, 0.f);
            l = sum_x16_32(l); const float sc = gt2 / l;
#pragma unroll
            for (int mt = 0; mt < 4; ++mt) yacc[mt] += O[mt] * sc; }
#pragma unroll
        for (int mt = 0; mt < 4; ++mt) { uint2 w; w.x = pg8::cvt_pk_bf16(yacc[mt][0], yacc[mt][1]); w.y = pg8::cvt_pk_bf16(yacc[mt][2], yacc[mt][3]);
            *(uint2*)(Y + (size_t)tcol * 1024 + (g * 4 + hh) * 64 + 16 * mt + 4 * q) = w; }
    }
}
__device__ __forceinline__ void prep_tiles(const Ctx& c, const PA& a, int layer) {
    const bf16* proj = (const bf16*)(a.ws + WS_PROJ);
    LAS bf16* tile = (LAS bf16*)(c.lds + c.wave * 8704);
    const int lane = c.lane, r = lane & 15, q = lane >> 4;
    for (int it = c.gw; it < 4 * 4 * 256; it += c.NGW) { const int blk = it & 255, g = (it >> 8) & 3, ten = it >> 10;
        const int scol = (ten == 0 ? PC_KS : (ten == 1 ? PC_VS : (ten == 2 ? PC_KW : PC_VW))) + g * 64;
        const u32x4* sp = (const u32x4*)(proj + (size_t)(blk * 64 + lane) * LDP + scol);
        float nq_ = 0.f;
#pragma unroll
        for (int i = 0; i < 8; ++i) { const u32x4 v = sp[i]; LAS unsigned* tp = (LAS unsigned*)(tile + lane * 66 + 8 * i); tp[0] = v.x; tp[1] = v.y; tp[2] = v.z; tp[3] = v.w;
            float f[8]; un8(v, f);
#pragma unroll
            for (int j = 0; j < 8; ++j) nq_ += f[j] * f[j]; }
        if ((ten & 1) == 0) { const float nm = wave_max(sqrtf(nq_)); if (lane == 0) atomicMax((unsigned*)(a.ws + WS_CTL) + CW_KMAX + layer * 64 + (ten >> 1) * 4 + g, __float_as_uint(nm)); }
        LDS_WAIT();
        bf16* dst = (bf16*)(a.ws + (ten == 0 ? WS_KFS : (ten == 1 ? WS_VFS : (ten == 2 ? WS_KFW : WS_VFW)))) + ((size_t)(g * 256 + blk) * 8) * 512 + lane * 8;
        if (ten == 0) {
            unsigned char* d8 = a.ws + WS_KF8 + ((size_t)(g * 256 + blk) * 4) * 1024 + lane * 16;
#pragma unroll
            for (int j = 0; j < 4; ++j) { unsigned w[4];
#pragma unroll
                for (int ks = 0; ks < 2; ++ks) { const LAS unsigned* tp = (const LAS unsigned*)(tile + (16 * j + r) * 66 + 32 * ks + 8 * q); float f[8]; un8((u32x4){tp[0], tp[1], tp[2], tp[3]}, f);
                    w[2 * ks] = pack4_fp8(4.f * f[0], 4.f * f[1], 4.f * f[2], 4.f * f[3]); w[2 * ks + 1] = pack4_fp8(4.f * f[4], 4.f * f[5], 4.f * f[6], 4.f * f[7]); }
                *(u32x4*)(d8 + j * 1024) = (u32x4){w[0], w[1], w[2], w[3]}; } }
        if (ten == 1) {
            unsigned char* d8 = a.ws + WS_VF8 + ((size_t)(g * 256 + blk) * 4) * 1024 + lane * 16;
#pragma unroll
            for (int mt = 0; mt < 4; ++mt) { unsigned w[4];
#pragma unroll
                for (int ks = 0; ks < 2; ++ks)
#pragma unroll
                    for (int h = 0; h < 2; ++h) { const int k0 = 32 * ks + 16 * h + 4 * q; const LAS bf16* tp = tile + k0 * 66 + 16 * mt + r;
                        w[2 * ks + h] = pack4_fp8(4.f * bf2f(tp[0]), 4.f * bf2f(tp[66]), 4.f * bf2f(tp[132]), 4.f * bf2f(tp[198])); }
                *(u32x4*)(d8 + mt * 1024) = (u32x4){w[0], w[1], w[2], w[3]}; } }
        if ((ten & 1) == 0) {
#pragma unroll
            for (int j = 0; j < 4; ++j)
#pragma unroll
                for (int ks = 0; ks < 2; ++ks) { const LAS unsigned* tp = (const LAS unsigned*)(tile + (16 * j + r) * 66 + 32 * ks + 8 * q);
                    *(u32x4*)(dst + (2 * j + ks) * 512) = (u32x4){tp[0], tp[1], tp[2], tp[3]}; }
        } else {
#pragma unroll
            for (int mt = 0; mt < 4; ++mt)
#pragma unroll
                for (int ks = 0; ks < 2; ++ks) { unsigned w[4];
#pragma unroll
                    for (int h = 0; h < 2; ++h)
#pragma unroll
                        for (int i2 = 0; i2 < 2; ++i2) { const int k0 = 32 * ks + 16 * h + 4 * q + 2 * i2;
                            w[2 * h + i2] = (unsigned)tile[k0 * 66 + 16 * mt + r] | ((unsigned)tile[(k0 + 1) * 66 + 16 * mt + r] << 16); }
                    *(u32x4*)(dst + (2 * mt + ks) * 512) = (u32x4){w[0], w[1], w[2], w[3]}; }
        }
        LDS_WAIT();
    }
}

__device__ __forceinline__ void ln_row(f32x4 (&v)[8], const float* gam, const float* bet, int lane) {
    float s = 0.f;
#pragma unroll
    for (int j = 0; j < 8; ++j) s += (v[j][0] + v[j][1]) + (v[j][2] + v[j][3]);
    const float mean = wave_sum(s) * (1.f / D); float s2 = 0.f;
#pragma unroll
    for (int j = 0; j < 8; ++j) { v[j] = v[j] - mean; s2 += (v[j][0] * v[j][0] + v[j][1] * v[j][1]) + (v[j][2] * v[j][2] + v[j][3] * v[j][3]); }
    const float rstd = 1.f / sqrtf(wave_sum(s2) * (1.f / D) + LN_EPS);
#pragma unroll
    for (int j = 0; j < 8; ++j) { const f32x4 g4 = *(const f32x4*)(gam + 4 * (lane + 64 * j)), b4 = *(const f32x4*)(bet + 4 * (lane + 64 * j)); v[j] = v[j] * rstd * g4 + b4; }
}
__device__ __forceinline__ void ph_ln1(const Ctx& c, const PA& a, int layer) {
    unsigned char* ws = a.ws; float* X = a.out; uint2* xb = (uint2*)(ws + WS_XB); const int lane = c.lane;
    for (int it = c.bx; it < T / 8; it += c.G) { const int t = it * 8 + c.wave;
        f32x4* row = (f32x4*)(X + (size_t)t * D); f32x4 v[8];
#pragma unroll
        for (int j = 0; j < 8; ++j) v[j] = row[lane + 64 * j];
        ln_row(v, a.in(25) + layer * D, a.in(26) + layer * D, lane);
#pragma unroll
        for (int j = 0; j < 8; ++j) { row[lane + 64 * j] = v[j]; xb[(size_t)t * (D / 4) + lane + 64 * j] = make_uint2(pk2(v[j][0], v[j][1]), pk2(v[j][2], v[j][3])); } }
}
__device__ __forceinline__ void ph_route(const Ctx& c, const PA& a, int layer) {
    unsigned char* ws = a.ws; const float* X = a.out;
    LAS float* lg = (LAS float*)(c.lds + c.wave * 256); LAS float* xr = (LAS float*)(c.lds + 4096 + c.wave * 8192); LAS float* wb = (LAS float*)(c.lds + 4096 + 65536);
    const int lane = c.lane, tid = c.tid, r0 = tid >> 3, p0_ = tid & 7;
    for (int it = c.bx; it < T / 8; it += c.G) { const int t = it * 8 + c.wave;
        const float* we = a.in(29) + (size_t)layer * D * 32; const float* wg = a.in(27) + (size_t)layer * D * 4;
        { const f32x4* row = (const f32x4*)(X + (size_t)t * D);
#pragma unroll
            for (int j = 0; j < 8; ++j) *(LAS f32x4*)(xr + 4 * (lane + 64 * j)) = row[lane + 64 * j];
#pragma unroll
            for (int i = 0; i < 4; ++i) *(LAS f32x4*)(wb + (r0 + 64 * i) * 36 + 4 + 4 * p0_) = *(const f32x4*)(we + (size_t)(r0 + 64 * i) * 32 + 4 * p0_);
            if (tid < 256) *(LAS f32x4*)(wb + tid * 36) = *(const f32x4*)(wg + (size_t)tid * 4); }
        __syncthreads();
        f32x4 acc[9];
#pragma unroll
        for (int q = 0; q < 9; ++q) acc[q] = (f32x4){0.f, 0.f, 0.f, 0.f};
#pragma unroll 1
        for (int ck = 0; ck < 8; ++ck) { const LAS float* wc = wb + (ck & 1) * 9216; LAS float* wn = wb + ((ck + 1) & 1) * 9216;
            const int d0 = ck + 1 < 8 ? 256 * (ck + 1) : 0;
            const f32x4 ne0 = *(const f32x4*)(we + (size_t)(d0 + r0) * 32 + 4 * p0_), ne1 = *(const f32x4*)(we + (size_t)(d0 + r0 + 64) * 32 + 4 * p0_),
                        ne2 = *(const f32x4*)(we + (size_t)(d0 + r0 + 128) * 32 + 4 * p0_), ne3 = *(const f32x4*)(we + (size_t)(d0 + r0 + 192) * 32 + 4 * p0_), ng = *(const f32x4*)(wg + (size_t)(d0 + (tid & 255)) * 4);
#pragma unroll
            for (int i = 0; i < 4; ++i) { const int dl = lane + 64 * i; const float x = xr[256 * ck + dl]; const LAS float* wr = wc + dl * 36;
#pragma unroll
                for (int q = 0; q < 9; ++q) acc[q] += *(const LAS f32x4*)(wr + 4 * q) * x;
                __builtin_amdgcn_sched_barrier(0); }
            *(LAS f32x4*)(wn + r0 * 36 + 4 + 4 * p0_) = ne0; *(LAS f32x4*)(wn + (r0 + 64) * 36 + 4 + 4 * p0_) = ne1; *(LAS f32x4*)(wn + (r0 + 128) * 36 + 4 + 4 * p0_) = ne2; *(LAS f32x4*)(wn + (r0 + 192) * 36 + 4 + 4 * p0_) = ne3;
            if (tid < 256) *(LAS f32x4*)(wn + tid * 36) = ng;
            __syncthreads(); }
        f32x4 ag = acc[0];
#pragma unroll
        for (int q = 0; q < 4; ++q) ag[q] = wave_sum(ag[q]) + a.in(28)[layer * 4 + q];
#pragma unroll
        for (int e4 = 0; e4 < 8; ++e4)
#pragma unroll
            for (int q = 0; q < 4; ++q) acc[1 + e4][q] = wave_sum(acc[1 + e4][q]);
        if (lane == 0) {
#pragma unroll
            for (int e4 = 0; e4 < 8; ++e4)
#pragma unroll
                for (int q = 0; q < 4; ++q) lg[e4 * 4 + q] = acc[1 + e4][q] + a.in(30)[layer * 32 + e4 * 4 + q]; }
        LDS_WAIT();
        int grp = 0; float gm = ag[0];
        if (ag[1] > gm) { gm = ag[1]; grp = 1; } if (ag[2] > gm) { gm = ag[2]; grp = 2; } if (ag[3] > gm) { gm = ag[3]; grp = 3; }
        const float gw_ = 1.f / (expf(ag[0] - gm) + expf(ag[1] - gm) + expf(ag[2] - gm) + expf(ag[3] - gm));
        float v0 = -3.0e38f, v1 = -3.0e38f; int i0 = 0, i1 = 0;
        for (int i = 0; i < 8; ++i) { const float x = lg[grp * 8 + i];
            if (x > v0) { v1 = v0; i1 = i0; v0 = x; i0 = i; } else if (x > v1) { v1 = x; i1 = i; } }
        const float e1 = expf(v1 - v0), p0 = 1.f / (1.f + e1), p1 = e1 * p0;
        if (lane == 0) { int* toke = (int*)(ws + WS_TOKE); float* tokw = (float*)(ws + WS_TOKW); unsigned* cnt = (unsigned*)(ws + WS_CTL) + CW_CNT + layer * 128; toke[2 * t] = grp * 8 + i0; toke[2 * t + 1] = grp * 8 + i1; tokw[2 * t] = p0 * gw_; tokw[2 * t + 1] = p1 * gw_;
            __hip_atomic_fetch_add(cnt + grp * 8 + i0, 1u, __ATOMIC_RELAXED, __HIP_MEMORY_SCOPE_AGENT); __hip_atomic_fetch_add(cnt + grp * 8 + i1, 1u, __ATOMIC_RELAXED, __HIP_MEMORY_SCOPE_AGENT); }
        __syncthreads();
    }
}
__device__ __forceinline__ void ph_slot(const Ctx& c, const PA& a, int layer) {
    unsigned char* ws = a.ws; unsigned* cnt = (unsigned*)(ws + WS_CTL) + CW_CNT + layer * 128; unsigned* cur = (unsigned*)(ws + WS_CTL) + CW_CUR + layer * 128;
    int* texp = (int*)(ws + WS_TEXP) + layer * 512; const int* toke = (const int*)(ws + WS_TOKE); int* slot = (int*)(ws + WS_SLOT);
    LAS int* pst = (LAS int*)c.lds;
    if (c.tid == 0) { int off = 0, nt = 0;
#pragma unroll 1
        for (int e = 0; e < NEXP; ++e) { const int n = (int)__hip_atomic_load(cnt + e, __ATOMIC_RELAXED, __HIP_MEMORY_SCOPE_AGENT), tl = (n + 255) >> 8;
            pst[e] = off; off += tl * 256;
            if (c.bx == 0) for (int q = 0; q < tl; ++q) texp[nt + q] = e;
            nt += tl; }
        if (c.bx == 0) texp[255] = nt; }
    __syncthreads();
    const u32x4* xb = (const u32x4*)(ws + WS_XB); u32x4* xs = (u32x4*)(ws + WS_XS);
    for (int a0 = c.gw * 16; a0 < 2 * T; a0 += c.NGW * 16) {
        int s = 0;
        if (c.lane < 16) { const int e = toke[a0 + c.lane]; s = pst[e] + (int)__hip_atomic_fetch_add(cur + e, 1u, __ATOMIC_RELAXED, __HIP_MEMORY_SCOPE_AGENT); slot[a0 + c.lane] = s; }
#pragma unroll 2
        for (int i = 0; i < 16; i += 2) { const int s0 = __builtin_amdgcn_readlane(s, i), s1 = __builtin_amdgcn_readlane(s, i + 1), t0 = (a0 + i) >> 1, t1 = (a0 + i + 1) >> 1;
            u32x4 v0[4], v1[4];
#pragma unroll
            for (int j = 0; j < 4; ++j) { v0[j] = xb[(size_t)t0 * 256 + c.lane + 64 * j]; v1[j] = xb[(size_t)t1 * 256 + c.lane + 64 * j]; }
#pragma unroll
            for (int j = 0; j < 4; ++j) { xs[(size_t)s0 * 256 + c.lane + 64 * j] = v0[j]; xs[(size_t)s1 * 256 + c.lane + 64 * j] = v1[j]; } } }
}
__device__ __forceinline__ void ph_ln2(const Ctx& c, const PA& a, int layer) {
    unsigned char* ws = a.ws; float* X = a.out; uint2* xb = (uint2*)(ws + WS_XB); const uint2* ys = (const uint2*)(ws + WS_YS);
    const float* gam = a.in(34) + layer * D; const float* bet = a.in(35) + layer * D; const int* slot = (const int*)(ws + WS_SLOT); const float* tokw = (const float*)(ws + WS_TOKW);
    const int lane = c.lane;
    for (int t = c.gw; t < T; t += c.NGW) {
        const int s0 = slot[2 * t], s1 = slot[2 * t + 1]; const float w0 = tokw[2 * t], w1 = tokw[2 * t + 1];
        f32x4* row = (f32x4*)(X + (size_t)t * D); f32x4 v[8];
#pragma unroll
        for (int j = 0; j < 8; ++j) { const uint2 y0 = ys[(size_t)s0 * 512 + lane + 64 * j], y1 = ys[(size_t)s1 * 512 + lane + 64 * j]; const f32x4 x = row[lane + 64 * j];
            v[j][0] = x[0] * DN_ALPHA + w0 * bflo(y0.x) + w1 * bflo(y1.x); v[j][1] = x[1] * DN_ALPHA + w0 * bfhi(y0.x) + w1 * bfhi(y1.x);
            v[j][2] = x[2] * DN_ALPHA + w0 * bflo(y0.y) + w1 * bflo(y1.y); v[j][3] = x[3] * DN_ALPHA + w0 * bfhi(y0.y) + w1 * bfhi(y1.y); }
        ln_row(v, gam, bet, lane);
#pragma unroll
        for (int j = 0; j < 8; ++j) { row[lane + 64 * j] = v[j]; xb[(size_t)t * (D / 4) + lane + 64 * j] = make_uint2(pk2(v[j][0], v[j][1]), pk2(v[j][2], v[j][3])); }
    }
}

enum { PH_CONV = 0, PH_INPROJ, PH_PREP, PH_LORA, PH_SCAN1, PH_SCAN2, PH_SCAN3, PH_GATES, PH_BRANCH, PH_OUT, PH_LN1, PH_SLOT, PH_MOE_GU, PH_MOE_DN, PH_LN2, NPH_L };
constexpr int NPH = NPH_L * DEPTH;

__device__ __forceinline__ Ctx mkctx(LAS unsigned char* lds, int wv) {
    int ln; asm volatile("v_mbcnt_lo_u32_b32 %0, -1, 0\n\tv_mbcnt_hi_u32_b32 %0, -1, %0" : "=v"(ln));
    int tid = wv * 64 + ln, bx = blockIdx.x, G = gridDim.x;
    asm volatile("" : "+s"(bx)); asm volatile("" : "+s"(G));
    Ctx c; c.lds = lds; c.tid = tid; c.lane = tid & 63; c.wave = __builtin_amdgcn_readfirstlane(tid >> 6); c.G = G; c.bx = bx; c.gw = bx * 8 + c.wave; c.NGW = G * 8; return c;
}
__global__ void __launch_bounds__(512, 2) fwd(Args args0) {
    extern __shared__ __attribute__((aligned(16))) unsigned char lds_raw[];
    LAS unsigned char* const lds0 = (LAS unsigned char*)lds_raw;
    const int lo = args0.ph_lo, hi = args0.ph_hi;
    const int wv0 = __builtin_amdgcn_readfirstlane(threadIdx.x >> 6);
    if (threadIdx.x < 36) ((LAS unsigned long long*)(lds0 + LDS_PTAB))[threadIdx.x] = (unsigned long long)args0.in[threadIdx.x];
    __syncthreads();
#if MK_ONE_LAUNCH
    volatile LAS unsigned* barw = (volatile LAS unsigned*)(lds0 + LDS_BARW);
    if (threadIdx.x == 0) { barw[0] = 0u; barw[1] = 0u; barw[2] = 0u; barw[3] = 0u; }
    __syncthreads();
    XcdBarrier bar = xcd_barrier_post((unsigned*)(args0.ws + WS_CTL) + CW_BAR, barw);
#define SEAM(p) do { if ((p) + 1 < hi) xcd_barrier(bar); } while (0)
#else
#define SEAM(p) do { } while (0)
#endif
#ifndef ONLY_PHASE
#define ONLY_PHASE -1
#endif
#define PHASE_BEGIN PA args; { unsigned long long w_ = (unsigned long long)args0.ws; asm volatile("" : "+s"(w_)); args.ws = (unsigned char*)(GAS unsigned char*)w_; unsigned long long o_ = (unsigned long long)args0.out; asm volatile("" : "+s"(o_)); args.out = (float*)(GAS float*)o_; args.tab = (const LAS unsigned*)(lds0 + LDS_PTAB); } unsigned char* const ws = args.ws; const Ctx c = mkctx(lds0, wv0); (void)ws; (void)c;
#define TASK_CTX() mkctx(lds0, wv0)
#ifdef TIME_PHASE
    unsigned long long tp_a_ = 0ull, tp_b_ = 0ull;
#define TP_BEGIN(p) do { if ((TIME_PHASE >> ((p) % NPH_L)) & 1) tp_a_ = __builtin_amdgcn_s_memrealtime(); } while (0)
#define TP_END(p) do { if ((TIME_PHASE >> ((p) % NPH_L)) & 1) tp_b_ += __builtin_amdgcn_s_memrealtime() - tp_a_; } while (0)
#else
#define TP_BEGIN(p) do { } while (0)
#define TP_END(p) do { } while (0)
#endif
#define IN(p) ((ONLY_PHASE < 0 || ONLY_PHASE == ((p) - pb)) && lo <= (p) && (p) < hi)
    for (int layer = 0; layer < DEPTH; ++layer) {
        const int pb = layer * NPH_L;
        if (IN(pb + PH_CONV)) { TP_BEGIN(pb + PH_CONV); PHASE_BEGIN ph_conv(c, args, layer); __syncthreads(); SEAM(pb + PH_CONV); TP_END(pb + PH_CONV); }
        if (IN(pb + PH_INPROJ)) { TP_BEGIN(pb + PH_INPROJ); PHASE_BEGIN
            Gemm g{D, D, D}; SchedPlain S; S.to.init(T / 256, PC_GATE / 256); S.G = c.G; S.c = c.bx; S.tid = c.tid; S.A = (const char*)(ws + WS_XB); S.B = (const char*)(ws + WS_WIN); S.ta = (size_t)256 * D * 2; S.tb = (size_t)256 * D * 2;
            EpiStore<0> E{(bf16*)(ws + WS_PROJ), LDP};
            pg8::gemm_phase<EpiStore<0>, SchedPlain, PG8_ALIGN, PG8_SP2>(c.lds, g, S, E);
#ifdef REP_GEMM
            pg8::gemm_phase<EpiStore<0>, SchedPlain, PG8_ALIGN, PG8_SP2>(c.lds, g, S, E);
#endif
            { const Ctx c2 = TASK_CTX(); int k2_ = D / 4; asm volatile("" : "+s"(k2_)); Gemm g2{k2_, D, D}; SchedSplitK S2; S2.G = c2.G; S2.c = c2.bx; S2.tid = c2.tid; S2.n = (T / 256) * 4; S2.A = (const char*)(ws + WS_XB); S2.B = (const char*)(ws + WS_WIN) + (size_t)PC_GATE * D * 2; S2.ta = (size_t)256 * D * 2; S2.kb = (size_t)(D / 4) * 2;
                EpiPart48 E2{(float*)(ws + WS_GPART)};
                pg8::gemm_phase<EpiPart48, SchedSplitK, PG8_ALIGN, PG8_SP2>(c2.lds, g2, S2, E2); }
            SEAM(pb + PH_INPROJ); TP_END(pb + PH_INPROJ); }
        if (IN(pb + PH_PREP)) { TP_BEGIN(pb + PH_PREP); PHASE_BEGIN
            { const float* gpart = (const float*)(ws + WS_GPART); bf16* pj = (bf16*)(ws + WS_PROJ);
#pragma unroll 1
                for (int i = c.bx * 512 + c.tid; i < T * 48; i += c.G * 512) { const int t = i / 48, cc = i - t * 48;
                    const float sgl = (gpart[i] + gpart[(size_t)T * 48 + i]) + (gpart[(size_t)2 * T * 48 + i] + gpart[(size_t)3 * T * 48 + i]);
                    pj[(size_t)t * LDP + PC_GATE + cc] = (bf16)f2bf(sgl); } }
            prep_rwkv(TASK_CTX(), args, layer); __syncthreads();
#ifdef REP_PRW
            prep_rwkv(TASK_CTX(), args, layer); __syncthreads();
#endif
#ifdef REP_PCMP
            prep_cmp(TASK_CTX(), args, layer);
#endif
#ifdef REP_PTILES
            prep_tiles(TASK_CTX(), args, layer); __syncthreads();
#endif
 prep_cmp(TASK_CTX(), args, layer); prep_rope(TASK_CTX(), args); prep_ret_frags(TASK_CTX(), args); __syncthreads(); prep_tiles(TASK_CTX(), args, layer);
#ifdef REP_RETPREP
            prep_ret_frags(TASK_CTX(), args, true); prep_ret_frags(TASK_CTX(), args, true);
#endif
 __syncthreads(); SEAM(pb + PH_PREP); TP_END(pb + PH_PREP); }
        if (IN(pb + PH_LORA)) { TP_BEGIN(pb + PH_LORA); PHASE_BEGIN
            int kl_ = 256; asm volatile("" : "+s"(kl_));
            Gemm g{kl_, 1024, 256}; SchedLora S; S.to.init(T / 256, layer ? 16 : 12); S.G = c.G; S.c = c.bx; S.tid = c.tid; S.A = (const char*)(ws + WS_ALORA); S.B = (const char*)(ws + WS_WLORA);
            EpiLora E{ws, args, layer};
            pg8::gemm_phase<EpiLora, SchedLora, PG8_ALIGN, PG8_SP2>(c.lds, g, S, E);
            SEAM(pb + PH_LORA); TP_END(pb + PH_LORA); }
#ifdef TIME_P1
        if (IN(pb + PH_SCAN1)) { PHASE_BEGIN tp_a_ = __builtin_amdgcn_s_memrealtime(); rw_pass1(c, args);
#else
        if (IN(pb + PH_SCAN1)) { TP_BEGIN(pb + PH_SCAN1); PHASE_BEGIN rw_pass1(c, args);
#endif
#if defined(REP_RW) || defined(REP_P1)
            rw_pass1(TASK_CTX(), args);
#endif
 ret_kv(TASK_CTX(), args);
#ifdef TIME_P1
 tp_b_ += __builtin_amdgcn_s_memrealtime() - tp_a_;
#endif
 nsa_attn2(TASK_CTX(), args, layer, 0); __syncthreads();

 SEAM(pb + PH_SCAN1); TP_END(pb + PH_SCAN1); }
        if (IN(pb + PH_SCAN2)) { TP_BEGIN(pb + PH_SCAN2); PHASE_BEGIN rw_pass2(c, args);
#if defined(REP_RW) || defined(REP_P2)
            rw_pass2(TASK_CTX(), args);
#endif
 ret_prefix(TASK_CTX(), args);
#ifdef REP_PFX
            ret_prefix(TASK_CTX(), args); ret_prefix(TASK_CTX(), args);
#endif
 __syncthreads(); SEAM(pb + PH_SCAN2); TP_END(pb + PH_SCAN2); }
        if (IN(pb + PH_SCAN3)) { TP_BEGIN(pb + PH_SCAN3); PHASE_BEGIN rw_pass3(c, args, layer); ret_out(TASK_CTX(), args, 4, 4); { const Ctx cn = TASK_CTX(); if (cn.wave >= 4) nsa_attn2(cn, args, layer, 1); }        __syncthreads(); SEAM(pb + PH_SCAN3); TP_END(pb + PH_SCAN3); }
        if (IN(pb + PH_GATES)) { TP_BEGIN(pb + PH_GATES); PHASE_BEGIN
            Gemm g{D, D, D}; SchedPlain S; S.to.init(T / 256, NG / 256); S.G = c.G; S.c = c.bx; S.tid = c.tid; S.A = (const char*)(ws + WS_XB); S.B = (const char*)(ws + WS_WG); S.ta = (size_t)256 * D * 2; S.tb = (size_t)256 * D * 2;
            EpiStore<1> E{(bf16*)(ws + WS_GATES), NG};
            pg8::gemm_phase<EpiStore<1>, SchedPlain, PG8_ALIGN, PG8_SP2>(c.lds, g, S, E);
#ifdef REP_GEMM
            pg8::gemm_phase<EpiStore<1>, SchedPlain, PG8_ALIGN, PG8_SP2>(c.lds, g, S, E);
#endif
            SEAM(pb + PH_GATES); TP_END(pb + PH_GATES); }
        if (IN(pb + PH_BRANCH)) { TP_BEGIN(pb + PH_BRANCH); PHASE_BEGIN
            Gemm g{RWW, RWW, RWW}; SchedBranch S; S.to.init(T / 256, D / 256); S.G = c.G; S.c = c.bx; S.tid = c.tid;
            S.A0 = (const char*)(ws + WS_YRW); S.sa = WS_YNSA - WS_YRW; static_assert(WS_YRET - WS_YNSA == WS_YNSA - WS_YRW, "y buffers equally spaced");
            S.B0 = (const char*)(ws + WS_WBR); S.sb = (size_t)D * RWW * 2; S.ta = (size_t)256 * RWW * 2; S.tb = (size_t)256 * RWW * 2;
            EpiBranch E{(bf16*)(ws + WS_MERGED), (const bf16*)(ws + WS_GATES)};
            pg8::gemm_phase<EpiBranch, SchedBranch, PG8_ALIGN, PG8_SP2>(c.lds, g, S, E);
            SEAM(pb + PH_BRANCH); TP_END(pb + PH_BRANCH); }
        if (IN(pb + PH_OUT)) { TP_BEGIN(pb + PH_OUT); PHASE_BEGIN
            Gemm g{D, D, D}; SchedPlain S; S.to.init(T / 256, D / 256); S.G = c.G; S.c = c.bx; S.tid = c.tid; S.A = (const char*)(ws + WS_MERGED); S.B = (const char*)(ws + WS_WOUT); S.ta = (size_t)256 * D * 2; S.tb = (size_t)256 * D * 2;
            EpiResid E{args.out};
            pg8::gemm_phase<EpiResid, SchedPlain, PG8_ALIGN, PG8_SP2>(c.lds, g, S, E);
            SEAM(pb + PH_OUT); TP_END(pb + PH_OUT); }
        if (IN(pb + PH_LN1)) { TP_BEGIN(pb + PH_LN1); PHASE_BEGIN ph_ln1(c, args, layer); __syncthreads(); ph_route(TASK_CTX(), args, layer); __syncthreads(); ph_conv_moe(TASK_CTX(), args, layer); __syncthreads();
#ifdef REP_CMOE
            ph_conv_moe(TASK_CTX(), args, layer); __syncthreads();
#endif
            SEAM(pb + PH_LN1); TP_END(pb + PH_LN1); }
        if (IN(pb + PH_SLOT)) { TP_BEGIN(pb + PH_SLOT); PHASE_BEGIN ph_slot(c, args, layer); __syncthreads(); SEAM(pb + PH_SLOT); TP_END(pb + PH_SLOT); }
        if (IN(pb + PH_MOE_GU)) { TP_BEGIN(pb + PH_MOE_GU); PHASE_BEGIN
            const int* texp = (const int*)(ws + WS_TEXP) + layer * 512;
            Gemm g{D, D, D}; SchedMoe S; S.nM = texp[255]; S.nN = 4; S.G = c.G; S.c = c.bx; S.tid = c.tid; S.A = (const char*)(ws + WS_XS); S.B = (const char*)(ws + WS_WGU); S.ta = (size_t)256 * D * 2; S.tb = (size_t)256 * D * 2; S.te = (size_t)1024 * D * 2; S.texp = texp;
            EpiGateUp E{(bf16*)(ws + WS_H)};
            pg8::gemm_phase<EpiGateUp, SchedMoe, PG8_ALIGN, PG8_SP2>(c.lds, g, S, E);
#ifdef REP_GEMM
            pg8::gemm_phase<EpiGateUp, SchedMoe, PG8_ALIGN, PG8_SP2>(c.lds, g, S, E);
#endif
            SEAM(pb + PH_MOE_GU); TP_END(pb + PH_MOE_GU); }
        if (IN(pb + PH_MOE_DN)) { TP_BEGIN(pb + PH_MOE_DN); PHASE_BEGIN
            const int* texp = (const int*)(ws + WS_TEXP) + layer * 512;
            Gemm g{FF, FF, FF}; SchedMoe S; S.nM = texp[255]; S.nN = 8; S.G = c.G; S.c = c.bx; S.tid = c.tid; S.A = (const char*)(ws + WS_H); S.B = (const char*)(ws + WS_WDN); S.ta = (size_t)256 * FF * 2; S.tb = (size_t)256 * FF * 2; S.te = (size_t)D * FF * 2; S.texp = texp;
            EpiStore<0> E{(bf16*)(ws + WS_YS), D};
            pg8::gemm_phase<EpiStore<0>, SchedMoe, PG8_ALIGN, PG8_SP2>(c.lds, g, S, E);
#ifdef REP_GEMM
            pg8::gemm_phase<EpiStore<0>, SchedMoe, PG8_ALIGN, PG8_SP2>(c.lds, g, S, E);
#endif
            SEAM(pb + PH_MOE_DN); TP_END(pb + PH_MOE_DN); }
        if (IN(pb + PH_LN2)) { TP_BEGIN(pb + PH_LN2); PHASE_BEGIN ph_ln2(c, args, layer); __syncthreads(); SEAM(pb + PH_LN2); TP_END(pb + PH_LN2); }
    }
#ifdef TIME_PHASE
    if (blockIdx.x == 0) { const unsigned long long w0 = __builtin_amdgcn_s_memrealtime(), dw = tp_b_ * TIME_AMP; while (__builtin_amdgcn_s_memrealtime() - w0 < dw) __builtin_amdgcn_s_sleep(8); }
#endif
#undef IN
#undef SEAM
}

#ifndef TRUNC_PH
#define TRUNC_PH NPH
#endif
#ifndef DUMP_MODE
#define DUMP_MODE 0
#endif
#if DUMP_MODE
__global__ void dump_k(float* out, const unsigned char* ws) {
    for (size_t i = (size_t)blockIdx.x * blockDim.x + threadIdx.x; i < (size_t)T * D; i += (size_t)gridDim.x * blockDim.x) {
        const int t = (int)(i / D), c = (int)(i % D); float v = 0.f;
#if DUMP_MODE == 1
        v = bf2f(((const bf16*)(ws + WS_PROJ))[(size_t)t * LDP + c * 5]);
#elif DUMP_MODE == 2
        if (c < 1024) v = bf2f(((const bf16*)(ws + WS_YRW))[(size_t)t * 1024 + c]); else v = bf2f(((const bf16*)(ws + WS_YNSA))[(size_t)t * 1024 + c - 1024]);
#elif DUMP_MODE == 3
        if (c < 1024) v = bf2f(((const bf16*)(ws + WS_YRET))[(size_t)t * 1024 + c]); else v = bf2f(((const bf16*)(ws + WS_MERGED))[(size_t)t * D + c]);
#elif DUMP_MODE == 4
        if (c < 1024) v = bf2f(((const bf16*)(ws + WS_YRET))[(size_t)t * 1024 + c]);
#elif DUMP_MODE == 5
        v = bf2f(((const bf16*)(ws + WS_GATES))[(size_t)t * NG + c * 3]);
#endif
        out[i] = (v == v && fabsf(v) < 1e30f) ? v : 0.f; }
}
#endif
extern "C" void kernel_launch(void* const* d_in, const int* in_sizes, int n_in, void* d_out, int out_size, void* d_ws, size_t ws_size, hipStream_t stream) {
    static int grid = 0;
    if (grid == 0) {
        if (n_in != 36 || out_size != T * D || ws_size < WS_END) { fprintf(stderr, "kernel_launch: unexpected shapes (n_in %d out %d ws %zu)\n", n_in, out_size, ws_size); grid = -1; return; }
        int dev = 0, cus = 0, per_cu = 0;
        if (hipGetDevice(&dev) != hipSuccess || hipDeviceGetAttribute(&cus, hipDeviceAttributeMultiprocessorCount, dev) != hipSuccess) { grid = -1; return; }
        if (hipFuncSetAttribute((const void*)fwd, hipFuncAttributeMaxDynamicSharedMemorySize, LDS_BYTES) != hipSuccess) { fprintf(stderr, "kernel_launch: hipFuncSetAttribute failed\n"); grid = -1; return; }
        if (hipOccupancyMaxActiveBlocksPerMultiprocessor(&per_cu, (const void*)fwd, 512, LDS_BYTES) != hipSuccess || per_cu < 1) fprintf(stderr, "kernel_launch: occupancy query says %d\n", per_cu);
        (void)hipGetLastError();
        grid = cus;
    }
    if (grid < 0) return;
    if (hipMemsetAsync((char*)d_ws + WS_CTL, 0, CTL_ZERO_BYTES, stream) != hipSuccess) return;
    Args a{};
    for (int i = 0; i < 36; ++i) a.in[i] = (const float*)d_in[i];
    a.out = (float*)d_out; a.ws = (unsigned char*)d_ws;
#if MK_ONE_LAUNCH
    a.ph_lo = 0; a.ph_hi = NPH;
    hipLaunchKernelGGL(fwd, dim3(grid), dim3(512), LDS_BYTES, stream, a);
#else
    for (int p = 0; p < TRUNC_PH; ++p) { a.ph_lo = p; a.ph_hi = p + 1; hipLaunchKernelGGL(fwd, dim3(grid), dim3(512), LDS_BYTES, stream, a); }
#if DUMP_MODE
    dump_k<<<2048, 256, 0, stream>>>((float*)d_out, (const unsigned char*)d_ws);
#endif
#endif
}
```

```cpp
#define MK_ONE_LAUNCH 1
#include <hip/hip_runtime.h>
#include <cstdio>
#include <cstdint>

#ifndef MK_ONE_LAUNCH
#define MK_ONE_LAUNCH 0
#endif

namespace pg8 {
#define PG8_LAS __attribute__((address_space(3)))
typedef unsigned short bf16_t;
typedef short bf16x8 __attribute__((ext_vector_type(8)));
typedef float f32x4 __attribute__((ext_vector_type(4)));
typedef unsigned u32x4 __attribute__((ext_vector_type(4)));
constexpr int BM = 256, BK = 64, HALF = 128, HTB = HALF * BK * 2  , STAGE_BYTES = 8 * HTB, NXCD = 8, WGM = 8;

__host__ __device__ __forceinline__ int lds_byte(int r, int c) { const int st = (r >> 4) * 2 + (c >> 5), rr = r & 15, cc = c & 31, ob = rr * 64 + cc * 2; return st * 1024 + (ob ^ (((ob >> 9) & 1) << 5)); }
__host__ __device__ __forceinline__ void stage_rc(int b, int& R, int& C) { const int st = b / 1024, sb = b % 1024, swz = sb ^ (((sb >> 9) & 1) << 5); R = (st >> 1) * 16 + swz / 64; C = (st & 1) * 32 + (swz % 64) / 2; }
__host__ __device__ __forceinline__ int perm32(int rho) { const int n = rho >> 4, i = rho & 15; return 8 * (i >> 2) + 4 * n + (i & 3); }

struct Unit { int pm, pn, aux; const char* a; const char* b; };
struct Gemm { int K, lda, ldb; };

struct TileOrder {
    int nM, nN, nwg;
    __device__ void init(int nM_, int nN_) { nM = nM_; nN = nN_; nwg = nM * nN; }
    __device__ bool tile(long L, int& pm, int& pn) const {
        if (L >= nwg) return false;
        int wgid = (int)L; { const int q = nwg / NXCD, r = nwg % NXCD, xcd = wgid % NXCD, off = wgid / NXCD; wgid = (xcd < r ? xcd * (q + 1) : r * (q + 1) + (xcd - r) * q) + off; }
        const int nig = WGM * nN, gid = wgid / nig, fm = gid * WGM, gsz = (nM - fm) < WGM ? (nM - fm) : WGM;
        pm = fm + ((wgid % nig) % gsz); pn = (wgid % nig) / gsz; return true;
    }
};

typedef float f32x2_t __attribute__((ext_vector_type(2))); typedef __bf16 bf16x2_t __attribute__((ext_vector_type(2)));
__device__ __forceinline__ unsigned cvt_pk_bf16(float lo, float hi) { f32x2_t v = {lo, hi}; bf16x2_t b = __builtin_convertvector(v, bf16x2_t); return __builtin_bit_cast(unsigned, b); }

template <class Epi, class Sched, bool ALIGN_EPI = false, bool SP2 = false>
__device__ __forceinline__ void gemm_phase(PG8_LAS unsigned char* lds, const Gemm g, const Sched& S, const Epi& E) {
    const int tid = S.tid, wid = __builtin_amdgcn_readfirstlane(tid >> 6), lane = tid & 63, wr = wid >> 2, wc = wid & 3, fr = lane & 15, fq = lane >> 4;
    const int K = g.K, nt = K / BK;
    unsigned voffA[2], voffB[2];
#pragma unroll
    for (int i = 0; i < 2; ++i) { int R, C; stage_rc(tid * 16 + i * 8192, R, C); const int Rb = Epi::PERM ? ((R & ~31) + perm32(R & 31)) : R;
        voffA[i] = (unsigned)(R * g.lda + C) * 2u; voffB[i] = (unsigned)(Rb * g.ldb + C) * 2u; }
    const size_t kstep = (size_t)(BK * 2);
    const size_t hstepA = (size_t)HALF * g.lda * 2, hstepB = (size_t)HALF * g.ldb * 2;
    const unsigned ldsw = (unsigned)wid * 1024u;
    const int aoff = lds_byte(wr * 64 + fr, fq * 8), boff = lds_byte(wc * 32 + fr, fq * 8);
#define PG8_SA(b, h) (((b) * 2 + (h)) * HTB)
#define PG8_SB(b, h) ((4 + (b) * 2 + (h)) * HTB)
#define PG8_STAGE(bufoff, gbase, voff) do { _Pragma("unroll") for (int _i = 0; _i < 2; ++_i) \
        __builtin_amdgcn_global_load_lds((const unsigned*)((const char*)(gbase) + (voff)[_i]), (PG8_LAS unsigned*)(lds + (bufoff) + ldsw + _i * 8192), 16, 0, 0); } while (0)
#define PG8_LDA(dst, b, h) do { _Pragma("unroll") for (int m = 0; m < 4; ++m) _Pragma("unroll") for (int k = 0; k < 2; ++k) dst[m][k] = *(const PG8_LAS bf16x8*)(lds + PG8_SA(b, h) + aoff + m * 2048 + k * 1024); } while (0)
#define PG8_LDB(dst, b, h) do { _Pragma("unroll") for (int n = 0; n < 2; ++n) _Pragma("unroll") for (int k = 0; k < 2; ++k) dst[n][k] = *(const PG8_LAS bf16x8*)(lds + PG8_SB(b, h) + boff + n * 2048 + k * 1024); } while (0)
#define PG8_MMA(ai, bj, At, Bt) do { __builtin_amdgcn_s_setprio(1); _Pragma("unroll") for (int m = 0; m < 4; ++m) _Pragma("unroll") for (int n = 0; n < 2; ++n) _Pragma("unroll") for (int k = 0; k < 2; ++k) \
        acc[ai][bj][m][n] = __builtin_amdgcn_mfma_f32_16x16x32_bf16(Bt[n][k], At[m][k], acc[ai][bj][m][n], 0, 0, 0); __builtin_amdgcn_s_setprio(0); } while (0)
#define PG8_WAIT_V(n) asm volatile("s_waitcnt vmcnt(" #n ")" ::: "memory")
#define PG8_WAIT_L(n) asm volatile("s_waitcnt lgkmcnt(" #n ")" ::: "memory")
#define PG8_BAR __builtin_amdgcn_s_barrier()
#define PG8_SCHED __builtin_amdgcn_sched_barrier(0)
    Unit cur, nxt; int ui = 0;
    if (!S.next(0, cur)) return;
    f32x4 acc[2][2][4][2];
#pragma unroll
    for (int a = 0; a < 2; ++a)
#pragma unroll
        for (int b = 0; b < 2; ++b)
#pragma unroll
            for (int m = 0; m < 4; ++m)
#pragma unroll
                for (int n = 0; n < 2; ++n) acc[a][b][m][n] = (f32x4){0.f, 0.f, 0.f, 0.f};
    bf16x8 At[4][2], B0[2][2], B1[2][2];
    const char* cA = cur.a; const char* cB = cur.b;
    if constexpr (SP2) {
        PG8_STAGE(PG8_SB(0, 0), cB, voffB); PG8_STAGE(PG8_SB(0, 1), cB + hstepB, voffB); PG8_STAGE(PG8_SA(0, 0), cA, voffA); PG8_STAGE(PG8_SA(0, 1), cA + hstepA, voffA);
        if (wr == 1) PG8_BAR;
        PG8_WAIT_V(2); PG8_BAR;
        PG8_STAGE(PG8_SB(1, 0), cB + kstep, voffB); PG8_STAGE(PG8_SA(1, 0), cA + kstep, voffA); PG8_STAGE(PG8_SB(1, 1), cB + hstepB + kstep, voffB);
        PG8_WAIT_V(6); PG8_BAR;
    } else {
        PG8_STAGE(PG8_SB(0, 0), cB, voffB); PG8_STAGE(PG8_SA(0, 0), cA, voffA); PG8_STAGE(PG8_SB(0, 1), cB + hstepB, voffB); PG8_STAGE(PG8_SA(0, 1), cA + hstepA, voffA);
        if (wr == 1) PG8_BAR;
        PG8_WAIT_V(4); PG8_BAR;
        PG8_STAGE(PG8_SB(1, 0), cB + kstep, voffB); PG8_STAGE(PG8_SA(1, 0), cA + kstep, voffA); PG8_STAGE(PG8_SB(1, 1), cB + hstepB + kstep, voffB);
        PG8_WAIT_V(6); PG8_BAR;
    }
    for (;;) {
        const bool has_next = S.next(ui + 1, nxt);
        const char* nA = has_next ? nxt.a : cA; const char* nB = has_next ? nxt.b : cB;
        for (int t = 0; t < nt; t += 2) {
            const bool last = (t == nt - 2);
            const char* a1 = cA + (size_t)(t + 1) * kstep;
            const char* a2 = last ? nA : cA + (size_t)(t + 2) * kstep; const char* b2 = last ? nB : cB + (size_t)(t + 2) * kstep;
            const char* a3 = a2 + kstep; const char* b3 = b2 + kstep;
            if constexpr (SP2) {
            PG8_LDB(B0, 0, 0); PG8_LDB(B1, 0, 1); PG8_SCHED; PG8_LDA(At, 0, 0); PG8_STAGE(PG8_SA(1, 1), a1 + hstepA, voffA);
            PG8_WAIT_V(8); PG8_WAIT_L(0); PG8_BAR; PG8_MMA(0, 0, At, B0); PG8_MMA(0, 1, At, B1); PG8_BAR; PG8_SCHED;
            PG8_LDA(At, 0, 1); PG8_STAGE(PG8_SB(0, 0), b2, voffB); PG8_STAGE(PG8_SB(0, 1), b2 + hstepB, voffB); PG8_STAGE(PG8_SA(0, 0), a2, voffA);
            PG8_WAIT_V(8); PG8_WAIT_L(0); PG8_BAR; PG8_MMA(1, 0, At, B0); PG8_MMA(1, 1, At, B1); PG8_BAR; PG8_SCHED;
            PG8_LDB(B0, 1, 0); PG8_LDB(B1, 1, 1); PG8_SCHED; PG8_LDA(At, 1, 0); PG8_STAGE(PG8_SA(0, 1), a2 + hstepA, voffA);
            PG8_WAIT_V(8); PG8_WAIT_L(0); PG8_BAR; PG8_MMA(0, 0, At, B0); PG8_MMA(0, 1, At, B1); PG8_BAR; PG8_SCHED;
            PG8_LDA(At, 1, 1); PG8_STAGE(PG8_SB(1, 0), b3, voffB); PG8_STAGE(PG8_SB(1, 1), b3 + hstepB, voffB); PG8_STAGE(PG8_SA(1, 0), a3, voffA);
            PG8_WAIT_V(8); PG8_WAIT_L(0); PG8_BAR; PG8_MMA(1, 0, At, B0); PG8_MMA(1, 1, At, B1); PG8_BAR; PG8_SCHED;
            } else {
            PG8_LDB(B0, 0, 0); PG8_SCHED; PG8_LDA(At, 0, 0); PG8_STAGE(PG8_SA(1, 1), a1 + hstepA, voffA);
            PG8_WAIT_L(8); PG8_BAR; PG8_WAIT_L(0); PG8_MMA(0, 0, At, B0); PG8_BAR; PG8_SCHED;
            PG8_LDB(B1, 0, 1); PG8_STAGE(PG8_SB(0, 0), b2, voffB);
            PG8_BAR; PG8_WAIT_L(0); PG8_MMA(0, 1, At, B1); PG8_BAR;
            PG8_LDA(At, 0, 1); PG8_STAGE(PG8_SA(0, 0), a2, voffA);
            PG8_BAR; PG8_WAIT_L(0); PG8_MMA(1, 0, At, B0); PG8_BAR; PG8_SCHED;
            PG8_STAGE(PG8_SB(0, 1), b2 + hstepB, voffB);
            PG8_WAIT_V(6); PG8_BAR; PG8_MMA(1, 1, At, B1); PG8_BAR;
            PG8_LDB(B0, 1, 0); PG8_SCHED; PG8_LDA(At, 1, 0); PG8_STAGE(PG8_SA(0, 1), a2 + hstepA, voffA);
            PG8_WAIT_L(8); PG8_BAR; PG8_WAIT_L(0); PG8_MMA(0, 0, At, B0); PG8_BAR; PG8_SCHED;
            PG8_LDB(B1, 1, 1); PG8_STAGE(PG8_SB(1, 0), b3, voffB);
            PG8_BAR; PG8_WAIT_L(0); PG8_MMA(0, 1, At, B1); PG8_BAR;
            PG8_LDA(At, 1, 1); PG8_STAGE(PG8_SA(1, 0), a3, voffA);
            PG8_BAR; PG8_WAIT_L(0); PG8_MMA(1, 0, At, B0); PG8_BAR; PG8_SCHED;
            PG8_STAGE(PG8_SB(1, 1), b3 + hstepB, voffB);
            PG8_WAIT_V(6); PG8_BAR; PG8_MMA(1, 1, At, B1); PG8_BAR;
            }
        }
        if constexpr (ALIGN_EPI) { if (wr == 0) PG8_BAR; }
        if constexpr (Epi::CHAIN) E.chain(acc, cur, wr, wc, fr, fq);
        else E(acc, cur, wr, wc, fr, fq);
        if (!has_next) break;
        if constexpr (!Epi::CHAIN)
#pragma unroll
        for (int a = 0; a < 2; ++a)
#pragma unroll
            for (int b = 0; b < 2; ++b)
#pragma unroll
                for (int m = 0; m < 4; ++m)
#pragma unroll
                    for (int n = 0; n < 2; ++n) acc[a][b][m][n] = (f32x4){0.f, 0.f, 0.f, 0.f};
        cur = nxt; cA = nA; cB = nB; ++ui;
        if constexpr (ALIGN_EPI) { if (wr == 1) PG8_BAR; }
    }
    PG8_WAIT_V(0);
    if constexpr (!ALIGN_EPI) { if (wr == 0) PG8_BAR; }
    PG8_BAR;
    #undef PG8_SA
#undef PG8_SB
#undef PG8_STAGE
#undef PG8_LDA
#undef PG8_LDB
#undef PG8_MMA
#undef PG8_WAIT_V
#undef PG8_WAIT_L
#undef PG8_BAR
#undef PG8_SCHED
}
}

#ifndef PG8_SP2
#define PG8_SP2 true
#endif
#ifndef PG8_ALIGN
#define PG8_ALIGN true
#endif

constexpr int T = 16384, D = 2048, DEPTH = 2;
constexpr int RWW = 1024;
constexpr int NCMP = 1023, NSELB = 256;
constexpr int NEXP = 32, FF = 512;
constexpr int LDP = 10496;
constexpr int NG = 6144;
constexpr int PC_RW_R = 0, PC_RW_K = 1024, PC_RW_V = 2048, PC_NQ = 3072, PC_KC = 4096, PC_VC = 4352, PC_KS = 4608, PC_VS = 4864, PC_KW = 5120, PC_VW = 5376,
              PC_RQ = 5632, PC_RK = 6656, PC_RV = 7680, PC_RG = 8704, PC_XW = 9728, PC_XA = 9824, PC_XG = 9920, PC_XV = 10176, PC_GATE = 10240;
constexpr float DN_ALPHA = 1.41421356237f, LN_EPS = 1e-5f;

constexpr size_t MiB = 1u << 20;
constexpr size_t WS_CTL = 0, CTL_ZERO_BYTES = 1 * MiB;
constexpr size_t WS_TEXP = 1 * MiB, WS_TOKE = WS_TEXP + 65536, WS_TOKW = WS_TOKE + 131072, WS_SLOT = WS_TOKW + 131072;
constexpr size_t WS_KCMPB = 2 * MiB, WS_VCMPT = 3 * MiB, WS_KF8 = 4 * MiB  , WS_COS = 8 * MiB, WS_SIN = 12 * MiB;
constexpr size_t WS_WIN = 16 * MiB, WS_WG = 57 * MiB, WS_WBR = 81 * MiB, WS_WOUT = 93 * MiB;
constexpr size_t WS_W1T = 103 * MiB, WS_WLORA = 101 * MiB, WS_ALORA = 896 * MiB;
constexpr size_t WS_XB = 112 * MiB, WS_VF = 176 * MiB, WS_PROJ = 208 * MiB;
constexpr size_t WS_RW_R = 536 * MiB, WS_RW_K = 568 * MiB, WS_RW_V = 600 * MiB, WS_RW_KK = 632 * MiB, WS_RW_B = 664 * MiB, WS_RW_W = 696 * MiB, WS_RW_G = 760 * MiB;
constexpr size_t WS_YRW = 800 * MiB, WS_YNSA = 832 * MiB, WS_YRET = 864 * MiB;
constexpr size_t WS_RWP = 896 * MiB, WS_RWU = 912 * MiB, WS_RWS = 928 * MiB, WS_RETKV = 944 * MiB, WS_KFS = 1008 * MiB, WS_VFS = 1016 * MiB, WS_KFW = 1024 * MiB, WS_VFW = 1032 * MiB, WS_VFR = 1040 * MiB, WS_KTR = 1072 * MiB, WS_RT = 1104 * MiB, WS_VF8 = 1136 * MiB  , WS_GPART = 1140 * MiB  , WS_END = 1152 * MiB;
constexpr size_t WS_GATES = 536 * MiB, WS_MERGED = 728 * MiB;
constexpr size_t WS_WGU = 208 * MiB, WS_WDN = 336 * MiB, WS_XS = 400 * MiB, WS_H = 560 * MiB, WS_YS = 600 * MiB;
static_assert(WS_PROJ + (size_t)T * LDP * 2 <= WS_RW_R && WS_GATES + (size_t)T * NG * 2 <= WS_MERGED && WS_MERGED + (size_t)T * D * 2 <= WS_YRW, "ws map");
static_assert(WS_XS + (size_t)160 * 256 * D * 2 <= WS_H && WS_H + (size_t)160 * 256 * FF * 2 <= WS_YS && WS_YS + (size_t)160 * 256 * D * 2 <= WS_RW_G, "ws map moe");
constexpr int CW_TMO = 0, CW_CNT = 1024, CW_CUR = 1088, CW_BAR = 4096, CW_NSAQ = 16384, CW_KMAX = 20480;
constexpr int LDS_BYTES = 147456, LDS_BARW = LDS_BYTES - 64;

#define GAS __attribute__((address_space(1)))
#define LAS __attribute__((address_space(3)))
typedef unsigned short bf16;
typedef float f32x4 __attribute__((ext_vector_type(4)));
typedef unsigned u32x4 __attribute__((ext_vector_type(4)));
typedef short bf16x8 __attribute__((ext_vector_type(8)));
typedef short bf16x4 __attribute__((ext_vector_type(4)));
#define LDS_WAIT() asm volatile("s_waitcnt lgkmcnt(0)" ::: "memory")
#define VM_WAIT() asm volatile("s_waitcnt vmcnt(0)" ::: "memory")

__device__ __forceinline__ float bf2f(unsigned short b) { return __uint_as_float(((unsigned)b) << 16); }
__device__ __forceinline__ unsigned f2bf(float f) { unsigned u = __float_as_uint(f); return (u + 0x7fffu + ((u >> 16) & 1u)) >> 16; }
__device__ __forceinline__ unsigned pk2(float lo, float hi) { return f2bf(lo) | (f2bf(hi) << 16); }
__device__ __forceinline__ float bflo(unsigned w) { return __uint_as_float(w << 16); }
__device__ __forceinline__ float bfhi(unsigned w) { return __uint_as_float(w & 0xffff0000u); }
#define DPP_I(v, ctrl) __builtin_amdgcn_update_dpp(0, (v), (ctrl), 0xf, 0xf, true)
#define DPP_F(v, ctrl) __int_as_float(__builtin_amdgcn_update_dpp(0, __float_as_int(v), (ctrl), 0xf, 0xf, true))
constexpr int DPP_X1 = 0xB1, DPP_X2 = 0x4E, DPP_HMIR = 0x141, DPP_ROR4 = 0x124, DPP_ROR8 = 0x128;
__device__ __forceinline__ float sum_x16_32(float v) { auto a = __builtin_amdgcn_permlane16_swap(__float_as_uint(v), __float_as_uint(v), false, false); v = __uint_as_float(a[0]) + __uint_as_float(a[1]);
    auto b = __builtin_amdgcn_permlane32_swap(__float_as_uint(v), __float_as_uint(v), false, false); return __uint_as_float(b[0]) + __uint_as_float(b[1]); }
__device__ __forceinline__ float max_x16_32(float v) { auto a = __builtin_amdgcn_permlane16_swap(__float_as_uint(v), __float_as_uint(v), false, false); v = fmaxf(__uint_as_float(a[0]), __uint_as_float(a[1]));
    auto b = __builtin_amdgcn_permlane32_swap(__float_as_uint(v), __float_as_uint(v), false, false); return fmaxf(__uint_as_float(b[0]), __uint_as_float(b[1])); }
__device__ __forceinline__ int min_x16_32(int v) { auto a = __builtin_amdgcn_permlane16_swap((unsigned)v, (unsigned)v, false, false); v = (int)a[0] < (int)a[1] ? (int)a[0] : (int)a[1];
    auto b = __builtin_amdgcn_permlane32_swap((unsigned)v, (unsigned)v, false, false); return (int)b[0] < (int)b[1] ? (int)b[0] : (int)b[1]; }
__device__ __forceinline__ float sum_x1_2(float v) { v += DPP_F(v, DPP_X1); v += DPP_F(v, DPP_X2); return v; }
__device__ __forceinline__ float sum_x1_2_4(float v) { v = sum_x1_2(v); v += DPP_F(v, DPP_HMIR); return v; }
__device__ __forceinline__ float wave_sum(float v) { v = sum_x1_2(v); v += DPP_F(v, DPP_ROR4); v += DPP_F(v, DPP_ROR8); return sum_x16_32(v); }
__device__ __forceinline__ float wave_max(float v) { v = fmaxf(v, DPP_F(v, DPP_X1)); v = fmaxf(v, DPP_F(v, DPP_X2)); v = fmaxf(v, DPP_F(v, DPP_ROR4)); v = fmaxf(v, DPP_F(v, DPP_ROR8)); return max_x16_32(v); }
__device__ __forceinline__ int wave_min_i(int v) { int w;
    w = DPP_I(v, DPP_X1); v = w < v ? w : v; w = DPP_I(v, DPP_X2); v = w < v ? w : v; w = DPP_I(v, DPP_ROR4); v = w < v ? w : v; w = DPP_I(v, DPP_ROR8); v = w < v ? w : v; return min_x16_32(v); }
__device__ __forceinline__ float sigm(float x) { return 1.f / (1.f + expf(-x)); }
__device__ __forceinline__ float sigm_fast(float x) { return __builtin_amdgcn_rcpf(1.f + __builtin_amdgcn_exp2f(-1.4426950408889634f * x)); }

__device__ const double INV_FREQ[64] = {1.00000000000000000e+00, 8.63988449483968579e-01, 7.46476040841712152e-01, 6.44946677103762411e-01, 5.57226479550717357e-01, 4.81437242078434580e-01, 4.15956216307184767e-01, 3.59381366380462752e-01, 3.10501349512486036e-01, 2.68269579527972590e-01, 2.31781818060089240e-01, 2.00256813604311801e-01, 1.73019573884589412e-01, 1.49486913370923374e-01, 1.29154966501488389e-01, 1.11588399250774864e-01, 9.64110880490750138e-02, 8.32980664765826800e-02, 7.19685673001152076e-02, 6.21800108732091794e-02, 5.37228111832403141e-02, 4.64158883361278016e-02, 4.01027913949520837e-02, 3.46483485573036779e-02, 2.99357729472049007e-02, 2.58641620527596990e-02, 2.23463372691659473e-02, 1.93069772888325060e-02, 1.66810053720005923e-02, 1.44121959671885402e-02, 1.24519708473503302e-02, 1.07583589854217902e-02, 9.29509789880649494e-03, 8.03085722139152032e-03, 6.93856787873718770e-03, 5.99484250318940964e-03, 5.17947467923121282e-03, 4.47500629725045354e-03, 3.86635375219241198e-03, 3.34048498351324471e-03, 2.88614044143008968e-03, 2.49359200498416086e-03, 2.15443469003188427e-03, 1.86140668735512152e-03, 1.60823387766704205e-03, 1.38949549437313892e-03, 1.20050805774840792e-03, 1.03722509540705695e-03, 8.96150501946605012e-04, 7.74263682681127744e-04, 6.68954878691414585e-04, 5.77969288415331340e-04, 4.99358789347314927e-04, 4.31440226144378508e-04, 3.72759372031494166e-04, 3.22059791872108224e-04, 2.78255940220712632e-04, 2.40409918350997456e-04, 2.07711392596645640e-04, 1.79460244029731636e-04, 1.55051577983262559e-04, 1.33962772451801717e-04, 1.15742288059205792e-04, 1.00000000000000005e-04};
__device__ const float RET_LOGG[8] = {-0.0317486983145803f, -0.015748356968139168f, -0.007843177461025893f, -0.003913899321136329f, -0.0019550348358033506f, -0.0009770396478266127f, -0.0004884004981088745f, -0.0002441704321739145f};

#define XB_TMO      128
#define XB_XCNT(j)  (256  + 64 * (j))
#define XB_XSUB(j)  (1280 + 64 * (j))
#define XB_XGEN(j)  (2304 + 64 * (j))
#define XB_TOP      3328
#define XB_TOPGEN   3392
#define XCD_BAR_WORDS 3456
#define XB_SPIN_CAP (1u << 18)

__device__ __forceinline__ unsigned xb_ld(unsigned* p)              { return __hip_atomic_load(p, __ATOMIC_RELAXED, __HIP_MEMORY_SCOPE_AGENT); }
__device__ __forceinline__ unsigned xb_add(unsigned* p, unsigned v) { return __hip_atomic_fetch_add(p, v, __ATOMIC_RELAXED, __HIP_MEMORY_SCOPE_AGENT); }
__device__ __forceinline__ unsigned xb_xcc_id() { return (unsigned)__builtin_amdgcn_s_getreg((3 << 11) | 20) & 0xFu; }
#define XB_SPIN(cond, bar) do { unsigned _sp = 0; while (cond) { __builtin_amdgcn_s_sleep(1); \
    if ((++_sp & 255u) == 0u) { if (xb_ld(&(bar)[XB_TMO])) break; if (_sp > XB_SPIN_CAP) { atomicAdd(&(bar)[XB_TMO], 1u); break; } } } } while (0)

struct XcdBarrier {
    unsigned* bar; unsigned x;
    volatile LAS unsigned* st;
};
__device__ __forceinline__ XcdBarrier xcd_barrier_post(unsigned* bar, volatile LAS unsigned* st) {
    XcdBarrier b; b.bar = bar; b.x = xb_xcc_id(); b.st = st;
    if (threadIdx.x == 0) (void)xb_add(&bar[XB_XCNT(b.x)], 1u);
    return b;
}
__device__ __forceinline__ void xcd_barrier_complete(unsigned* bar, unsigned x, unsigned& nloc, unsigned& nx) {
    const unsigned G = gridDim.x * gridDim.y * gridDim.z;
    unsigned sum, cnt, mine, sp = 0u;
    for (;;) {
        sum = 0u; cnt = 0u; mine = 0u;
#pragma unroll
        for (unsigned j = 0; j < 16; ++j) { const unsigned c = xb_ld(&bar[XB_XCNT(j)]); sum += c; cnt += (c > 0u) ? 1u : 0u; mine = (j == x) ? c : mine; }
        if (sum == G) break;
        __builtin_amdgcn_s_sleep(1);
        if ((++sp & 255u) == 0u) { if (xb_ld(&bar[XB_TMO])) break; if (sp > XB_SPIN_CAP) { atomicAdd(&bar[XB_TMO], 1u); break; } }
    }
    nloc = mine > 0u ? mine : 1u; nx = cnt > 0u ? cnt : 1u;
}
__device__ __forceinline__ void xcd_barrier(const XcdBarrier& b) {
    asm volatile("s_waitcnt vmcnt(0)" ::: "memory");
    __syncthreads();
    if (threadIdx.x == 0) {
        unsigned* bar = b.bar;
        __builtin_amdgcn_s_waitcnt(0);
        unsigned nloc = b.st[0], nx = b.st[1];
        if (nloc == 0u) { xcd_barrier_complete(bar, b.x, nloc, nx); b.st[0] = nloc; b.st[1] = nx; }
        const unsigned old = xb_add(&bar[XB_XSUB(b.x)], 1u);
        const unsigned gen = old / nloc;
        if (old + 1u == (gen + 1u) * nloc) {
            __builtin_amdgcn_fence(__ATOMIC_RELEASE, "agent");
            asm volatile("s_waitcnt vmcnt(0)" ::: "memory");
            const unsigned og = xb_add(&bar[XB_TOP], 1u);
            const unsigned tg = og / nx;
            if (og + 1u == (tg + 1u) * nx) xb_add(&bar[XB_TOPGEN], 1u);
            else XB_SPIN(xb_ld(&bar[XB_TOPGEN]) == tg, bar);
            __builtin_amdgcn_fence(__ATOMIC_ACQUIRE, "agent");
            xb_add(&bar[XB_XGEN(b.x)], 1u);
            asm volatile("s_waitcnt vmcnt(0)" ::: "memory");
        } else {
            XB_SPIN(xb_ld(&bar[XB_XGEN(b.x)]) == gen, bar);
            __builtin_amdgcn_fence(__ATOMIC_ACQUIRE, "agent");
            asm volatile("s_waitcnt vmcnt(0)" ::: "memory");
        }
    }
    __syncthreads();
}

#if defined(__HIP_DEVICE_COMPILE__)
#define ASSUME_GLOBAL(p) do { __builtin_assume(!__builtin_amdgcn_is_shared((const __attribute__((address_space(0))) void*)(p))); __builtin_assume(!__builtin_amdgcn_is_private((const __attribute__((address_space(0))) void*)(p))); } while (0)
#else
#define ASSUME_GLOBAL(p) do { } while (0)
#endif
struct Args { const float* in[36]; float* out; unsigned char* ws; int ph_lo, ph_hi; };
constexpr int LDS_PTAB = LDS_BYTES - 512;
struct PA { unsigned char* ws; float* out; const LAS unsigned* tab;
    __device__ __forceinline__ const float* in(int i) const { const unsigned lo = __builtin_amdgcn_readfirstlane(tab[2 * i]), hi = __builtin_amdgcn_readfirstlane(tab[2 * i + 1]);
        return (const float*)(const GAS float*)(((unsigned long long)hi << 32) | lo); } };

__device__ __forceinline__ void un8(const u32x4 p, float (&o)[8]) { o[0] = bflo(p.x); o[1] = bfhi(p.x); o[2] = bflo(p.y); o[3] = bfhi(p.y); o[4] = bflo(p.z); o[5] = bfhi(p.z); o[6] = bflo(p.w); o[7] = bfhi(p.w); }
__device__ __forceinline__ u32x4 pk8(const float (&v)[8]) { return (u32x4){pk2(v[0], v[1]), pk2(v[2], v[3]), pk2(v[4], v[5]), pk2(v[6], v[7])}; }
using pg8::Unit; using pg8::Gemm; using pg8::TileOrder;
struct SchedPlain {
    TileOrder to; int G, c, tid; const char* A; const char* B; size_t ta, tb;
    __device__ __forceinline__ bool next(int i, Unit& u) const {
        if (!to.tile((long)i * G + c, u.pm, u.pn)) return false;
        u.a = A + (size_t)u.pm * ta; u.b = B + (size_t)u.pn * tb; u.aux = 0; return true; }
};
struct SchedSplitK {
    int G, c, tid, n; const char* A; const char* B; size_t ta, kb;
    __device__ __forceinline__ bool next(int i, Unit& u) const { const long L = (long)i * G + c; if (L >= n) return false;
        u.pm = (int)(L >> 2); u.pn = 0; u.aux = (int)(L & 3); u.a = A + (size_t)u.pm * ta + (size_t)u.aux * kb; u.b = B + (size_t)u.aux * kb; return true; }
};
struct EpiPart48 {
    static constexpr bool PERM = true, CHAIN = false;
    float* P;
    __device__ __forceinline__ void operator()(const f32x4 (&acc)[2][2][4][2], const Unit& u, int wr, int wc, int fr, int fq) const {
        const int col = wc * 32 + 8 * fq, row0 = u.pm * 256 + wr * 64 + fr;
        if (col < 48) {
#pragma unroll
            for (int ai = 0; ai < 2; ++ai)
#pragma unroll
                for (int m = 0; m < 4; ++m) { float* p = P + ((size_t)u.aux * T + row0 + ai * 128 + m * 16) * 48 + col; *(f32x4*)p = acc[ai][0][m][0]; *(f32x4*)(p + 4) = acc[ai][0][m][1]; } }
    }
};
struct SchedBranch {
    TileOrder to; int G, c, tid; const char* A0; const char* B0; size_t sa, sb, ta, tb;
    __device__ __forceinline__ bool next(int i, Unit& u) const {
        const int br = i % 3;
        if (!to.tile((long)(i / 3) * G + c, u.pm, u.pn)) return false;
        u.a = A0 + (size_t)br * sa + (size_t)u.pm * ta; u.b = B0 + (size_t)br * sb + (size_t)u.pn * tb; u.aux = br; return true; }
};
struct SchedMoe {
    int nM, nN, G, c, tid; const char* A; const char* B; size_t ta, tb, te; const int* texp;
    __device__ __forceinline__ bool next(int i, Unit& u) const {
        const long L = (long)i * G + c; if (L >= (long)nM * nN) return false;
        u.pm = (int)(L % nM); u.pn = (int)(L / nM); const int e = texp[u.pm];
        u.a = A + (size_t)u.pm * ta; u.b = B + (size_t)e * te + (size_t)u.pn * tb; u.aux = e; return true; }
};
template <int ACT  > struct EpiStore {
    static constexpr bool PERM = true, CHAIN = false;
    bf16* O; int ldc;
    __device__ __forceinline__ void operator()(const f32x4 (&acc)[2][2][4][2], const Unit& u, int wr, int wc, int fr, int fq) const {
        const int row0 = u.pm * 256 + wr * 64 + fr, col0 = u.pn * 256 + wc * 32 + 8 * fq;
#pragma unroll
        for (int ai = 0; ai < 2; ++ai)
#pragma unroll
            for (int m = 0; m < 4; ++m) { bf16* rowp = O + (size_t)(row0 + ai * 128 + m * 16) * ldc + col0;
#pragma unroll
                for (int bj = 0; bj < 2; ++bj) { f32x4 v0 = acc[ai][bj][m][0], v1 = acc[ai][bj][m][1];
                    if (ACT == 1) {
#pragma unroll
                        for (int j = 0; j < 4; ++j) { v0[j] = sigm_fast(v0[j]); v1[j] = sigm_fast(v1[j]); } }
                    u32x4 w; w.x = pg8::cvt_pk_bf16(v0[0], v0[1]); w.y = pg8::cvt_pk_bf16(v0[2], v0[3]); w.z = pg8::cvt_pk_bf16(v1[0], v1[1]); w.w = pg8::cvt_pk_bf16(v1[2], v1[3]);
                    *(u32x4*)(rowp + bj * 128) = w; __builtin_amdgcn_sched_barrier(0); } }
    }
};
struct EpiBranch {
    static constexpr bool PERM = true, CHAIN = true;
    bf16* Mg; const bf16* Gt;
    __device__ __forceinline__ void chain(f32x4 (&acc)[2][2][4][2], const Unit& u, int wr, int wc, int fr, int fq) const {
        const int row0 = u.pm * 256 + wr * 64 + fr, col0 = u.pn * 256 + wc * 32 + 8 * fq, br = u.aux;
#pragma unroll
        for (int ai = 0; ai < 2; ++ai)
#pragma unroll
            for (int m = 0; m < 4; ++m) { const size_t r = (size_t)(row0 + ai * 128 + m * 16);
#pragma unroll
                for (int bj = 0; bj < 2; ++bj) { const int col = col0 + bj * 128; float g[8]; un8(*(const u32x4*)(Gt + r * NG + br * 2048 + col), g);
                    if (br < 2) { float gn[8]; un8(*(const u32x4*)(Gt + r * NG + (br + 1) * 2048 + col), gn);
#pragma unroll
                        for (int j = 0; j < 8; ++j) g[j] = fmaxf(g[j], 1e-18f) * __builtin_amdgcn_rcpf(fmaxf(gn[j], 1e-18f)); }
                    else {
#pragma unroll
                        for (int j = 0; j < 8; ++j) g[j] = fmaxf(g[j], 1e-18f); }
                    f32x4& v0 = acc[ai][bj][m][0]; f32x4& v1 = acc[ai][bj][m][1];
                    v0[0] *= g[0]; v0[1] *= g[1]; v0[2] *= g[2]; v0[3] *= g[3]; v1[0] *= g[4]; v1[1] *= g[5]; v1[2] *= g[6]; v1[3] *= g[7];
                    if (br == 2) { u32x4 w; w.x = pg8::cvt_pk_bf16(v0[0], v0[1]); w.y = pg8::cvt_pk_bf16(v0[2], v0[3]); w.z = pg8::cvt_pk_bf16(v1[0], v1[1]); w.w = pg8::cvt_pk_bf16(v1[2], v1[3]);
                        *(u32x4*)(Mg + r * D + col) = w; v0 = (f32x4){0.f, 0.f, 0.f, 0.f}; v1 = v0; }
                    __builtin_amdgcn_sched_barrier(0); } }
    }
    __device__ __forceinline__ void operator()(const f32x4 (&)[2][2][4][2], const Unit&, int, int, int, int) const {}
};
struct EpiResid {
    static constexpr bool PERM = true, CHAIN = false;
    float* X;
    __device__ __forceinline__ void operator()(const f32x4 (&acc)[2][2][4][2], const Unit& u, int wr, int wc, int fr, int fq) const {
        const int row0 = u.pm * 256 + wr * 64 + fr, col0 = u.pn * 256 + wc * 32 + 8 * fq;
#pragma unroll
        for (int ai = 0; ai < 2; ++ai)
#pragma unroll
            for (int m = 0; m < 4; ++m) { float* rowp = X + (size_t)(row0 + ai * 128 + m * 16) * D + col0;
#pragma unroll
                for (int bj = 0; bj < 2; ++bj) { f32x4* p = (f32x4*)(rowp + bj * 128);
                    const f32x4 x0 = p[0], x1 = p[1];
                    p[0] = x0 * DN_ALPHA + acc[ai][bj][m][0]; p[1] = x1 * DN_ALPHA + acc[ai][bj][m][1]; __builtin_amdgcn_sched_barrier(0); } }
    }
};
struct EpiGateUp {
    static constexpr bool PERM = true, CHAIN = false;
    bf16* H;
    __device__ __forceinline__ void operator()(const f32x4 (&acc)[2][2][4][2], const Unit& u, int wr, int wc, int fr, int fq) const {
        const int row0 = u.pm * 256 + wr * 64 + fr, col0 = u.pn * 128 + wc * 32 + 8 * fq;
#pragma unroll
        for (int ai = 0; ai < 2; ++ai)
#pragma unroll
            for (int m = 0; m < 4; ++m) { bf16* rowp = H + (size_t)(row0 + ai * 128 + m * 16) * FF + col0;
                f32x4 h0, h1;
#pragma unroll
                for (int j = 0; j < 4; ++j) { const float g0 = acc[ai][0][m][0][j], g1 = acc[ai][0][m][1][j];
                    h0[j] = g0 * sigm_fast(g0) * acc[ai][1][m][0][j]; h1[j] = g1 * sigm_fast(g1) * acc[ai][1][m][1][j]; }
                u32x4 w; w.x = pg8::cvt_pk_bf16(h0[0], h0[1]); w.y = pg8::cvt_pk_bf16(h0[2], h0[3]); w.z = pg8::cvt_pk_bf16(h1[0], h1[1]); w.w = pg8::cvt_pk_bf16(h1[2], h1[3]);
                *(u32x4*)rowp = w; }
    }
};

struct Ctx { LAS unsigned char* lds; int tid, lane, wave, G, bx, gw, NGW; };

template <class SRC>
__device__ __forceinline__ void transpose_task(const Ctx& c, const SRC& src, int ldsrc, int K, bf16* dst, int ndst) {
    LAS float* scr = (LAS float*)(c.lds + c.wave * 16640);
    const int nblk = ndst / 64, items = (K / 64) * nblk, lane = c.lane;
    for (int it = c.gw; it < items; it += c.NGW) {
        const int kb = it / nblk, nb = it % nblk, k0 = 64 * kb, n0 = 64 * nb;
        const int nn = n0 + 4 * (lane & 15); const float* sp = src(nn); const int kl = src.klim(nn); const bool al = sp && ((((size_t)sp) & 15) == 0) && ((ldsrc & 3) == 0);
        f32x4 v[16];
#pragma unroll
        for (int i = 0; i < 16; ++i) { const int kk = 4 * i + (lane >> 4); v[i] = (f32x4){0.f, 0.f, 0.f, 0.f};
            if (sp && k0 + kk < kl) { const float* p = sp + (size_t)(k0 + kk) * ldsrc; if (al) v[i] = *(const f32x4*)p; else v[i] = (f32x4){p[0], p[1], p[2], p[3]}; } }
#pragma unroll
        for (int i = 0; i < 16; ++i) { LAS float* tp = scr + (4 * i + (lane >> 4)) * 65 + 4 * (lane & 15); tp[0] = v[i][0]; tp[1] = v[i][1]; tp[2] = v[i][2]; tp[3] = v[i][3]; }
        LDS_WAIT();
        const int cc = lane & 7;
#pragma unroll
        for (int j = 0; j < 8; ++j) { const int n = (lane >> 3) + 8 * j; const LAS float* s = scr + (8 * cc) * 65 + n;
            u32x4 o; o.x = pk2(s[0 * 65], s[1 * 65]); o.y = pk2(s[2 * 65], s[3 * 65]); o.z = pk2(s[4 * 65], s[5 * 65]); o.w = pk2(s[6 * 65], s[7 * 65]);
            *(u32x4*)(dst + (size_t)(n0 + n) * K + k0 + 8 * cc) = o; }
        LDS_WAIT();
    }
}
struct SrcWin { const float* W; int layer; __device__ __forceinline__ int klim(int) const { return 1 << 30; }
    __device__ __forceinline__ const float* operator()(int n) const {
        const int rw = layer ? 3584 : 3520; int sc;
        if (n < 3072) sc = n; else if (n < 5632) sc = rw + (n - 3072); else if (n < 9728) sc = rw + 2608 + (n - 5632); else if (n < 10176) sc = 3072 + (n - 9728);
        else if (n < 10240) sc = layer ? 3520 + (n - 10176) : -1; else if (n < 10288) sc = rw + 2560 + (n - 10240); else sc = -1;
        return sc >= 0 ? W + sc : nullptr; } };
struct SrcOff { const float* W; __device__ __forceinline__ int klim(int) const { return 1 << 30; } __device__ __forceinline__ const float* operator()(int n) const { return W + n; } };
struct SrcGU { const float* Wg; const float* Wu; __device__ __forceinline__ int klim(int) const { return 1 << 30; }
    __device__ __forceinline__ const float* operator()(int nn) const { const int e = nn >> 10, r1 = nn & 1023, pn = r1 >> 8, rr = r1 & 255;
        const size_t du = (size_t)((const char*)Wu - (const char*)Wg);
        return (const float*)((const char*)Wg + (rr < 128 ? (size_t)0 : du)) + (size_t)e * D * FF + 128 * pn + (rr & 127); } };
struct SrcDN { const float* Wd; __device__ __forceinline__ int klim(int) const { return 1 << 30; }
    __device__ __forceinline__ const float* operator()(int nn) const { const int e = nn >> 11, n = nn & 2047; return Wd + (size_t)e * FF * D + n; } };

struct SrcLora { const float* w; const float* a_; const float* g; const float* v;
    __device__ __forceinline__ const float* operator()(int n) const { const int blk = n >> 10, cc = n & 1023; const size_t b0 = (size_t)w, d1 = (size_t)a_ - b0, d2 = (size_t)g - b0, d3 = (size_t)v - b0; if (blk == 3 && v == nullptr) return nullptr; const size_t off = blk == 0 ? 0 : (blk == 1 ? d1 : (blk == 2 ? d2 : d3)); return (const float*)(b0 + off) + cc; }
    __device__ __forceinline__ int klim(int n) const { const int blk = n >> 10; return blk < 2 ? 96 : (blk == 2 ? 256 : 64); } };
__device__ __forceinline__ void ph_conv(const Ctx& c, const PA& a, int layer) {
    unsigned char* ws = a.ws;
    const float* Win = layer ? a.in(2) : a.in(1); const int ldw = layer ? 16432 : 16368, rw = layer ? 3584 : 3520;
    transpose_task(c, SrcWin{Win, layer}, ldw, D, (bf16*)(ws + WS_WIN), LDP);
    transpose_task(c, SrcOff{Win + rw + 2608 + 4096}, ldw, D, (bf16*)(ws + WS_WG), NG);
    transpose_task(c, SrcOff{a.in(21) + (size_t)layer * RWW * D}, D, RWW, (bf16*)(ws + WS_WBR), D);
    transpose_task(c, SrcOff{a.in(22) + (size_t)layer * RWW * D}, D, RWW, (bf16*)(ws + WS_WBR) + (size_t)D * RWW, D);
    transpose_task(c, SrcOff{a.in(23) + (size_t)layer * RWW * D}, D, RWW, (bf16*)(ws + WS_WBR) + (size_t)2 * D * RWW, D);
    transpose_task(c, SrcOff{a.in(24) + (size_t)layer * D * D}, D, D, (bf16*)(ws + WS_WOUT), D);
    transpose_task(c, SrcOff{a.in(18) + (size_t)(layer * 2) * 2048 * 128}, 128, 2048, (bf16*)(ws + WS_W1T), 128);
    transpose_task(c, SrcOff{a.in(18) + (size_t)(layer * 2 + 1) * 2048 * 128}, 128, 2048, (bf16*)(ws + WS_W1T) + (size_t)128 * 2048, 128);
    transpose_task(c, SrcLora{a.in(6) + (size_t)layer * 96 * 1024, a.in(8) + (size_t)layer * 96 * 1024, a.in(11) + (size_t)layer * 256 * 1024, layer ? a.in(10) : nullptr}, 1024, 256, (bf16*)(ws + WS_WLORA), 4096);
    if (layer == 0) {
        const f32x4* x4 = (const f32x4*)a.in(0); f32x4* o4 = (f32x4*)a.out; uint2* xb = (uint2*)(ws + WS_XB);
        for (size_t i = (size_t)c.bx * 512 + c.tid; i < (size_t)T * D / 4; i += (size_t)c.G * 512) { const f32x4 v = x4[i]; o4[i] = v; xb[i] = make_uint2(pk2(v[0], v[1]), pk2(v[2], v[3])); }
        float* cs = (float*)(ws + WS_COS); float* sn = (float*)(ws + WS_SIN);
        for (int i = c.bx * 512 + c.tid; i < T * 64; i += c.G * 512) { const int t = i >> 6, j = i & 63;
            const double rev = (double)t * INV_FREQ[j] * 0.15915494309189533577; const float fr = (float)(rev - __builtin_rint(rev));
            cs[i] = __builtin_amdgcn_cosf(fr); sn[i] = __builtin_amdgcn_sinf(fr); }
    }
}
__device__ __forceinline__ void ph_conv_moe(const Ctx& c, const PA& a, int layer) {
    unsigned char* ws = a.ws; const size_t lo = (size_t)layer * NEXP * D * FF;
    transpose_task(c, SrcGU{a.in(31) + lo, a.in(32) + lo}, FF, D, (bf16*)(ws + WS_WGU), NEXP * 1024);
    transpose_task(c, SrcDN{a.in(33) + lo}, D, FF, (bf16*)(ws + WS_WDN), NEXP * D);
}

__device__ __forceinline__ float softplusf_(float x) { return fmaxf(x, 0.f) + log1pf(expf(-fabsf(x))); }
__device__ __forceinline__ void prep_rwkv(const Ctx& c, const PA& a, int layer) {
    unsigned char* ws = a.ws; const bf16* proj = (const bf16*)(ws + WS_PROJ);
    bf16* oR = (bf16*)(ws + WS_RW_R); bf16* oK = (bf16*)(ws + WS_RW_K); bf16* oV = (bf16*)(ws + WS_RW_V); bf16* oKK = (bf16*)(ws + WS_RW_KK); bf16* VF = (bf16*)(ws + WS_VF); bf16* AL = (bf16*)(ws + WS_ALORA);
    const float* mu = a.in(layer ? 4 : 3); const float* k_k = a.in(12) + layer * 1024;
    const int lane = c.lane;
    for (int t = c.gw; t < T; t += c.NGW) {
        const bf16* prow = proj + (size_t)t * LDP; const bf16* pprev = prow - LDP; const size_t o = (size_t)t * 1024 + 16 * lane;
#pragma unroll
        for (int piece = 0; piece < 3; ++piece) { float sh[16];
#pragma unroll
            for (int hf = 0; hf < 2; ++hf) { const int c8 = piece * 1024 + 16 * lane + 8 * hf; float pv[8], qv[8]; un8(*(const u32x4*)(prow + c8), pv);
                if (t > 0) un8(*(const u32x4*)(pprev + c8), qv); else { for (int j = 0; j < 8; ++j) qv[j] = 0.f; }
                const f32x4 m0 = *(const f32x4*)(mu + c8), m1 = *(const f32x4*)(mu + c8 + 4);
#pragma unroll
                for (int j = 0; j < 8; ++j) sh[8 * hf + j] = pv[j] + (qv[j] - pv[j]) * (j < 4 ? m0[j] : m1[j - 4]); }
            float lo8[8], hi8[8];
#pragma unroll
            for (int j = 0; j < 8; ++j) { lo8[j] = sh[j]; hi8[j] = sh[8 + j]; }
            bf16* dst = piece == 0 ? oR : (piece == 1 ? oK : oV);
            *(u32x4*)(dst + o) = pk8(lo8); *(u32x4*)(dst + o + 8) = pk8(hi8);
            if (piece == 2 && layer == 0) { *(u32x4*)(VF + o) = pk8(lo8); *(u32x4*)(VF + o + 8) = pk8(hi8); }
            if (piece == 1) { float n2 = 0.f;
#pragma unroll
                for (int j = 0; j < 16; ++j) { sh[j] *= k_k[16 * lane + j]; n2 += sh[j] * sh[j]; }
                n2 = sum_x1_2(n2); const float inv = 1.f / fmaxf(sqrtf(n2), 1e-12f);
#pragma unroll
                for (int j = 0; j < 8; ++j) { lo8[j] = sh[j] * inv; hi8[j] = sh[8 + j] * inv; }
                *(u32x4*)(oKK + o) = pk8(lo8); *(u32x4*)(oKK + o + 8) = pk8(hi8); } }
        { const int i8 = lane * 8; int sc, mi, fn, dc;
            if (i8 < 96) { sc = PC_XW + i8; mi = 3072 + i8; fn = 1; dc = i8; } else if (i8 < 192) { sc = PC_XA + (i8 - 96); mi = 3168 + (i8 - 96); fn = 0; dc = 256 + (i8 - 96); }
            else if (i8 < 448) { sc = PC_XG + (i8 - 192); mi = 3264 + (i8 - 192); fn = 2; dc = 512 + (i8 - 192); } else { sc = PC_XV + (i8 - 448); mi = 3520 + (i8 - 448); fn = layer ? 0 : 3; dc = 768 + (i8 - 448); }
            float pv[8], qv[8], ov[8]; un8(*(const u32x4*)(prow + sc), pv); if (t > 0) un8(*(const u32x4*)(pprev + sc), qv); else { for (int j = 0; j < 8; ++j) qv[j] = 0.f; }
#pragma unroll
            for (int j = 0; j < 8; ++j) { float s = 0.f;
                if (fn != 3) { const float mm = mu[mi + j]; s = pv[j] + (qv[j] - pv[j]) * mm; if (fn == 1) s = tanhf(s); else if (fn == 2) s = sigm(s); }
                ov[j] = s; }
            *(u32x4*)(AL + (size_t)t * 1024 + dc) = pk8(ov);
            const int zc = lane < 20 ? 96 + 8 * lane : (lane < 40 ? 352 + 8 * (lane - 20) : 832 + 8 * (lane - 40));
            { unsigned z0 = 0u; asm volatile("" : "+v"(z0)); *(u32x4*)(AL + (size_t)t * 1024 + zc) = (u32x4){z0, z0, z0, z0}; } }
    }
}
__device__ __forceinline__ float ex2(float x) { return __builtin_amdgcn_exp2f(x); }
__device__ __forceinline__ void un4(const uint2 p, float (&o)[4]) { o[0] = bflo(p.x); o[1] = bfhi(p.x); o[2] = bflo(p.y); o[3] = bfhi(p.y); }
struct EpiLora {
    static constexpr bool PERM = true, CHAIN = false;
    unsigned char* ws; PA pa; int layer;
#define EPL_ROWS(...) _Pragma("unroll") for (int bj = 0; bj < 2; ++bj) _Pragma("unroll") for (int hf = 0; hf < 2; ++hf) { const int col = col0 + bj * 128 + 4 * hf; PRE _Pragma("unroll") for (int ai = 0; ai < 2; ++ai) _Pragma("unroll") for (int m = 0; m < 4; ++m) { \
        const size_t o = (size_t)(row0 + ai * 128 + m * 16) * 1024 + col; const f32x4 x = acc[ai][bj][m][hf]; __VA_ARGS__ __builtin_amdgcn_sched_barrier(0); } }
    __device__ __forceinline__ void operator()(const f32x4 (&acc)[2][2][4][2], const Unit& u, int wr, int wc, int fr, int fq) const {
        const int blk = u.pn >> 2, row0 = u.pm * 256 + wr * 64 + fr, col0 = (u.pn & 3) * 256 + wc * 32 + 8 * fq;
        if (blk == 0) {
#define PRE const f32x4 p = *(const f32x4*)(pa.in(5) + layer * 1024 + col);
            EPL_ROWS({ f32x4 d;
                _Pragma("unroll") for (int j = 0; j < 4; ++j) { const float z = -(x[j] + p[j]), sp = fmaxf(z, 0.f) + 0.6931471805599453f * __builtin_amdgcn_logf(1.f + ex2(-1.4426950408889634f * fabsf(z)));
                    d[j] = ex2(-1.4426950408889634f * ex2(1.4426950408889634f * (-sp - 0.5f))); }
                *(f32x4*)((float*)(ws + WS_RW_W) + o) = d; })
#undef PRE
        } else if (blk == 1) {
#define PRE const f32x4 p = *(const f32x4*)(pa.in(7) + layer * 1024 + col), qa = *(const f32x4*)(pa.in(13) + layer * 1024 + col);
            EPL_ROWS({ float kk[4], k0[4]; un4(*(const uint2*)((const bf16*)(ws + WS_RW_KK) + o), kk); un4(*(const uint2*)((const bf16*)(ws + WS_RW_K) + o), k0); float bb[4], kf[4];
                _Pragma("unroll") for (int j = 0; j < 4; ++j) { const float aa = sigm_fast(x[j] + p[j]); bb[j] = kk[j] * aa; kf[j] = k0[j] * (1.f + (aa - 1.f) * qa[j]); }
                *(uint2*)((bf16*)(ws + WS_RW_B) + o) = make_uint2(pk2(bb[0], bb[1]), pk2(bb[2], bb[3])); *(uint2*)((bf16*)(ws + WS_RW_K) + o) = make_uint2(pk2(kf[0], kf[1]), pk2(kf[2], kf[3])); })
#undef PRE
        } else if (blk == 2) {
#define PRE
            EPL_ROWS({ *(uint2*)((bf16*)(ws + WS_RW_G) + o) = make_uint2(pg8::cvt_pk_bf16(x[0], x[1]), pg8::cvt_pk_bf16(x[2], x[3])); })
#undef PRE
        } else {
#define PRE const f32x4 p = *(const f32x4*)(pa.in(9) + col);
            EPL_ROWS({ float v0[4], vf[4], vv[4]; un4(*(const uint2*)((const bf16*)(ws + WS_RW_V) + o), v0); un4(*(const uint2*)((const bf16*)(ws + WS_VF) + o), vf);
                _Pragma("unroll") for (int j = 0; j < 4; ++j) vv[j] = v0[j] + (vf[j] - v0[j]) * sigm_fast(x[j] + p[j]);
                *(uint2*)((bf16*)(ws + WS_RW_V) + o) = make_uint2(pk2(vv[0], vv[1]), pk2(vv[2], vv[3])); })
#undef PRE
        }
    }
#undef EPL_ROWS
};
struct SchedLora { TileOrder to; int G, c, tid; const char* A; const char* B;
    __device__ __forceinline__ bool next(int i, Unit& u) const {
        if (!to.tile((long)i * G + c, u.pm, u.pn)) return false;
        u.a = A + (size_t)u.pm * 256 * 1024 * 2 + (size_t)(u.pn >> 2) * 256 * 2; u.b = B + (size_t)u.pn * 256 * 256 * 2; u.aux = 0; return true; }
};
__device__ __forceinline__ float gelu_tanh(float x) { return 0.5f * x * (1.f + tanhf(0.7978845608028654f * (x + 0.044715f * x * x * x))); }
__device__ __forceinline__ void prep_cmp(const Ctx& c, const PA& a, int layer) {
    unsigned char* ws = a.ws; const bf16* proj = (const bf16*)(ws + WS_PROJ);
    constexpr int RS = 2056;
    LAS bf16* sh_in = (LAS bf16*)c.lds; LAS float* sh_h = (LAS float*)(c.lds + 16 * RS * 2);
    const int tid = c.tid, lane = c.lane, r = lane & 15, q = lane >> 4, w = c.wave;
    for (int it = c.bx; it < 256 * 2; it += c.G) {
        const int cg = it >> 1, kv = it & 1, col0 = kv ? PC_VC : PC_KC, lk = layer * 2 + kv;
        const float* pe = a.in(17) + (size_t)lk * 2048;
        for (int idx = tid; idx < 16 * 2048 / 8; idx += 512) { const int row = idx >> 8, r8 = (idx & 255) * 8, cb = 4 * cg + (row >> 2), g = row & 3, l = r8 >> 6, d = r8 & 63;
            int tok = 16 * cb + l; tok = tok > T - 1 ? T - 1 : tok;
            float v[8]; un8(*(const u32x4*)(proj + (size_t)tok * LDP + col0 + g * 64 + d), v); const f32x4 p0 = *(const f32x4*)(pe + r8), p1 = *(const f32x4*)(pe + r8 + 4);
#pragma unroll
            for (int j = 0; j < 8; ++j) v[j] += j < 4 ? p0[j] : p1[j - 4];
            *(LAS u32x4*)(sh_in + row * RS + r8) = pk8(v); }
        __syncthreads();
        { const bf16* wt = (const bf16*)(ws + WS_W1T) + ((size_t)(kv * 128 + 16 * w + r)) * 2048 + 8 * q; const LAS bf16* ap = sh_in + r * RS + 8 * q;
            f32x4 acc = (f32x4){0.f, 0.f, 0.f, 0.f};
#pragma unroll 8
            for (int ks = 0; ks < 64; ++ks) acc = __builtin_amdgcn_mfma_f32_16x16x32_bf16(*(const LAS bf16x8*)(ap + 32 * ks), *(const bf16x8*)(wt + 32 * ks), acc, 0, 0, 0);
            const float bj = a.in(19)[lk * 128 + 16 * w + r];
#pragma unroll
            for (int i = 0; i < 4; ++i) sh_h[(4 * q + i) * 128 + 16 * w + r] = gelu_tanh(acc[i] + bj); }
        __syncthreads();
        const float* w2 = a.in(20) + (size_t)lk * 128 * 64;
        for (int oidx = tid; oidx < 16 * 64; oidx += 512) { const int row = oidx >> 6, d = oidx & 63, cb = 4 * cg + (row >> 2), g = row & 3; float o = 0.f;
#pragma unroll 16
            for (int j = 0; j < 128; ++j) o += sh_h[row * 128 + j] * w2[j * 64 + d];
            if (kv == 0) { const float ob = bf2f((bf16)f2bf(o)), n2 = wave_sum(ob * ob); if (c.lane == 0 && cb < NCMP) atomicMax((unsigned*)(ws + WS_CTL) + CW_KMAX + layer * 64 + 8 + g, __float_as_uint(sqrtf(n2))); }
            if (cb < NCMP) {
            const int blk = cb >> 6, kc = cb & 63;
            if (kv == 0) { const int j2 = kc >> 4, rr = kc & 15, ks = d >> 5, qq = (d & 31) >> 3, i = d & 7;
                ((bf16*)(ws + WS_KCMPB))[((((size_t)g * 16 + blk) * 8 + 2 * j2 + ks) * 64 + qq * 16 + rr) * 8 + i] = (bf16)f2bf(o);
                if (cb == 0) ((bf16*)(ws + WS_KCMPB))[((((size_t)g * 16 + 15) * 8 + 2 * 3 + ks) * 64 + qq * 16 + 15) * 8 + i] = 0; }
            else { const int ks = kc >> 5, kk = kc & 31, hh = kk >> 4, qq = (kk & 15) >> 2, i = (kk & 3) + 4 * hh, mt = d >> 4, rr = d & 15;
                ((bf16*)(ws + WS_VCMPT))[((((size_t)g * 16 + blk) * 8 + 2 * mt + ks) * 64 + qq * 16 + rr) * 8 + i] = (bf16)f2bf(o);
                if (cb == 0) ((bf16*)(ws + WS_VCMPT))[((((size_t)g * 16 + 15) * 8 + 2 * mt + 1) * 64 + 3 * 16 + rr) * 8 + 7] = 0; } } }
        __syncthreads();
    }
}
__device__ __forceinline__ void prep_rope(const Ctx& c, const PA& a) {
    unsigned char* ws = a.ws; bf16* proj = (bf16*)(ws + WS_PROJ); const float* cs = (const float*)(ws + WS_COS); const float* sn = (const float*)(ws + WS_SIN);
    for (int i = c.bx * 512 + c.tid; i < T * 8 * 8; i += c.G * 512) { const int j8 = (i & 7) * 8, h = (i >> 3) & 7, t = i >> 6;
        bf16* qp = proj + (size_t)t * LDP + PC_RQ + h * 128 + j8; float q1[8], q2[8], o1[8], o2[8]; un8(*(const u32x4*)qp, q1); un8(*(const u32x4*)(qp + 64), q2);
        const f32x4 c0 = *(const f32x4*)(cs + (size_t)t * 64 + j8), c1 = *(const f32x4*)(cs + (size_t)t * 64 + j8 + 4), s0 = *(const f32x4*)(sn + (size_t)t * 64 + j8), s1 = *(const f32x4*)(sn + (size_t)t * 64 + j8 + 4);
#pragma unroll
        for (int j = 0; j < 8; ++j) { const float co = j < 4 ? c0[j] : c1[j - 4], si = j < 4 ? s0[j] : s1[j - 4]; o1[j] = q1[j] * co - q2[j] * si; o2[j] = q1[j] * si + q2[j] * co; }
        *(u32x4*)qp = pk8(o1); *(u32x4*)(qp + 64) = pk8(o2); }
}

constexpr int RW_NC = 64, RW_CL = 256, RW_TS = 8;
typedef float f32x2 __attribute__((ext_vector_type(2)));
__device__ __forceinline__ void rw_put8(LAS float* d, u32x4 v) { *(LAS f32x4*)d = (f32x4){bflo(v.x), bfhi(v.x), bflo(v.y), bfhi(v.y)}; *(LAS f32x4*)(d + 4) = (f32x4){bflo(v.z), bfhi(v.z), bflo(v.w), bfhi(v.w)}; }
struct RwRegs { u32x4 kk, b, k, v, r, g; f32x4 w0, w1; };
__device__ __forceinline__ void rw_stage_load(const unsigned char* ws, RwRegs& R, int t0, int h, int lane, bool need_r) {
    const unsigned e = (unsigned)((t0 + (lane >> 3)) * 1024 + h * 64 + 8 * (lane & 7));
    R.kk = *(const u32x4*)(ws + ((unsigned)WS_RW_KK + e * 2u)); R.b = *(const u32x4*)(ws + ((unsigned)WS_RW_B + e * 2u)); R.k = *(const u32x4*)(ws + ((unsigned)WS_RW_K + e * 2u)); R.v = *(const u32x4*)(ws + ((unsigned)WS_RW_V + e * 2u));
    R.w0 = *(const f32x4*)(ws + ((unsigned)WS_RW_W + e * 4u)); R.w1 = *(const f32x4*)(ws + ((unsigned)WS_RW_W + e * 4u + 16u));
    R.r = (u32x4){0u, 0u, 0u, 0u}; R.g = R.r; if (need_r) { R.r = *(const u32x4*)(ws + ((unsigned)WS_RW_R + e * 2u)); R.g = *(const u32x4*)(ws + ((unsigned)WS_RW_G + e * 2u)); }
}
__device__ __forceinline__ void rw_stage_store(LAS float* tile, const RwRegs& R, int lane) {
    LAS float* tp = tile + (lane >> 3) * 384 + 8 * (lane & 7);
    rw_put8(tp, R.kk); rw_put8(tp + 64, R.b); *(LAS f32x4*)(tp + 128) = R.w0; *(LAS f32x4*)(tp + 132) = R.w1; rw_put8(tp + 192, R.k); rw_put8(tp + 256, R.r); rw_put8(tp + 320, R.v);
}
#define RW_LD4(p) (*(const LAS f32x4*)(p))
__device__ __forceinline__ void rw_step(f32x2 (&S)[32], const LAS float* tp, float vi) {
    f32x4 kk[16];
#pragma unroll
    for (int i = 0; i < 16; ++i) kk[i] = RW_LD4(tp + 4 * i);
    f32x4 b4[2][4], w4[2][4], k4[2][4];
#pragma unroll
    for (int i = 0; i < 4; ++i) { b4[0][i] = RW_LD4(tp + 64 + 4 * i); w4[0][i] = RW_LD4(tp + 128 + 4 * i); k4[0][i] = RW_LD4(tp + 192 + 4 * i); }
    __builtin_amdgcn_sched_barrier(0);
    f32x2 d0 = (f32x2){0.f, 0.f}, d1 = d0;
#pragma unroll
    for (int i = 0; i < 16; ++i) { d0 += S[2 * i] * (f32x2){kk[i][0], kk[i][1]}; d1 += S[2 * i + 1] * (f32x2){kk[i][2], kk[i][3]}; }
    const float sk = (d0[0] + d0[1]) + (d1[0] + d1[1]); const f32x2 nsk = (f32x2){-sk, -sk}, vi2 = (f32x2){vi, vi};
#pragma unroll
    for (int c = 0; c < 4; ++c) { const int cb = c & 1, nb = cb ^ 1;
        if (c + 1 < 4) {
#pragma unroll
            for (int i = 0; i < 4; ++i) { b4[nb][i] = RW_LD4(tp + 64 + 16 * (c + 1) + 4 * i); w4[nb][i] = RW_LD4(tp + 128 + 16 * (c + 1) + 4 * i); k4[nb][i] = RW_LD4(tp + 192 + 16 * (c + 1) + 4 * i); } }
        __builtin_amdgcn_sched_barrier(0);
#pragma unroll
        for (int i = 0; i < 4; ++i) { const int p = 8 * c + 2 * i;
            S[p] = S[p] * (f32x2){w4[cb][i][0], w4[cb][i][1]} + (vi2 * (f32x2){k4[cb][i][0], k4[cb][i][1]} + nsk * (f32x2){b4[cb][i][0], b4[cb][i][1]});
            S[p + 1] = S[p + 1] * (f32x2){w4[cb][i][2], w4[cb][i][3]} + (vi2 * (f32x2){k4[cb][i][2], k4[cb][i][3]} + nsk * (f32x2){b4[cb][i][2], b4[cb][i][3]}); }
        __builtin_amdgcn_sched_barrier(0); }
}
__device__ __forceinline__ float rw_dot_r(const f32x2 (&S)[32], const LAS float* tp) {
    f32x4 r4[16];
#pragma unroll
    for (int i = 0; i < 16; ++i) r4[i] = RW_LD4(tp + 256 + 4 * i);
    __builtin_amdgcn_sched_barrier(0);
    f32x2 d0 = (f32x2){0.f, 0.f}, d1 = d0;
#pragma unroll
    for (int i = 0; i < 16; ++i) { d0 += S[2 * i] * (f32x2){r4[i][0], r4[i][1]}; d1 += S[2 * i + 1] * (f32x2){r4[i][2], r4[i][3]}; }
    return (d0[0] + d0[1]) + (d1[0] + d1[1]);
}

__device__ __forceinline__ void rw_step_dual(f32x2 (&SP)[32], f32x2 (&SU)[32], const LAS float* tp, float vi) {
    f32x2 p0 = (f32x2){0.f, 0.f}, p1 = p0, u0 = p0, u1 = p0;
#pragma unroll
    for (int h2 = 0; h2 < 2; ++h2) { f32x4 kk[8];
#pragma unroll
        for (int i = 0; i < 8; ++i) kk[i] = RW_LD4(tp + 32 * h2 + 4 * i);
        __builtin_amdgcn_sched_barrier(0);
#pragma unroll
        for (int i = 0; i < 8; ++i) { const int p = 16 * h2 + 2 * i; const f32x2 ka = (f32x2){kk[i][0], kk[i][1]}, kb = (f32x2){kk[i][2], kk[i][3]};
            p0 += SP[p] * ka; p1 += SP[p + 1] * kb; u0 += SU[p] * ka; u1 += SU[p + 1] * kb; }
        __builtin_amdgcn_sched_barrier(0); }
    const float skp = (p0[0] + p0[1]) + (p1[0] + p1[1]), sku = (u0[0] + u0[1]) + (u1[0] + u1[1]); const f32x2 nsp = (f32x2){-skp, -skp}, nsu = (f32x2){-sku, -sku}, vi2 = (f32x2){vi, vi};
#pragma unroll
    for (int c = 0; c < 8; ++c) { f32x4 b4[2], w4[2], k4[2];
#pragma unroll
        for (int i = 0; i < 2; ++i) { b4[i] = RW_LD4(tp + 64 + 8 * c + 4 * i); w4[i] = RW_LD4(tp + 128 + 8 * c + 4 * i); k4[i] = RW_LD4(tp + 192 + 8 * c + 4 * i); }
        __builtin_amdgcn_sched_barrier(0);
#pragma unroll
        for (int i = 0; i < 2; ++i) { const int p = 4 * c + 2 * i;
            const f32x2 ba = (f32x2){b4[i][0], b4[i][1]}, bb = (f32x2){b4[i][2], b4[i][3]}, wa = (f32x2){w4[i][0], w4[i][1]}, wb = (f32x2){w4[i][2], w4[i][3]}, ka = (f32x2){k4[i][0], k4[i][1]}, kb = (f32x2){k4[i][2], k4[i][3]};
            SP[p] = SP[p] * wa + nsp * ba; SP[p + 1] = SP[p + 1] * wb + nsp * bb;
            SU[p] = SU[p] * wa + (vi2 * ka + nsu * ba); SU[p + 1] = SU[p + 1] * wb + (vi2 * kb + nsu * bb); }
        __builtin_amdgcn_sched_barrier(0); }
}
__device__ __forceinline__ void rw_pass1(const Ctx& c, const PA& a) {
    const unsigned char* ws = a.ws; LAS float* tile = (LAS float*)(c.lds + c.wave * (2 * RW_TS * 384 * 4));
    const int lane = c.lane;
    if (c.wave >= 4) return;
    for (int task = c.bx * 4 + c.wave; task < 16 * RW_NC; task += c.G * 4) {
        const int h = task / RW_NC, ch = task % RW_NC;
        f32x2 SP[32], SU[32]; int lz = lane; asm volatile("" : "+v"(lz));
#pragma unroll
        for (int j = 0; j < 32; ++j) { SP[j] = (f32x2){(2 * j == lz) ? 1.f : 0.f, (2 * j + 1 == lz) ? 1.f : 0.f}; SU[j] = (f32x2){0.f, 0.f}; }
        { RwRegs R; rw_stage_load(ws, R, ch * RW_CL, h, lane, false); rw_stage_store(tile, R, lane); }
        for (int ti = 0; ti < RW_CL / RW_TS; ++ti) { const int t0 = ch * RW_CL + ti * RW_TS; LAS float* tcur = tile + (ti & 1) * 3072; LAS float* tnxt = tile + ((ti + 1) & 1) * 3072;
            RwRegs R; if (ti + 1 < RW_CL / RW_TS) rw_stage_load(ws, R, t0 + RW_TS, h, lane, false);
            LDS_WAIT();
#pragma unroll 1
            for (int s = 0; s < RW_TS; ++s) { const LAS float* tp = tcur + s * 384; rw_step_dual(SP, SU, tp, tp[320 + lane]); }
            if (ti + 1 < RW_CL / RW_TS) rw_stage_store(tnxt, R, lane);
            LDS_WAIT();
        }
        float* op = (float*)(a.ws + WS_RWP) + ((size_t)task * 64 + lane) * 64; float* ou = (float*)(a.ws + WS_RWU) + ((size_t)task * 64 + lane) * 64;
#pragma unroll
        for (int jj = 0; jj < 16; ++jj) { *(f32x4*)(op + 4 * jj) = (f32x4){SP[2 * jj][0], SP[2 * jj][1], SP[2 * jj + 1][0], SP[2 * jj + 1][1]}; *(f32x4*)(ou + 4 * jj) = (f32x4){SU[2 * jj][0], SU[2 * jj][1], SU[2 * jj + 1][0], SU[2 * jj + 1][1]}; }
    }
}
#define RDL(v, l) __int_as_float(__builtin_amdgcn_readlane(__float_as_int(v), (l)))
__device__ __forceinline__ void rw_pass2(const Ctx& c, const PA& a) {
    const float* P = (const float*)(a.ws + WS_RWP); const float* U = (const float*)(a.ws + WS_RWU); float* Si = (float*)(a.ws + WS_RWS);
    LAS float* pb = (LAS float*)c.lds;
    const int lane = c.lane, w = c.wave, tid = c.tid;
    for (int unit = c.bx; unit < 256; unit += c.G) { const int h = unit >> 4, i = (unit & 15) * 4 + (w & 3); const size_t hc0 = (size_t)h * RW_NC;
        { const f32x4* src = (const f32x4*)(P + hc0 * 4096) + tid * 2; *(LAS f32x4*)(pb + tid * 8) = src[0]; *(LAS f32x4*)(pb + tid * 8 + 4) = src[1]; }
        float s = 0.f, u = U[(hc0 * 64 + i) * 64 + lane];
        __syncthreads();
        for (int ch = 0; ch < RW_NC; ++ch) { const LAS float* pc = pb + (ch & 1) * 4096 + lane;
            f32x4 n0 = (f32x4){0.f, 0.f, 0.f, 0.f}, n1 = n0; float un = 0.f;
            if (ch + 1 < RW_NC) { const f32x4* src = (const f32x4*)(P + (hc0 + ch + 1) * 4096) + tid * 2; n0 = src[0]; n1 = src[1]; un = U[((hc0 + ch + 1) * 64 + i) * 64 + lane]; }
            if (w < 4) { Si[((hc0 + ch) * 64 + i) * 64 + lane] = s;
                float a0 = u, a1 = 0.f, a2 = 0.f, a3 = 0.f;
#pragma unroll
                for (int i2 = 0; i2 < 64; i2 += 4) { a0 += RDL(s, i2) * pc[i2 * 64]; a1 += RDL(s, i2 + 1) * pc[(i2 + 1) * 64]; a2 += RDL(s, i2 + 2) * pc[(i2 + 2) * 64]; a3 += RDL(s, i2 + 3) * pc[(i2 + 3) * 64]; }
                s = (a0 + a1) + (a2 + a3); }
            { LAS float* dst = pb + ((ch + 1) & 1) * 4096 + tid * 8; *(LAS f32x4*)dst = n0; *(LAS f32x4*)(dst + 4) = n1; }
            u = un;
            __syncthreads(); }
    }
}
__device__ __forceinline__ void rw_pass3(const Ctx& c, const PA& a, int layer) {
    const unsigned char* ws = a.ws; LAS float* tile = (LAS float*)(c.lds + c.wave * 28800); LAS float* tg = tile + 6144; LAS float* ty = tg + 512; LAS float* trk = ty + 512; LAS float* tst = trk + 8;
    const float* Si = (const float*)(ws + WS_RWS); bf16* Y = (bf16*)(a.ws + WS_YRW); const float* r_k = a.in(14) + layer * 1024;
    const float* lng = a.in(15) + layer * 1024; const float* lnb = a.in(16) + layer * 1024;
    const int lane = c.lane;
    if (c.wave >= 4) return;
    for (int task = c.bx * 4 + c.wave; task < 16 * RW_NC; task += c.G * 4) {
        const int h = task / RW_NC, ch = task % RW_NC, col = h * 64 + lane;
        const float lg = lng[col], lb = lnb[col]; const f32x4 rk0 = *(const f32x4*)(r_k + h * 64 + 8 * (lane & 7)), rk1 = *(const f32x4*)(r_k + h * 64 + 8 * (lane & 7) + 4);
        f32x2 S[32]; const float* sp = Si + ((size_t)task * 64 + lane) * 64;
#pragma unroll
        for (int jj = 0; jj < 16; ++jj) { const f32x4 v = *(const f32x4*)(sp + 4 * jj); S[2 * jj] = (f32x2){v[0], v[1]}; S[2 * jj + 1] = (f32x2){v[2], v[3]}; }
        { RwRegs R; rw_stage_load(ws, R, ch * RW_CL, h, lane, true); rw_stage_store(tile, R, lane); rw_put8(tg + (lane >> 3) * 64 + 8 * (lane & 7), R.g); }
        for (int ti = 0; ti < RW_CL / RW_TS; ++ti) { const int t0 = ch * RW_CL + ti * RW_TS; LAS float* tcur = tile + (ti & 1) * 3072; LAS float* tnxt = tile + ((ti + 1) & 1) * 3072;
            RwRegs R; if (ti + 1 < RW_CL / RW_TS) rw_stage_load(ws, R, t0 + RW_TS, h, lane, true);
            LDS_WAIT();
            { const LAS float* rp = tcur + (lane >> 3) * 384 + 256 + 8 * (lane & 7); const LAS float* kp = tcur + (lane >> 3) * 384 + 192 + 8 * (lane & 7);
                const f32x4 r0 = *(const LAS f32x4*)rp, r1 = *(const LAS f32x4*)(rp + 4), k0 = *(const LAS f32x4*)kp, k1 = *(const LAS f32x4*)(kp + 4);
                float sm = ((r0[0] * k0[0] * rk0[0] + r0[1] * k0[1] * rk0[1]) + (r0[2] * k0[2] * rk0[2] + r0[3] * k0[3] * rk0[3])) + ((r1[0] * k1[0] * rk1[0] + r1[1] * k1[1] * rk1[1]) + (r1[2] * k1[2] * rk1[2] + r1[3] * k1[3] * rk1[3]));
                sm = sum_x1_2_4(sm); if ((lane & 7) == 0) trk[lane >> 3] = sm; }
#pragma unroll 1
            for (int s = 0; s < RW_TS; ++s) { const LAS float* tp = tcur + s * 384; const float vi = tp[320 + lane]; rw_step(S, tp, vi); ty[s * 64 + lane] = rw_dot_r(S, tp); }
            LDS_WAIT();
            { const LAS float* yp = ty + (lane >> 3) * 64 + 8 * (lane & 7); const f32x4 y0 = *(const LAS f32x4*)yp, y1 = *(const LAS f32x4*)(yp + 4);
                float sm = ((y0[0] + y0[1]) + (y0[2] + y0[3])) + ((y1[0] + y1[1]) + (y1[2] + y1[3]));
                sm = sum_x1_2_4(sm); const float mean = sm * (1.f / 64.f);
                const f32x4 d0 = y0 - mean, d1 = y1 - mean; float sq = ((d0[0] * d0[0] + d0[1] * d0[1]) + (d0[2] * d0[2] + d0[3] * d0[3])) + ((d1[0] * d1[0] + d1[1] * d1[1]) + (d1[2] * d1[2] + d1[3] * d1[3]));
                sq = sum_x1_2_4(sq);
                if ((lane & 7) == 0) { tst[2 * (lane >> 3)] = mean; tst[2 * (lane >> 3) + 1] = 1.f / sqrtf(sq * (1.f / 64.f) + 64e-5f); } }
            LDS_WAIT();
#pragma unroll
            for (int s = 0; s < RW_TS; ++s) { const float y = ty[s * 64 + lane], vi = tcur[s * 384 + 320 + lane], yn = (y - tst[2 * s]) * tst[2 * s + 1];
                Y[(size_t)(t0 + s) * 1024 + col] = (bf16)f2bf((yn * lg + lb + trk[s] * vi) * tg[s * 64 + lane]); }
            LDS_WAIT();
            if (ti + 1 < RW_CL / RW_TS) { rw_stage_store(tnxt, R, lane); rw_put8(tg + (lane >> 3) * 64 + 8 * (lane & 7), R.g); }
            LDS_WAIT();
        }
    }
}

__device__ __forceinline__ int ret_tok(int ks, int q, int i) { return 32 * ks + 4 * q + (i & 3) + ((i >> 2) << 4); }
__device__ __forceinline__ void prep_ret_frags(const Ctx& c, const PA& a, bool vonly = false) {
    unsigned char* ws = a.ws; bf16* proj = (bf16*)(ws + WS_PROJ); const float* cs = (const float*)(ws + WS_COS); const float* sn = (const float*)(ws + WS_SIN);
    LAS float* tile = (LAS float*)(c.lds + c.wave * 16896);
    const int lane = c.lane, r = lane & 15, q = lane >> 4;
    for (int it = c.gw; it < 8 * 128 * 4 * 2; it += c.NGW) { if (vonly && (it & 1)) continue; const int ten = it & 1, ks = (it >> 1) & 3, ch = (it >> 3) & 127, h = it >> 10; const int tb = ch * 128 + 32 * ks;
        if (ten == 0) {
#pragma unroll
            for (int i = 0; i < 8; ++i) { const int id = lane + 64 * i, row = id >> 4, c8 = (id & 15) * 8; const u32x4 v = *(const u32x4*)(proj + (size_t)(tb + row) * LDP + PC_RV + h * 128 + c8);
                LAS float* tp = tile + row * 132 + c8; *(LAS f32x4*)tp = (f32x4){bflo(v.x), bfhi(v.x), bflo(v.y), bfhi(v.y)}; *(LAS f32x4*)(tp + 4) = (f32x4){bflo(v.z), bfhi(v.z), bflo(v.w), bfhi(v.w)}; }
        } else {
#pragma unroll
            for (int i = 0; i < 4; ++i) { const int id = lane + 64 * i, row = id >> 3, c8 = (id & 7) * 8; bf16* kp = proj + (size_t)(tb + row) * LDP + PC_RK + h * 128 + c8;
                const u32x4 lo = *(const u32x4*)kp, hi = *(const u32x4*)(kp + 64);
                const f32x4 c0 = *(const f32x4*)(cs + (size_t)(tb + row) * 64 + c8), c1 = *(const f32x4*)(cs + (size_t)(tb + row) * 64 + c8 + 4), s0 = *(const f32x4*)(sn + (size_t)(tb + row) * 64 + c8), s1 = *(const f32x4*)(sn + (size_t)(tb + row) * 64 + c8 + 4);
                const float k1[8] = {bflo(lo.x), bfhi(lo.x), bflo(lo.y), bfhi(lo.y), bflo(lo.z), bfhi(lo.z), bflo(lo.w), bfhi(lo.w)}, k2[8] = {bflo(hi.x), bfhi(hi.x), bflo(hi.y), bfhi(hi.y), bflo(hi.z), bfhi(hi.z), bflo(hi.w), bfhi(hi.w)};
                float o1[8], o2[8];
#pragma unroll
                for (int j = 0; j < 8; ++j) { const float co = j < 4 ? c0[j] : c1[j - 4], si = j < 4 ? s0[j] : s1[j - 4];
                    o1[j] = bf2f((bf16)f2bf((k1[j] * co - k2[j] * si) * 0.08838834764831845f)); o2[j] = bf2f((bf16)f2bf((k1[j] * si + k2[j] * co) * 0.08838834764831845f)); }
                *(u32x4*)kp = (u32x4){pk2(o1[0], o1[1]), pk2(o1[2], o1[3]), pk2(o1[4], o1[5]), pk2(o1[6], o1[7])}; *(u32x4*)(kp + 64) = (u32x4){pk2(o2[0], o2[1]), pk2(o2[2], o2[3]), pk2(o2[4], o2[5]), pk2(o2[6], o2[7])};
                LAS float* tp = tile + row * 132 + c8;
                *(LAS f32x4*)tp = (f32x4){o1[0], o1[1], o1[2], o1[3]}; *(LAS f32x4*)(tp + 4) = (f32x4){o1[4], o1[5], o1[6], o1[7]}; *(LAS f32x4*)(tp + 64) = (f32x4){o2[0], o2[1], o2[2], o2[3]}; *(LAS f32x4*)(tp + 68) = (f32x4){o2[4], o2[5], o2[6], o2[7]}; }
        }
        LDS_WAIT();
        bf16* dst = (bf16*)(ws + (ten == 0 ? WS_VFR : WS_KTR)) + (((size_t)(h * 128 + ch) * 4 + ks) * 8) * 512 + lane * 8;
        float dec[8];
#pragma unroll
        for (int i = 0; i < 8; ++i) { const int tl = ret_tok(0, q, i); dec[i] = ten ? expf(RET_LOGG[h] * (float)(127 - (32 * ks + tl))) : 1.f; }
#pragma unroll
        for (int mt = 0; mt < 8; ++mt) { float v[8];
#pragma unroll
            for (int i = 0; i < 8; ++i) v[i] = tile[ret_tok(0, q, i) * 132 + 16 * mt + r] * dec[i];
            *(u32x4*)(dst + (size_t)mt * 512) = (u32x4){pk2(v[0], v[1]), pk2(v[2], v[3]), pk2(v[4], v[5]), pk2(v[6], v[7])}; }
        LDS_WAIT();
    }
}
__device__ __forceinline__ void ret_kv(const Ctx& c, const PA& a) {
    const bf16* VF = (const bf16*)(a.ws + WS_VFR); const bf16* KT = (const bf16*)(a.ws + WS_KTR); float* KV = (float*)(a.ws + WS_RETKV);
    const int lane = c.lane, r = lane & 15, q = lane >> 4;
    for (int task = c.gw; task < 128 * 8 * 8; task += c.NGW) { const int it = task >> 3, w = task & 7, ch = it >> 3, h = it & 7; const size_t fb = ((size_t)(h * 128 + ch) * 8) * 4 * 512 + lane * 8;
        f32x4 acc[8];
#pragma unroll
        for (int mt = 0; mt < 8; ++mt) acc[mt] = (f32x4){0.f, 0.f, 0.f, 0.f};
#pragma unroll
        for (int ks = 0; ks < 4; ++ks) { const bf16x8 kb = *(const bf16x8*)(KT + fb + (size_t)(ks * 8 + w) * 512);
#pragma unroll
            for (int mt = 0; mt < 8; ++mt) { const bf16x8 va = *(const bf16x8*)(VF + fb + (size_t)(ks * 8 + mt) * 512); acc[mt] = __builtin_amdgcn_mfma_f32_16x16x32_bf16(kb, va, acc[mt], 0, 0, 0); } }
        float* o = KV + ((size_t)it * 128 + r) * 128 + 16 * w + 4 * q;
#pragma unroll
        for (int mt = 0; mt < 8; ++mt) *(f32x4*)(o + (size_t)(16 * mt) * 128) = acc[mt];
    }
}
__device__ __forceinline__ void ret_prefix(const Ctx& c, const PA& a) {
    const float* KV = (const float*)(a.ws + WS_RETKV); bf16* RT = (bf16*)(a.ws + WS_RT);
    typedef float f32x2_ __attribute__((ext_vector_type(2)));
    for (int i = c.bx * 512 + c.tid; i < 8 * 8192; i += c.G * 512) { const int h = i >> 13, e = (i & 8191) * 2; const float cd = expf(RET_LOGG[h] * 128.f);
        float r0 = 0.f, r1 = 0.f;
        for (int c0 = 0; c0 < 128; c0 += 16) { f32x2_ tmp[16];
#pragma unroll
            for (int k = 0; k < 16; ++k) tmp[k] = *(const f32x2_*)(KV + ((size_t)((c0 + k) * 8 + h) << 14) + e);
#pragma unroll
            for (int k = 0; k < 16; ++k) { *(unsigned*)(RT + ((size_t)((c0 + k) * 8 + h) << 14) + e) = pk2(r0, r1); r0 = r0 * cd + tmp[k][0]; r1 = r1 * cd + tmp[k][1]; } } }
}
__device__ __forceinline__ void ret_out(const Ctx& c, const PA& a, int wv_first, int wv_count) {
    const bf16* proj = (const bf16*)(a.ws + WS_PROJ); const bf16* VF = (const bf16*)(a.ws + WS_VFR); const bf16* RT = (const bf16*)(a.ws + WS_RT); bf16* Y = (bf16*)(a.ws + WS_YRET);
    const int lane = c.lane, r = lane & 15, q = lane >> 4;
    if (c.wave < wv_first) return;
    for (int task = c.bx * wv_count + (c.wave - wv_first); task < 128 * 8 * 8; task += c.G * wv_count) { const int it = task >> 3, w = task & 7, ch = it >> 3, h = it & 7; const float lg2 = RET_LOGG[h] * 1.4426950408889634f;
        const int iq = 16 * w + r, tq = ch * 128 + iq;
        bf16x8 qb[4];
#pragma unroll
        for (int ks = 0; ks < 4; ++ks) qb[ks] = *(const bf16x8*)(proj + (size_t)tq * LDP + PC_RQ + h * 128 + 32 * ks + 8 * q);
        f32x4 oi[8], oc[8];
#pragma unroll
        for (int mt = 0; mt < 8; ++mt) { oi[mt] = (f32x4){0.f, 0.f, 0.f, 0.f}; oc[mt] = oi[mt]; }
        const size_t fb = ((size_t)(h * 128 + ch) * 8) * 4 * 512 + lane * 8;
#pragma unroll
        for (int ks = 0; ks < 4; ++ks) if (2 * ks <= w) { f32x4 st[2];
#pragma unroll
            for (int jj = 0; jj < 2; ++jj) { const int j = 2 * ks + jj; st[jj] = (f32x4){0.f, 0.f, 0.f, 0.f};
                if (j <= w) { const bf16* kp = proj + (size_t)(ch * 128 + 16 * j + r) * LDP + PC_RK + h * 128 + 8 * q;
#pragma unroll
                    for (int k2 = 0; k2 < 4; ++k2) st[jj] = __builtin_amdgcn_mfma_f32_16x16x32_bf16(*(const bf16x8*)(kp + 32 * k2), qb[k2], st[jj], 0, 0, 0);
#pragma unroll
                    for (int i = 0; i < 4; ++i) { const int d = iq - (16 * j + 4 * q + i); st[jj][i] = d >= 0 ? st[jj][i] * __builtin_amdgcn_exp2f(lg2 * (float)d) : 0.f; } } }
            const u32x4 pw = (u32x4){pg8::cvt_pk_bf16(st[0][0], st[0][1]), pg8::cvt_pk_bf16(st[0][2], st[0][3]), pg8::cvt_pk_bf16(st[1][0], st[1][1]), pg8::cvt_pk_bf16(st[1][2], st[1][3])};
            const bf16x8 pf = __builtin_bit_cast(bf16x8, pw);
#pragma unroll
            for (int mt = 0; mt < 8; ++mt) oi[mt] = __builtin_amdgcn_mfma_f32_16x16x32_bf16(*(const bf16x8*)(VF + fb + (size_t)(ks * 8 + mt) * 512), pf, oi[mt], 0, 0, 0);
            __builtin_amdgcn_sched_barrier(0); }
        const bf16* rp = RT + ((size_t)it * 128 + r) * 128 + 8 * q;
#pragma unroll
        for (int mt = 0; mt < 8; ++mt)
#pragma unroll
            for (int ks = 0; ks < 4; ++ks) { oc[mt] = __builtin_amdgcn_mfma_f32_16x16x32_bf16(*(const bf16x8*)(rp + (size_t)(16 * mt) * 128 + 32 * ks), qb[ks], oc[mt], 0, 0, 0); if (ks == 3 && (mt & 1)) __builtin_amdgcn_sched_barrier(0); }
        const float qd = __builtin_amdgcn_exp2f(lg2 * (float)(iq + 1));
        float sm = 0.f;
#pragma unroll
        for (int mt = 0; mt < 8; ++mt) { oi[mt] = oi[mt] + oc[mt] * qd; sm += (oi[mt][0] + oi[mt][1]) + (oi[mt][2] + oi[mt][3]); }
        sm = sum_x16_32(sm); const float mean = sm * (1.f / 128.f); float sq = 0.f;
#pragma unroll
        for (int mt = 0; mt < 8; ++mt) { oi[mt] = oi[mt] - mean; sq += (oi[mt][0] * oi[mt][0] + oi[mt][1] * oi[mt][1]) + (oi[mt][2] * oi[mt][2] + oi[mt][3] * oi[mt][3]); }
        sq = sum_x16_32(sq); const float rs = 1.f / sqrtf(sq * (1.f / 128.f) + 1e-5f);
        const bf16* gp = proj + (size_t)tq * LDP + PC_RG + h * 128 + 4 * q; bf16* yp = Y + (size_t)tq * 1024 + h * 128 + 4 * q;
#pragma unroll
        for (int mt = 0; mt < 8; ++mt) { const uint2 gw = *(const uint2*)(gp + 16 * mt); const float g0 = bflo(gw.x), g1 = bfhi(gw.x), g2 = bflo(gw.y), g3 = bfhi(gw.y);
            uint2 o; o.x = pg8::cvt_pk_bf16(g0 * sigm(g0) * oi[mt][0] * rs, g1 * sigm(g1) * oi[mt][1] * rs); o.y = pg8::cvt_pk_bf16(g2 * sigm(g2) * oi[mt][2] * rs, g3 * sigm(g3) * oi[mt][3] * rs);
            *(uint2*)(yp + 16 * mt) = o; }
    }
}


constexpr float NSA_C = 0.125f * 1.4426950408889634f;
constexpr float NSA_C8 = NSA_C * (1.f / 16.f);
struct NsaSrc { const bf16* kf; const bf16* vf; };

__device__ __forceinline__ void nsa_loadK(const NsaSrc& src, int key0, bf16x8 (&kf)[4][2], int lane) {
    const bf16* kp = src.kf + (size_t)(key0 >> 6) * 4096 + lane * 8;
#pragma unroll
    for (int j = 0; j < 4; ++j) { kf[j][0] = *(const bf16x8*)(kp + (2 * j) * 512); kf[j][1] = *(const bf16x8*)(kp + (2 * j + 1) * 512); }
}
__device__ __forceinline__ void nsa_loadV(const NsaSrc& src, int key0, bf16x8 (&vf)[4][2], int lane) {
    const bf16* vp = src.vf + (size_t)(key0 >> 6) * 4096 + lane * 8;
#pragma unroll
    for (int mt = 0; mt < 4; ++mt) { vf[mt][0] = *(const bf16x8*)(vp + (2 * mt) * 512); vf[mt][1] = *(const bf16x8*)(vp + (2 * mt + 1) * 512); }
}
__device__ __forceinline__ void nsa_qk(const bf16x8 (&kf)[4][2], const bf16x8 (&qf)[2], f32x4 (&st)[4]) {
#pragma unroll
    for (int j = 0; j < 4; ++j) { st[j] = (f32x4){0.f, 0.f, 0.f, 0.f};
        st[j] = __builtin_amdgcn_mfma_f32_16x16x32_bf16(kf[j][0], qf[0], st[j], 0, 0, 0); st[j] = __builtin_amdgcn_mfma_f32_16x16x32_bf16(kf[j][1], qf[1], st[j], 0, 0, 0); }
}
template <int MODE, bool MASKED>
__device__ __forceinline__ void nsa_rest(f32x4 (&st)[4], const bf16x8 (&vf)[4][2], int key0, int lo, int hi, f32x4 (&O)[4], float& m, float& l, float inv, int r, int q, LAS float* impA, LAS float* impB) {
    const float cm = NSA_C * m; float ps = 0.f;
#pragma unroll
    for (int j = 0; j < 4; ++j)
#pragma unroll
        for (int i = 0; i < 4; ++i) { float e = __builtin_amdgcn_exp2f(NSA_C * st[j][i] - cm);
            if (MASKED) { const int key = key0 + 16 * j + 4 * q + i; e = (key >= lo && key <= hi) ? e : 0.f; }
            st[j][i] = MODE == 2 ? e * inv : e; ps += e; }
    if (MODE != 2) l += ps;
    if (MODE == 2) {
#pragma unroll
        for (int j = 0; j < 4; ++j) { float a = (st[j][0] + st[j][1]) + (st[j][2] + st[j][3]), b = st[j][3];
            a = sum_x1_2(a); b = sum_x1_2(b);
            if ((r & 3) == 0) { const int J = (r >> 2) * 260 + (key0 >> 2) + 4 * j + q; atomicAdd((float*)(impA + J), a); atomicAdd((float*)(impA + J + 1), b); } } }
    if (MODE != 0) {
        bf16x8 pf[2];
#pragma unroll
        for (int ks = 0; ks < 2; ++ks) { const unsigned w0 = pg8::cvt_pk_bf16(st[2 * ks][0], st[2 * ks][1]), w1 = pg8::cvt_pk_bf16(st[2 * ks][2], st[2 * ks][3]),
                                                        w2 = pg8::cvt_pk_bf16(st[2 * ks + 1][0], st[2 * ks + 1][1]), w3 = pg8::cvt_pk_bf16(st[2 * ks + 1][2], st[2 * ks + 1][3]);
            const u32x4 w = (u32x4){w0, w1, w2, w3}; pf[ks] = __builtin_bit_cast(bf16x8, w); }
#pragma unroll
        for (int mt = 0; mt < 4; ++mt) {
#pragma unroll
            for (int ks = 0; ks < 2; ++ks) O[mt] = __builtin_amdgcn_mfma_f32_16x16x32_bf16(vf[mt][ks], pf[ks], O[mt], 0, 0, 0); } }
}
#define NSA_REST_(MODE, ST, VF, K0, LO, HI, LOU, HIU, INV) do { if ((K0) >= (LOU) && (K0) + 63 <= (HIU)) nsa_rest<MODE, false>(ST, VF, K0, LO, HI, O, m, l, INV, r, q, impA, impB);     \
        else nsa_rest<MODE, true>(ST, VF, K0, LO, HI, O, m, l, INV, r, q, impA, impB); } while (0)
#define NSA_LOOP(MODE, SRC, NBLK, KEY0, LO, HI, LOU, HIU, INV) do { const int nblk_ = (NBLK); if (nblk_ > 0) { bf16x8 kf_[4][2], vf_[4][2]; f32x4 st_[4]; nsa_loadK(SRC, KEY0(0), kf_, lane); \
    _Pragma("unroll 1") for (int b_ = 0; b_ < nblk_; ++b_) { const int k0_ = KEY0(b_); if (MODE != 0) nsa_loadV(SRC, k0_, vf_, lane); \
        nsa_qk(kf_, qf, st_); __builtin_amdgcn_sched_barrier(0); \
        if (b_ + 1 < nblk_) nsa_loadK(SRC, KEY0(b_ + 1), kf_, lane);     \
        NSA_REST_(MODE, st_, vf_, k0_, LO, HI, LOU, HIU, INV); } } } while (0)
typedef unsigned u32x2 __attribute__((ext_vector_type(2)));
__device__ __forceinline__ unsigned pack4_fp8(float a, float b, float c, float d) { int w = 0; w = __builtin_amdgcn_cvt_pk_fp8_f32(a, b, w, false); w = __builtin_amdgcn_cvt_pk_fp8_f32(c, d, w, true); return (unsigned)w; }
__device__ __forceinline__ void nsa_loadK8(const unsigned char* kf8, int key0, u32x4 (&k8)[4], int lane) {
    const unsigned char* kp = kf8 + (size_t)(key0 >> 6) * 4096 + lane * 16;
#pragma unroll
    for (int j = 0; j < 4; ++j) k8[j] = *(const u32x4*)(kp + j * 1024);
}
__device__ __forceinline__ void nsa_qk8(const u32x4 (&k8)[4], const long (&q8)[2], f32x4 (&st)[4]) {
#pragma unroll
    for (int j = 0; j < 4; ++j) st[j] = __builtin_amdgcn_mfma_f32_16x16x32_fp8_fp8(__builtin_bit_cast(long, (u32x2){k8[j].x, k8[j].y}), q8[0], (f32x4){0.f, 0.f, 0.f, 0.f}, 0, 0, 0);
#pragma unroll
    for (int j = 0; j < 4; ++j) st[j] = __builtin_amdgcn_mfma_f32_16x16x32_fp8_fp8(__builtin_bit_cast(long, (u32x2){k8[j].z, k8[j].w}), q8[1], st[j], 0, 0, 0);
}
__device__ __forceinline__ void nsa_loadV8(const unsigned char* vf8, int key0, u32x4 (&v8)[4], int lane) {
    const unsigned char* vp = vf8 + (size_t)(key0 >> 6) * 4096 + lane * 16;
#pragma unroll
    for (int mt = 0; mt < 4; ++mt) v8[mt] = *(const u32x4*)(vp + mt * 1024);
}
__device__ __forceinline__ void nsa_rest_dense(const f32x4 (&st)[4], const u32x4 (&v8)[4], f32x4 (&O)[4], float cm, float& l, int s4) {
    const bool i0 = s4 == 0, i1 = s4 == 1, i2 = s4 == 2, i3 = s4 == 3;
    const f32x4 x = i0 ? st[0] : (i1 ? st[1] : (i2 ? st[2] : st[3]));
    const float e0 = fminf(__builtin_amdgcn_exp2f(NSA_C8 * x[0] - cm), 416.f), e1 = fminf(__builtin_amdgcn_exp2f(NSA_C8 * x[1] - cm), 416.f), e2 = fminf(__builtin_amdgcn_exp2f(NSA_C8 * x[2] - cm), 416.f), e3 = fminf(__builtin_amdgcn_exp2f(NSA_C8 * x[3] - cm), 416.f);
    l += (e0 + e1) + (e2 + e3);
    const unsigned w = pack4_fp8(e0, e1, e2, e3);
    const long p0 = __builtin_bit_cast(long, (u32x2){i0 ? w : 0u, i1 ? w : 0u}), p1 = __builtin_bit_cast(long, (u32x2){i2 ? w : 0u, i3 ? w : 0u});
#pragma unroll
    for (int mt = 0; mt < 4; ++mt) O[mt] = __builtin_amdgcn_mfma_f32_16x16x32_fp8_fp8(__builtin_bit_cast(long, (u32x2){v8[mt].x, v8[mt].y}), p0, O[mt], 0, 0, 0);
#pragma unroll
    for (int mt = 0; mt < 4; ++mt) O[mt] = __builtin_amdgcn_mfma_f32_16x16x32_fp8_fp8(__builtin_bit_cast(long, (u32x2){v8[mt].z, v8[mt].w}), p1, O[mt], 0, 0, 0);
}
#define NSA_LOOP_DENSE(K8, V8, NBLK, KEY0, QD, CM, L, S4, KF, VA) do { const int nblk_ = (NBLK); if (nblk_ > 0) { u32x4 vb_[4]; f32x4 st_[4];     \
    _Pragma("unroll 1") for (int b_ = 0; b_ < nblk_; b_ += 2) { \
        if (b_ + 1 < nblk_) nsa_loadV8(V8, KEY0(b_ + 1), vb_, lane); \
        nsa_qk8(KF, QD, st_); __builtin_amdgcn_sched_barrier(0); \
        if (b_ + 1 < nblk_) nsa_loadK8(K8, KEY0(b_ + 1), KF, lane); \
        nsa_rest_dense(st_, VA, O, CM, L, S4); \
        if (b_ + 1 >= nblk_) break; \
        __builtin_amdgcn_sched_barrier(0); \
        if (b_ + 2 < nblk_) nsa_loadV8(V8, KEY0(b_ + 2), VA, lane); \
        nsa_qk8(KF, QD, st_); __builtin_amdgcn_sched_barrier(0); \
        if (b_ + 2 < nblk_) nsa_loadK8(K8, KEY0(b_ + 2), KF, lane); \
        nsa_rest_dense(st_, vb_, O, CM, L, S4); __builtin_amdgcn_sched_barrier(0); } } } while (0)
__device__ __forceinline__ float lane_get(float v, int src) { return __int_as_float(__builtin_amdgcn_ds_bpermute(src << 2, __float_as_int(v))); }
constexpr int NSA2_WLDS = 4352;
#ifndef NSA_SPLIT
#define NSA_SPLIT 218
#endif
__device__ __forceinline__ void nsa_attn2(const Ctx& c, const PA& a, int layer, int part) {
    const unsigned char* ws = a.ws; const bf16* proj = (const bf16*)(ws + WS_PROJ); bf16* Y = (bf16*)(a.ws + WS_YNSA);
    LAS float* impA = (LAS float*)(c.lds + (part ? 4 * 28800 + (c.wave - 4) * NSA2_WLDS : (c.wave < 4 ? c.wave * 24576 : 4 * 24576 + (c.wave - 4) * NSA2_WLDS)));         LAS float* impB = impA; LAS int* KST = (LAS int*)(impA + 1040);
    const int lane = c.lane, r = lane & 15, q = lane >> 4, tk = r >> 2, hh = r & 3;
    const bool xdeal = (c.G & 7) == 0; const int xg = c.bx & 7, ntask = xdeal ? T / 8 : T; unsigned* qctr = (unsigned*)(a.ws + WS_CTL) + CW_NSAQ + (xdeal ? xg : 0) * 64 + layer * 1024 + part * 32;
    const int nsplit = (ntask * NSA_SPLIT) >> 8, tbeg = part ? nsplit : 0, tend = part ? ntask : nsplit;
    unsigned tk_ = 0; if (lane == 0) tk_ = __hip_atomic_fetch_add(qctr, 1u, __ATOMIC_RELAXED, __HIP_MEMORY_SCOPE_AGENT);
    for (;;) { const int task = tbeg + (int)__builtin_amdgcn_readfirstlane(tk_); if (task >= tend) break;
        if (lane == 0) tk_ = __hip_atomic_fetch_add(qctr, 1u, __ATOMIC_RELAXED, __HIP_MEMORY_SCOPE_AGENT);
        const int rt = ntask - 1 - task, tq = xdeal ? 2 * rt + (xg >> 2) : rt >> 2, g = xdeal ? (xg & 3) : (rt & 3), t0 = 4 * tq, tcol = t0 + tk;
        const bf16* prow = proj + (size_t)tcol * LDP;
        bf16x8 qf[2]; { const bf16* qp = prow + PC_NQ + (g * 4 + hh) * 64 + 8 * q; qf[0] = *(const bf16x8*)qp; qf[1] = *(const bf16x8*)(qp + 32); }
        float gt0, gt1, gt2; { const bf16* gp = prow + PC_GATE + (g * 4 + hh) * 3; gt0 = sigm(bf2f(gp[0])); gt1 = sigm(bf2f(gp[1])); gt2 = sigm(bf2f(gp[2])); }
        float qn; { float f0[8], f1[8], sq = 0.f; un8(__builtin_bit_cast(u32x4, qf[0]), f0); un8(__builtin_bit_cast(u32x4, qf[1]), f1);
#pragma unroll
            for (int i = 0; i < 8; ++i) sq += f0[i] * f0[i] + f1[i] * f1[i];
            qn = sqrtf(sum_x16_32(sq)); }
        float kmx[3]; { const unsigned* kw = (const unsigned*)(ws + WS_CTL) + CW_KMAX + layer * 64 + g;
            kmx[0] = __uint_as_float(kw[0]); kmx[1] = __uint_as_float(kw[4]); kmx[2] = __uint_as_float(kw[8]); }
        const int cur = t0 >> 6, ncv = tcol >= 31 ? ((tcol - 31) >> 4) + 1 : 0, ncvmax = t0 + 3 >= 31 ? ((t0 + 3 - 31) >> 4) + 1 : 0;
#pragma unroll
        for (int i = 0; i < 17; ++i) if (lane + 64 * i < 1040) impA[lane + 64 * i] = 0.f;
        LDS_WAIT();
        f32x4 yacc[4], O[4];
#pragma unroll
        for (int mt = 0; mt < 4; ++mt) yacc[mt] = (f32x4){0.f, 0.f, 0.f, 0.f};
        if (ncvmax > 0) {
            NsaSrc sc; sc.kf = (const bf16*)(ws + WS_KCMPB) + (size_t)g * 16 * 4096; sc.vf = (const bf16*)(ws + WS_VCMPT) + (size_t)g * 16 * 4096;
            const int nb = (ncvmax + 63) >> 6; float m = qn * kmx[2], l = 0.f;
#define K0_CMP(b) (64 * (b))
            const int ncvmin = t0 >= 31 ? ((t0 - 31) >> 4) + 1 : 0;
            NSA_LOOP(0, sc, nb, K0_CMP, 0, ncv - 1, 0, ncvmin - 1, 0.f);
            l = sum_x16_32(l); const float inv = l > 0.f ? 1.f / l : 0.f;
#pragma unroll
            for (int mt = 0; mt < 4; ++mt) O[mt] = (f32x4){0.f, 0.f, 0.f, 0.f};
            NSA_LOOP(2, sc, nb, K0_CMP, 0, ncv - 1, 0, ncvmin - 1, inv);
#pragma unroll
            for (int mt = 0; mt < 4; ++mt) yacc[mt] = O[mt] * gt0;
        }
        LDS_WAIT();
        const unsigned char* ss8 = ws + WS_KF8 + (size_t)g * 256 * 4096; const unsigned char* sv8 = ws + WS_VF8 + (size_t)g * 256 * 4096;
        NsaSrc ss; ss.kf = (const bf16*)(ws + WS_KFS) + (size_t)g * 256 * 4096; ss.vf = (const bf16*)(ws + WS_VFS) + (size_t)g * 256 * 4096;
        f32x4 Oj[4]; const float mj = qn * kmx[0]; float lj = 0.f; const int nf = cur >= 2 ? 3 : cur + 1;
        { float m = mj, l = 0.f;
#pragma unroll
            for (int mt = 0; mt < 4; ++mt) O[mt] = (f32x4){0.f, 0.f, 0.f, 0.f};
#define K0_FRC(b) (64 * ((b) == 0 ? 0 : cur - (nf - 1) + (b)))
            NSA_LOOP(1, ss, nf, K0_FRC, 0, tcol, 0, t0, 0.f);
#pragma unroll
            for (int mt = 0; mt < 4; ++mt) Oj[mt] = O[mt];
            lj = l; }
        const float ljs = sum_x16_32(lj);
#pragma unroll 1
        for (int k = 0; k < 4; ++k) {
            const int hd = r >> 2, s4 = r & 3;
            bf16x8 qd[2]; { const bf16* qp = proj + (size_t)(t0 + k) * LDP + PC_NQ + (g * 4 + hd) * 64 + 8 * q; qd[0] = *(const bf16x8*)qp; qd[1] = *(const bf16x8*)(qp + 32); }
            u32x4 kfp[4], vap[4];
            float scv[4];
#pragma unroll
            for (int mm = 0; mm < 4; ++mm) { const int j = 4 * lane + mm; float s = -1.0e30f;
                if (j <= cur && !(j == 0 || j == cur || j == cur - 1)) s = impA[k * 260 + j];
                scv[mm] = s; }
            int nsel = 0;
            for (int itk = 0; itk < 16 - nf; ++itk) {
                float lv = scv[0]; int lj2 = 4 * lane;
                if (scv[1] > lv) { lv = scv[1]; lj2 = 4 * lane + 1; } if (scv[2] > lv) { lv = scv[2]; lj2 = 4 * lane + 2; } if (scv[3] > lv) { lv = scv[3]; lj2 = 4 * lane + 3; }
                const float vmax = wave_max(lv); if (vmax < -5.0e29f) break;
                const int jmin = wave_min_i(lv == vmax ? lj2 : (1 << 30));
                if (lane == 0) KST[itk] = jmin * 64;
                if (itk == 0) { const int k0f = __builtin_amdgcn_readfirstlane(jmin) * 64; nsa_loadK8(ss8, k0f, kfp, lane); nsa_loadV8(sv8, k0f, vap, lane); }
                if ((jmin >> 2) == lane) { const int mm = jmin & 3; if (mm == 0) scv[0] = -3.0e38f; else if (mm == 1) scv[1] = -3.0e38f; else if (mm == 2) scv[2] = -3.0e38f; else scv[3] = -3.0e38f; }
                ++nsel; }
            LDS_WAIT();
            { const bool mine = tk == k; const int srcl = (lane & 48) | (hh << 2) | tk;
                long q8[2];
#pragma unroll
                for (int ks = 0; ks < 2; ++ks) { float f[8]; un8(__builtin_bit_cast(u32x4, qd[ks]), f); q8[ks] = __builtin_bit_cast(long, (u32x2){pack4_fp8(4.f * f[0], 4.f * f[1], 4.f * f[2], 4.f * f[3]), pack4_fp8(4.f * f[4], 4.f * f[5], 4.f * f[6], 4.f * f[7])}); }
                const int srck = (lane & 48) | (k << 2) | hd;
                const float ljk = lane_get(ljs, srck), nj = (float)(129 + t0 + k - 64 * cur);
                const float kap = ljk > 0.f ? fminf(fmaxf(1.f + __builtin_amdgcn_logf(nj) - __builtin_amdgcn_logf(ljk), 0.f), 100.f) : 0.f, sk = __builtin_amdgcn_exp2f(-kap);
                const float cmd = NSA_C * lane_get(mj, srck) - kap;
                float ld = 0.f;
#pragma unroll
                for (int mt = 0; mt < 4; ++mt) O[mt] = (f32x4){0.f, 0.f, 0.f, 0.f};
#define K0_SEL(b) (__builtin_amdgcn_readfirstlane(KST[b]))
                NSA_LOOP_DENSE(ss8, sv8, nsel, K0_SEL, q8, cmd, ld, s4, kfp, vap);
                ld = sum_x16_32(sum_x1_2(ld)) * sk;
                const float l = ljs + lane_get(ld, srcl), sc = mine ? gt1 / l : 0.f;
#pragma unroll
                for (int mt = 0; mt < 4; ++mt)
#pragma unroll
                    for (int i = 0; i < 4; ++i) { const float od = lane_get(sum_x1_2(O[mt][i]) * (0.25f * sk), srcl);        yacc[mt][i] += (Oj[mt][i] + od) * sc; } }
            LDS_WAIT();
        }
        { NsaSrc sw; sw.kf = (const bf16*)(ws + WS_KFW) + (size_t)g * 256 * 4096; sw.vf = (const bf16*)(ws + WS_VFW) + (size_t)g * 256 * 4096;
            { const bf16* qp = prow + PC_NQ + (g * 4 + hh) * 64 + 8 * q; qf[0] = *(const bf16x8*)qp; qf[1] = *(const bf16x8*)(qp + 32); }
            float m = qn * kmx[1], l = 0.f; const int wlo = tcol - 511 > 0 ? tcol - 511 : 0, ulo = t0 - 511 > 0 ? t0 - 511 : 0;
#pragma unroll
            for (int mt = 0; mt < 4; ++mt) O[mt] = (f32x4){0.f, 0.f, 0.f, 0.f};
            const int jb0 = ulo >> 6;
#define K0_WIN(b) (64 * (jb0 + (b)))
            NSA_LOOP(1, sw, cur - jb0 + 1, K0_WIN, wlo, tcol, (t0 + 3 - 511 > 0 ? t0 + 3 - 511 : 0), t0, 0.f);
            l = sum_x16_32(l); const float sc = gt2 / l;
#pragma unroll
            for (int mt = 0; mt < 4; ++mt) yacc[mt] += O[mt] * sc; }
#pragma unroll
        for (int mt = 0; mt < 4; ++mt) { uint2 w; w.x = pg8::cvt_pk_bf16(yacc[mt][0], yacc[mt][1]); w.y = pg8::cvt_pk_bf16(yacc[mt][2], yacc[mt][3]);
            *(uint2*)(Y + (size_t)tcol * 1024 + (g * 4 + hh) * 64 + 16 * mt + 4 * q) = w; }
    }
}
__device__ __forceinline__ void prep_tiles(const Ctx& c, const PA& a, int layer) {
    const bf16* proj = (const bf16*)(a.ws + WS_PROJ);
    LAS bf16* tile = (LAS bf16*)(c.lds + c.wave * 8704);
    const int lane = c.lane, r = lane & 15, q = lane >> 4;
    for (int it = c.gw; it < 4 * 4 * 256; it += c.NGW) { const int blk = it & 255, g = (it >> 8) & 3, ten = it >> 10;
        const int scol = (ten == 0 ? PC_KS : (ten == 1 ? PC_VS : (ten == 2 ? PC_KW : PC_VW))) + g * 64;
        const u32x4* sp = (const u32x4*)(proj + (size_t)(blk * 64 + lane) * LDP + scol);
        float nq_ = 0.f;
#pragma unroll
        for (int i = 0; i < 8; ++i) { const u32x4 v = sp[i]; LAS unsigned* tp = (LAS unsigned*)(tile + lane * 66 + 8 * i); tp[0] = v.x; tp[1] = v.y; tp[2] = v.z; tp[3] = v.w;
            float f[8]; un8(v, f);
#pragma unroll
            for (int j = 0; j < 8; ++j) nq_ += f[j] * f[j]; }
        if ((ten & 1) == 0) { const float nm = wave_max(sqrtf(nq_)); if (lane == 0) atomicMax((unsigned*)(a.ws + WS_CTL) + CW_KMAX + layer * 64 + (ten >> 1) * 4 + g, __float_as_uint(nm)); }
        LDS_WAIT();
        bf16* dst = (bf16*)(a.ws + (ten == 0 ? WS_KFS : (ten == 1 ? WS_VFS : (ten == 2 ? WS_KFW : WS_VFW)))) + ((size_t)(g * 256 + blk) * 8) * 512 + lane * 8;
        if (ten == 0) {
            unsigned char* d8 = a.ws + WS_KF8 + ((size_t)(g * 256 + blk) * 4) * 1024 + lane * 16;
#pragma unroll
            for (int j = 0; j < 4; ++j) { unsigned w[4];
#pragma unroll
                for (int ks = 0; ks < 2; ++ks) { const LAS unsigned* tp = (const LAS unsigned*)(tile + (16 * j + r) * 66 + 32 * ks + 8 * q); float f[8]; un8((u32x4){tp[0], tp[1], tp[2], tp[3]}, f);
                    w[2 * ks] = pack4_fp8(4.f * f[0], 4.f * f[1], 4.f * f[2], 4.f * f[3]); w[2 * ks + 1] = pack4_fp8(4.f * f[4], 4.f * f[5], 4.f * f[6], 4.f * f[7]); }
                *(u32x4*)(d8 + j * 1024) = (u32x4){w[0], w[1], w[2], w[3]}; } }
        if (ten == 1) {
            unsigned char* d8 = a.ws + WS_VF8 + ((size_t)(g * 256 + blk) * 4) * 1024 + lane * 16;
#pragma unroll
            for (int mt = 0; mt < 4; ++mt) { unsigned w[4];
#pragma unroll
                for (int ks = 0; ks < 2; ++ks)
#pragma unroll
                    for (int h = 0; h < 2; ++h) { const int k0 = 32 * ks + 16 * h + 4 * q; const LAS bf16* tp = tile + k0 * 66 + 16 * mt + r;
                        w[2 * ks + h] = pack4_fp8(4.f * bf2f(tp[0]), 4.f * bf2f(tp[66]), 4.f * bf2f(tp[132]), 4.f * bf2f(tp[198])); }
                *(u32x4*)(d8 + mt * 1024) = (u32x4){w[0], w[1], w[2], w[3]}; } }
        if ((ten & 1) == 0) {
#pragma unroll
            for (int j = 0; j < 4; ++j)
#pragma unroll
                for (int ks = 0; ks < 2; ++ks) { const LAS unsigned* tp = (const LAS unsigned*)(tile + (16 * j + r) * 66 + 32 * ks + 8 * q);
                    *(u32x4*)(dst + (2 * j + ks) * 512) = (u32x4){tp[0], tp[1], tp[2], tp[3]}; }
        } else {
#pragma unroll
            for (int mt = 0; mt < 4; ++mt)
#pragma unroll
                for (int ks = 0; ks < 2; ++ks) { unsigned w[4];
#pragma unroll
                    for (int h = 0; h < 2; ++h)
#pragma unroll
                        for (int i2 = 0; i2 < 2; ++i2) { const int k0 = 32 * ks + 16 * h + 4 * q + 2 * i2;
                            w[2 * h + i2] = (unsigned)tile[k0 * 66 + 16 * mt + r] | ((unsigned)tile[(k0 + 1) * 66 + 16 * mt + r] << 16); }
                    *(u32x4*)(dst + (2 * mt + ks) * 512) = (u32x4){w[0], w[1], w[2], w[3]}; }
        }
        LDS_WAIT();
    }
}

__device__ __forceinline__ void ln_row(f32x4 (&v)[8], const float* gam, const float* bet, int lane) {
    float s = 0.f;
#pragma unroll
    for (int j = 0; j < 8; ++j) s += (v[j][0] + v[j][1]) + (v[j][2] + v[j][3]);
    const float mean = wave_sum(s) * (1.f / D); float s2 = 0.f;
#pragma unroll
    for (int j = 0; j < 8; ++j) { v[j] = v[j] - mean; s2 += (v[j][0] * v[j][0] + v[j][1] * v[j][1]) + (v[j][2] * v[j][2] + v[j][3] * v[j][3]); }
    const float rstd = 1.f / sqrtf(wave_sum(s2) * (1.f / D) + LN_EPS);
#pragma unroll
    for (int j = 0; j < 8; ++j) { const f32x4 g4 = *(const f32x4*)(gam + 4 * (lane + 64 * j)), b4 = *(const f32x4*)(bet + 4 * (lane + 64 * j)); v[j] = v[j] * rstd * g4 + b4; }
}
__device__ __forceinline__ void ph_ln1(const Ctx& c, const PA& a, int layer) {
    unsigned char* ws = a.ws; float* X = a.out; uint2* xb = (uint2*)(ws + WS_XB); const int lane = c.lane;
    for (int it = c.bx; it < T / 8; it += c.G) { const int t = it * 8 + c.wave;
        f32x4* row = (f32x4*)(X + (size_t)t * D); f32x4 v[8];
#pragma unroll
        for (int j = 0; j < 8; ++j) v[j] = row[lane + 64 * j];
        ln_row(v, a.in(25) + layer * D, a.in(26) + layer * D, lane);
#pragma unroll
        for (int j = 0; j < 8; ++j) { row[lane + 64 * j] = v[j]; xb[(size_t)t * (D / 4) + lane + 64 * j] = make_uint2(pk2(v[j][0], v[j][1]), pk2(v[j][2], v[j][3])); } }
}
__device__ __forceinline__ void ph_route(const Ctx& c, const PA& a, int layer) {
    unsigned char* ws = a.ws; const float* X = a.out;
    LAS float* lg = (LAS float*)(c.lds + c.wave * 256); LAS float* xr = (LAS float*)(c.lds + 4096 + c.wave * 8192); LAS float* wb = (LAS float*)(c.lds + 4096 + 65536);
    const int lane = c.lane, tid = c.tid, r0 = tid >> 3, p0_ = tid & 7;
    for (int it = c.bx; it < T / 8; it += c.G) { const int t = it * 8 + c.wave;
        const float* we = a.in(29) + (size_t)layer * D * 32; const float* wg = a.in(27) + (size_t)layer * D * 4;
        { const f32x4* row = (const f32x4*)(X + (size_t)t * D);
#pragma unroll
            for (int j = 0; j < 8; ++j) *(LAS f32x4*)(xr + 4 * (lane + 64 * j)) = row[lane + 64 * j];
#pragma unroll
            for (int i = 0; i < 4; ++i) *(LAS f32x4*)(wb + (r0 + 64 * i) * 36 + 4 + 4 * p0_) = *(const f32x4*)(we + (size_t)(r0 + 64 * i) * 32 + 4 * p0_);
            if (tid < 256) *(LAS f32x4*)(wb + tid * 36) = *(const f32x4*)(wg + (size_t)tid * 4); }
        __syncthreads();
        f32x4 acc[9];
#pragma unroll
        for (int q = 0; q < 9; ++q) acc[q] = (f32x4){0.f, 0.f, 0.f, 0.f};
#pragma unroll 1
        for (int ck = 0; ck < 8; ++ck) { const LAS float* wc = wb + (ck & 1) * 9216; LAS float* wn = wb + ((ck + 1) & 1) * 9216;
            const int d0 = ck + 1 < 8 ? 256 * (ck + 1) : 0;
            const f32x4 ne0 = *(const f32x4*)(we + (size_t)(d0 + r0) * 32 + 4 * p0_), ne1 = *(const f32x4*)(we + (size_t)(d0 + r0 + 64) * 32 + 4 * p0_),
                        ne2 = *(const f32x4*)(we + (size_t)(d0 + r0 + 128) * 32 + 4 * p0_), ne3 = *(const f32x4*)(we + (size_t)(d0 + r0 + 192) * 32 + 4 * p0_), ng = *(const f32x4*)(wg + (size_t)(d0 + (tid & 255)) * 4);
#pragma unroll
            for (int i = 0; i < 4; ++i) { const int dl = lane + 64 * i; const float x = xr[256 * ck + dl]; const LAS float* wr = wc + dl * 36;
#pragma unroll
                for (int q = 0; q < 9; ++q) acc[q] += *(const LAS f32x4*)(wr + 4 * q) * x;
                __builtin_amdgcn_sched_barrier(0); }
            *(LAS f32x4*)(wn + r0 * 36 + 4 + 4 * p0_) = ne0; *(LAS f32x4*)(wn + (r0 + 64) * 36 + 4 + 4 * p0_) = ne1; *(LAS f32x4*)(wn + (r0 + 128) * 36 + 4 + 4 * p0_) = ne2; *(LAS f32x4*)(wn + (r0 + 192) * 36 + 4 + 4 * p0_) = ne3;
            if (tid < 256) *(LAS f32x4*)(wn + tid * 36) = ng;
            __syncthreads(); }
        f32x4 ag = acc[0];
#pragma unroll
        for (int q = 0; q < 4; ++q) ag[q] = wave_sum(ag[q]) + a.in(28)[layer * 4 + q];
#pragma unroll
        for (int e4 = 0; e4 < 8; ++e4)
#pragma unroll
            for (int q = 0; q < 4; ++q) acc[1 + e4][q] = wave_sum(acc[1 + e4][q]);
        if (lane == 0) {
#pragma unroll
            for (int e4 = 0; e4 < 8; ++e4)
#pragma unroll
                for (int q = 0; q < 4; ++q) lg[e4 * 4 + q] = acc[1 + e4][q] + a.in(30)[layer * 32 + e4 * 4 + q]; }
        LDS_WAIT();
        int grp = 0; float gm = ag[0];
        if (ag[1] > gm) { gm = ag[1]; grp = 1; } if (ag[2] > gm) { gm = ag[2]; grp = 2; } if (ag[3] > gm) { gm = ag[3]; grp = 3; }
        const float gw_ = 1.f / (expf(ag[0] - gm) + expf(ag[1] - gm) + expf(ag[2] - gm) + expf(ag[3] - gm));
        float v0 = -3.0e38f, v1 = -3.0e38f; int i0 = 0, i1 = 0;
        for (int i = 0; i < 8; ++i) { const float x = lg[grp * 8 + i];
            if (x > v0) { v1 = v0; i1 = i0; v0 = x; i0 = i; } else if (x > v1) { v1 = x; i1 = i; } }
        const float e1 = expf(v1 - v0), p0 = 1.f / (1.f + e1), p1 = e1 * p0;
        if (lane == 0) { int* toke = (int*)(ws + WS_TOKE); float* tokw = (float*)(ws + WS_TOKW); unsigned* cnt = (unsigned*)(ws + WS_CTL) + CW_CNT + layer * 128; toke[2 * t] = grp * 8 + i0; toke[2 * t + 1] = grp * 8 + i1; tokw[2 * t] = p0 * gw_; tokw[2 * t + 1] = p1 * gw_;
            __hip_atomic_fetch_add(cnt + grp * 8 + i0, 1u, __ATOMIC_RELAXED, __HIP_MEMORY_SCOPE_AGENT); __hip_atomic_fetch_add(cnt + grp * 8 + i1, 1u, __ATOMIC_RELAXED, __HIP_MEMORY_SCOPE_AGENT); }
        __syncthreads();
    }
}
__device__ __forceinline__ void ph_slot(const Ctx& c, const PA& a, int layer) {
    unsigned char* ws = a.ws; unsigned* cnt = (unsigned*)(ws + WS_CTL) + CW_CNT + layer * 128; unsigned* cur = (unsigned*)(ws + WS_CTL) + CW_CUR + layer * 128;
    int* texp = (int*)(ws + WS_TEXP) + layer * 512; const int* toke = (const int*)(ws + WS_TOKE); int* slot = (int*)(ws + WS_SLOT);
    LAS int* pst = (LAS int*)c.lds; LAS int* ptl = pst + 64;
    if (c.tid < NEXP) ptl[c.tid] = ((int)__hip_atomic_load(cnt + c.tid, __ATOMIC_RELAXED, __HIP_MEMORY_SCOPE_AGENT) + 255) >> 8;
    __syncthreads();
    if (c.tid == 0) { int off = 0, nt = 0;
#pragma unroll 1
        for (int e = 0; e < NEXP; ++e) { const int tl = ptl[e];
            pst[e] = off; off += tl * 256;
            if (c.bx == 0) for (int q = 0; q < tl; ++q) texp[nt + q] = e;
            nt += tl; }
        if (c.bx == 0) texp[255] = nt; }
    __syncthreads();
    const u32x4* xb = (const u32x4*)(ws + WS_XB); u32x4* xs = (u32x4*)(ws + WS_XS);
    for (int a0 = c.gw * 16; a0 < 2 * T; a0 += c.NGW * 16) {
        int s = 0;
        if (c.lane < 16) { const int e = toke[a0 + c.lane]; s = pst[e] + (int)__hip_atomic_fetch_add(cur + e, 1u, __ATOMIC_RELAXED, __HIP_MEMORY_SCOPE_AGENT); slot[a0 + c.lane] = s; }
#pragma unroll 2
        for (int i = 0; i < 16; i += 2) { const int s0 = __builtin_amdgcn_readlane(s, i), s1 = __builtin_amdgcn_readlane(s, i + 1), t0 = (a0 + i) >> 1, t1 = (a0 + i + 1) >> 1;
            u32x4 v0[4], v1[4];
#pragma unroll
            for (int j = 0; j < 4; ++j) { v0[j] = xb[(size_t)t0 * 256 + c.lane + 64 * j]; v1[j] = xb[(size_t)t1 * 256 + c.lane + 64 * j]; }
#pragma unroll
            for (int j = 0; j < 4; ++j) { xs[(size_t)s0 * 256 + c.lane + 64 * j] = v0[j]; xs[(size_t)s1 * 256 + c.lane + 64 * j] = v1[j]; } } }
}
__device__ __forceinline__ void ph_ln2(const Ctx& c, const PA& a, int layer) {
    unsigned char* ws = a.ws; float* X = a.out; uint2* xb = (uint2*)(ws + WS_XB); const uint2* ys = (const uint2*)(ws + WS_YS);
    const float* gam = a.in(34) + layer * D; const float* bet = a.in(35) + layer * D; const int* slot = (const int*)(ws + WS_SLOT); const float* tokw = (const float*)(ws + WS_TOKW);
    const int lane = c.lane;
    for (int t = c.gw; t < T; t += c.NGW) {
        const int s0 = slot[2 * t], s1 = slot[2 * t + 1]; const float w0 = tokw[2 * t], w1 = tokw[2 * t + 1];
        f32x4* row = (f32x4*)(X + (size_t)t * D); f32x4 v[8];
#pragma unroll
        for (int j = 0; j < 8; ++j) { const uint2 y0 = ys[(size_t)s0 * 512 + lane + 64 * j], y1 = ys[(size_t)s1 * 512 + lane + 64 * j]; const f32x4 x = row[lane + 64 * j];
            v[j][0] = x[0] * DN_ALPHA + w0 * bflo(y0.x) + w1 * bflo(y1.x); v[j][1] = x[1] * DN_ALPHA + w0 * bfhi(y0.x) + w1 * bfhi(y1.x);
            v[j][2] = x[2] * DN_ALPHA + w0 * bflo(y0.y) + w1 * bflo(y1.y); v[j][3] = x[3] * DN_ALPHA + w0 * bfhi(y0.y) + w1 * bfhi(y1.y); }
        ln_row(v, gam, bet, lane);
#pragma unroll
        for (int j = 0; j < 8; ++j) { row[lane + 64 * j] = v[j]; xb[(size_t)t * (D / 4) + lane + 64 * j] = make_uint2(pk2(v[j][0], v[j][1]), pk2(v[j][2], v[j][3])); }
    }
}

enum { PH_CONV = 0, PH_INPROJ, PH_PREP, PH_LORA, PH_SCAN1, PH_SCAN2, PH_SCAN3, PH_GATES, PH_BRANCH, PH_OUT, PH_LN1, PH_SLOT, PH_MOE_GU, PH_MOE_DN, PH_LN2, NPH_L };
constexpr int NPH = NPH_L * DEPTH;

__device__ __forceinline__ Ctx mkctx(LAS unsigned char* lds, int wv) {
    int ln; asm volatile("v_mbcnt_lo_u32_b32 %0, -1, 0\n\tv_mbcnt_hi_u32_b32 %0, -1, %0" : "=v"(ln));
    int tid = wv * 64 + ln, bx = blockIdx.x, G = gridDim.x;
    asm volatile("" : "+s"(bx)); asm volatile("" : "+s"(G));
    Ctx c; c.lds = lds; c.tid = tid; c.lane = tid & 63; c.wave = __builtin_amdgcn_readfirstlane(tid >> 6); c.G = G; c.bx = bx; c.gw = bx * 8 + c.wave; c.NGW = G * 8; return c;
}
__global__ void __launch_bounds__(512, 2) fwd(Args args0) {
    extern __shared__ __attribute__((aligned(16))) unsigned char lds_raw[];
    LAS unsigned char* const lds0 = (LAS unsigned char*)lds_raw;
    const int lo = args0.ph_lo, hi = args0.ph_hi;
    const int wv0 = __builtin_amdgcn_readfirstlane(threadIdx.x >> 6);
    if (threadIdx.x < 36) ((LAS unsigned long long*)(lds0 + LDS_PTAB))[threadIdx.x] = (unsigned long long)args0.in[threadIdx.x];
    __syncthreads();
#if MK_ONE_LAUNCH
    volatile LAS unsigned* barw = (volatile LAS unsigned*)(lds0 + LDS_BARW);
    if (threadIdx.x == 0) { barw[0] = 0u; barw[1] = 0u; barw[2] = 0u; barw[3] = 0u; }
    __syncthreads();
    XcdBarrier bar = xcd_barrier_post((unsigned*)(args0.ws + WS_CTL) + CW_BAR, barw);
#define SEAM(p) do { if ((p) + 1 < hi) xcd_barrier(bar); } while (0)
#else
#define SEAM(p) do { } while (0)
#endif
#ifndef ONLY_PHASE
#define ONLY_PHASE -1
#endif
#define PHASE_BEGIN PA args; { unsigned long long w_ = (unsigned long long)args0.ws; asm volatile("" : "+s"(w_)); args.ws = (unsigned char*)(GAS unsigned char*)w_; unsigned long long o_ = (unsigned long long)args0.out; asm volatile("" : "+s"(o_)); args.out = (float*)(GAS float*)o_; args.tab = (const LAS unsigned*)(lds0 + LDS_PTAB); } unsigned char* const ws = args.ws; const Ctx c = mkctx(lds0, wv0); (void)ws; (void)c;
#define TASK_CTX() mkctx(lds0, wv0)
#ifdef TIME_PHASE
    unsigned long long tp_a_ = 0ull, tp_b_ = 0ull;
#define TP_BEGIN(p) do { if ((TIME_PHASE >> ((p) % NPH_L)) & 1) tp_a_ = __builtin_amdgcn_s_memrealtime(); } while (0)
#define TP_END(p) do { if ((TIME_PHASE >> ((p) % NPH_L)) & 1) tp_b_ += __builtin_amdgcn_s_memrealtime() - tp_a_; } while (0)
#else
#define TP_BEGIN(p) do { } while (0)
#define TP_END(p) do { } while (0)
#endif
#define IN(p) ((ONLY_PHASE < 0 || ONLY_PHASE == ((p) - pb)) && lo <= (p) && (p) < hi)
    for (int layer = 0; layer < DEPTH; ++layer) {
        const int pb = layer * NPH_L;
        if (IN(pb + PH_CONV)) { TP_BEGIN(pb + PH_CONV); PHASE_BEGIN ph_conv(c, args, layer); __syncthreads(); SEAM(pb + PH_CONV); TP_END(pb + PH_CONV); }
        if (IN(pb + PH_INPROJ)) { TP_BEGIN(pb + PH_INPROJ); PHASE_BEGIN
            Gemm g{D, D, D}; SchedPlain S; S.to.init(T / 256, PC_GATE / 256); S.G = c.G; S.c = c.bx; S.tid = c.tid; S.A = (const char*)(ws + WS_XB); S.B = (const char*)(ws + WS_WIN); S.ta = (size_t)256 * D * 2; S.tb = (size_t)256 * D * 2;
            EpiStore<0> E{(bf16*)(ws + WS_PROJ), LDP};
            pg8::gemm_phase<EpiStore<0>, SchedPlain, PG8_ALIGN, PG8_SP2>(c.lds, g, S, E);
#ifdef REP_GEMM
            pg8::gemm_phase<EpiStore<0>, SchedPlain, PG8_ALIGN, PG8_SP2>(c.lds, g, S, E);
#endif
            { const Ctx c2 = TASK_CTX(); int k2_ = D / 4; asm volatile("" : "+s"(k2_)); Gemm g2{k2_, D, D}; SchedSplitK S2; S2.G = c2.G; S2.c = c2.bx; S2.tid = c2.tid; S2.n = (T / 256) * 4; S2.A = (const char*)(ws + WS_XB); S2.B = (const char*)(ws + WS_WIN) + (size_t)PC_GATE * D * 2; S2.ta = (size_t)256 * D * 2; S2.kb = (size_t)(D / 4) * 2;
                EpiPart48 E2{(float*)(ws + WS_GPART)};
                pg8::gemm_phase<EpiPart48, SchedSplitK, PG8_ALIGN, PG8_SP2>(c2.lds, g2, S2, E2); }
            SEAM(pb + PH_INPROJ); TP_END(pb + PH_INPROJ); }
        if (IN(pb + PH_PREP)) { TP_BEGIN(pb + PH_PREP); PHASE_BEGIN
            { const float* gpart = (const float*)(ws + WS_GPART); bf16* pj = (bf16*)(ws + WS_PROJ);
#pragma unroll 1
                for (int i = c.bx * 512 + c.tid; i < T * 48; i += c.G * 512) { const int t = i / 48, cc = i - t * 48;
                    const float sgl = (gpart[i] + gpart[(size_t)T * 48 + i]) + (gpart[(size_t)2 * T * 48 + i] + gpart[(size_t)3 * T * 48 + i]);
                    pj[(size_t)t * LDP + PC_GATE + cc] = (bf16)f2bf(sgl); } }
            prep_rwkv(TASK_CTX(), args, layer); __syncthreads();
#ifdef REP_PRW
            prep_rwkv(TASK_CTX(), args, layer); __syncthreads();
#endif
#ifdef REP_PCMP
            prep_cmp(TASK_CTX(), args, layer);
#endif
#ifdef REP_PTILES
            prep_tiles(TASK_CTX(), args, layer); __syncthreads();
#endif
 prep_cmp(TASK_CTX(), args, layer); prep_rope(TASK_CTX(), args); prep_ret_frags(TASK_CTX(), args); __syncthreads(); prep_tiles(TASK_CTX(), args, layer);
#ifdef REP_RETPREP
            prep_ret_frags(TASK_CTX(), args, true); prep_ret_frags(TASK_CTX(), args, true);
#endif
 __syncthreads(); SEAM(pb + PH_PREP); TP_END(pb + PH_PREP); }
        if (IN(pb + PH_LORA)) { TP_BEGIN(pb + PH_LORA); PHASE_BEGIN
            int kl_ = 256; asm volatile("" : "+s"(kl_));
            Gemm g{kl_, 1024, 256}; SchedLora S; S.to.init(T / 256, layer ? 16 : 12); S.G = c.G; S.c = c.bx; S.tid = c.tid; S.A = (const char*)(ws + WS_ALORA); S.B = (const char*)(ws + WS_WLORA);
            EpiLora E{ws, args, layer};
            pg8::gemm_phase<EpiLora, SchedLora, PG8_ALIGN, PG8_SP2>(c.lds, g, S, E);
            SEAM(pb + PH_LORA); TP_END(pb + PH_LORA); }
#ifdef TIME_P1
        if (IN(pb + PH_SCAN1)) { PHASE_BEGIN tp_a_ = __builtin_amdgcn_s_memrealtime(); rw_pass1(c, args);
#else
        if (IN(pb + PH_SCAN1)) { TP_BEGIN(pb + PH_SCAN1); PHASE_BEGIN rw_pass1(c, args);
#endif
#if defined(REP_RW) || defined(REP_P1)
            rw_pass1(TASK_CTX(), args);
#endif
 ret_kv(TASK_CTX(), args);
#ifdef TIME_P1
 tp_b_ += __builtin_amdgcn_s_memrealtime() - tp_a_;
#endif
 nsa_attn2(TASK_CTX(), args, layer, 0); __syncthreads();

 SEAM(pb + PH_SCAN1); TP_END(pb + PH_SCAN1); }
        if (IN(pb + PH_SCAN2)) { TP_BEGIN(pb + PH_SCAN2); PHASE_BEGIN rw_pass2(c, args);
#if defined(REP_RW) || defined(REP_P2)
            rw_pass2(TASK_CTX(), args);
#endif
 ret_prefix(TASK_CTX(), args);
#ifdef REP_PFX
            ret_prefix(TASK_CTX(), args); ret_prefix(TASK_CTX(), args);
#endif
 __syncthreads(); SEAM(pb + PH_SCAN2); TP_END(pb + PH_SCAN2); }
        if (IN(pb + PH_SCAN3)) { TP_BEGIN(pb + PH_SCAN3); PHASE_BEGIN rw_pass3(c, args, layer); ret_out(TASK_CTX(), args, 4, 4); { const Ctx cn = TASK_CTX(); if (cn.wave >= 4) nsa_attn2(cn, args, layer, 1); }        __syncthreads(); SEAM(pb + PH_SCAN3); TP_END(pb + PH_SCAN3); }
        if (IN(pb + PH_GATES)) { TP_BEGIN(pb + PH_GATES); PHASE_BEGIN
            Gemm g{D, D, D}; SchedPlain S; S.to.init(T / 256, NG / 256); S.G = c.G; S.c = c.bx; S.tid = c.tid; S.A = (const char*)(ws + WS_XB); S.B = (const char*)(ws + WS_WG); S.ta = (size_t)256 * D * 2; S.tb = (size_t)256 * D * 2;
            EpiStore<1> E{(bf16*)(ws + WS_GATES), NG};
            pg8::gemm_phase<EpiStore<1>, SchedPlain, PG8_ALIGN, PG8_SP2>(c.lds, g, S, E);
#ifdef REP_GEMM
            pg8::gemm_phase<EpiStore<1>, SchedPlain, PG8_ALIGN, PG8_SP2>(c.lds, g, S, E);
#endif
            SEAM(pb + PH_GATES); TP_END(pb + PH_GATES); }
        if (IN(pb + PH_BRANCH)) { TP_BEGIN(pb + PH_BRANCH); PHASE_BEGIN
            Gemm g{RWW, RWW, RWW}; SchedBranch S; S.to.init(T / 256, D / 256); S.G = c.G; S.c = c.bx; S.tid = c.tid;
            S.A0 = (const char*)(ws + WS_YRW); S.sa = WS_YNSA - WS_YRW; static_assert(WS_YRET - WS_YNSA == WS_YNSA - WS_YRW, "y buffers equally spaced");
            S.B0 = (const char*)(ws + WS_WBR); S.sb = (size_t)D * RWW * 2; S.ta = (size_t)256 * RWW * 2; S.tb = (size_t)256 * RWW * 2;
            EpiBranch E{(bf16*)(ws + WS_MERGED), (const bf16*)(ws + WS_GATES)};
            pg8::gemm_phase<EpiBranch, SchedBranch, PG8_ALIGN, PG8_SP2>(c.lds, g, S, E);
            SEAM(pb + PH_BRANCH); TP_END(pb + PH_BRANCH); }
        if (IN(pb + PH_OUT)) { TP_BEGIN(pb + PH_OUT); PHASE_BEGIN
            Gemm g{D, D, D}; SchedPlain S; S.to.init(T / 256, D / 256); S.G = c.G; S.c = c.bx; S.tid = c.tid; S.A = (const char*)(ws + WS_MERGED); S.B = (const char*)(ws + WS_WOUT); S.ta = (size_t)256 * D * 2; S.tb = (size_t)256 * D * 2;
            EpiResid E{args.out};
            pg8::gemm_phase<EpiResid, SchedPlain, PG8_ALIGN, PG8_SP2>(c.lds, g, S, E);
            SEAM(pb + PH_OUT); TP_END(pb + PH_OUT); }
        if (IN(pb + PH_LN1)) { TP_BEGIN(pb + PH_LN1); PHASE_BEGIN ph_ln1(c, args, layer); __syncthreads(); ph_route(TASK_CTX(), args, layer); __syncthreads(); ph_conv_moe(TASK_CTX(), args, layer); __syncthreads();
#ifdef REP_CMOE
            ph_conv_moe(TASK_CTX(), args, layer); __syncthreads();
#endif
            SEAM(pb + PH_LN1); TP_END(pb + PH_LN1); }
        if (IN(pb + PH_SLOT)) { TP_BEGIN(pb + PH_SLOT); PHASE_BEGIN ph_slot(c, args, layer); __syncthreads(); SEAM(pb + PH_SLOT); TP_END(pb + PH_SLOT); }
        if (IN(pb + PH_MOE_GU)) { TP_BEGIN(pb + PH_MOE_GU); PHASE_BEGIN
            const int* texp = (const int*)(ws + WS_TEXP) + layer * 512;
            Gemm g{D, D, D}; SchedMoe S; S.nM = texp[255]; S.nN = 4; S.G = c.G; S.c = c.bx; S.tid = c.tid; S.A = (const char*)(ws + WS_XS); S.B = (const char*)(ws + WS_WGU); S.ta = (size_t)256 * D * 2; S.tb = (size_t)256 * D * 2; S.te = (size_t)1024 * D * 2; S.texp = texp;
            EpiGateUp E{(bf16*)(ws + WS_H)};
            pg8::gemm_phase<EpiGateUp, SchedMoe, PG8_ALIGN, PG8_SP2>(c.lds, g, S, E);
#ifdef REP_GEMM
            pg8::gemm_phase<EpiGateUp, SchedMoe, PG8_ALIGN, PG8_SP2>(c.lds, g, S, E);
#endif
            SEAM(pb + PH_MOE_GU); TP_END(pb + PH_MOE_GU); }
        if (IN(pb + PH_MOE_DN)) { TP_BEGIN(pb + PH_MOE_DN); PHASE_BEGIN
            const int* texp = (const int*)(ws + WS_TEXP) + layer * 512;
            Gemm g{FF, FF, FF}; SchedMoe S; S.nM = texp[255]; S.nN = 8; S.G = c.G; S.c = c.bx; S.tid = c.tid; S.A = (const char*)(ws + WS_H); S.B = (const char*)(ws + WS_WDN); S.ta = (size_t)256 * FF * 2; S.tb = (size_t)256 * FF * 2; S.te = (size_t)D * FF * 2; S.texp = texp;
            EpiStore<0> E{(bf16*)(ws + WS_YS), D};
            pg8::gemm_phase<EpiStore<0>, SchedMoe, PG8_ALIGN, PG8_SP2>(c.lds, g, S, E);
#ifdef REP_GEMM
            pg8::gemm_phase<EpiStore<0>, SchedMoe, PG8_ALIGN, PG8_SP2>(c.lds, g, S, E);
#endif
            SEAM(pb + PH_MOE_DN); TP_END(pb + PH_MOE_DN); }
        if (IN(pb + PH_LN2)) { TP_BEGIN(pb + PH_LN2); PHASE_BEGIN ph_ln2(c, args, layer); __syncthreads(); SEAM(pb + PH_LN2); TP_END(pb + PH_LN2); }
    }
#ifdef TIME_PHASE
    if (blockIdx.x == 0) { const unsigned long long w0 = __builtin_amdgcn_s_memrealtime(), dw = tp_b_ * TIME_AMP; while (__builtin_amdgcn_s_memrealtime() - w0 < dw) __builtin_amdgcn_s_sleep(8); }
#endif
#undef IN
#undef SEAM
}

#ifndef TRUNC_PH
#define TRUNC_PH NPH
#endif
#ifndef DUMP_MODE
#define DUMP_MODE 0
#endif
#if DUMP_MODE
__global__ void dump_k(float* out, const unsigned char* ws) {
    for (size_t i = (size_t)blockIdx.x * blockDim.x + threadIdx.x; i < (size_t)T * D; i += (size_t)gridDim.x * blockDim.x) {
        const int t = (int)(i / D), c = (int)(i % D); float v = 0.f;
#if DUMP_MODE == 1
        v = bf2f(((const bf16*)(ws + WS_PROJ))[(size_t)t * LDP + c * 5]);
#elif DUMP_MODE == 2
        if (c < 1024) v = bf2f(((const bf16*)(ws + WS_YRW))[(size_t)t * 1024 + c]); else v = bf2f(((const bf16*)(ws + WS_YNSA))[(size_t)t * 1024 + c - 1024]);
#elif DUMP_MODE == 3
        if (c < 1024) v = bf2f(((const bf16*)(ws + WS_YRET))[(size_t)t * 1024 + c]); else v = bf2f(((const bf16*)(ws + WS_MERGED))[(size_t)t * D + c]);
#elif DUMP_MODE == 4
        if (c < 1024) v = bf2f(((const bf16*)(ws + WS_YRET))[(size_t)t * 1024 + c]);
#elif DUMP_MODE == 5
        v = bf2f(((const bf16*)(ws + WS_GATES))[(size_t)t * NG + c * 3]);
#endif
        out[i] = (v == v && fabsf(v) < 1e30f) ? v : 0.f; }
}
#endif
extern "C" void kernel_launch(void* const* d_in, const int* in_sizes, int n_in, void* d_out, int out_size, void* d_ws, size_t ws_size, hipStream_t stream) {
    static int grid = 0;
    if (grid == 0) {
        if (n_in != 36 || out_size != T * D || ws_size < WS_END) { fprintf(stderr, "kernel_launch: unexpected shapes (n_in %d out %d ws %zu)\n", n_in, out_size, ws_size); grid = -1; return; }
        int dev = 0, cus = 0, per_cu = 0;
        if (hipGetDevice(&dev) != hipSuccess || hipDeviceGetAttribute(&cus, hipDeviceAttributeMultiprocessorCount, dev) != hipSuccess) { grid = -1; return; }
        if (hipFuncSetAttribute((const void*)fwd, hipFuncAttributeMaxDynamicSharedMemorySize, LDS_BYTES) != hipSuccess) { fprintf(stderr, "kernel_launch: hipFuncSetAttribute failed\n"); grid = -1; return; }
        if (hipOccupancyMaxActiveBlocksPerMultiprocessor(&per_cu, (const void*)fwd, 512, LDS_BYTES) != hipSuccess || per_cu < 1) fprintf(stderr, "kernel_launch: occupancy query says %d\n", per_cu);
        (void)hipGetLastError();
        grid = cus;
    }
    if (grid < 0) return;
    if (hipMemsetAsync((char*)d_ws + WS_CTL, 0, CTL_ZERO_BYTES, stream) != hipSuccess) return;
    Args a{};
    for (int i = 0; i < 36; ++i) a.in[i] = (const float*)d_in[i];
    a.out = (float*)d_out; a.ws = (unsigned char*)d_ws;
#if MK_ONE_LAUNCH
    a.ph_lo = 0; a.ph_hi = NPH;
    hipLaunchKernelGGL(fwd, dim3(grid), dim3(512), LDS_BYTES, stream, a);
#else
    for (int p = 0; p < TRUNC_PH; ++p) { a.ph_lo = p; a.ph_hi = p + 1; hipLaunchKernelGGL(fwd, dim3(grid), dim3(512), LDS_BYTES, stream, a); }
#if DUMP_MODE
    dump_k<<<2048, 256, 0, stream>>>((float*)d_out, (const unsigned char*)d_ws);
#endif
#endif
}
```

```cpp
#define MK_ONE_LAUNCH 1
#include <hip/hip_runtime.h>
#include <cstdio>
#include <cstdint>

#ifndef MK_ONE_LAUNCH
#define MK_ONE_LAUNCH 0
#endif

namespace pg8 {
#define PG8_LAS __attribute__((address_space(3)))
typedef unsigned short bf16_t;
typedef short bf16x8 __attribute__((ext_vector_type(8)));
typedef float f32x4 __attribute__((ext_vector_type(4)));
typedef unsigned u32x4 __attribute__((ext_vector_type(4)));
constexpr int BM = 256, BK = 64, HALF = 128, HTB = HALF * BK * 2  , STAGE_BYTES = 8 * HTB, NXCD = 8, WGM = 8;

__host__ __device__ __forceinline__ int lds_byte(int r, int c) { const int st = (r >> 4) * 2 + (c >> 5), rr = r & 15, cc = c & 31, ob = rr * 64 + cc * 2; return st * 1024 + (ob ^ (((ob >> 9) & 1) << 5)); }
__host__ __device__ __forceinline__ void stage_rc(int b, int& R, int& C) { const int st = b / 1024, sb = b % 1024, swz = sb ^ (((sb >> 9) & 1) << 5); R = (st >> 1) * 16 + swz / 64; C = (st & 1) * 32 + (swz % 64) / 2; }
__host__ __device__ __forceinline__ int perm32(int rho) { const int n = rho >> 4, i = rho & 15; return 8 * (i >> 2) + 4 * n + (i & 3); }

struct Unit { int pm, pn, aux; const char* a; const char* b; };
struct Gemm { int K, lda, ldb; };

struct TileOrder {
    int nM, nN, nwg;
    __device__ void init(int nM_, int nN_) { nM = nM_; nN = nN_; nwg = nM * nN; }
    __device__ bool tile(long L, int& pm, int& pn) const {
        if (L >= nwg) return false;
        int wgid = (int)L; { const int q = nwg / NXCD, r = nwg % NXCD, xcd = wgid % NXCD, off = wgid / NXCD; wgid = (xcd < r ? xcd * (q + 1) : r * (q + 1) + (xcd - r) * q) + off; }
        const int nig = WGM * nN, gid = wgid / nig, fm = gid * WGM, gsz = (nM - fm) < WGM ? (nM - fm) : WGM;
        pm = fm + ((wgid % nig) % gsz); pn = (wgid % nig) / gsz; return true;
    }
};

typedef float f32x2_t __attribute__((ext_vector_type(2))); typedef __bf16 bf16x2_t __attribute__((ext_vector_type(2)));
__device__ __forceinline__ unsigned cvt_pk_bf16(float lo, float hi) { f32x2_t v = {lo, hi}; bf16x2_t b = __builtin_convertvector(v, bf16x2_t); return __builtin_bit_cast(unsigned, b); }

template <class Epi, class Sched, bool ALIGN_EPI = false, bool SP2 = false>
__device__ __forceinline__ void gemm_phase(PG8_LAS unsigned char* lds, const Gemm g, const Sched& S, const Epi& E) {
    const int tid = S.tid, wid = __builtin_amdgcn_readfirstlane(tid >> 6), lane = tid & 63, wr = wid >> 2, wc = wid & 3, fr = lane & 15, fq = lane >> 4;
    const int K = g.K, nt = K / BK;
    unsigned voffA[2], voffB[2];
#pragma unroll
    for (int i = 0; i < 2; ++i) { int R, C; stage_rc(tid * 16 + i * 8192, R, C); const int Rb = Epi::PERM ? ((R & ~31) + perm32(R & 31)) : R;
        voffA[i] = (unsigned)(R * g.lda + C) * 2u; voffB[i] = (unsigned)(Rb * g.ldb + C) * 2u; }
    const size_t kstep = (size_t)(BK * 2);
    const size_t hstepA = (size_t)HALF * g.lda * 2, hstepB = (size_t)HALF * g.ldb * 2;
    const unsigned ldsw = (unsigned)wid * 1024u;
    const int aoff = lds_byte(wr * 64 + fr, fq * 8), boff = lds_byte(wc * 32 + fr, fq * 8);
#define PG8_SA(b, h) (((b) * 2 + (h)) * HTB)
#define PG8_SB(b, h) ((4 + (b) * 2 + (h)) * HTB)
#define PG8_STAGE(bufoff, gbase, voff) do { _Pragma("unroll") for (int _i = 0; _i < 2; ++_i) \
        __builtin_amdgcn_global_load_lds((const unsigned*)((const char*)(gbase) + (voff)[_i]), (PG8_LAS unsigned*)(lds + (bufoff) + ldsw + _i * 8192), 16, 0, 0); } while (0)
#define PG8_LDA(dst, b, h) do { _Pragma("unroll") for (int m = 0; m < 4; ++m) _Pragma("unroll") for (int k = 0; k < 2; ++k) dst[m][k] = *(const PG8_LAS bf16x8*)(lds + PG8_SA(b, h) + aoff + m * 2048 + k * 1024); } while (0)
#define PG8_LDB(dst, b, h) do { _Pragma("unroll") for (int n = 0; n < 2; ++n) _Pragma("unroll") for (int k = 0; k < 2; ++k) dst[n][k] = *(const PG8_LAS bf16x8*)(lds + PG8_SB(b, h) + boff + n * 2048 + k * 1024); } while (0)
#define PG8_MMA(ai, bj, At, Bt) do { __builtin_amdgcn_s_setprio(1); _Pragma("unroll") for (int m = 0; m < 4; ++m) _Pragma("unroll") for (int n = 0; n < 2; ++n) _Pragma("unroll") for (int k = 0; k < 2; ++k) \
        acc[ai][bj][m][n] = __builtin_amdgcn_mfma_f32_16x16x32_bf16(Bt[n][k], At[m][k], acc[ai][bj][m][n], 0, 0, 0); __builtin_amdgcn_s_setprio(0); } while (0)
#define PG8_WAIT_V(n) asm volatile("s_waitcnt vmcnt(" #n ")" ::: "memory")
#define PG8_WAIT_L(n) asm volatile("s_waitcnt lgkmcnt(" #n ")" ::: "memory")
#define PG8_BAR __builtin_amdgcn_s_barrier()
#define PG8_SCHED __builtin_amdgcn_sched_barrier(0)
    Unit cur, nxt; int ui = 0;
    if (!S.next(0, cur)) return;
    f32x4 acc[2][2][4][2];
#pragma unroll
    for (int a = 0; a < 2; ++a)
#pragma unroll
        for (int b = 0; b < 2; ++b)
#pragma unroll
            for (int m = 0; m < 4; ++m)
#pragma unroll
                for (int n = 0; n < 2; ++n) acc[a][b][m][n] = (f32x4){0.f, 0.f, 0.f, 0.f};
    bf16x8 At[4][2], B0[2][2], B1[2][2];
    const char* cA = cur.a; const char* cB = cur.b;
    if constexpr (SP2) {
        PG8_STAGE(PG8_SB(0, 0), cB, voffB); PG8_STAGE(PG8_SB(0, 1), cB + hstepB, voffB); PG8_STAGE(PG8_SA(0, 0), cA, voffA); PG8_STAGE(PG8_SA(0, 1), cA + hstepA, voffA);
        if (wr == 1) PG8_BAR;
        PG8_WAIT_V(2); PG8_BAR;
        PG8_STAGE(PG8_SB(1, 0), cB + kstep, voffB); PG8_STAGE(PG8_SA(1, 0), cA + kstep, voffA); PG8_STAGE(PG8_SB(1, 1), cB + hstepB + kstep, voffB);
        PG8_WAIT_V(6); PG8_BAR;
    } else {
        PG8_STAGE(PG8_SB(0, 0), cB, voffB); PG8_STAGE(PG8_SA(0, 0), cA, voffA); PG8_STAGE(PG8_SB(0, 1), cB + hstepB, voffB); PG8_STAGE(PG8_SA(0, 1), cA + hstepA, voffA);
        if (wr == 1) PG8_BAR;
        PG8_WAIT_V(4); PG8_BAR;
        PG8_STAGE(PG8_SB(1, 0), cB + kstep, voffB); PG8_STAGE(PG8_SA(1, 0), cA + kstep, voffA); PG8_STAGE(PG8_SB(1, 1), cB + hstepB + kstep, voffB);
        PG8_WAIT_V(6); PG8_BAR;
    }
    for (;;) {
        const bool has_next = S.next(ui + 1, nxt);
        const char* nA = has_next ? nxt.a : cA; const char* nB = has_next ? nxt.b : cB;
        for (int t = 0; t < nt; t += 2) {
            const bool last = (t == nt - 2);
            const char* a1 = cA + (size_t)(t + 1) * kstep;
            const char* a2 = last ? nA : cA + (size_t)(t + 2) * kstep; const char* b2 = last ? nB : cB + (size_t)(t + 2) * kstep;
            const char* a3 = a2 + kstep; const char* b3 = b2 + kstep;
            if constexpr (SP2) {
            PG8_LDB(B0, 0, 0); PG8_LDB(B1, 0, 1); PG8_SCHED; PG8_LDA(At, 0, 0); PG8_STAGE(PG8_SA(1, 1), a1 + hstepA, voffA);
            PG8_WAIT_V(8); PG8_WAIT_L(0); PG8_BAR; PG8_MMA(0, 0, At, B0); PG8_MMA(0, 1, At, B1); PG8_BAR; PG8_SCHED;
            PG8_LDA(At, 0, 1); PG8_STAGE(PG8_SB(0, 0), b2, voffB); PG8_STAGE(PG8_SB(0, 1), b2 + hstepB, voffB); PG8_STAGE(PG8_SA(0, 0), a2, voffA);
            PG8_WAIT_V(8); PG8_WAIT_L(0); PG8_BAR; PG8_MMA(1, 0, At, B0); PG8_MMA(1, 1, At, B1); PG8_BAR; PG8_SCHED;
            PG8_LDB(B0, 1, 0); PG8_LDB(B1, 1, 1); PG8_SCHED; PG8_LDA(At, 1, 0); PG8_STAGE(PG8_SA(0, 1), a2 + hstepA, voffA);
            PG8_WAIT_V(8); PG8_WAIT_L(0); PG8_BAR; PG8_MMA(0, 0, At, B0); PG8_MMA(0, 1, At, B1); PG8_BAR; PG8_SCHED;
            PG8_LDA(At, 1, 1); PG8_STAGE(PG8_SB(1, 0), b3, voffB); PG8_STAGE(PG8_SB(1, 1), b3 + hstepB, voffB); PG8_STAGE(PG8_SA(1, 0), a3, voffA);
            PG8_WAIT_V(8); PG8_WAIT_L(0); PG8_BAR; PG8_MMA(1, 0, At, B0); PG8_MMA(1, 1, At, B1); PG8_BAR; PG8_SCHED;
            } else {
            PG8_LDB(B0, 0, 0); PG8_SCHED; PG8_LDA(At, 0, 0); PG8_STAGE(PG8_SA(1, 1), a1 + hstepA, voffA);
            PG8_WAIT_L(8); PG8_BAR; PG8_WAIT_L(0); PG8_MMA(0, 0, At, B0); PG8_BAR; PG8_SCHED;
            PG8_LDB(B1, 0, 1); PG8_STAGE(PG8_SB(0, 0), b2, voffB);
            PG8_BAR; PG8_WAIT_L(0); PG8_MMA(0, 1, At, B1); PG8_BAR;
            PG8_LDA(At, 0, 1); PG8_STAGE(PG8_SA(0, 0), a2, voffA);
            PG8_BAR; PG8_WAIT_L(0); PG8_MMA(1, 0, At, B0); PG8_BAR; PG8_SCHED;
            PG8_STAGE(PG8_SB(0, 1), b2 + hstepB, voffB);
            PG8_WAIT_V(6); PG8_BAR; PG8_MMA(1, 1, At, B1); PG8_BAR;
            PG8_LDB(B0, 1, 0); PG8_SCHED; PG8_LDA(At, 1, 0); PG8_STAGE(PG8_SA(0, 1), a2 + hstepA, voffA);
            PG8_WAIT_L(8); PG8_BAR; PG8_WAIT_L(0); PG8_MMA(0, 0, At, B0); PG8_BAR; PG8_SCHED;
            PG8_LDB(B1, 1, 1); PG8_STAGE(PG8_SB(1, 0), b3, voffB);
            PG8_BAR; PG8_WAIT_L(0); PG8_MMA(0, 1, At, B1); PG8_BAR;
            PG8_LDA(At, 1, 1); PG8_STAGE(PG8_SA(1, 0), a3, voffA);
            PG8_BAR; PG8_WAIT_L(0); PG8_MMA(1, 0, At, B0); PG8_BAR; PG8_SCHED;
            PG8_STAGE(PG8_SB(1, 1), b3 + hstepB, voffB);
            PG8_WAIT_V(6); PG8_BAR; PG8_MMA(1, 1, At, B1); PG8_BAR;
            }
        }
        if constexpr (ALIGN_EPI) { if (wr == 0) PG8_BAR; }
        if constexpr (Epi::CHAIN) E.chain(acc, cur, wr, wc, fr, fq);
        else E(acc, cur, wr, wc, fr, fq);
        if (!has_next) break;
        if constexpr (!Epi::CHAIN)
#pragma unroll
        for (int a = 0; a < 2; ++a)
#pragma unroll
            for (int b = 0; b < 2; ++b)
#pragma unroll
                for (int m = 0; m < 4; ++m)
#pragma unroll
                    for (int n = 0; n < 2; ++n) acc[a][b][m][n] = (f32x4){0.f, 0.f, 0.f, 0.f};
        cur = nxt; cA = nA; cB = nB; ++ui;
        if constexpr (ALIGN_EPI) { if (wr == 1) PG8_BAR; }
    }
    PG8_WAIT_V(0);
    if constexpr (!ALIGN_EPI) { if (wr == 0) PG8_BAR; }
    PG8_BAR;
    #undef PG8_SA
#undef PG8_SB
#undef PG8_STAGE
#undef PG8_LDA
#undef PG8_LDB
#undef PG8_MMA
#undef PG8_WAIT_V
#undef PG8_WAIT_L
#undef PG8_BAR
#undef PG8_SCHED
}
}

#ifndef PG8_SP2
#define PG8_SP2 true
#endif
#ifndef PG8_ALIGN
#define PG8_ALIGN true
#endif

constexpr int T = 16384, D = 2048, DEPTH = 2;
constexpr int RWW = 1024;
constexpr int NCMP = 1023, NSELB = 256;
constexpr int NEXP = 32, FF = 512;
constexpr int LDP = 10496;
constexpr int NG = 6144;
constexpr int PC_RW_R = 0, PC_RW_K = 1024, PC_RW_V = 2048, PC_NQ = 3072, PC_KC = 4096, PC_VC = 4352, PC_KS = 4608, PC_VS = 4864, PC_KW = 5120, PC_VW = 5376,
              PC_RQ = 5632, PC_RK = 6656, PC_RV = 7680, PC_RG = 8704, PC_XW = 9728, PC_XA = 9824, PC_XG = 9920, PC_XV = 10176, PC_GATE = 10240;
constexpr float DN_ALPHA = 1.41421356237f, LN_EPS = 1e-5f;

constexpr size_t MiB = 1u << 20;
constexpr size_t WS_CTL = 0, CTL_ZERO_BYTES = 1 * MiB;
constexpr size_t WS_TEXP = 1 * MiB, WS_TOKE = WS_TEXP + 65536, WS_TOKW = WS_TOKE + 131072, WS_SLOT = WS_TOKW + 131072;
constexpr size_t WS_KCMPB = 2 * MiB, WS_VCMPT = 3 * MiB, WS_KF8 = 4 * MiB  , WS_COS = 8 * MiB, WS_SIN = 12 * MiB;
constexpr size_t WS_WIN = 16 * MiB, WS_WG = 57 * MiB, WS_WBR = 81 * MiB, WS_WOUT = 93 * MiB;
constexpr size_t WS_W1T = 103 * MiB, WS_WLORA = 101 * MiB, WS_ALORA = 896 * MiB;
constexpr size_t WS_XB = 112 * MiB, WS_VF = 176 * MiB, WS_PROJ = 208 * MiB;
constexpr size_t WS_RW_R = 536 * MiB, WS_RW_K = 568 * MiB, WS_RW_V = 600 * MiB, WS_RW_KK = 632 * MiB, WS_RW_B = 664 * MiB, WS_RW_W = 696 * MiB, WS_RW_G = 760 * MiB;
constexpr size_t WS_YRW = 800 * MiB, WS_YNSA = 832 * MiB, WS_YRET = 864 * MiB;
constexpr size_t WS_RWP = 896 * MiB, WS_RWU = 912 * MiB, WS_RWS = 928 * MiB, WS_RETKV = 944 * MiB, WS_KFS = 1008 * MiB, WS_VFS = 1016 * MiB, WS_KFW = 1024 * MiB, WS_VFW = 1032 * MiB, WS_VFR = 1040 * MiB, WS_KTR = 1072 * MiB, WS_RT = 1104 * MiB, WS_VF8 = 1136 * MiB  , WS_GPART = 1140 * MiB  , WS_END = 1152 * MiB;
constexpr size_t WS_GATES = 536 * MiB, WS_MERGED = 728 * MiB;
constexpr size_t WS_WGU = 208 * MiB, WS_WDN = 336 * MiB, WS_XS = 400 * MiB, WS_H = 560 * MiB, WS_YS = 600 * MiB;
static_assert(WS_PROJ + (size_t)T * LDP * 2 <= WS_RW_R && WS_GATES + (size_t)T * NG * 2 <= WS_MERGED && WS_MERGED + (size_t)T * D * 2 <= WS_YRW, "ws map");
static_assert(WS_XS + (size_t)160 * 256 * D * 2 <= WS_H && WS_H + (size_t)160 * 256 * FF * 2 <= WS_YS && WS_YS + (size_t)160 * 256 * D * 2 <= WS_RW_G, "ws map moe");
constexpr int CW_TMO = 0, CW_CNT = 1024, CW_CUR = 1088, CW_BAR = 4096, CW_NSAQ = 16384, CW_KMAX = 20480;
constexpr int LDS_BYTES = 147456, LDS_BARW = LDS_BYTES - 64;

#define GAS __attribute__((address_space(1)))
#define LAS __attribute__((address_space(3)))
typedef unsigned short bf16;
typedef float f32x4 __attribute__((ext_vector_type(4)));
typedef unsigned u32x4 __attribute__((ext_vector_type(4)));
typedef short bf16x8 __attribute__((ext_vector_type(8)));
typedef short bf16x4 __attribute__((ext_vector_type(4)));
#define LDS_WAIT() asm volatile("s_waitcnt lgkmcnt(0)" ::: "memory")
#define VM_WAIT() asm volatile("s_waitcnt vmcnt(0)" ::: "memory")

__device__ __forceinline__ float bf2f(unsigned short b) { return __uint_as_float(((unsigned)b) << 16); }
__device__ __forceinline__ unsigned f2bf(float f) { unsigned u = __float_as_uint(f); return (u + 0x7fffu + ((u >> 16) & 1u)) >> 16; }
__device__ __forceinline__ unsigned pk2(float lo, float hi) { return f2bf(lo) | (f2bf(hi) << 16); }
__device__ __forceinline__ float bflo(unsigned w) { return __uint_as_float(w << 16); }
__device__ __forceinline__ float bfhi(unsigned w) { return __uint_as_float(w & 0xffff0000u); }
#define DPP_I(v, ctrl) __builtin_amdgcn_update_dpp(0, (v), (ctrl), 0xf, 0xf, true)
#define DPP_F(v, ctrl) __int_as_float(__builtin_amdgcn_update_dpp(0, __float_as_int(v), (ctrl), 0xf, 0xf, true))
constexpr int DPP_X1 = 0xB1, DPP_X2 = 0x4E, DPP_HMIR = 0x141, DPP_ROR4 = 0x124, DPP_ROR8 = 0x128;
__device__ __forceinline__ float sum_x16_32(float v) { auto a = __builtin_amdgcn_permlane16_swap(__float_as_uint(v), __float_as_uint(v), false, false); v = __uint_as_float(a[0]) + __uint_as_float(a[1]);
    auto b = __builtin_amdgcn_permlane32_swap(__float_as_uint(v), __float_as_uint(v), false, false); return __uint_as_float(b[0]) + __uint_as_float(b[1]); }
__device__ __forceinline__ float max_x16_32(float v) { auto a = __builtin_amdgcn_permlane16_swap(__float_as_uint(v), __float_as_uint(v), false, false); v = fmaxf(__uint_as_float(a[0]), __uint_as_float(a[1]));
    auto b = __builtin_amdgcn_permlane32_swap(__float_as_uint(v), __float_as_uint(v), false, false); return fmaxf(__uint_as_float(b[0]), __uint_as_float(b[1])); }
__device__ __forceinline__ int min_x16_32(int v) { auto a = __builtin_amdgcn_permlane16_swap((unsigned)v, (unsigned)v, false, false); v = (int)a[0] < (int)a[1] ? (int)a[0] : (int)a[1];
    auto b = __builtin_amdgcn_permlane32_swap((unsigned)v, (unsigned)v, false, false); return (int)b[0] < (int)b[1] ? (int)b[0] : (int)b[1]; }
__device__ __forceinline__ float sum_x1_2(float v) { v += DPP_F(v, DPP_X1); v += DPP_F(v, DPP_X2); return v; }
__device__ __forceinline__ float sum_x1_2_4(float v) { v = sum_x1_2(v); v += DPP_F(v, DPP_HMIR); return v; }
__device__ __forceinline__ float wave_sum(float v) { v = sum_x1_2(v); v += DPP_F(v, DPP_ROR4); v += DPP_F(v, DPP_ROR8); return sum_x16_32(v); }
__device__ __forceinline__ float wave_max(float v) { v = fmaxf(v, DPP_F(v, DPP_X1)); v = fmaxf(v, DPP_F(v, DPP_X2)); v = fmaxf(v, DPP_F(v, DPP_ROR4)); v = fmaxf(v, DPP_F(v, DPP_ROR8)); return max_x16_32(v); }
__device__ __forceinline__ int wave_min_i(int v) { int w;
    w = DPP_I(v, DPP_X1); v = w < v ? w : v; w = DPP_I(v, DPP_X2); v = w < v ? w : v; w = DPP_I(v, DPP_ROR4); v = w < v ? w : v; w = DPP_I(v, DPP_ROR8); v = w < v ? w : v; return min_x16_32(v); }
__device__ __forceinline__ float sigm(float x) { return 1.f / (1.f + expf(-x)); }
__device__ __forceinline__ float sigm_fast(float x) { return __builtin_amdgcn_rcpf(1.f + __builtin_amdgcn_exp2f(-1.4426950408889634f * x)); }

__device__ const double INV_FREQ[64] = {1.00000000000000000e+00, 8.63988449483968579e-01, 7.46476040841712152e-01, 6.44946677103762411e-01, 5.57226479550717357e-01, 4.81437242078434580e-01, 4.15956216307184767e-01, 3.59381366380462752e-01, 3.10501349512486036e-01, 2.68269579527972590e-01, 2.31781818060089240e-01, 2.00256813604311801e-01, 1.73019573884589412e-01, 1.49486913370923374e-01, 1.29154966501488389e-01, 1.11588399250774864e-01, 9.64110880490750138e-02, 8.32980664765826800e-02, 7.19685673001152076e-02, 6.21800108732091794e-02, 5.37228111832403141e-02, 4.64158883361278016e-02, 4.01027913949520837e-02, 3.46483485573036779e-02, 2.99357729472049007e-02, 2.58641620527596990e-02, 2.23463372691659473e-02, 1.93069772888325060e-02, 1.66810053720005923e-02, 1.44121959671885402e-02, 1.24519708473503302e-02, 1.07583589854217902e-02, 9.29509789880649494e-03, 8.03085722139152032e-03, 6.93856787873718770e-03, 5.99484250318940964e-03, 5.17947467923121282e-03, 4.47500629725045354e-03, 3.86635375219241198e-03, 3.34048498351324471e-03, 2.88614044143008968e-03, 2.49359200498416086e-03, 2.15443469003188427e-03, 1.86140668735512152e-03, 1.60823387766704205e-03, 1.38949549437313892e-03, 1.20050805774840792e-03, 1.03722509540705695e-03, 8.96150501946605012e-04, 7.74263682681127744e-04, 6.68954878691414585e-04, 5.77969288415331340e-04, 4.99358789347314927e-04, 4.31440226144378508e-04, 3.72759372031494166e-04, 3.22059791872108224e-04, 2.78255940220712632e-04, 2.40409918350997456e-04, 2.07711392596645640e-04, 1.79460244029731636e-04, 1.55051577983262559e-04, 1.33962772451801717e-04, 1.15742288059205792e-04, 1.00000000000000005e-04};
__device__ const float RET_LOGG[8] = {-0.0317486983145803f, -0.015748356968139168f, -0.007843177461025893f, -0.003913899321136329f, -0.0019550348358033506f, -0.0009770396478266127f, -0.0004884004981088745f, -0.0002441704321739145f};

#define XB_TMO      128
#define XB_XCNT(j)  (256  + 64 * (j))
#define XB_XSUB(j)  (1280 + 64 * (j))
#define XB_XGEN(j)  (2304 + 64 * (j))
#define XB_TOP      3328
#define XB_TOPGEN   3392
#define XCD_BAR_WORDS 3456
#define XB_SPIN_CAP (1u << 18)

__device__ __forceinline__ unsigned xb_ld(unsigned* p)              { return __hip_atomic_load(p, __ATOMIC_RELAXED, __HIP_MEMORY_SCOPE_AGENT); }
__device__ __forceinline__ unsigned xb_add(unsigned* p, unsigned v) { return __hip_atomic_fetch_add(p, v, __ATOMIC_RELAXED, __HIP_MEMORY_SCOPE_AGENT); }
__device__ __forceinline__ unsigned xb_xcc_id() { return (unsigned)__builtin_amdgcn_s_getreg((3 << 11) | 20) & 0xFu; }
#define XB_SPIN(cond, bar) do { unsigned _sp = 0; while (cond) { __builtin_amdgcn_s_sleep(1); \
    if ((++_sp & 255u) == 0u) { if (xb_ld(&(bar)[XB_TMO])) break; if (_sp > XB_SPIN_CAP) { atomicAdd(&(bar)[XB_TMO], 1u); break; } } } } while (0)

struct XcdBarrier {
    unsigned* bar; unsigned x;
    volatile LAS unsigned* st;
};
__device__ __forceinline__ XcdBarrier xcd_barrier_post(unsigned* bar, volatile LAS unsigned* st) {
    XcdBarrier b; b.bar = bar; b.x = xb_xcc_id(); b.st = st;
    if (threadIdx.x == 0) (void)xb_add(&bar[XB_XCNT(b.x)], 1u);
    return b;
}
__device__ __forceinline__ void xcd_barrier_complete(unsigned* bar, unsigned x, unsigned& nloc, unsigned& nx) {
    const unsigned G = gridDim.x * gridDim.y * gridDim.z;
    unsigned sum, cnt, mine, sp = 0u;
    for (;;) {
        sum = 0u; cnt = 0u; mine = 0u;
#pragma unroll
        for (unsigned j = 0; j < 16; ++j) { const unsigned c = xb_ld(&bar[XB_XCNT(j)]); sum += c; cnt += (c > 0u) ? 1u : 0u; mine = (j == x) ? c : mine; }
        if (sum == G) break;
        __builtin_amdgcn_s_sleep(1);
        if ((++sp & 255u) == 0u) { if (xb_ld(&bar[XB_TMO])) break; if (sp > XB_SPIN_CAP) { atomicAdd(&bar[XB_TMO], 1u); break; } }
    }
    nloc = mine > 0u ? mine : 1u; nx = cnt > 0u ? cnt : 1u;
}
__device__ __forceinline__ void xcd_barrier(const XcdBarrier& b) {
    asm volatile("s_waitcnt vmcnt(0)" ::: "memory");
    __syncthreads();
    if (threadIdx.x == 0) {
        unsigned* bar = b.bar;
        __builtin_amdgcn_s_waitcnt(0);
        unsigned nloc = b.st[0], nx = b.st[1];
        if (nloc == 0u) { xcd_barrier_complete(bar, b.x, nloc, nx); b.st[0] = nloc; b.st[1] = nx; }
        const unsigned old = xb_add(&bar[XB_XSUB(b.x)], 1u);
        const unsigned gen = old / nloc;
        if (old + 1u == (gen + 1u) * nloc) {
            __builtin_amdgcn_fence(__ATOMIC_RELEASE, "agent");
            asm volatile("s_waitcnt vmcnt(0)" ::: "memory");
            const unsigned og = xb_add(&bar[XB_TOP], 1u);
            const unsigned tg = og / nx;
            if (og + 1u == (tg + 1u) * nx) xb_add(&bar[XB_TOPGEN], 1u);
            else XB_SPIN(xb_ld(&bar[XB_TOPGEN]) == tg, bar);
            __builtin_amdgcn_fence(__ATOMIC_ACQUIRE, "agent");
            xb_add(&bar[XB_XGEN(b.x)], 1u);
            asm volatile("s_waitcnt vmcnt(0)" ::: "memory");
        } else {
            XB_SPIN(xb_ld(&bar[XB_XGEN(b.x)]) == gen, bar);
            __builtin_amdgcn_fence(__ATOMIC_ACQUIRE, "agent");
            asm volatile("s_waitcnt vmcnt(0)" ::: "memory");
        }
    }
    __syncthreads();
}

#if defined(__HIP_DEVICE_COMPILE__)
#define ASSUME_GLOBAL(p) do { __builtin_assume(!__builtin_amdgcn_is_shared((const __attribute__((address_space(0))) void*)(p))); __builtin_assume(!__builtin_amdgcn_is_private((const __attribute__((address_space(0))) void*)(p))); } while (0)
#else
#define ASSUME_GLOBAL(p) do { } while (0)
#endif
struct Args { const float* in[36]; float* out; unsigned char* ws; int ph_lo, ph_hi; };
constexpr int LDS_PTAB = LDS_BYTES - 512;
struct PA { unsigned char* ws; float* out; const LAS unsigned* tab;
    __device__ __forceinline__ const float* in(int i) const { const unsigned lo = __builtin_amdgcn_readfirstlane(tab[2 * i]), hi = __builtin_amdgcn_readfirstlane(tab[2 * i + 1]);
        return (const float*)(const GAS float*)(((unsigned long long)hi << 32) | lo); } };

__device__ __forceinline__ void un8(const u32x4 p, float (&o)[8]) { o[0] = bflo(p.x); o[1] = bfhi(p.x); o[2] = bflo(p.y); o[3] = bfhi(p.y); o[4] = bflo(p.z); o[5] = bfhi(p.z); o[6] = bflo(p.w); o[7] = bfhi(p.w); }
__device__ __forceinline__ u32x4 pk8(const float (&v)[8]) { return (u32x4){pk2(v[0], v[1]), pk2(v[2], v[3]), pk2(v[4], v[5]), pk2(v[6], v[7])}; }
using pg8::Unit; using pg8::Gemm; using pg8::TileOrder;
struct SchedPlain {
    TileOrder to; int G, c, tid; const char* A; const char* B; size_t ta, tb;
    __device__ __forceinline__ bool next(int i, Unit& u) const {
        if (!to.tile((long)i * G + c, u.pm, u.pn)) return false;
        u.a = A + (size_t)u.pm * ta; u.b = B + (size_t)u.pn * tb; u.aux = 0; return true; }
};
struct SchedSplitK {
    int G, c, tid, n; const char* A; const char* B; size_t ta, kb;
    __device__ __forceinline__ bool next(int i, Unit& u) const { const long L = (long)i * G + c; if (L >= n) return false;
        u.pm = (int)(L >> 2); u.pn = 0; u.aux = (int)(L & 3); u.a = A + (size_t)u.pm * ta + (size_t)u.aux * kb; u.b = B + (size_t)u.aux * kb; return true; }
};
struct EpiPart48 {
    static constexpr bool PERM = true, CHAIN = false;
    float* P;
    __device__ __forceinline__ void operator()(const f32x4 (&acc)[2][2][4][2], const Unit& u, int wr, int wc, int fr, int fq) const {
        const int col = wc * 32 + 8 * fq, row0 = u.pm * 256 + wr * 64 + fr;
        if (col < 48) {
#pragma unroll
            for (int ai = 0; ai < 2; ++ai)
#pragma unroll
                for (int m = 0; m < 4; ++m) { float* p = P + ((size_t)u.aux * T + row0 + ai * 128 + m * 16) * 48 + col; *(f32x4*)p = acc[ai][0][m][0]; *(f32x4*)(p + 4) = acc[ai][0][m][1]; } }
    }
};
struct SchedBranch {
    TileOrder to; int G, c, tid; const char* A0; const char* B0; size_t sa, sb, ta, tb;
    __device__ __forceinline__ bool next(int i, Unit& u) const {
        const int br = i % 3;
        if (!to.tile((long)(i / 3) * G + c, u.pm, u.pn)) return false;
        u.a = A0 + (size_t)br * sa + (size_t)u.pm * ta; u.b = B0 + (size_t)br * sb + (size_t)u.pn * tb; u.aux = br; return true; }
};
struct SchedMoe {
    int nM, nN, G, c, tid; const char* A; const char* B; size_t ta, tb, te; const int* texp;
    __device__ __forceinline__ bool next(int i, Unit& u) const {
        const long L = (long)i * G + c; if (L >= (long)nM * nN) return false;
        u.pm = (int)(L % nM); u.pn = (int)(L / nM); const int e = texp[u.pm];
        u.a = A + (size_t)u.pm * ta; u.b = B + (size_t)e * te + (size_t)u.pn * tb; u.aux = e; return true; }
};
template <int ACT  > struct EpiStore {
    static constexpr bool PERM = true, CHAIN = false;
    bf16* O; int ldc;
    __device__ __forceinline__ void operator()(const f32x4 (&acc)[2][2][4][2], const Unit& u, int wr, int wc, int fr, int fq) const {
        const int row0 = u.pm * 256 + wr * 64 + fr, col0 = u.pn * 256 + wc * 32 + 8 * fq;
#pragma unroll
        for (int ai = 0; ai < 2; ++ai)
#pragma unroll
            for (int m = 0; m < 4; ++m) { bf16* rowp = O + (size_t)(row0 + ai * 128 + m * 16) * ldc + col0;
#pragma unroll
                for (int bj = 0; bj < 2; ++bj) { f32x4 v0 = acc[ai][bj][m][0], v1 = acc[ai][bj][m][1];
                    if (ACT == 1) {
#pragma unroll
                        for (int j = 0; j < 4; ++j) { v0[j] = sigm_fast(v0[j]); v1[j] = sigm_fast(v1[j]); } }
                    u32x4 w; w.x = pg8::cvt_pk_bf16(v0[0], v0[1]); w.y = pg8::cvt_pk_bf16(v0[2], v0[3]); w.z = pg8::cvt_pk_bf16(v1[0], v1[1]); w.w = pg8::cvt_pk_bf16(v1[2], v1[3]);
                    *(u32x4*)(rowp + bj * 128) = w; __builtin_amdgcn_sched_barrier(0); } }
    }
};
struct EpiBranch {
    static constexpr bool PERM = true, CHAIN = true;
    bf16* Mg; const bf16* Gt;
    __device__ __forceinline__ void chain(f32x4 (&acc)[2][2][4][2], const Unit& u, int wr, int wc, int fr, int fq) const {
        const int row0 = u.pm * 256 + wr * 64 + fr, col0 = u.pn * 256 + wc * 32 + 8 * fq, br = u.aux;
#pragma unroll
        for (int ai = 0; ai < 2; ++ai)
#pragma unroll
            for (int m = 0; m < 4; ++m) { const size_t r = (size_t)(row0 + ai * 128 + m * 16);
#pragma unroll
                for (int bj = 0; bj < 2; ++bj) { const int col = col0 + bj * 128; float g[8]; un8(*(const u32x4*)(Gt + r * NG + br * 2048 + col), g);
                    if (br < 2) { float gn[8]; un8(*(const u32x4*)(Gt + r * NG + (br + 1) * 2048 + col), gn);
#pragma unroll
                        for (int j = 0; j < 8; ++j) g[j] = fmaxf(g[j], 1e-18f) * __builtin_amdgcn_rcpf(fmaxf(gn[j], 1e-18f)); }
                    else {
#pragma unroll
                        for (int j = 0; j < 8; ++j) g[j] = fmaxf(g[j], 1e-18f); }
                    f32x4& v0 = acc[ai][bj][m][0]; f32x4& v1 = acc[ai][bj][m][1];
                    v0[0] *= g[0]; v0[1] *= g[1]; v0[2] *= g[2]; v0[3] *= g[3]; v1[0] *= g[4]; v1[1] *= g[5]; v1[2] *= g[6]; v1[3] *= g[7];
                    if (br == 2) { u32x4 w; w.x = pg8::cvt_pk_bf16(v0[0], v0[1]); w.y = pg8::cvt_pk_bf16(v0[2], v0[3]); w.z = pg8::cvt_pk_bf16(v1[0], v1[1]); w.w = pg8::cvt_pk_bf16(v1[2], v1[3]);
                        *(u32x4*)(Mg + r * D + col) = w; v0 = (f32x4){0.f, 0.f, 0.f, 0.f}; v1 = v0; }
                    __builtin_amdgcn_sched_barrier(0); } }
    }
    __device__ __forceinline__ void operator()(const f32x4 (&)[2][2][4][2], const Unit&, int, int, int, int) const {}
};
struct EpiResid {
    static constexpr bool PERM = true, CHAIN = false;
    float* X;
    __device__ __forceinline__ void operator()(const f32x4 (&acc)[2][2][4][2], const Unit& u, int wr, int wc, int fr, int fq) const {
        const int row0 = u.pm * 256 + wr * 64 + fr, col0 = u.pn * 256 + wc * 32 + 8 * fq;
#pragma unroll
        for (int ai = 0; ai < 2; ++ai)
#pragma unroll
            for (int m = 0; m < 4; ++m) { float* rowp = X + (size_t)(row0 + ai * 128 + m * 16) * D + col0;
#pragma unroll
                for (int bj = 0; bj < 2; ++bj) { f32x4* p = (f32x4*)(rowp + bj * 128);
                    const f32x4 x0 = p[0], x1 = p[1];
                    p[0] = x0 * DN_ALPHA + acc[ai][bj][m][0]; p[1] = x1 * DN_ALPHA + acc[ai][bj][m][1]; __builtin_amdgcn_sched_barrier(0); } }
    }
};
struct EpiGateUp {
    static constexpr bool PERM = true, CHAIN = false;
    bf16* H;
    __device__ __forceinline__ void operator()(const f32x4 (&acc)[2][2][4][2], const Unit& u, int wr, int wc, int fr, int fq) const {
        const int row0 = u.pm * 256 + wr * 64 + fr, col0 = u.pn * 128 + wc * 32 + 8 * fq;
#pragma unroll
        for (int ai = 0; ai < 2; ++ai)
#pragma unroll
            for (int m = 0; m < 4; ++m) { bf16* rowp = H + (size_t)(row0 + ai * 128 + m * 16) * FF + col0;
                f32x4 h0, h1;
#pragma unroll
                for (int j = 0; j < 4; ++j) { const float g0 = acc[ai][0][m][0][j], g1 = acc[ai][0][m][1][j];
                    h0[j] = g0 * sigm_fast(g0) * acc[ai][1][m][0][j]; h1[j] = g1 * sigm_fast(g1) * acc[ai][1][m][1][j]; }
                u32x4 w; w.x = pg8::cvt_pk_bf16(h0[0], h0[1]); w.y = pg8::cvt_pk_bf16(h0[2], h0[3]); w.z = pg8::cvt_pk_bf16(h1[0], h1[1]); w.w = pg8::cvt_pk_bf16(h1[2], h1[3]);
                *(u32x4*)rowp = w; }
    }
};

struct Ctx { LAS unsigned char* lds; int tid, lane, wave, G, bx, gw, NGW; };

template <class SRC>
__device__ __forceinline__ void transpose_task(const Ctx& c, const SRC& src, int ldsrc, int K, bf16* dst, int ndst) {
    LAS float* scr = (LAS float*)(c.lds + c.wave * 16640);
    const int nblk = ndst / 64, items = (K / 64) * nblk, lane = c.lane;
    for (int it = c.gw; it < items; it += c.NGW) {
        const int kb = it / nblk, nb = it % nblk, k0 = 64 * kb, n0 = 64 * nb;
        const int nn = n0 + 4 * (lane & 15); const float* sp = src(nn); const int kl = src.klim(nn); const bool al = sp && ((((size_t)sp) & 15) == 0) && ((ldsrc & 3) == 0);
        f32x4 v[16];
#pragma unroll
        for (int i = 0; i < 16; ++i) { const int kk = 4 * i + (lane >> 4); v[i] = (f32x4){0.f, 0.f, 0.f, 0.f};
            if (sp && k0 + kk < kl) { const float* p = sp + (size_t)(k0 + kk) * ldsrc; if (al) v[i] = *(const f32x4*)p; else v[i] = (f32x4){p[0], p[1], p[2], p[3]}; } }
#pragma unroll
        for (int i = 0; i < 16; ++i) { LAS float* tp = scr + (4 * i + (lane >> 4)) * 65 + 4 * (lane & 15); tp[0] = v[i][0]; tp[1] = v[i][1]; tp[2] = v[i][2]; tp[3] = v[i][3]; }
        LDS_WAIT();
        const int cc = lane & 7;
#pragma unroll
        for (int j = 0; j < 8; ++j) { const int n = (lane >> 3) + 8 * j; const LAS float* s = scr + (8 * cc) * 65 + n;
            u32x4 o; o.x = pk2(s[0 * 65], s[1 * 65]); o.y = pk2(s[2 * 65], s[3 * 65]); o.z = pk2(s[4 * 65], s[5 * 65]); o.w = pk2(s[6 * 65], s[7 * 65]);
            *(u32x4*)(dst + (size_t)(n0 + n) * K + k0 + 8 * cc) = o; }
        LDS_WAIT();
    }
}
struct SrcWin { const float* W; int layer; __device__ __forceinline__ int klim(int) const { return 1 << 30; }
    __device__ __forceinline__ const float* operator()(int n) const {
        const int rw = layer ? 3584 : 3520; int sc;
        if (n < 3072) sc = n; else if (n < 5632) sc = rw + (n - 3072); else if (n < 9728) sc = rw + 2608 + (n - 5632); else if (n < 10176) sc = 3072 + (n - 9728);
        else if (n < 10240) sc = layer ? 3520 + (n - 10176) : -1; else if (n < 10288) sc = rw + 2560 + (n - 10240); else sc = -1;
        return sc >= 0 ? W + sc : nullptr; } };
struct SrcOff { const float* W; __device__ __forceinline__ int klim(int) const { return 1 << 30; } __device__ __forceinline__ const float* operator()(int n) const { return W + n; } };
struct SrcGU { const float* Wg; const float* Wu; __device__ __forceinline__ int klim(int) const { return 1 << 30; }
    __device__ __forceinline__ const float* operator()(int nn) const { const int e = nn >> 10, r1 = nn & 1023, pn = r1 >> 8, rr = r1 & 255;
        const size_t du = (size_t)((const char*)Wu - (const char*)Wg);
        return (const float*)((const char*)Wg + (rr < 128 ? (size_t)0 : du)) + (size_t)e * D * FF + 128 * pn + (rr & 127); } };
struct SrcDN { const float* Wd; __device__ __forceinline__ int klim(int) const { return 1 << 30; }
    __device__ __forceinline__ const float* operator()(int nn) const { const int e = nn >> 11, n = nn & 2047; return Wd + (size_t)e * FF * D + n; } };

struct SrcLora { const float* w; const float* a_; const float* g; const float* v;
    __device__ __forceinline__ const float* operator()(int n) const { const int blk = n >> 10, cc = n & 1023; const size_t b0 = (size_t)w, d1 = (size_t)a_ - b0, d2 = (size_t)g - b0, d3 = (size_t)v - b0; if (blk == 3 && v == nullptr) return nullptr; const size_t off = blk == 0 ? 0 : (blk == 1 ? d1 : (blk == 2 ? d2 : d3)); return (const float*)(b0 + off) + cc; }
    __device__ __forceinline__ int klim(int n) const { const int blk = n >> 10; return blk < 2 ? 96 : (blk == 2 ? 256 : 64); } };
__device__ __forceinline__ void ph_conv(const Ctx& c, const PA& a, int layer) {
    unsigned char* ws = a.ws;
    const float* Win = layer ? a.in(2) : a.in(1); const int ldw = layer ? 16432 : 16368, rw = layer ? 3584 : 3520;
    transpose_task(c, SrcWin{Win, layer}, ldw, D, (bf16*)(ws + WS_WIN), LDP);
    transpose_task(c, SrcOff{Win + rw + 2608 + 4096}, ldw, D, (bf16*)(ws + WS_WG), NG);
    transpose_task(c, SrcOff{a.in(21) + (size_t)layer * RWW * D}, D, RWW, (bf16*)(ws + WS_WBR), D);
    transpose_task(c, SrcOff{a.in(22) + (size_t)layer * RWW * D}, D, RWW, (bf16*)(ws + WS_WBR) + (size_t)D * RWW, D);
    transpose_task(c, SrcOff{a.in(23) + (size_t)layer * RWW * D}, D, RWW, (bf16*)(ws + WS_WBR) + (size_t)2 * D * RWW, D);
    transpose_task(c, SrcOff{a.in(24) + (size_t)layer * D * D}, D, D, (bf16*)(ws + WS_WOUT), D);
    transpose_task(c, SrcOff{a.in(18) + (size_t)(layer * 2) * 2048 * 128}, 128, 2048, (bf16*)(ws + WS_W1T), 128);
    transpose_task(c, SrcOff{a.in(18) + (size_t)(layer * 2 + 1) * 2048 * 128}, 128, 2048, (bf16*)(ws + WS_W1T) + (size_t)128 * 2048, 128);
    transpose_task(c, SrcLora{a.in(6) + (size_t)layer * 96 * 1024, a.in(8) + (size_t)layer * 96 * 1024, a.in(11) + (size_t)layer * 256 * 1024, layer ? a.in(10) : nullptr}, 1024, 256, (bf16*)(ws + WS_WLORA), 4096);
    if (layer == 0) {
        const f32x4* x4 = (const f32x4*)a.in(0); f32x4* o4 = (f32x4*)a.out; uint2* xb = (uint2*)(ws + WS_XB);
        for (size_t i = (size_t)c.bx * 512 + c.tid; i < (size_t)T * D / 4; i += (size_t)c.G * 512) { const f32x4 v = x4[i]; o4[i] = v; xb[i] = make_uint2(pk2(v[0], v[1]), pk2(v[2], v[3])); }
        float* cs = (float*)(ws + WS_COS); float* sn = (float*)(ws + WS_SIN);
        for (int i = c.bx * 512 + c.tid; i < T * 64; i += c.G * 512) { const int t = i >> 6, j = i & 63;
            const double rev = (double)t * INV_FREQ[j] * 0.15915494309189533577; const float fr = (float)(rev - __builtin_rint(rev));
            cs[i] = __builtin_amdgcn_cosf(fr); sn[i] = __builtin_amdgcn_sinf(fr); }
    }
}
__device__ __forceinline__ void ph_conv_moe(const Ctx& c, const PA& a, int layer) {
    unsigned char* ws = a.ws; const size_t lo = (size_t)layer * NEXP * D * FF;
    transpose_task(c, SrcGU{a.in(31) + lo, a.in(32) + lo}, FF, D, (bf16*)(ws + WS_WGU), NEXP * 1024);
    transpose_task(c, SrcDN{a.in(33) + lo}, D, FF, (bf16*)(ws + WS_WDN), NEXP * D);
}

__device__ __forceinline__ float softplusf_(float x) { return fmaxf(x, 0.f) + log1pf(expf(-fabsf(x))); }
__device__ __forceinline__ void prep_rwkv(const Ctx& c, const PA& a, int layer) {
    unsigned char* ws = a.ws; const bf16* proj = (const bf16*)(ws + WS_PROJ);
    bf16* oR = (bf16*)(ws + WS_RW_R); bf16* oK = (bf16*)(ws + WS_RW_K); bf16* oV = (bf16*)(ws + WS_RW_V); bf16* oKK = (bf16*)(ws + WS_RW_KK); bf16* VF = (bf16*)(ws + WS_VF); bf16* AL = (bf16*)(ws + WS_ALORA);
    const float* mu = a.in(layer ? 4 : 3); const float* k_k = a.in(12) + layer * 1024;
    const int lane = c.lane;
    for (int t = c.gw; t < T; t += c.NGW) {
        const bf16* prow = proj + (size_t)t * LDP; const bf16* pprev = prow - LDP; const size_t o = (size_t)t * 1024 + 16 * lane;
#pragma unroll
        for (int piece = 0; piece < 3; ++piece) { float sh[16];
#pragma unroll
            for (int hf = 0; hf < 2; ++hf) { const int c8 = piece * 1024 + 16 * lane + 8 * hf; float pv[8], qv[8]; un8(*(const u32x4*)(prow + c8), pv);
                if (t > 0) un8(*(const u32x4*)(pprev + c8), qv); else { for (int j = 0; j < 8; ++j) qv[j] = 0.f; }
                const f32x4 m0 = *(const f32x4*)(mu + c8), m1 = *(const f32x4*)(mu + c8 + 4);
#pragma unroll
                for (int j = 0; j < 8; ++j) sh[8 * hf + j] = pv[j] + (qv[j] - pv[j]) * (j < 4 ? m0[j] : m1[j - 4]); }
            float lo8[8], hi8[8];
#pragma unroll
            for (int j = 0; j < 8; ++j) { lo8[j] = sh[j]; hi8[j] = sh[8 + j]; }
            bf16* dst = piece == 0 ? oR : (piece == 1 ? oK : oV);
            *(u32x4*)(dst + o) = pk8(lo8); *(u32x4*)(dst + o + 8) = pk8(hi8);
            if (piece == 2 && layer == 0) { *(u32x4*)(VF + o) = pk8(lo8); *(u32x4*)(VF + o + 8) = pk8(hi8); }
            if (piece == 1) { float n2 = 0.f;
#pragma unroll
                for (int j = 0; j < 16; ++j) { sh[j] *= k_k[16 * lane + j]; n2 += sh[j] * sh[j]; }
                n2 = sum_x1_2(n2); const float inv = 1.f / fmaxf(sqrtf(n2), 1e-12f);
#pragma unroll
                for (int j = 0; j < 8; ++j) { lo8[j] = sh[j] * inv; hi8[j] = sh[8 + j] * inv; }
                *(u32x4*)(oKK + o) = pk8(lo8); *(u32x4*)(oKK + o + 8) = pk8(hi8); } }
        { const int i8 = lane * 8; int sc, mi, fn, dc;
            if (i8 < 96) { sc = PC_XW + i8; mi = 3072 + i8; fn = 1; dc = i8; } else if (i8 < 192) { sc = PC_XA + (i8 - 96); mi = 3168 + (i8 - 96); fn = 0; dc = 256 + (i8 - 96); }
            else if (i8 < 448) { sc = PC_XG + (i8 - 192); mi = 3264 + (i8 - 192); fn = 2; dc = 512 + (i8 - 192); } else { sc = PC_XV + (i8 - 448); mi = 3520 + (i8 - 448); fn = layer ? 0 : 3; dc = 768 + (i8 - 448); }
            float pv[8], qv[8], ov[8]; un8(*(const u32x4*)(prow + sc), pv); if (t > 0) un8(*(const u32x4*)(pprev + sc), qv); else { for (int j = 0; j < 8; ++j) qv[j] = 0.f; }
#pragma unroll
            for (int j = 0; j < 8; ++j) { float s = 0.f;
                if (fn != 3) { const float mm = mu[mi + j]; s = pv[j] + (qv[j] - pv[j]) * mm; if (fn == 1) s = tanhf(s); else if (fn == 2) s = sigm(s); }
                ov[j] = s; }
            *(u32x4*)(AL + (size_t)t * 1024 + dc) = pk8(ov);
            const int zc = lane < 20 ? 96 + 8 * lane : (lane < 40 ? 352 + 8 * (lane - 20) : 832 + 8 * (lane - 40));
            { unsigned z0 = 0u; asm volatile("" : "+v"(z0)); *(u32x4*)(AL + (size_t)t * 1024 + zc) = (u32x4){z0, z0, z0, z0}; } }
    }
}
__device__ __forceinline__ float ex2(float x) { return __builtin_amdgcn_exp2f(x); }
__device__ __forceinline__ void un4(const uint2 p, float (&o)[4]) { o[0] = bflo(p.x); o[1] = bfhi(p.x); o[2] = bflo(p.y); o[3] = bfhi(p.y); }
struct EpiLora {
    static constexpr bool PERM = true, CHAIN = false;
    unsigned char* ws; PA pa; int layer;
#define EPL_ROWS(...) _Pragma("unroll") for (int bj = 0; bj < 2; ++bj) _Pragma("unroll") for (int hf = 0; hf < 2; ++hf) { const int col = col0 + bj * 128 + 4 * hf; PRE _Pragma("unroll") for (int ai = 0; ai < 2; ++ai) _Pragma("unroll") for (int m = 0; m < 4; ++m) { \
        const size_t o = (size_t)(row0 + ai * 128 + m * 16) * 1024 + col; const f32x4 x = acc[ai][bj][m][hf]; __VA_ARGS__ __builtin_amdgcn_sched_barrier(0); } }
    __device__ __forceinline__ void operator()(const f32x4 (&acc)[2][2][4][2], const Unit& u, int wr, int wc, int fr, int fq) const {
        const int blk = u.pn >> 2, row0 = u.pm * 256 + wr * 64 + fr, col0 = (u.pn & 3) * 256 + wc * 32 + 8 * fq;
        if (blk == 0) {
#define PRE const f32x4 p = *(const f32x4*)(pa.in(5) + layer * 1024 + col);
            EPL_ROWS({ f32x4 d;
                _Pragma("unroll") for (int j = 0; j < 4; ++j) { const float z = -(x[j] + p[j]), sp = fmaxf(z, 0.f) + 0.6931471805599453f * __builtin_amdgcn_logf(1.f + ex2(-1.4426950408889634f * fabsf(z)));
                    d[j] = ex2(-1.4426950408889634f * ex2(1.4426950408889634f * (-sp - 0.5f))); }
                *(f32x4*)((float*)(ws + WS_RW_W) + o) = d; })
#undef PRE
        } else if (blk == 1) {
#define PRE const f32x4 p = *(const f32x4*)(pa.in(7) + layer * 1024 + col), qa = *(const f32x4*)(pa.in(13) + layer * 1024 + col);
            EPL_ROWS({ float kk[4], k0[4]; un4(*(const uint2*)((const bf16*)(ws + WS_RW_KK) + o), kk); un4(*(const uint2*)((const bf16*)(ws + WS_RW_K) + o), k0); float bb[4], kf[4];
                _Pragma("unroll") for (int j = 0; j < 4; ++j) { const float aa = sigm_fast(x[j] + p[j]); bb[j] = kk[j] * aa; kf[j] = k0[j] * (1.f + (aa - 1.f) * qa[j]); }
                *(uint2*)((bf16*)(ws + WS_RW_B) + o) = make_uint2(pk2(bb[0], bb[1]), pk2(bb[2], bb[3])); *(uint2*)((bf16*)(ws + WS_RW_K) + o) = make_uint2(pk2(kf[0], kf[1]), pk2(kf[2], kf[3])); })
#undef PRE
        } else if (blk == 2) {
#define PRE
            EPL_ROWS({ *(uint2*)((bf16*)(ws + WS_RW_G) + o) = make_uint2(pg8::cvt_pk_bf16(x[0], x[1]), pg8::cvt_pk_bf16(x[2], x[3])); })
#undef PRE
        } else {
#define PRE const f32x4 p = *(const f32x4*)(pa.in(9) + col);
            EPL_ROWS({ float v0[4], vf[4], vv[4]; un4(*(const uint2*)((const bf16*)(ws + WS_RW_V) + o), v0); un4(*(const uint2*)((const bf16*)(ws + WS_VF) + o), vf);
                _Pragma("unroll") for (int j = 0; j < 4; ++j) vv[j] = v0[j] + (vf[j] - v0[j]) * sigm_fast(x[j] + p[j]);
                *(uint2*)((bf16*)(ws + WS_RW_V) + o) = make_uint2(pk2(vv[0], vv[1]), pk2(vv[2], vv[3])); })
#undef PRE
        }
    }
#undef EPL_ROWS
};
struct SchedLora { TileOrder to; int G, c, tid; const char* A; const char* B;
    __device__ __forceinline__ bool next(int i, Unit& u) const {
        if (!to.tile((long)i * G + c, u.pm, u.pn)) return false;
        u.a = A + (size_t)u.pm * 256 * 1024 * 2 + (size_t)(u.pn >> 2) * 256 * 2; u.b = B + (size_t)u.pn * 256 * 256 * 2; u.aux = 0; return true; }
};
__device__ __forceinline__ float gelu_tanh(float x) { return 0.5f * x * (1.f + tanhf(0.7978845608028654f * (x + 0.044715f * x * x * x))); }
__device__ __forceinline__ void prep_cmp(const Ctx& c, const PA& a, int layer) {
    unsigned char* ws = a.ws; const bf16* proj = (const bf16*)(ws + WS_PROJ);
    constexpr int RS = 2056;
    LAS bf16* sh_in = (LAS bf16*)c.lds; LAS float* sh_h = (LAS float*)(c.lds + 16 * RS * 2);
    const int tid = c.tid, lane = c.lane, r = lane & 15, q = lane >> 4, w = c.wave;
    for (int it = c.bx; it < 256 * 2; it += c.G) {
        const int cg = it >> 1, kv = it & 1, col0 = kv ? PC_VC : PC_KC, lk = layer * 2 + kv;
        const float* pe = a.in(17) + (size_t)lk * 2048;
        for (int idx = tid; idx < 16 * 2048 / 8; idx += 512) { const int row = idx >> 8, r8 = (idx & 255) * 8, cb = 4 * cg + (row >> 2), g = row & 3, l = r8 >> 6, d = r8 & 63;
            int tok = 16 * cb + l; tok = tok > T - 1 ? T - 1 : tok;
            float v[8]; un8(*(const u32x4*)(proj + (size_t)tok * LDP + col0 + g * 64 + d), v); const f32x4 p0 = *(const f32x4*)(pe + r8), p1 = *(const f32x4*)(pe + r8 + 4);
#pragma unroll
            for (int j = 0; j < 8; ++j) v[j] += j < 4 ? p0[j] : p1[j - 4];
            *(LAS u32x4*)(sh_in + row * RS + r8) = pk8(v); }
        __syncthreads();
        { const bf16* wt = (const bf16*)(ws + WS_W1T) + ((size_t)(kv * 128 + 16 * w + r)) * 2048 + 8 * q; const LAS bf16* ap = sh_in + r * RS + 8 * q;
            f32x4 acc = (f32x4){0.f, 0.f, 0.f, 0.f};
#pragma unroll 8
            for (int ks = 0; ks < 64; ++ks) acc = __builtin_amdgcn_mfma_f32_16x16x32_bf16(*(const LAS bf16x8*)(ap + 32 * ks), *(const bf16x8*)(wt + 32 * ks), acc, 0, 0, 0);
            const float bj = a.in(19)[lk * 128 + 16 * w + r];
#pragma unroll
            for (int i = 0; i < 4; ++i) sh_h[(4 * q + i) * 128 + 16 * w + r] = gelu_tanh(acc[i] + bj); }
        __syncthreads();
        const float* w2 = a.in(20) + (size_t)lk * 128 * 64;
        for (int oidx = tid; oidx < 16 * 64; oidx += 512) { const int row = oidx >> 6, d = oidx & 63, cb = 4 * cg + (row >> 2), g = row & 3; float o = 0.f;
#pragma unroll 16
            for (int j = 0; j < 128; ++j) o += sh_h[row * 128 + j] * w2[j * 64 + d];
            if (kv == 0) { const float ob = bf2f((bf16)f2bf(o)), n2 = wave_sum(ob * ob); if (c.lane == 0 && cb < NCMP) atomicMax((unsigned*)(ws + WS_CTL) + CW_KMAX + layer * 64 + 8 + g, __float_as_uint(sqrtf(n2))); }
            if (cb < NCMP) {
            const int blk = cb >> 6, kc = cb & 63;
            if (kv == 0) { const int j2 = kc >> 4, rr = kc & 15, ks = d >> 5, qq = (d & 31) >> 3, i = d & 7;
                ((bf16*)(ws + WS_KCMPB))[((((size_t)g * 16 + blk) * 8 + 2 * j2 + ks) * 64 + qq * 16 + rr) * 8 + i] = (bf16)f2bf(o);
                if (cb == 0) ((bf16*)(ws + WS_KCMPB))[((((size_t)g * 16 + 15) * 8 + 2 * 3 + ks) * 64 + qq * 16 + 15) * 8 + i] = 0; }
            else { const int ks = kc >> 5, kk = kc & 31, hh = kk >> 4, qq = (kk & 15) >> 2, i = (kk & 3) + 4 * hh, mt = d >> 4, rr = d & 15;
                ((bf16*)(ws + WS_VCMPT))[((((size_t)g * 16 + blk) * 8 + 2 * mt + ks) * 64 + qq * 16 + rr) * 8 + i] = (bf16)f2bf(o);
                if (cb == 0) ((bf16*)(ws + WS_VCMPT))[((((size_t)g * 16 + 15) * 8 + 2 * mt + 1) * 64 + 3 * 16 + rr) * 8 + 7] = 0; } } }
        __syncthreads();
    }
}
__device__ __forceinline__ void prep_rope(const Ctx& c, const PA& a) {
    unsigned char* ws = a.ws; bf16* proj = (bf16*)(ws + WS_PROJ); const float* cs = (const float*)(ws + WS_COS); const float* sn = (const float*)(ws + WS_SIN);
    for (int i = c.bx * 512 + c.tid; i < T * 8 * 8; i += c.G * 512) { const int j8 = (i & 7) * 8, h = (i >> 3) & 7, t = i >> 6;
        bf16* qp = proj + (size_t)t * LDP + PC_RQ + h * 128 + j8; float q1[8], q2[8], o1[8], o2[8]; un8(*(const u32x4*)qp, q1); un8(*(const u32x4*)(qp + 64), q2);
        const f32x4 c0 = *(const f32x4*)(cs + (size_t)t * 64 + j8), c1 = *(const f32x4*)(cs + (size_t)t * 64 + j8 + 4), s0 = *(const f32x4*)(sn + (size_t)t * 64 + j8), s1 = *(const f32x4*)(sn + (size_t)t * 64 + j8 + 4);
#pragma unroll
        for (int j = 0; j < 8; ++j) { const float co = j < 4 ? c0[j] : c1[j - 4], si = j < 4 ? s0[j] : s1[j - 4]; o1[j] = q1[j] * co - q2[j] * si; o2[j] = q1[j] * si + q2[j] * co; }
        *(u32x4*)qp = pk8(o1); *(u32x4*)(qp + 64) = pk8(o2); }
}

constexpr int RW_NC = 64, RW_CL = 256, RW_TS = 8;
typedef float f32x2 __attribute__((ext_vector_type(2)));
__device__ __forceinline__ void rw_put8(LAS float* d, u32x4 v) { *(LAS f32x4*)d = (f32x4){bflo(v.x), bfhi(v.x), bflo(v.y), bfhi(v.y)}; *(LAS f32x4*)(d + 4) = (f32x4){bflo(v.z), bfhi(v.z), bflo(v.w), bfhi(v.w)}; }
struct RwRegs { u32x4 kk, b, k, v, r, g; f32x4 w0, w1; };
__device__ __forceinline__ void rw_stage_load(const unsigned char* ws, RwRegs& R, int t0, int h, int lane, bool need_r) {
    const unsigned e = (unsigned)((t0 + (lane >> 3)) * 1024 + h * 64 + 8 * (lane & 7));
    R.kk = *(const u32x4*)(ws + ((unsigned)WS_RW_KK + e * 2u)); R.b = *(const u32x4*)(ws + ((unsigned)WS_RW_B + e * 2u)); R.k = *(const u32x4*)(ws + ((unsigned)WS_RW_K + e * 2u)); R.v = *(const u32x4*)(ws + ((unsigned)WS_RW_V + e * 2u));
    R.w0 = *(const f32x4*)(ws + ((unsigned)WS_RW_W + e * 4u)); R.w1 = *(const f32x4*)(ws + ((unsigned)WS_RW_W + e * 4u + 16u));
    R.r = (u32x4){0u, 0u, 0u, 0u}; R.g = R.r; if (need_r) { R.r = *(const u32x4*)(ws + ((unsigned)WS_RW_R + e * 2u)); R.g = *(const u32x4*)(ws + ((unsigned)WS_RW_G + e * 2u)); }
}
__device__ __forceinline__ void rw_stage_store(LAS float* tile, const RwRegs& R, int lane) {
    LAS float* tp = tile + (lane >> 3) * 384 + 8 * (lane & 7);
    rw_put8(tp, R.kk); rw_put8(tp + 64, R.b); *(LAS f32x4*)(tp + 128) = R.w0; *(LAS f32x4*)(tp + 132) = R.w1; rw_put8(tp + 192, R.k); rw_put8(tp + 256, R.r); rw_put8(tp + 320, R.v);
}
#define RW_LD4(p) (*(const LAS f32x4*)(p))
__device__ __forceinline__ void rw_step(f32x2 (&S)[32], const LAS float* tp, float vi) {
    f32x4 kk[16];
#pragma unroll
    for (int i = 0; i < 16; ++i) kk[i] = RW_LD4(tp + 4 * i);
    f32x4 b4[2][4], w4[2][4], k4[2][4];
#pragma unroll
    for (int i = 0; i < 4; ++i) { b4[0][i] = RW_LD4(tp + 64 + 4 * i); w4[0][i] = RW_LD4(tp + 128 + 4 * i); k4[0][i] = RW_LD4(tp + 192 + 4 * i); }
    __builtin_amdgcn_sched_barrier(0);
    f32x2 d0 = (f32x2){0.f, 0.f}, d1 = d0;
#pragma unroll
    for (int i = 0; i < 16; ++i) { d0 += S[2 * i] * (f32x2){kk[i][0], kk[i][1]}; d1 += S[2 * i + 1] * (f32x2){kk[i][2], kk[i][3]}; }
    const float sk = (d0[0] + d0[1]) + (d1[0] + d1[1]); const f32x2 nsk = (f32x2){-sk, -sk}, vi2 = (f32x2){vi, vi};
#pragma unroll
    for (int c = 0; c < 4; ++c) { const int cb = c & 1, nb = cb ^ 1;
        if (c + 1 < 4) {
#pragma unroll
            for (int i = 0; i < 4; ++i) { b4[nb][i] = RW_LD4(tp + 64 + 16 * (c + 1) + 4 * i); w4[nb][i] = RW_LD4(tp + 128 + 16 * (c + 1) + 4 * i); k4[nb][i] = RW_LD4(tp + 192 + 16 * (c + 1) + 4 * i); } }
        __builtin_amdgcn_sched_barrier(0);
#pragma unroll
        for (int i = 0; i < 4; ++i) { const int p = 8 * c + 2 * i;
            S[p] = S[p] * (f32x2){w4[cb][i][0], w4[cb][i][1]} + (vi2 * (f32x2){k4[cb][i][0], k4[cb][i][1]} + nsk * (f32x2){b4[cb][i][0], b4[cb][i][1]});
            S[p + 1] = S[p + 1] * (f32x2){w4[cb][i][2], w4[cb][i][3]} + (vi2 * (f32x2){k4[cb][i][2], k4[cb][i][3]} + nsk * (f32x2){b4[cb][i][2], b4[cb][i][3]}); }
        __builtin_amdgcn_sched_barrier(0); }
}
__device__ __forceinline__ float rw_dot_r(const f32x2 (&S)[32], const LAS float* tp) {
    f32x4 r4[16];
#pragma unroll
    for (int i = 0; i < 16; ++i) r4[i] = RW_LD4(tp + 256 + 4 * i);
    __builtin_amdgcn_sched_barrier(0);
    f32x2 d0 = (f32x2){0.f, 0.f}, d1 = d0;
#pragma unroll
    for (int i = 0; i < 16; ++i) { d0 += S[2 * i] * (f32x2){r4[i][0], r4[i][1]}; d1 += S[2 * i + 1] * (f32x2){r4[i][2], r4[i][3]}; }
    return (d0[0] + d0[1]) + (d1[0] + d1[1]);
}

__device__ __forceinline__ void rw_step_dual(f32x2 (&SP)[32], f32x2 (&SU)[32], const LAS float* tp, float vi) {
    f32x2 p0 = (f32x2){0.f, 0.f}, p1 = p0, u0 = p0, u1 = p0;
#pragma unroll
    for (int h2 = 0; h2 < 2; ++h2) { f32x4 kk[8];
#pragma unroll
        for (int i = 0; i < 8; ++i) kk[i] = RW_LD4(tp + 32 * h2 + 4 * i);
        __builtin_amdgcn_sched_barrier(0);
#pragma unroll
        for (int i = 0; i < 8; ++i) { const int p = 16 * h2 + 2 * i; const f32x2 ka = (f32x2){kk[i][0], kk[i][1]}, kb = (f32x2){kk[i][2], kk[i][3]};
            p0 += SP[p] * ka; p1 += SP[p + 1] * kb; u0 += SU[p] * ka; u1 += SU[p + 1] * kb; }
        __builtin_amdgcn_sched_barrier(0); }
    const float skp = (p0[0] + p0[1]) + (p1[0] + p1[1]), sku = (u0[0] + u0[1]) + (u1[0] + u1[1]); const f32x2 nsp = (f32x2){-skp, -skp}, nsu = (f32x2){-sku, -sku}, vi2 = (f32x2){vi, vi};
#pragma unroll
    for (int c = 0; c < 8; ++c) { f32x4 b4[2], w4[2], k4[2];
#pragma unroll
        for (int i = 0; i < 2; ++i) { b4[i] = RW_LD4(tp + 64 + 8 * c + 4 * i); w4[i] = RW_LD4(tp + 128 + 8 * c + 4 * i); k4[i] = RW_LD4(tp + 192 + 8 * c + 4 * i); }
        __builtin_amdgcn_sched_barrier(0);
#pragma unroll
        for (int i = 0; i < 2; ++i) { const int p = 4 * c + 2 * i;
            const f32x2 ba = (f32x2){b4[i][0], b4[i][1]}, bb = (f32x2){b4[i][2], b4[i][3]}, wa = (f32x2){w4[i][0], w4[i][1]}, wb = (f32x2){w4[i][2], w4[i][3]}, ka = (f32x2){k4[i][0], k4[i][1]}, kb = (f32x2){k4[i][2], k4[i][3]};
            SP[p] = SP[p] * wa + nsp * ba; SP[p + 1] = SP[p + 1] * wb + nsp * bb;
            SU[p] = SU[p] * wa + (vi2 * ka + nsu * ba); SU[p + 1] = SU[p + 1] * wb + (vi2 * kb + nsu * bb); }
        __builtin_amdgcn_sched_barrier(0); }
}
__device__ __forceinline__ void rw_pass1(const Ctx& c, const PA& a) {
    const unsigned char* ws = a.ws; LAS float* tile = (LAS float*)(c.lds + c.wave * (2 * RW_TS * 384 * 4));
    const int lane = c.lane;
    if (c.wave >= 4) return;
    for (int task = c.bx * 4 + c.wave; task < 16 * RW_NC; task += c.G * 4) {
        const int h = task / RW_NC, ch = task % RW_NC;
        f32x2 SP[32], SU[32]; int lz = lane; asm volatile("" : "+v"(lz));
#pragma unroll
        for (int j = 0; j < 32; ++j) { SP[j] = (f32x2){(2 * j == lz) ? 1.f : 0.f, (2 * j + 1 == lz) ? 1.f : 0.f}; SU[j] = (f32x2){0.f, 0.f}; }
        { RwRegs R; rw_stage_load(ws, R, ch * RW_CL, h, lane, false); rw_stage_store(tile, R, lane); }
        for (int ti = 0; ti < RW_CL / RW_TS; ++ti) { const int t0 = ch * RW_CL + ti * RW_TS; LAS float* tcur = tile + (ti & 1) * 3072; LAS float* tnxt = tile + ((ti + 1) & 1) * 3072;
            RwRegs R; if (ti + 1 < RW_CL / RW_TS) rw_stage_load(ws, R, t0 + RW_TS, h, lane, false);
            LDS_WAIT();
#pragma unroll 1
            for (int s = 0; s < RW_TS; ++s) { const LAS float* tp = tcur + s * 384; rw_step_dual(SP, SU, tp, tp[320 + lane]); }
            if (ti + 1 < RW_CL / RW_TS) rw_stage_store(tnxt, R, lane);
            LDS_WAIT();
        }
        float* op = (float*)(a.ws + WS_RWP) + ((size_t)task * 64 + lane) * 64; float* ou = (float*)(a.ws + WS_RWU) + ((size_t)task * 64 + lane) * 64;
#pragma unroll
        for (int jj = 0; jj < 16; ++jj) { *(f32x4*)(op + 4 * jj) = (f32x4){SP[2 * jj][0], SP[2 * jj][1], SP[2 * jj + 1][0], SP[2 * jj + 1][1]}; *(f32x4*)(ou + 4 * jj) = (f32x4){SU[2 * jj][0], SU[2 * jj][1], SU[2 * jj + 1][0], SU[2 * jj + 1][1]}; }
    }
}
#define RDL(v, l) __int_as_float(__builtin_amdgcn_readlane(__float_as_int(v), (l)))
__device__ __forceinline__ void rw_pass2(const Ctx& c, const PA& a) {
    const float* P = (const float*)(a.ws + WS_RWP); const float* U = (const float*)(a.ws + WS_RWU); float* Si = (float*)(a.ws + WS_RWS);
    LAS float* pb = (LAS float*)c.lds;
    const int lane = c.lane, w = c.wave, tid = c.tid;
    for (int unit = c.bx; unit < 256; unit += c.G) { const int h = unit >> 4, i = (unit & 15) * 4 + (w & 3); const size_t hc0 = (size_t)h * RW_NC;
        { const f32x4* src = (const f32x4*)(P + hc0 * 4096) + tid * 2; *(LAS f32x4*)(pb + tid * 8) = src[0]; *(LAS f32x4*)(pb + tid * 8 + 4) = src[1]; }
        float s = 0.f, u = U[(hc0 * 64 + i) * 64 + lane];
        __syncthreads();
        for (int ch = 0; ch < RW_NC; ++ch) { const LAS float* pc = pb + (ch & 1) * 4096 + lane;
            f32x4 n0 = (f32x4){0.f, 0.f, 0.f, 0.f}, n1 = n0; float un = 0.f;
            if (ch + 1 < RW_NC) { const f32x4* src = (const f32x4*)(P + (hc0 + ch + 1) * 4096) + tid * 2; n0 = src[0]; n1 = src[1]; un = U[((hc0 + ch + 1) * 64 + i) * 64 + lane]; }
            if (w < 4) { Si[((hc0 + ch) * 64 + i) * 64 + lane] = s;
                float a0 = u, a1 = 0.f, a2 = 0.f, a3 = 0.f;
#pragma unroll
                for (int i2 = 0; i2 < 64; i2 += 4) { a0 += RDL(s, i2) * pc[i2 * 64]; a1 += RDL(s, i2 + 1) * pc[(i2 + 1) * 64]; a2 += RDL(s, i2 + 2) * pc[(i2 + 2) * 64]; a3 += RDL(s, i2 + 3) * pc[(i2 + 3) * 64]; }
                s = (a0 + a1) + (a2 + a3); }
            { LAS float* dst = pb + ((ch + 1) & 1) * 4096 + tid * 8; *(LAS f32x4*)dst = n0; *(LAS f32x4*)(dst + 4) = n1; }
            u = un;
            __syncthreads(); }
    }
}
__device__ __forceinline__ void rw_pass3(const Ctx& c, const PA& a, int layer) {
    const unsigned char* ws = a.ws; LAS float* tile = (LAS float*)(c.lds + c.wave * 28800); LAS float* tg = tile + 6144; LAS float* ty = tg + 512; LAS float* trk = ty + 512; LAS float* tst = trk + 8;
    const float* Si = (const float*)(ws + WS_RWS); bf16* Y = (bf16*)(a.ws + WS_YRW); const float* r_k = a.in(14) + layer * 1024;
    const float* lng = a.in(15) + layer * 1024; const float* lnb = a.in(16) + layer * 1024;
    const int lane = c.lane;
    if (c.wave >= 4) return;
    for (int task = c.bx * 4 + c.wave; task < 16 * RW_NC; task += c.G * 4) {
        const int h = task / RW_NC, ch = task % RW_NC, col = h * 64 + lane;
        const float lg = lng[col], lb = lnb[col]; const f32x4 rk0 = *(const f32x4*)(r_k + h * 64 + 8 * (lane & 7)), rk1 = *(const f32x4*)(r_k + h * 64 + 8 * (lane & 7) + 4);
        f32x2 S[32]; const float* sp = Si + ((size_t)task * 64 + lane) * 64;
#pragma unroll
        for (int jj = 0; jj < 16; ++jj) { const f32x4 v = *(const f32x4*)(sp + 4 * jj); S[2 * jj] = (f32x2){v[0], v[1]}; S[2 * jj + 1] = (f32x2){v[2], v[3]}; }
        { RwRegs R; rw_stage_load(ws, R, ch * RW_CL, h, lane, true); rw_stage_store(tile, R, lane); rw_put8(tg + (lane >> 3) * 64 + 8 * (lane & 7), R.g); }
        for (int ti = 0; ti < RW_CL / RW_TS; ++ti) { const int t0 = ch * RW_CL + ti * RW_TS; LAS float* tcur = tile + (ti & 1) * 3072; LAS float* tnxt = tile + ((ti + 1) & 1) * 3072;
            RwRegs R; if (ti + 1 < RW_CL / RW_TS) rw_stage_load(ws, R, t0 + RW_TS, h, lane, true);
            LDS_WAIT();
            { const LAS float* rp = tcur + (lane >> 3) * 384 + 256 + 8 * (lane & 7); const LAS float* kp = tcur + (lane >> 3) * 384 + 192 + 8 * (lane & 7);
                const f32x4 r0 = *(const LAS f32x4*)rp, r1 = *(const LAS f32x4*)(rp + 4), k0 = *(const LAS f32x4*)kp, k1 = *(const LAS f32x4*)(kp + 4);
                float sm = ((r0[0] * k0[0] * rk0[0] + r0[1] * k0[1] * rk0[1]) + (r0[2] * k0[2] * rk0[2] + r0[3] * k0[3] * rk0[3])) + ((r1[0] * k1[0] * rk1[0] + r1[1] * k1[1] * rk1[1]) + (r1[2] * k1[2] * rk1[2] + r1[3] * k1[3] * rk1[3]));
                sm = sum_x1_2_4(sm); if ((lane & 7) == 0) trk[lane >> 3] = sm; }
#pragma unroll 1
            for (int s = 0; s < RW_TS; ++s) { const LAS float* tp = tcur + s * 384; const float vi = tp[320 + lane]; rw_step(S, tp, vi); ty[s * 64 + lane] = rw_dot_r(S, tp); }
            LDS_WAIT();
            { const LAS float* yp = ty + (lane >> 3) * 64 + 8 * (lane & 7); const f32x4 y0 = *(const LAS f32x4*)yp, y1 = *(const LAS f32x4*)(yp + 4);
                float sm = ((y0[0] + y0[1]) + (y0[2] + y0[3])) + ((y1[0] + y1[1]) + (y1[2] + y1[3]));
                sm = sum_x1_2_4(sm); const float mean = sm * (1.f / 64.f);
                const f32x4 d0 = y0 - mean, d1 = y1 - mean; float sq = ((d0[0] * d0[0] + d0[1] * d0[1]) + (d0[2] * d0[2] + d0[3] * d0[3])) + ((d1[0] * d1[0] + d1[1] * d1[1]) + (d1[2] * d1[2] + d1[3] * d1[3]));
                sq = sum_x1_2_4(sq);
                if ((lane & 7) == 0) { tst[2 * (lane >> 3)] = mean; tst[2 * (lane >> 3) + 1] = 1.f / sqrtf(sq * (1.f / 64.f) + 64e-5f); } }
            LDS_WAIT();
#pragma unroll
            for (int s = 0; s < RW_TS; ++s) { const float y = ty[s * 64 + lane], vi = tcur[s * 384 + 320 + lane], yn = (y - tst[2 * s]) * tst[2 * s + 1];
                Y[(size_t)(t0 + s) * 1024 + col] = (bf16)f2bf((yn * lg + lb + trk[s] * vi) * tg[s * 64 + lane]); }
            LDS_WAIT();
            if (ti + 1 < RW_CL / RW_TS) { rw_stage_store(tnxt, R, lane); rw_put8(tg + (lane >> 3) * 64 + 8 * (lane & 7), R.g); }
            LDS_WAIT();
        }
    }
}

__device__ __forceinline__ int ret_tok(int ks, int q, int i) { return 32 * ks + 4 * q + (i & 3) + ((i >> 2) << 4); }
__device__ __forceinline__ void prep_ret_frags(const Ctx& c, const PA& a, bool vonly = false) {
    unsigned char* ws = a.ws; bf16* proj = (bf16*)(ws + WS_PROJ); const float* cs = (const float*)(ws + WS_COS); const float* sn = (const float*)(ws + WS_SIN);
    LAS float* tile = (LAS float*)(c.lds + c.wave * 16896);
    const int lane = c.lane, r = lane & 15, q = lane >> 4;
    for (int it = c.gw; it < 8 * 128 * 4 * 2; it += c.NGW) { if (vonly && (it & 1)) continue; const int ten = it & 1, ks = (it >> 1) & 3, ch = (it >> 3) & 127, h = it >> 10; const int tb = ch * 128 + 32 * ks;
        if (ten == 0) {
#pragma unroll
            for (int i = 0; i < 8; ++i) { const int id = lane + 64 * i, row = id >> 4, c8 = (id & 15) * 8; const u32x4 v = *(const u32x4*)(proj + (size_t)(tb + row) * LDP + PC_RV + h * 128 + c8);
                LAS float* tp = tile + row * 132 + c8; *(LAS f32x4*)tp = (f32x4){bflo(v.x), bfhi(v.x), bflo(v.y), bfhi(v.y)}; *(LAS f32x4*)(tp + 4) = (f32x4){bflo(v.z), bfhi(v.z), bflo(v.w), bfhi(v.w)}; }
        } else {
#pragma unroll
            for (int i = 0; i < 4; ++i) { const int id = lane + 64 * i, row = id >> 3, c8 = (id & 7) * 8; bf16* kp = proj + (size_t)(tb + row) * LDP + PC_RK + h * 128 + c8;
                const u32x4 lo = *(const u32x4*)kp, hi = *(const u32x4*)(kp + 64);
                const f32x4 c0 = *(const f32x4*)(cs + (size_t)(tb + row) * 64 + c8), c1 = *(const f32x4*)(cs + (size_t)(tb + row) * 64 + c8 + 4), s0 = *(const f32x4*)(sn + (size_t)(tb + row) * 64 + c8), s1 = *(const f32x4*)(sn + (size_t)(tb + row) * 64 + c8 + 4);
                const float k1[8] = {bflo(lo.x), bfhi(lo.x), bflo(lo.y), bfhi(lo.y), bflo(lo.z), bfhi(lo.z), bflo(lo.w), bfhi(lo.w)}, k2[8] = {bflo(hi.x), bfhi(hi.x), bflo(hi.y), bfhi(hi.y), bflo(hi.z), bfhi(hi.z), bflo(hi.w), bfhi(hi.w)};
                float o1[8], o2[8];
#pragma unroll
                for (int j = 0; j < 8; ++j) { const float co = j < 4 ? c0[j] : c1[j - 4], si = j < 4 ? s0[j] : s1[j - 4];
                    o1[j] = bf2f((bf16)f2bf((k1[j] * co - k2[j] * si) * 0.08838834764831845f)); o2[j] = bf2f((bf16)f2bf((k1[j] * si + k2[j] * co) * 0.08838834764831845f)); }
                *(u32x4*)kp = (u32x4){pk2(o1[0], o1[1]), pk2(o1[2], o1[3]), pk2(o1[4], o1[5]), pk2(o1[6], o1[7])}; *(u32x4*)(kp + 64) = (u32x4){pk2(o2[0], o2[1]), pk2(o2[2], o2[3]), pk2(o2[4], o2[5]), pk2(o2[6], o2[7])};
                LAS float* tp = tile + row * 132 + c8;
                *(LAS f32x4*)tp = (f32x4){o1[0], o1[1], o1[2], o1[3]}; *(LAS f32x4*)(tp + 4) = (f32x4){o1[4], o1[5], o1[6], o1[7]}; *(LAS f32x4*)(tp + 64) = (f32x4){o2[0], o2[1], o2[2], o2[3]}; *(LAS f32x4*)(tp + 68) = (f32x4){o2[4], o2[5], o2[6], o2[7]}; }
        }
        LDS_WAIT();
        bf16* dst = (bf16*)(ws + (ten == 0 ? WS_VFR : WS_KTR)) + (((size_t)(h * 128 + ch) * 4 + ks) * 8) * 512 + lane * 8;
        float dec[8];
#pragma unroll
        for (int i = 0; i < 8; ++i) { const int tl = ret_tok(0, q, i); dec[i] = ten ? expf(RET_LOGG[h] * (float)(127 - (32 * ks + tl))) : 1.f; }
#pragma unroll
        for (int mt = 0; mt < 8; ++mt) { float v[8];
#pragma unroll
            for (int i = 0; i < 8; ++i) v[i] = tile[ret_tok(0, q, i) * 132 + 16 * mt + r] * dec[i];
            *(u32x4*)(dst + (size_t)mt * 512) = (u32x4){pk2(v[0], v[1]), pk2(v[2], v[3]), pk2(v[4], v[5]), pk2(v[6], v[7])}; }
        LDS_WAIT();
    }
}
__device__ __forceinline__ void ret_kv(const Ctx& c, const PA& a) {
    const bf16* VF = (const bf16*)(a.ws + WS_VFR); const bf16* KT = (const bf16*)(a.ws + WS_KTR); float* KV = (float*)(a.ws + WS_RETKV);
    const int lane = c.lane, r = lane & 15, q = lane >> 4;
    for (int task = c.gw; task < 128 * 8 * 8; task += c.NGW) { const int it = task >> 3, w = task & 7, ch = it >> 3, h = it & 7; const size_t fb = ((size_t)(h * 128 + ch) * 8) * 4 * 512 + lane * 8;
        f32x4 acc[8];
#pragma unroll
        for (int mt = 0; mt < 8; ++mt) acc[mt] = (f32x4){0.f, 0.f, 0.f, 0.f};
#pragma unroll
        for (int ks = 0; ks < 4; ++ks) { const bf16x8 kb = *(const bf16x8*)(KT + fb + (size_t)(ks * 8 + w) * 512);
#pragma unroll
            for (int mt = 0; mt < 8; ++mt) { const bf16x8 va = *(const bf16x8*)(VF + fb + (size_t)(ks * 8 + mt) * 512); acc[mt] = __builtin_amdgcn_mfma_f32_16x16x32_bf16(kb, va, acc[mt], 0, 0, 0); } }
        float* o = KV + ((size_t)it * 128 + r) * 128 + 16 * w + 4 * q;
#pragma unroll
        for (int mt = 0; mt < 8; ++mt) *(f32x4*)(o + (size_t)(16 * mt) * 128) = acc[mt];
    }
}
__device__ __forceinline__ void ret_prefix(const Ctx& c, const PA& a) {
    const float* KV = (const float*)(a.ws + WS_RETKV); bf16* RT = (bf16*)(a.ws + WS_RT);
    typedef float f32x2_ __attribute__((ext_vector_type(2)));
    for (int i = c.bx * 512 + c.tid; i < 8 * 8192; i += c.G * 512) { const int h = i >> 13, e = (i & 8191) * 2; const float cd = expf(RET_LOGG[h] * 128.f);
        float r0 = 0.f, r1 = 0.f;
        for (int c0 = 0; c0 < 128; c0 += 16) { f32x2_ tmp[16];
#pragma unroll
            for (int k = 0; k < 16; ++k) tmp[k] = *(const f32x2_*)(KV + ((size_t)((c0 + k) * 8 + h) << 14) + e);
#pragma unroll
            for (int k = 0; k < 16; ++k) { *(unsigned*)(RT + ((size_t)((c0 + k) * 8 + h) << 14) + e) = pk2(r0, r1); r0 = r0 * cd + tmp[k][0]; r1 = r1 * cd + tmp[k][1]; } } }
}
__device__ __forceinline__ void ret_out(const Ctx& c, const PA& a, int wv_first, int wv_count) {
    const bf16* proj = (const bf16*)(a.ws + WS_PROJ); const bf16* VF = (const bf16*)(a.ws + WS_VFR); const bf16* RT = (const bf16*)(a.ws + WS_RT); bf16* Y = (bf16*)(a.ws + WS_YRET);
    const int lane = c.lane, r = lane & 15, q = lane >> 4;
    if (c.wave < wv_first) return;
    for (int task = c.bx * wv_count + (c.wave - wv_first); task < 128 * 8 * 8; task += c.G * wv_count) { const int it = task >> 3, w = task & 7, ch = it >> 3, h = it & 7; const float lg2 = RET_LOGG[h] * 1.4426950408889634f;
        const int iq = 16 * w + r, tq = ch * 128 + iq;
        bf16x8 qb[4];
#pragma unroll
        for (int ks = 0; ks < 4; ++ks) qb[ks] = *(const bf16x8*)(proj + (size_t)tq * LDP + PC_RQ + h * 128 + 32 * ks + 8 * q);
        f32x4 oi[8], oc[8];
#pragma unroll
        for (int mt = 0; mt < 8; ++mt) { oi[mt] = (f32x4){0.f, 0.f, 0.f, 0.f}; oc[mt] = oi[mt]; }
        const size_t fb = ((size_t)(h * 128 + ch) * 8) * 4 * 512 + lane * 8;
#pragma unroll
        for (int ks = 0; ks < 4; ++ks) if (2 * ks <= w) { f32x4 st[2];
#pragma unroll
            for (int jj = 0; jj < 2; ++jj) { const int j = 2 * ks + jj; st[jj] = (f32x4){0.f, 0.f, 0.f, 0.f};
                if (j <= w) { const bf16* kp = proj + (size_t)(ch * 128 + 16 * j + r) * LDP + PC_RK + h * 128 + 8 * q;
#pragma unroll
                    for (int k2 = 0; k2 < 4; ++k2) st[jj] = __builtin_amdgcn_mfma_f32_16x16x32_bf16(*(const bf16x8*)(kp + 32 * k2), qb[k2], st[jj], 0, 0, 0);
#pragma unroll
                    for (int i = 0; i < 4; ++i) { const int d = iq - (16 * j + 4 * q + i); st[jj][i] = d >= 0 ? st[jj][i] * __builtin_amdgcn_exp2f(lg2 * (float)d) : 0.f; } } }
            const u32x4 pw = (u32x4){pg8::cvt_pk_bf16(st[0][0], st[0][1]), pg8::cvt_pk_bf16(st[0][2], st[0][3]), pg8::cvt_pk_bf16(st[1][0], st[1][1]), pg8::cvt_pk_bf16(st[1][2], st[1][3])};
            const bf16x8 pf = __builtin_bit_cast(bf16x8, pw);
#pragma unroll
            for (int mt = 0; mt < 8; ++mt) oi[mt] = __builtin_amdgcn_mfma_f32_16x16x32_bf16(*(const bf16x8*)(VF + fb + (size_t)(ks * 8 + mt) * 512), pf, oi[mt], 0, 0, 0);
            __builtin_amdgcn_sched_barrier(0); }
        const bf16* rp = RT + ((size_t)it * 128 + r) * 128 + 8 * q;
#pragma unroll
        for (int mt = 0; mt < 8; ++mt)
#pragma unroll
            for (int ks = 0; ks < 4; ++ks) { oc[mt] = __builtin_amdgcn_mfma_f32_16x16x32_bf16(*(const bf16x8*)(rp + (size_t)(16 * mt) * 128 + 32 * ks), qb[ks], oc[mt], 0, 0, 0); if (ks == 3 && (mt & 1)) __builtin_amdgcn_sched_barrier(0); }
        const float qd = __builtin_amdgcn_exp2f(lg2 * (float)(iq + 1));
        float sm = 0.f;
#pragma unroll
        for (int mt = 0; mt < 8; ++mt) { oi[mt] = oi[mt] + oc[mt] * qd; sm += (oi[mt][0] + oi[mt][1]) + (oi[mt][2] + oi[mt][3]); }
        sm = sum_x16_32(sm); const float mean = sm * (1.f / 128.f); float sq = 0.f;
#pragma unroll
        for (int mt = 0; mt < 8; ++mt) { oi[mt] = oi[mt] - mean; sq += (oi[mt][0] * oi[mt][0] + oi[mt][1] * oi[mt][1]) + (oi[mt][2] * oi[mt][2] + oi[mt][3] * oi[mt][3]); }
        sq = sum_x16_32(sq); const float rs = 1.f / sqrtf(sq * (1.f / 128.f) + 1e-5f);
        const bf16* gp = proj + (size_t)tq * LDP + PC_RG + h * 128 + 4 * q; bf16* yp = Y + (size_t)tq * 1024 + h * 128 + 4 * q;
#pragma unroll
        for (int mt = 0; mt < 8; ++mt) { const uint2 gw = *(const uint2*)(gp + 16 * mt); const float g0 = bflo(gw.x), g1 = bfhi(gw.x), g2 = bflo(gw.y), g3 = bfhi(gw.y);
            uint2 o; o.x = pg8::cvt_pk_bf16(g0 * sigm(g0) * oi[mt][0] * rs, g1 * sigm(g1) * oi[mt][1] * rs); o.y = pg8::cvt_pk_bf16(g2 * sigm(g2) * oi[mt][2] * rs, g3 * sigm(g3) * oi[mt][3] * rs);
            *(uint2*)(yp + 16 * mt) = o; }
    }
}


constexpr float NSA_C = 0.125f * 1.4426950408889634f;
constexpr float NSA_C8 = NSA_C * (1.f / 16.f);
struct NsaSrc { const bf16* kf; const bf16* vf; };

__device__ __forceinline__ void nsa_loadK(const NsaSrc& src, int key0, bf16x8 (&kf)[4][2], int lane) {
    const bf16* kp = src.kf + (size_t)(key0 >> 6) * 4096 + lane * 8;
#pragma unroll
    for (int j = 0; j < 4; ++j) { kf[j][0] = *(const bf16x8*)(kp + (2 * j) * 512); kf[j][1] = *(const bf16x8*)(kp + (2 * j + 1) * 512); }
}
__device__ __forceinline__ void nsa_loadV(const NsaSrc& src, int key0, bf16x8 (&vf)[4][2], int lane) {
    const bf16* vp = src.vf + (size_t)(key0 >> 6) * 4096 + lane * 8;
#pragma unroll
    for (int mt = 0; mt < 4; ++mt) { vf[mt][0] = *(const bf16x8*)(vp + (2 * mt) * 512); vf[mt][1] = *(const bf16x8*)(vp + (2 * mt + 1) * 512); }
}
__device__ __forceinline__ void nsa_qk(const bf16x8 (&kf)[4][2], const bf16x8 (&qf)[2], f32x4 (&st)[4]) {
#pragma unroll
    for (int j = 0; j < 4; ++j) { st[j] = (f32x4){0.f, 0.f, 0.f, 0.f};
        st[j] = __builtin_amdgcn_mfma_f32_16x16x32_bf16(kf[j][0], qf[0], st[j], 0, 0, 0); st[j] = __builtin_amdgcn_mfma_f32_16x16x32_bf16(kf[j][1], qf[1], st[j], 0, 0, 0); }
}
template <int MODE, bool MASKED>
__device__ __forceinline__ void nsa_rest(f32x4 (&st)[4], const bf16x8 (&vf)[4][2], int key0, int lo, int hi, f32x4 (&O)[4], float& m, float& l, float inv, int r, int q, LAS float* impA, LAS float* impB) {
    const float cm = NSA_C * m; float ps = 0.f;
#pragma unroll
    for (int j = 0; j < 4; ++j)
#pragma unroll
        for (int i = 0; i < 4; ++i) { float e = __builtin_amdgcn_exp2f(NSA_C * st[j][i] - cm);
            if (MASKED) { const int key = key0 + 16 * j + 4 * q + i; e = (key >= lo && key <= hi) ? e : 0.f; }
            st[j][i] = MODE == 2 ? e * inv : e; ps += e; }
    if (MODE != 2) l += ps;
    if (MODE == 2) {
#pragma unroll
        for (int j = 0; j < 4; ++j) { float a = (st[j][0] + st[j][1]) + (st[j][2] + st[j][3]), b = st[j][3];
            a = sum_x1_2(a); b = sum_x1_2(b);
            if ((r & 3) == 0) { const int J = (r >> 2) * 260 + (key0 >> 2) + 4 * j + q; atomicAdd((float*)(impA + J), a); atomicAdd((float*)(impA + J + 1), b); } } }
    if (MODE != 0) {
        bf16x8 pf[2];
#pragma unroll
        for (int ks = 0; ks < 2; ++ks) { const unsigned w0 = pg8::cvt_pk_bf16(st[2 * ks][0], st[2 * ks][1]), w1 = pg8::cvt_pk_bf16(st[2 * ks][2], st[2 * ks][3]),
                                                        w2 = pg8::cvt_pk_bf16(st[2 * ks + 1][0], st[2 * ks + 1][1]), w3 = pg8::cvt_pk_bf16(st[2 * ks + 1][2], st[2 * ks + 1][3]);
            const u32x4 w = (u32x4){w0, w1, w2, w3}; pf[ks] = __builtin_bit_cast(bf16x8, w); }
#pragma unroll
        for (int mt = 0; mt < 4; ++mt) {
#pragma unroll
            for (int ks = 0; ks < 2; ++ks) O[mt] = __builtin_amdgcn_mfma_f32_16x16x32_bf16(vf[mt][ks], pf[ks], O[mt], 0, 0, 0); } }
}
#define NSA_REST_(MODE, ST, VF, K0, LO, HI, LOU, HIU, INV) do { if ((K0) >= (LOU) && (K0) + 63 <= (HIU)) nsa_rest<MODE, false>(ST, VF, K0, LO, HI, O, m, l, INV, r, q, impA, impB);     \
        else nsa_rest<MODE, true>(ST, VF, K0, LO, HI, O, m, l, INV, r, q, impA, impB); } while (0)
#define NSA_LOOP(MODE, SRC, NBLK, KEY0, LO, HI, LOU, HIU, INV) do { const int nblk_ = (NBLK); if (nblk_ > 0) { bf16x8 kf_[4][2], vf_[4][2]; f32x4 st_[4]; nsa_loadK(SRC, KEY0(0), kf_, lane); \
    _Pragma("unroll 1") for (int b_ = 0; b_ < nblk_; ++b_) { const int k0_ = KEY0(b_); if (MODE != 0) nsa_loadV(SRC, k0_, vf_, lane); \
        nsa_qk(kf_, qf, st_); __builtin_amdgcn_sched_barrier(0); \
        if (b_ + 1 < nblk_) nsa_loadK(SRC, KEY0(b_ + 1), kf_, lane);     \
        NSA_REST_(MODE, st_, vf_, k0_, LO, HI, LOU, HIU, INV); } } } while (0)
typedef unsigned u32x2 __attribute__((ext_vector_type(2)));
__device__ __forceinline__ unsigned pack4_fp8(float a, float b, float c, float d) { int w = 0; w = __builtin_amdgcn_cvt_pk_fp8_f32(a, b, w, false); w = __builtin_amdgcn_cvt_pk_fp8_f32(c, d, w, true); return (unsigned)w; }
__device__ __forceinline__ void nsa_loadK8(const unsigned char* kf8, int key0, u32x4 (&k8)[4], int lane) {
    const unsigned char* kp = kf8 + (size_t)(key0 >> 6) * 4096 + lane * 16;
#pragma unroll
    for (int j = 0; j < 4; ++j) k8[j] = *(const u32x4*)(kp + j * 1024);
}
__device__ __forceinline__ void nsa_qk8(const u32x4 (&k8)[4], const long (&q8)[2], f32x4 (&st)[4]) {
#pragma unroll
    for (int j = 0; j < 4; ++j) st[j] = __builtin_amdgcn_mfma_f32_16x16x32_fp8_fp8(__builtin_bit_cast(long, (u32x2){k8[j].x, k8[j].y}), q8[0], (f32x4){0.f, 0.f, 0.f, 0.f}, 0, 0, 0);
#pragma unroll
    for (int j = 0; j < 4; ++j) st[j] = __builtin_amdgcn_mfma_f32_16x16x32_fp8_fp8(__builtin_bit_cast(long, (u32x2){k8[j].z, k8[j].w}), q8[1], st[j], 0, 0, 0);
}
__device__ __forceinline__ void nsa_loadV8(const unsigned char* vf8, int key0, u32x4 (&v8)[4], int lane) {
    const unsigned char* vp = vf8 + (size_t)(key0 >> 6) * 4096 + lane * 16;
#pragma unroll
    for (int mt = 0; mt < 4; ++mt) v8[mt] = *(const u32x4*)(vp + mt * 1024);
}
__device__ __forceinline__ void nsa_rest_dense(const f32x4 (&st)[4], const u32x4 (&v8)[4], f32x4 (&O)[4], float cm, float& l, int s4) {
    const bool i0 = s4 == 0, i1 = s4 == 1, i2 = s4 == 2, i3 = s4 == 3;
    const f32x4 x = i0 ? st[0] : (i1 ? st[1] : (i2 ? st[2] : st[3]));
    const float e0 = fminf(__builtin_amdgcn_exp2f(NSA_C8 * x[0] - cm), 416.f), e1 = fminf(__builtin_amdgcn_exp2f(NSA_C8 * x[1] - cm), 416.f), e2 = fminf(__builtin_amdgcn_exp2f(NSA_C8 * x[2] - cm), 416.f), e3 = fminf(__builtin_amdgcn_exp2f(NSA_C8 * x[3] - cm), 416.f);
    l += (e0 + e1) + (e2 + e3);
    const unsigned w = pack4_fp8(e0, e1, e2, e3);
    const long p0 = __builtin_bit_cast(long, (u32x2){i0 ? w : 0u, i1 ? w : 0u}), p1 = __builtin_bit_cast(long, (u32x2){i2 ? w : 0u, i3 ? w : 0u});
#pragma unroll
    for (int mt = 0; mt < 4; ++mt) O[mt] = __builtin_amdgcn_mfma_f32_16x16x32_fp8_fp8(__builtin_bit_cast(long, (u32x2){v8[mt].x, v8[mt].y}), p0, O[mt], 0, 0, 0);
#pragma unroll
    for (int mt = 0; mt < 4; ++mt) O[mt] = __builtin_amdgcn_mfma_f32_16x16x32_fp8_fp8(__builtin_bit_cast(long, (u32x2){v8[mt].z, v8[mt].w}), p1, O[mt], 0, 0, 0);
}
#define NSA_LOOP_DENSE(K8, V8, NBLK, KEY0, QD, CM, L, S4, KF, VA) do { const int nblk_ = (NBLK); if (nblk_ > 0) { u32x4 vb_[4]; f32x4 st_[4];     \
    _Pragma("unroll 1") for (int b_ = 0; b_ < nblk_; b_ += 2) { \
        if (b_ + 1 < nblk_) nsa_loadV8(V8, KEY0(b_ + 1), vb_, lane); \
        nsa_qk8(KF, QD, st_); __builtin_amdgcn_sched_barrier(0); \
        if (b_ + 1 < nblk_) nsa_loadK8(K8, KEY0(b_ + 1), KF, lane); \
        nsa_rest_dense(st_, VA, O, CM, L, S4); \
        if (b_ + 1 >= nblk_) break; \
        __builtin_amdgcn_sched_barrier(0); \
        if (b_ + 2 < nblk_) nsa_loadV8(V8, KEY0(b_ + 2), VA, lane); \
        nsa_qk8(KF, QD, st_); __builtin_amdgcn_sched_barrier(0); \
        if (b_ + 2 < nblk_) nsa_loadK8(K8, KEY0(b_ + 2), KF, lane); \
        nsa_rest_dense(st_, vb_, O, CM, L, S4); __builtin_amdgcn_sched_barrier(0); } } } while (0)
__device__ __forceinline__ float lane_get(float v, int src) { return __int_as_float(__builtin_amdgcn_ds_bpermute(src << 2, __float_as_int(v))); }
constexpr int NSA2_WLDS = 4352;
#ifndef NSA_SPLIT
#define NSA_SPLIT 218
#endif
__device__ __forceinline__ void nsa_attn2(const Ctx& c, const PA& a, int layer, int part) {
    const unsigned char* ws = a.ws; const bf16* proj = (const bf16*)(ws + WS_PROJ); bf16* Y = (bf16*)(a.ws + WS_YNSA);
    LAS float* impA = (LAS float*)(c.lds + (part ? 4 * 28800 + (c.wave - 4) * NSA2_WLDS : (c.wave < 4 ? c.wave * 24576 : 4 * 24576 + (c.wave - 4) * NSA2_WLDS)));         LAS float* impB = impA; LAS int* KST = (LAS int*)(impA + 1040);
    const int lane = c.lane, r = lane & 15, q = lane >> 4, tk = r >> 2, hh = r & 3;
    const bool xdeal = (c.G & 7) == 0; const int xg = c.bx & 7, ntask = xdeal ? T / 8 : T; unsigned* qctr = (unsigned*)(a.ws + WS_CTL) + CW_NSAQ + (xdeal ? xg : 0) * 64 + layer * 1024 + part * 32;
    const int nsplit = (ntask * NSA_SPLIT) >> 8, tbeg = part ? nsplit : 0, tend = part ? ntask : nsplit;
    unsigned tk_ = 0; if (lane == 0) tk_ = __hip_atomic_fetch_add(qctr, 1u, __ATOMIC_RELAXED, __HIP_MEMORY_SCOPE_AGENT);
    for (;;) { const int task = tbeg + (int)__builtin_amdgcn_readfirstlane(tk_); if (task >= tend) break;
        if (lane == 0) tk_ = __hip_atomic_fetch_add(qctr, 1u, __ATOMIC_RELAXED, __HIP_MEMORY_SCOPE_AGENT);
        const int rt = ntask - 1 - task, tq = xdeal ? 2 * rt + (xg >> 2) : rt >> 2, g = xdeal ? (xg & 3) : (rt & 3), t0 = 4 * tq, tcol = t0 + tk;
        const bf16* prow = proj + (size_t)tcol * LDP;
        bf16x8 qf[2]; { const bf16* qp = prow + PC_NQ + (g * 4 + hh) * 64 + 8 * q; qf[0] = *(const bf16x8*)qp; qf[1] = *(const bf16x8*)(qp + 32); }
        float gt0, gt1, gt2; { const bf16* gp = prow + PC_GATE + (g * 4 + hh) * 3; gt0 = sigm(bf2f(gp[0])); gt1 = sigm(bf2f(gp[1])); gt2 = sigm(bf2f(gp[2])); }
        float qn; { float f0[8], f1[8], sq = 0.f; un8(__builtin_bit_cast(u32x4, qf[0]), f0); un8(__builtin_bit_cast(u32x4, qf[1]), f1);
#pragma unroll
            for (int i = 0; i < 8; ++i) sq += f0[i] * f0[i] + f1[i] * f1[i];
            qn = sqrtf(sum_x16_32(sq)); }
        float kmx[3]; { const unsigned* kw = (const unsigned*)(ws + WS_CTL) + CW_KMAX + layer * 64 + g;
            kmx[0] = __uint_as_float(kw[0]); kmx[1] = __uint_as_float(kw[4]); kmx[2] = __uint_as_float(kw[8]); }
        const int cur = t0 >> 6, ncv = tcol >= 31 ? ((tcol - 31) >> 4) + 1 : 0, ncvmax = t0 + 3 >= 31 ? ((t0 + 3 - 31) >> 4) + 1 : 0;
#pragma unroll
        for (int i = 0; i < 17; ++i) if (lane + 64 * i < 1040) impA[lane + 64 * i] = 0.f;
        LDS_WAIT();
        f32x4 yacc[4], O[4];
#pragma unroll
        for (int mt = 0; mt < 4; ++mt) yacc[mt] = (f32x4){0.f, 0.f, 0.f, 0.f};
        if (ncvmax > 0) {
            NsaSrc sc; sc.kf = (const bf16*)(ws + WS_KCMPB) + (size_t)g * 16 * 4096; sc.vf = (const bf16*)(ws + WS_VCMPT) + (size_t)g * 16 * 4096;
            const int nb = (ncvmax + 63) >> 6; float m = qn * kmx[2], l = 0.f;
#define K0_CMP(b) (64 * (b))
            const int ncvmin = t0 >= 31 ? ((t0 - 31) >> 4) + 1 : 0;
            NSA_LOOP(0, sc, nb, K0_CMP, 0, ncv - 1, 0, ncvmin - 1, 0.f);
            l = sum_x16_32(l); const float inv = l > 0.f ? 1.f / l : 0.f;
#pragma unroll
            for (int mt = 0; mt < 4; ++mt) O[mt] = (f32x4){0.f, 0.f, 0.f, 0.f};
            NSA_LOOP(2, sc, nb, K0_CMP, 0, ncv - 1, 0, ncvmin - 1, inv);
#pragma unroll
            for (int mt = 0; mt < 4; ++mt) yacc[mt] = O[mt] * gt0;
        }
        LDS_WAIT();
        const unsigned char* ss8 = ws + WS_KF8 + (size_t)g * 256 * 4096; const unsigned char* sv8 = ws + WS_VF8 + (size_t)g * 256 * 4096;
        NsaSrc ss; ss.kf = (const bf16*)(ws + WS_KFS) + (size_t)g * 256 * 4096; ss.vf = (const bf16*)(ws + WS_VFS) + (size_t)g * 256 * 4096;
        f32x4 Oj[4]; const float mj = qn * kmx[0]; float lj = 0.f; const int nf = cur >= 2 ? 3 : cur + 1;
        { float m = mj, l = 0.f;
#pragma unroll
            for (int mt = 0; mt < 4; ++mt) O[mt] = (f32x4){0.f, 0.f, 0.f, 0.f};
#define K0_FRC(b) (64 * ((b) == 0 ? 0 : cur - (nf - 1) + (b)))
            NSA_LOOP(1, ss, nf, K0_FRC, 0, tcol, 0, t0, 0.f);
#pragma unroll
            for (int mt = 0; mt < 4; ++mt) Oj[mt] = O[mt];
            lj = l; }
        const float ljs = sum_x16_32(lj);
#pragma unroll 1
        for (int k = 0; k < 4; ++k) {
            const int hd = r >> 2, s4 = r & 3;
            bf16x8 qd[2]; { const bf16* qp = proj + (size_t)(t0 + k) * LDP + PC_NQ + (g * 4 + hd) * 64 + 8 * q; qd[0] = *(const bf16x8*)qp; qd[1] = *(const bf16x8*)(qp + 32); }
            u32x4 kfp[4], vap[4];
            float scv[4];
#pragma unroll
            for (int mm = 0; mm < 4; ++mm) { const int j = 4 * lane + mm; float s = -1.0e30f;
                if (j <= cur && !(j == 0 || j == cur || j == cur - 1)) s = impA[k * 260 + j];
                scv[mm] = s; }
            int nsel = 0;
            for (int itk = 0; itk < 16 - nf; ++itk) {
                float lv = scv[0]; int lj2 = 4 * lane;
                if (scv[1] > lv) { lv = scv[1]; lj2 = 4 * lane + 1; } if (scv[2] > lv) { lv = scv[2]; lj2 = 4 * lane + 2; } if (scv[3] > lv) { lv = scv[3]; lj2 = 4 * lane + 3; }
                const float vmax = wave_max(lv); if (vmax < -5.0e29f) break;
                const int jmin = wave_min_i(lv == vmax ? lj2 : (1 << 30));
                if (lane == 0) KST[itk] = jmin * 64;
                if (itk == 0) { const int k0f = __builtin_amdgcn_readfirstlane(jmin) * 64; nsa_loadK8(ss8, k0f, kfp, lane); nsa_loadV8(sv8, k0f, vap, lane); }
                if ((jmin >> 2) == lane) { const int mm = jmin & 3; if (mm == 0) scv[0] = -3.0e38f; else if (mm == 1) scv[1] = -3.0e38f; else if (mm == 2) scv[2] = -3.0e38f; else scv[3] = -3.0e38f; }
                ++nsel; }
            LDS_WAIT();
            { const bool mine = tk == k; const int srcl = (lane & 48) | (hh << 2) | tk;
                long q8[2];
#pragma unroll
                for (int ks = 0; ks < 2; ++ks) { float f[8]; un8(__builtin_bit_cast(u32x4, qd[ks]), f); q8[ks] = __builtin_bit_cast(long, (u32x2){pack4_fp8(4.f * f[0], 4.f * f[1], 4.f * f[2], 4.f * f[3]), pack4_fp8(4.f * f[4], 4.f * f[5], 4.f * f[6], 4.f * f[7])}); }
                const int srck = (lane & 48) | (k << 2) | hd;
                const float ljk = lane_get(ljs, srck), nj = (float)(129 + t0 + k - 64 * cur);
                const float kap = ljk > 0.f ? fminf(fmaxf(1.f + __builtin_amdgcn_logf(nj) - __builtin_amdgcn_logf(ljk), 0.f), 100.f) : 0.f, sk = __builtin_amdgcn_exp2f(-kap);
                const float cmd = NSA_C * lane_get(mj, srck) - kap;
                float ld = 0.f;
#pragma unroll
                for (int mt = 0; mt < 4; ++mt) O[mt] = (f32x4){0.f, 0.f, 0.f, 0.f};
#define K0_SEL(b) (__builtin_amdgcn_readfirstlane(KST[b]))
                NSA_LOOP_DENSE(ss8, sv8, nsel, K0_SEL, q8, cmd, ld, s4, kfp, vap);
                ld = sum_x16_32(sum_x1_2(ld)) * sk;
                const float l = ljs + lane_get(ld, srcl), sc = mine ? gt1 / l : 0.f;
#pragma unroll
                for (int mt = 0; mt < 4; ++mt)
#pragma unroll
                    for (int i = 0; i < 4; ++i) { const float od = lane_get(sum_x1_2(O[mt][i]) * (0.25f * sk), srcl);        yacc[mt][i] += (Oj[mt][i] + od) * sc; } }
            LDS_WAIT();
        }
        { NsaSrc sw; sw.kf = (const bf16*)(ws + WS_KFW) + (size_t)g * 256 * 4096; sw.vf = (const bf16*)(ws + WS_VFW) + (size_t)g * 256 * 4096;
            { const bf16* qp = prow + PC_NQ + (g * 4 + hh) * 64 + 8 * q; qf[0] = *(const bf16x8*)qp; qf[1] = *(const bf16x8*)(qp + 32); }
            float m = qn * kmx[1], l = 0.f; const int wlo = tcol - 511 > 0 ? tcol - 511 : 0, ulo = t0 - 511 > 0 ? t0 - 511 : 0;
#pragma unroll
            for (int mt = 0; mt < 4; ++mt) O[mt] = (f32x4){0.f, 0.f, 0.f, 0.f};
            const int jb0 = ulo >> 6;
#define K0_WIN(b) (64 * (jb0 + (b)))
            NSA_LOOP(1, sw, cur - jb0 + 1, K0_WIN, wlo, tcol, (t0 + 3 - 511 > 0 ? t0 + 3 - 511 : 0), t0, 0.f);
            l = sum_x16_32(l); const float sc = gt2 / l;
#pragma unroll
            for (int mt = 0; mt < 4; ++mt) yacc[mt] += O[mt] * sc; }
#pragma unroll
        for (int mt = 0; mt < 4; ++mt) { uint2 w; w.x = pg8::cvt_pk_bf16(yacc[mt][0], yacc[mt][1]); w.y = pg8::cvt_pk_bf16(yacc[mt][2], yacc[mt][3]);
            *(uint2*)(Y + (size_t)tcol * 1024 + (g * 4 + hh) * 64 + 16 * mt + 4 * q) = w; }
    }
}
__device__ __forceinline__ void prep_tiles(const Ctx& c, const PA& a, int layer) {
    const bf16* proj = (const bf16*)(a.ws + WS_PROJ);
    LAS bf16* tile = (LAS bf16*)(c.lds + c.wave * 8704);
    const int lane = c.lane, r = lane & 15, q = lane >> 4;
    for (int it = c.gw; it < 4 * 4 * 256; it += c.NGW) { const int blk = it & 255, g = (it >> 8) & 3, ten = it >> 10;
        const int scol = (ten == 0 ? PC_KS : (ten == 1 ? PC_VS : (ten == 2 ? PC_KW : PC_VW))) + g * 64;
        const u32x4* sp = (const u32x4*)(proj + (size_t)(blk * 64 + lane) * LDP + scol);
        float nq_ = 0.f;
#pragma unroll
        for (int i = 0; i < 8; ++i) { const u32x4 v = sp[i]; LAS unsigned* tp = (LAS unsigned*)(tile + lane * 66 + 8 * i); tp[0] = v.x; tp[1] = v.y; tp[2] = v.z; tp[3] = v.w;
            float f[8]; un8(v, f);
#pragma unroll
            for (int j = 0; j < 8; ++j) nq_ += f[j] * f[j]; }
        if ((ten & 1) == 0) { const float nm = wave_max(sqrtf(nq_)); if (lane == 0) atomicMax((unsigned*)(a.ws + WS_CTL) + CW_KMAX + layer * 64 + (ten >> 1) * 4 + g, __float_as_uint(nm)); }
        LDS_WAIT();
        bf16* dst = (bf16*)(a.ws + (ten == 0 ? WS_KFS : (ten == 1 ? WS_VFS : (ten == 2 ? WS_KFW : WS_VFW)))) + ((size_t)(g * 256 + blk) * 8) * 512 + lane * 8;
        if (ten == 0) {
            unsigned char* d8 = a.ws + WS_KF8 + ((size_t)(g * 256 + blk) * 4) * 1024 + lane * 16;
#pragma unroll
            for (int j = 0; j < 4; ++j) { unsigned w[4];
#pragma unroll
                for (int ks = 0; ks < 2; ++ks) { const LAS unsigned* tp = (const LAS unsigned*)(tile + (16 * j + r) * 66 + 32 * ks + 8 * q); float f[8]; un8((u32x4){tp[0], tp[1], tp[2], tp[3]}, f);
                    w[2 * ks] = pack4_fp8(4.f * f[0], 4.f * f[1], 4.f * f[2], 4.f * f[3]); w[2 * ks + 1] = pack4_fp8(4.f * f[4], 4.f * f[5], 4.f * f[6], 4.f * f[7]); }
                *(u32x4*)(d8 + j * 1024) = (u32x4){w[0], w[1], w[2], w[3]}; } }
        if (ten == 1) {
            unsigned char* d8 = a.ws + WS_VF8 + ((size_t)(g * 256 + blk) * 4) * 1024 + lane * 16;
#pragma unroll
            for (int mt = 0; mt < 4; ++mt) { unsigned w[4];
#pragma unroll
                for (int ks = 0; ks < 2; ++ks)
#pragma unroll
                    for (int h = 0; h < 2; ++h) { const int k0 = 32 * ks + 16 * h + 4 * q; const LAS bf16* tp = tile + k0 * 66 + 16 * mt + r;
                        w[2 * ks + h] = pack4_fp8(4.f * bf2f(tp[0]), 4.f * bf2f(tp[66]), 4.f * bf2f(tp[132]), 4.f * bf2f(tp[198])); }
                *(u32x4*)(d8 + mt * 1024) = (u32x4){w[0], w[1], w[2], w[3]}; } }
        if ((ten & 1) == 0) {
#pragma unroll
            for (int j = 0; j < 4; ++j)
#pragma unroll
                for (int ks = 0; ks < 2; ++ks) { const LAS unsigned* tp = (const LAS unsigned*)(tile + (16 * j + r) * 66 + 32 * ks + 8 * q);
                    *(u32x4*)(dst + (2 * j + ks) * 512) = (u32x4){tp[0], tp[1], tp[2], tp[3]}; }
        } else {
#pragma unroll
            for (int mt = 0; mt < 4; ++mt)
#pragma unroll
                for (int ks = 0; ks < 2; ++ks) { unsigned w[4];
#pragma unroll
                    for (int h = 0; h < 2; ++h)
#pragma unroll
                        for (int i2 = 0; i2 < 2; ++i2) { const int k0 = 32 * ks + 16 * h + 4 * q + 2 * i2;
                            w[2 * h + i2] = (unsigned)tile[k0 * 66 + 16 * mt + r] | ((unsigned)tile[(k0 + 1) * 66 + 16 * mt + r] << 16); }
                    *(u32x4*)(dst + (2 * mt + ks) * 512) = (u32x4){w[0], w[1], w[2], w[3]}; }
        }
        LDS_WAIT();
    }
}

__device__ __forceinline__ void ln_row(f32x4 (&v)[8], const float* gam, const float* bet, int lane) {
    float s = 0.f;
#pragma unroll
    for (int j = 0; j < 8; ++j) s += (v[j][0] + v[j][1]) + (v[j][2] + v[j][3]);
    const float mean = wave_sum(s) * (1.f / D); float s2 = 0.f;
#pragma unroll
    for (int j = 0; j < 8; ++j) { v[j] = v[j] - mean; s2 += (v[j][0] * v[j][0] + v[j][1] * v[j][1]) + (v[j][2] * v[j][2] + v[j][3] * v[j][3]); }
    const float rstd = 1.f / sqrtf(wave_sum(s2) * (1.f / D) + LN_EPS);
#pragma unroll
    for (int j = 0; j < 8; ++j) { const f32x4 g4 = *(const f32x4*)(gam + 4 * (lane + 64 * j)), b4 = *(const f32x4*)(bet + 4 * (lane + 64 * j)); v[j] = v[j] * rstd * g4 + b4; }
}
__device__ __forceinline__ void ph_ln1(const Ctx& c, const PA& a, int layer) {
    unsigned char* ws = a.ws; float* X = a.out; uint2* xb = (uint2*)(ws + WS_XB); const int lane = c.lane;
    for (int it = c.bx; it < T / 8; it += c.G) { const int t = it * 8 + c.wave;
        f32x4* row = (f32x4*)(X + (size_t)t * D); f32x4 v[8];
#pragma unroll
        for (int j = 0; j < 8; ++j) v[j] = row[lane + 64 * j];
        ln_row(v, a.in(25) + layer * D, a.in(26) + layer * D, lane);
#pragma unroll
        for (int j = 0; j < 8; ++j) { row[lane + 64 * j] = v[j]; xb[(size_t)t * (D / 4) + lane + 64 * j] = make_uint2(pk2(v[j][0], v[j][1]), pk2(v[j][2], v[j][3])); } }
}
__device__ __forceinline__ void ph_route(const Ctx& c, const PA& a, int layer) {
    unsigned char* ws = a.ws; const float* X = a.out;
    LAS float* lg = (LAS float*)(c.lds + c.wave * 256); LAS float* xr = (LAS float*)(c.lds + 4096 + c.wave * 8192); LAS float* wb = (LAS float*)(c.lds + 4096 + 65536);
    const int lane = c.lane, tid = c.tid, r0 = tid >> 3, p0_ = tid & 7;
    for (int it = c.bx; it < T / 8; it += c.G) { const int t = it * 8 + c.wave;
        const float* we = a.in(29) + (size_t)layer * D * 32; const float* wg = a.in(27) + (size_t)layer * D * 4;
        { const f32x4* row = (const f32x4*)(X + (size_t)t * D);
#pragma unroll
            for (int j = 0; j < 8; ++j) *(LAS f32x4*)(xr + 4 * (lane + 64 * j)) = row[lane + 64 * j];
#pragma unroll
            for (int i = 0; i < 4; ++i) *(LAS f32x4*)(wb + (r0 + 64 * i) * 36 + 4 + 4 * p0_) = *(const f32x4*)(we + (size_t)(r0 + 64 * i) * 32 + 4 * p0_);
            if (tid < 256) *(LAS f32x4*)(wb + tid * 36) = *(const f32x4*)(wg + (size_t)tid * 4); }
        __syncthreads();
        f32x4 acc[9];
#pragma unroll
        for (int q = 0; q < 9; ++q) acc[q] = (f32x4){0.f, 0.f, 0.f, 0.f};
#pragma unroll 1
        for (int ck = 0; ck < 8; ++ck) { const LAS float* wc = wb + (ck & 1) * 9216; LAS float* wn = wb + ((ck + 1) & 1) * 9216;
            const int d0 = ck + 1 < 8 ? 256 * (ck + 1) : 0;
            const f32x4 ne0 = *(const f32x4*)(we + (size_t)(d0 + r0) * 32 + 4 * p0_), ne1 = *(const f32x4*)(we + (size_t)(d0 + r0 + 64) * 32 + 4 * p0_),
                        ne2 = *(const f32x4*)(we + (size_t)(d0 + r0 + 128) * 32 + 4 * p0_), ne3 = *(const f32x4*)(we + (size_t)(d0 + r0 + 192) * 32 + 4 * p0_), ng = *(const f32x4*)(wg + (size_t)(d0 + (tid & 255)) * 4);
#pragma unroll
            for (int i = 0; i < 4; ++i) { const int dl = lane + 64 * i; const float x = xr[256 * ck + dl]; const LAS float* wr = wc + dl * 36;
#pragma unroll
                for (int q = 0; q < 9; ++q) acc[q] += *(const LAS f32x4*)(wr + 4 * q) * x;
                __builtin_amdgcn_sched_barrier(0); }
            *(LAS f32x4*)(wn + r0 * 36 + 4 + 4 * p0_) = ne0; *(LAS f32x4*)(wn + (r0 + 64) * 36 + 4 + 4 * p0_) = ne1; *(LAS f32x4*)(wn + (r0 + 128) * 36 + 4 + 4 * p0_) = ne2; *(LAS f32x4*)(wn + (r0 + 192) * 36 + 4 + 4 * p0_) = ne3;
            if (tid < 256) *(LAS f32x4*)(wn + tid * 36) = ng;
            __syncthreads(); }
        f32x4 ag = acc[0];
#pragma unroll
        for (int q = 0; q < 4; ++q) ag[q] = wave_sum(ag[q]) + a.in(28)[layer * 4 + q];
#pragma unroll
        for (int e4 = 0; e4 < 8; ++e4)
#pragma unroll
            for (int q = 0; q < 4; ++q) acc[1 + e4][q] = wave_sum(acc[1 + e4][q]);
        if (lane == 0) {
#pragma unroll
            for (int e4 = 0; e4 < 8; ++e4)
#pragma unroll
                for (int q = 0; q < 4; ++q) lg[e4 * 4 + q] = acc[1 + e4][q] + a.in(30)[layer * 32 + e4 * 4 + q]; }
        LDS_WAIT();
        int grp = 0; float gm = ag[0];
        if (ag[1] > gm) { gm = ag[1]; grp = 1; } if (ag[2] > gm) { gm = ag[2]; grp = 2; } if (ag[3] > gm) { gm = ag[3]; grp = 3; }
        const float gw_ = 1.f / (expf(ag[0] - gm) + expf(ag[1] - gm) + expf(ag[2] - gm) + expf(ag[3] - gm));
        float v0 = -3.0e38f, v1 = -3.0e38f; int i0 = 0, i1 = 0;
        for (int i = 0; i < 8; ++i) { const float x = lg[grp * 8 + i];
            if (x > v0) { v1 = v0; i1 = i0; v0 = x; i0 = i; } else if (x > v1) { v1 = x; i1 = i; } }
        const float e1 = expf(v1 - v0), p0 = 1.f / (1.f + e1), p1 = e1 * p0;
        if (lane == 0) { int* toke = (int*)(ws + WS_TOKE); float* tokw = (float*)(ws + WS_TOKW); unsigned* cnt = (unsigned*)(ws + WS_CTL) + CW_CNT + layer * 128; toke[2 * t] = grp * 8 + i0; toke[2 * t + 1] = grp * 8 + i1; tokw[2 * t] = p0 * gw_; tokw[2 * t + 1] = p1 * gw_;
            __hip_atomic_fetch_add(cnt + grp * 8 + i0, 1u, __ATOMIC_RELAXED, __HIP_MEMORY_SCOPE_AGENT); __hip_atomic_fetch_add(cnt + grp * 8 + i1, 1u, __ATOMIC_RELAXED, __HIP_MEMORY_SCOPE_AGENT); }
        __syncthreads();
    }
}
__device__ __forceinline__ void ph_slot(const Ctx& c, const PA& a, int layer) {
    unsigned char* ws = a.ws; unsigned* cnt = (unsigned*)(ws + WS_CTL) + CW_CNT + layer * 128; unsigned* cur = (unsigned*)(ws + WS_CTL) + CW_CUR + layer * 128;
    int* texp = (int*)(ws + WS_TEXP) + layer * 512; const int* toke = (const int*)(ws + WS_TOKE); int* slot = (int*)(ws + WS_SLOT);
    LAS int* pst = (LAS int*)c.lds; LAS int* ptl = pst + 64;
    if (c.tid < NEXP) ptl[c.tid] = ((int)__hip_atomic_load(cnt + c.tid, __ATOMIC_RELAXED, __HIP_MEMORY_SCOPE_AGENT) + 255) >> 8;
    __syncthreads();
    if (c.tid == 0) { int off = 0, nt = 0;
#pragma unroll 1
        for (int e = 0; e < NEXP; ++e) { const int tl = ptl[e];
            pst[e] = off; off += tl * 256;
            if (c.bx == 0) for (int q = 0; q < tl; ++q) texp[nt + q] = e;
            nt += tl; }
        if (c.bx == 0) texp[255] = nt; }
    __syncthreads();
    const u32x4* xb = (const u32x4*)(ws + WS_XB); u32x4* xs = (u32x4*)(ws + WS_XS);
    for (int a0 = c.gw * 16; a0 < 2 * T; a0 += c.NGW * 16) {
        int s = 0;
        if (c.lane < 16) { const int e = toke[a0 + c.lane]; s = pst[e] + (int)__hip_atomic_fetch_add(cur + e, 1u, __ATOMIC_RELAXED, __HIP_MEMORY_SCOPE_AGENT); slot[a0 + c.lane] = s; }
#pragma unroll 2
        for (int i = 0; i < 16; i += 2) { const int s0 = __builtin_amdgcn_readlane(s, i), s1 = __builtin_amdgcn_readlane(s, i + 1), t0 = (a0 + i) >> 1, t1 = (a0 + i + 1) >> 1;
            u32x4 v0[4], v1[4];
#pragma unroll
            for (int j = 0; j < 4; ++j) { v0[j] = xb[(size_t)t0 * 256 + c.lane + 64 * j]; v1[j] = xb[(size_t)t1 * 256 + c.lane + 64 * j]; }
#pragma unroll
            for (int j = 0; j < 4; ++j) { xs[(size_t)s0 * 256 + c.lane + 64 * j] = v0[j]; xs[(size_t)s1 * 256 + c.lane + 64 * j] = v1[j]; } } }
}
__device__ __forceinline__ void ph_ln2(const Ctx& c, const PA& a, int layer) {
    unsigned char* ws = a.ws; float* X = a.out; uint2* xb = (uint2*)(ws + WS_XB); const uint2* ys = (const uint2*)(ws + WS_YS);
    const float* gam = a.in(34) + layer * D; const float* bet = a.in(35) + layer * D; const int* slot = (const int*)(ws + WS_SLOT); const float* tokw = (const float*)(ws + WS_TOKW);
    const int lane = c.lane;
    for (int t = c.gw; t < T; t += c.NGW) {
        const int s0 = slot[2 * t], s1 = slot[2 * t + 1]; const float w0 = tokw[2 * t], w1 = tokw[2 * t + 1];
        f32x4* row = (f32x4*)(X + (size_t)t * D); f32x4 v[8];
#pragma unroll
        for (int j = 0; j < 8; ++j) { const uint2 y0 = ys[(size_t)s0 * 512 + lane + 64 * j], y1 = ys[(size_t)s1 * 512 + lane + 64 * j]; const f32x4 x = row[lane + 64 * j];
            v[j][0] = x[0] * DN_ALPHA + w0 * bflo(y0.x) + w1 * bflo(y1.x); v[j][1] = x[1] * DN_ALPHA + w0 * bfhi(y0.x) + w1 * bfhi(y1.x);
            v[j][2] = x[2] * DN_ALPHA + w0 * bflo(y0.y) + w1 * bflo(y1.y); v[j][3] = x[3] * DN_ALPHA + w0 * bfhi(y0.y) + w1 * bfhi(y1.y); }
        ln_row(v, gam, bet, lane);
#pragma unroll
        for (int j = 0; j < 8; ++j) { row[lane + 64 * j] = v[j]; xb[(size_t)t * (D / 4) + lane + 64 * j] = make_uint2(pk2(v[j][0], v[j][1]), pk2(v[j][2], v[j][3])); }
    }
}

enum { PH_CONV = 0, PH_INPROJ, PH_PREP, PH_LORA, PH_SCAN1, PH_SCAN2, PH_SCAN3, PH_GATES, PH_BRANCH, PH_OUT, PH_LN1, PH_SLOT, PH_MOE_GU, PH_MOE_DN, PH_LN2, NPH_L };
constexpr int NPH = NPH_L * DEPTH;

__device__ __forceinline__ Ctx mkctx(LAS unsigned char* lds, int wv) {
    int ln; asm volatile("v_mbcnt_lo_u32_b32 %0, -1, 0\n\tv_mbcnt_hi_u32_b32 %0, -1, %0" : "=v"(ln));
    int tid = wv * 64 + ln, bx = blockIdx.x, G = gridDim.x;
    asm volatile("" : "+s"(bx)); asm volatile("" : "+s"(G));
    Ctx c; c.lds = lds; c.tid = tid; c.lane = tid & 63; c.wave = __builtin_amdgcn_readfirstlane(tid >> 6); c.G = G; c.bx = bx; c.gw = bx * 8 + c.wave; c.NGW = G * 8; return c;
}
__global__ void __launch_bounds__(512, 2) fwd(Args args0) {
    extern __shared__ __attribute__((aligned(16))) unsigned char lds_raw[];
    LAS unsigned char* const lds0 = (LAS unsigned char*)lds_raw;
    const int lo = args0.ph_lo, hi = args0.ph_hi;
    const int wv0 = __builtin_amdgcn_readfirstlane(threadIdx.x >> 6);
    if (threadIdx.x < 36) ((LAS unsigned long long*)(lds0 + LDS_PTAB))[threadIdx.x] = (unsigned long long)args0.in[threadIdx.x];
    __syncthreads();
#if MK_ONE_LAUNCH
    volatile LAS unsigned* barw = (volatile LAS unsigned*)(lds0 + LDS_BARW);
    if (threadIdx.x == 0) { barw[0] = 0u; barw[1] = 0u; barw[2] = 0u; barw[3] = 0u; }
    __syncthreads();
    XcdBarrier bar = xcd_barrier_post((unsigned*)(args0.ws + WS_CTL) + CW_BAR, barw);
#define SEAM(p) do { if ((p) + 1 < hi) xcd_barrier(bar); } while (0)
#else
#define SEAM(p) do { } while (0)
#endif
#ifndef ONLY_PHASE
#define ONLY_PHASE -1
#endif
#define PHASE_BEGIN PA args; { unsigned long long w_ = (unsigned long long)args0.ws; asm volatile("" : "+s"(w_)); args.ws = (unsigned char*)(GAS unsigned char*)w_; unsigned long long o_ = (unsigned long long)args0.out; asm volatile("" : "+s"(o_)); args.out = (float*)(GAS float*)o_; args.tab = (const LAS unsigned*)(lds0 + LDS_PTAB); } unsigned char* const ws = args.ws; const Ctx c = mkctx(lds0, wv0); (void)ws; (void)c;
#define TASK_CTX() mkctx(lds0, wv0)
#ifdef TIME_PHASE
    unsigned long long tp_a_ = 0ull, tp_b_ = 0ull;
#define TP_BEGIN(p) do { if ((TIME_PHASE >> ((p) % NPH_L)) & 1) tp_a_ = __builtin_amdgcn_s_memrealtime(); } while (0)
#define TP_END(p) do { if ((TIME_PHASE >> ((p) % NPH_L)) & 1) tp_b_ += __builtin_amdgcn_s_memrealtime() - tp_a_; } while (0)
#else
#define TP_BEGIN(p) do { } while (0)
#define TP_END(p) do { } while (0)
#endif
#define IN(p) ((ONLY_PHASE < 0 || ONLY_PHASE == ((p) - pb)) && lo <= (p) && (p) < hi)
    for (int layer = 0; layer < DEPTH; ++layer) {
        const int pb = layer * NPH_L;
        if (IN(pb + PH_CONV)) { TP_BEGIN(pb + PH_CONV); PHASE_BEGIN ph_conv(c, args, layer); __syncthreads(); SEAM(pb + PH_CONV); TP_END(pb + PH_CONV); }
        if (IN(pb + PH_INPROJ)) { TP_BEGIN(pb + PH_INPROJ); PHASE_BEGIN
            Gemm g{D, D, D}; SchedPlain S; S.to.init(T / 256, PC_GATE / 256); S.G = c.G; S.c = c.bx; S.tid = c.tid; S.A = (const char*)(ws + WS_XB); S.B = (const char*)(ws + WS_WIN); S.ta = (size_t)256 * D * 2; S.tb = (size_t)256 * D * 2;
            EpiStore<0> E{(bf16*)(ws + WS_PROJ), LDP};
            pg8::gemm_phase<EpiStore<0>, SchedPlain, PG8_ALIGN, PG8_SP2>(c.lds, g, S, E);
#ifdef REP_GEMM
            pg8::gemm_phase<EpiStore<0>, SchedPlain, PG8_ALIGN, PG8_SP2>(c.lds, g, S, E);
#endif
            { const Ctx c2 = TASK_CTX(); int k2_ = D / 4; asm volatile("" : "+s"(k2_)); Gemm g2{k2_, D, D}; SchedSplitK S2; S2.G = c2.G; S2.c = c2.bx; S2.tid = c2.tid; S2.n = (T / 256) * 4; S2.A = (const char*)(ws + WS_XB); S2.B = (const char*)(ws + WS_WIN) + (size_t)PC_GATE * D * 2; S2.ta = (size_t)256 * D * 2; S2.kb = (size_t)(D / 4) * 2;
                EpiPart48 E2{(float*)(ws + WS_GPART)};
                pg8::gemm_phase<EpiPart48, SchedSplitK, PG8_ALIGN, PG8_SP2>(c2.lds, g2, S2, E2); }
            SEAM(pb + PH_INPROJ); TP_END(pb + PH_INPROJ); }
        if (IN(pb + PH_PREP)) { TP_BEGIN(pb + PH_PREP); PHASE_BEGIN
            { const float* gpart = (const float*)(ws + WS_GPART); bf16* pj = (bf16*)(ws + WS_PROJ);
#pragma unroll 1
                for (int i = c.bx * 512 + c.tid; i < T * 48; i += c.G * 512) { const int t = i / 48, cc = i - t * 48;
                    const float sgl = (gpart[i] + gpart[(size_t)T * 48 + i]) + (gpart[(size_t)2 * T * 48 + i] + gpart[(size_t)3 * T * 48 + i]);
                    pj[(size_t)t * LDP + PC_GATE + cc] = (bf16)f2bf(sgl); } }
            prep_rwkv(TASK_CTX(), args, layer); __syncthreads();
#ifdef REP_PRW
            prep_rwkv(TASK_CTX(), args, layer); __syncthreads();
#endif
#ifdef REP_PCMP
            prep_cmp(TASK_CTX(), args, layer);
#endif
#ifdef REP_PTILES
            prep_tiles(TASK_CTX(), args, layer); __syncthreads();
#endif
 prep_cmp(TASK_CTX(), args, layer); prep_rope(TASK_CTX(), args); prep_ret_frags(TASK_CTX(), args); __syncthreads(); prep_tiles(TASK_CTX(), args, layer);
#ifdef REP_RETPREP
            prep_ret_frags(TASK_CTX(), args, true); prep_ret_frags(TASK_CTX(), args, true);
#endif
 __syncthreads(); SEAM(pb + PH_PREP); TP_END(pb + PH_PREP); }
        if (IN(pb + PH_LORA)) { TP_BEGIN(pb + PH_LORA); PHASE_BEGIN
            int kl_ = 256; asm volatile("" : "+s"(kl_));
            Gemm g{kl_, 1024, 256}; SchedLora S; S.to.init(T / 256, layer ? 16 : 12); S.G = c.G; S.c = c.bx; S.tid = c.tid; S.A = (const char*)(ws + WS_ALORA); S.B = (const char*)(ws + WS_WLORA);
            EpiLora E{ws, args, layer};
            pg8::gemm_phase<EpiLora, SchedLora, PG8_ALIGN, PG8_SP2>(c.lds, g, S, E);
            SEAM(pb + PH_LORA); TP_END(pb + PH_LORA); }
#ifdef TIME_P1
        if (IN(pb + PH_SCAN1)) { PHASE_BEGIN tp_a_ = __builtin_amdgcn_s_memrealtime(); rw_pass1(c, args);
#else
        if (IN(pb + PH_SCAN1)) { TP_BEGIN(pb + PH_SCAN1); PHASE_BEGIN __builtin_amdgcn_s_setprio(2); rw_pass1(c, args); __builtin_amdgcn_s_setprio(0);
#endif
#if defined(REP_RW) || defined(REP_P1)
            rw_pass1(TASK_CTX(), args);
#endif
 ret_kv(TASK_CTX(), args);
#ifdef TIME_P1
 tp_b_ += __builtin_amdgcn_s_memrealtime() - tp_a_;
#endif
 nsa_attn2(TASK_CTX(), args, layer, 0); __syncthreads();

 SEAM(pb + PH_SCAN1); TP_END(pb + PH_SCAN1); }
        if (IN(pb + PH_SCAN2)) { TP_BEGIN(pb + PH_SCAN2); PHASE_BEGIN rw_pass2(c, args);
#if defined(REP_RW) || defined(REP_P2)
            rw_pass2(TASK_CTX(), args);
#endif
 ret_prefix(TASK_CTX(), args);
#ifdef REP_PFX
            ret_prefix(TASK_CTX(), args); ret_prefix(TASK_CTX(), args);
#endif
 __syncthreads(); SEAM(pb + PH_SCAN2); TP_END(pb + PH_SCAN2); }
        if (IN(pb + PH_SCAN3)) { TP_BEGIN(pb + PH_SCAN3); PHASE_BEGIN __builtin_amdgcn_s_setprio(2); rw_pass3(c, args, layer); __builtin_amdgcn_s_setprio(0); ret_out(TASK_CTX(), args, 4, 4); { const Ctx cn = TASK_CTX(); if (cn.wave >= 4) nsa_attn2(cn, args, layer, 1); }        __syncthreads(); SEAM(pb + PH_SCAN3); TP_END(pb + PH_SCAN3); }
        if (IN(pb + PH_GATES)) { TP_BEGIN(pb + PH_GATES); PHASE_BEGIN
            Gemm g{D, D, D}; SchedPlain S; S.to.init(T / 256, NG / 256); S.G = c.G; S.c = c.bx; S.tid = c.tid; S.A = (const char*)(ws + WS_XB); S.B = (const char*)(ws + WS_WG); S.ta = (size_t)256 * D * 2; S.tb = (size_t)256 * D * 2;
            EpiStore<1> E{(bf16*)(ws + WS_GATES), NG};
            pg8::gemm_phase<EpiStore<1>, SchedPlain, PG8_ALIGN, PG8_SP2>(c.lds, g, S, E);
#ifdef REP_GEMM
            pg8::gemm_phase<EpiStore<1>, SchedPlain, PG8_ALIGN, PG8_SP2>(c.lds, g, S, E);
#endif
            SEAM(pb + PH_GATES); TP_END(pb + PH_GATES); }
        if (IN(pb + PH_BRANCH)) { TP_BEGIN(pb + PH_BRANCH); PHASE_BEGIN
            Gemm g{RWW, RWW, RWW}; SchedBranch S; S.to.init(T / 256, D / 256); S.G = c.G; S.c = c.bx; S.tid = c.tid;
            S.A0 = (const char*)(ws + WS_YRW); S.sa = WS_YNSA - WS_YRW; static_assert(WS_YRET - WS_YNSA == WS_YNSA - WS_YRW, "y buffers equally spaced");
            S.B0 = (const char*)(ws + WS_WBR); S.sb = (size_t)D * RWW * 2; S.ta = (size_t)256 * RWW * 2; S.tb = (size_t)256 * RWW * 2;
            EpiBranch E{(bf16*)(ws + WS_MERGED), (const bf16*)(ws + WS_GATES)};
            pg8::gemm_phase<EpiBranch, SchedBranch, PG8_ALIGN, PG8_SP2>(c.lds, g, S, E);
            SEAM(pb + PH_BRANCH); TP_END(pb + PH_BRANCH); }
        if (IN(pb + PH_OUT)) { TP_BEGIN(pb + PH_OUT); PHASE_BEGIN
            Gemm g{D, D, D}; SchedPlain S; S.to.init(T / 256, D / 256); S.G = c.G; S.c = c.bx; S.tid = c.tid; S.A = (const char*)(ws + WS_MERGED); S.B = (const char*)(ws + WS_WOUT); S.ta = (size_t)256 * D * 2; S.tb = (size_t)256 * D * 2;
            EpiResid E{args.out};
            pg8::gemm_phase<EpiResid, SchedPlain, PG8_ALIGN, PG8_SP2>(c.lds, g, S, E);
            SEAM(pb + PH_OUT); TP_END(pb + PH_OUT); }
        if (IN(pb + PH_LN1)) { TP_BEGIN(pb + PH_LN1); PHASE_BEGIN ph_ln1(c, args, layer); __syncthreads(); ph_route(TASK_CTX(), args, layer); __syncthreads(); ph_conv_moe(TASK_CTX(), args, layer); __syncthreads();
#ifdef REP_CMOE
            ph_conv_moe(TASK_CTX(), args, layer); __syncthreads();
#endif
            SEAM(pb + PH_LN1); TP_END(pb + PH_LN1); }
        if (IN(pb + PH_SLOT)) { TP_BEGIN(pb + PH_SLOT); PHASE_BEGIN ph_slot(c, args, layer); __syncthreads(); SEAM(pb + PH_SLOT); TP_END(pb + PH_SLOT); }
        if (IN(pb + PH_MOE_GU)) { TP_BEGIN(pb + PH_MOE_GU); PHASE_BEGIN
            const int* texp = (const int*)(ws + WS_TEXP) + layer * 512;
            Gemm g{D, D, D}; SchedMoe S; S.nM = texp[255]; S.nN = 4; S.G = c.G; S.c = c.bx; S.tid = c.tid; S.A = (const char*)(ws + WS_XS); S.B = (const char*)(ws + WS_WGU); S.ta = (size_t)256 * D * 2; S.tb = (size_t)256 * D * 2; S.te = (size_t)1024 * D * 2; S.texp = texp;
            EpiGateUp E{(bf16*)(ws + WS_H)};
            pg8::gemm_phase<EpiGateUp, SchedMoe, PG8_ALIGN, PG8_SP2>(c.lds, g, S, E);
#ifdef REP_GEMM
            pg8::gemm_phase<EpiGateUp, SchedMoe, PG8_ALIGN, PG8_SP2>(c.lds, g, S, E);
#endif
            SEAM(pb + PH_MOE_GU); TP_END(pb + PH_MOE_GU); }
        if (IN(pb + PH_MOE_DN)) { TP_BEGIN(pb + PH_MOE_DN); PHASE_BEGIN
            const int* texp = (const int*)(ws + WS_TEXP) + layer * 512;
            Gemm g{FF, FF, FF}; SchedMoe S; S.nM = texp[255]; S.nN = 8; S.G = c.G; S.c = c.bx; S.tid = c.tid; S.A = (const char*)(ws + WS_H); S.B = (const char*)(ws + WS_WDN); S.ta = (size_t)256 * FF * 2; S.tb = (size_t)256 * FF * 2; S.te = (size_t)D * FF * 2; S.texp = texp;
            EpiStore<0> E{(bf16*)(ws + WS_YS), D};
            pg8::gemm_phase<EpiStore<0>, SchedMoe, PG8_ALIGN, PG8_SP2>(c.lds, g, S, E);
#ifdef REP_GEMM
            pg8::gemm_phase<EpiStore<0>, SchedMoe, PG8_ALIGN, PG8_SP2>(c.lds, g, S, E);
#endif
            SEAM(pb + PH_MOE_DN); TP_END(pb + PH_MOE_DN); }
        if (IN(pb + PH_LN2)) { TP_BEGIN(pb + PH_LN2); PHASE_BEGIN ph_ln2(c, args, layer); __syncthreads(); SEAM(pb + PH_LN2); TP_END(pb + PH_LN2); }
    }
#ifdef TIME_PHASE
    if (blockIdx.x == 0) { const unsigned long long w0 = __builtin_amdgcn_s_memrealtime(), dw = tp_b_ * TIME_AMP; while (__builtin_amdgcn_s_memrealtime() - w0 < dw) __builtin_amdgcn_s_sleep(8); }
#endif
#undef IN
#undef SEAM
}

#ifndef TRUNC_PH
#define TRUNC_PH NPH
#endif
#ifndef DUMP_MODE
#define DUMP_MODE 0
#endif
#if DUMP_MODE
__global__ void dump_k(float* out, const unsigned char* ws) {
    for (size_t i = (size_t)blockIdx.x * blockDim.x + threadIdx.x; i < (size_t)T * D; i += (size_t)gridDim.x * blockDim.x) {
        const int t = (int)(i / D), c = (int)(i % D); float v = 0.f;
#if DUMP_MODE == 1
        v = bf2f(((const bf16*)(ws + WS_PROJ))[(size_t)t * LDP + c * 5]);
#elif DUMP_MODE == 2
        if (c < 1024) v = bf2f(((const bf16*)(ws + WS_YRW))[(size_t)t * 1024 + c]); else v = bf2f(((const bf16*)(ws + WS_YNSA))[(size_t)t * 1024 + c - 1024]);
#elif DUMP_MODE == 3
        if (c < 1024) v = bf2f(((const bf16*)(ws + WS_YRET))[(size_t)t * 1024 + c]); else v = bf2f(((const bf16*)(ws + WS_MERGED))[(size_t)t * D + c]);
#elif DUMP_MODE == 4
        if (c < 1024) v = bf2f(((const bf16*)(ws + WS_YRET))[(size_t)t * 1024 + c]);
#elif DUMP_MODE == 5
        v = bf2f(((const bf16*)(ws + WS_GATES))[(size_t)t * NG + c * 3]);
#endif
        out[i] = (v == v && fabsf(v) < 1e30f) ? v : 0.f; }
}
#endif
extern "C" void kernel_launch(void* const* d_in, const int* in_sizes, int n_in, void* d_out, int out_size, void* d_ws, size_t ws_size, hipStream_t stream) {
    static int grid = 0;
    if (grid == 0) {
        if (n_in != 36 || out_size != T * D || ws_size < WS_END) { fprintf(stderr, "kernel_launch: unexpected shapes (n_in %d out %d ws %zu)\n", n_in, out_size, ws_size); grid = -1; return; }
        int dev = 0, cus = 0, per_cu = 0;
        if (hipGetDevice(&dev) != hipSuccess || hipDeviceGetAttribute(&cus, hipDeviceAttributeMultiprocessorCount, dev) != hipSuccess) { grid = -1; return; }
        if (hipFuncSetAttribute((const void*)fwd, hipFuncAttributeMaxDynamicSharedMemorySize, LDS_BYTES) != hipSuccess) { fprintf(stderr, "kernel_launch: hipFuncSetAttribute failed\n"); grid = -1; return; }
        if (hipOccupancyMaxActiveBlocksPerMultiprocessor(&per_cu, (const void*)fwd, 512, LDS_BYTES) != hipSuccess || per_cu < 1) fprintf(stderr, "kernel_launch: occupancy query says %d\n", per_cu);
        (void)hipGetLastError();
        grid = cus;
    }
    if (grid < 0) return;
    if (hipMemsetAsync((char*)d_ws + WS_CTL, 0, CTL_ZERO_BYTES, stream) != hipSuccess) return;
    Args a{};
    for (int i = 0; i < 36; ++i) a.in[i] = (const float*)d_in[i];
    a.out = (float*)d_out; a.ws = (unsigned char*)d_ws;
#if MK_ONE_LAUNCH
    a.ph_lo = 0; a.ph_hi = NPH;
    hipLaunchKernelGGL(fwd, dim3(grid), dim3(512), LDS_BYTES, stream, a);
#else
    for (int p = 0; p < TRUNC_PH; ++p) { a.ph_lo = p; a.ph_hi = p + 1; hipLaunchKernelGGL(fwd, dim3(grid), dim3(512), LDS_BYTES, stream, a); }
#if DUMP_MODE
    dump_k<<<2048, 256, 0, stream>>>((float*)d_out, (const unsigned char*)d_ws);
#endif
#endif
}
```
